# Optimizing an MI355X kernel written in HIP

```python
import math
import jax
import jax.numpy as jnp
from jax import lax
import numpy as np

D_MODEL = 1024
BATCH = 8
SEQ = 4096
DEPTH = 2

PLE_DIM = 256
CONV_K = 4
NORM_EPS = 1e-6
N_BRANCH = 3
D_FF = 4 * D_MODEL

GDN_HEADS = 8
GDN_DK = 64
GDN_DV = 64
GDN_CHUNK = 64
GDN_QK = GDN_HEADS * GDN_DK
GDN_VW = GDN_HEADS * GDN_DV
GDN_QKV = 2 * GDN_QK + GDN_VW

SSM_HEADS = 8
SSM_HEAD_DIM = 64
SSM_GROUPS = 2
SSM_STATE = 64
SSM_CHUNK = 128
SSM_INNER = SSM_HEADS * SSM_HEAD_DIM
SSM_XBC = SSM_INNER + 2 * SSM_GROUPS * SSM_STATE

RET_HEADS = 8
RET_DK = 64
RET_DV = 64
RET_CHUNK = 128
RET_QK = RET_HEADS * RET_DK
RET_VW = RET_HEADS * RET_DV
ROPE_BASE = 10000.0

BRANCH_W = 512

IN_SPLITS = (
    GDN_QKV, GDN_VW, GDN_HEADS, GDN_HEADS,
    SSM_INNER, SSM_XBC, SSM_HEADS,
    RET_QK, RET_QK, RET_VW, RET_VW,
    N_BRANCH * D_MODEL,
)

kernel_name = "hybrid_gdn_ssd_retention_block"

F32 = jnp.float32


def rmsnorm(x, w=None, eps=NORM_EPS):
    xf = x.astype(F32)
    y = xf * lax.rsqrt(jnp.mean(xf * xf, axis=-1, keepdims=True) + eps)
    if w is not None:
        y = y * w.astype(F32)
    return y.astype(x.dtype)


def l2norm(x, eps=1e-6):
    return x * lax.rsqrt(jnp.sum(x * x, axis=-1, keepdims=True) + eps)


def split_cols(t, sizes):
    idx = np.cumsum(np.array(sizes))[:-1].tolist()
    return jnp.split(t, idx, axis=-1)


def causal_dwconv(x, w, b=None):
    K, C = w.shape
    y = lax.conv_general_dilated(
        x, w[:, None, :].astype(x.dtype), window_strides=(1,), padding=[(K - 1, 0)],
        dimension_numbers=('NWC', 'WIO', 'NWC'), feature_group_count=C)
    if b is not None:
        y = y + b.astype(y.dtype)
    return y


def to_chunks(t, L):
    Bz, S, H = t.shape[:3]
    t = t.reshape((Bz, S // L, L, H) + t.shape[3:])
    return jnp.moveaxis(t, 3, 1)


def from_chunks(t):
    Bz, H, NC, L = t.shape[:4]
    t = jnp.moveaxis(t, 1, 3)
    return t.reshape((Bz, NC * L, H) + t.shape[4:])


def rotary(t, pos):
    half = t.shape[-1] // 2
    inv_freq = ROPE_BASE ** (-jnp.linspace(0.0, 1.0, half, dtype=F32))
    ang = pos[:, None] * inv_freq[None, :]
    cos = jnp.cos(ang)[:, None, :]
    sin = jnp.sin(ang)[:, None, :]
    t1, t2 = t[..., :half], t[..., half:]
    return jnp.concatenate([t1 * cos - t2 * sin, t1 * sin + t2 * cos], axis=-1)


def chunk_gated_delta_rule(q, k, v, g, beta):
    Bz, S, H, DK = q.shape
    DV = v.shape[-1]
    L = GDN_CHUNK
    q, k, v, g, beta = (to_chunks(t, L) for t in (q, k, v, g, beta))
    g = jnp.cumsum(g, axis=-1)
    tril = jnp.tril(jnp.ones((L, L), bool))
    strict = jnp.tril(jnp.ones((L, L), bool), -1)
    decay = jnp.exp(jnp.where(tril, g[..., :, None] - g[..., None, :], -jnp.inf))
    kb = k * beta[..., None]
    vb = v * beta[..., None]
    A = jnp.where(strict, jnp.einsum('bhcld,bhcsd->bhcls', kb, k) * decay, 0.0)
    eye = jnp.eye(L, dtype=F32)
    rhs = jnp.concatenate([vb, kb * jnp.exp(g)[..., None]], axis=-1)
    sol = lax.linalg.triangular_solve(eye + A, rhs, left_side=True, lower=True, unit_diagonal=True)
    u, w = sol[..., :DV], sol[..., DV:]
    attn = jnp.einsum('bhcld,bhcsd->bhcls', q, k) * decay
    q_dec = q * jnp.exp(g)[..., None]
    k_dec = k * jnp.exp(g[..., -1:] - g)[..., None]
    g_last = jnp.exp(g[..., -1])
    xs = tuple(jnp.moveaxis(t, 2, 0) for t in (u, w, attn, q_dec, k_dec, g_last))

    def step(state, inp):
        u_c, w_c, attn_c, qd_c, kd_c, gl_c = inp
        v_new = u_c - jnp.einsum('bhld,bhde->bhle', w_c, state)
        o_c = jnp.einsum('bhld,bhde->bhle', qd_c, state) + jnp.einsum('bhls,bhse->bhle', attn_c, v_new)
        state = state * gl_c[..., None, None] + jnp.einsum('bhld,bhle->bhde', kd_c, v_new)
        return state, o_c

    state0 = jnp.zeros((Bz, H, DK, DV), F32)
    _, o = lax.scan(step, state0, xs)
    return from_chunks(jnp.moveaxis(o, 0, 2))


def gated_deltanet(qkv, z, b, a, conv_w, A_log, dt_bias, norm_w):
    Bz, S, _ = qkv.shape
    H = GDN_HEADS
    qkv = jax.nn.silu(causal_dwconv(qkv, conv_w)).astype(F32)
    q, k, v = jnp.split(qkv, [GDN_QK, 2 * GDN_QK], axis=-1)
    q = l2norm(q.reshape(Bz, S, H, GDN_DK)) * (GDN_DK ** -0.5)
    k = l2norm(k.reshape(Bz, S, H, GDN_DK))
    v = v.reshape(Bz, S, H, GDN_DV)
    beta = jax.nn.sigmoid(b.astype(F32))
    g = -jnp.exp(A_log.astype(F32)) * jax.nn.softplus(a.astype(F32) + dt_bias.astype(F32))
    o = chunk_gated_delta_rule(q, k, v, g, beta)
    o = rmsnorm(o, norm_w) * jax.nn.silu(z.astype(F32).reshape(Bz, S, H, GDN_DV))
    return o.reshape(Bz, S, GDN_VW)


def ssd_chunked(X, a, Bm, Cm):
    Bz, S, H, P = X.shape
    G, N = Bm.shape[2:]
    R = H // G
    L = SSM_CHUNK
    NC = S // L
    X = X.reshape(Bz, NC, L, G, R, P)
    a = a.reshape(Bz, NC, L, G, R)
    Bm = Bm.reshape(Bz, NC, L, G, N)
    Cm = Cm.reshape(Bz, NC, L, G, N)
    a_cs = jnp.cumsum(a, axis=2)
    tril = jnp.tril(jnp.ones((L, L), bool))[:, :, None, None]
    seg = a_cs[:, :, :, None] - a_cs[:, :, None, :]
    Lmat = jnp.exp(jnp.where(tril, seg, -jnp.inf))
    CB = jnp.einsum('bclgn,bcsgn->bclsg', Cm, Bm)
    y_diag = jnp.einsum('bclsg,bclsgr,bcsgrp->bclgrp', CB, Lmat, X)
    decay_states = jnp.exp(a_cs[:, :, -1:] - a_cs)
    states = jnp.einsum('bclgn,bclgr,bclgrp->bcgrpn', Bm, decay_states, X)
    chunk_decay = jnp.exp(a_cs[:, :, -1])

    def step(h, inp):
        s_c, d_c = inp
        return h * d_c[..., None, None] + s_c, h

    h0 = jnp.zeros((Bz, G, R, P, N), F32)
    _, h_in = lax.scan(step, h0, (jnp.moveaxis(states, 1, 0), jnp.moveaxis(chunk_decay, 1, 0)))
    h_in = jnp.moveaxis(h_in, 0, 1)
    y_off = jnp.einsum('bclgn,bcgrpn,bclgr->bclgrp', Cm, h_in, jnp.exp(a_cs))
    return (y_diag + y_off).reshape(Bz, S, H, P)


def mamba2_ssd(z, xbc, dt, conv_w, conv_b, A_log, dt_bias, D, norm_w):
    Bz, S, _ = z.shape
    G = SSM_GROUPS
    xbc = jax.nn.silu(causal_dwconv(xbc, conv_w, conv_b)).astype(F32)
    xs, Bm, Cm = jnp.split(xbc, [SSM_INNER, SSM_INNER + G * SSM_STATE], axis=-1)
    xs = xs.reshape(Bz, S, SSM_HEADS, SSM_HEAD_DIM)
    Bm = Bm.reshape(Bz, S, G, SSM_STATE)
    Cm = Cm.reshape(Bz, S, G, SSM_STATE)
    dt = jax.nn.softplus(dt.astype(F32) + dt_bias.astype(F32))
    A = -jnp.exp(A_log.astype(F32))
    y = ssd_chunked(xs * dt[..., None], A * dt, Bm, Cm)
    y = y + D.astype(F32)[:, None] * xs
    y = y.reshape(Bz, S, SSM_INNER) * jax.nn.silu(z.astype(F32))
    gs = SSM_INNER // G
    y = rmsnorm(y.reshape(Bz, S, G, gs), norm_w.reshape(G, gs))
    return y.reshape(Bz, S, SSM_INNER)


def retention(q, k, v, gate):
    Bz, S, _ = q.shape
    H, L = RET_HEADS, RET_CHUNK
    pos = jnp.arange(S, dtype=F32)
    q = rotary(q.astype(F32).reshape(Bz, S, H, RET_DK), pos)
    k = rotary(k.astype(F32).reshape(Bz, S, H, RET_DK), pos) * (RET_DK ** -0.5)
    v = v.astype(F32).reshape(Bz, S, H, RET_DV)
    q, k, v = (to_chunks(t, L) for t in (q, k, v))
    log_gamma = jnp.log1p(-jnp.exp2(-5.0 - jnp.arange(H, dtype=F32)))
    idx = jnp.arange(L, dtype=F32)
    tril = jnp.tril(jnp.ones((L, L), bool))
    dmat = jnp.exp(jnp.where(tril, (idx[:, None] - idx[None, :]) * log_gamma[:, None, None], -jnp.inf))
    attn = jnp.einsum('bhcld,bhcsd->bhcls', q, k) * dmat[:, None]
    y_in = jnp.einsum('bhcls,bhcse->bhcle', attn, v)
    k_dec = k * jnp.exp((L - 1 - idx)[None, :] * log_gamma[:, None])[:, None, :, None]
    kv = jnp.einsum('bhcld,bhcle->bhcde', k_dec, v)
    chunk_gamma = jnp.exp(L * log_gamma)

    def step(state, kv_c):
        return state * chunk_gamma[:, None, None] + kv_c, state

    s0 = jnp.zeros((Bz, H, RET_DK, RET_DV), F32)
    _, s_in = lax.scan(step, s0, jnp.moveaxis(kv, 2, 0))
    s_in = jnp.moveaxis(s_in, 0, 2)
    q_dec = q * jnp.exp((idx + 1)[None, :] * log_gamma[:, None])[:, None, :, None]
    y = from_chunks(y_in + jnp.einsum('bhcld,bhcde->bhcle', q_dec, s_in))
    y = rmsnorm(y) * jax.nn.silu(gate.astype(F32).reshape(Bz, S, H, RET_DV))
    return y.reshape(Bz, S, RET_VW)


def setup_inputs(seed: int = 0) -> dict:
    key = jax.random.key(seed)
    ks = jax.random.split(key, 24)

    def nrm(k, shape, fan_in):
        return jax.random.normal(k, shape, F32) * (fan_in ** -0.5)

    def gain(k, shape):
        return 1.0 + 0.02 * jax.random.normal(k, shape, F32)

    def dt_bias_init(k, shape):
        u = jax.random.uniform(k, shape, F32)
        dt = jnp.exp(u * (math.log(0.1) - math.log(0.001)) + math.log(0.001))
        return dt + jnp.log(-jnp.expm1(-dt))

    def a_log_init(k, shape):
        return jnp.log(jax.random.uniform(k, shape, F32, 1.0, 16.0))

    n_in = sum(IN_SPLITS)
    return {
        'x': jax.random.normal(ks[0], (BATCH, SEQ, D_MODEL), F32),
        'p': jax.random.normal(ks[1], (DEPTH, BATCH, SEQ, PLE_DIM), F32),
        'norm_mix': gain(ks[2], (DEPTH, D_MODEL)),
        'w_in': nrm(ks[3], (DEPTH, D_MODEL, n_in), D_MODEL),
        'gdn_conv_w': nrm(ks[4], (DEPTH, CONV_K, GDN_QKV), CONV_K),
        'gdn_A_log': a_log_init(ks[5], (DEPTH, GDN_HEADS)),
        'gdn_dt_bias': dt_bias_init(ks[6], (DEPTH, GDN_HEADS)),
        'gdn_norm_w': gain(ks[7], (DEPTH, GDN_DV)),
        'ssm_conv_w': nrm(ks[8], (DEPTH, CONV_K, SSM_XBC), CONV_K),
        'ssm_conv_b': 0.02 * jax.random.normal(ks[9], (DEPTH, SSM_XBC), F32),
        'ssm_A_log': a_log_init(ks[10], (DEPTH, SSM_HEADS)),
        'ssm_dt_bias': dt_bias_init(ks[11], (DEPTH, SSM_HEADS)),
        'ssm_D': gain(ks[12], (DEPTH, SSM_HEADS)),
        'ssm_norm_w': gain(ks[13], (DEPTH, SSM_INNER)),
        'w_branch': nrm(ks[14], (DEPTH, N_BRANCH, BRANCH_W, D_MODEL), BRANCH_W),
        'w_out': nrm(ks[15], (DEPTH, D_MODEL, D_MODEL), D_MODEL),
        'norm_mlp': gain(ks[16], (DEPTH, D_MODEL)),
        'w_up': nrm(ks[17], (DEPTH, D_MODEL, D_FF), D_MODEL),
        'w_down': nrm(ks[18], (DEPTH, D_FF, D_MODEL), D_FF),
        'norm_ple': gain(ks[19], (DEPTH, D_MODEL)),
        'w_ple_gate': nrm(ks[20], (DEPTH, D_MODEL, D_MODEL), D_MODEL),
        'w_ple_proj': nrm(ks[21], (DEPTH, PLE_DIM, D_MODEL), PLE_DIM),
        'norm_final': gain(ks[22], (D_MODEL,)),
    }


def reference(x, p, norm_mix, w_in, gdn_conv_w, gdn_A_log, gdn_dt_bias, gdn_norm_w,
              ssm_conv_w, ssm_conv_b, ssm_A_log, ssm_dt_bias, ssm_D, ssm_norm_w,
              w_branch, w_out, norm_mlp, w_up, w_down, norm_ple, w_ple_gate, w_ple_proj,
              norm_final):
    Bz, S, D = x.shape
    for i in range(DEPTH):
        h = rmsnorm(x, norm_mix[i])
        proj = jnp.einsum('bsd,dn->bsn', h, w_in[i])
        (a_qkv, a_z, a_beta, a_alpha, b_z, b_xbc, b_dt,
         c_q, c_k, c_v, c_g, gate_logits) = split_cols(proj, IN_SPLITS)
        y_a = gated_deltanet(a_qkv, a_z, a_beta, a_alpha, gdn_conv_w[i], gdn_A_log[i],
                             gdn_dt_bias[i], gdn_norm_w[i])
        y_b = mamba2_ssd(b_z, b_xbc, b_dt, ssm_conv_w[i], ssm_conv_b[i], ssm_A_log[i],
                         ssm_dt_bias[i], ssm_D[i], ssm_norm_w[i])
        y_c = retention(c_q, c_k, c_v, c_g)
        ys = jnp.stack([y_a, y_b, y_c], axis=2).astype(x.dtype)
        branch = jnp.einsum('bsnc,ncd->bsnd', ys, w_branch[i])
        gates = jax.nn.sigmoid(gate_logits.reshape(Bz, S, N_BRANCH, D))
        mixed = jnp.sum(gates * branch, axis=2)
        x = x + jnp.einsum('bsd,de->bse', mixed, w_out[i])
        h = rmsnorm(x, norm_mlp[i])
        u = jax.nn.relu(jnp.einsum('bsd,df->bsf', h, w_up[i]))
        x = x + jnp.einsum('bsf,fd->bsd', u * u, w_down[i])
        h = rmsnorm(x, norm_ple[i])
        ple = jnp.einsum('bse,ed->bsd', p[i], w_ple_proj[i])
        x = x + jax.nn.sigmoid(jnp.einsum('bsd,de->bse', h, w_ple_gate[i])) * ple
    return rmsnorm(x, norm_final)
```

```cpp
#include <hip/hip_runtime.h>
#include <cstdio>
#include <cstdint>
#include <cstring>
namespace pg8 {
#define PG8_LAS __attribute__((address_space(3)))
typedef unsigned short bf16_t;
typedef short bf16x8 __attribute__((ext_vector_type(8)));
typedef float f32x4 __attribute__((ext_vector_type(4)));
typedef unsigned u32x4 __attribute__((ext_vector_type(4)));
constexpr int BM = 256, BK = 64, HALF = 128, HTB = HALF * BK * 2  , STAGE_BYTES = 8 * HTB, NXCD = 8, WGM = 8;

__host__ __device__ __forceinline__ int lds_byte(int r, int c) { const int st = (r >> 4) * 2 + (c >> 5), rr = r & 15, cc = c & 31, ob = rr * 64 + cc * 2; return st * 1024 + (ob ^ (((ob >> 9) & 1) << 5)); }
__host__ __device__ __forceinline__ void stage_rc(int b, int& R, int& C) { const int st = b / 1024, sb = b % 1024, swz = sb ^ (((sb >> 9) & 1) << 5); R = (st >> 1) * 16 + swz / 64; C = (st & 1) * 32 + (swz % 64) / 2; }
__host__ __device__ __forceinline__ int perm32(int rho) { const int n = rho >> 4, i = rho & 15; return 8 * (i >> 2) + 4 * n + (i & 3); }

struct Unit { int pm, pn; };
struct Gemm { const bf16_t* A; const bf16_t* Bt; int M, N, K; };

struct StaticOrder {
    int nM, nN, nwg, G, c;
    __host__ __device__ void init(int M, int N, int G_, int c_) { nM = M / BM; nN = N / BM; nwg = nM * nN; G = G_; c = c_; }
    __host__ __device__ bool next(int i, Unit& u) const {
        const long L = (long)i * G + c; if (L >= nwg) return false;
        int wgid = (int)L; { const int q = nwg / NXCD, r = nwg % NXCD, xcd = wgid % NXCD, off = wgid / NXCD; wgid = (xcd < r ? xcd * (q + 1) : r * (q + 1) + (xcd - r) * q) + off; }
        const int nig = WGM * nN, gid = wgid / nig, fm = gid * WGM, gsz = (nM - fm) < WGM ? (nM - fm) : WGM;
        u.pm = fm + ((wgid % nig) % gsz); u.pn = (wgid % nig) / gsz; return true;
    }
    __device__ __forceinline__ void a_ready(const Unit&) const {}
    __device__ __forceinline__ void done(const Unit&) const {}
};

__device__ __forceinline__ unsigned cvt_pk_bf16(float lo, float hi) { unsigned r; asm volatile("v_cvt_pk_bf16_f32 %0, %1, %2" : "=v"(r) : "v"(lo), "v"(hi)); return r; }
typedef unsigned u32x2 __attribute__((ext_vector_type(2)));
__device__ __forceinline__ float bflo(unsigned w) { return __uint_as_float(w << 16); }
__device__ __forceinline__ float bfhi(unsigned w) { return __uint_as_float(w & 0xffff0000u); }
__device__ __forceinline__ u32x4 pack8(const f32x4 v0, const f32x4 v1) { u32x4 w; w.x = cvt_pk_bf16(v0[0], v0[1]); w.y = cvt_pk_bf16(v0[2], v0[3]); w.z = cvt_pk_bf16(v1[0], v1[1]); w.w = cvt_pk_bf16(v1[2], v1[3]); return w; }
__device__ __forceinline__ void unpack8(const u32x4 w, f32x4& v0, f32x4& v1) { v0 = (f32x4){bflo(w.x), bfhi(w.x), bflo(w.y), bfhi(w.y)}; v1 = (f32x4){bflo(w.z), bfhi(w.z), bflo(w.w), bfhi(w.w)}; }
constexpr float RMS_EPS = 1e-6f;
__device__ __forceinline__ void load_rstd(const float* ssqp, int row0, int fq, float (&rs)[2][4]) {
#pragma unroll
    for (int ai = 0; ai < 2; ++ai)
#pragma unroll
        for (int m = 0; m < 4; ++m) {
            if (ssqp) { const f32x4 p = *(const f32x4*)(ssqp + (size_t)(row0 + ai * HALF + m * 16) * 16 + 4 * fq); float s = (p[0] + p[1]) + (p[2] + p[3]);
                s += __shfl_xor(s, 16); s += __shfl_xor(s, 32); rs[ai][m] = rsqrtf(s * (1.0f / 1024.0f) + RMS_EPS); }
            else rs[ai][m] = 1.0f;
        }
}
struct EpiP1 {
    static constexpr bool PERM = true, AFTER_DRAIN = false, HOOK = false; static constexpr int SEG1 = -1, SEG2 = -1;
    bf16_t* ZB; bf16_t* MIX; float* SM; const float* ssqp;
    __device__ __forceinline__ void rescale(f32x4 (&)[2][2][4][2], const Unit&, int, int, int, int, int) const {}
    __device__ __forceinline__ void operator()(const f32x4 (&acc)[2][2][4][2], const Unit& u, int wr, int wc, int fr, int fq) const {
        const int row0 = u.pm * BM + wr * 64 + fr;
        float rs[2][4]; load_rstd(ssqp, row0, fq, rs);
        if (u.pn == 21) {
            if (wc == 0) {
#pragma unroll
                for (int ai = 0; ai < 2; ++ai)
#pragma unroll
                    for (int m = 0; m < 4; ++m) { float* p = SM + (size_t)(row0 + ai * HALF + m * 16) * 32 + 8 * fq;
                        *(f32x4*)p = acc[ai][0][m][0] * rs[ai][m]; *(f32x4*)(p + 4) = acc[ai][0][m][1] * rs[ai][m]; }
            }
            return;
        }
        bf16_t* base; int ldc, colt;
        if (u.pn < 6) { base = ZB; ldc = 1536; colt = u.pn * BM; } else { base = MIX; ldc = 3840; colt = (u.pn - 6) * BM; }
        const int col0 = colt + wc * 32 + 8 * fq;
#pragma unroll
        for (int ai = 0; ai < 2; ++ai)
#pragma unroll
            for (int m = 0; m < 4; ++m) { bf16_t* rowp = base + (size_t)(row0 + ai * HALF + m * 16) * ldc + col0;
#pragma unroll
                for (int bj = 0; bj < 2; ++bj) *(u32x4*)(rowp + bj * HALF) = pack8(acc[ai][bj][m][0] * rs[ai][m], acc[ai][bj][m][1] * rs[ai][m]); }
    }
};
template <int ACT> struct EpiRS {
    static constexpr bool PERM = true, AFTER_DRAIN = false, HOOK = false; static constexpr int SEG1 = -1, SEG2 = -1;
    bf16_t* O; int ldc; const float* ssqp;
    __device__ __forceinline__ void rescale(f32x4 (&)[2][2][4][2], const Unit&, int, int, int, int, int) const {}
    __device__ __forceinline__ void operator()(const f32x4 (&acc)[2][2][4][2], const Unit& u, int wr, int wc, int fr, int fq) const {
        const int row0 = u.pm * BM + wr * 64 + fr, col0 = u.pn * BM + wc * 32 + 8 * fq;
        float rs[2][4]; load_rstd(ssqp, row0, fq, rs);
#pragma unroll
        for (int ai = 0; ai < 2; ++ai)
#pragma unroll
            for (int m = 0; m < 4; ++m) { bf16_t* rowp = O + (size_t)(row0 + ai * HALF + m * 16) * ldc + col0;
#pragma unroll
                for (int bj = 0; bj < 2; ++bj) { f32x4 v0 = acc[ai][bj][m][0] * rs[ai][m], v1 = acc[ai][bj][m][1] * rs[ai][m];
                    if (ACT == 1) {
#pragma unroll
                        for (int j = 0; j < 4; ++j) { const float a = fmaxf(v0[j], 0.f), b = fmaxf(v1[j], 0.f); v0[j] = a * a; v1[j] = b * b; } }
                    *(u32x4*)(rowp + bj * HALF) = pack8(v0, v1); } }
    }
};
struct EpiMerge {
    static constexpr bool PERM = true, AFTER_DRAIN = false, HOOK = true; static constexpr int SEG1 = 8, SEG2 = 16;
    const bf16_t* GATE; bf16_t* O;
    __device__ __forceinline__ void rescale(f32x4 (&acc)[2][2][4][2], const Unit& u, int seg, int wr, int wc, int, int) const {
        int t_ = threadIdx.x; asm volatile("" : "+v"(t_)); const int fr = t_ & 15, fq = (t_ & 63) >> 4;
        const int row0 = u.pm * BM + wr * 64 + fr, col0 = u.pn * BM + wc * 32 + 8 * fq + (seg - 1) * 1024;
#pragma unroll
        for (int ai = 0; ai < 2; ++ai)
#pragma unroll
            for (int m = 0; m < 4; ++m) { const bf16_t* gp = GATE + (size_t)(row0 + ai * HALF + m * 16) * 3072 + col0;
#pragma unroll
                for (int bj = 0; bj < 2; ++bj) { const u32x4 wa = *(const u32x4*)(gp + bj * HALF), wb = *(const u32x4*)(gp + bj * HALF + 1024);
                    f32x4 a0, a1, b0, b1; unpack8(wa, a0, a1); unpack8(wb, b0, b1);
#pragma unroll
                    for (int j = 0; j < 4; ++j) {
                        acc[ai][bj][m][0][j] *= (1.0f + __expf(-b0[j])) * __builtin_amdgcn_rcpf(1.0f + __expf(-a0[j]));
                        acc[ai][bj][m][1][j] *= (1.0f + __expf(-b1[j])) * __builtin_amdgcn_rcpf(1.0f + __expf(-a1[j])); } }
                asm volatile("" ::: "memory"); }
    }
    __device__ __forceinline__ void operator()(const f32x4 (&acc)[2][2][4][2], const Unit& u, int wr, int wc, int fr, int fq) const {
        const int row0 = u.pm * BM + wr * 64 + fr, col0 = u.pn * BM + wc * 32 + 8 * fq;
#pragma unroll
        for (int ai = 0; ai < 2; ++ai)
#pragma unroll
            for (int m = 0; m < 4; ++m) { const size_t r = (size_t)(row0 + ai * HALF + m * 16);
#pragma unroll
                for (int bj = 0; bj < 2; ++bj) { const u32x4 wa = *(const u32x4*)(GATE + r * 3072 + 2048 + col0 + bj * HALF);
                    f32x4 a0, a1; unpack8(wa, a0, a1); f32x4 v0 = acc[ai][bj][m][0], v1 = acc[ai][bj][m][1];
#pragma unroll
                    for (int j = 0; j < 4; ++j) { v0[j] *= __builtin_amdgcn_rcpf(1.0f + __expf(-a0[j])); v1[j] *= __builtin_amdgcn_rcpf(1.0f + __expf(-a1[j])); }
                    *(u32x4*)(O + r * 1024 + col0 + bj * HALF) = pack8(v0, v1); }
                asm volatile("" ::: "memory"); }
    }
};
template <int MODE> struct EpiResid {
    static constexpr bool PERM = true, AFTER_DRAIN = false, HOOK = false; static constexpr int SEG1 = -1, SEG2 = -1;
    const float* base; float* X; bf16_t* XB; float* ssq_out; const float* ssq_in; const bf16_t* PLE;
    __device__ __forceinline__ void rescale(f32x4 (&)[2][2][4][2], const Unit&, int, int, int, int, int) const {}
    __device__ __forceinline__ void operator()(const f32x4 (&acc)[2][2][4][2], const Unit& u, int wr, int wc, int fr, int fq) const {
        const int row0 = u.pm * BM + wr * 64 + fr, col0 = u.pn * BM + wc * 32 + 8 * fq;
        float rs[2][4]; if (MODE == 1) load_rstd(ssq_in, row0, fq, rs);
#pragma unroll
        for (int ai = 0; ai < 2; ++ai)
#pragma unroll
            for (int m = 0; m < 4; ++m) { const size_t r = (size_t)(row0 + ai * HALF + m * 16); float ss = 0.f;
#pragma unroll
                for (int bj = 0; bj < 2; ++bj) { const size_t o = r * 1024 + col0 + bj * HALF;
                    f32x4 v0 = acc[ai][bj][m][0], v1 = acc[ai][bj][m][1];
                    if (MODE == 1) { const u32x4 wp = *(const u32x4*)(PLE + o); f32x4 p0, p1; unpack8(wp, p0, p1);
#pragma unroll
                        for (int j = 0; j < 4; ++j) { v0[j] = p0[j] * __builtin_amdgcn_rcpf(1.0f + __expf(-v0[j] * rs[ai][m])); v1[j] = p1[j] * __builtin_amdgcn_rcpf(1.0f + __expf(-v1[j] * rs[ai][m])); } }
                    v0 += *(const f32x4*)(base + o); v1 += *(const f32x4*)(base + o + 4);
                    *(f32x4*)(X + o) = v0; *(f32x4*)(X + o + 4) = v1; *(u32x4*)(XB + o) = pack8(v0, v1);
                    ss += (v0[0] * v0[0] + v0[1] * v0[1]) + (v0[2] * v0[2] + v0[3] * v0[3]) + (v1[0] * v1[0] + v1[1] * v1[1]) + (v1[2] * v1[2] + v1[3] * v1[3]); }
                ss += __shfl_xor(ss, 16); ss += __shfl_xor(ss, 32);
                if (fq == 0) ssq_out[r * 16 + u.pn * 4 + wc] = ss;
                asm volatile("" ::: "memory"); }
    }
};
template <class Epi, class Sched, bool ALIGN_EPI = false, bool SP2 = false>
__device__ __forceinline__ void gemm_phase(PG8_LAS unsigned char* lds, Gemm g, const Sched& S, const Epi& E) {
    asm volatile("" : "+s"(g.A), "+s"(g.Bt));
    int tid_ = threadIdx.x; asm volatile("" : "+v"(tid_));
    const int tid = tid_, wid = __builtin_amdgcn_readfirstlane(tid >> 6), lane = tid & 63, wr = wid >> 2, wc = wid & 3, fr = lane & 15, fq = lane >> 4;
    const int K = g.K, nt = K / BK;
    unsigned voffA[2], voffB[2];
#pragma unroll
    for (int i = 0; i < 2; ++i) { int R, C; stage_rc(tid * 16 + i * 8192, R, C); const int Rb = Epi::PERM ? ((R & ~31) + perm32(R & 31)) : R;
        voffA[i] = (unsigned)(R * K + C) * 2u; voffB[i] = (unsigned)(Rb * K + C) * 2u; }
    const size_t kstep = (size_t)(BK * 2);
    const size_t hstep = (size_t)HALF * K * 2;
    const size_t tstep = 2 * hstep;
    const unsigned ldsw = (unsigned)wid * 1024u;
    const int aoff = lds_byte(wr * 64 + fr, fq * 8), boff = lds_byte(wc * 32 + fr, fq * 8);
#define PG8_SA(b, h) (((b) * 2 + (h)) * HTB)
#define PG8_SB(b, h) ((4 + (b) * 2 + (h)) * HTB)
#define PG8_STAGE(bufoff, gbase, voff) do { _Pragma("unroll") for (int _i = 0; _i < 2; ++_i) \
        __builtin_amdgcn_global_load_lds((const unsigned*)((const char*)(gbase) + (voff)[_i]), (PG8_LAS unsigned*)(lds + (bufoff) + ldsw + _i * 8192), 16, 0, 0); } while (0)
#define PG8_LDA(dst, b, h) do { _Pragma("unroll") for (int m = 0; m < 4; ++m) _Pragma("unroll") for (int k = 0; k < 2; ++k) dst[m][k] = *(const PG8_LAS bf16x8*)(lds + PG8_SA(b, h) + aoff + m * 2048 + k * 1024); } while (0)
#define PG8_LDB(dst, b, h) do { _Pragma("unroll") for (int n = 0; n < 2; ++n) _Pragma("unroll") for (int k = 0; k < 2; ++k) dst[n][k] = *(const PG8_LAS bf16x8*)(lds + PG8_SB(b, h) + boff + n * 2048 + k * 1024); } while (0)
#define PG8_MMA(ai, bj, At, Bt) do { __builtin_amdgcn_s_setprio(1); _Pragma("unroll") for (int m = 0; m < 4; ++m) _Pragma("unroll") for (int n = 0; n < 2; ++n) _Pragma("unroll") for (int k = 0; k < 2; ++k) \
        acc[ai][bj][m][n] = __builtin_amdgcn_mfma_f32_16x16x32_bf16(Bt[n][k], At[m][k], acc[ai][bj][m][n], 0, 0, 0); __builtin_amdgcn_s_setprio(0); } while (0)
#define PG8_WAIT_V(n) asm volatile("s_waitcnt vmcnt(" #n ")" ::: "memory")
#define PG8_WAIT_L(n) asm volatile("s_waitcnt lgkmcnt(" #n ")" ::: "memory")
#define PG8_BAR __builtin_amdgcn_s_barrier()
#define PG8_SCHED __builtin_amdgcn_sched_barrier(0)
    Unit cur, nxt; int ui = 0;
    if (!S.next(0, cur)) return;
    f32x4 acc[2][2][4][2];
#pragma unroll
    for (int a = 0; a < 2; ++a)
#pragma unroll
        for (int b = 0; b < 2; ++b)
#pragma unroll
            for (int m = 0; m < 4; ++m)
#pragma unroll
                for (int n = 0; n < 2; ++n) acc[a][b][m][n] = (f32x4){0.f, 0.f, 0.f, 0.f};
    bf16x8 At[4][2], B0[2][2], B1[2][2];
    const char* cA = (const char*)g.A + (size_t)cur.pm * tstep; const char* cB = (const char*)g.Bt + (size_t)cur.pn * tstep;
    S.a_ready(cur);
    if constexpr (SP2) {
        PG8_STAGE(PG8_SB(0, 0), cB, voffB); PG8_STAGE(PG8_SB(0, 1), cB + hstep, voffB); PG8_STAGE(PG8_SA(0, 0), cA, voffA); PG8_STAGE(PG8_SA(0, 1), cA + hstep, voffA);
        if (wr == 1) PG8_BAR;
        PG8_WAIT_V(2); PG8_BAR;
        PG8_STAGE(PG8_SB(1, 0), cB + kstep, voffB); PG8_STAGE(PG8_SA(1, 0), cA + kstep, voffA); PG8_STAGE(PG8_SB(1, 1), cB + hstep + kstep, voffB);
        PG8_WAIT_V(6); PG8_BAR;
    } else {
        PG8_STAGE(PG8_SB(0, 0), cB, voffB); PG8_STAGE(PG8_SA(0, 0), cA, voffA); PG8_STAGE(PG8_SB(0, 1), cB + hstep, voffB); PG8_STAGE(PG8_SA(0, 1), cA + hstep, voffA);
        if (wr == 1) PG8_BAR;
        PG8_WAIT_V(4); PG8_BAR;
        PG8_STAGE(PG8_SB(1, 0), cB + kstep, voffB); PG8_STAGE(PG8_SA(1, 0), cA + kstep, voffA); PG8_STAGE(PG8_SB(1, 1), cB + hstep + kstep, voffB);
        PG8_WAIT_V(6); PG8_BAR;
    }
    for (;;) {
        const bool has_next = S.next(ui + 1, nxt);
        const char* nA = has_next ? (const char*)g.A + (size_t)nxt.pm * tstep : cA; const char* nB = has_next ? (const char*)g.Bt + (size_t)nxt.pn * tstep : cB;
        for (int t = 0; t < nt; t += 2) {
            const bool last = (t == nt - 2);
            const char* a1 = cA + (size_t)(t + 1) * kstep;
            const char* a2 = last ? nA : cA + (size_t)(t + 2) * kstep; const char* b2 = last ? nB : cB + (size_t)(t + 2) * kstep;
            const char* a3 = a2 + kstep; const char* b3 = b2 + kstep;
            if (last && has_next) S.a_ready(nxt);
            if constexpr (Epi::HOOK) { if (t == Epi::SEG1 || t == Epi::SEG2) E.rescale(acc, cur, t == Epi::SEG1 ? 1 : 2, wr, wc, fr, fq); }
            if constexpr (SP2) {
            PG8_LDB(B0, 0, 0); PG8_LDB(B1, 0, 1); PG8_SCHED; PG8_LDA(At, 0, 0); PG8_STAGE(PG8_SA(1, 1), a1 + hstep, voffA);
            PG8_WAIT_V(8); PG8_WAIT_L(0); PG8_BAR; PG8_MMA(0, 0, At, B0); PG8_MMA(0, 1, At, B1); PG8_BAR; PG8_SCHED;
            PG8_LDA(At, 0, 1); PG8_STAGE(PG8_SB(0, 0), b2, voffB); PG8_STAGE(PG8_SB(0, 1), b2 + hstep, voffB); PG8_STAGE(PG8_SA(0, 0), a2, voffA);
            PG8_WAIT_V(8); PG8_WAIT_L(0); PG8_BAR; PG8_MMA(1, 0, At, B0); PG8_MMA(1, 1, At, B1); PG8_BAR; PG8_SCHED;
            PG8_LDB(B0, 1, 0); PG8_LDB(B1, 1, 1); PG8_SCHED; PG8_LDA(At, 1, 0); PG8_STAGE(PG8_SA(0, 1), a2 + hstep, voffA);
            PG8_WAIT_V(8); PG8_WAIT_L(0); PG8_BAR; PG8_MMA(0, 0, At, B0); PG8_MMA(0, 1, At, B1); PG8_BAR; PG8_SCHED;
            PG8_LDA(At, 1, 1); PG8_STAGE(PG8_SB(1, 0), b3, voffB); PG8_STAGE(PG8_SB(1, 1), b3 + hstep, voffB); PG8_STAGE(PG8_SA(1, 0), a3, voffA);
            PG8_WAIT_V(8); PG8_WAIT_L(0); PG8_BAR; PG8_MMA(1, 0, At, B0); PG8_MMA(1, 1, At, B1); PG8_BAR; PG8_SCHED;
            } else {
            PG8_LDB(B0, 0, 0); PG8_SCHED; PG8_LDA(At, 0, 0); PG8_STAGE(PG8_SA(1, 1), a1 + hstep, voffA);
            PG8_WAIT_L(8); PG8_BAR; PG8_WAIT_L(0); PG8_MMA(0, 0, At, B0); PG8_BAR; PG8_SCHED;
            PG8_LDB(B1, 0, 1); PG8_STAGE(PG8_SB(0, 0), b2, voffB);
            PG8_BAR; PG8_WAIT_L(0); PG8_MMA(0, 1, At, B1); PG8_BAR;
            PG8_LDA(At, 0, 1); PG8_STAGE(PG8_SA(0, 0), a2, voffA);
            PG8_BAR; PG8_WAIT_L(0); PG8_MMA(1, 0, At, B0); PG8_BAR; PG8_SCHED;
            PG8_STAGE(PG8_SB(0, 1), b2 + hstep, voffB);
            PG8_WAIT_V(6); PG8_BAR; PG8_MMA(1, 1, At, B1); PG8_BAR;
            PG8_LDB(B0, 1, 0); PG8_SCHED; PG8_LDA(At, 1, 0); PG8_STAGE(PG8_SA(0, 1), a2 + hstep, voffA);
            PG8_WAIT_L(8); PG8_BAR; PG8_WAIT_L(0); PG8_MMA(0, 0, At, B0); PG8_BAR; PG8_SCHED;
            PG8_LDB(B1, 1, 1); PG8_STAGE(PG8_SB(1, 0), b3, voffB);
            PG8_BAR; PG8_WAIT_L(0); PG8_MMA(0, 1, At, B1); PG8_BAR;
            PG8_LDA(At, 1, 1); PG8_STAGE(PG8_SA(1, 0), a3, voffA);
            PG8_BAR; PG8_WAIT_L(0); PG8_MMA(1, 0, At, B0); PG8_BAR; PG8_SCHED;
            PG8_STAGE(PG8_SB(1, 1), b3 + hstep, voffB);
            PG8_WAIT_V(6); PG8_BAR; PG8_MMA(1, 1, At, B1); PG8_BAR;
            }
        }
        if constexpr (ALIGN_EPI) { if (wr == 0) PG8_BAR; }
        if constexpr (!Epi::AFTER_DRAIN) { E(acc, cur, wr, wc, fr, fq); S.done(cur); }
        if (!has_next) break;
#pragma unroll
        for (int a = 0; a < 2; ++a)
#pragma unroll
            for (int b = 0; b < 2; ++b)
#pragma unroll
                for (int m = 0; m < 4; ++m)
#pragma unroll
                    for (int n = 0; n < 2; ++n) acc[a][b][m][n] = (f32x4){0.f, 0.f, 0.f, 0.f};
        cur = nxt; cA = nA; cB = nB; ++ui;
        if constexpr (ALIGN_EPI) { if (wr == 1) PG8_BAR; }
    }
    PG8_WAIT_V(0);
    if constexpr (!ALIGN_EPI) { if (wr == 0) PG8_BAR; }
    PG8_BAR;
    if constexpr (Epi::AFTER_DRAIN) { E.fused(acc, cur, wr, wc, fr, fq, lds, wid, lane); S.done(cur); }
#undef PG8_SA
#undef PG8_SB
#undef PG8_STAGE
#undef PG8_LDA
#undef PG8_LDB
#undef PG8_MMA
#undef PG8_WAIT_V
#undef PG8_WAIT_L
#undef PG8_BAR
#undef PG8_SCHED
}
}
constexpr int DM = 1024, NBATCH = 8, SEQ = 4096, MTOK = NBATCH * SEQ, DEPTH = 2, DFF = 4096, PLED = 256, NIN = 8472;
constexpr int ZB_LD = 1536, MIX_LD = 3840, SM_LD = 32, N1 = 5632, NGATE = 3072, KMERGE = 1536;
constexpr int MX_AQ = 0, MX_AK = 512, MX_AV = 1024, MX_BX = 1536, MX_BB = 2048, MX_BC = 2176, MX_CQ = 2304, MX_CK = 2816, MX_CV = 3328;
constexpr size_t KiB = 1024, MiB = 1024 * 1024;
constexpr size_t WS_CTL = 0, CTL_BYTES = 64 * KiB;
constexpr size_t WS_W = 1 * MiB;
constexpr size_t W_1T = WS_W, W_GT = W_1T + (size_t)N1 * DM * 2, W_MT = W_GT + (size_t)NGATE * DM * 2, W_OT = W_MT + (size_t)DM * KMERGE * 2, W_UT = W_OT + (size_t)DM * DM * 2,
                 W_DT = W_UT + (size_t)DFF * DM * 2, W_PGT = W_DT + (size_t)DM * DFF * 2, W_PPT = W_PGT + (size_t)DM * DM * 2, W_END = W_PPT + (size_t)DM * PLED * 2;
constexpr size_t WS_ROPE = W_1T, WS_SSQA = W_1T + 1 * MiB, WS_SSQB = W_1T + 3 * MiB;
constexpr size_t WS_XB0 = W_END, WS_XB1 = WS_XB0 + 64 * MiB, WS_ZB = WS_XB1 + 64 * MiB, WS_MIX = WS_ZB + 96 * MiB, WS_SM = WS_MIX + 240 * MiB, WS_SSQC = WS_SM + 4 * MiB, WS_END = WS_SSQC + 2 * MiB;
constexpr size_t WS_PB = WS_ZB, WS_PLE = WS_ZB + 16 * MiB, WS_U = WS_ZB + 80 * MiB, WS_GATE = WS_MIX;
static_assert(W_END == WS_W + (size_t)(40 * MiB + 512 * KiB), "weights");
static_assert(WS_U + (size_t)MTOK * DFF * 2 == WS_SM, "U overlay");
static_assert(WS_END <= 512 * MiB, "workspace");
constexpr int LDS_BYTES = 147456, RING_BYTES = 131072, MISC_OFF = RING_BYTES + 320;

#define GAS __attribute__((address_space(1)))
#define LAS __attribute__((address_space(3)))
typedef unsigned short bf16;
typedef unsigned v4u __attribute__((ext_vector_type(4)));
typedef unsigned v2u __attribute__((ext_vector_type(2)));
typedef float f32x4 __attribute__((ext_vector_type(4)));
#define LDS_WAIT() asm volatile("s_waitcnt lgkmcnt(0)" ::: "memory")
__device__ __forceinline__ unsigned f2bf(float f) { unsigned u = __builtin_bit_cast(unsigned, f); return (u + 0x7fffu + ((u >> 16) & 1u)) >> 16; }
__device__ __forceinline__ unsigned pk2(float lo, float hi) { return f2bf(lo) | (f2bf(hi) << 16); }
__device__ __forceinline__ float bf2f(bf16 v) { return __uint_as_float((unsigned)v << 16); }
__device__ __forceinline__ float wave_sum(float v) {
#pragma unroll
    for (int o = 1; o < 64; o <<= 1) v += __shfl_xor(v, o);
    return v;
}
__device__ __forceinline__ float siluf(float x) { return x / (1.0f + __expf(-x)); }
__device__ __forceinline__ float sigmf(float x) { return 1.0f / (1.0f + __expf(-x)); }
__device__ __forceinline__ float softplusf(float x) { return fmaxf(x, 0.f) + log1pf(__expf(-fabsf(x))); }
__device__ __forceinline__ float rdl(float v, int l) { return __int_as_float(__builtin_amdgcn_readlane(__float_as_int(v), l)); }

#define XB_TMO      128
#define XB_XCNT(j)  (256  + 64 * (j))
#define XB_XSUB(j)  (1280 + 64 * (j))
#define XB_XGEN(j)  (2304 + 64 * (j))
#define XB_TOP      3328
#define XB_TOPGEN   3392
#define XCD_BAR_WORDS 3456
#define XB_SPIN_CAP (1u << 18)
__device__ __forceinline__ unsigned xb_ld(unsigned* p)              { return __hip_atomic_load(p, __ATOMIC_RELAXED, __HIP_MEMORY_SCOPE_AGENT); }
__device__ __forceinline__ unsigned xb_add(unsigned* p, unsigned v) { return __hip_atomic_fetch_add(p, v, __ATOMIC_RELAXED, __HIP_MEMORY_SCOPE_AGENT); }
__device__ __forceinline__ unsigned xb_xcc_id() { return (unsigned)__builtin_amdgcn_s_getreg((3 << 11) | 20) & 0xFu; }
#define XB_SPIN(cond, bar) do { unsigned _sp = 0; while (cond) { __builtin_amdgcn_s_sleep(1); \
    if ((++_sp & 255u) == 0u) { if (xb_ld(&(bar)[XB_TMO])) break; if (_sp > XB_SPIN_CAP) { atomicAdd(&(bar)[XB_TMO], 1u); break; } } } } while (0)
struct XcdBarrier { unsigned* bar; unsigned x; volatile LAS unsigned* st; };
__device__ __forceinline__ XcdBarrier xcd_barrier_post(unsigned* bar, volatile LAS unsigned* st) {
    XcdBarrier b; b.bar = bar; b.x = xb_xcc_id(); b.st = st;
    if (threadIdx.x == 0) (void)xb_add(&bar[XB_XCNT(b.x)], 1u);
    return b;
}
__device__ __forceinline__ void xcd_barrier_complete(unsigned* bar, unsigned x, unsigned& nloc, unsigned& nx) {
    const unsigned G = gridDim.x * gridDim.y * gridDim.z;
    unsigned sum, cnt, mine, sp = 0u;
    for (;;) {
        sum = 0u; cnt = 0u; mine = 0u;
#pragma unroll
        for (unsigned j = 0; j < 16; ++j) { const unsigned c = xb_ld(&bar[XB_XCNT(j)]); sum += c; cnt += (c > 0u) ? 1u : 0u; mine = (j == x) ? c : mine; }
        if (sum == G) break;
        __builtin_amdgcn_s_sleep(1);
        if ((++sp & 255u) == 0u) { if (xb_ld(&bar[XB_TMO])) break; if (sp > XB_SPIN_CAP) { atomicAdd(&bar[XB_TMO], 1u); break; } }
    }
    nloc = mine > 0u ? mine : 1u; nx = cnt > 0u ? cnt : 1u;
}
__device__ __forceinline__ void xcd_barrier(const XcdBarrier& b) {
    asm volatile("s_waitcnt vmcnt(0)" ::: "memory");
    __syncthreads();
    if (threadIdx.x == 0) {
        unsigned* bar = b.bar;
        __builtin_amdgcn_s_waitcnt(0);
        unsigned nloc = b.st[0], nx = b.st[1];
        if (nloc == 0u) { xcd_barrier_complete(bar, b.x, nloc, nx); b.st[0] = nloc; b.st[1] = nx; }
        const unsigned old = xb_add(&bar[XB_XSUB(b.x)], 1u);
        const unsigned gen = old / nloc;
        if (old + 1u == (gen + 1u) * nloc) {
            __builtin_amdgcn_fence(__ATOMIC_RELEASE, "agent");
            asm volatile("s_waitcnt vmcnt(0)" ::: "memory");
            const unsigned og = xb_add(&bar[XB_TOP], 1u);
            const unsigned tg = og / nx;
            if (og + 1u == (tg + 1u) * nx) xb_add(&bar[XB_TOPGEN], 1u);
            else XB_SPIN(xb_ld(&bar[XB_TOPGEN]) == tg, bar);
            __builtin_amdgcn_fence(__ATOMIC_ACQUIRE, "agent");
            xb_add(&bar[XB_XGEN(b.x)], 1u);
            asm volatile("s_waitcnt vmcnt(0)" ::: "memory");
        } else {
            XB_SPIN(xb_ld(&bar[XB_XGEN(b.x)]) == gen, bar);
            __builtin_amdgcn_fence(__ATOMIC_ACQUIRE, "agent");
            asm volatile("s_waitcnt vmcnt(0)" ::: "memory");
        }
    }
    __syncthreads();
}

__device__ __forceinline__ void tr_item(const float* W, int ldw, int c0, int ncols, const float* scale, bf16* dst, int ldd, int r0, int kofs, LAS float* scr, int item, int lane) {
    const int nblk = (ncols + 31) / 32, kb = item / nblk, nb = item % nblk, k0 = 64 * kb, n0 = 32 * nb;
    const int nn = n0 + (lane & 31);
#pragma unroll 8
    for (int i = 0; i < 32; ++i) { const int kk = 2 * i + (lane >> 5); float v = 0.f;
        if (W != nullptr && nn < ncols) { v = W[(size_t)(k0 + kk) * ldw + c0 + nn]; if (scale) v *= scale[k0 + kk]; }
        scr[kk * 33 + (lane & 31)] = v; }
    LDS_WAIT(); asm volatile("" ::: "memory");
    const int c = lane & 7;
#pragma unroll
    for (int j = 0; j < 4; ++j) { const int n = (lane >> 3) + 8 * j; const LAS float* s = scr + (8 * c) * 33 + n;
        v4u o; o.x = pk2(s[0 * 33], s[1 * 33]); o.y = pk2(s[2 * 33], s[3 * 33]); o.z = pk2(s[4 * 33], s[5 * 33]); o.w = pk2(s[6 * 33], s[7 * 33]);
        if (n0 + n < ncols) *(GAS v4u*)(dst + (size_t)(r0 + n0 + n) * ldd + kofs + k0 + 8 * c) = o; }
    LDS_WAIT(); asm volatile("" ::: "memory");
}
#define TR_SEG(W_, ldw_, c0_, ncols_, K_, scale_, dst_, ldd_, r0_, kofs_) do { const int _n = ((K_) / 64) * (((ncols_) + 31) / 32); \
    for (int _it = (gw + NGW - (ibase % NGW)) % NGW; _it < _n; _it += NGW) tr_item(W_, ldw_, c0_, ncols_, scale_, dst_, ldd_, r0_, kofs_, scr, _it, lane); ibase += _n; } while (0)

struct Args { const float* in[23]; float* out; unsigned char* ws; int ph_lo, ph_hi; };
constexpr int NPH = 10, PH_FINAL = DEPTH * NPH, N_PHASES = PH_FINAL + 1;

constexpr int WG = 8;
__device__ __forceinline__ void gdn_naive(const Args& A, int layer, int b, int h, int lane, const bf16* MIX, const float* SM, bf16* ZB) {
    const float* cw = A.in[4] + (size_t)layer * 4 * 1536;
    float wq[4], wk[4], wv[4];
#pragma unroll
    for (int k = 0; k < 4; ++k) { wq[k] = cw[k * 1536 + h * 64 + lane]; wk[k] = cw[k * 1536 + 512 + h * 64 + lane]; wv[k] = cw[k * 1536 + 1024 + h * 64 + lane]; }
    const float Aexp = expf(A.in[5][layer * 8 + h]), dtb = A.in[6][layer * 8 + h], nw = A.in[7][layer * 64 + lane];
    float M[64];
#pragma unroll
    for (int d = 0; d < 64; ++d) M[d] = 0.f;
    float hq0 = 0.f, hq1 = 0.f, hq2 = 0.f, hk0 = 0.f, hk1 = 0.f, hk2 = 0.f, hv0 = 0.f, hv1 = 0.f, hv2 = 0.f;
    const size_t tok0 = (size_t)b * SEQ;
    bf16 nq[WG], nk[WG], nv[WG], nz[WG]; float nb[WG], na[WG];
#define GDN_LOAD(t0) do { _Pragma("unroll") for (int i = 0; i < WG; ++i) { const size_t r = tok0 + (t0) + i; const bf16* mp = MIX + r * MIX_LD + h * 64 + lane; \
        nq[i] = mp[MX_AQ]; nk[i] = mp[MX_AK]; nv[i] = mp[MX_AV]; nz[i] = ZB[r * ZB_LD + h * 64 + lane]; nb[i] = SM[r * SM_LD + h]; na[i] = SM[r * SM_LD + 8 + h]; } } while (0)
    GDN_LOAD(0);
    for (int t0 = 0; t0 < SEQ; t0 += WG) {
        bf16 cq[WG], ck[WG], cv[WG], cz[WG]; float cb[WG], ca[WG];
#pragma unroll
        for (int i = 0; i < WG; ++i) { cq[i] = nq[i]; ck[i] = nk[i]; cv[i] = nv[i]; cz[i] = nz[i]; cb[i] = nb[i]; ca[i] = na[i]; }
        if (t0 + WG < SEQ) GDN_LOAD(t0 + WG);
#pragma unroll
        for (int i = 0; i < WG; ++i) {
            const float xq = bf2f(cq[i]), xk = bf2f(ck[i]), xv = bf2f(cv[i]);
            float q = siluf(wq[0] * hq0 + wq[1] * hq1 + wq[2] * hq2 + wq[3] * xq); hq0 = hq1; hq1 = hq2; hq2 = xq;
            float k = siluf(wk[0] * hk0 + wk[1] * hk1 + wk[2] * hk2 + wk[3] * xk); hk0 = hk1; hk1 = hk2; hk2 = xk;
            const float v = siluf(wv[0] * hv0 + wv[1] * hv1 + wv[2] * hv2 + wv[3] * xv); hv0 = hv1; hv1 = hv2; hv2 = xv;
            q *= rsqrtf(wave_sum(q * q) + 1e-6f) * 0.125f; k *= rsqrtf(wave_sum(k * k) + 1e-6f);
            const float beta = sigmf(cb[i]), a = __expf(-Aexp * softplusf(ca[i] + dtb));
            float r = 0.f;
#pragma unroll
            for (int d = 0; d < 64; ++d) { M[d] *= a; r += rdl(k, d) * M[d]; }
            const float u = beta * (v - r); float o = 0.f;
#pragma unroll
            for (int d = 0; d < 64; ++d) { M[d] += rdl(k, d) * u; o += rdl(q, d) * M[d]; }
            const float y = o * rsqrtf(wave_sum(o * o) * (1.0f / 64.0f) + 1e-6f) * nw * siluf(bf2f(cz[i]));
            ZB[(tok0 + t0 + i) * ZB_LD + h * 64 + lane] = (bf16)f2bf(y);
        }
    }
#undef GDN_LOAD
}
__device__ __forceinline__ void ssd_naive(const Args& A, int layer, int b, int h, int lane, const bf16* MIX, float* SM, bf16* ZB) {
    const int g = h >> 2;
    const float* cw = A.in[8] + (size_t)layer * 4 * 768; const float* cb_ = A.in[9] + (size_t)layer * 768;
    float wx[4], wB[4], wC[4];
#pragma unroll
    for (int k = 0; k < 4; ++k) { wx[k] = cw[k * 768 + h * 64 + lane]; wB[k] = cw[k * 768 + 512 + g * 64 + lane]; wC[k] = cw[k * 768 + 640 + g * 64 + lane]; }
    const float bx = cb_[h * 64 + lane], bB = cb_[512 + g * 64 + lane], bC = cb_[640 + g * 64 + lane];
    const float Aexp = expf(A.in[10][layer * 8 + h]), dtb = A.in[11][layer * 8 + h], Dh = A.in[12][layer * 8 + h];
    float Hs[64];
#pragma unroll
    for (int d = 0; d < 64; ++d) Hs[d] = 0.f;
    float hx0 = 0.f, hx1 = 0.f, hx2 = 0.f, hB0 = 0.f, hB1 = 0.f, hB2 = 0.f, hC0 = 0.f, hC1 = 0.f, hC2 = 0.f;
    const size_t tok0 = (size_t)b * SEQ;
    bf16 nx[WG], nB[WG], nC[WG], nz[WG]; float nd[WG];
#define SSD_LOAD(t0) do { _Pragma("unroll") for (int i = 0; i < WG; ++i) { const size_t r = tok0 + (t0) + i; const bf16* mp = MIX + r * MIX_LD; \
        nx[i] = mp[MX_BX + h * 64 + lane]; nB[i] = mp[MX_BB + g * 64 + lane]; nC[i] = mp[MX_BC + g * 64 + lane]; nz[i] = ZB[r * ZB_LD + 512 + h * 64 + lane]; nd[i] = SM[r * SM_LD + 16 + h]; } } while (0)
    SSD_LOAD(0);
    for (int t0 = 0; t0 < SEQ; t0 += WG) {
        bf16 cx[WG], cB[WG], cC[WG], cz[WG]; float cd[WG];
#pragma unroll
        for (int i = 0; i < WG; ++i) { cx[i] = nx[i]; cB[i] = nB[i]; cC[i] = nC[i]; cz[i] = nz[i]; cd[i] = nd[i]; }
        if (t0 + WG < SEQ) SSD_LOAD(t0 + WG);
#pragma unroll
        for (int i = 0; i < WG; ++i) {
            const float rx = bf2f(cx[i]), rB = bf2f(cB[i]), rC = bf2f(cC[i]);
            const float x = siluf(wx[0] * hx0 + wx[1] * hx1 + wx[2] * hx2 + wx[3] * rx + bx); hx0 = hx1; hx1 = hx2; hx2 = rx;
            const float Bv = siluf(wB[0] * hB0 + wB[1] * hB1 + wB[2] * hB2 + wB[3] * rB + bB); hB0 = hB1; hB1 = hB2; hB2 = rB;
            const float Cv = siluf(wC[0] * hC0 + wC[1] * hC1 + wC[2] * hC2 + wC[3] * rC + bC); hC0 = hC1; hC1 = hC2; hC2 = rC;
            const float dt = softplusf(cd[i] + dtb), a = __expf(-Aexp * dt), xdt = x * dt;
            float y = 0.f;
#pragma unroll
            for (int n = 0; n < 64; ++n) { Hs[n] = a * Hs[n] + xdt * rdl(Bv, n); y += Hs[n] * rdl(Cv, n); }
            y = (y + Dh * x) * siluf(bf2f(cz[i]));
            const float ss = wave_sum(y * y);
            const size_t r = tok0 + t0 + i;
            ZB[r * ZB_LD + 512 + h * 64 + lane] = (bf16)f2bf(y);
            if (lane == 0) SM[r * SM_LD + 24 + h] = ss;
        }
    }
#undef SSD_LOAD
}
__device__ __forceinline__ void ret_naive(int b, int h, int lane, const bf16* MIX, const float* ROPE, bf16* ZB) {
    const float gamma = 1.0f - exp2f(-5.0f - (float)h);
    float M[64];
#pragma unroll
    for (int d = 0; d < 64; ++d) M[d] = 0.f;
    const size_t tok0 = (size_t)b * SEQ;
    bf16 nq[WG], nk[WG], nv[WG], nz[WG]; float nc[WG], ns[WG];
#define RET_LOAD(t0) do { _Pragma("unroll") for (int i = 0; i < WG; ++i) { const size_t r = tok0 + (t0) + i; const bf16* mp = MIX + r * MIX_LD + h * 64 + lane; \
        nq[i] = mp[MX_CQ]; nk[i] = mp[MX_CK]; nv[i] = mp[MX_CV]; nz[i] = ZB[r * ZB_LD + 1024 + h * 64 + lane]; nc[i] = ROPE[((t0) + i) * 32 + (lane & 31)]; ns[i] = ROPE[SEQ * 32 + ((t0) + i) * 32 + (lane & 31)]; } } while (0)
    RET_LOAD(0);
    for (int t0 = 0; t0 < SEQ; t0 += WG) {
        bf16 cq[WG], ck[WG], cv[WG], cz[WG]; float cc[WG], cs[WG];
#pragma unroll
        for (int i = 0; i < WG; ++i) { cq[i] = nq[i]; ck[i] = nk[i]; cv[i] = nv[i]; cz[i] = nz[i]; cc[i] = nc[i]; cs[i] = ns[i]; }
        if (t0 + WG < SEQ) RET_LOAD(t0 + WG);
#pragma unroll
        for (int i = 0; i < WG; ++i) {
            const float q0 = bf2f(cq[i]), k0 = bf2f(ck[i]), v = bf2f(cv[i]);
            const float qp = __shfl_xor(q0, 32), kp = __shfl_xor(k0, 32);
            const float sg = lane < 32 ? -cs[i] : cs[i];
            const float q = q0 * cc[i] + qp * sg, k = (k0 * cc[i] + kp * sg) * 0.125f;
            float o = 0.f;
#pragma unroll
            for (int d = 0; d < 64; ++d) { M[d] = gamma * M[d] + rdl(k, d) * v; o += rdl(q, d) * M[d]; }
            const float y = o * rsqrtf(wave_sum(o * o) * (1.0f / 64.0f) + 1e-6f) * siluf(bf2f(cz[i]));
            ZB[(tok0 + t0 + i) * ZB_LD + 1024 + h * 64 + lane] = (bf16)f2bf(y);
        }
    }
#undef RET_LOAD
}

#ifndef MK_ONE_LAUNCH
#define MK_ONE_LAUNCH 0
#endif
__global__ void __launch_bounds__(64) mixers_naive(Args args, int layer) {
    const int lane = threadIdx.x, w = blockIdx.x, kind = w >> 6, b = (w & 63) >> 3, h = w & 7;
    unsigned char* ws = args.ws;
    bf16* ZB = (bf16*)(ws + WS_ZB); const bf16* MIX = (const bf16*)(ws + WS_MIX); float* SM = (float*)(ws + WS_SM); const float* ROPE = (const float*)(ws + WS_ROPE);
    if (kind == 0) gdn_naive(args, layer, b, h, lane, MIX, SM, ZB);
    else if (kind == 1) ssd_naive(args, layer, b, h, lane, MIX, SM, ZB);
    else ret_naive(b, h, lane, MIX, ROPE, ZB);
}
__global__ void __launch_bounds__(512, 2) fwd_kernel(Args args) {
    extern __shared__ __attribute__((aligned(16))) unsigned char lds_raw[];
    LAS unsigned char* lds = (LAS unsigned char*)lds_raw;
    volatile LAS unsigned* MISC = (volatile LAS unsigned*)(lds + MISC_OFF);
    const int G = gridDim.x, NGW = G * 8;
    unsigned char* ws0 = args.ws;
    for (int u = threadIdx.x; u < (LDS_BYTES - RING_BYTES) / 4; u += 512) ((LAS unsigned*)(lds + RING_BYTES))[u] = 0u;
    __syncthreads();
#if MK_ONE_LAUNCH
    XcdBarrier bar = xcd_barrier_post((unsigned*)(ws0 + WS_CTL) + 4096, MISC + 8);
#define GRID_BAR() xcd_barrier(bar)
#else
#define GRID_BAR() do {} while (0)
#endif
    const int lo = args.ph_lo, hi = args.ph_hi;
#define IN(p) (lo <= (p) && (p) < hi)
#define SEAM(p) do { if (IN(p) && IN((p) + 1)) GRID_BAR(); } while (0)
    typedef const __attribute__((address_space(4))) Args* KArgs;
    const KArgs kp0 = (KArgs)__builtin_amdgcn_kernarg_segment_ptr();
#define PHASE_PTRS() KArgs kp = kp0; asm volatile("" : "+s"(kp)); unsigned char* ws = kp->ws; float* X = kp->out; (void)X; \
    int tid = threadIdx.x; asm volatile("" : "+v"(tid)); const int lane = tid & 63, wave = __builtin_amdgcn_readfirstlane(tid >> 6), gw = blockIdx.x * 8 + wave; (void)lane; (void)gw; \
    bf16* ZB = (bf16*)(ws + WS_ZB); bf16* MIX = (bf16*)(ws + WS_MIX); float* SM = (float*)(ws + WS_SM); (void)ZB; (void)MIX; (void)SM; \
    float* SSQA = (float*)(ws + WS_SSQA); float* SSQB = (float*)(ws + WS_SSQB); float* SSQC = (float*)(ws + WS_SSQC); float* ROPE = (float*)(ws + WS_ROPE); (void)SSQA; (void)SSQB; (void)SSQC; (void)ROPE; \
    bf16* W1T = (bf16*)(ws + W_1T); bf16* WGT = (bf16*)(ws + W_GT); bf16* WMT = (bf16*)(ws + W_MT); bf16* WOT = (bf16*)(ws + W_OT); bf16* WUT = (bf16*)(ws + W_UT); (void)W1T; (void)WGT; (void)WMT; (void)WOT; (void)WUT; \
    bf16* WDT = (bf16*)(ws + W_DT); bf16* WPGT = (bf16*)(ws + W_PGT); bf16* WPPT = (bf16*)(ws + W_PPT); (void)WDT; (void)WPGT; (void)WPPT; \
    bf16* GATE = (bf16*)(ws + WS_GATE); bf16* U = (bf16*)(ws + WS_U); bf16* PB = (bf16*)(ws + WS_PB); bf16* PLE = (bf16*)(ws + WS_PLE); (void)GATE; (void)U; (void)PB; (void)PLE; \
    bf16* XBl = (bf16*)(ws + ((layer & 1) ? WS_XB1 : WS_XB0)); bf16* XBf = (bf16*)(ws + ((layer & 1) ? WS_XB0 : WS_XB1)); (void)XBl; (void)XBf
    for (int layer = 0; layer < DEPTH; ++layer) {
        const int P = layer * NPH;
        if (IN(P + 0)) { PHASE_PTRS();
            LAS float* scr = (LAS float*)(lds + wave * 16384);
            int ibase = 0;
            const float* w_in = kp->in[3] + (size_t)layer * DM * NIN; const float* nmix = kp->in[2] + (size_t)layer * DM;
            TR_SEG(w_in, NIN, 1536, 512, DM, nmix, W1T, DM, 0, 0);
            TR_SEG(w_in, NIN, 2064, 512, DM, nmix, W1T, DM, 512, 0);
            TR_SEG(w_in, NIN, 4888, 512, DM, nmix, W1T, DM, 1024, 0);
            TR_SEG(w_in, NIN, 0, 1536, DM, nmix, W1T, DM, 1536, 0);
            TR_SEG(w_in, NIN, 2576, 768, DM, nmix, W1T, DM, 3072, 0);
            TR_SEG(w_in, NIN, 3352, 1536, DM, nmix, W1T, DM, 3840, 0);
            TR_SEG(w_in, NIN, 2048, 16, DM, nmix, W1T, DM, 5376, 0);
            TR_SEG(w_in, NIN, 3344, 8, DM, nmix, W1T, DM, 5392, 0);
            TR_SEG((const float*)nullptr, NIN, 0, 232, DM, (const float*)nullptr, W1T, DM, 5400, 0);
            TR_SEG(w_in, NIN, 5400, 3072, DM, nmix, WGT, DM, 0, 0);
            const float* wbr = kp->in[14] + (size_t)layer * 3 * 512 * DM;
            TR_SEG(wbr, DM, 0, DM, 512, (const float*)nullptr, WMT, KMERGE, 0, 0);
            TR_SEG(wbr + 512 * DM, DM, 0, DM, 512, kp->in[13] + (size_t)layer * 512, WMT, KMERGE, 0, 512);
            TR_SEG(wbr + 2 * 512 * DM, DM, 0, DM, 512, (const float*)nullptr, WMT, KMERGE, 0, 1024);
            TR_SEG(kp->in[15] + (size_t)layer * DM * DM, DM, 0, DM, DM, (const float*)nullptr, WOT, DM, 0, 0);
            TR_SEG(kp->in[17] + (size_t)layer * DM * DFF, DFF, 0, DFF, DM, kp->in[16] + (size_t)layer * DM, WUT, DM, 0, 0);
            TR_SEG(kp->in[18] + (size_t)layer * DFF * DM, DM, 0, DM, DFF, (const float*)nullptr, WDT, DFF, 0, 0);
            TR_SEG(kp->in[20] + (size_t)layer * DM * DM, DM, 0, DM, DM, kp->in[19] + (size_t)layer * DM, WPGT, DM, 0, 0);
            TR_SEG(kp->in[21] + (size_t)layer * PLED * DM, DM, 0, DM, PLED, (const float*)nullptr, WPPT, PLED, 0, 0);
            if (layer == 0) {
                const float* xin = kp->in[0];
                for (int m = gw; m < MTOK; m += NGW) {
                    const GAS f32x4* xr = (const GAS f32x4*)(xin + (size_t)m * DM) + lane; f32x4 v[4]; float s = 0.f;
#pragma unroll
                    for (int j = 0; j < 4; ++j) { v[j] = xr[64 * j]; s += (v[j].x * v[j].x + v[j].y * v[j].y) + (v[j].z * v[j].z + v[j].w * v[j].w); }
                    s = wave_sum(s);
                    GAS v2u* o8 = (GAS v2u*)(XBl + (size_t)m * DM) + lane;
#pragma unroll
                    for (int j = 0; j < 4; ++j) { v2u w; w.x = pk2(v[j].x, v[j].y); w.y = pk2(v[j].z, v[j].w); o8[64 * j] = w; }
                    if (lane < 16) SSQC[(size_t)m * 16 + lane] = lane == 0 ? s : 0.f;
                }
            }
        }
        SEAM(P + 0);
        if (IN(P + 1)) { PHASE_PTRS();
            pg8::Gemm g{XBl, W1T, MTOK, N1, DM}; pg8::StaticOrder S; S.init(MTOK, N1, G, (int)blockIdx.x);
            pg8::EpiP1 E{ZB, MIX, SM, SSQC};
            pg8::gemm_phase<pg8::EpiP1, pg8::StaticOrder, true, true>(lds, g, S, E);
        }
        SEAM(P + 1);
        if (IN(P + 2)) { PHASE_PTRS();
            for (int e = blockIdx.x * 512 + tid; e < SEQ * 32; e += G * 512) { const int t = e >> 5, i = e & 31;
                double f = 1.0; for (int j = 0; j < i; ++j) f *= 0.7429639507594948;
                const double ang = (double)t * f, kk = rint(ang * 0.15915494309189535);
                double r = fma(-kk, 6.283185307179586, ang); r = fma(-kk, 2.4492935982947064e-16, r); const double r2 = r * r;
                double sn = 1.0, cs = 1.0;
#pragma unroll
                for (int n = 15; n >= 1; --n) { sn = 1.0 - r2 * (1.0 / (double)((2 * n) * (2 * n + 1))) * sn; cs = 1.0 - r2 * (1.0 / (double)((2 * n - 1) * (2 * n))) * cs; }
                ROPE[e] = (float)cs; ROPE[SEQ * 32 + e] = (float)(r * sn); }
        }
        SEAM(P + 2);
        if (IN(P + 3)) { PHASE_PTRS();
        }
        SEAM(P + 3);
        if (IN(P + 4)) { PHASE_PTRS();
            for (int m = gw; m < MTOK; m += NGW) {
                GAS v4u* yp = (GAS v4u*)(ZB + (size_t)m * ZB_LD + 512) + lane; const v4u w = *yp;
                const f32x4 sq = *(const f32x4*)(SM + (size_t)m * SM_LD + 24 + 4 * (lane >> 5));
                const float rstd = rsqrtf(((sq[0] + sq[1]) + (sq[2] + sq[3])) * (1.0f / 256.0f) + 1e-6f);
                v4u o; o.x = pk2(pg8::bflo(w.x) * rstd, pg8::bfhi(w.x) * rstd); o.y = pk2(pg8::bflo(w.y) * rstd, pg8::bfhi(w.y) * rstd);
                o.z = pk2(pg8::bflo(w.z) * rstd, pg8::bfhi(w.z) * rstd); o.w = pk2(pg8::bflo(w.w) * rstd, pg8::bfhi(w.w) * rstd);
                *yp = o;
            }
            pg8::Gemm g{XBl, WGT, MTOK, NGATE, DM}; pg8::StaticOrder S; S.init(MTOK, NGATE, G, (int)blockIdx.x);
            pg8::EpiRS<0> E{GATE, NGATE, SSQC};
            pg8::gemm_phase<pg8::EpiRS<0>, pg8::StaticOrder, true, true>(lds, g, S, E);
        }
        SEAM(P + 4);
        if (IN(P + 5)) { PHASE_PTRS();
            pg8::Gemm g{ZB, WMT, MTOK, DM, KMERGE}; pg8::StaticOrder S; S.init(MTOK, DM, G, (int)blockIdx.x);
            pg8::EpiMerge E{GATE, XBf};
            pg8::gemm_phase<pg8::EpiMerge, pg8::StaticOrder, true, true>(lds, g, S, E);
        }
        SEAM(P + 5);
        if (IN(P + 6)) { PHASE_PTRS();
            const float* pl = kp->in[1] + (size_t)layer * MTOK * PLED;
            for (size_t e = (size_t)blockIdx.x * 512 + tid; e < (size_t)MTOK * PLED / 4; e += (size_t)G * 512) { const f32x4 v = ((const GAS f32x4*)pl)[e]; v2u w; w.x = pk2(v.x, v.y); w.y = pk2(v.z, v.w); ((GAS v2u*)PB)[e] = w; }
            pg8::Gemm g{XBf, WOT, MTOK, DM, DM}; pg8::StaticOrder S; S.init(MTOK, DM, G, (int)blockIdx.x);
            pg8::EpiResid<0> E{layer == 0 ? kp->in[0] : X, X, XBl, SSQA, nullptr, nullptr};
            pg8::gemm_phase<pg8::EpiResid<0>, pg8::StaticOrder, true, true>(lds, g, S, E);
        }
        SEAM(P + 6);
        if (IN(P + 7)) { PHASE_PTRS();
            { pg8::Gemm g{XBl, WUT, MTOK, DFF, DM}; pg8::StaticOrder S; S.init(MTOK, DFF, G, (int)blockIdx.x);
              pg8::EpiRS<1> E{U, DFF, SSQA};
              pg8::gemm_phase<pg8::EpiRS<1>, pg8::StaticOrder, true, true>(lds, g, S, E); }
            { pg8::Gemm g{PB, WPPT, MTOK, DM, PLED}; pg8::StaticOrder S; S.init(MTOK, DM, G, (int)blockIdx.x);
              pg8::EpiRS<0> E{PLE, DM, nullptr};
              pg8::gemm_phase<pg8::EpiRS<0>, pg8::StaticOrder, true, true>(lds, g, S, E); }
        }
        SEAM(P + 7);
        if (IN(P + 8)) { PHASE_PTRS();
            pg8::Gemm g{U, WDT, MTOK, DM, DFF}; pg8::StaticOrder S; S.init(MTOK, DM, G, (int)blockIdx.x);
            pg8::EpiResid<0> E{X, X, XBl, SSQB, nullptr, nullptr};
            pg8::gemm_phase<pg8::EpiResid<0>, pg8::StaticOrder, true, true>(lds, g, S, E);
        }
        SEAM(P + 8);
        if (IN(P + 9)) { PHASE_PTRS();
            pg8::Gemm g{XBl, WPGT, MTOK, DM, DM}; pg8::StaticOrder S; S.init(MTOK, DM, G, (int)blockIdx.x);
            pg8::EpiResid<1> E{X, X, XBf, SSQC, SSQB, PLE};
            pg8::gemm_phase<pg8::EpiResid<1>, pg8::StaticOrder, true, true>(lds, g, S, E);
        }
        SEAM(P + 9);
    }
    if (IN(PH_FINAL)) { const int layer = 0; PHASE_PTRS();
        const float* nf = kp->in[22];
        for (int m = gw; m < MTOK; m += NGW) {
            const float sp = lane < 16 ? SSQC[(size_t)m * 16 + lane] : 0.f;
            const float rstd = rsqrtf(wave_sum(sp) * (1.0f / 1024.0f) + 1e-6f);
            GAS f32x4* xr = (GAS f32x4*)(X + (size_t)m * DM) + lane;
#pragma unroll
            for (int j = 0; j < 4; ++j) { const f32x4 v = xr[64 * j], w = ((const GAS f32x4*)nf)[64 * j + lane]; xr[64 * j] = v * rstd * w; }
        }
    }
#undef IN
#undef SEAM
}

extern "C" void kernel_launch(void* const* d_in, const int* in_sizes, int n_in, void* d_out, int out_size, void* d_ws, size_t ws_size, hipStream_t stream) {
    static int grid = 0;
    if (grid == 0) {
        if (n_in != 23 || out_size != MTOK * DM || ws_size < WS_END) { fprintf(stderr, "kernel_launch: unexpected problem (n_in %d, out %d, ws %zu < %zu)\n", n_in, out_size, ws_size, (size_t)WS_END); grid = -1; return; }
        int dev = 0, cus = 0;
        if (hipGetDevice(&dev) != hipSuccess || hipDeviceGetAttribute(&cus, hipDeviceAttributeMultiprocessorCount, dev) != hipSuccess) { grid = -1; return; }
        if (hipFuncSetAttribute((const void*)fwd_kernel, hipFuncAttributeMaxDynamicSharedMemorySize, LDS_BYTES) != hipSuccess) { fprintf(stderr, "kernel_launch: hipFuncSetAttribute failed\n"); grid = -1; return; }
        int per_cu = 0;
        if (hipOccupancyMaxActiveBlocksPerMultiprocessor(&per_cu, (const void*)fwd_kernel, 512, LDS_BYTES) != hipSuccess || per_cu < 1) { fprintf(stderr, "kernel_launch: occupancy query says %d blocks per CU\n", per_cu); }
        (void)hipGetLastError();
        grid = cus;
    }
    if (grid < 0) return;
    (void)hipMemsetAsync((char*)d_ws + WS_CTL, 0, CTL_BYTES, stream);
    Args a; memset(&a, 0, sizeof(a));
    for (int i = 0; i < 23; ++i) a.in[i] = (const float*)d_in[i];
    a.out = (float*)d_out; a.ws = (unsigned char*)d_ws;
#if MK_ONE_LAUNCH
    a.ph_lo = 0; a.ph_hi = N_PHASES;
    hipLaunchKernelGGL(fwd_kernel, dim3(grid), dim3(512), LDS_BYTES, stream, a);
#else
    for (int p = 0; p < N_PHASES; ++p) {
        if (p != PH_FINAL && (p % NPH) == 3) { hipLaunchKernelGGL(mixers_naive, dim3(192), dim3(64), 0, stream, a, p / NPH); continue; }
        a.ph_lo = p; a.ph_hi = p + 1;
        hipLaunchKernelGGL(fwd_kernel, dim3(grid), dim3(512), LDS_BYTES, stream, a);
    }
#endif
}
```

```cpp
#include <hip/hip_runtime.h>
#include <cstdio>
#include <cstdint>
#include <cstring>
namespace pg8 {
#define PG8_LAS __attribute__((address_space(3)))
typedef unsigned short bf16_t;
typedef short bf16x8 __attribute__((ext_vector_type(8)));
typedef float f32x4 __attribute__((ext_vector_type(4)));
typedef unsigned u32x4 __attribute__((ext_vector_type(4)));
constexpr int BM = 256, BK = 64, HALF = 128, HTB = HALF * BK * 2  , STAGE_BYTES = 8 * HTB, NXCD = 8, WGM = 8;

__host__ __device__ __forceinline__ int lds_byte(int r, int c) { const int st = (r >> 4) * 2 + (c >> 5), rr = r & 15, cc = c & 31, ob = rr * 64 + cc * 2; return st * 1024 + (ob ^ (((ob >> 9) & 1) << 5)); }
__host__ __device__ __forceinline__ void stage_rc(int b, int& R, int& C) { const int st = b / 1024, sb = b % 1024, swz = sb ^ (((sb >> 9) & 1) << 5); R = (st >> 1) * 16 + swz / 64; C = (st & 1) * 32 + (swz % 64) / 2; }
__host__ __device__ __forceinline__ int perm32(int rho) { const int n = rho >> 4, i = rho & 15; return 8 * (i >> 2) + 4 * n + (i & 3); }

struct Unit { int pm, pn; };
struct Gemm { const bf16_t* A; const bf16_t* Bt; int M, N, K; };

struct StaticOrder {
    int nM, nN, nwg, G, c;
    __host__ __device__ void init(int M, int N, int G_, int c_) { nM = M / BM; nN = N / BM; nwg = nM * nN; G = G_; c = c_; }
    __host__ __device__ bool next(int i, Unit& u) const {
        const long L = (long)i * G + c; if (L >= nwg) return false;
        int wgid = (int)L; { const int q = nwg / NXCD, r = nwg % NXCD, xcd = wgid % NXCD, off = wgid / NXCD; wgid = (xcd < r ? xcd * (q + 1) : r * (q + 1) + (xcd - r) * q) + off; }
        const int nig = WGM * nN, gid = wgid / nig, fm = gid * WGM, gsz = (nM - fm) < WGM ? (nM - fm) : WGM;
        u.pm = fm + ((wgid % nig) % gsz); u.pn = (wgid % nig) / gsz; return true;
    }
    __device__ __forceinline__ void a_ready(const Unit&) const {}
    __device__ __forceinline__ void done(const Unit&) const {}
};

__device__ __forceinline__ unsigned cvt_pk_bf16(float lo, float hi) { unsigned r; asm volatile("v_cvt_pk_bf16_f32 %0, %1, %2" : "=v"(r) : "v"(lo), "v"(hi)); return r; }
typedef unsigned u32x2 __attribute__((ext_vector_type(2)));
__device__ __forceinline__ float bflo(unsigned w) { return __uint_as_float(w << 16); }
__device__ __forceinline__ float bfhi(unsigned w) { return __uint_as_float(w & 0xffff0000u); }
__device__ __forceinline__ u32x4 pack8(const f32x4 v0, const f32x4 v1) { u32x4 w; w.x = cvt_pk_bf16(v0[0], v0[1]); w.y = cvt_pk_bf16(v0[2], v0[3]); w.z = cvt_pk_bf16(v1[0], v1[1]); w.w = cvt_pk_bf16(v1[2], v1[3]); return w; }
__device__ __forceinline__ void unpack8(const u32x4 w, f32x4& v0, f32x4& v1) { v0 = (f32x4){bflo(w.x), bfhi(w.x), bflo(w.y), bfhi(w.y)}; v1 = (f32x4){bflo(w.z), bfhi(w.z), bflo(w.w), bfhi(w.w)}; }
constexpr float RMS_EPS = 1e-6f;
__device__ __forceinline__ void load_rstd(const float* ssqp, int row0, int fq, float (&rs)[2][4]) {
#pragma unroll
    for (int ai = 0; ai < 2; ++ai)
#pragma unroll
        for (int m = 0; m < 4; ++m) {
            if (ssqp) { const f32x4 p = *(const f32x4*)(ssqp + (size_t)(row0 + ai * HALF + m * 16) * 16 + 4 * fq); float s = (p[0] + p[1]) + (p[2] + p[3]);
                s += __shfl_xor(s, 16); s += __shfl_xor(s, 32); rs[ai][m] = rsqrtf(s * (1.0f / 1024.0f) + RMS_EPS); }
            else rs[ai][m] = 1.0f;
        }
}
struct EpiP1 {
    static constexpr bool PERM = true, AFTER_DRAIN = false, HOOK = false; static constexpr int SEG1 = -1, SEG2 = -1;
    bf16_t* ZB; bf16_t* MIX; float* SM; const float* ssqp; bf16_t* HALO;
    __device__ __forceinline__ void rescale(f32x4 (&)[2][2][4][2], const Unit&, int, int, int, int, int) const {}
    __device__ __forceinline__ void operator()(const f32x4 (&acc)[2][2][4][2], const Unit& u, int wr, int wc, int fr, int fq) const {
        const int row0 = u.pm * BM + wr * 64 + fr;
        float rs[2][4]; load_rstd(ssqp, row0, fq, rs);
        if (u.pn == 21) {
            if (wc == 0) {
#pragma unroll
                for (int ai = 0; ai < 2; ++ai)
#pragma unroll
                    for (int m = 0; m < 4; ++m) { float* p = SM + (size_t)(row0 + ai * HALF + m * 16) * 32 + 8 * fq;
                        *(f32x4*)p = acc[ai][0][m][0] * rs[ai][m]; *(f32x4*)(p + 4) = acc[ai][0][m][1] * rs[ai][m]; }
            }
            return;
        }
        bf16_t* base; int ldc, colt;
        if (u.pn < 6) { base = ZB; ldc = 1536; colt = u.pn * BM; } else { base = MIX; ldc = 3840; colt = (u.pn - 6) * BM; }
        const int col0 = colt + wc * 32 + 8 * fq;
#pragma unroll
        for (int ai = 0; ai < 2; ++ai)
#pragma unroll
            for (int m = 0; m < 4; ++m) { bf16_t* rowp = base + (size_t)(row0 + ai * HALF + m * 16) * ldc + col0;
#pragma unroll
                for (int bj = 0; bj < 2; ++bj) { const u32x4 w = pack8(acc[ai][bj][m][0] * rs[ai][m], acc[ai][bj][m][1] * rs[ai][m]); *(u32x4*)(rowp + bj * HALF) = w;
                    if (m == 3 && fr >= 13 && u.pn >= 6 && u.pn < 12) *(u32x4*)(HALO + ((size_t)((row0 + ai * HALF + m * 16) >> 6) * 3 + (fr - 13)) * 1536 + col0 + bj * HALF) = w; } }
    }
};
template <int ACT> struct EpiRS {
    static constexpr bool PERM = true, AFTER_DRAIN = false, HOOK = false; static constexpr int SEG1 = -1, SEG2 = -1;
    bf16_t* O; int ldc; const float* ssqp;
    __device__ __forceinline__ void rescale(f32x4 (&)[2][2][4][2], const Unit&, int, int, int, int, int) const {}
    __device__ __forceinline__ void operator()(const f32x4 (&acc)[2][2][4][2], const Unit& u, int wr, int wc, int fr, int fq) const {
        const int row0 = u.pm * BM + wr * 64 + fr, col0 = u.pn * BM + wc * 32 + 8 * fq;
        float rs[2][4]; load_rstd(ssqp, row0, fq, rs);
#pragma unroll
        for (int ai = 0; ai < 2; ++ai)
#pragma unroll
            for (int m = 0; m < 4; ++m) { bf16_t* rowp = O + (size_t)(row0 + ai * HALF + m * 16) * ldc + col0;
#pragma unroll
                for (int bj = 0; bj < 2; ++bj) { f32x4 v0 = acc[ai][bj][m][0] * rs[ai][m], v1 = acc[ai][bj][m][1] * rs[ai][m];
                    if (ACT == 1) {
#pragma unroll
                        for (int j = 0; j < 4; ++j) { const float a = fmaxf(v0[j], 0.f), b = fmaxf(v1[j], 0.f); v0[j] = a * a; v1[j] = b * b; } }
                    *(u32x4*)(rowp + bj * HALF) = pack8(v0, v1); } }
    }
};
struct EpiMerge {
    static constexpr bool PERM = true, AFTER_DRAIN = false, HOOK = true; static constexpr int SEG1 = 8, SEG2 = 16;
    const bf16_t* GATE; bf16_t* O;
    __device__ __forceinline__ void rescale(f32x4 (&acc)[2][2][4][2], const Unit& u, int seg, int wr, int wc, int, int) const {
        int t_ = threadIdx.x; asm volatile("" : "+v"(t_)); const int fr = t_ & 15, fq = (t_ & 63) >> 4;
        const int row0 = u.pm * BM + wr * 64 + fr, col0 = u.pn * BM + wc * 32 + 8 * fq + (seg - 1) * 1024;
#pragma unroll
        for (int ai = 0; ai < 2; ++ai)
#pragma unroll
            for (int m = 0; m < 4; ++m) { const bf16_t* gp = GATE + (size_t)(row0 + ai * HALF + m * 16) * 3072 + col0;
#pragma unroll
                for (int bj = 0; bj < 2; ++bj) { const u32x4 wa = *(const u32x4*)(gp + bj * HALF), wb = *(const u32x4*)(gp + bj * HALF + 1024);
                    f32x4 a0, a1, b0, b1; unpack8(wa, a0, a1); unpack8(wb, b0, b1);
#pragma unroll
                    for (int j = 0; j < 4; ++j) {
                        acc[ai][bj][m][0][j] *= (1.0f + __expf(-b0[j])) * __builtin_amdgcn_rcpf(1.0f + __expf(-a0[j]));
                        acc[ai][bj][m][1][j] *= (1.0f + __expf(-b1[j])) * __builtin_amdgcn_rcpf(1.0f + __expf(-a1[j])); } }
                asm volatile("" ::: "memory"); }
    }
    __device__ __forceinline__ void operator()(const f32x4 (&acc)[2][2][4][2], const Unit& u, int wr, int wc, int fr, int fq) const {
        const int row0 = u.pm * BM + wr * 64 + fr, col0 = u.pn * BM + wc * 32 + 8 * fq;
#pragma unroll
        for (int ai = 0; ai < 2; ++ai)
#pragma unroll
            for (int m = 0; m < 4; ++m) { const size_t r = (size_t)(row0 + ai * HALF + m * 16);
#pragma unroll
                for (int bj = 0; bj < 2; ++bj) { const u32x4 wa = *(const u32x4*)(GATE + r * 3072 + 2048 + col0 + bj * HALF);
                    f32x4 a0, a1; unpack8(wa, a0, a1); f32x4 v0 = acc[ai][bj][m][0], v1 = acc[ai][bj][m][1];
#pragma unroll
                    for (int j = 0; j < 4; ++j) { v0[j] *= __builtin_amdgcn_rcpf(1.0f + __expf(-a0[j])); v1[j] *= __builtin_amdgcn_rcpf(1.0f + __expf(-a1[j])); }
                    *(u32x4*)(O + r * 1024 + col0 + bj * HALF) = pack8(v0, v1); }
                asm volatile("" ::: "memory"); }
    }
};
template <int MODE> struct EpiResid {
    static constexpr bool PERM = true, AFTER_DRAIN = false, HOOK = false; static constexpr int SEG1 = -1, SEG2 = -1;
    const float* base; float* X; bf16_t* XB; float* ssq_out; const float* ssq_in; const bf16_t* PLE;
    __device__ __forceinline__ void rescale(f32x4 (&)[2][2][4][2], const Unit&, int, int, int, int, int) const {}
    __device__ __forceinline__ void operator()(const f32x4 (&acc)[2][2][4][2], const Unit& u, int wr, int wc, int fr, int fq) const {
        const int row0 = u.pm * BM + wr * 64 + fr, col0 = u.pn * BM + wc * 32 + 8 * fq;
        float rs[2][4]; if (MODE == 1) load_rstd(ssq_in, row0, fq, rs);
#pragma unroll
        for (int ai = 0; ai < 2; ++ai)
#pragma unroll
            for (int m = 0; m < 4; ++m) { const size_t r = (size_t)(row0 + ai * HALF + m * 16); float ss = 0.f;
#pragma unroll
                for (int bj = 0; bj < 2; ++bj) { const size_t o = r * 1024 + col0 + bj * HALF;
                    f32x4 v0 = acc[ai][bj][m][0], v1 = acc[ai][bj][m][1];
                    if (MODE == 1) { const u32x4 wp = *(const u32x4*)(PLE + o); f32x4 p0, p1; unpack8(wp, p0, p1);
#pragma unroll
                        for (int j = 0; j < 4; ++j) { v0[j] = p0[j] * __builtin_amdgcn_rcpf(1.0f + __expf(-v0[j] * rs[ai][m])); v1[j] = p1[j] * __builtin_amdgcn_rcpf(1.0f + __expf(-v1[j] * rs[ai][m])); } }
                    v0 += *(const f32x4*)(base + o); v1 += *(const f32x4*)(base + o + 4);
                    *(f32x4*)(X + o) = v0; *(f32x4*)(X + o + 4) = v1; *(u32x4*)(XB + o) = pack8(v0, v1);
                    ss += (v0[0] * v0[0] + v0[1] * v0[1]) + (v0[2] * v0[2] + v0[3] * v0[3]) + (v1[0] * v1[0] + v1[1] * v1[1]) + (v1[2] * v1[2] + v1[3] * v1[3]); }
                ss += __shfl_xor(ss, 16); ss += __shfl_xor(ss, 32);
                if (fq == 0) ssq_out[r * 16 + u.pn * 4 + wc] = ss;
                asm volatile("" ::: "memory"); }
    }
};
template <class Epi, class Sched, bool ALIGN_EPI = false, bool SP2 = false>
__device__ __forceinline__ void gemm_phase(PG8_LAS unsigned char* lds, Gemm g, const Sched& S, const Epi& E) {
    asm volatile("" : "+s"(g.A), "+s"(g.Bt));
    int tid_ = threadIdx.x; asm volatile("" : "+v"(tid_));
    const int tid = tid_, wid = __builtin_amdgcn_readfirstlane(tid >> 6), lane = tid & 63, wr = wid >> 2, wc = wid & 3, fr = lane & 15, fq = lane >> 4;
    const int K = g.K, nt = K / BK;
    unsigned voffA[2], voffB[2];
#pragma unroll
    for (int i = 0; i < 2; ++i) { int R, C; stage_rc(tid * 16 + i * 8192, R, C); const int Rb = Epi::PERM ? ((R & ~31) + perm32(R & 31)) : R;
        voffA[i] = (unsigned)(R * K + C) * 2u; voffB[i] = (unsigned)(Rb * K + C) * 2u; }
    const size_t kstep = (size_t)(BK * 2);
    const size_t hstep = (size_t)HALF * K * 2;
    const size_t tstep = 2 * hstep;
    const unsigned ldsw = (unsigned)wid * 1024u;
    const int aoff = lds_byte(wr * 64 + fr, fq * 8), boff = lds_byte(wc * 32 + fr, fq * 8);
#define PG8_SA(b, h) (((b) * 2 + (h)) * HTB)
#define PG8_SB(b, h) ((4 + (b) * 2 + (h)) * HTB)
#define PG8_STAGE(bufoff, gbase, voff) do { _Pragma("unroll") for (int _i = 0; _i < 2; ++_i) \
        __builtin_amdgcn_global_load_lds((const unsigned*)((const char*)(gbase) + (voff)[_i]), (PG8_LAS unsigned*)(lds + (bufoff) + ldsw + _i * 8192), 16, 0, 0); } while (0)
#define PG8_LDA(dst, b, h) do { _Pragma("unroll") for (int m = 0; m < 4; ++m) _Pragma("unroll") for (int k = 0; k < 2; ++k) dst[m][k] = *(const PG8_LAS bf16x8*)(lds + PG8_SA(b, h) + aoff + m * 2048 + k * 1024); } while (0)
#define PG8_LDB(dst, b, h) do { _Pragma("unroll") for (int n = 0; n < 2; ++n) _Pragma("unroll") for (int k = 0; k < 2; ++k) dst[n][k] = *(const PG8_LAS bf16x8*)(lds + PG8_SB(b, h) + boff + n * 2048 + k * 1024); } while (0)
#define PG8_MMA(ai, bj, At, Bt) do { __builtin_amdgcn_s_setprio(1); _Pragma("unroll") for (int m = 0; m < 4; ++m) _Pragma("unroll") for (int n = 0; n < 2; ++n) _Pragma("unroll") for (int k = 0; k < 2; ++k) \
        acc[ai][bj][m][n] = __builtin_amdgcn_mfma_f32_16x16x32_bf16(Bt[n][k], At[m][k], acc[ai][bj][m][n], 0, 0, 0); __builtin_amdgcn_s_setprio(0); } while (0)
#define PG8_WAIT_V(n) asm volatile("s_waitcnt vmcnt(" #n ")" ::: "memory")
#define PG8_WAIT_L(n) asm volatile("s_waitcnt lgkmcnt(" #n ")" ::: "memory")
#define PG8_BAR __builtin_amdgcn_s_barrier()
#define PG8_SCHED __builtin_amdgcn_sched_barrier(0)
    Unit cur, nxt; int ui = 0;
    if (!S.next(0, cur)) return;
    f32x4 acc[2][2][4][2];
#pragma unroll
    for (int a = 0; a < 2; ++a)
#pragma unroll
        for (int b = 0; b < 2; ++b)
#pragma unroll
            for (int m = 0; m < 4; ++m)
#pragma unroll
                for (int n = 0; n < 2; ++n) acc[a][b][m][n] = (f32x4){0.f, 0.f, 0.f, 0.f};
    bf16x8 At[4][2], B0[2][2], B1[2][2];
    const char* cA = (const char*)g.A + (size_t)cur.pm * tstep; const char* cB = (const char*)g.Bt + (size_t)cur.pn * tstep;
    S.a_ready(cur);
    if constexpr (SP2) {
        PG8_STAGE(PG8_SB(0, 0), cB, voffB); PG8_STAGE(PG8_SB(0, 1), cB + hstep, voffB); PG8_STAGE(PG8_SA(0, 0), cA, voffA); PG8_STAGE(PG8_SA(0, 1), cA + hstep, voffA);
        if (wr == 1) PG8_BAR;
        PG8_WAIT_V(2); PG8_BAR;
        PG8_STAGE(PG8_SB(1, 0), cB + kstep, voffB); PG8_STAGE(PG8_SA(1, 0), cA + kstep, voffA); PG8_STAGE(PG8_SB(1, 1), cB + hstep + kstep, voffB);
        PG8_WAIT_V(6); PG8_BAR;
    } else {
        PG8_STAGE(PG8_SB(0, 0), cB, voffB); PG8_STAGE(PG8_SA(0, 0), cA, voffA); PG8_STAGE(PG8_SB(0, 1), cB + hstep, voffB); PG8_STAGE(PG8_SA(0, 1), cA + hstep, voffA);
        if (wr == 1) PG8_BAR;
        PG8_WAIT_V(4); PG8_BAR;
        PG8_STAGE(PG8_SB(1, 0), cB + kstep, voffB); PG8_STAGE(PG8_SA(1, 0), cA + kstep, voffA); PG8_STAGE(PG8_SB(1, 1), cB + hstep + kstep, voffB);
        PG8_WAIT_V(6); PG8_BAR;
    }
    for (;;) {
        const bool has_next = S.next(ui + 1, nxt);
        const char* nA = has_next ? (const char*)g.A + (size_t)nxt.pm * tstep : cA; const char* nB = has_next ? (const char*)g.Bt + (size_t)nxt.pn * tstep : cB;
        for (int t = 0; t < nt; t += 2) {
            const bool last = (t == nt - 2);
            const char* a1 = cA + (size_t)(t + 1) * kstep;
            const char* a2 = last ? nA : cA + (size_t)(t + 2) * kstep; const char* b2 = last ? nB : cB + (size_t)(t + 2) * kstep;
            const char* a3 = a2 + kstep; const char* b3 = b2 + kstep;
            if (last && has_next) S.a_ready(nxt);
            if constexpr (Epi::HOOK) { if (t == Epi::SEG1 || t == Epi::SEG2) E.rescale(acc, cur, t == Epi::SEG1 ? 1 : 2, wr, wc, fr, fq); }
            if constexpr (SP2) {
            PG8_LDB(B0, 0, 0); PG8_LDB(B1, 0, 1); PG8_SCHED; PG8_LDA(At, 0, 0); PG8_STAGE(PG8_SA(1, 1), a1 + hstep, voffA);
            PG8_WAIT_V(8); PG8_WAIT_L(0); PG8_BAR; PG8_MMA(0, 0, At, B0); PG8_MMA(0, 1, At, B1); PG8_BAR; PG8_SCHED;
            PG8_LDA(At, 0, 1); PG8_STAGE(PG8_SB(0, 0), b2, voffB); PG8_STAGE(PG8_SB(0, 1), b2 + hstep, voffB); PG8_STAGE(PG8_SA(0, 0), a2, voffA);
            PG8_WAIT_V(8); PG8_WAIT_L(0); PG8_BAR; PG8_MMA(1, 0, At, B0); PG8_MMA(1, 1, At, B1); PG8_BAR; PG8_SCHED;
            PG8_LDB(B0, 1, 0); PG8_LDB(B1, 1, 1); PG8_SCHED; PG8_LDA(At, 1, 0); PG8_STAGE(PG8_SA(0, 1), a2 + hstep, voffA);
            PG8_WAIT_V(8); PG8_WAIT_L(0); PG8_BAR; PG8_MMA(0, 0, At, B0); PG8_MMA(0, 1, At, B1); PG8_BAR; PG8_SCHED;
            PG8_LDA(At, 1, 1); PG8_STAGE(PG8_SB(1, 0), b3, voffB); PG8_STAGE(PG8_SB(1, 1), b3 + hstep, voffB); PG8_STAGE(PG8_SA(1, 0), a3, voffA);
            PG8_WAIT_V(8); PG8_WAIT_L(0); PG8_BAR; PG8_MMA(1, 0, At, B0); PG8_MMA(1, 1, At, B1); PG8_BAR; PG8_SCHED;
            } else {
            PG8_LDB(B0, 0, 0); PG8_SCHED; PG8_LDA(At, 0, 0); PG8_STAGE(PG8_SA(1, 1), a1 + hstep, voffA);
            PG8_WAIT_L(8); PG8_BAR; PG8_WAIT_L(0); PG8_MMA(0, 0, At, B0); PG8_BAR; PG8_SCHED;
            PG8_LDB(B1, 0, 1); PG8_STAGE(PG8_SB(0, 0), b2, voffB);
            PG8_BAR; PG8_WAIT_L(0); PG8_MMA(0, 1, At, B1); PG8_BAR;
            PG8_LDA(At, 0, 1); PG8_STAGE(PG8_SA(0, 0), a2, voffA);
            PG8_BAR; PG8_WAIT_L(0); PG8_MMA(1, 0, At, B0); PG8_BAR; PG8_SCHED;
            PG8_STAGE(PG8_SB(0, 1), b2 + hstep, voffB);
            PG8_WAIT_V(6); PG8_BAR; PG8_MMA(1, 1, At, B1); PG8_BAR;
            PG8_LDB(B0, 1, 0); PG8_SCHED; PG8_LDA(At, 1, 0); PG8_STAGE(PG8_SA(0, 1), a2 + hstep, voffA);
            PG8_WAIT_L(8); PG8_BAR; PG8_WAIT_L(0); PG8_MMA(0, 0, At, B0); PG8_BAR; PG8_SCHED;
            PG8_LDB(B1, 1, 1); PG8_STAGE(PG8_SB(1, 0), b3, voffB);
            PG8_BAR; PG8_WAIT_L(0); PG8_MMA(0, 1, At, B1); PG8_BAR;
            PG8_LDA(At, 1, 1); PG8_STAGE(PG8_SA(1, 0), a3, voffA);
            PG8_BAR; PG8_WAIT_L(0); PG8_MMA(1, 0, At, B0); PG8_BAR; PG8_SCHED;
            PG8_STAGE(PG8_SB(1, 1), b3 + hstep, voffB);
            PG8_WAIT_V(6); PG8_BAR; PG8_MMA(1, 1, At, B1); PG8_BAR;
            }
        }
        if constexpr (ALIGN_EPI) { if (wr == 0) PG8_BAR; }
        if constexpr (!Epi::AFTER_DRAIN) { E(acc, cur, wr, wc, fr, fq); S.done(cur); }
        if (!has_next) break;
#pragma unroll
        for (int a = 0; a < 2; ++a)
#pragma unroll
            for (int b = 0; b < 2; ++b)
#pragma unroll
                for (int m = 0; m < 4; ++m)
#pragma unroll
                    for (int n = 0; n < 2; ++n) acc[a][b][m][n] = (f32x4){0.f, 0.f, 0.f, 0.f};
        cur = nxt; cA = nA; cB = nB; ++ui;
        if constexpr (ALIGN_EPI) { if (wr == 1) PG8_BAR; }
    }
    PG8_WAIT_V(0);
    if constexpr (!ALIGN_EPI) { if (wr == 0) PG8_BAR; }
    PG8_BAR;
    if constexpr (Epi::AFTER_DRAIN) { E.fused(acc, cur, wr, wc, fr, fq, lds, wid, lane); S.done(cur); }
#undef PG8_SA
#undef PG8_SB
#undef PG8_STAGE
#undef PG8_LDA
#undef PG8_LDB
#undef PG8_MMA
#undef PG8_WAIT_V
#undef PG8_WAIT_L
#undef PG8_BAR
#undef PG8_SCHED
}
}
constexpr int DM = 1024, NBATCH = 8, SEQ = 4096, MTOK = NBATCH * SEQ, DEPTH = 2, DFF = 4096, PLED = 256, NIN = 8472;
constexpr int ZB_LD = 1536, MIX_LD = 3840, SM_LD = 32, N1 = 5632, NGATE = 3072, KMERGE = 1536;
constexpr int MX_AQ = 0, MX_AK = 512, MX_AV = 1024, MX_BX = 1536, MX_BB = 2048, MX_BC = 2176, MX_CQ = 2304, MX_CK = 2816, MX_CV = 3328;
constexpr size_t KiB = 1024, MiB = 1024 * 1024;
constexpr size_t WS_CTL = 0, CTL_BYTES = 64 * KiB;
constexpr size_t WS_W = 1 * MiB;
constexpr size_t W_1T = WS_W, W_GT = W_1T + (size_t)N1 * DM * 2, W_MT = W_GT + (size_t)NGATE * DM * 2, W_OT = W_MT + (size_t)DM * KMERGE * 2, W_UT = W_OT + (size_t)DM * DM * 2,
                 W_DT = W_UT + (size_t)DFF * DM * 2, W_PGT = W_DT + (size_t)DM * DFF * 2, W_PPT = W_PGT + (size_t)DM * DM * 2, W_END = W_PPT + (size_t)DM * PLED * 2;
constexpr size_t WS_ROPE = W_1T, WS_SSQA = W_1T + 1 * MiB, WS_SSQB = W_1T + 3 * MiB;
constexpr size_t WS_XB0 = W_END, WS_XB1 = WS_XB0 + 64 * MiB, WS_ZB = WS_XB1 + 64 * MiB, WS_MIX = WS_ZB + 96 * MiB, WS_SM = WS_MIX + 240 * MiB, WS_SSQC = WS_SM + 4 * MiB, WS_END = WS_SSQC + 2 * MiB;
constexpr size_t WS_PB = WS_ZB, WS_PLE = WS_ZB + 16 * MiB, WS_U = WS_ZB + 80 * MiB, WS_GATE = WS_MIX;
static_assert(W_END == WS_W + (size_t)(40 * MiB + 512 * KiB), "weights");
static_assert(WS_U + (size_t)MTOK * DFF * 2 == WS_SM, "U overlay");
static_assert(WS_END <= 512 * MiB, "workspace");
constexpr int LDS_BYTES = 147456, RING_BYTES = 131072, MISC_OFF = RING_BYTES + 320;

#define GAS __attribute__((address_space(1)))
#define LAS __attribute__((address_space(3)))
typedef unsigned short bf16;
typedef unsigned v4u __attribute__((ext_vector_type(4)));
typedef unsigned v2u __attribute__((ext_vector_type(2)));
typedef float f32x4 __attribute__((ext_vector_type(4)));
#define LDS_WAIT() asm volatile("s_waitcnt lgkmcnt(0)" ::: "memory")
__device__ __forceinline__ unsigned f2bf(float f) { unsigned u = __builtin_bit_cast(unsigned, f); return (u + 0x7fffu + ((u >> 16) & 1u)) >> 16; }
__device__ __forceinline__ unsigned pk2(float lo, float hi) { return f2bf(lo) | (f2bf(hi) << 16); }
__device__ __forceinline__ float bf2f(bf16 v) { return __uint_as_float((unsigned)v << 16); }
__device__ __forceinline__ float wave_sum(float v) {
#pragma unroll
    for (int o = 1; o < 64; o <<= 1) v += __shfl_xor(v, o);
    return v;
}
__device__ __forceinline__ float siluf(float x) { return x / (1.0f + __expf(-x)); }
__device__ __forceinline__ float sigmf(float x) { return 1.0f / (1.0f + __expf(-x)); }
__device__ __forceinline__ float softplusf(float x) { return fmaxf(x, 0.f) + log1pf(__expf(-fabsf(x))); }
__device__ __forceinline__ float rdl(float v, int l) { return __int_as_float(__builtin_amdgcn_readlane(__float_as_int(v), l)); }

#define XB_TMO      128
#define XB_XCNT(j)  (256  + 64 * (j))
#define XB_XSUB(j)  (1280 + 64 * (j))
#define XB_XGEN(j)  (2304 + 64 * (j))
#define XB_TOP      3328
#define XB_TOPGEN   3392
#define XCD_BAR_WORDS 3456
#define XB_SPIN_CAP (1u << 18)
__device__ __forceinline__ unsigned xb_ld(unsigned* p)              { return __hip_atomic_load(p, __ATOMIC_RELAXED, __HIP_MEMORY_SCOPE_AGENT); }
__device__ __forceinline__ unsigned xb_add(unsigned* p, unsigned v) { return __hip_atomic_fetch_add(p, v, __ATOMIC_RELAXED, __HIP_MEMORY_SCOPE_AGENT); }
__device__ __forceinline__ unsigned xb_xcc_id() { return (unsigned)__builtin_amdgcn_s_getreg((3 << 11) | 20) & 0xFu; }
#define XB_SPIN(cond, bar) do { unsigned _sp = 0; while (cond) { __builtin_amdgcn_s_sleep(1); \
    if ((++_sp & 255u) == 0u) { if (xb_ld(&(bar)[XB_TMO])) break; if (_sp > XB_SPIN_CAP) { atomicAdd(&(bar)[XB_TMO], 1u); break; } } } } while (0)
struct XcdBarrier { unsigned* bar; unsigned x; volatile LAS unsigned* st; };
__device__ __forceinline__ XcdBarrier xcd_barrier_post(unsigned* bar, volatile LAS unsigned* st) {
    XcdBarrier b; b.bar = bar; b.x = xb_xcc_id(); b.st = st;
    if (threadIdx.x == 0) (void)xb_add(&bar[XB_XCNT(b.x)], 1u);
    return b;
}
__device__ __forceinline__ void xcd_barrier_complete(unsigned* bar, unsigned x, unsigned& nloc, unsigned& nx) {
    const unsigned G = gridDim.x * gridDim.y * gridDim.z;
    unsigned sum, cnt, mine, sp = 0u;
    for (;;) {
        sum = 0u; cnt = 0u; mine = 0u;
#pragma unroll
        for (unsigned j = 0; j < 16; ++j) { const unsigned c = xb_ld(&bar[XB_XCNT(j)]); sum += c; cnt += (c > 0u) ? 1u : 0u; mine = (j == x) ? c : mine; }
        if (sum == G) break;
        __builtin_amdgcn_s_sleep(1);
        if ((++sp & 255u) == 0u) { if (xb_ld(&bar[XB_TMO])) break; if (sp > XB_SPIN_CAP) { atomicAdd(&bar[XB_TMO], 1u); break; } }
    }
    nloc = mine > 0u ? mine : 1u; nx = cnt > 0u ? cnt : 1u;
}
__device__ __forceinline__ void xcd_barrier(const XcdBarrier& b) {
    asm volatile("s_waitcnt vmcnt(0)" ::: "memory");
    __syncthreads();
    if (threadIdx.x == 0) {
        unsigned* bar = b.bar;
        __builtin_amdgcn_s_waitcnt(0);
        unsigned nloc = b.st[0], nx = b.st[1];
        if (nloc == 0u) { xcd_barrier_complete(bar, b.x, nloc, nx); b.st[0] = nloc; b.st[1] = nx; }
        const unsigned old = xb_add(&bar[XB_XSUB(b.x)], 1u);
        const unsigned gen = old / nloc;
        if (old + 1u == (gen + 1u) * nloc) {
            __builtin_amdgcn_fence(__ATOMIC_RELEASE, "agent");
            asm volatile("s_waitcnt vmcnt(0)" ::: "memory");
            const unsigned og = xb_add(&bar[XB_TOP], 1u);
            const unsigned tg = og / nx;
            if (og + 1u == (tg + 1u) * nx) xb_add(&bar[XB_TOPGEN], 1u);
            else XB_SPIN(xb_ld(&bar[XB_TOPGEN]) == tg, bar);
            __builtin_amdgcn_fence(__ATOMIC_ACQUIRE, "agent");
            xb_add(&bar[XB_XGEN(b.x)], 1u);
            asm volatile("s_waitcnt vmcnt(0)" ::: "memory");
        } else {
            XB_SPIN(xb_ld(&bar[XB_XGEN(b.x)]) == gen, bar);
            __builtin_amdgcn_fence(__ATOMIC_ACQUIRE, "agent");
            asm volatile("s_waitcnt vmcnt(0)" ::: "memory");
        }
    }
    __syncthreads();
}

__device__ __forceinline__ void tr_item(const float* W, int ldw, int c0, int ncols, const float* scale, bf16* dst, int ldd, int r0, int kofs, LAS float* scr, int item, int lane) {
    const int nblk = (ncols + 31) / 32, kb = item / nblk, nb = item % nblk, k0 = 64 * kb, n0 = 32 * nb;
    const int nn = n0 + (lane & 31);
#pragma unroll 8
    for (int i = 0; i < 32; ++i) { const int kk = 2 * i + (lane >> 5); float v = 0.f;
        if (W != nullptr && nn < ncols) { v = W[(size_t)(k0 + kk) * ldw + c0 + nn]; if (scale) v *= scale[k0 + kk]; }
        scr[kk * 33 + (lane & 31)] = v; }
    LDS_WAIT(); asm volatile("" ::: "memory");
    const int c = lane & 7;
#pragma unroll
    for (int j = 0; j < 4; ++j) { const int n = (lane >> 3) + 8 * j; const LAS float* s = scr + (8 * c) * 33 + n;
        v4u o; o.x = pk2(s[0 * 33], s[1 * 33]); o.y = pk2(s[2 * 33], s[3 * 33]); o.z = pk2(s[4 * 33], s[5 * 33]); o.w = pk2(s[6 * 33], s[7 * 33]);
        if (n0 + n < ncols) *(GAS v4u*)(dst + (size_t)(r0 + n0 + n) * ldd + kofs + k0 + 8 * c) = o; }
    LDS_WAIT(); asm volatile("" ::: "memory");
}
#define TR_SEG(W_, ldw_, c0_, ncols_, K_, scale_, dst_, ldd_, r0_, kofs_) do { const int _n = ((K_) / 64) * (((ncols_) + 31) / 32); \
    for (int _it = (gw + NGW - (ibase % NGW)) % NGW; _it < _n; _it += NGW) tr_item(W_, ldw_, c0_, ncols_, scale_, dst_, ldd_, r0_, kofs_, scr, _it, lane); ibase += _n; } while (0)

struct Args { const float* in[23]; float* out; unsigned char* ws; int ph_lo, ph_hi; };
constexpr int NPH = 10, PH_FINAL = DEPTH * NPH, N_PHASES = PH_FINAL + 1;

constexpr int WG = 8;
__device__ __forceinline__ void gdn_naive(const Args& A, int layer, int b, int h, int lane, const bf16* MIX, const float* SM, bf16* ZB) {
    const float* cw = A.in[4] + (size_t)layer * 4 * 1536;
    float wq[4], wk[4], wv[4];
#pragma unroll
    for (int k = 0; k < 4; ++k) { wq[k] = cw[k * 1536 + h * 64 + lane]; wk[k] = cw[k * 1536 + 512 + h * 64 + lane]; wv[k] = cw[k * 1536 + 1024 + h * 64 + lane]; }
    const float Aexp = expf(A.in[5][layer * 8 + h]), dtb = A.in[6][layer * 8 + h], nw = A.in[7][layer * 64 + lane];
    float M[64];
#pragma unroll
    for (int d = 0; d < 64; ++d) M[d] = 0.f;
    float hq0 = 0.f, hq1 = 0.f, hq2 = 0.f, hk0 = 0.f, hk1 = 0.f, hk2 = 0.f, hv0 = 0.f, hv1 = 0.f, hv2 = 0.f;
    const size_t tok0 = (size_t)b * SEQ;
    bf16 nq[WG], nk[WG], nv[WG], nz[WG]; float nb[WG], na[WG];
#define GDN_LOAD(t0) do { _Pragma("unroll") for (int i = 0; i < WG; ++i) { const size_t r = tok0 + (t0) + i; const bf16* mp = MIX + r * MIX_LD + h * 64 + lane; \
        nq[i] = mp[MX_AQ]; nk[i] = mp[MX_AK]; nv[i] = mp[MX_AV]; nz[i] = ZB[r * ZB_LD + h * 64 + lane]; nb[i] = SM[r * SM_LD + h]; na[i] = SM[r * SM_LD + 8 + h]; } } while (0)
    GDN_LOAD(0);
    for (int t0 = 0; t0 < SEQ; t0 += WG) {
        bf16 cq[WG], ck[WG], cv[WG], cz[WG]; float cb[WG], ca[WG];
#pragma unroll
        for (int i = 0; i < WG; ++i) { cq[i] = nq[i]; ck[i] = nk[i]; cv[i] = nv[i]; cz[i] = nz[i]; cb[i] = nb[i]; ca[i] = na[i]; }
        if (t0 + WG < SEQ) GDN_LOAD(t0 + WG);
#pragma unroll
        for (int i = 0; i < WG; ++i) {
            const float xq = bf2f(cq[i]), xk = bf2f(ck[i]), xv = bf2f(cv[i]);
            float q = siluf(wq[0] * hq0 + wq[1] * hq1 + wq[2] * hq2 + wq[3] * xq); hq0 = hq1; hq1 = hq2; hq2 = xq;
            float k = siluf(wk[0] * hk0 + wk[1] * hk1 + wk[2] * hk2 + wk[3] * xk); hk0 = hk1; hk1 = hk2; hk2 = xk;
            const float v = siluf(wv[0] * hv0 + wv[1] * hv1 + wv[2] * hv2 + wv[3] * xv); hv0 = hv1; hv1 = hv2; hv2 = xv;
            q *= rsqrtf(wave_sum(q * q) + 1e-6f) * 0.125f; k *= rsqrtf(wave_sum(k * k) + 1e-6f);
            const float beta = sigmf(cb[i]), a = __expf(-Aexp * softplusf(ca[i] + dtb));
            float r = 0.f;
#pragma unroll
            for (int d = 0; d < 64; ++d) { M[d] *= a; r += rdl(k, d) * M[d]; }
            const float u = beta * (v - r); float o = 0.f;
#pragma unroll
            for (int d = 0; d < 64; ++d) { M[d] += rdl(k, d) * u; o += rdl(q, d) * M[d]; }
            const float y = o * rsqrtf(wave_sum(o * o) * (1.0f / 64.0f) + 1e-6f) * nw * siluf(bf2f(cz[i]));
            ZB[(tok0 + t0 + i) * ZB_LD + h * 64 + lane] = (bf16)f2bf(y);
        }
    }
#undef GDN_LOAD
}
__device__ __forceinline__ void ssd_naive(const Args& A, int layer, int b, int h, int lane, const bf16* MIX, float* SM, bf16* ZB) {
    const int g = h >> 2;
    const float* cw = A.in[8] + (size_t)layer * 4 * 768; const float* cb_ = A.in[9] + (size_t)layer * 768;
    float wx[4], wB[4], wC[4];
#pragma unroll
    for (int k = 0; k < 4; ++k) { wx[k] = cw[k * 768 + h * 64 + lane]; wB[k] = cw[k * 768 + 512 + g * 64 + lane]; wC[k] = cw[k * 768 + 640 + g * 64 + lane]; }
    const float bx = cb_[h * 64 + lane], bB = cb_[512 + g * 64 + lane], bC = cb_[640 + g * 64 + lane];
    const float Aexp = expf(A.in[10][layer * 8 + h]), dtb = A.in[11][layer * 8 + h], Dh = A.in[12][layer * 8 + h];
    float Hs[64];
#pragma unroll
    for (int d = 0; d < 64; ++d) Hs[d] = 0.f;
    float hx0 = 0.f, hx1 = 0.f, hx2 = 0.f, hB0 = 0.f, hB1 = 0.f, hB2 = 0.f, hC0 = 0.f, hC1 = 0.f, hC2 = 0.f;
    const size_t tok0 = (size_t)b * SEQ;
    bf16 nx[WG], nB[WG], nC[WG], nz[WG]; float nd[WG];
#define SSD_LOAD(t0) do { _Pragma("unroll") for (int i = 0; i < WG; ++i) { const size_t r = tok0 + (t0) + i; const bf16* mp = MIX + r * MIX_LD; \
        nx[i] = mp[MX_BX + h * 64 + lane]; nB[i] = mp[MX_BB + g * 64 + lane]; nC[i] = mp[MX_BC + g * 64 + lane]; nz[i] = ZB[r * ZB_LD + 512 + h * 64 + lane]; nd[i] = SM[r * SM_LD + 16 + h]; } } while (0)
    SSD_LOAD(0);
    for (int t0 = 0; t0 < SEQ; t0 += WG) {
        bf16 cx[WG], cB[WG], cC[WG], cz[WG]; float cd[WG];
#pragma unroll
        for (int i = 0; i < WG; ++i) { cx[i] = nx[i]; cB[i] = nB[i]; cC[i] = nC[i]; cz[i] = nz[i]; cd[i] = nd[i]; }
        if (t0 + WG < SEQ) SSD_LOAD(t0 + WG);
#pragma unroll
        for (int i = 0; i < WG; ++i) {
            const float rx = bf2f(cx[i]), rB = bf2f(cB[i]), rC = bf2f(cC[i]);
            const float x = siluf(wx[0] * hx0 + wx[1] * hx1 + wx[2] * hx2 + wx[3] * rx + bx); hx0 = hx1; hx1 = hx2; hx2 = rx;
            const float Bv = siluf(wB[0] * hB0 + wB[1] * hB1 + wB[2] * hB2 + wB[3] * rB + bB); hB0 = hB1; hB1 = hB2; hB2 = rB;
            const float Cv = siluf(wC[0] * hC0 + wC[1] * hC1 + wC[2] * hC2 + wC[3] * rC + bC); hC0 = hC1; hC1 = hC2; hC2 = rC;
            const float dt = softplusf(cd[i] + dtb), a = __expf(-Aexp * dt), xdt = x * dt;
            float y = 0.f;
#pragma unroll
            for (int n = 0; n < 64; ++n) { Hs[n] = a * Hs[n] + xdt * rdl(Bv, n); y += Hs[n] * rdl(Cv, n); }
            y = (y + Dh * x) * siluf(bf2f(cz[i]));
            const float ss = wave_sum(y * y);
            const size_t r = tok0 + t0 + i;
            ZB[r * ZB_LD + 512 + h * 64 + lane] = (bf16)f2bf(y);
            if (lane == 0) SM[r * SM_LD + 24 + h] = ss;
        }
    }
#undef SSD_LOAD
}
__device__ __forceinline__ void ret_naive(int b, int h, int lane, const bf16* MIX, const float* ROPE, bf16* ZB) {
    const float gamma = 1.0f - exp2f(-5.0f - (float)h);
    float M[64];
#pragma unroll
    for (int d = 0; d < 64; ++d) M[d] = 0.f;
    const size_t tok0 = (size_t)b * SEQ;
    bf16 nq[WG], nk[WG], nv[WG], nz[WG]; float nc[WG], ns[WG];
#define RET_LOAD(t0) do { _Pragma("unroll") for (int i = 0; i < WG; ++i) { const size_t r = tok0 + (t0) + i; const bf16* mp = MIX + r * MIX_LD + h * 64 + lane; \
        nq[i] = mp[MX_CQ]; nk[i] = mp[MX_CK]; nv[i] = mp[MX_CV]; nz[i] = ZB[r * ZB_LD + 1024 + h * 64 + lane]; nc[i] = ROPE[((t0) + i) * 32 + (lane & 31)]; ns[i] = ROPE[SEQ * 32 + ((t0) + i) * 32 + (lane & 31)]; } } while (0)
    RET_LOAD(0);
    for (int t0 = 0; t0 < SEQ; t0 += WG) {
        bf16 cq[WG], ck[WG], cv[WG], cz[WG]; float cc[WG], cs[WG];
#pragma unroll
        for (int i = 0; i < WG; ++i) { cq[i] = nq[i]; ck[i] = nk[i]; cv[i] = nv[i]; cz[i] = nz[i]; cc[i] = nc[i]; cs[i] = ns[i]; }
        if (t0 + WG < SEQ) RET_LOAD(t0 + WG);
#pragma unroll
        for (int i = 0; i < WG; ++i) {
            const float q0 = bf2f(cq[i]), k0 = bf2f(ck[i]), v = bf2f(cv[i]);
            const float qp = __shfl_xor(q0, 32), kp = __shfl_xor(k0, 32);
            const float sg = lane < 32 ? -cs[i] : cs[i];
            const float q = q0 * cc[i] + qp * sg, k = (k0 * cc[i] + kp * sg) * 0.125f;
            float o = 0.f;
#pragma unroll
            for (int d = 0; d < 64; ++d) { M[d] = gamma * M[d] + rdl(k, d) * v; o += rdl(q, d) * M[d]; }
            const float y = o * rsqrtf(wave_sum(o * o) * (1.0f / 64.0f) + 1e-6f) * siluf(bf2f(cz[i]));
            ZB[(tok0 + t0 + i) * ZB_LD + 1024 + h * 64 + lane] = (bf16)f2bf(y);
        }
    }
#undef RET_LOAD
}

typedef short bf16x8 __attribute__((ext_vector_type(8)));
constexpr int PT = 72, MAT = 64 * PT * 2;
constexpr int L_Q = 0, L_K = MAT, L_KDT = 2 * MAT, L_VT = 3 * MAT, L_P = 4 * MAT, L_ST0 = 5 * MAT, L_ST1 = 6 * MAT, L_W = 7 * MAT, L_UT = 8 * MAT, L_YT = 9 * MAT,
              YPT = 68, L_G = L_YT + 64 * YPT * 4, L_CW = L_G + 256, L_WEND = L_CW + 192 * 5 * 4;
static_assert(L_WEND <= RING_BYTES, "walker LDS");
constexpr size_t GW_OFF = 0, HALO_OFF = 32 * MiB;
#define MFMA16(a, b, c) __builtin_amdgcn_mfma_f32_16x16x32_bf16(a, b, c, 0, 0, 0)
__device__ __forceinline__ bf16x8 ldfrag(LAS unsigned char* base, int row, int kelem) { return *(const LAS bf16x8*)(base + row * (PT * 2) + kelem * 2); }
__device__ __forceinline__ void unpk8(const v4u w, float (&f)[8]) { f[0] = pg8::bflo(w.x); f[1] = pg8::bfhi(w.x); f[2] = pg8::bflo(w.y); f[3] = pg8::bfhi(w.y); f[4] = pg8::bflo(w.z); f[5] = pg8::bfhi(w.z); f[6] = pg8::bflo(w.w); f[7] = pg8::bfhi(w.w); }
__device__ __forceinline__ v4u pk8(const float (&f)[8]) { v4u w; w.x = pk2(f[0], f[1]); w.y = pk2(f[2], f[3]); w.z = pk2(f[4], f[5]); w.w = pk2(f[6], f[7]); return w; }
__device__ __forceinline__ void st_tr8(LAS unsigned char* base, int row0, int col, const float (&f)[8]) {
#pragma unroll
    for (int j = 0; j < 8; ++j) *(LAS bf16*)(base + (row0 + j) * (PT * 2) + col * 2) = (bf16)f2bf(f[j]);
}

template <int KIND>
__device__ __forceinline__ void mixer_walk(const __attribute__((address_space(4))) Args* kp, int layer, int b, int h, LAS unsigned char* lds) {
    int tid = threadIdx.x; asm volatile("" : "+v"(tid));
    const int lane = tid & 63, wave = __builtin_amdgcn_readfirstlane(tid >> 6), fr = lane & 15, fq = lane >> 4;
    const int prow = tid >> 3, pcg = tid & 7;
    unsigned char* ws = kp->ws;
    const bf16* MIX = (const bf16*)(ws + WS_MIX); bf16* ZB = (bf16*)(ws + WS_ZB); float* SM = (float*)(ws + WS_SM); const float* ROPE = (const float*)(ws + WS_ROPE);
    const bf16* GW = (const bf16*)(ws + ((layer & 1) ? WS_XB0 : WS_XB1) + GW_OFF);
    const size_t tok0 = (size_t)b * SEQ;
    const int zcol = KIND * 512 + h * 64 + pcg * 8;
    const int g = h >> 2;
    float nw[8];
    float p_aexp = 0.f, p_dtb = 0.f, p_D = 0.f, p_lg = 0.f;
    if (KIND == 0) {
#pragma unroll
        for (int j = 0; j < 8; ++j) nw[j] = kp->in[7][layer * 64 + pcg * 8 + j];
    }
    if (KIND == 1) { p_aexp = expf(kp->in[10][layer * 8 + h]); p_dtb = kp->in[11][layer * 8 + h]; p_D = kp->in[12][layer * 8 + h];
        const float* cw = kp->in[8] + (size_t)layer * 4 * 768; const float* cb = kp->in[9] + (size_t)layer * 768;
        if (tid < 192) { const int ch = tid < 64 ? h * 64 + tid : (tid < 128 ? 512 + g * 64 + (tid - 64) : 640 + g * 64 + (tid - 128));
            LAS float* d = (LAS float*)(lds + L_CW) + tid * 5;
            d[0] = cw[ch]; d[1] = cw[768 + ch]; d[2] = cw[2 * 768 + ch]; d[3] = cw[3 * 768 + ch]; d[4] = cb[ch]; }
    }
    if (KIND == 2) p_lg = log1pf(-exp2f(-5.0f - (float)h));
    for (int i = tid; i < MAT / 4; i += 512) ((LAS unsigned*)(lds + L_ST0))[i] = 0u;
    pg8::f32x4 sacc[4];
#pragma unroll
    for (int i = 0; i < 4; ++i) sacc[i] = (pg8::f32x4){0.f, 0.f, 0.f, 0.f};
    float xsD[8];
#pragma unroll
    for (int j = 0; j < 8; ++j) xsD[j] = 0.f;
    __syncthreads();

    v4u r0[4], r1[4], r2[4]; v4u rz_n; float rf0 = 0.f, rf1 = 0.f; pg8::f32x4 rc0, rc1, rs0, rs1;
    (void)r0; (void)r1; (void)r2; (void)rf0; (void)rf1; (void)rc0; (void)rc1; (void)rs0; (void)rs1;
#define WALK_LOAD(c) do { const size_t row = tok0 + (size_t)(c) * 64 + prow; \
        if (KIND == 0) { const bf16* mp = MIX + row * MIX_LD + h * 64 + pcg * 8; \
            r0[0] = *(const GAS v4u*)(mp + MX_AQ); r0[1] = *(const GAS v4u*)(mp + MX_AK); r0[2] = *(const GAS v4u*)(mp + MX_AV); r0[3] = *(const GAS v4u*)(GW + row * 512 + h * 64 + pcg * 8); \
            rf0 = SM[row * SM_LD + 8 + h]; rf1 = SM[(tok0 + (size_t)(c) * 64 + 63) * SM_LD + 8 + h]; } \
        if (KIND == 1) { _Pragma("unroll") for (int k = 0; k < 4; ++k) { const long rr = (long)(c) * 64 + prow - 3 + k; \
                if (rr >= 0) { const bf16* mp = MIX + (tok0 + rr) * MIX_LD; r0[k] = *(const GAS v4u*)(mp + MX_BX + h * 64 + pcg * 8); r1[k] = *(const GAS v4u*)(mp + MX_BB + g * 64 + pcg * 8); r2[k] = *(const GAS v4u*)(mp + MX_BC + g * 64 + pcg * 8); } \
                else { r0[k] = (v4u){0u, 0u, 0u, 0u}; r1[k] = r0[k]; r2[k] = r0[k]; } } \
            rf0 = SM[(tok0 + (size_t)(c) * 64 + lane) * SM_LD + 16 + h]; } \
        if (KIND == 2) { const bf16* mp = MIX + row * MIX_LD + h * 64 + pcg * 8; \
            r0[0] = *(const GAS v4u*)(mp + MX_CQ); r0[1] = *(const GAS v4u*)(mp + MX_CK); r0[2] = *(const GAS v4u*)(mp + MX_CV); \
            const float* rp = ROPE + ((c) * 64 + prow) * 32 + (pcg & 3) * 8; rc0 = *(const GAS pg8::f32x4*)rp; rc1 = *(const GAS pg8::f32x4*)(rp + 4); rs0 = *(const GAS pg8::f32x4*)(rp + SEQ * 32); rs1 = *(const GAS pg8::f32x4*)(rp + SEQ * 32 + 4); } \
        rz_n = *(const GAS v4u*)(ZB + row * ZB_LD + zcol); } while (0)

#define WALK_PREP() do { \
        if (KIND == 0) { \
            *(LAS v4u*)(lds + L_Q + prow * (PT * 2) + pcg * 16) = r0[0]; *(LAS v4u*)(lds + L_K + prow * (PT * 2) + pcg * 16) = r0[1]; *(LAS v4u*)(lds + L_W + prow * (PT * 2) + pcg * 16) = r0[3]; \
            float kf[8], uf[8]; unpk8(r0[1], kf); unpk8(r0[2], uf); const float sc = __expf(rf1 - rf0); \
            _Pragma("unroll") for (int j = 0; j < 8; ++j) kf[j] *= sc; \
            st_tr8(lds + L_KDT, pcg * 8, prow, kf); st_tr8(lds + L_UT, pcg * 8, prow, uf); \
            if (pcg == 0) { ((LAS float*)(lds + L_G))[prow] = rf0; } } \
        if (KIND == 1) { \
            float dt = softplusf(rf0 + p_dtb), Gs = -p_aexp * dt;                           \
            _Pragma("unroll") for (int o = 1; o < 64; o <<= 1) { const float t_ = __shfl_up(Gs, o); if (lane >= o) Gs += t_; } \
            const float Glast = __shfl(Gs, 63), Gr = __shfl(Gs, prow), dtr = __shfl(dt, prow); \
            if (wave == 0) ((LAS float*)(lds + L_G))[lane] = Gs; \
            const LAS float* cwx = (const LAS float*)(lds + L_CW) + (pcg * 8) * 5; \
            float xa[8], ba[8], ca[8]; \
            _Pragma("unroll") for (int j = 0; j < 8; ++j) { xa[j] = cwx[j * 5 + 4]; ba[j] = cwx[(64 + j) * 5 + 4]; ca[j] = cwx[(128 + j) * 5 + 4]; } \
            _Pragma("unroll") for (int k = 0; k < 4; ++k) { float f[8]; \
                unpk8(r0[k], f); _Pragma("unroll") for (int j = 0; j < 8; ++j) xa[j] += cwx[j * 5 + k] * f[j]; \
                unpk8(r1[k], f); _Pragma("unroll") for (int j = 0; j < 8; ++j) ba[j] += cwx[(64 + j) * 5 + k] * f[j]; \
                unpk8(r2[k], f); _Pragma("unroll") for (int j = 0; j < 8; ++j) ca[j] += cwx[(128 + j) * 5 + k] * f[j]; } \
            const float kd = __expf(Glast - Gr); float vx[8], kdv[8]; \
            _Pragma("unroll") for (int j = 0; j < 8; ++j) { xa[j] = siluf(xa[j]); ba[j] = siluf(ba[j]); ca[j] = siluf(ca[j]); xsD[j] = p_D * xa[j]; vx[j] = xa[j] * dtr; kdv[j] = ba[j] * kd; } \
            *(LAS v4u*)(lds + L_Q + prow * (PT * 2) + pcg * 16) = pk8(ca); *(LAS v4u*)(lds + L_K + prow * (PT * 2) + pcg * 16) = pk8(ba); \
            st_tr8(lds + L_KDT, pcg * 8, prow, kdv); st_tr8(lds + L_VT, pcg * 8, prow, vx); } \
        if (KIND == 2) { \
            float qf[8], kf[8], vf[8], qp[8], kp_[8]; unpk8(r0[0], qf); unpk8(r0[1], kf); unpk8(r0[2], vf); \
            _Pragma("unroll") for (int j = 0; j < 8; ++j) { qp[j] = __shfl_xor(qf[j], 4); kp_[j] = __shfl_xor(kf[j], 4); } \
            const float sg = pcg < 4 ? -1.f : 1.f; const float kd = __expf((float)(63 - prow) * p_lg) * 0.125f; float kdv[8]; \
            _Pragma("unroll") for (int j = 0; j < 8; ++j) { const float cs_ = j < 4 ? rc0[j & 3] : rc1[j & 3], sn_ = (j < 4 ? rs0[j & 3] : rs1[j & 3]) * sg; \
                qf[j] = qf[j] * cs_ + qp[j] * sn_; kf[j] = kf[j] * cs_ + kp_[j] * sn_; kdv[j] = kf[j] * kd; kf[j] *= 0.125f; } \
            *(LAS v4u*)(lds + L_Q + prow * (PT * 2) + pcg * 16) = pk8(qf); *(LAS v4u*)(lds + L_K + prow * (PT * 2) + pcg * 16) = pk8(kf); \
            st_tr8(lds + L_KDT, pcg * 8, prow, kdv); st_tr8(lds + L_VT, pcg * 8, prow, vf); \
            if (pcg == 0) ((LAS float*)(lds + L_G))[prow] = (float)(prow + 1) * p_lg; } \
    } while (0)

    WALK_LOAD(0);
    v4u rz = rz_n;
    WALK_PREP();
    __syncthreads();
    for (int c = 0; c < SEQ / 64; ++c) {
        LAS unsigned char* STc = lds + ((c & 1) ? L_ST1 : L_ST0); LAS unsigned char* STn = lds + ((c & 1) ? L_ST0 : L_ST1);
        const LAS float* Gl = (const LAS float*)(lds + L_G);
        rz = rz_n;
        if (c + 1 < SEQ / 64) WALK_LOAD(c + 1);
        if (wave >= 4) {
            if (KIND == 0) { const int wq = wave - 4;
#pragma unroll
                for (int eb = 0; eb < 4; ++eb) { pg8::f32x4 acc = (pg8::f32x4){0.f, 0.f, 0.f, 0.f};
#pragma unroll
                    for (int ks = 0; ks < 2; ++ks) acc = MFMA16(ldfrag(lds + L_W, 16 * wq + fr, 32 * ks + 8 * fq), ldfrag(STc, 16 * eb + fr, 32 * ks + 8 * fq), acc);
                    const v2u uu = *(const LAS v2u*)(lds + L_UT + (16 * eb + fr) * (PT * 2) + (16 * wq + 4 * fq) * 2);
                    v2u o; o.x = pk2(pg8::bflo(uu.x) - acc[0], pg8::bfhi(uu.x) - acc[1]); o.y = pk2(pg8::bflo(uu.y) - acc[2], pg8::bfhi(uu.y) - acc[3]);
                    *(LAS v2u*)(lds + L_VT + (16 * eb + fr) * (PT * 2) + (16 * wq + 4 * fq) * 2) = o; }
            }
        } else {
            const int sb = wave;
            float gs[4];
#pragma unroll
            for (int r = 0; r < 4; ++r) gs[r] = Gl[16 * sb + 4 * fq + r];
#pragma unroll
            for (int lb = 0; lb < 4; ++lb) { v2u o; o.x = 0u; o.y = 0u;
                if (lb >= sb) { pg8::f32x4 acc = (pg8::f32x4){0.f, 0.f, 0.f, 0.f};
#pragma unroll
                    for (int ks = 0; ks < 2; ++ks) acc = MFMA16(ldfrag(lds + L_K, 16 * sb + fr, 32 * ks + 8 * fq), ldfrag(lds + L_Q, 16 * lb + fr, 32 * ks + 8 * fq), acc);
                    const float gl = Gl[16 * lb + fr]; const int l = 16 * lb + fr; float pv[4];
#pragma unroll
                    for (int r = 0; r < 4; ++r) { const int s = 16 * sb + 4 * fq + r; pv[r] = s <= l ? acc[r] * __expf(gl - gs[r]) : 0.f; }
                    o.x = pk2(pv[0], pv[1]); o.y = pk2(pv[2], pv[3]); }
                *(LAS v2u*)(lds + L_P + (16 * lb + fr) * (PT * 2) + (16 * sb + 4 * fq) * 2) = o; }
        }
        __syncthreads();
        if (wave < 4) { const int lb = wave; float eg[4];
#pragma unroll
            for (int r = 0; r < 4; ++r) eg[r] = __expf(Gl[16 * lb + 4 * fq + r]);
#pragma unroll
            for (int eb = 0; eb < 4; ++eb) { pg8::f32x4 acc = (pg8::f32x4){0.f, 0.f, 0.f, 0.f};
#pragma unroll
                for (int ks = 0; ks < 2; ++ks) acc = MFMA16(ldfrag(lds + L_Q, 16 * lb + fr, 32 * ks + 8 * fq), ldfrag(STc, 16 * eb + fr, 32 * ks + 8 * fq), acc);
#pragma unroll
                for (int r = 0; r < 4; ++r) acc[r] *= eg[r];
#pragma unroll
                for (int ks = 0; ks < 2; ++ks) acc = MFMA16(ldfrag(lds + L_P, 16 * lb + fr, 32 * ks + 8 * fq), ldfrag(lds + L_VT, 16 * eb + fr, 32 * ks + 8 * fq), acc);
#pragma unroll
                for (int r = 0; r < 4; ++r) ((LAS float*)(lds + L_YT))[(16 * lb + 4 * fq + r) * YPT + 16 * eb + fr] = acc[r]; }
        } else { const int db = wave - 4; const float egl = __expf(Gl[63]);
#pragma unroll
            for (int eb = 0; eb < 4; ++eb) { pg8::f32x4 acc = sacc[eb] * egl;
#pragma unroll
                for (int ks = 0; ks < 2; ++ks) acc = MFMA16(ldfrag(lds + L_KDT, 16 * db + fr, 32 * ks + 8 * fq), ldfrag(lds + L_VT, 16 * eb + fr, 32 * ks + 8 * fq), acc);
                sacc[eb] = acc;
                v2u o; o.x = pk2(acc[0], acc[1]); o.y = pk2(acc[2], acc[3]);
                *(LAS v2u*)(STn + (16 * eb + fr) * (PT * 2) + (16 * db + 4 * fq) * 2) = o; }
        }
        __syncthreads();
        {
            const LAS float* yr = (const LAS float*)(lds + L_YT) + prow * YPT + pcg * 8;
            const pg8::f32x4 y0 = *(const LAS pg8::f32x4*)yr, y1 = *(const LAS pg8::f32x4*)(yr + 4);
            float y[8] = {y0[0], y0[1], y0[2], y0[3], y1[0], y1[1], y1[2], y1[3]}, zf[8]; unpk8(rz, zf);
            const size_t row = tok0 + (size_t)c * 64 + prow;
            if (KIND == 1) { float ss = 0.f;
#pragma unroll
                for (int j = 0; j < 8; ++j) { y[j] = (y[j] + xsD[j]) * siluf(zf[j]); ss += y[j] * y[j]; }
                ss += __shfl_xor(ss, 1); ss += __shfl_xor(ss, 2); ss += __shfl_xor(ss, 4);
                if (pcg == 0) SM[row * SM_LD + 24 + h] = ss;
            } else { float ss = 0.f;
#pragma unroll
                for (int j = 0; j < 8; ++j) ss += y[j] * y[j];
                ss += __shfl_xor(ss, 1); ss += __shfl_xor(ss, 2); ss += __shfl_xor(ss, 4);
                const float rstd = rsqrtf(ss * (1.0f / 64.0f) + 1e-6f);
#pragma unroll
                for (int j = 0; j < 8; ++j) y[j] = y[j] * rstd * (KIND == 0 ? nw[j] : 1.0f) * siluf(zf[j]); }
            *(GAS v4u*)(ZB + row * ZB_LD + zcol) = pk8(y);
        }
        if (c + 1 < SEQ / 64) WALK_PREP();
        __syncthreads();
    }
#undef WALK_LOAD
#undef WALK_PREP
}

constexpr int GP_KN = 0, GP_AF = MAT, APT = 68, FPT = 65, GP_R = GP_AF + 64 * APT * 4, GP_TEAM = GP_R + 3 * 256;
constexpr int GP_RAW1 = 67 * 128;
static_assert(4 * GP_TEAM <= LDS_BYTES - 1024 && 2 * GP_RAW1 <= 64 * APT * 4 && 64 * FPT * 4 <= 64 * APT * 4, "gdn_prep LDS");
__device__ __forceinline__ void gdn_prep(const __attribute__((address_space(4))) Args* kp, int layer, LAS unsigned char* lds_all, int G_) {
    int tid = threadIdx.x; asm volatile("" : "+v"(tid));
    const int team = __builtin_amdgcn_readfirstlane(tid >> 7), j = tid & 127, lane = tid & 63, hw = __builtin_amdgcn_readfirstlane((tid >> 6) & 1), fr = lane & 15, fq = lane >> 4;
    LAS unsigned char* lds = lds_all + team * GP_TEAM;
    LAS unsigned char* OV = lds + GP_AF;
    LAS float* AF = (LAS float*)OV; LAS float* FF = (LAS float*)OV; LAS float* Gs = (LAS float*)(lds + GP_R); LAS float* Bs = Gs + 64; LAS float* Rn = Gs + 128;
    unsigned char* ws = kp->ws;
    bf16* MIX = (bf16*)(ws + WS_MIX); float* SM = (float*)(ws + WS_SM);
    unsigned char* xbf = ws + ((layer & 1) ? WS_XB0 : WS_XB1); bf16* GW = (bf16*)(xbf + GW_OFF); const bf16* HALO = (const bf16*)(xbf + HALO_OFF);
    const float* cw = kp->in[4] + (size_t)layer * 4 * 1536;
    for (int round = 0; round < 4; ++round) {
        const int unit_ = (round * G_ + (int)blockIdx.x) * 4 + team;
        const bool live = unit_ < NBATCH * 8 * 64;
        const int unit = live ? unit_ : 0;
        const int c = unit & 63, h = (unit >> 6) & 7, b = unit >> 9;
        const size_t tok0 = (size_t)b * SEQ + (size_t)c * 64;
        const float Aexp = expf(kp->in[5][layer * 8 + h]), dtb = kp->in[6][layer * 8 + h];
        for (int i = j; i < 67 * 8; i += 128) { const int r = i >> 3, ch = i & 7; v4u vk = (v4u){0u, 0u, 0u, 0u}, vv = vk;
            if (r >= 3) { const bf16* mp = MIX + (tok0 + r - 3) * MIX_LD + h * 64 + ch * 8; vk = *(const GAS v4u*)(mp + MX_AK); vv = *(const GAS v4u*)(mp + MX_AV); }
            else if (c > 0) { const bf16* hp = HALO + ((size_t)(b * 64 + c - 1) * 3 + r) * 1536 + h * 64 + ch * 8; vk = *(const GAS v4u*)(hp + MX_AK); vv = *(const GAS v4u*)(hp + MX_AV); }
            *(LAS v4u*)(OV + r * 128 + ch * 16) = vk; *(LAS v4u*)(OV + GP_RAW1 + r * 128 + ch * 16) = vv; }
        __syncthreads();
        float x[64];
        { const int colA = (hw == 0 ? MX_AV : MX_AK) + h * 64 + lane;
          const float w0 = cw[colA], w1 = cw[1536 + colA], w2 = cw[2 * 1536 + colA], w3 = cw[3 * 1536 + colA];
          const LAS bf16* rp = (const LAS bf16*)(OV + (hw == 0 ? GP_RAW1 : 0)) + lane;
          float h0 = bf2f(rp[0]), h1 = bf2f(rp[64]), h2 = bf2f(rp[128]);
#pragma unroll
          for (int t = 0; t < 64; ++t) { const float xr = bf2f(rp[(t + 3) * 64]); x[t] = siluf(w0 * h0 + w1 * h1 + w2 * h2 + w3 * xr); h0 = h1; h1 = h2; h2 = xr; } }
        if (hw == 0) { const float bl = SM[(tok0 + lane) * SM_LD + h], al = SM[(tok0 + lane) * SM_LD + 8 + h];
            float gsum = -Aexp * softplusf(al + dtb);
#pragma unroll
            for (int o = 1; o < 64; o <<= 1) { const float t_ = __shfl_up(gsum, o); if (lane >= o) gsum += t_; }
            Gs[lane] = gsum; Bs[lane] = sigmf(bl);
            if (live) SM[(tok0 + lane) * SM_LD + 8 + h] = gsum; }
        __syncthreads();
        if (hw == 1) {
#pragma unroll
            for (int t = 0; t < 64; ++t) FF[t * FPT + lane] = x[t]; }
        __syncthreads();
        if (hw == 1) { float s = 0.f;
#pragma unroll
            for (int d = 0; d < 64; ++d) { const float v = FF[lane * FPT + d]; s += v * v; }
            Rn[lane] = rsqrtf(s + 1e-6f); }
        __syncthreads();
        if (hw == 1) {
#pragma unroll
            for (int t = 0; t < 64; ++t) { const float kn = x[t] * Rn[t]; const bf16 kb = (bf16)f2bf(kn);
                *(LAS bf16*)(lds + GP_KN + t * (PT * 2) + lane * 2) = kb;
                x[t] = Bs[t] * bf2f(kb) * __expf(Gs[t]);
                if ((t & 7) == 7) asm volatile("" ::: "memory"); }
        } else {
#pragma unroll
            for (int t = 0; t < 64; ++t) { x[t] *= Bs[t]; if ((t & 15) == 15) asm volatile("" ::: "memory"); }
        }
        __syncthreads();
        if (live) for (int i = j; i < 64 * 8; i += 128) { const int t = i >> 3, ch = i & 7; *(GAS v4u*)(MIX + (tok0 + t) * MIX_LD + MX_AK + h * 64 + ch * 8) = *(const LAS v4u*)(lds + GP_KN + t * (PT * 2) + ch * 16); }
#pragma unroll
        for (int blk = 0; blk < 5; ++blk) { const int id = blk * 2 + hw;
            const int lb = id < 1 ? 0 : (id < 3 ? 1 : (id < 6 ? 2 : 3)), sb = id - (lb * (lb + 1)) / 2;
            pg8::f32x4 acc = (pg8::f32x4){0.f, 0.f, 0.f, 0.f};
#pragma unroll
            for (int ks = 0; ks < 2; ++ks) acc = MFMA16(ldfrag(lds + GP_KN, 16 * lb + fr, 32 * ks + 8 * fq), ldfrag(lds + GP_KN, 16 * sb + fr, 32 * ks + 8 * fq), acc);
            const int s = 16 * sb + fr; const float gsv = Gs[s];
#pragma unroll
            for (int r = 0; r < 4; ++r) { const int l = 16 * lb + 4 * fq + r; AF[l * APT + s] = s < l ? Bs[l] * acc[r] * __expf(Gs[l] - gsv) : 0.f; } }
        __syncthreads();
#pragma unroll
        for (int l = 1; l < 64; ++l) { float a = x[l];
#pragma unroll
            for (int s4 = 0; s4 < l; s4 += 4) { const pg8::f32x4 av = *(const LAS pg8::f32x4*)(AF + l * APT + s4);
                a -= av[0] * x[s4];
                if (s4 + 1 < l) a -= av[1] * x[s4 + 1];
                if (s4 + 2 < l) a -= av[2] * x[s4 + 2];
                if (s4 + 3 < l) a -= av[3] * x[s4 + 3]; }
            x[l] = a; asm volatile("" ::: "memory"); }
        __syncthreads();
#pragma unroll
        for (int t = 0; t < 64; ++t) *(LAS bf16*)(OV + hw * 8192 + t * 128 + lane * 2) = (bf16)f2bf(x[t]);
        __syncthreads();
        if (live) for (int i = j; i < 64 * 8; i += 128) { const int t = i >> 3, ch = i & 7;
            *(GAS v4u*)(MIX + (tok0 + t) * MIX_LD + MX_AV + h * 64 + ch * 8) = *(const LAS v4u*)(OV + t * 128 + ch * 16);
            *(GAS v4u*)(GW + (tok0 + t) * 512 + h * 64 + ch * 8) = *(const LAS v4u*)(OV + 8192 + t * 128 + ch * 16); }
        __syncthreads();
        for (int i = j; i < 67 * 8; i += 128) { const int r = i >> 3, ch = i & 7; v4u vq = (v4u){0u, 0u, 0u, 0u};
            if (r >= 3) vq = *(const GAS v4u*)(MIX + (tok0 + r - 3) * MIX_LD + MX_AQ + h * 64 + ch * 8);
            else if (c > 0) vq = *(const GAS v4u*)(HALO + ((size_t)(b * 64 + c - 1) * 3 + r) * 1536 + MX_AQ + h * 64 + ch * 8);
            *(LAS v4u*)(OV + r * 128 + ch * 16) = vq; }
        __syncthreads();
        if (hw == 0) { const int colQ = MX_AQ + h * 64 + lane;
            const float w0 = cw[colQ], w1 = cw[1536 + colQ], w2 = cw[2 * 1536 + colQ], w3 = cw[3 * 1536 + colQ];
            const LAS bf16* rp = (const LAS bf16*)OV + lane;
            float h0 = bf2f(rp[0]), h1 = bf2f(rp[64]), h2 = bf2f(rp[128]);
#pragma unroll
            for (int t = 0; t < 64; ++t) { const float xr = bf2f(rp[(t + 3) * 64]); x[t] = siluf(w0 * h0 + w1 * h1 + w2 * h2 + w3 * xr); h0 = h1; h1 = h2; h2 = xr; } }
        __syncthreads();
        if (hw == 0) {
#pragma unroll
            for (int t = 0; t < 64; ++t) FF[t * FPT + lane] = x[t]; }
        __syncthreads();
        if (hw == 0) { float s = 0.f;
#pragma unroll
            for (int d = 0; d < 64; ++d) { const float v = FF[lane * FPT + d]; s += v * v; }
            Rn[lane] = rsqrtf(s + 1e-6f) * 0.125f; }
        __syncthreads();
        if (hw == 0) {
#pragma unroll
            for (int t = 0; t < 64; ++t) *(LAS bf16*)(lds + GP_KN + t * (PT * 2) + lane * 2) = (bf16)f2bf(x[t] * Rn[t]); }
        __syncthreads();
        if (live) for (int i = j; i < 64 * 8; i += 128) { const int t = i >> 3, ch = i & 7; *(GAS v4u*)(MIX + (tok0 + t) * MIX_LD + MX_AQ + h * 64 + ch * 8) = *(const LAS v4u*)(lds + GP_KN + t * (PT * 2) + ch * 16); }
        __syncthreads();
    }
}
#ifndef MK_ONE_LAUNCH
#define MK_ONE_LAUNCH 1
#endif
#ifndef MK_NAIVE
#define MK_NAIVE 0
#endif
__global__ void __launch_bounds__(64) mixers_naive(Args args, int layer) {
    const int lane = threadIdx.x, w = blockIdx.x, kind = w >> 6, b = (w & 63) >> 3, h = w & 7;
    unsigned char* ws = args.ws;
    bf16* ZB = (bf16*)(ws + WS_ZB); const bf16* MIX = (const bf16*)(ws + WS_MIX); float* SM = (float*)(ws + WS_SM); const float* ROPE = (const float*)(ws + WS_ROPE);
    if (kind == 0) gdn_naive(args, layer, b, h, lane, MIX, SM, ZB);
    else if (kind == 1) ssd_naive(args, layer, b, h, lane, MIX, SM, ZB);
    else ret_naive(b, h, lane, MIX, ROPE, ZB);
}
__global__ void __launch_bounds__(512, 2) fwd_kernel(Args args) {
    extern __shared__ __attribute__((aligned(16))) unsigned char lds_raw[];
    LAS unsigned char* lds = (LAS unsigned char*)lds_raw;
    volatile LAS unsigned* MISC = (volatile LAS unsigned*)(lds + MISC_OFF);
    const int G = gridDim.x, NGW = G * 8;
    unsigned char* ws0 = args.ws;
    for (int u = threadIdx.x; u < (LDS_BYTES - RING_BYTES) / 4; u += 512) ((LAS unsigned*)(lds + RING_BYTES))[u] = 0u;
    __syncthreads();
#if MK_ONE_LAUNCH
    XcdBarrier bar = xcd_barrier_post((unsigned*)(ws0 + WS_CTL) + 4096, MISC + 8);
#define GRID_BAR() xcd_barrier(bar)
#else
#define GRID_BAR() do {} while (0)
#endif
    const int lo = args.ph_lo, hi = args.ph_hi;
#define IN(p) (lo <= (p) && (p) < hi)
#define SEAM(p) do { if (IN(p) && IN((p) + 1)) GRID_BAR(); } while (0)
    typedef const __attribute__((address_space(4))) Args* KArgs;
    const KArgs kp0 = (KArgs)__builtin_amdgcn_kernarg_segment_ptr();
#define PHASE_PTRS() KArgs kp = kp0; asm volatile("" : "+s"(kp)); unsigned char* ws = kp->ws; float* X = kp->out; (void)X; \
    int tid = threadIdx.x; asm volatile("" : "+v"(tid)); const int lane = tid & 63, wave = __builtin_amdgcn_readfirstlane(tid >> 6), gw = blockIdx.x * 8 + wave; (void)lane; (void)gw; \
    bf16* ZB = (bf16*)(ws + WS_ZB); bf16* MIX = (bf16*)(ws + WS_MIX); float* SM = (float*)(ws + WS_SM); (void)ZB; (void)MIX; (void)SM; \
    float* SSQA = (float*)(ws + WS_SSQA); float* SSQB = (float*)(ws + WS_SSQB); float* SSQC = (float*)(ws + WS_SSQC); float* ROPE = (float*)(ws + WS_ROPE); (void)SSQA; (void)SSQB; (void)SSQC; (void)ROPE; \
    bf16* W1T = (bf16*)(ws + W_1T); bf16* WGT = (bf16*)(ws + W_GT); bf16* WMT = (bf16*)(ws + W_MT); bf16* WOT = (bf16*)(ws + W_OT); bf16* WUT = (bf16*)(ws + W_UT); (void)W1T; (void)WGT; (void)WMT; (void)WOT; (void)WUT; \
    bf16* WDT = (bf16*)(ws + W_DT); bf16* WPGT = (bf16*)(ws + W_PGT); bf16* WPPT = (bf16*)(ws + W_PPT); (void)WDT; (void)WPGT; (void)WPPT; \
    bf16* GATE = (bf16*)(ws + WS_GATE); bf16* U = (bf16*)(ws + WS_U); bf16* PB = (bf16*)(ws + WS_PB); bf16* PLE = (bf16*)(ws + WS_PLE); (void)GATE; (void)U; (void)PB; (void)PLE; \
    bf16* XBl = (bf16*)(ws + ((layer & 1) ? WS_XB1 : WS_XB0)); bf16* XBf = (bf16*)(ws + ((layer & 1) ? WS_XB0 : WS_XB1)); (void)XBl; (void)XBf
    for (int layer = 0; layer < DEPTH; ++layer) {
        const int P = layer * NPH;
        if (IN(P + 0)) { PHASE_PTRS();
            LAS float* scr = (LAS float*)(lds + wave * 16384);
            int ibase = 0;
            const float* w_in = kp->in[3] + (size_t)layer * DM * NIN; const float* nmix = kp->in[2] + (size_t)layer * DM;
            TR_SEG(w_in, NIN, 1536, 512, DM, nmix, W1T, DM, 0, 0);
            TR_SEG(w_in, NIN, 2064, 512, DM, nmix, W1T, DM, 512, 0);
            TR_SEG(w_in, NIN, 4888, 512, DM, nmix, W1T, DM, 1024, 0);
            TR_SEG(w_in, NIN, 0, 1536, DM, nmix, W1T, DM, 1536, 0);
            TR_SEG(w_in, NIN, 2576, 768, DM, nmix, W1T, DM, 3072, 0);
            TR_SEG(w_in, NIN, 3352, 1536, DM, nmix, W1T, DM, 3840, 0);
            TR_SEG(w_in, NIN, 2048, 16, DM, nmix, W1T, DM, 5376, 0);
            TR_SEG(w_in, NIN, 3344, 8, DM, nmix, W1T, DM, 5392, 0);
            TR_SEG((const float*)nullptr, NIN, 0, 232, DM, (const float*)nullptr, W1T, DM, 5400, 0);
            TR_SEG(w_in, NIN, 5400, 3072, DM, nmix, WGT, DM, 0, 0);
            const float* wbr = kp->in[14] + (size_t)layer * 3 * 512 * DM;
            TR_SEG(wbr, DM, 0, DM, 512, (const float*)nullptr, WMT, KMERGE, 0, 0);
            TR_SEG(wbr + 512 * DM, DM, 0, DM, 512, kp->in[13] + (size_t)layer * 512, WMT, KMERGE, 0, 512);
            TR_SEG(wbr + 2 * 512 * DM, DM, 0, DM, 512, (const float*)nullptr, WMT, KMERGE, 0, 1024);
            TR_SEG(kp->in[15] + (size_t)layer * DM * DM, DM, 0, DM, DM, (const float*)nullptr, WOT, DM, 0, 0);
            TR_SEG(kp->in[17] + (size_t)layer * DM * DFF, DFF, 0, DFF, DM, kp->in[16] + (size_t)layer * DM, WUT, DM, 0, 0);
            TR_SEG(kp->in[18] + (size_t)layer * DFF * DM, DM, 0, DM, DFF, (const float*)nullptr, WDT, DFF, 0, 0);
            TR_SEG(kp->in[20] + (size_t)layer * DM * DM, DM, 0, DM, DM, kp->in[19] + (size_t)layer * DM, WPGT, DM, 0, 0);
            TR_SEG(kp->in[21] + (size_t)layer * PLED * DM, DM, 0, DM, PLED, (const float*)nullptr, WPPT, PLED, 0, 0);
            if (layer == 0) {
                const float* xin = kp->in[0];
                for (int m = gw; m < MTOK; m += NGW) {
                    const GAS f32x4* xr = (const GAS f32x4*)(xin + (size_t)m * DM) + lane; f32x4 v[4]; float s = 0.f;
#pragma unroll
                    for (int j = 0; j < 4; ++j) { v[j] = xr[64 * j]; s += (v[j].x * v[j].x + v[j].y * v[j].y) + (v[j].z * v[j].z + v[j].w * v[j].w); }
                    s = wave_sum(s);
                    GAS v2u* o8 = (GAS v2u*)(XBl + (size_t)m * DM) + lane;
#pragma unroll
                    for (int j = 0; j < 4; ++j) { v2u w; w.x = pk2(v[j].x, v[j].y); w.y = pk2(v[j].z, v[j].w); o8[64 * j] = w; }
                    if (lane < 16) SSQC[(size_t)m * 16 + lane] = lane == 0 ? s : 0.f;
                }
            }
        }
        SEAM(P + 0);
        if (IN(P + 1)) { PHASE_PTRS();
            pg8::Gemm g{XBl, W1T, MTOK, N1, DM}; pg8::StaticOrder S; S.init(MTOK, N1, G, (int)blockIdx.x);
            pg8::EpiP1 E{ZB, MIX, SM, SSQC, (bf16*)((unsigned char*)XBf + HALO_OFF)};
            pg8::gemm_phase<pg8::EpiP1, pg8::StaticOrder, true, true>(lds, g, S, E);
        }
        SEAM(P + 1);
        if (IN(P + 2)) { PHASE_PTRS();
#if !MK_NAIVE
            gdn_prep(kp, layer, lds, G);
#endif
            for (int e = blockIdx.x * 512 + tid; e < SEQ * 32; e += G * 512) { const int t = e >> 5, i = e & 31;
                double f = 1.0; for (int j = 0; j < i; ++j) f *= 0.7429639507594948;
                const double ang = (double)t * f, kk = rint(ang * 0.15915494309189535);
                double r = fma(-kk, 6.283185307179586, ang); r = fma(-kk, 2.4492935982947064e-16, r); const double r2 = r * r;
                double sn = 1.0, cs = 1.0;
#pragma unroll
                for (int n = 15; n >= 1; --n) { sn = 1.0 - r2 * (1.0 / (double)((2 * n) * (2 * n + 1))) * sn; cs = 1.0 - r2 * (1.0 / (double)((2 * n - 1) * (2 * n))) * cs; }
                ROPE[e] = (float)cs; ROPE[SEQ * 32 + e] = (float)(r * sn); }
        }
        SEAM(P + 2);
        if (IN(P + 3)) { PHASE_PTRS();
#if !MK_NAIVE
            for (int w = blockIdx.x; w < 192; w += G) { const int kind = w >> 6, b = (w & 63) >> 3, h = w & 7;
                if (kind == 0) mixer_walk<0>(kp, layer, b, h, lds);
                else if (kind == 1) mixer_walk<1>(kp, layer, b, h, lds);
                else mixer_walk<2>(kp, layer, b, h, lds);
                __syncthreads(); }
#endif
        }
        SEAM(P + 3);
        if (IN(P + 4)) { PHASE_PTRS();
            for (int m = gw; m < MTOK; m += NGW) {
                GAS v4u* yp = (GAS v4u*)(ZB + (size_t)m * ZB_LD + 512) + lane; const v4u w = *yp;
                const f32x4 sq = *(const f32x4*)(SM + (size_t)m * SM_LD + 24 + 4 * (lane >> 5));
                const float rstd = rsqrtf(((sq[0] + sq[1]) + (sq[2] + sq[3])) * (1.0f / 256.0f) + 1e-6f);
                v4u o; o.x = pk2(pg8::bflo(w.x) * rstd, pg8::bfhi(w.x) * rstd); o.y = pk2(pg8::bflo(w.y) * rstd, pg8::bfhi(w.y) * rstd);
                o.z = pk2(pg8::bflo(w.z) * rstd, pg8::bfhi(w.z) * rstd); o.w = pk2(pg8::bflo(w.w) * rstd, pg8::bfhi(w.w) * rstd);
                *yp = o;
            }
            pg8::Gemm g{XBl, WGT, MTOK, NGATE, DM}; pg8::StaticOrder S; S.init(MTOK, NGATE, G, (int)blockIdx.x);
            pg8::EpiRS<0> E{GATE, NGATE, SSQC};
            pg8::gemm_phase<pg8::EpiRS<0>, pg8::StaticOrder, true, true>(lds, g, S, E);
        }
        SEAM(P + 4);
        if (IN(P + 5)) { PHASE_PTRS();
            pg8::Gemm g{ZB, WMT, MTOK, DM, KMERGE}; pg8::StaticOrder S; S.init(MTOK, DM, G, (int)blockIdx.x);
            pg8::EpiMerge E{GATE, XBf};
            pg8::gemm_phase<pg8::EpiMerge, pg8::StaticOrder, true, true>(lds, g, S, E);
        }
        SEAM(P + 5);
        if (IN(P + 6)) { PHASE_PTRS();
            const float* pl = kp->in[1] + (size_t)layer * MTOK * PLED;
            for (size_t e = (size_t)blockIdx.x * 512 + tid; e < (size_t)MTOK * PLED / 4; e += (size_t)G * 512) { const f32x4 v = ((const GAS f32x4*)pl)[e]; v2u w; w.x = pk2(v.x, v.y); w.y = pk2(v.z, v.w); ((GAS v2u*)PB)[e] = w; }
            pg8::Gemm g{XBf, WOT, MTOK, DM, DM}; pg8::StaticOrder S; S.init(MTOK, DM, G, (int)blockIdx.x);
            pg8::EpiResid<0> E{layer == 0 ? kp->in[0] : X, X, XBl, SSQA, nullptr, nullptr};
            pg8::gemm_phase<pg8::EpiResid<0>, pg8::StaticOrder, true, true>(lds, g, S, E);
        }
        SEAM(P + 6);
        if (IN(P + 7)) { PHASE_PTRS();
            { pg8::Gemm g{XBl, WUT, MTOK, DFF, DM}; pg8::StaticOrder S; S.init(MTOK, DFF, G, (int)blockIdx.x);
              pg8::EpiRS<1> E{U, DFF, SSQA};
              pg8::gemm_phase<pg8::EpiRS<1>, pg8::StaticOrder, true, true>(lds, g, S, E); }
            { pg8::Gemm g{PB, WPPT, MTOK, DM, PLED}; pg8::StaticOrder S; S.init(MTOK, DM, G, (int)blockIdx.x);
              pg8::EpiRS<0> E{PLE, DM, nullptr};
              pg8::gemm_phase<pg8::EpiRS<0>, pg8::StaticOrder, true, true>(lds, g, S, E); }
        }
        SEAM(P + 7);
        if (IN(P + 8)) { PHASE_PTRS();
            pg8::Gemm g{U, WDT, MTOK, DM, DFF}; pg8::StaticOrder S; S.init(MTOK, DM, G, (int)blockIdx.x);
            pg8::EpiResid<0> E{X, X, XBl, SSQB, nullptr, nullptr};
            pg8::gemm_phase<pg8::EpiResid<0>, pg8::StaticOrder, true, true>(lds, g, S, E);
        }
        SEAM(P + 8);
        if (IN(P + 9)) { PHASE_PTRS();
            pg8::Gemm g{XBl, WPGT, MTOK, DM, DM}; pg8::StaticOrder S; S.init(MTOK, DM, G, (int)blockIdx.x);
            pg8::EpiResid<1> E{X, X, XBf, SSQC, SSQB, PLE};
            pg8::gemm_phase<pg8::EpiResid<1>, pg8::StaticOrder, true, true>(lds, g, S, E);
        }
        SEAM(P + 9);
    }
    if (IN(PH_FINAL)) { const int layer = 0; PHASE_PTRS();
        const float* nf = kp->in[22];
        for (int m = gw; m < MTOK; m += NGW) {
            const float sp = lane < 16 ? SSQC[(size_t)m * 16 + lane] : 0.f;
            const float rstd = rsqrtf(wave_sum(sp) * (1.0f / 1024.0f) + 1e-6f);
            GAS f32x4* xr = (GAS f32x4*)(X + (size_t)m * DM) + lane;
#pragma unroll
            for (int j = 0; j < 4; ++j) { const f32x4 v = xr[64 * j], w = ((const GAS f32x4*)nf)[64 * j + lane]; xr[64 * j] = v * rstd * w; }
        }
    }
#undef IN
#undef SEAM
}

extern "C" void kernel_launch(void* const* d_in, const int* in_sizes, int n_in, void* d_out, int out_size, void* d_ws, size_t ws_size, hipStream_t stream) {
    static int grid = 0;
    if (grid == 0) {
        if (n_in != 23 || out_size != MTOK * DM || ws_size < WS_END) { fprintf(stderr, "kernel_launch: unexpected problem (n_in %d, out %d, ws %zu < %zu)\n", n_in, out_size, ws_size, (size_t)WS_END); grid = -1; return; }
        int dev = 0, cus = 0;
        if (hipGetDevice(&dev) != hipSuccess || hipDeviceGetAttribute(&cus, hipDeviceAttributeMultiprocessorCount, dev) != hipSuccess) { grid = -1; return; }
        if (hipFuncSetAttribute((const void*)fwd_kernel, hipFuncAttributeMaxDynamicSharedMemorySize, LDS_BYTES) != hipSuccess) { fprintf(stderr, "kernel_launch: hipFuncSetAttribute failed\n"); grid = -1; return; }
        int per_cu = 0;
        if (hipOccupancyMaxActiveBlocksPerMultiprocessor(&per_cu, (const void*)fwd_kernel, 512, LDS_BYTES) != hipSuccess || per_cu < 1) { fprintf(stderr, "kernel_launch: occupancy query says %d blocks per CU\n", per_cu); }
        (void)hipGetLastError();
        grid = cus;
    }
    if (grid < 0) return;
    (void)hipMemsetAsync((char*)d_ws + WS_CTL, 0, CTL_BYTES, stream);
    Args a; memset(&a, 0, sizeof(a));
    for (int i = 0; i < 23; ++i) a.in[i] = (const float*)d_in[i];
    a.out = (float*)d_out; a.ws = (unsigned char*)d_ws;
#if MK_ONE_LAUNCH
    a.ph_lo = 0; a.ph_hi = N_PHASES;
    hipLaunchKernelGGL(fwd_kernel, dim3(grid), dim3(512), LDS_BYTES, stream, a);
#else
    for (int p = 0; p < N_PHASES; ++p) {
#if MK_NAIVE
        if (p != PH_FINAL && (p % NPH) == 3) { hipLaunchKernelGGL(mixers_naive, dim3(192), dim3(64), 0, stream, a, p / NPH); continue; }
#endif
        a.ph_lo = p; a.ph_hi = p + 1;
        hipLaunchKernelGGL(fwd_kernel, dim3(grid), dim3(512), LDS_BYTES, stream, a);
    }
#endif
}
```

```cpp
#include <hip/hip_runtime.h>
#include <cstdio>
#include <cstdint>
#include <cstring>
namespace pg8 {
#define PG8_LAS __attribute__((address_space(3)))
typedef unsigned short bf16_t;
typedef short bf16x8 __attribute__((ext_vector_type(8)));
typedef float f32x4 __attribute__((ext_vector_type(4)));
typedef unsigned u32x4 __attribute__((ext_vector_type(4)));
constexpr int BM = 256, BK = 64, HALF = 128, HTB = HALF * BK * 2  , STAGE_BYTES = 8 * HTB, NXCD = 8, WGM = 8;

__host__ __device__ __forceinline__ int lds_byte(int r, int c) { const int st = (r >> 4) * 2 + (c >> 5), rr = r & 15, cc = c & 31, ob = rr * 64 + cc * 2; return st * 1024 + (ob ^ (((ob >> 9) & 1) << 5)); }
__host__ __device__ __forceinline__ void stage_rc(int b, int& R, int& C) { const int st = b / 1024, sb = b % 1024, swz = sb ^ (((sb >> 9) & 1) << 5); R = (st >> 1) * 16 + swz / 64; C = (st & 1) * 32 + (swz % 64) / 2; }
__host__ __device__ __forceinline__ int perm32(int rho) { const int n = rho >> 4, i = rho & 15; return 8 * (i >> 2) + 4 * n + (i & 3); }

struct Unit { int pm, pn; };
struct Gemm { const bf16_t* A; const bf16_t* Bt; int M, N, K; };

struct StaticOrder {
    int nM, nN, nwg, G, c;
    __host__ __device__ void init(int M, int N, int G_, int c_) { nM = M / BM; nN = N / BM; nwg = nM * nN; G = G_; c = c_; }
    __host__ __device__ bool next(int i, Unit& u) const {
        const long L = (long)i * G + c; if (L >= nwg) return false;
        int wgid = (int)L; { const int q = nwg / NXCD, r = nwg % NXCD, xcd = wgid % NXCD, off = wgid / NXCD; wgid = (xcd < r ? xcd * (q + 1) : r * (q + 1) + (xcd - r) * q) + off; }
        const int nig = WGM * nN, gid = wgid / nig, fm = gid * WGM, gsz = (nM - fm) < WGM ? (nM - fm) : WGM;
        u.pm = fm + ((wgid % nig) % gsz); u.pn = (wgid % nig) / gsz; return true;
    }
    __device__ __forceinline__ void a_ready(const Unit&) const {}
    __device__ __forceinline__ void done(const Unit&) const {}
};

typedef float f32x2c __attribute__((ext_vector_type(2))); typedef __bf16 bf16x2c __attribute__((ext_vector_type(2)));
__device__ __forceinline__ unsigned cvt_pk_bf16(float lo, float hi) { const f32x2c v = {lo, hi}; const bf16x2c b = __builtin_convertvector(v, bf16x2c); return __builtin_bit_cast(unsigned, b); }
typedef unsigned u32x2 __attribute__((ext_vector_type(2)));
__device__ __forceinline__ float bflo(unsigned w) { return __uint_as_float(w << 16); }
__device__ __forceinline__ float bfhi(unsigned w) { return __uint_as_float(w & 0xffff0000u); }
__device__ __forceinline__ u32x4 pack8(const f32x4 v0, const f32x4 v1) { u32x4 w; w.x = cvt_pk_bf16(v0[0], v0[1]); w.y = cvt_pk_bf16(v0[2], v0[3]); w.z = cvt_pk_bf16(v1[0], v1[1]); w.w = cvt_pk_bf16(v1[2], v1[3]); return w; }
__device__ __forceinline__ void unpack8(const u32x4 w, f32x4& v0, f32x4& v1) { v0 = (f32x4){bflo(w.x), bfhi(w.x), bflo(w.y), bfhi(w.y)}; v1 = (f32x4){bflo(w.z), bfhi(w.z), bflo(w.w), bfhi(w.w)}; }
constexpr float RMS_EPS = 1e-6f;
__device__ __forceinline__ void load_rstd(const float* ssqp, int row0, int fq, float (&rs)[2][4]) {
#pragma unroll
    for (int ai = 0; ai < 2; ++ai)
#pragma unroll
        for (int m = 0; m < 4; ++m) {
            if (ssqp) { const f32x4 p = *(const f32x4*)(ssqp + (size_t)(row0 + ai * HALF + m * 16) * 16 + 4 * fq); float s = (p[0] + p[1]) + (p[2] + p[3]);
                s += __shfl_xor(s, 16); s += __shfl_xor(s, 32); rs[ai][m] = rsqrtf(s * (1.0f / 1024.0f) + RMS_EPS); }
            else rs[ai][m] = 1.0f;
        }
}
struct EpiP1 {
    static constexpr bool PERM = true, AFTER_DRAIN = false, HOOK = false; static constexpr int SEG1 = -1, SEG2 = -1;
    bf16_t* ZB; bf16_t* MIX; float* SM; const float* ssqp; bf16_t* HALO;
    __device__ __forceinline__ void rescale(f32x4 (&)[2][2][4][2], const Unit&, int, int, int, int, int) const {}
    __device__ __forceinline__ void operator()(const f32x4 (&acc)[2][2][4][2], const Unit& u, int wr, int wc, int fr, int fq) const {
        const int row0 = u.pm * BM + wr * 64 + fr;
        float rs[2][4]; load_rstd(ssqp, row0, fq, rs);
        if (u.pn == 21) {
            if (wc == 0) {
#pragma unroll
                for (int ai = 0; ai < 2; ++ai)
#pragma unroll
                    for (int m = 0; m < 4; ++m) { float* p = SM + (size_t)(row0 + ai * HALF + m * 16) * 32 + 8 * fq;
                        *(f32x4*)p = acc[ai][0][m][0] * rs[ai][m]; *(f32x4*)(p + 4) = acc[ai][0][m][1] * rs[ai][m]; }
            }
            return;
        }
        bf16_t* base; int ldc, colt;
        if (u.pn < 6) { base = ZB; ldc = 1536; colt = u.pn * BM; } else { base = MIX; ldc = 3840; colt = (u.pn - 6) * BM; }
        const int col0 = colt + wc * 32 + 8 * fq;
#pragma unroll
        for (int ai = 0; ai < 2; ++ai)
#pragma unroll
            for (int m = 0; m < 4; ++m) { bf16_t* rowp = base + (size_t)(row0 + ai * HALF + m * 16) * ldc + col0;
#pragma unroll
                for (int bj = 0; bj < 2; ++bj) { const u32x4 w = pack8(acc[ai][bj][m][0] * rs[ai][m], acc[ai][bj][m][1] * rs[ai][m]); *(u32x4*)(rowp + bj * HALF) = w;
                    if (m == 3 && fr >= 13 && u.pn >= 6 && u.pn < 15) *(u32x4*)(HALO + ((size_t)((row0 + ai * HALF + m * 16) >> 6) * 3 + (fr - 13)) * 2304 + col0 + bj * HALF) = w; } }
    }
};
template <int ACT> struct EpiRS {
    static constexpr bool PERM = true, AFTER_DRAIN = false, HOOK = false; static constexpr int SEG1 = -1, SEG2 = -1;
    bf16_t* O; int ldc; const float* ssqp;
    __device__ __forceinline__ void rescale(f32x4 (&)[2][2][4][2], const Unit&, int, int, int, int, int) const {}
    __device__ __forceinline__ void operator()(const f32x4 (&acc)[2][2][4][2], const Unit& u, int wr, int wc, int fr, int fq) const {
        const int row0 = u.pm * BM + wr * 64 + fr, col0 = u.pn * BM + wc * 32 + 8 * fq;
        float rs[2][4]; load_rstd(ssqp, row0, fq, rs);
#pragma unroll
        for (int ai = 0; ai < 2; ++ai)
#pragma unroll
            for (int m = 0; m < 4; ++m) { bf16_t* rowp = O + (size_t)(row0 + ai * HALF + m * 16) * ldc + col0;
#pragma unroll
                for (int bj = 0; bj < 2; ++bj) { f32x4 v0 = acc[ai][bj][m][0] * rs[ai][m], v1 = acc[ai][bj][m][1] * rs[ai][m];
                    if (ACT == 1) {
#pragma unroll
                        for (int j = 0; j < 4; ++j) { const float a = fmaxf(v0[j], 0.f), b = fmaxf(v1[j], 0.f); v0[j] = a * a; v1[j] = b * b; } }
                    if (ACT == 2) {
#pragma unroll
                        for (int j = 0; j < 4; ++j) { v0[j] = __builtin_amdgcn_rcpf(1.0f + __expf(-v0[j])); v1[j] = __builtin_amdgcn_rcpf(1.0f + __expf(-v1[j])); } }
                    *(u32x4*)(rowp + bj * HALF) = pack8(v0, v1); } }
    }
};
struct EpiMerge {
    static constexpr bool PERM = true, AFTER_DRAIN = false, HOOK = true; static constexpr int SEG1 = 8, SEG2 = 16;
    const bf16_t* GATE; bf16_t* O;
    __device__ __forceinline__ void rescale(f32x4 (&acc)[2][2][4][2], const Unit& u, int seg, int wr, int wc, int, int) const {
        int t_ = threadIdx.x; asm volatile("" : "+v"(t_)); const int fr = t_ & 15, fq = (t_ & 63) >> 4;
        const int row0 = u.pm * BM + wr * 64 + fr, col0 = u.pn * BM + wc * 32 + 8 * fq + (seg - 1) * 1024;
#pragma unroll
        for (int ai = 0; ai < 2; ++ai)
#pragma unroll
            for (int m = 0; m < 4; ++m) { const bf16_t* gp = GATE + (size_t)(row0 + ai * HALF + m * 16) * 3072 + col0;
#pragma unroll
                for (int bj = 0; bj < 2; ++bj) { const u32x4 wa = *(const u32x4*)(gp + bj * HALF), wb = *(const u32x4*)(gp + bj * HALF + 1024);
                    f32x4 a0, a1, b0, b1; unpack8(wa, a0, a1); unpack8(wb, b0, b1);
#pragma unroll
                    for (int j = 0; j < 4; ++j) {
                        acc[ai][bj][m][0][j] *= a0[j] * __builtin_amdgcn_rcpf(b0[j]);
                        acc[ai][bj][m][1][j] *= a1[j] * __builtin_amdgcn_rcpf(b1[j]); } }
                asm volatile("" ::: "memory"); }
    }
    __device__ __forceinline__ void operator()(const f32x4 (&acc)[2][2][4][2], const Unit& u, int wr, int wc, int fr, int fq) const {
        const int row0 = u.pm * BM + wr * 64 + fr, col0 = u.pn * BM + wc * 32 + 8 * fq;
#pragma unroll
        for (int ai = 0; ai < 2; ++ai)
#pragma unroll
            for (int m = 0; m < 4; ++m) { const size_t r = (size_t)(row0 + ai * HALF + m * 16);
#pragma unroll
                for (int bj = 0; bj < 2; ++bj) { const u32x4 wa = *(const u32x4*)(GATE + r * 3072 + 2048 + col0 + bj * HALF);
                    f32x4 a0, a1; unpack8(wa, a0, a1); f32x4 v0 = acc[ai][bj][m][0], v1 = acc[ai][bj][m][1];
#pragma unroll
                    for (int j = 0; j < 4; ++j) { v0[j] *= a0[j]; v1[j] *= a1[j]; }
                    *(u32x4*)(O + r * 1024 + col0 + bj * HALF) = pack8(v0, v1); }
                asm volatile("" ::: "memory"); }
    }
};
template <int MODE> struct EpiResid {
    static constexpr bool PERM = true, AFTER_DRAIN = false, HOOK = false; static constexpr int SEG1 = -1, SEG2 = -1;
    const float* base; float* X; bf16_t* XB; float* ssq_out; const float* ssq_in; const bf16_t* PLE; float scale;
    __device__ __forceinline__ void rescale(f32x4 (&)[2][2][4][2], const Unit&, int, int, int, int, int) const {}
    __device__ __forceinline__ void operator()(const f32x4 (&acc)[2][2][4][2], const Unit& u, int wr, int wc, int fr, int fq) const {
        const int row0 = u.pm * BM + wr * 64 + fr, col0 = u.pn * BM + wc * 32 + 8 * fq;
        float rs[2][4]; if (MODE == 1) load_rstd(ssq_in, row0, fq, rs);
#pragma unroll
        for (int ai = 0; ai < 2; ++ai)
#pragma unroll
            for (int m = 0; m < 4; ++m) { const size_t r = (size_t)(row0 + ai * HALF + m * 16); float ss = 0.f;
#pragma unroll
                for (int bj = 0; bj < 2; ++bj) { const size_t o = r * 1024 + col0 + bj * HALF;
                    f32x4 v0 = acc[ai][bj][m][0], v1 = acc[ai][bj][m][1];
                    if (MODE == 1) { const u32x4 wp = *(const u32x4*)(PLE + o); f32x4 p0, p1; unpack8(wp, p0, p1);
#pragma unroll
                        for (int j = 0; j < 4; ++j) { v0[j] = p0[j] * __builtin_amdgcn_rcpf(1.0f + __expf(-v0[j] * rs[ai][m])); v1[j] = p1[j] * __builtin_amdgcn_rcpf(1.0f + __expf(-v1[j] * rs[ai][m])); } }
                    v0 = v0 * scale + *(const f32x4*)(base + o); v1 = v1 * scale + *(const f32x4*)(base + o + 4);
                    *(f32x4*)(X + o) = v0; *(f32x4*)(X + o + 4) = v1; *(u32x4*)(XB + o) = pack8(v0, v1);
                    ss += (v0[0] * v0[0] + v0[1] * v0[1]) + (v0[2] * v0[2] + v0[3] * v0[3]) + (v1[0] * v1[0] + v1[1] * v1[1]) + (v1[2] * v1[2] + v1[3] * v1[3]); }
                ss += __shfl_xor(ss, 16); ss += __shfl_xor(ss, 32);
                if (fq == 0) ssq_out[r * 16 + u.pn * 4 + wc] = ss;
                asm volatile("" ::: "memory"); }
    }
};
template <class Epi, class Sched, bool ALIGN_EPI = false, bool SP2 = false>
__device__ __forceinline__ void gemm_phase(PG8_LAS unsigned char* lds, Gemm g, const Sched& S, const Epi& E) {
    asm volatile("" : "+s"(g.A), "+s"(g.Bt), "+s"(g.K));
    int tid_ = threadIdx.x; asm volatile("" : "+v"(tid_));
    const int tid = tid_, wid = __builtin_amdgcn_readfirstlane(tid >> 6), lane = tid & 63, wr = wid >> 2, wc = wid & 3, fr = lane & 15, fq = lane >> 4;
    const int K = g.K, nt = K / BK;
    unsigned voffA[2], voffB[2];
#pragma unroll
    for (int i = 0; i < 2; ++i) { int R, C; stage_rc(tid * 16 + i * 8192, R, C); const int Rb = Epi::PERM ? ((R & ~31) + perm32(R & 31)) : R;
        voffA[i] = (unsigned)(R * K + C) * 2u; voffB[i] = (unsigned)(Rb * K + C) * 2u; }
    const size_t kstep = (size_t)(BK * 2);
    const size_t hstep = (size_t)HALF * K * 2;
    const size_t tstep = 2 * hstep;
    const unsigned ldsw = (unsigned)wid * 1024u;
    const int aoff = lds_byte(wr * 64 + fr, fq * 8), boff = lds_byte(wc * 32 + fr, fq * 8);
#define PG8_SA(b, h) (((b) * 2 + (h)) * HTB)
#define PG8_SB(b, h) ((4 + (b) * 2 + (h)) * HTB)
#define PG8_STAGE(bufoff, gbase, voff) do { _Pragma("unroll") for (int _i = 0; _i < 2; ++_i) \
        __builtin_amdgcn_global_load_lds((const unsigned*)((const char*)(gbase) + (voff)[_i]), (PG8_LAS unsigned*)(lds + (bufoff) + ldsw + _i * 8192), 16, 0, 0); } while (0)
#define PG8_LDA(dst, b, h) do { _Pragma("unroll") for (int m = 0; m < 4; ++m) _Pragma("unroll") for (int k = 0; k < 2; ++k) dst[m][k] = *(const PG8_LAS bf16x8*)(lds + PG8_SA(b, h) + aoff + m * 2048 + k * 1024); } while (0)
#define PG8_LDB(dst, b, h) do { _Pragma("unroll") for (int n = 0; n < 2; ++n) _Pragma("unroll") for (int k = 0; k < 2; ++k) dst[n][k] = *(const PG8_LAS bf16x8*)(lds + PG8_SB(b, h) + boff + n * 2048 + k * 1024); } while (0)
#define PG8_MMA(ai, bj, At, Bt) do { __builtin_amdgcn_s_setprio(1); _Pragma("unroll") for (int m = 0; m < 4; ++m) _Pragma("unroll") for (int n = 0; n < 2; ++n) _Pragma("unroll") for (int k = 0; k < 2; ++k) \
        acc[ai][bj][m][n] = __builtin_amdgcn_mfma_f32_16x16x32_bf16(Bt[n][k], At[m][k], acc[ai][bj][m][n], 0, 0, 0); __builtin_amdgcn_s_setprio(0); } while (0)
#define PG8_WAIT_V(n) asm volatile("s_waitcnt vmcnt(" #n ")" ::: "memory")
#define PG8_WAIT_L(n) asm volatile("s_waitcnt lgkmcnt(" #n ")" ::: "memory")
#define PG8_BAR __builtin_amdgcn_s_barrier()
#define PG8_SCHED __builtin_amdgcn_sched_barrier(0)
    Unit cur, nxt; int ui = 0;
    if (!S.next(0, cur)) return;
    f32x4 acc[2][2][4][2];
#pragma unroll
    for (int a = 0; a < 2; ++a)
#pragma unroll
        for (int b = 0; b < 2; ++b)
#pragma unroll
            for (int m = 0; m < 4; ++m)
#pragma unroll
                for (int n = 0; n < 2; ++n) acc[a][b][m][n] = (f32x4){0.f, 0.f, 0.f, 0.f};
    bf16x8 At[4][2], B0[2][2], B1[2][2];
    const char* cA = (const char*)g.A + (size_t)cur.pm * tstep; const char* cB = (const char*)g.Bt + (size_t)cur.pn * tstep;
    S.a_ready(cur);
    if constexpr (SP2) {
        PG8_STAGE(PG8_SB(0, 0), cB, voffB); PG8_STAGE(PG8_SB(0, 1), cB + hstep, voffB); PG8_STAGE(PG8_SA(0, 0), cA, voffA); PG8_STAGE(PG8_SA(0, 1), cA + hstep, voffA);
        if (wr == 1) PG8_BAR;
        PG8_WAIT_V(2); PG8_BAR;
        PG8_STAGE(PG8_SB(1, 0), cB + kstep, voffB); PG8_STAGE(PG8_SA(1, 0), cA + kstep, voffA); PG8_STAGE(PG8_SB(1, 1), cB + hstep + kstep, voffB);
        PG8_WAIT_V(6); PG8_BAR;
    } else {
        PG8_STAGE(PG8_SB(0, 0), cB, voffB); PG8_STAGE(PG8_SA(0, 0), cA, voffA); PG8_STAGE(PG8_SB(0, 1), cB + hstep, voffB); PG8_STAGE(PG8_SA(0, 1), cA + hstep, voffA);
        if (wr == 1) PG8_BAR;
        PG8_WAIT_V(4); PG8_BAR;
        PG8_STAGE(PG8_SB(1, 0), cB + kstep, voffB); PG8_STAGE(PG8_SA(1, 0), cA + kstep, voffA); PG8_STAGE(PG8_SB(1, 1), cB + hstep + kstep, voffB);
        PG8_WAIT_V(6); PG8_BAR;
    }
    for (;;) {
        const bool has_next = S.next(ui + 1, nxt);
        const char* nA = has_next ? (const char*)g.A + (size_t)nxt.pm * tstep : cA; const char* nB = has_next ? (const char*)g.Bt + (size_t)nxt.pn * tstep : cB;
        for (int t = 0; t < nt; t += 2) {
            const bool last = (t == nt - 2);
            const char* a1 = cA + (size_t)(t + 1) * kstep;
            const char* a2 = last ? nA : cA + (size_t)(t + 2) * kstep; const char* b2 = last ? nB : cB + (size_t)(t + 2) * kstep;
            const char* a3 = a2 + kstep; const char* b3 = b2 + kstep;
            if (last && has_next) S.a_ready(nxt);
            if constexpr (Epi::HOOK) { if (t == Epi::SEG1 || t == Epi::SEG2) E.rescale(acc, cur, t == Epi::SEG1 ? 1 : 2, wr, wc, fr, fq); }
            if constexpr (SP2) {
            PG8_LDB(B0, 0, 0); PG8_LDB(B1, 0, 1); PG8_SCHED; PG8_LDA(At, 0, 0); PG8_STAGE(PG8_SA(1, 1), a1 + hstep, voffA);
            PG8_WAIT_V(8); PG8_WAIT_L(0); PG8_BAR; PG8_MMA(0, 0, At, B0); PG8_MMA(0, 1, At, B1); PG8_BAR; PG8_SCHED;
            PG8_LDA(At, 0, 1); PG8_STAGE(PG8_SB(0, 0), b2, voffB); PG8_STAGE(PG8_SB(0, 1), b2 + hstep, voffB); PG8_STAGE(PG8_SA(0, 0), a2, voffA);
            PG8_WAIT_V(8); PG8_WAIT_L(0); PG8_BAR; PG8_MMA(1, 0, At, B0); PG8_MMA(1, 1, At, B1); PG8_BAR; PG8_SCHED;
            PG8_LDB(B0, 1, 0); PG8_LDB(B1, 1, 1); PG8_SCHED; PG8_LDA(At, 1, 0); PG8_STAGE(PG8_SA(0, 1), a2 + hstep, voffA);
            PG8_WAIT_V(8); PG8_WAIT_L(0); PG8_BAR; PG8_MMA(0, 0, At, B0); PG8_MMA(0, 1, At, B1); PG8_BAR; PG8_SCHED;
            PG8_LDA(At, 1, 1); PG8_STAGE(PG8_SB(1, 0), b3, voffB); PG8_STAGE(PG8_SB(1, 1), b3 + hstep, voffB); PG8_STAGE(PG8_SA(1, 0), a3, voffA);
            PG8_WAIT_V(8); PG8_WAIT_L(0); PG8_BAR; PG8_MMA(1, 0, At, B0); PG8_MMA(1, 1, At, B1); PG8_BAR; PG8_SCHED;
            } else {
            PG8_LDB(B0, 0, 0); PG8_SCHED; PG8_LDA(At, 0, 0); PG8_STAGE(PG8_SA(1, 1), a1 + hstep, voffA);
            PG8_WAIT_L(8); PG8_BAR; PG8_WAIT_L(0); PG8_MMA(0, 0, At, B0); PG8_BAR; PG8_SCHED;
            PG8_LDB(B1, 0, 1); PG8_STAGE(PG8_SB(0, 0), b2, voffB);
            PG8_BAR; PG8_WAIT_L(0); PG8_MMA(0, 1, At, B1); PG8_BAR;
            PG8_LDA(At, 0, 1); PG8_STAGE(PG8_SA(0, 0), a2, voffA);
            PG8_BAR; PG8_WAIT_L(0); PG8_MMA(1, 0, At, B0); PG8_BAR; PG8_SCHED;
            PG8_STAGE(PG8_SB(0, 1), b2 + hstep, voffB);
            PG8_WAIT_V(6); PG8_BAR; PG8_MMA(1, 1, At, B1); PG8_BAR;
            PG8_LDB(B0, 1, 0); PG8_SCHED; PG8_LDA(At, 1, 0); PG8_STAGE(PG8_SA(0, 1), a2 + hstep, voffA);
            PG8_WAIT_L(8); PG8_BAR; PG8_WAIT_L(0); PG8_MMA(0, 0, At, B0); PG8_BAR; PG8_SCHED;
            PG8_LDB(B1, 1, 1); PG8_STAGE(PG8_SB(1, 0), b3, voffB);
            PG8_BAR; PG8_WAIT_L(0); PG8_MMA(0, 1, At, B1); PG8_BAR;
            PG8_LDA(At, 1, 1); PG8_STAGE(PG8_SA(1, 0), a3, voffA);
            PG8_BAR; PG8_WAIT_L(0); PG8_MMA(1, 0, At, B0); PG8_BAR; PG8_SCHED;
            PG8_STAGE(PG8_SB(1, 1), b3 + hstep, voffB);
            PG8_WAIT_V(6); PG8_BAR; PG8_MMA(1, 1, At, B1); PG8_BAR;
            }
        }
        if constexpr (ALIGN_EPI) { if (wr == 0) PG8_BAR; }
        if constexpr (!Epi::AFTER_DRAIN) { int t2_ = threadIdx.x; asm volatile("" : "+v"(t2_)); E(acc, cur, wr, wc, t2_ & 15, (t2_ & 63) >> 4); S.done(cur); }
        if (!has_next) break;
#pragma unroll
        for (int a = 0; a < 2; ++a)
#pragma unroll
            for (int b = 0; b < 2; ++b)
#pragma unroll
                for (int m = 0; m < 4; ++m)
#pragma unroll
                    for (int n = 0; n < 2; ++n) acc[a][b][m][n] = (f32x4){0.f, 0.f, 0.f, 0.f};
        cur = nxt; cA = nA; cB = nB; ++ui;
        if constexpr (ALIGN_EPI) { if (wr == 1) PG8_BAR; }
    }
    PG8_WAIT_V(0);
    if constexpr (!ALIGN_EPI) { if (wr == 0) PG8_BAR; }
    PG8_BAR;
    if constexpr (Epi::AFTER_DRAIN) { E.fused(acc, cur, wr, wc, fr, fq, lds, wid, lane); S.done(cur); }
#undef PG8_SA
#undef PG8_SB
#undef PG8_STAGE
#undef PG8_LDA
#undef PG8_LDB
#undef PG8_MMA
#undef PG8_WAIT_V
#undef PG8_WAIT_L
#undef PG8_BAR
#undef PG8_SCHED
}
}
constexpr int DM = 1024, NBATCH = 8, SEQ = 4096, MTOK = NBATCH * SEQ, DEPTH = 2, DFF = 4096, PLED = 256, NIN = 8472;
constexpr int ZB_LD = 1536, MIX_LD = 3840, SM_LD = 32, N1 = 5632, NGATE = 3072, KMERGE = 1536;
constexpr int MX_AQ = 0, MX_AK = 512, MX_AV = 1024, MX_BX = 1536, MX_BB = 2048, MX_BC = 2176, MX_CQ = 2304, MX_CK = 2816, MX_CV = 3328;
constexpr size_t KiB = 1024, MiB = 1024 * 1024;
constexpr size_t WS_CTL = 0, CTL_BYTES = 64 * KiB;
constexpr size_t WS_W = 64 * KiB;
constexpr size_t W_1T = WS_W, W_GT = W_1T + (size_t)N1 * DM * 2, W_MT = W_GT + (size_t)NGATE * DM * 2, W_OT = W_MT + (size_t)DM * KMERGE * 2, W_UT = W_OT + (size_t)DM * DM * 2,
                 W_DT = W_UT + (size_t)DFF * DM * 2, W_PGT = W_DT + (size_t)DM * DFF * 2, W_PPT = W_PGT + (size_t)DM * DM * 2, W_END = W_PPT + (size_t)DM * PLED * 2;
constexpr size_t WS_SSQA = W_1T + 1 * MiB, WS_SSQB = W_1T + 3 * MiB;
constexpr size_t WS_XB0 = W_END, WS_XB1 = WS_XB0 + 64 * MiB, WS_ZB = WS_XB1 + 64 * MiB, WS_MIX = WS_ZB + 96 * MiB, WS_SM = WS_MIX + 240 * MiB, WS_SSQC = WS_SM + 4 * MiB, WS_ROPE = WS_SSQC + 2 * MiB, WS_END = WS_ROPE + 1 * MiB;
constexpr size_t WS_PB = WS_ZB, WS_PLE = WS_ZB + 16 * MiB, WS_U = WS_ZB + 80 * MiB, WS_GATE = WS_MIX;
static_assert(W_END == WS_W + (size_t)(40 * MiB + 512 * KiB), "weights");
static_assert(WS_U + (size_t)MTOK * DFF * 2 == WS_SM, "U overlay");
static_assert(WS_END <= 512 * MiB, "workspace");
constexpr int LDS_BYTES = 147456, RING_BYTES = 131072, MISC_OFF = RING_BYTES + 320;

#define GAS __attribute__((address_space(1)))
#define LAS __attribute__((address_space(3)))
typedef unsigned short bf16;
typedef unsigned v4u __attribute__((ext_vector_type(4)));
typedef unsigned v2u __attribute__((ext_vector_type(2)));
typedef float f32x4 __attribute__((ext_vector_type(4)));
#define LDS_WAIT() asm volatile("s_waitcnt lgkmcnt(0)" ::: "memory")
typedef float f32x2_t __attribute__((ext_vector_type(2))); typedef __bf16 bf16x2_t __attribute__((ext_vector_type(2)));
__device__ __forceinline__ unsigned pk2(float lo, float hi) { f32x2_t v = {lo, hi}; bf16x2_t b = __builtin_convertvector(v, bf16x2_t); return __builtin_bit_cast(unsigned, b); }
__device__ __forceinline__ unsigned f2bf(float f) { return pk2(f, 0.f) & 0xffffu; }
__device__ __forceinline__ float bf2f(bf16 v) { return __uint_as_float((unsigned)v << 16); }
__device__ __forceinline__ float wave_sum(float v) {
#pragma unroll
    for (int o = 1; o < 64; o <<= 1) v += __shfl_xor(v, o);
    return v;
}
__device__ __forceinline__ float siluf(float x) { return x / (1.0f + __expf(-x)); }
__device__ __forceinline__ float sigmf(float x) { return 1.0f / (1.0f + __expf(-x)); }
__device__ __forceinline__ float softplusf(float x) { return fmaxf(x, 0.f) + log1pf(__expf(-fabsf(x))); }
__device__ __forceinline__ float rdl(float v, int l) { return __int_as_float(__builtin_amdgcn_readlane(__float_as_int(v), l)); }

#define XB_TMO      128
#define XB_XCNT(j)  (256  + 64 * (j))
#define XB_XSUB(j)  (1280 + 64 * (j))
#define XB_XGEN(j)  (2304 + 64 * (j))
#define XB_TOP      3328
#define XB_TOPGEN   3392
#define XCD_BAR_WORDS 3456
#define XB_SPIN_CAP (1u << 18)
__device__ __forceinline__ unsigned xb_ld(unsigned* p)              { return __hip_atomic_load(p, __ATOMIC_RELAXED, __HIP_MEMORY_SCOPE_AGENT); }
__device__ __forceinline__ unsigned xb_add(unsigned* p, unsigned v) { return __hip_atomic_fetch_add(p, v, __ATOMIC_RELAXED, __HIP_MEMORY_SCOPE_AGENT); }
__device__ __forceinline__ unsigned xb_xcc_id() { return (unsigned)__builtin_amdgcn_s_getreg((3 << 11) | 20) & 0xFu; }
#define XB_SPIN(cond, bar) do { unsigned _sp = 0; while (cond) { __builtin_amdgcn_s_sleep(1); \
    if ((++_sp & 255u) == 0u) { if (xb_ld(&(bar)[XB_TMO])) break; if (_sp > XB_SPIN_CAP) { atomicAdd(&(bar)[XB_TMO], 1u); break; } } } } while (0)
struct XcdBarrier { unsigned* bar; unsigned x; volatile LAS unsigned* st; };
__device__ __forceinline__ XcdBarrier xcd_barrier_post(unsigned* bar, volatile LAS unsigned* st) {
    XcdBarrier b; b.bar = bar; b.x = xb_xcc_id(); b.st = st;
    if (threadIdx.x == 0) (void)xb_add(&bar[XB_XCNT(b.x)], 1u);
    return b;
}
__device__ __forceinline__ void xcd_barrier_complete(unsigned* bar, unsigned x, unsigned& nloc, unsigned& nx) {
    const unsigned G = gridDim.x * gridDim.y * gridDim.z;
    unsigned sum, cnt, mine, sp = 0u;
    for (;;) {
        sum = 0u; cnt = 0u; mine = 0u;
#pragma unroll
        for (unsigned j = 0; j < 16; ++j) { const unsigned c = xb_ld(&bar[XB_XCNT(j)]); sum += c; cnt += (c > 0u) ? 1u : 0u; mine = (j == x) ? c : mine; }
        if (sum == G) break;
        __builtin_amdgcn_s_sleep(1);
        if ((++sp & 255u) == 0u) { if (xb_ld(&bar[XB_TMO])) break; if (sp > XB_SPIN_CAP) { atomicAdd(&bar[XB_TMO], 1u); break; } }
    }
    nloc = mine > 0u ? mine : 1u; nx = cnt > 0u ? cnt : 1u;
}
__device__ __forceinline__ void xcd_barrier(const XcdBarrier& b) {
    asm volatile("s_waitcnt vmcnt(0)" ::: "memory");
    __syncthreads();
    if (threadIdx.x == 0) {
        unsigned* bar = b.bar;
        __builtin_amdgcn_s_waitcnt(0);
        unsigned nloc = b.st[0], nx = b.st[1];
        if (nloc == 0u) { xcd_barrier_complete(bar, b.x, nloc, nx); b.st[0] = nloc; b.st[1] = nx; }
        const unsigned old = xb_add(&bar[XB_XSUB(b.x)], 1u);
        const unsigned gen = old / nloc;
        if (old + 1u == (gen + 1u) * nloc) {
            __builtin_amdgcn_fence(__ATOMIC_RELEASE, "agent");
            asm volatile("s_waitcnt vmcnt(0)" ::: "memory");
            const unsigned og = xb_add(&bar[XB_TOP], 1u);
            const unsigned tg = og / nx;
            if (og + 1u == (tg + 1u) * nx) xb_add(&bar[XB_TOPGEN], 1u);
            else XB_SPIN(xb_ld(&bar[XB_TOPGEN]) == tg, bar);
            __builtin_amdgcn_fence(__ATOMIC_ACQUIRE, "agent");
            xb_add(&bar[XB_XGEN(b.x)], 1u);
            asm volatile("s_waitcnt vmcnt(0)" ::: "memory");
        } else {
            XB_SPIN(xb_ld(&bar[XB_XGEN(b.x)]) == gen, bar);
            __builtin_amdgcn_fence(__ATOMIC_ACQUIRE, "agent");
            asm volatile("s_waitcnt vmcnt(0)" ::: "memory");
        }
    }
    __syncthreads();
}

__device__ __forceinline__ void tr_item(const float* W, int ldw, int c0, int ncols, const float* scale, bf16* dst, int ldd, int r0, int kofs, LAS unsigned char* lds, int item, int tid) {
    const int lane = tid & 63, wave = __builtin_amdgcn_readfirstlane(tid >> 6);
    const int nblk = (ncols + 255) / 256, kb = item / nblk, nb = item - kb * nblk, k0 = 64 * kb, n0 = 256 * nb;
    asm volatile("s_waitcnt lgkmcnt(0)\n\ts_barrier" ::: "memory");
#pragma unroll
    for (int jj = 0; jj < 4; ++jj) { const int n = n0 + lane + 64 * jj; const bool ok = W != nullptr && n < ncols; float v[8];
        const float* wp = W + (size_t)(k0 + 8 * wave) * ldw + c0 + n;
#pragma unroll
        for (int kk = 0; kk < 8; ++kk) { v[kk] = 0.f; if (ok) { v[kk] = wp[(size_t)kk * ldw]; if (scale) v[kk] *= scale[k0 + 8 * wave + kk]; } }
        v4u o; o.x = pk2(v[0], v[1]); o.y = pk2(v[2], v[3]); o.z = pk2(v[4], v[5]); o.w = pk2(v[6], v[7]);
        *(LAS v4u*)(lds + (lane + 64 * jj) * 144 + wave * 16) = o; }
    asm volatile("s_waitcnt lgkmcnt(0)\n\ts_barrier" ::: "memory");
#pragma unroll
    for (int i = 0; i < 4; ++i) { const int nl = (tid >> 3) + 64 * i, ch = tid & 7;
        if (n0 + nl < ncols) *(GAS v4u*)(dst + (size_t)(r0 + n0 + nl) * ldd + kofs + k0 + ch * 8) = *(const LAS v4u*)(lds + nl * 144 + ch * 16); }
}
#define TR_SEG(W_, ldw_, c0_, ncols_, K_, scale_, dst_, ldd_, r0_, kofs_) do { const int _n = ((K_) / 64) * (((ncols_) + 255) / 256); \
    for (int _it = (bx + G - (ibase % G)) % G; _it < _n; _it += G) tr_item(W_, ldw_, c0_, ncols_, scale_, dst_, ldd_, r0_, kofs_, lds, _it, tid); ibase += _n; } while (0)

struct Args { const float* in[23]; float* out; unsigned char* ws; int ph_lo, ph_hi; };
constexpr int NPH = 10, PH_FINAL = DEPTH * NPH, N_PHASES = PH_FINAL + 1;

constexpr int WG = 8;
__device__ __forceinline__ void gdn_naive(const Args& A, int layer, int b, int h, int lane, const bf16* MIX, const float* SM, bf16* ZB) {
    const float* cw = A.in[4] + (size_t)layer * 4 * 1536;
    float wq[4], wk[4], wv[4];
#pragma unroll
    for (int k = 0; k < 4; ++k) { wq[k] = cw[k * 1536 + h * 64 + lane]; wk[k] = cw[k * 1536 + 512 + h * 64 + lane]; wv[k] = cw[k * 1536 + 1024 + h * 64 + lane]; }
    const float Aexp = expf(A.in[5][layer * 8 + h]), dtb = A.in[6][layer * 8 + h], nw = A.in[7][layer * 64 + lane];
    float M[64];
#pragma unroll
    for (int d = 0; d < 64; ++d) M[d] = 0.f;
    float hq0 = 0.f, hq1 = 0.f, hq2 = 0.f, hk0 = 0.f, hk1 = 0.f, hk2 = 0.f, hv0 = 0.f, hv1 = 0.f, hv2 = 0.f;
    const size_t tok0 = (size_t)b * SEQ;
    bf16 nq[WG], nk[WG], nv[WG], nz[WG]; float nb[WG], na[WG];
#define GDN_LOAD(t0) do { _Pragma("unroll") for (int i = 0; i < WG; ++i) { const size_t r = tok0 + (t0) + i; const bf16* mp = MIX + r * MIX_LD + h * 64 + lane; \
        nq[i] = mp[MX_AQ]; nk[i] = mp[MX_AK]; nv[i] = mp[MX_AV]; nz[i] = ZB[r * ZB_LD + h * 64 + lane]; nb[i] = SM[r * SM_LD + h]; na[i] = SM[r * SM_LD + 8 + h]; } } while (0)
    GDN_LOAD(0);
    for (int t0 = 0; t0 < SEQ; t0 += WG) {
        bf16 cq[WG], ck[WG], cv[WG], cz[WG]; float cb[WG], ca[WG];
#pragma unroll
        for (int i = 0; i < WG; ++i) { cq[i] = nq[i]; ck[i] = nk[i]; cv[i] = nv[i]; cz[i] = nz[i]; cb[i] = nb[i]; ca[i] = na[i]; }
        if (t0 + WG < SEQ) GDN_LOAD(t0 + WG);
#pragma unroll
        for (int i = 0; i < WG; ++i) {
            const float xq = bf2f(cq[i]), xk = bf2f(ck[i]), xv = bf2f(cv[i]);
            float q = siluf(wq[0] * hq0 + wq[1] * hq1 + wq[2] * hq2 + wq[3] * xq); hq0 = hq1; hq1 = hq2; hq2 = xq;
            float k = siluf(wk[0] * hk0 + wk[1] * hk1 + wk[2] * hk2 + wk[3] * xk); hk0 = hk1; hk1 = hk2; hk2 = xk;
            const float v = siluf(wv[0] * hv0 + wv[1] * hv1 + wv[2] * hv2 + wv[3] * xv); hv0 = hv1; hv1 = hv2; hv2 = xv;
            q *= rsqrtf(wave_sum(q * q) + 1e-6f) * 0.125f; k *= rsqrtf(wave_sum(k * k) + 1e-6f);
            const float beta = sigmf(cb[i]), a = __expf(-Aexp * softplusf(ca[i] + dtb));
            float r = 0.f;
#pragma unroll
            for (int d = 0; d < 64; ++d) { M[d] *= a; r += rdl(k, d) * M[d]; }
            const float u = beta * (v - r); float o = 0.f;
#pragma unroll
            for (int d = 0; d < 64; ++d) { M[d] += rdl(k, d) * u; o += rdl(q, d) * M[d]; }
            const float y = o * rsqrtf(wave_sum(o * o) * (1.0f / 64.0f) + 1e-6f) * nw * siluf(bf2f(cz[i]));
            ZB[(tok0 + t0 + i) * ZB_LD + h * 64 + lane] = (bf16)f2bf(y);
        }
    }
#undef GDN_LOAD
}
__device__ __forceinline__ void ssd_naive(const Args& A, int layer, int b, int h, int lane, const bf16* MIX, float* SM, bf16* ZB) {
    const int g = h >> 2;
    const float* cw = A.in[8] + (size_t)layer * 4 * 768; const float* cb_ = A.in[9] + (size_t)layer * 768;
    float wx[4], wB[4], wC[4];
#pragma unroll
    for (int k = 0; k < 4; ++k) { wx[k] = cw[k * 768 + h * 64 + lane]; wB[k] = cw[k * 768 + 512 + g * 64 + lane]; wC[k] = cw[k * 768 + 640 + g * 64 + lane]; }
    const float bx = cb_[h * 64 + lane], bB = cb_[512 + g * 64 + lane], bC = cb_[640 + g * 64 + lane];
    const float Aexp = expf(A.in[10][layer * 8 + h]), dtb = A.in[11][layer * 8 + h], Dh = A.in[12][layer * 8 + h];
    float Hs[64];
#pragma unroll
    for (int d = 0; d < 64; ++d) Hs[d] = 0.f;
    float hx0 = 0.f, hx1 = 0.f, hx2 = 0.f, hB0 = 0.f, hB1 = 0.f, hB2 = 0.f, hC0 = 0.f, hC1 = 0.f, hC2 = 0.f;
    const size_t tok0 = (size_t)b * SEQ;
    bf16 nx[WG], nB[WG], nC[WG], nz[WG]; float nd[WG];
#define SSD_LOAD(t0) do { _Pragma("unroll") for (int i = 0; i < WG; ++i) { const size_t r = tok0 + (t0) + i; const bf16* mp = MIX + r * MIX_LD; \
        nx[i] = mp[MX_BX + h * 64 + lane]; nB[i] = mp[MX_BB + g * 64 + lane]; nC[i] = mp[MX_BC + g * 64 + lane]; nz[i] = ZB[r * ZB_LD + 512 + h * 64 + lane]; nd[i] = SM[r * SM_LD + 16 + h]; } } while (0)
    SSD_LOAD(0);
    for (int t0 = 0; t0 < SEQ; t0 += WG) {
        bf16 cx[WG], cB[WG], cC[WG], cz[WG]; float cd[WG];
#pragma unroll
        for (int i = 0; i < WG; ++i) { cx[i] = nx[i]; cB[i] = nB[i]; cC[i] = nC[i]; cz[i] = nz[i]; cd[i] = nd[i]; }
        if (t0 + WG < SEQ) SSD_LOAD(t0 + WG);
#pragma unroll
        for (int i = 0; i < WG; ++i) {
            const float rx = bf2f(cx[i]), rB = bf2f(cB[i]), rC = bf2f(cC[i]);
            const float x = siluf(wx[0] * hx0 + wx[1] * hx1 + wx[2] * hx2 + wx[3] * rx + bx); hx0 = hx1; hx1 = hx2; hx2 = rx;
            const float Bv = siluf(wB[0] * hB0 + wB[1] * hB1 + wB[2] * hB2 + wB[3] * rB + bB); hB0 = hB1; hB1 = hB2; hB2 = rB;
            const float Cv = siluf(wC[0] * hC0 + wC[1] * hC1 + wC[2] * hC2 + wC[3] * rC + bC); hC0 = hC1; hC1 = hC2; hC2 = rC;
            const float dt = softplusf(cd[i] + dtb), a = __expf(-Aexp * dt), xdt = x * dt;
            float y = 0.f;
#pragma unroll
            for (int n = 0; n < 64; ++n) { Hs[n] = a * Hs[n] + xdt * rdl(Bv, n); y += Hs[n] * rdl(Cv, n); }
            y = (y + Dh * x) * siluf(bf2f(cz[i]));
            const float ss = wave_sum(y * y);
            const size_t r = tok0 + t0 + i;
            ZB[r * ZB_LD + 512 + h * 64 + lane] = (bf16)f2bf(y);
            if (lane == 0) SM[r * SM_LD + 24 + h] = ss;
        }
    }
#undef SSD_LOAD
}
__device__ __forceinline__ void ret_naive(int b, int h, int lane, const bf16* MIX, const float* ROPE, bf16* ZB) {
    const float gamma = 1.0f - exp2f(-5.0f - (float)h);
    float M[64];
#pragma unroll
    for (int d = 0; d < 64; ++d) M[d] = 0.f;
    const size_t tok0 = (size_t)b * SEQ;
    bf16 nq[WG], nk[WG], nv[WG], nz[WG]; float nc[WG], ns[WG];
#define RET_LOAD(t0) do { _Pragma("unroll") for (int i = 0; i < WG; ++i) { const size_t r = tok0 + (t0) + i; const bf16* mp = MIX + r * MIX_LD + h * 64 + lane; \
        nq[i] = mp[MX_CQ]; nk[i] = mp[MX_CK]; nv[i] = mp[MX_CV]; nz[i] = ZB[r * ZB_LD + 1024 + h * 64 + lane]; nc[i] = ROPE[((t0) + i) * 32 + (lane & 31)]; ns[i] = ROPE[SEQ * 32 + ((t0) + i) * 32 + (lane & 31)]; } } while (0)
    RET_LOAD(0);
    for (int t0 = 0; t0 < SEQ; t0 += WG) {
        bf16 cq[WG], ck[WG], cv[WG], cz[WG]; float cc[WG], cs[WG];
#pragma unroll
        for (int i = 0; i < WG; ++i) { cq[i] = nq[i]; ck[i] = nk[i]; cv[i] = nv[i]; cz[i] = nz[i]; cc[i] = nc[i]; cs[i] = ns[i]; }
        if (t0 + WG < SEQ) RET_LOAD(t0 + WG);
#pragma unroll
        for (int i = 0; i < WG; ++i) {
            const float q0 = bf2f(cq[i]), k0 = bf2f(ck[i]), v = bf2f(cv[i]);
            const float qp = __shfl_xor(q0, 32), kp = __shfl_xor(k0, 32);
            const float sg = lane < 32 ? -cs[i] : cs[i];
            const float q = q0 * cc[i] + qp * sg, k = (k0 * cc[i] + kp * sg) * 0.125f;
            float o = 0.f;
#pragma unroll
            for (int d = 0; d < 64; ++d) { M[d] = gamma * M[d] + rdl(k, d) * v; o += rdl(q, d) * M[d]; }
            const float y = o * rsqrtf(wave_sum(o * o) * (1.0f / 64.0f) + 1e-6f) * siluf(bf2f(cz[i]));
            ZB[(tok0 + t0 + i) * ZB_LD + 1024 + h * 64 + lane] = (bf16)f2bf(y);
        }
    }
#undef RET_LOAD
}

typedef short bf16x8 __attribute__((ext_vector_type(8)));
constexpr int PT = 72, MAT = 64 * PT * 2;
constexpr int L_Q = 0, L_K = MAT, L_V = 2 * MAT, L_W = 3 * MAT, L_U = 4 * MAT, L_ST0 = 5 * MAT, L_ST1 = 6 * MAT, L_PP = 7 * MAT, L_YT = 8 * MAT,
              YPT = 68, L_G = L_YT + 64 * YPT * 4, L_DT = L_G + 256, L_WEND = L_DT + 256;
static_assert(L_WEND <= RING_BYTES, "walker LDS");
constexpr size_t GW_OFF = 0, HALO_OFF = 32 * MiB;
constexpr int HALO_LD = 2304;
#define MFMA16(a, b, c) __builtin_amdgcn_mfma_f32_16x16x32_bf16(a, b, c, 0, 0, 0)
__device__ __forceinline__ bf16x8 ldfrag(LAS unsigned char* base, int row, int kelem) { return *(const LAS bf16x8*)(base + row * (PT * 2) + kelem * 2); }
__device__ __forceinline__ void unpk8(const v4u w, float (&f)[8]) { f[0] = pg8::bflo(w.x); f[1] = pg8::bfhi(w.x); f[2] = pg8::bflo(w.y); f[3] = pg8::bfhi(w.y); f[4] = pg8::bflo(w.z); f[5] = pg8::bfhi(w.z); f[6] = pg8::bflo(w.w); f[7] = pg8::bfhi(w.w); }
__device__ __forceinline__ v4u pk8(const float (&f)[8]) { v4u w; w.x = pk2(f[0], f[1]); w.y = pk2(f[2], f[3]); w.z = pk2(f[4], f[5]); w.w = pk2(f[6], f[7]); return w; }
__device__ __forceinline__ void st_tr8(LAS unsigned char* base, int row0, int col, const float (&f)[8]) {
#pragma unroll
    for (int j = 0; j < 8; ++j) *(LAS bf16*)(base + (row0 + j) * (PT * 2) + col * 2) = (bf16)f2bf(f[j]);
}

#define LBAR() asm volatile("s_waitcnt lgkmcnt(0)\n\ts_barrier" ::: "memory")
typedef short s16x4 __attribute__((ext_vector_type(4)));
__device__ __forceinline__ s16x4 tr4(LAS unsigned char* p) { return __builtin_bit_cast(s16x4, __builtin_amdgcn_ds_read_tr16_b64_v4i16((LAS s16x4*)p)); }
__device__ __forceinline__ bf16x8 trfrag(LAS unsigned char* tile, int krow0, int col0, int fr) {
    LAS unsigned char* a = tile + (krow0 + (fr >> 2)) * (PT * 2) + (col0 + 4 * (fr & 3)) * 2;
    const s16x4 lo = tr4(a), hi = tr4(a + 4 * PT * 2);
    return (bf16x8){lo[0], lo[1], lo[2], lo[3], hi[0], hi[1], hi[2], hi[3]};
}
__device__ __forceinline__ float bfs(short v) { return __uint_as_float((unsigned)(unsigned short)v << 16); }

template <int KIND>
__device__ __forceinline__ void mixer_walk(const __attribute__((address_space(4))) Args* kp, int layer, int b, int h, LAS unsigned char* lds) {
    int tid = threadIdx.x; asm volatile("" : "+v"(tid));
    const int lane = tid & 63, wave = __builtin_amdgcn_readfirstlane(tid >> 6), fr = lane & 15, fq = lane >> 4;
    const int prow = tid >> 3, pcg = tid & 7;
    unsigned char* ws = kp->ws;
    const bf16* MIX = (const bf16*)(ws + WS_MIX); bf16* ZB = (bf16*)(ws + WS_ZB); float* SM = (float*)(ws + WS_SM);
    const bf16* GW = (const bf16*)(ws + ((layer & 1) ? WS_XB0 : WS_XB1) + GW_OFF);
    const size_t tok0 = (size_t)b * SEQ;
    const int g = h >> 2;
    const int qcol = (KIND == 0 ? MX_AQ + h * 64 : (KIND == 1 ? MX_BC + g * 64 : MX_CQ + h * 64)) + pcg * 8;
    const int kcol = (KIND == 0 ? MX_AK + h * 64 : (KIND == 1 ? MX_BB + g * 64 : MX_CK + h * 64)) + pcg * 8;
    const int vcol = (KIND == 0 ? MX_AV + h * 64 : (KIND == 1 ? MX_BX + h * 64 : MX_CV + h * 64)) + pcg * 8;
    const int zcol = KIND * 512 + h * 64 + pcg * 8;
    const int gcol = (KIND == 0 ? 8 : 16) + h;
    float nw[8];
    if (KIND == 0) {
#pragma unroll
        for (int j = 0; j < 8; ++j) nw[j] = kp->in[7][layer * 64 + pcg * 8 + j];
    }
    const float p_D = KIND == 1 ? kp->in[12][layer * 8 + h] : 0.f;
    const float p_lg = KIND == 2 ? log1pf(-exp2f(-5.0f - (float)h)) : 0.f;
    for (int i = tid; i < MAT / 4; i += 512) ((LAS unsigned*)(lds + L_ST0))[i] = 0u;
    pg8::f32x4 sacc[4];
#pragma unroll
    for (int i = 0; i < 4; ++i) sacc[i] = (pg8::f32x4){0.f, 0.f, 0.f, 0.f};
    LAS float* Gv = (LAS float*)(lds + L_G); LAS float* Dv = (LAS float*)(lds + L_DT);
    LAS unsigned char* PPw = lds + L_PP + (wave & 3) * (16 * PT * 2);

    v4u tq, tk, tv, tw, tz; float sg = 0.f, sd = 1.f; (void)tw;
#define WALK_LOAD(c) do { const size_t row = tok0 + (size_t)(c) * 64 + prow; const bf16* mp = MIX + row * MIX_LD; \
        tq = *(const GAS v4u*)(mp + qcol); tk = *(const GAS v4u*)(mp + kcol); tv = *(const GAS v4u*)(mp + vcol); \
        if (KIND == 0) tw = *(const GAS v4u*)(GW + row * 512 + h * 64 + pcg * 8); \
        tz = *(const GAS v4u*)(ZB + row * ZB_LD + zcol); \
        if (tid < 64) { const size_t r2 = tok0 + (size_t)(c) * 64 + tid; \
            if (KIND == 2) sg = (float)(tid + 1) * p_lg; else sg = SM[r2 * SM_LD + gcol]; \
            if (KIND == 1) sd = SM[r2 * SM_LD + 24 + h]; } } while (0)
#define WALK_PREP() do { \
        *(LAS v4u*)(lds + L_Q + prow * (PT * 2) + pcg * 16) = tq; *(LAS v4u*)(lds + L_K + prow * (PT * 2) + pcg * 16) = tk; \
        if (KIND == 0) { *(LAS v4u*)(lds + L_U + prow * (PT * 2) + pcg * 16) = tv; *(LAS v4u*)(lds + L_W + prow * (PT * 2) + pcg * 16) = tw; } \
        else *(LAS v4u*)(lds + L_V + prow * (PT * 2) + pcg * 16) = tv; \
        if (tid < 64) { Gv[tid] = sg; Dv[tid] = sd; } } while (0)

    WALK_LOAD(0);
    WALK_PREP();
    v4u zc = tz, xc = tv;
    LBAR();
    for (int c = 0; c < SEQ / 64; ++c) {
        LAS unsigned char* STc = lds + ((c & 1) ? L_ST1 : L_ST0); LAS unsigned char* STn = lds + ((c & 1) ? L_ST0 : L_ST1);
        if (c + 1 < SEQ / 64) WALK_LOAD(c + 1);
        bf16x8 Qf[2];
        if (wave < 4) { const int lb = wave;
            Qf[0] = ldfrag(lds + L_Q, 16 * lb + fr, 8 * fq); Qf[1] = ldfrag(lds + L_Q, 16 * lb + fr, 32 + 8 * fq);
            const float gl = Gv[16 * lb + fr];
#pragma unroll
            for (int sb = 0; sb < 4; ++sb) { v2u o; o.x = 0u; o.y = 0u;
                if (sb <= lb) { pg8::f32x4 acc = (pg8::f32x4){0.f, 0.f, 0.f, 0.f};
#pragma unroll
                    for (int ks = 0; ks < 2; ++ks) acc = MFMA16(ldfrag(lds + L_K, 16 * sb + fr, 32 * ks + 8 * fq), Qf[ks], acc);
                    const pg8::f32x4 gs = *(const LAS pg8::f32x4*)(Gv + 16 * sb + 4 * fq); pg8::f32x4 ds = (pg8::f32x4){1.f, 1.f, 1.f, 1.f};
                    if (KIND == 1) ds = *(const LAS pg8::f32x4*)(Dv + 16 * sb + 4 * fq);
                    float pv[4];
#pragma unroll
                    for (int r = 0; r < 4; ++r) pv[r] = (16 * sb + 4 * fq + r <= 16 * lb + fr) ? acc[r] * __expf(gl - gs[r]) * ds[r] : 0.f;
                    o.x = pk2(pv[0], pv[1]); o.y = pk2(pv[2], pv[3]); }
                *(LAS v2u*)(PPw + fr * (PT * 2) + (16 * sb + 4 * fq) * 2) = o; }
        } else if (KIND == 0) { const int wq = wave - 4;
            const bf16x8 Wf0 = ldfrag(lds + L_W, 16 * wq + fr, 8 * fq), Wf1 = ldfrag(lds + L_W, 16 * wq + fr, 32 + 8 * fq);
#pragma unroll
            for (int eb = 0; eb < 4; ++eb) { pg8::f32x4 acc = (pg8::f32x4){0.f, 0.f, 0.f, 0.f};
                acc = MFMA16(Wf0, ldfrag(STc, 16 * eb + fr, 8 * fq), acc); acc = MFMA16(Wf1, ldfrag(STc, 16 * eb + fr, 32 + 8 * fq), acc);
                const s16x4 u4 = tr4(lds + L_U + (16 * wq + 4 * fq + (fr >> 2)) * (PT * 2) + (16 * eb + 4 * (fr & 3)) * 2);
                v2u o; o.x = pk2(bfs(u4[0]) - acc[0], bfs(u4[1]) - acc[1]); o.y = pk2(bfs(u4[2]) - acc[2], bfs(u4[3]) - acc[3]);
                *(LAS v2u*)(lds + L_V + (16 * eb + fr) * (PT * 2) + (16 * wq + 4 * fq) * 2) = o; }
        }
        if (KIND == 0) LBAR();
        if (wave < 4) { const int lb = wave;
            const bf16x8 Pf0 = ldfrag(PPw, fr, 8 * fq), Pf1 = ldfrag(PPw, fr, 32 + 8 * fq);
            const pg8::f32x4 gv = *(const LAS pg8::f32x4*)(Gv + 16 * lb + 4 * fq);
            const pg8::f32x4 eg = (pg8::f32x4){__expf(gv[0]), __expf(gv[1]), __expf(gv[2]), __expf(gv[3])};
#pragma unroll
            for (int eb = 0; eb < 4; ++eb) { pg8::f32x4 acc = (pg8::f32x4){0.f, 0.f, 0.f, 0.f};
                acc = MFMA16(Qf[0], ldfrag(STc, 16 * eb + fr, 8 * fq), acc); acc = MFMA16(Qf[1], ldfrag(STc, 16 * eb + fr, 32 + 8 * fq), acc);
                acc *= eg;
                if (KIND == 0) { acc = MFMA16(Pf0, ldfrag(lds + L_V, 16 * eb + fr, 8 * fq), acc); acc = MFMA16(Pf1, ldfrag(lds + L_V, 16 * eb + fr, 32 + 8 * fq), acc); }
                else { acc = MFMA16(Pf0, trfrag(lds + L_V, 8 * fq, 16 * eb, fr), acc); acc = MFMA16(Pf1, trfrag(lds + L_V, 32 + 8 * fq, 16 * eb, fr), acc); }
#pragma unroll
                for (int r = 0; r < 4; ++r) ((LAS float*)(lds + L_YT))[(16 * lb + 4 * fq + r) * YPT + 16 * eb + fr] = acc[r]; }
        } else { const int db = wave - 4;
            const float glast = Gv[63], egl = __expf(glast);
            bf16x8 Kf[2];
#pragma unroll
            for (int ks = 0; ks < 2; ++ks) { const bf16x8 kr = trfrag(lds + L_K, 32 * ks + 8 * fq, 16 * db, fr);
                const pg8::f32x4 g0 = *(const LAS pg8::f32x4*)(Gv + 32 * ks + 8 * fq), g1 = *(const LAS pg8::f32x4*)(Gv + 32 * ks + 8 * fq + 4);
                pg8::f32x4 d0 = (pg8::f32x4){1.f, 1.f, 1.f, 1.f}, d1 = d0;
                if (KIND == 1) { d0 = *(const LAS pg8::f32x4*)(Dv + 32 * ks + 8 * fq); d1 = *(const LAS pg8::f32x4*)(Dv + 32 * ks + 8 * fq + 4); }
                float kf[8];
#pragma unroll
                for (int j = 0; j < 4; ++j) { kf[j] = bfs(kr[j]) * __expf(glast - g0[j]) * d0[j]; kf[4 + j] = bfs(kr[4 + j]) * __expf(glast - g1[j]) * d1[j]; }
                const v4u kw = pk8(kf); Kf[ks] = __builtin_bit_cast(bf16x8, kw); }
#pragma unroll
            for (int eb = 0; eb < 4; ++eb) { pg8::f32x4 acc = sacc[eb] * egl;
                if (KIND == 0) { acc = MFMA16(Kf[0], ldfrag(lds + L_V, 16 * eb + fr, 8 * fq), acc); acc = MFMA16(Kf[1], ldfrag(lds + L_V, 16 * eb + fr, 32 + 8 * fq), acc); }
                else { acc = MFMA16(Kf[0], trfrag(lds + L_V, 8 * fq, 16 * eb, fr), acc); acc = MFMA16(Kf[1], trfrag(lds + L_V, 32 + 8 * fq, 16 * eb, fr), acc); }
                sacc[eb] = acc;
                v2u o; o.x = pk2(acc[0], acc[1]); o.y = pk2(acc[2], acc[3]);
                *(LAS v2u*)(STn + (16 * eb + fr) * (PT * 2) + (16 * db + 4 * fq) * 2) = o; }
        }
        LBAR();
        {
            const LAS float* yr = (const LAS float*)(lds + L_YT) + prow * YPT + pcg * 8;
            const pg8::f32x4 y0 = *(const LAS pg8::f32x4*)yr, y1 = *(const LAS pg8::f32x4*)(yr + 4);
            float y[8] = {y0[0], y0[1], y0[2], y0[3], y1[0], y1[1], y1[2], y1[3]}, zf[8]; unpk8(zc, zf);
            const size_t row = tok0 + (size_t)c * 64 + prow;
            if (KIND == 1) { float ss = 0.f, xf[8]; unpk8(xc, xf);
#pragma unroll
                for (int j = 0; j < 8; ++j) { y[j] = (y[j] + p_D * xf[j]) * siluf(zf[j]); ss += y[j] * y[j]; }
                ss += __shfl_xor(ss, 1); ss += __shfl_xor(ss, 2); ss += __shfl_xor(ss, 4);
                if (pcg == 0) SM[row * SM_LD + 16 + h] = ss;
            } else { float ss = 0.f;
#pragma unroll
                for (int j = 0; j < 8; ++j) ss += y[j] * y[j];
                ss += __shfl_xor(ss, 1); ss += __shfl_xor(ss, 2); ss += __shfl_xor(ss, 4);
                const float rstd = rsqrtf(ss * (1.0f / 64.0f) + 1e-6f);
#pragma unroll
                for (int j = 0; j < 8; ++j) y[j] = y[j] * rstd * (KIND == 0 ? nw[j] : 1.0f) * siluf(zf[j]); }
            *(GAS v4u*)(ZB + row * ZB_LD + zcol) = pk8(y);
        }
        if (c + 1 < SEQ / 64) { WALK_PREP(); zc = tz; xc = tv; }
        LBAR();
    }
#undef WALK_LOAD
#undef WALK_PREP
}

constexpr int SP_RAW = 0, SP_CW = 67 * 1536, SP_END = SP_CW + 5 * 768 * 4;
static_assert(SP_END <= RING_BYTES, "ssd_prep LDS");
__device__ __forceinline__ void ssd_prep(const __attribute__((address_space(4))) Args* kp, int layer, LAS unsigned char* lds, int G_) {
    int tid = threadIdx.x; asm volatile("" : "+v"(tid));
    const int lane = tid & 63, wave = __builtin_amdgcn_readfirstlane(tid >> 6);
    unsigned char* ws = kp->ws;
    bf16* MIX = (bf16*)(ws + WS_MIX); float* SM = (float*)(ws + WS_SM);
    const bf16* HALO = (const bf16*)(ws + ((layer & 1) ? WS_XB0 : WS_XB1) + HALO_OFF);
    LAS float* CW = (LAS float*)(lds + SP_CW);
    { const float* cw = kp->in[8] + (size_t)layer * 4 * 768; const float* cb = kp->in[9] + (size_t)layer * 768;
      for (int i = tid; i < 768; i += 512) { CW[i] = cw[i]; CW[768 + i] = cw[768 + i]; CW[2 * 768 + i] = cw[2 * 768 + i]; CW[3 * 768 + i] = cw[3 * 768 + i]; CW[4 * 768 + i] = cb[i]; } }
    const float Aexp = expf(kp->in[10][layer * 8 + wave]), dtb = kp->in[11][layer * 8 + wave];
    for (int unit = blockIdx.x; unit < NBATCH * 64; unit += G_) { const int b = unit >> 6, c = unit & 63; const size_t tok0 = (size_t)b * SEQ + (size_t)c * 64;
        LBAR();
        for (int i = tid; i < 67 * 96; i += 512) { const int r = i / 96, pc = i - r * 96; v4u v = (v4u){0u, 0u, 0u, 0u};
            if (r >= 3) v = *(const GAS v4u*)(MIX + (tok0 + r - 3) * MIX_LD + MX_BX + pc * 8);
            else if (c > 0) v = *(const GAS v4u*)(HALO + ((size_t)(b * 64 + c - 1) * 3 + r) * HALO_LD + MX_BX + pc * 8);
            *(LAS v4u*)(lds + SP_RAW + r * 1536 + pc * 16) = v; }
        { const size_t r2 = tok0 + lane; const float dt = softplusf(SM[r2 * SM_LD + 16 + wave] + dtb); float gs = -Aexp * dt;
#pragma unroll
          for (int o = 1; o < 64; o <<= 1) { const float t_ = __shfl_up(gs, o); if (lane >= o) gs += t_; }
          SM[r2 * SM_LD + 16 + wave] = gs; SM[r2 * SM_LD + 24 + wave] = dt; }
        LBAR();
        for (int i = tid; i < 64 * 96; i += 512) { const int l = i / 96, pc = i - l * 96; float a[8];
            { const pg8::f32x4 b0 = *(const LAS pg8::f32x4*)(CW + 4 * 768 + pc * 8), b1 = *(const LAS pg8::f32x4*)(CW + 4 * 768 + pc * 8 + 4);
              a[0] = b0[0]; a[1] = b0[1]; a[2] = b0[2]; a[3] = b0[3]; a[4] = b1[0]; a[5] = b1[1]; a[6] = b1[2]; a[7] = b1[3]; }
#pragma unroll
            for (int k = 0; k < 4; ++k) { float f[8]; unpk8(*(const LAS v4u*)(lds + SP_RAW + (l + k) * 1536 + pc * 16), f);
                const pg8::f32x4 w0 = *(const LAS pg8::f32x4*)(CW + k * 768 + pc * 8), w1 = *(const LAS pg8::f32x4*)(CW + k * 768 + pc * 8 + 4);
#pragma unroll
                for (int j = 0; j < 4; ++j) { a[j] += w0[j] * f[j]; a[4 + j] += w1[j] * f[4 + j]; } }
#pragma unroll
            for (int j = 0; j < 8; ++j) a[j] = siluf(a[j]);
            *(GAS v4u*)(MIX + (tok0 + l) * MIX_LD + MX_BX + pc * 8) = pk8(a); }
    }
    LBAR();
}
__device__ __forceinline__ void ret_prep(const __attribute__((address_space(4))) Args* kp, int G_) {
    int tid = threadIdx.x; asm volatile("" : "+v"(tid));
    unsigned char* ws = kp->ws;
    bf16* MIX = (bf16*)(ws + WS_MIX); const float* ROPE = (const float*)(ws + WS_ROPE);
    for (int it = blockIdx.x * 512 + tid; it < MTOK * 32; it += G_ * 512) { const int m = it >> 5, hh = (it >> 2) & 7, i4 = it & 3, t = m & (SEQ - 1);
        const float* rp = ROPE + t * 32 + i4 * 8;
        const pg8::f32x4 c0 = *(const GAS pg8::f32x4*)rp, c1 = *(const GAS pg8::f32x4*)(rp + 4), s0 = *(const GAS pg8::f32x4*)(rp + SEQ * 32), s1 = *(const GAS pg8::f32x4*)(rp + SEQ * 32 + 4);
        const float cs[8] = {c0[0], c0[1], c0[2], c0[3], c1[0], c1[1], c1[2], c1[3]}, sn[8] = {s0[0], s0[1], s0[2], s0[3], s1[0], s1[1], s1[2], s1[3]};
#pragma unroll
        for (int T = 0; T < 2; ++T) { bf16* p = MIX + (size_t)m * MIX_LD + (T == 0 ? MX_CQ : MX_CK) + hh * 64 + i4 * 8; const float sc = T == 0 ? 1.0f : 0.125f;
            float a[8], bb[8], o1[8], o2[8]; unpk8(*(const GAS v4u*)p, a); unpk8(*(const GAS v4u*)(p + 32), bb);
#pragma unroll
            for (int j = 0; j < 8; ++j) { o1[j] = (a[j] * cs[j] - bb[j] * sn[j]) * sc; o2[j] = (a[j] * sn[j] + bb[j] * cs[j]) * sc; }
            *(GAS v4u*)p = pk8(o1); *(GAS v4u*)(p + 32) = pk8(o2); }
    }
}

constexpr int GP_KN = 0, GP_AF = MAT, APT = 68, FPT = 65, GP_R = GP_AF + 64 * APT * 4, GP_TEAM = GP_R + 3 * 256;
constexpr int GP_RAW1 = 67 * 128;
static_assert(4 * GP_TEAM <= LDS_BYTES - 1024 && 2 * GP_RAW1 <= 64 * APT * 4 && 64 * FPT * 4 <= 64 * APT * 4, "gdn_prep LDS");
__device__ __forceinline__ void gdn_prep(const __attribute__((address_space(4))) Args* kp, int layer, LAS unsigned char* lds_all, int G_) {
    int tid = threadIdx.x; asm volatile("" : "+v"(tid));
    const int team = __builtin_amdgcn_readfirstlane(tid >> 7), j = tid & 127, lane = tid & 63, hw = __builtin_amdgcn_readfirstlane((tid >> 6) & 1), fr = lane & 15, fq = lane >> 4;
    LAS unsigned char* lds = lds_all + team * GP_TEAM;
    LAS unsigned char* OV = lds + GP_AF;
    LAS float* AF = (LAS float*)OV; LAS float* FF = (LAS float*)OV; LAS float* Gs = (LAS float*)(lds + GP_R); LAS float* Bs = Gs + 64; LAS float* Rn = Gs + 128;
    unsigned char* ws = kp->ws;
    bf16* MIX = (bf16*)(ws + WS_MIX); float* SM = (float*)(ws + WS_SM);
    unsigned char* xbf = ws + ((layer & 1) ? WS_XB0 : WS_XB1); bf16* GW = (bf16*)(xbf + GW_OFF); const bf16* HALO = (const bf16*)(xbf + HALO_OFF);
    const float* cw = kp->in[4] + (size_t)layer * 4 * 1536;
    for (int round = 0; round < 4; ++round) {
        const int unit_ = (round * G_ + (int)blockIdx.x) * 4 + team;
        const bool live = unit_ < NBATCH * 8 * 64;
        const int unit = live ? unit_ : 0;
        const int c = unit & 63, h = (unit >> 6) & 7, b = unit >> 9;
        const size_t tok0 = (size_t)b * SEQ + (size_t)c * 64;
        const float Aexp = expf(kp->in[5][layer * 8 + h]), dtb = kp->in[6][layer * 8 + h];
        for (int i = j; i < 67 * 8; i += 128) { const int r = i >> 3, ch = i & 7; v4u vk = (v4u){0u, 0u, 0u, 0u}, vv = vk;
            if (r >= 3) { const bf16* mp = MIX + (tok0 + r - 3) * MIX_LD + h * 64 + ch * 8; vk = *(const GAS v4u*)(mp + MX_AK); vv = *(const GAS v4u*)(mp + MX_AV); }
            else if (c > 0) { const bf16* hp = HALO + ((size_t)(b * 64 + c - 1) * 3 + r) * HALO_LD + h * 64 + ch * 8; vk = *(const GAS v4u*)(hp + MX_AK); vv = *(const GAS v4u*)(hp + MX_AV); }
            *(LAS v4u*)(OV + r * 128 + ch * 16) = vk; *(LAS v4u*)(OV + GP_RAW1 + r * 128 + ch * 16) = vv; }
        LBAR();
        float x[64];
        { const int colA = (hw == 0 ? MX_AV : MX_AK) + h * 64 + lane;
          const float w0 = cw[colA], w1 = cw[1536 + colA], w2 = cw[2 * 1536 + colA], w3 = cw[3 * 1536 + colA];
          const LAS bf16* rp = (const LAS bf16*)(OV + (hw == 0 ? GP_RAW1 : 0)) + lane;
          float h0 = bf2f(rp[0]), h1 = bf2f(rp[64]), h2 = bf2f(rp[128]);
#pragma unroll
          for (int t = 0; t < 64; ++t) { const float xr = bf2f(rp[(t + 3) * 64]); x[t] = siluf(w0 * h0 + w1 * h1 + w2 * h2 + w3 * xr); h0 = h1; h1 = h2; h2 = xr; } }
        if (hw == 0) { const float bl = SM[(tok0 + lane) * SM_LD + h], al = SM[(tok0 + lane) * SM_LD + 8 + h];
            float gsum = -Aexp * softplusf(al + dtb);
#pragma unroll
            for (int o = 1; o < 64; o <<= 1) { const float t_ = __shfl_up(gsum, o); if (lane >= o) gsum += t_; }
            Gs[lane] = gsum; Bs[lane] = sigmf(bl);
            if (live) SM[(tok0 + lane) * SM_LD + 8 + h] = gsum; }
        LBAR();
        if (hw == 1) {
#pragma unroll
            for (int t = 0; t < 64; ++t) FF[t * FPT + lane] = x[t]; }
        LBAR();
        if (hw == 1) { float s = 0.f;
#pragma unroll
            for (int d = 0; d < 64; ++d) { const float v = FF[lane * FPT + d]; s += v * v; }
            Rn[lane] = rsqrtf(s + 1e-6f); }
        LBAR();
        if (hw == 1) {
#pragma unroll
            for (int t = 0; t < 64; ++t) { const float kn = x[t] * Rn[t]; const bf16 kb = (bf16)f2bf(kn);
                *(LAS bf16*)(lds + GP_KN + t * (PT * 2) + lane * 2) = kb;
                x[t] = Bs[t] * bf2f(kb) * __expf(Gs[t]);
                if ((t & 7) == 7) asm volatile("" ::: "memory"); }
        } else {
#pragma unroll
            for (int t = 0; t < 64; ++t) { x[t] *= Bs[t]; if ((t & 15) == 15) asm volatile("" ::: "memory"); }
        }
        LBAR();
        if (live) for (int i = j; i < 64 * 8; i += 128) { const int t = i >> 3, ch = i & 7; *(GAS v4u*)(MIX + (tok0 + t) * MIX_LD + MX_AK + h * 64 + ch * 8) = *(const LAS v4u*)(lds + GP_KN + t * (PT * 2) + ch * 16); }
#pragma unroll
        for (int blk = 0; blk < 5; ++blk) { const int id = blk * 2 + hw;
            const int lb = id < 1 ? 0 : (id < 3 ? 1 : (id < 6 ? 2 : 3)), sb = id - (lb * (lb + 1)) / 2;
            pg8::f32x4 acc = (pg8::f32x4){0.f, 0.f, 0.f, 0.f};
#pragma unroll
            for (int ks = 0; ks < 2; ++ks) acc = MFMA16(ldfrag(lds + GP_KN, 16 * lb + fr, 32 * ks + 8 * fq), ldfrag(lds + GP_KN, 16 * sb + fr, 32 * ks + 8 * fq), acc);
            const int s = 16 * sb + fr; const float gsv = Gs[s];
#pragma unroll
            for (int r = 0; r < 4; ++r) { const int l = 16 * lb + 4 * fq + r; AF[l * APT + s] = s < l ? Bs[l] * acc[r] * __expf(Gs[l] - gsv) : 0.f; } }
        LBAR();
#pragma unroll
        for (int l = 1; l < 64; ++l) { float a = x[l];
#pragma unroll
            for (int s4 = 0; s4 < l; s4 += 4) { const pg8::f32x4 av = *(const LAS pg8::f32x4*)(AF + l * APT + s4);
                a -= av[0] * x[s4];
                if (s4 + 1 < l) a -= av[1] * x[s4 + 1];
                if (s4 + 2 < l) a -= av[2] * x[s4 + 2];
                if (s4 + 3 < l) a -= av[3] * x[s4 + 3]; }
            x[l] = a; asm volatile("" ::: "memory"); }
        LBAR();
#pragma unroll
        for (int t = 0; t < 64; ++t) *(LAS bf16*)(OV + hw * 8192 + t * 128 + lane * 2) = (bf16)f2bf(x[t]);
        LBAR();
        if (live) for (int i = j; i < 64 * 8; i += 128) { const int t = i >> 3, ch = i & 7;
            *(GAS v4u*)(MIX + (tok0 + t) * MIX_LD + MX_AV + h * 64 + ch * 8) = *(const LAS v4u*)(OV + t * 128 + ch * 16);
            *(GAS v4u*)(GW + (tok0 + t) * 512 + h * 64 + ch * 8) = *(const LAS v4u*)(OV + 8192 + t * 128 + ch * 16); }
        LBAR();
        for (int i = j; i < 67 * 8; i += 128) { const int r = i >> 3, ch = i & 7; v4u vq = (v4u){0u, 0u, 0u, 0u};
            if (r >= 3) vq = *(const GAS v4u*)(MIX + (tok0 + r - 3) * MIX_LD + MX_AQ + h * 64 + ch * 8);
            else if (c > 0) vq = *(const GAS v4u*)(HALO + ((size_t)(b * 64 + c - 1) * 3 + r) * HALO_LD + MX_AQ + h * 64 + ch * 8);
            *(LAS v4u*)(OV + r * 128 + ch * 16) = vq; }
        LBAR();
        if (hw == 0) { const int colQ = MX_AQ + h * 64 + lane;
            const float w0 = cw[colQ], w1 = cw[1536 + colQ], w2 = cw[2 * 1536 + colQ], w3 = cw[3 * 1536 + colQ];
            const LAS bf16* rp = (const LAS bf16*)OV + lane;
            float h0 = bf2f(rp[0]), h1 = bf2f(rp[64]), h2 = bf2f(rp[128]);
#pragma unroll
            for (int t = 0; t < 64; ++t) { const float xr = bf2f(rp[(t + 3) * 64]); x[t] = siluf(w0 * h0 + w1 * h1 + w2 * h2 + w3 * xr); h0 = h1; h1 = h2; h2 = xr; } }
        LBAR();
        if (hw == 0) {
#pragma unroll
            for (int t = 0; t < 64; ++t) FF[t * FPT + lane] = x[t]; }
        LBAR();
        if (hw == 0) { float s = 0.f;
#pragma unroll
            for (int d = 0; d < 64; ++d) { const float v = FF[lane * FPT + d]; s += v * v; }
            Rn[lane] = rsqrtf(s + 1e-6f) * 0.125f; }
        LBAR();
        if (hw == 0) {
#pragma unroll
            for (int t = 0; t < 64; ++t) *(LAS bf16*)(lds + GP_KN + t * (PT * 2) + lane * 2) = (bf16)f2bf(x[t] * Rn[t]); }
        LBAR();
        if (live) for (int i = j; i < 64 * 8; i += 128) { const int t = i >> 3, ch = i & 7; *(GAS v4u*)(MIX + (tok0 + t) * MIX_LD + MX_AQ + h * 64 + ch * 8) = *(const LAS v4u*)(lds + GP_KN + t * (PT * 2) + ch * 16); }
        LBAR();
    }
}
#ifndef MK_ONE_LAUNCH
#define MK_ONE_LAUNCH 1
#endif
#ifndef MK_NAIVE
#define MK_NAIVE 0
#endif
__global__ void __launch_bounds__(64) mixers_naive(Args args, int layer) {
    const int lane = threadIdx.x, w = blockIdx.x, kind = w >> 6, b = (w & 63) >> 3, h = w & 7;
    unsigned char* ws = args.ws;
    bf16* ZB = (bf16*)(ws + WS_ZB); const bf16* MIX = (const bf16*)(ws + WS_MIX); float* SM = (float*)(ws + WS_SM); const float* ROPE = (const float*)(ws + WS_ROPE);
    if (kind == 0) gdn_naive(args, layer, b, h, lane, MIX, SM, ZB);
    else if (kind == 1) ssd_naive(args, layer, b, h, lane, MIX, SM, ZB);
    else ret_naive(b, h, lane, MIX, ROPE, ZB);
}
__global__ void __launch_bounds__(512, 2) fwd_kernel(Args args) {
    extern __shared__ __attribute__((aligned(16))) unsigned char lds_raw[];
    LAS unsigned char* lds = (LAS unsigned char*)lds_raw;
    volatile LAS unsigned* MISC = (volatile LAS unsigned*)(lds + MISC_OFF);
    const int G = gridDim.x, NGW = G * 8;
    unsigned char* ws0 = args.ws;
    for (int u = threadIdx.x; u < (LDS_BYTES - RING_BYTES) / 4; u += 512) ((LAS unsigned*)(lds + RING_BYTES))[u] = 0u;
    __syncthreads();
#if MK_ONE_LAUNCH
    XcdBarrier bar = xcd_barrier_post((unsigned*)(ws0 + WS_CTL) + 4096, MISC + 8);
#define GRID_BAR() do { XcdBarrier b_ = bar; asm volatile("" : "+s"(b_.bar), "+s"(b_.x)); xcd_barrier(b_); } while (0)
#else
#define GRID_BAR() do {} while (0)
#endif
    const int lo = args.ph_lo, hi = args.ph_hi;
#define IN(p) (lo <= (p) && (p) < hi)
#define SEAM(p) do { if (IN(p) && IN((p) + 1)) GRID_BAR(); } while (0)
    typedef const __attribute__((address_space(4))) Args* KArgs;
    const KArgs kp0 = (KArgs)__builtin_amdgcn_kernarg_segment_ptr();
#define PHASE_PTRS() KArgs kp = kp0; asm volatile("" : "+s"(kp)); unsigned char* ws = kp->ws; float* X = kp->out; (void)X; \
    int tid = threadIdx.x; asm volatile("" : "+v"(tid)); int bx = blockIdx.x; asm volatile("" : "+s"(bx)); const int lane = tid & 63, wave = __builtin_amdgcn_readfirstlane(tid >> 6), gw = bx * 8 + wave; (void)lane; (void)gw; \
    bf16* ZB = (bf16*)(ws + WS_ZB); bf16* MIX = (bf16*)(ws + WS_MIX); float* SM = (float*)(ws + WS_SM); (void)ZB; (void)MIX; (void)SM; \
    float* SSQA = (float*)(ws + WS_SSQA); float* SSQB = (float*)(ws + WS_SSQB); float* SSQC = (float*)(ws + WS_SSQC); float* ROPE = (float*)(ws + WS_ROPE); (void)SSQA; (void)SSQB; (void)SSQC; (void)ROPE; \
    bf16* W1T = (bf16*)(ws + W_1T); bf16* WGT = (bf16*)(ws + W_GT); bf16* WMT = (bf16*)(ws + W_MT); bf16* WOT = (bf16*)(ws + W_OT); bf16* WUT = (bf16*)(ws + W_UT); (void)W1T; (void)WGT; (void)WMT; (void)WOT; (void)WUT; \
    bf16* WDT = (bf16*)(ws + W_DT); bf16* WPGT = (bf16*)(ws + W_PGT); bf16* WPPT = (bf16*)(ws + W_PPT); (void)WDT; (void)WPGT; (void)WPPT; \
    bf16* GATE = (bf16*)(ws + WS_GATE); bf16* U = (bf16*)(ws + WS_U); bf16* PB = (bf16*)(ws + WS_PB); bf16* PLE = (bf16*)(ws + WS_PLE); (void)GATE; (void)U; (void)PB; (void)PLE; \
    bf16* XBl = (bf16*)(ws + ((layer & 1) ? WS_XB1 : WS_XB0)); bf16* XBf = (bf16*)(ws + ((layer & 1) ? WS_XB0 : WS_XB1)); (void)XBl; (void)XBf
    if (IN(0)) { const int layer = 0; PHASE_PTRS();
        for (int e = bx * 512 + tid; e < SEQ * 32; e += G * 512) { const int t = e >> 5, i = e & 31;
            double f = 1.0; for (int j = 0; j < i; ++j) f *= 0.7429639507594948;
            const double ang = (double)t * f, kk = rint(ang * 0.15915494309189535);
            double r = fma(-kk, 6.283185307179586, ang); r = fma(-kk, 2.4492935982947064e-16, r); const double r2 = r * r;
            double sn = 1.0, cs = 1.0;
    #pragma unroll
            for (int n = 15; n >= 1; --n) { sn = 1.0 - r2 * (1.0 / (double)((2 * n) * (2 * n + 1))) * sn; cs = 1.0 - r2 * (1.0 / (double)((2 * n - 1) * (2 * n))) * cs; }
            ROPE[e] = (float)cs; ROPE[SEQ * 32 + e] = (float)(r * sn); }
    }
    for (int layer = 0; layer < DEPTH; ++layer) {
        const int P = layer * NPH;
        if (IN(P + 0)) { PHASE_PTRS();
            int ibase = 0;
            const float* w_in = kp->in[3] + (size_t)layer * DM * NIN; const float* nmix = kp->in[2] + (size_t)layer * DM;
            TR_SEG(w_in, NIN, 1536, 512, DM, nmix, W1T, DM, 0, 0);
            TR_SEG(w_in, NIN, 2064, 512, DM, nmix, W1T, DM, 512, 0);
            TR_SEG(w_in, NIN, 4888, 512, DM, nmix, W1T, DM, 1024, 0);
            TR_SEG(w_in, NIN, 0, 1536, DM, nmix, W1T, DM, 1536, 0);
            TR_SEG(w_in, NIN, 2576, 768, DM, nmix, W1T, DM, 3072, 0);
            TR_SEG(w_in, NIN, 3352, 1536, DM, nmix, W1T, DM, 3840, 0);
            TR_SEG(w_in, NIN, 2048, 16, DM, nmix, W1T, DM, 5376, 0);
            TR_SEG(w_in, NIN, 3344, 8, DM, nmix, W1T, DM, 5392, 0);
            TR_SEG((const float*)nullptr, NIN, 0, 232, DM, (const float*)nullptr, W1T, DM, 5400, 0);
            TR_SEG(w_in, NIN, 5400, 3072, DM, nmix, WGT, DM, 0, 0);
            const float* wbr = kp->in[14] + (size_t)layer * 3 * 512 * DM;
            TR_SEG(wbr, DM, 0, DM, 512, (const float*)nullptr, WMT, KMERGE, 0, 0);
            TR_SEG(wbr + 512 * DM, DM, 0, DM, 512, kp->in[13] + (size_t)layer * 512, WMT, KMERGE, 0, 512);
            TR_SEG(wbr + 2 * 512 * DM, DM, 0, DM, 512, (const float*)nullptr, WMT, KMERGE, 0, 1024);
            TR_SEG(kp->in[15] + (size_t)layer * DM * DM, DM, 0, DM, DM, (const float*)nullptr, WOT, DM, 0, 0);
            TR_SEG(kp->in[17] + (size_t)layer * DM * DFF, DFF, 0, DFF, DM, kp->in[16] + (size_t)layer * DM, WUT, DM, 0, 0);
            TR_SEG(kp->in[18] + (size_t)layer * DFF * DM, DM, 0, DM, DFF, (const float*)nullptr, WDT, DFF, 0, 0);
            TR_SEG(kp->in[20] + (size_t)layer * DM * DM, DM, 0, DM, DM, kp->in[19] + (size_t)layer * DM, WPGT, DM, 0, 0);
            TR_SEG(kp->in[21] + (size_t)layer * PLED * DM, DM, 0, DM, PLED, (const float*)nullptr, WPPT, PLED, 0, 0);
            if (layer == 0) {
                const float* xin = kp->in[0];
                for (int m = gw; m < MTOK; m += NGW) {
                    const GAS f32x4* xr = (const GAS f32x4*)(xin + (size_t)m * DM) + lane; f32x4 v[4]; float s = 0.f;
#pragma unroll
                    for (int j = 0; j < 4; ++j) { v[j] = xr[64 * j]; s += (v[j].x * v[j].x + v[j].y * v[j].y) + (v[j].z * v[j].z + v[j].w * v[j].w); }
                    s = wave_sum(s);
                    GAS v2u* o8 = (GAS v2u*)(XBl + (size_t)m * DM) + lane;
#pragma unroll
                    for (int j = 0; j < 4; ++j) { v2u w; w.x = pk2(v[j].x, v[j].y); w.y = pk2(v[j].z, v[j].w); o8[64 * j] = w; }
                    if (lane < 16) SSQC[(size_t)m * 16 + lane] = lane == 0 ? s : 0.f;
                }
            }
        }
        SEAM(P + 0);
        if (IN(P + 1)) { PHASE_PTRS();
            pg8::Gemm g{XBl, W1T, MTOK, N1, DM}; pg8::StaticOrder S; S.init(MTOK, N1, G, bx);
            pg8::EpiP1 E{ZB, MIX, SM, SSQC, (bf16*)((unsigned char*)XBf + HALO_OFF)};
            pg8::gemm_phase<pg8::EpiP1, pg8::StaticOrder, true, true>(lds, g, S, E);
        }
        SEAM(P + 1);
        if (IN(P + 2)) { PHASE_PTRS();
#if !MK_NAIVE
            gdn_prep(kp, layer, lds, G);
            ssd_prep(kp, layer, lds, G);
            ret_prep(kp, G);
#endif
        }
        SEAM(P + 2);
        if (IN(P + 3)) { PHASE_PTRS();
#if !MK_NAIVE
            for (int w = bx; w < 192; w += G) { const int kind = w >> 6, b = (w & 63) >> 3, h = w & 7;
                if (kind == 0) mixer_walk<0>(kp, layer, b, h, lds);
                else if (kind == 1) mixer_walk<1>(kp, layer, b, h, lds);
                else mixer_walk<2>(kp, layer, b, h, lds);
                __syncthreads(); }
#endif
        }
        SEAM(P + 3);
        if (IN(P + 4)) { PHASE_PTRS();
            for (int m = gw; m < MTOK; m += NGW) {
                GAS v4u* yp = (GAS v4u*)(ZB + (size_t)m * ZB_LD + 512) + lane; const v4u w = *yp;
                const f32x4 sq = *(const f32x4*)(SM + (size_t)m * SM_LD + 16 + 4 * (lane >> 5));
                const float rstd = rsqrtf(((sq[0] + sq[1]) + (sq[2] + sq[3])) * (1.0f / 256.0f) + 1e-6f);
                v4u o; o.x = pk2(pg8::bflo(w.x) * rstd, pg8::bfhi(w.x) * rstd); o.y = pk2(pg8::bflo(w.y) * rstd, pg8::bfhi(w.y) * rstd);
                o.z = pk2(pg8::bflo(w.z) * rstd, pg8::bfhi(w.z) * rstd); o.w = pk2(pg8::bflo(w.w) * rstd, pg8::bfhi(w.w) * rstd);
                *yp = o;
            }
            pg8::Gemm g{XBl, WGT, MTOK, NGATE, DM}; pg8::StaticOrder S; S.init(MTOK, NGATE, G, bx);
            pg8::EpiRS<2> E{GATE, NGATE, SSQC};
            pg8::gemm_phase<pg8::EpiRS<2>, pg8::StaticOrder, true, true>(lds, g, S, E);
        }
        SEAM(P + 4);
        if (IN(P + 5)) { PHASE_PTRS();
            pg8::Gemm g{ZB, WMT, MTOK, DM, KMERGE}; pg8::StaticOrder S; S.init(MTOK, DM, G, bx);
            pg8::EpiMerge E{GATE, XBf};
            pg8::gemm_phase<pg8::EpiMerge, pg8::StaticOrder, true, true>(lds, g, S, E);
        }
        SEAM(P + 5);
        if (IN(P + 6)) { PHASE_PTRS();
            const float* pl = kp->in[1] + (size_t)layer * MTOK * PLED;
            for (size_t e = (size_t)bx * 512 + tid; e < (size_t)MTOK * PLED / 4; e += (size_t)G * 512) { const f32x4 v = ((const GAS f32x4*)pl)[e]; v2u w; w.x = pk2(v.x, v.y); w.y = pk2(v.z, v.w); ((GAS v2u*)PB)[e] = w; }
            pg8::Gemm g{XBf, WOT, MTOK, DM, DM}; pg8::StaticOrder S; S.init(MTOK, DM, G, bx);
            pg8::EpiResid<0> E{layer == 0 ? kp->in[0] : X, X, XBl, SSQA, nullptr, nullptr,  1.0f};
            pg8::gemm_phase<pg8::EpiResid<0>, pg8::StaticOrder, true, true>(lds, g, S, E);
        }
        SEAM(P + 6);
        if (IN(P + 7)) { PHASE_PTRS();
            { pg8::Gemm g{XBl, WUT, MTOK, DFF, DM}; pg8::StaticOrder S; S.init(MTOK, DFF, G, bx);
              pg8::EpiRS<1> E{U, DFF, SSQA};
              pg8::gemm_phase<pg8::EpiRS<1>, pg8::StaticOrder, true, true>(lds, g, S, E); }
        }
        SEAM(P + 7);
        if (IN(P + 8)) { PHASE_PTRS();
            pg8::Gemm g{U, WDT, MTOK, DM, DFF}; pg8::StaticOrder S; S.init(MTOK, DM, G, bx);
            pg8::EpiResid<0> E{X, X, XBl, SSQB, nullptr, nullptr,  1.0f};
            pg8::gemm_phase<pg8::EpiResid<0>, pg8::StaticOrder, true, true>(lds, g, S, E);
            __builtin_amdgcn_sched_barrier(0);
            { pg8::Gemm g{PB, WPPT, MTOK, DM, PLED}; pg8::StaticOrder S; S.init(MTOK, DM, G, bx);
              pg8::EpiRS<0> E{PLE, DM, nullptr};
              pg8::gemm_phase<pg8::EpiRS<0>, pg8::StaticOrder, true, true>(lds, g, S, E); }
        }
        SEAM(P + 8);
        if (IN(P + 9)) { PHASE_PTRS();
            pg8::Gemm g{XBl, WPGT, MTOK, DM, DM}; pg8::StaticOrder S; S.init(MTOK, DM, G, bx);
            pg8::EpiResid<1> E{X, X, XBf, SSQC, SSQB, PLE,  1.0f};
            pg8::gemm_phase<pg8::EpiResid<1>, pg8::StaticOrder, true, true>(lds, g, S, E);
        }
        SEAM(P + 9);
    }
    if (IN(PH_FINAL)) { const int layer = 0; PHASE_PTRS();
        const float* nf = kp->in[22];
        for (int m = gw; m < MTOK; m += NGW) {
            const float sp = lane < 16 ? SSQC[(size_t)m * 16 + lane] : 0.f;
            const float rstd = rsqrtf(wave_sum(sp) * (1.0f / 1024.0f) + 1e-6f);
            GAS f32x4* xr = (GAS f32x4*)(X + (size_t)m * DM) + lane;
#pragma unroll
            for (int j = 0; j < 4; ++j) { const f32x4 v = xr[64 * j], w = ((const GAS f32x4*)nf)[64 * j + lane]; xr[64 * j] = v * rstd * w; }
        }
    }
#undef IN
#undef SEAM
}

extern "C" void kernel_launch(void* const* d_in, const int* in_sizes, int n_in, void* d_out, int out_size, void* d_ws, size_t ws_size, hipStream_t stream) {
    static int grid = 0;
    if (grid == 0) {
        if (n_in != 23 || out_size != MTOK * DM || ws_size < WS_END) { fprintf(stderr, "kernel_launch: unexpected problem (n_in %d, out %d, ws %zu < %zu)\n", n_in, out_size, ws_size, (size_t)WS_END); grid = -1; return; }
        int dev = 0, cus = 0;
        if (hipGetDevice(&dev) != hipSuccess || hipDeviceGetAttribute(&cus, hipDeviceAttributeMultiprocessorCount, dev) != hipSuccess) { grid = -1; return; }
        if (hipFuncSetAttribute((const void*)fwd_kernel, hipFuncAttributeMaxDynamicSharedMemorySize, LDS_BYTES) != hipSuccess) { fprintf(stderr, "kernel_launch: hipFuncSetAttribute failed\n"); grid = -1; return; }
        int per_cu = 0;
        if (hipOccupancyMaxActiveBlocksPerMultiprocessor(&per_cu, (const void*)fwd_kernel, 512, LDS_BYTES) != hipSuccess || per_cu < 1) { fprintf(stderr, "kernel_launch: occupancy query says %d blocks per CU\n", per_cu); }
        (void)hipGetLastError();
        grid = cus;
    }
    if (grid < 0) return;
    (void)hipMemsetAsync((char*)d_ws + WS_CTL, 0, CTL_BYTES, stream);
    Args a; memset(&a, 0, sizeof(a));
    for (int i = 0; i < 23; ++i) a.in[i] = (const float*)d_in[i];
    a.out = (float*)d_out; a.ws = (unsigned char*)d_ws;
#if MK_ONE_LAUNCH
    a.ph_lo = 0; a.ph_hi = N_PHASES;
    hipLaunchKernelGGL(fwd_kernel, dim3(grid), dim3(512), LDS_BYTES, stream, a);
#else
    for (int p = 0; p < N_PHASES; ++p) {
#if MK_NAIVE
        if (p != PH_FINAL && (p % NPH) == 3) { hipLaunchKernelGGL(mixers_naive, dim3(192), dim3(64), 0, stream, a, p / NPH); continue; }
#endif
        a.ph_lo = p; a.ph_hi = p + 1;
        hipLaunchKernelGGL(fwd_kernel, dim3(grid), dim3(512), LDS_BYTES, stream, a);
    }
#endif
}
```

```cpp
#include <hip/hip_runtime.h>
#include <cstdio>
#include <cstdint>
#include <cstring>
namespace pg8 {
#define PG8_LAS __attribute__((address_space(3)))
typedef unsigned short bf16_t;
typedef short bf16x8 __attribute__((ext_vector_type(8)));
typedef float f32x4 __attribute__((ext_vector_type(4)));
typedef unsigned u32x4 __attribute__((ext_vector_type(4)));
constexpr int BM = 256, BK = 64, HALF = 128, HTB = HALF * BK * 2  , STAGE_BYTES = 8 * HTB, NXCD = 8, WGM = 8;

__host__ __device__ __forceinline__ int lds_byte(int r, int c) { const int st = (r >> 4) * 2 + (c >> 5), rr = r & 15, cc = c & 31, ob = rr * 64 + cc * 2; return st * 1024 + (ob ^ (((ob >> 9) & 1) << 5)); }
__host__ __device__ __forceinline__ void stage_rc(int b, int& R, int& C) { const int st = b / 1024, sb = b % 1024, swz = sb ^ (((sb >> 9) & 1) << 5); R = (st >> 1) * 16 + swz / 64; C = (st & 1) * 32 + (swz % 64) / 2; }
__host__ __device__ __forceinline__ int perm32(int rho) { const int n = rho >> 4, i = rho & 15; return 8 * (i >> 2) + 4 * n + (i & 3); }

struct Unit { int pm, pn; };
struct Gemm { const bf16_t* A; const bf16_t* Bt; int M, N, K; };

struct StaticOrder {
    int nM, nN, nwg, G, c;
    __host__ __device__ void init(int M, int N, int G_, int c_) { nM = M / BM; nN = N / BM; nwg = nM * nN; G = G_; c = c_; }
    __host__ __device__ bool next(int i, Unit& u) const {
        const long L = (long)i * G + c; if (L >= nwg) return false;
        int wgid = (int)L; { const int q = nwg / NXCD, r = nwg % NXCD, xcd = wgid % NXCD, off = wgid / NXCD; wgid = (xcd < r ? xcd * (q + 1) : r * (q + 1) + (xcd - r) * q) + off; }
        const int nig = WGM * nN, gid = wgid / nig, fm = gid * WGM, gsz = (nM - fm) < WGM ? (nM - fm) : WGM;
        u.pm = fm + ((wgid % nig) % gsz); u.pn = (wgid % nig) / gsz; return true;
    }
    __device__ __forceinline__ void a_ready(const Unit&) const {}
    __device__ __forceinline__ void done(const Unit&) const {}
};

typedef float f32x2c __attribute__((ext_vector_type(2))); typedef __bf16 bf16x2c __attribute__((ext_vector_type(2)));
__device__ __forceinline__ unsigned cvt_pk_bf16(float lo, float hi) { const f32x2c v = {lo, hi}; const bf16x2c b = __builtin_convertvector(v, bf16x2c); return __builtin_bit_cast(unsigned, b); }
typedef unsigned u32x2 __attribute__((ext_vector_type(2)));
__device__ __forceinline__ float bflo(unsigned w) { return __uint_as_float(w << 16); }
__device__ __forceinline__ float bfhi(unsigned w) { return __uint_as_float(w & 0xffff0000u); }
__device__ __forceinline__ u32x4 pack8(const f32x4 v0, const f32x4 v1) { u32x4 w; w.x = cvt_pk_bf16(v0[0], v0[1]); w.y = cvt_pk_bf16(v0[2], v0[3]); w.z = cvt_pk_bf16(v1[0], v1[1]); w.w = cvt_pk_bf16(v1[2], v1[3]); return w; }
__device__ __forceinline__ void unpack8(const u32x4 w, f32x4& v0, f32x4& v1) { v0 = (f32x4){bflo(w.x), bfhi(w.x), bflo(w.y), bfhi(w.y)}; v1 = (f32x4){bflo(w.z), bfhi(w.z), bflo(w.w), bfhi(w.w)}; }
constexpr float RMS_EPS = 1e-6f;
__device__ __forceinline__ void load_rstd(const float* ssqp, int row0, int fq, float (&rs)[2][4]) {
#pragma unroll
    for (int ai = 0; ai < 2; ++ai)
#pragma unroll
        for (int m = 0; m < 4; ++m) {
            if (ssqp) { const f32x4 p = *(const f32x4*)(ssqp + (size_t)(row0 + ai * HALF + m * 16) * 16 + 4 * fq); float s = (p[0] + p[1]) + (p[2] + p[3]);
                s += __shfl_xor(s, 16); s += __shfl_xor(s, 32); rs[ai][m] = rsqrtf(s * (1.0f / 1024.0f) + RMS_EPS); }
            else rs[ai][m] = 1.0f;
        }
}
struct EpiP1 {
    static constexpr bool PERM = true, AFTER_DRAIN = false, HOOK = false; static constexpr int SEG1 = -1, SEG2 = -1;
    bf16_t* ZB; bf16_t* MIX; float* SM; const float* ssqp; bf16_t* HALO;
    __device__ __forceinline__ void rescale(f32x4 (&)[2][2][4][2], const Unit&, int, int, int, int, int) const {}
    __device__ __forceinline__ void operator()(const f32x4 (&acc)[2][2][4][2], const Unit& u, int wr, int wc, int fr, int fq) const {
        const int row0 = u.pm * BM + wr * 64 + fr;
        float rs[2][4]; load_rstd(ssqp, row0, fq, rs);
        if (u.pn == 21) {
            if (wc == 0) {
#pragma unroll
                for (int ai = 0; ai < 2; ++ai)
#pragma unroll
                    for (int m = 0; m < 4; ++m) { float* p = SM + (size_t)(row0 + ai * HALF + m * 16) * 32 + 8 * fq;
                        *(f32x4*)p = acc[ai][0][m][0] * rs[ai][m]; *(f32x4*)(p + 4) = acc[ai][0][m][1] * rs[ai][m]; }
            }
            return;
        }
        bf16_t* base; int ldc, colt;
        if (u.pn < 6) { base = ZB; ldc = 1536; colt = u.pn * BM; } else { base = MIX; ldc = 3840; colt = (u.pn - 6) * BM; }
        const int col0 = colt + wc * 32 + 8 * fq;
#pragma unroll
        for (int ai = 0; ai < 2; ++ai)
#pragma unroll
            for (int m = 0; m < 4; ++m) { bf16_t* rowp = base + (size_t)(row0 + ai * HALF + m * 16) * ldc + col0;
#pragma unroll
                for (int bj = 0; bj < 2; ++bj) { const u32x4 w = pack8(acc[ai][bj][m][0] * rs[ai][m], acc[ai][bj][m][1] * rs[ai][m]); *(u32x4*)(rowp + bj * HALF) = w;
                    if (m == 3 && fr >= 13 && u.pn >= 6 && u.pn < 15) *(u32x4*)(HALO + ((size_t)((row0 + ai * HALF + m * 16) >> 6) * 3 + (fr - 13)) * 2304 + col0 + bj * HALF) = w; } }
    }
};
template <int ACT> struct EpiRS {
    static constexpr bool PERM = true, AFTER_DRAIN = false, HOOK = false; static constexpr int SEG1 = -1, SEG2 = -1;
    bf16_t* O; int ldc; const float* ssqp;
    __device__ __forceinline__ void rescale(f32x4 (&)[2][2][4][2], const Unit&, int, int, int, int, int) const {}
    __device__ __forceinline__ void operator()(const f32x4 (&acc)[2][2][4][2], const Unit& u, int wr, int wc, int fr, int fq) const {
        const int row0 = u.pm * BM + wr * 64 + fr, col0 = u.pn * BM + wc * 32 + 8 * fq;
        float rs[2][4]; load_rstd(ssqp, row0, fq, rs);
#pragma unroll
        for (int ai = 0; ai < 2; ++ai)
#pragma unroll
            for (int m = 0; m < 4; ++m) { bf16_t* rowp = O + (size_t)(row0 + ai * HALF + m * 16) * ldc + col0;
#pragma unroll
                for (int bj = 0; bj < 2; ++bj) { f32x4 v0 = acc[ai][bj][m][0] * rs[ai][m], v1 = acc[ai][bj][m][1] * rs[ai][m];
                    if (ACT == 1) {
#pragma unroll
                        for (int j = 0; j < 4; ++j) { const float a = fmaxf(v0[j], 0.f), b = fmaxf(v1[j], 0.f); v0[j] = a * a; v1[j] = b * b; } }
                    if (ACT == 2) {
#pragma unroll
                        for (int j = 0; j < 4; ++j) { v0[j] = __builtin_amdgcn_rcpf(1.0f + __expf(-v0[j])); v1[j] = __builtin_amdgcn_rcpf(1.0f + __expf(-v1[j])); } }
                    *(u32x4*)(rowp + bj * HALF) = pack8(v0, v1); } }
    }
};
struct EpiMerge {
    static constexpr bool PERM = true, AFTER_DRAIN = false, HOOK = true; static constexpr int SEG1 = 8, SEG2 = 16;
    const bf16_t* GATE; bf16_t* O;
    __device__ __forceinline__ void rescale(f32x4 (&acc)[2][2][4][2], const Unit& u, int seg, int wr, int wc, int, int) const {
        int t_ = threadIdx.x; asm volatile("" : "+v"(t_)); const int fr = t_ & 15, fq = (t_ & 63) >> 4;
        const int row0 = u.pm * BM + wr * 64 + fr, col0 = u.pn * BM + wc * 32 + 8 * fq + (seg - 1) * 1024;
#pragma unroll
        for (int ai = 0; ai < 2; ++ai)
#pragma unroll
            for (int m = 0; m < 4; ++m) { const bf16_t* gp = GATE + (size_t)(row0 + ai * HALF + m * 16) * 3072 + col0;
#pragma unroll
                for (int bj = 0; bj < 2; ++bj) { const u32x4 wa = *(const u32x4*)(gp + bj * HALF), wb = *(const u32x4*)(gp + bj * HALF + 1024);
                    f32x4 a0, a1, b0, b1; unpack8(wa, a0, a1); unpack8(wb, b0, b1);
#pragma unroll
                    for (int j = 0; j < 4; ++j) {
                        acc[ai][bj][m][0][j] *= a0[j] * __builtin_amdgcn_rcpf(b0[j]);
                        acc[ai][bj][m][1][j] *= a1[j] * __builtin_amdgcn_rcpf(b1[j]); } }
                if (m == 3) asm volatile("" ::: "memory"); }
    }
    __device__ __forceinline__ void operator()(const f32x4 (&acc)[2][2][4][2], const Unit& u, int wr, int wc, int fr, int fq) const {
        const int row0 = u.pm * BM + wr * 64 + fr, col0 = u.pn * BM + wc * 32 + 8 * fq;
#pragma unroll
        for (int ai = 0; ai < 2; ++ai)
#pragma unroll
            for (int m = 0; m < 4; ++m) { const size_t r = (size_t)(row0 + ai * HALF + m * 16);
#pragma unroll
                for (int bj = 0; bj < 2; ++bj) { const u32x4 wa = *(const u32x4*)(GATE + r * 3072 + 2048 + col0 + bj * HALF);
                    f32x4 a0, a1; unpack8(wa, a0, a1); f32x4 v0 = acc[ai][bj][m][0], v1 = acc[ai][bj][m][1];
#pragma unroll
                    for (int j = 0; j < 4; ++j) { v0[j] *= a0[j]; v1[j] *= a1[j]; }
                    *(u32x4*)(O + r * 1024 + col0 + bj * HALF) = pack8(v0, v1); }
                if (m == 3) asm volatile("" ::: "memory"); }
    }
};
template <int MODE> struct EpiResid {
    static constexpr bool PERM = true, AFTER_DRAIN = false, HOOK = false; static constexpr int SEG1 = -1, SEG2 = -1;
    const float* base; float* X; bf16_t* XB; float* ssq_out; const float* ssq_in; const bf16_t* PLE; float scale;
    __device__ __forceinline__ void rescale(f32x4 (&)[2][2][4][2], const Unit&, int, int, int, int, int) const {}
    __device__ __forceinline__ void operator()(const f32x4 (&acc)[2][2][4][2], const Unit& u, int wr, int wc, int fr, int fq) const {
        const int row0 = u.pm * BM + wr * 64 + fr, col0 = u.pn * BM + wc * 32 + 8 * fq;
        float rs[2][4]; if (MODE == 1) load_rstd(ssq_in, row0, fq, rs);
#pragma unroll
        for (int ai = 0; ai < 2; ++ai)
#pragma unroll
            for (int m = 0; m < 4; ++m) { const size_t r = (size_t)(row0 + ai * HALF + m * 16); float ss = 0.f;
#pragma unroll
                for (int bj = 0; bj < 2; ++bj) { const size_t o = r * 1024 + col0 + bj * HALF;
                    f32x4 v0 = acc[ai][bj][m][0], v1 = acc[ai][bj][m][1];
                    if (MODE == 1) { const u32x4 wp = *(const u32x4*)(PLE + o); f32x4 p0, p1; unpack8(wp, p0, p1);
#pragma unroll
                        for (int j = 0; j < 4; ++j) { v0[j] = p0[j] * __builtin_amdgcn_rcpf(1.0f + __expf(-v0[j] * rs[ai][m])); v1[j] = p1[j] * __builtin_amdgcn_rcpf(1.0f + __expf(-v1[j] * rs[ai][m])); } }
                    v0 = v0 * scale + *(const f32x4*)(base + o); v1 = v1 * scale + *(const f32x4*)(base + o + 4);
                    *(f32x4*)(X + o) = v0; *(f32x4*)(X + o + 4) = v1; *(u32x4*)(XB + o) = pack8(v0, v1);
                    ss += (v0[0] * v0[0] + v0[1] * v0[1]) + (v0[2] * v0[2] + v0[3] * v0[3]) + (v1[0] * v1[0] + v1[1] * v1[1]) + (v1[2] * v1[2] + v1[3] * v1[3]); }
                ss += __shfl_xor(ss, 16); ss += __shfl_xor(ss, 32);
                if (fq == 0) ssq_out[r * 16 + u.pn * 4 + wc] = ss;
                if (m & 1) asm volatile("" ::: "memory"); }
    }
};
template <class Epi, class Sched, bool ALIGN_EPI = false, bool SP2 = false>
__device__ __forceinline__ void gemm_phase(PG8_LAS unsigned char* lds, Gemm g, const Sched& S, const Epi& E) {
    asm volatile("" : "+s"(g.A), "+s"(g.Bt), "+s"(g.K));
    int tid_ = threadIdx.x; asm volatile("" : "+v"(tid_));
    const int tid = tid_, wid = __builtin_amdgcn_readfirstlane(tid >> 6), lane = tid & 63, wr = wid >> 2, wc = wid & 3, fr = lane & 15, fq = lane >> 4;
    const int K = g.K, nt = K / BK;
    unsigned voffA[2], voffB[2];
#pragma unroll
    for (int i = 0; i < 2; ++i) { int R, C; stage_rc(tid * 16 + i * 8192, R, C); const int Rb = Epi::PERM ? ((R & ~31) + perm32(R & 31)) : R;
        voffA[i] = (unsigned)(R * K + C) * 2u; voffB[i] = (unsigned)(Rb * K + C) * 2u; }
    const size_t kstep = (size_t)(BK * 2);
    const size_t hstep = (size_t)HALF * K * 2;
    const size_t tstep = 2 * hstep;
    const unsigned ldsw = (unsigned)wid * 1024u;
    const int aoff = lds_byte(wr * 64 + fr, fq * 8), boff = lds_byte(wc * 32 + fr, fq * 8);
#define PG8_SA(b, h) (((b) * 2 + (h)) * HTB)
#define PG8_SB(b, h) ((4 + (b) * 2 + (h)) * HTB)
#define PG8_STAGE(bufoff, gbase, voff) do { _Pragma("unroll") for (int _i = 0; _i < 2; ++_i) \
        __builtin_amdgcn_global_load_lds((const unsigned*)((const char*)(gbase) + (voff)[_i]), (PG8_LAS unsigned*)(lds + (bufoff) + ldsw + _i * 8192), 16, 0, 0); } while (0)
#define PG8_LDA(dst, b, h) do { _Pragma("unroll") for (int m = 0; m < 4; ++m) _Pragma("unroll") for (int k = 0; k < 2; ++k) dst[m][k] = *(const PG8_LAS bf16x8*)(lds + PG8_SA(b, h) + aoff + m * 2048 + k * 1024); } while (0)
#define PG8_LDB(dst, b, h) do { _Pragma("unroll") for (int n = 0; n < 2; ++n) _Pragma("unroll") for (int k = 0; k < 2; ++k) dst[n][k] = *(const PG8_LAS bf16x8*)(lds + PG8_SB(b, h) + boff + n * 2048 + k * 1024); } while (0)
#define PG8_MMA(ai, bj, At, Bt) do { __builtin_amdgcn_s_setprio(1); _Pragma("unroll") for (int m = 0; m < 4; ++m) _Pragma("unroll") for (int n = 0; n < 2; ++n) _Pragma("unroll") for (int k = 0; k < 2; ++k) \
        acc[ai][bj][m][n] = __builtin_amdgcn_mfma_f32_16x16x32_bf16(Bt[n][k], At[m][k], acc[ai][bj][m][n], 0, 0, 0); __builtin_amdgcn_s_setprio(0); } while (0)
#define PG8_WAIT_V(n) asm volatile("s_waitcnt vmcnt(" #n ")" ::: "memory")
#define PG8_WAIT_L(n) asm volatile("s_waitcnt lgkmcnt(" #n ")" ::: "memory")
#define PG8_BAR __builtin_amdgcn_s_barrier()
#define PG8_SCHED __builtin_amdgcn_sched_barrier(0)
    Unit cur, nxt; int ui = 0;
    if (!S.next(0, cur)) return;
    f32x4 acc[2][2][4][2];
#pragma unroll
    for (int a = 0; a < 2; ++a)
#pragma unroll
        for (int b = 0; b < 2; ++b)
#pragma unroll
            for (int m = 0; m < 4; ++m)
#pragma unroll
                for (int n = 0; n < 2; ++n) acc[a][b][m][n] = (f32x4){0.f, 0.f, 0.f, 0.f};
    bf16x8 At[4][2], B0[2][2], B1[2][2];
    const char* cA = (const char*)g.A + (size_t)cur.pm * tstep; const char* cB = (const char*)g.Bt + (size_t)cur.pn * tstep;
    S.a_ready(cur);
    if constexpr (SP2) {
        PG8_STAGE(PG8_SB(0, 0), cB, voffB); PG8_STAGE(PG8_SB(0, 1), cB + hstep, voffB); PG8_STAGE(PG8_SA(0, 0), cA, voffA); PG8_STAGE(PG8_SA(0, 1), cA + hstep, voffA);
        if (wr == 1) PG8_BAR;
        PG8_WAIT_V(2); PG8_BAR;
        PG8_STAGE(PG8_SB(1, 0), cB + kstep, voffB); PG8_STAGE(PG8_SA(1, 0), cA + kstep, voffA); PG8_STAGE(PG8_SB(1, 1), cB + hstep + kstep, voffB);
        PG8_WAIT_V(6); PG8_BAR;
    } else {
        PG8_STAGE(PG8_SB(0, 0), cB, voffB); PG8_STAGE(PG8_SA(0, 0), cA, voffA); PG8_STAGE(PG8_SB(0, 1), cB + hstep, voffB); PG8_STAGE(PG8_SA(0, 1), cA + hstep, voffA);
        if (wr == 1) PG8_BAR;
        PG8_WAIT_V(4); PG8_BAR;
        PG8_STAGE(PG8_SB(1, 0), cB + kstep, voffB); PG8_STAGE(PG8_SA(1, 0), cA + kstep, voffA); PG8_STAGE(PG8_SB(1, 1), cB + hstep + kstep, voffB);
        PG8_WAIT_V(6); PG8_BAR;
    }
    for (;;) {
        const bool has_next = S.next(ui + 1, nxt);
        const char* nA = has_next ? (const char*)g.A + (size_t)nxt.pm * tstep : cA; const char* nB = has_next ? (const char*)g.Bt + (size_t)nxt.pn * tstep : cB;
        for (int t = 0; t < nt; t += 2) {
            const bool last = (t == nt - 2);
            const char* a1 = cA + (size_t)(t + 1) * kstep;
            const char* a2 = last ? nA : cA + (size_t)(t + 2) * kstep; const char* b2 = last ? nB : cB + (size_t)(t + 2) * kstep;
            const char* a3 = a2 + kstep; const char* b3 = b2 + kstep;
            if (last && has_next) S.a_ready(nxt);
            if constexpr (Epi::HOOK) { if (t == Epi::SEG1 || t == Epi::SEG2) E.rescale(acc, cur, t == Epi::SEG1 ? 1 : 2, wr, wc, fr, fq); }
            if constexpr (SP2) {
            PG8_LDB(B0, 0, 0); PG8_LDB(B1, 0, 1); PG8_SCHED; PG8_LDA(At, 0, 0); PG8_STAGE(PG8_SA(1, 1), a1 + hstep, voffA);
            PG8_WAIT_V(8); PG8_WAIT_L(0); PG8_BAR; PG8_MMA(0, 0, At, B0); PG8_MMA(0, 1, At, B1); PG8_BAR; PG8_SCHED;
            PG8_LDA(At, 0, 1); PG8_STAGE(PG8_SB(0, 0), b2, voffB); PG8_STAGE(PG8_SB(0, 1), b2 + hstep, voffB); PG8_STAGE(PG8_SA(0, 0), a2, voffA);
            PG8_WAIT_V(8); PG8_WAIT_L(0); PG8_BAR; PG8_MMA(1, 0, At, B0); PG8_MMA(1, 1, At, B1); PG8_BAR; PG8_SCHED;
            PG8_LDB(B0, 1, 0); PG8_LDB(B1, 1, 1); PG8_SCHED; PG8_LDA(At, 1, 0); PG8_STAGE(PG8_SA(0, 1), a2 + hstep, voffA);
            PG8_WAIT_V(8); PG8_WAIT_L(0); PG8_BAR; PG8_MMA(0, 0, At, B0); PG8_MMA(0, 1, At, B1); PG8_BAR; PG8_SCHED;
            PG8_LDA(At, 1, 1); PG8_STAGE(PG8_SB(1, 0), b3, voffB); PG8_STAGE(PG8_SB(1, 1), b3 + hstep, voffB); PG8_STAGE(PG8_SA(1, 0), a3, voffA);
            PG8_WAIT_V(8); PG8_WAIT_L(0); PG8_BAR; PG8_MMA(1, 0, At, B0); PG8_MMA(1, 1, At, B1); PG8_BAR; PG8_SCHED;
            } else {
            PG8_LDB(B0, 0, 0); PG8_SCHED; PG8_LDA(At, 0, 0); PG8_STAGE(PG8_SA(1, 1), a1 + hstep, voffA);
            PG8_WAIT_L(8); PG8_BAR; PG8_WAIT_L(0); PG8_MMA(0, 0, At, B0); PG8_BAR; PG8_SCHED;
            PG8_LDB(B1, 0, 1); PG8_STAGE(PG8_SB(0, 0), b2, voffB);
            PG8_BAR; PG8_WAIT_L(0); PG8_MMA(0, 1, At, B1); PG8_BAR;
            PG8_LDA(At, 0, 1); PG8_STAGE(PG8_SA(0, 0), a2, voffA);
            PG8_BAR; PG8_WAIT_L(0); PG8_MMA(1, 0, At, B0); PG8_BAR; PG8_SCHED;
            PG8_STAGE(PG8_SB(0, 1), b2 + hstep, voffB);
            PG8_WAIT_V(6); PG8_BAR; PG8_MMA(1, 1, At, B1); PG8_BAR;
            PG8_LDB(B0, 1, 0); PG8_SCHED; PG8_LDA(At, 1, 0); PG8_STAGE(PG8_SA(0, 1), a2 + hstep, voffA);
            PG8_WAIT_L(8); PG8_BAR; PG8_WAIT_L(0); PG8_MMA(0, 0, At, B0); PG8_BAR; PG8_SCHED;
            PG8_LDB(B1, 1, 1); PG8_STAGE(PG8_SB(1, 0), b3, voffB);
            PG8_BAR; PG8_WAIT_L(0); PG8_MMA(0, 1, At, B1); PG8_BAR;
            PG8_LDA(At, 1, 1); PG8_STAGE(PG8_SA(1, 0), a3, voffA);
            PG8_BAR; PG8_WAIT_L(0); PG8_MMA(1, 0, At, B0); PG8_BAR; PG8_SCHED;
            PG8_STAGE(PG8_SB(1, 1), b3 + hstep, voffB);
            PG8_WAIT_V(6); PG8_BAR; PG8_MMA(1, 1, At, B1); PG8_BAR;
            }
        }
        if constexpr (ALIGN_EPI) { if (wr == 0) PG8_BAR; }
        if constexpr (!Epi::AFTER_DRAIN) { int t2_ = threadIdx.x; asm volatile("" : "+v"(t2_)); E(acc, cur, wr, wc, t2_ & 15, (t2_ & 63) >> 4); S.done(cur); }
        if (!has_next) break;
#pragma unroll
        for (int a = 0; a < 2; ++a)
#pragma unroll
            for (int b = 0; b < 2; ++b)
#pragma unroll
                for (int m = 0; m < 4; ++m)
#pragma unroll
                    for (int n = 0; n < 2; ++n) acc[a][b][m][n] = (f32x4){0.f, 0.f, 0.f, 0.f};
        cur = nxt; cA = nA; cB = nB; ++ui;
        if constexpr (ALIGN_EPI) { if (wr == 1) PG8_BAR; }
    }
    PG8_WAIT_V(0);
    if constexpr (!ALIGN_EPI) { if (wr == 0) PG8_BAR; }
    PG8_BAR;
    if constexpr (Epi::AFTER_DRAIN) { E.fused(acc, cur, wr, wc, fr, fq, lds, wid, lane); S.done(cur); }
#undef PG8_SA
#undef PG8_SB
#undef PG8_STAGE
#undef PG8_LDA
#undef PG8_LDB
#undef PG8_MMA
#undef PG8_WAIT_V
#undef PG8_WAIT_L
#undef PG8_BAR
#undef PG8_SCHED
}
}
constexpr int DM = 1024, NBATCH = 8, SEQ = 4096, MTOK = NBATCH * SEQ, DEPTH = 2, DFF = 4096, PLED = 256, NIN = 8472;
constexpr int ZB_LD = 1536, MIX_LD = 3840, SM_LD = 32, N1 = 5632, NGATE = 3072, KMERGE = 1536;
constexpr int MX_AQ = 0, MX_AK = 512, MX_AV = 1024, MX_BX = 1536, MX_BB = 2048, MX_BC = 2176, MX_CQ = 2304, MX_CK = 2816, MX_CV = 3328;
constexpr size_t KiB = 1024, MiB = 1024 * 1024;
constexpr size_t WS_CTL = 0, CTL_BYTES = 64 * KiB;
constexpr size_t WS_W = 64 * KiB;
constexpr size_t W_1T = WS_W, W_GT = W_1T + (size_t)N1 * DM * 2, W_MT = W_GT + (size_t)NGATE * DM * 2, W_OT = W_MT + (size_t)DM * KMERGE * 2, W_UT = W_OT + (size_t)DM * DM * 2,
                 W_DT = W_UT + (size_t)DFF * DM * 2, W_PGT = W_DT + (size_t)DM * DFF * 2, W_PPT = W_PGT + (size_t)DM * DM * 2, W_END = W_PPT + (size_t)DM * PLED * 2;
constexpr size_t WS_SSQA = W_1T + 1 * MiB, WS_SSQB = W_1T + 3 * MiB;
constexpr size_t WS_XB0 = W_END, WS_XB1 = WS_XB0 + 64 * MiB, WS_ZB = WS_XB1 + 64 * MiB, WS_MIX = WS_ZB + 96 * MiB, WS_SM = WS_MIX + 240 * MiB, WS_SSQC = WS_SM + 4 * MiB, WS_ROPE = WS_SSQC + 2 * MiB, WS_END = WS_ROPE + 1 * MiB;
constexpr size_t WS_PB = WS_ZB, WS_PLE = WS_ZB + 16 * MiB, WS_U = WS_ZB + 80 * MiB, WS_GATE = WS_MIX;
static_assert(W_END == WS_W + (size_t)(40 * MiB + 512 * KiB), "weights");
static_assert(WS_U + (size_t)MTOK * DFF * 2 == WS_SM, "U overlay");
static_assert(WS_END <= 512 * MiB, "workspace");
constexpr int LDS_BYTES = 147456, RING_BYTES = 131072, MISC_OFF = RING_BYTES + 320;

#define GAS __attribute__((address_space(1)))
#define LAS __attribute__((address_space(3)))
typedef unsigned short bf16;
typedef unsigned v4u __attribute__((ext_vector_type(4)));
typedef unsigned v2u __attribute__((ext_vector_type(2)));
typedef float f32x4 __attribute__((ext_vector_type(4)));
#define LDS_WAIT() asm volatile("s_waitcnt lgkmcnt(0)" ::: "memory")
typedef float f32x2_t __attribute__((ext_vector_type(2))); typedef __bf16 bf16x2_t __attribute__((ext_vector_type(2)));
__device__ __forceinline__ unsigned pk2(float lo, float hi) { f32x2_t v = {lo, hi}; bf16x2_t b = __builtin_convertvector(v, bf16x2_t); return __builtin_bit_cast(unsigned, b); }
__device__ __forceinline__ unsigned f2bf(float f) { return pk2(f, 0.f) & 0xffffu; }
__device__ __forceinline__ float bf2f(bf16 v) { return __uint_as_float((unsigned)v << 16); }
__device__ __forceinline__ float wave_sum(float v) {
#pragma unroll
    for (int o = 1; o < 64; o <<= 1) v += __shfl_xor(v, o);
    return v;
}
__device__ __forceinline__ float siluf(float x) { return x * __builtin_amdgcn_rcpf(1.0f + __expf(-x)); }
__device__ __forceinline__ float sigmf(float x) { return __builtin_amdgcn_rcpf(1.0f + __expf(-x)); }
__device__ __forceinline__ float softplusf(float x) { return fmaxf(x, 0.f) + log1pf(__expf(-fabsf(x))); }
__device__ __forceinline__ float rdl(float v, int l) { return __int_as_float(__builtin_amdgcn_readlane(__float_as_int(v), l)); }

#define XB_TMO      128
#define XB_XCNT(j)  (256  + 64 * (j))
#define XB_XSUB(j)  (1280 + 64 * (j))
#define XB_XGEN(j)  (2304 + 64 * (j))
#define XB_TOP      3328
#define XB_TOPGEN   3392
#define XCD_BAR_WORDS 3456
#define XB_SPIN_CAP (1u << 18)
__device__ __forceinline__ unsigned xb_ld(unsigned* p)              { return __hip_atomic_load(p, __ATOMIC_RELAXED, __HIP_MEMORY_SCOPE_AGENT); }
__device__ __forceinline__ unsigned xb_add(unsigned* p, unsigned v) { return __hip_atomic_fetch_add(p, v, __ATOMIC_RELAXED, __HIP_MEMORY_SCOPE_AGENT); }
__device__ __forceinline__ unsigned xb_xcc_id() { return (unsigned)__builtin_amdgcn_s_getreg((3 << 11) | 20) & 0xFu; }
#define XB_SPIN(cond, bar) do { unsigned _sp = 0; while (cond) { __builtin_amdgcn_s_sleep(1); \
    if ((++_sp & 255u) == 0u) { if (xb_ld(&(bar)[XB_TMO])) break; if (_sp > XB_SPIN_CAP) { atomicAdd(&(bar)[XB_TMO], 1u); break; } } } } while (0)
struct XcdBarrier { unsigned* bar; unsigned x; volatile LAS unsigned* st; };
__device__ __forceinline__ XcdBarrier xcd_barrier_post(unsigned* bar, volatile LAS unsigned* st) {
    XcdBarrier b; b.bar = bar; b.x = xb_xcc_id(); b.st = st;
    if (threadIdx.x == 0) (void)xb_add(&bar[XB_XCNT(b.x)], 1u);
    return b;
}
__device__ __forceinline__ void xcd_barrier_complete(unsigned* bar, unsigned x, unsigned& nloc, unsigned& nx) {
    const unsigned G = gridDim.x * gridDim.y * gridDim.z;
    unsigned sum, cnt, mine, sp = 0u;
    for (;;) {
        sum = 0u; cnt = 0u; mine = 0u;
#pragma unroll
        for (unsigned j = 0; j < 16; ++j) { const unsigned c = xb_ld(&bar[XB_XCNT(j)]); sum += c; cnt += (c > 0u) ? 1u : 0u; mine = (j == x) ? c : mine; }
        if (sum == G) break;
        __builtin_amdgcn_s_sleep(1);
        if ((++sp & 255u) == 0u) { if (xb_ld(&bar[XB_TMO])) break; if (sp > XB_SPIN_CAP) { atomicAdd(&bar[XB_TMO], 1u); break; } }
    }
    nloc = mine > 0u ? mine : 1u; nx = cnt > 0u ? cnt : 1u;
}
__device__ __forceinline__ void xcd_barrier(const XcdBarrier& b) {
    asm volatile("s_waitcnt vmcnt(0)" ::: "memory");
    __syncthreads();
    if (threadIdx.x == 0) {
        unsigned* bar = b.bar;
        __builtin_amdgcn_s_waitcnt(0);
        unsigned nloc = b.st[0], nx = b.st[1];
        if (nloc == 0u) { xcd_barrier_complete(bar, b.x, nloc, nx); b.st[0] = nloc; b.st[1] = nx; }
        const unsigned old = xb_add(&bar[XB_XSUB(b.x)], 1u);
        const unsigned gen = old / nloc;
        if (old + 1u == (gen + 1u) * nloc) {
            __builtin_amdgcn_fence(__ATOMIC_RELEASE, "agent");
            asm volatile("s_waitcnt vmcnt(0)" ::: "memory");
            const unsigned og = xb_add(&bar[XB_TOP], 1u);
            const unsigned tg = og / nx;
            if (og + 1u == (tg + 1u) * nx) xb_add(&bar[XB_TOPGEN], 1u);
            else XB_SPIN(xb_ld(&bar[XB_TOPGEN]) == tg, bar);
            __builtin_amdgcn_fence(__ATOMIC_ACQUIRE, "agent");
            xb_add(&bar[XB_XGEN(b.x)], 1u);
            asm volatile("s_waitcnt vmcnt(0)" ::: "memory");
        } else {
            XB_SPIN(xb_ld(&bar[XB_XGEN(b.x)]) == gen, bar);
            __builtin_amdgcn_fence(__ATOMIC_ACQUIRE, "agent");
            asm volatile("s_waitcnt vmcnt(0)" ::: "memory");
        }
    }
    __syncthreads();
}

__device__ __forceinline__ void tr_item(const float* W, int ldw, int c0, int ncols, const float* scale, bf16* dst, int ldd, int r0, int kofs, LAS unsigned char* lds, int item, int tid) {
    const int lane = tid & 63, wave = __builtin_amdgcn_readfirstlane(tid >> 6);
    const int nblk = (ncols + 255) / 256, kb = item / nblk, nb = item - kb * nblk, k0 = 64 * kb, n0 = 256 * nb;
    asm volatile("s_waitcnt lgkmcnt(0)\n\ts_barrier" ::: "memory");
#pragma unroll
    for (int jj = 0; jj < 4; ++jj) { const int n = n0 + lane + 64 * jj; const bool ok = W != nullptr && n < ncols; float v[8];
        const float* wp = W + (size_t)(k0 + 8 * wave) * ldw + c0 + n;
#pragma unroll
        for (int kk = 0; kk < 8; ++kk) { v[kk] = 0.f; if (ok) { v[kk] = wp[(size_t)kk * ldw]; if (scale) v[kk] *= scale[k0 + 8 * wave + kk]; } }
        v4u o; o.x = pk2(v[0], v[1]); o.y = pk2(v[2], v[3]); o.z = pk2(v[4], v[5]); o.w = pk2(v[6], v[7]);
        *(LAS v4u*)(lds + (lane + 64 * jj) * 144 + wave * 16) = o; }
    asm volatile("s_waitcnt lgkmcnt(0)\n\ts_barrier" ::: "memory");
#pragma unroll
    for (int i = 0; i < 4; ++i) { const int nl = (tid >> 3) + 64 * i, ch = tid & 7;
        if (n0 + nl < ncols) *(GAS v4u*)(dst + (size_t)(r0 + n0 + nl) * ldd + kofs + k0 + ch * 8) = *(const LAS v4u*)(lds + nl * 144 + ch * 16); }
}
#define TR_SEG(W_, ldw_, c0_, ncols_, K_, scale_, dst_, ldd_, r0_, kofs_) do { const int _n = ((K_) / 64) * (((ncols_) + 255) / 256); \
    for (int _it = (bx + G - (ibase % G)) % G; _it < _n; _it += G) tr_item(W_, ldw_, c0_, ncols_, scale_, dst_, ldd_, r0_, kofs_, lds, _it, tid); ibase += _n; } while (0)

struct Args { const float* in[23]; float* out; unsigned char* ws; int ph_lo, ph_hi; };
constexpr int NPH = 10, PH_FINAL = DEPTH * NPH, N_PHASES = PH_FINAL + 1;

constexpr int WG = 8;
__device__ __forceinline__ void gdn_naive(const Args& A, int layer, int b, int h, int lane, const bf16* MIX, const float* SM, bf16* ZB) {
    const float* cw = A.in[4] + (size_t)layer * 4 * 1536;
    float wq[4], wk[4], wv[4];
#pragma unroll
    for (int k = 0; k < 4; ++k) { wq[k] = cw[k * 1536 + h * 64 + lane]; wk[k] = cw[k * 1536 + 512 + h * 64 + lane]; wv[k] = cw[k * 1536 + 1024 + h * 64 + lane]; }
    const float Aexp = expf(A.in[5][layer * 8 + h]), dtb = A.in[6][layer * 8 + h], nw = A.in[7][layer * 64 + lane];
    float M[64];
#pragma unroll
    for (int d = 0; d < 64; ++d) M[d] = 0.f;
    float hq0 = 0.f, hq1 = 0.f, hq2 = 0.f, hk0 = 0.f, hk1 = 0.f, hk2 = 0.f, hv0 = 0.f, hv1 = 0.f, hv2 = 0.f;
    const size_t tok0 = (size_t)b * SEQ;
    bf16 nq[WG], nk[WG], nv[WG], nz[WG]; float nb[WG], na[WG];
#define GDN_LOAD(t0) do { _Pragma("unroll") for (int i = 0; i < WG; ++i) { const size_t r = tok0 + (t0) + i; const bf16* mp = MIX + r * MIX_LD + h * 64 + lane; \
        nq[i] = mp[MX_AQ]; nk[i] = mp[MX_AK]; nv[i] = mp[MX_AV]; nz[i] = ZB[r * ZB_LD + h * 64 + lane]; nb[i] = SM[r * SM_LD + h]; na[i] = SM[r * SM_LD + 8 + h]; } } while (0)
    GDN_LOAD(0);
    for (int t0 = 0; t0 < SEQ; t0 += WG) {
        bf16 cq[WG], ck[WG], cv[WG], cz[WG]; float cb[WG], ca[WG];
#pragma unroll
        for (int i = 0; i < WG; ++i) { cq[i] = nq[i]; ck[i] = nk[i]; cv[i] = nv[i]; cz[i] = nz[i]; cb[i] = nb[i]; ca[i] = na[i]; }
        if (t0 + WG < SEQ) GDN_LOAD(t0 + WG);
#pragma unroll
        for (int i = 0; i < WG; ++i) {
            const float xq = bf2f(cq[i]), xk = bf2f(ck[i]), xv = bf2f(cv[i]);
            float q = siluf(wq[0] * hq0 + wq[1] * hq1 + wq[2] * hq2 + wq[3] * xq); hq0 = hq1; hq1 = hq2; hq2 = xq;
            float k = siluf(wk[0] * hk0 + wk[1] * hk1 + wk[2] * hk2 + wk[3] * xk); hk0 = hk1; hk1 = hk2; hk2 = xk;
            const float v = siluf(wv[0] * hv0 + wv[1] * hv1 + wv[2] * hv2 + wv[3] * xv); hv0 = hv1; hv1 = hv2; hv2 = xv;
            q *= rsqrtf(wave_sum(q * q) + 1e-6f) * 0.125f; k *= rsqrtf(wave_sum(k * k) + 1e-6f);
            const float beta = sigmf(cb[i]), a = __expf(-Aexp * softplusf(ca[i] + dtb));
            float r = 0.f;
#pragma unroll
            for (int d = 0; d < 64; ++d) { M[d] *= a; r += rdl(k, d) * M[d]; }
            const float u = beta * (v - r); float o = 0.f;
#pragma unroll
            for (int d = 0; d < 64; ++d) { M[d] += rdl(k, d) * u; o += rdl(q, d) * M[d]; }
            const float y = o * rsqrtf(wave_sum(o * o) * (1.0f / 64.0f) + 1e-6f) * nw * siluf(bf2f(cz[i]));
            ZB[(tok0 + t0 + i) * ZB_LD + h * 64 + lane] = (bf16)f2bf(y);
        }
    }
#undef GDN_LOAD
}
__device__ __forceinline__ void ssd_naive(const Args& A, int layer, int b, int h, int lane, const bf16* MIX, float* SM, bf16* ZB) {
    const int g = h >> 2;
    const float* cw = A.in[8] + (size_t)layer * 4 * 768; const float* cb_ = A.in[9] + (size_t)layer * 768;
    float wx[4], wB[4], wC[4];
#pragma unroll
    for (int k = 0; k < 4; ++k) { wx[k] = cw[k * 768 + h * 64 + lane]; wB[k] = cw[k * 768 + 512 + g * 64 + lane]; wC[k] = cw[k * 768 + 640 + g * 64 + lane]; }
    const float bx = cb_[h * 64 + lane], bB = cb_[512 + g * 64 + lane], bC = cb_[640 + g * 64 + lane];
    const float Aexp = expf(A.in[10][layer * 8 + h]), dtb = A.in[11][layer * 8 + h], Dh = A.in[12][layer * 8 + h];
    float Hs[64];
#pragma unroll
    for (int d = 0; d < 64; ++d) Hs[d] = 0.f;
    float hx0 = 0.f, hx1 = 0.f, hx2 = 0.f, hB0 = 0.f, hB1 = 0.f, hB2 = 0.f, hC0 = 0.f, hC1 = 0.f, hC2 = 0.f;
    const size_t tok0 = (size_t)b * SEQ;
    bf16 nx[WG], nB[WG], nC[WG], nz[WG]; float nd[WG];
#define SSD_LOAD(t0) do { _Pragma("unroll") for (int i = 0; i < WG; ++i) { const size_t r = tok0 + (t0) + i; const bf16* mp = MIX + r * MIX_LD; \
        nx[i] = mp[MX_BX + h * 64 + lane]; nB[i] = mp[MX_BB + g * 64 + lane]; nC[i] = mp[MX_BC + g * 64 + lane]; nz[i] = ZB[r * ZB_LD + 512 + h * 64 + lane]; nd[i] = SM[r * SM_LD + 16 + h]; } } while (0)
    SSD_LOAD(0);
    for (int t0 = 0; t0 < SEQ; t0 += WG) {
        bf16 cx[WG], cB[WG], cC[WG], cz[WG]; float cd[WG];
#pragma unroll
        for (int i = 0; i < WG; ++i) { cx[i] = nx[i]; cB[i] = nB[i]; cC[i] = nC[i]; cz[i] = nz[i]; cd[i] = nd[i]; }
        if (t0 + WG < SEQ) SSD_LOAD(t0 + WG);
#pragma unroll
        for (int i = 0; i < WG; ++i) {
            const float rx = bf2f(cx[i]), rB = bf2f(cB[i]), rC = bf2f(cC[i]);
            const float x = siluf(wx[0] * hx0 + wx[1] * hx1 + wx[2] * hx2 + wx[3] * rx + bx); hx0 = hx1; hx1 = hx2; hx2 = rx;
            const float Bv = siluf(wB[0] * hB0 + wB[1] * hB1 + wB[2] * hB2 + wB[3] * rB + bB); hB0 = hB1; hB1 = hB2; hB2 = rB;
            const float Cv = siluf(wC[0] * hC0 + wC[1] * hC1 + wC[2] * hC2 + wC[3] * rC + bC); hC0 = hC1; hC1 = hC2; hC2 = rC;
            const float dt = softplusf(cd[i] + dtb), a = __expf(-Aexp * dt), xdt = x * dt;
            float y = 0.f;
#pragma unroll
            for (int n = 0; n < 64; ++n) { Hs[n] = a * Hs[n] + xdt * rdl(Bv, n); y += Hs[n] * rdl(Cv, n); }
            y = (y + Dh * x) * siluf(bf2f(cz[i]));
            const float ss = wave_sum(y * y);
            const size_t r = tok0 + t0 + i;
            ZB[r * ZB_LD + 512 + h * 64 + lane] = (bf16)f2bf(y);
            if (lane == 0) SM[r * SM_LD + 24 + h] = ss;
        }
    }
#undef SSD_LOAD
}
__device__ __forceinline__ void ret_naive(int b, int h, int lane, const bf16* MIX, const float* ROPE, bf16* ZB) {
    const float gamma = 1.0f - exp2f(-5.0f - (float)h);
    float M[64];
#pragma unroll
    for (int d = 0; d < 64; ++d) M[d] = 0.f;
    const size_t tok0 = (size_t)b * SEQ;
    bf16 nq[WG], nk[WG], nv[WG], nz[WG]; float nc[WG], ns[WG];
#define RET_LOAD(t0) do { _Pragma("unroll") for (int i = 0; i < WG; ++i) { const size_t r = tok0 + (t0) + i; const bf16* mp = MIX + r * MIX_LD + h * 64 + lane; \
        nq[i] = mp[MX_CQ]; nk[i] = mp[MX_CK]; nv[i] = mp[MX_CV]; nz[i] = ZB[r * ZB_LD + 1024 + h * 64 + lane]; nc[i] = ROPE[((t0) + i) * 32 + (lane & 31)]; ns[i] = ROPE[SEQ * 32 + ((t0) + i) * 32 + (lane & 31)]; } } while (0)
    RET_LOAD(0);
    for (int t0 = 0; t0 < SEQ; t0 += WG) {
        bf16 cq[WG], ck[WG], cv[WG], cz[WG]; float cc[WG], cs[WG];
#pragma unroll
        for (int i = 0; i < WG; ++i) { cq[i] = nq[i]; ck[i] = nk[i]; cv[i] = nv[i]; cz[i] = nz[i]; cc[i] = nc[i]; cs[i] = ns[i]; }
        if (t0 + WG < SEQ) RET_LOAD(t0 + WG);
#pragma unroll
        for (int i = 0; i < WG; ++i) {
            const float q0 = bf2f(cq[i]), k0 = bf2f(ck[i]), v = bf2f(cv[i]);
            const float qp = __shfl_xor(q0, 32), kp = __shfl_xor(k0, 32);
            const float sg = lane < 32 ? -cs[i] : cs[i];
            const float q = q0 * cc[i] + qp * sg, k = (k0 * cc[i] + kp * sg) * 0.125f;
            float o = 0.f;
#pragma unroll
            for (int d = 0; d < 64; ++d) { M[d] = gamma * M[d] + rdl(k, d) * v; o += rdl(q, d) * M[d]; }
            const float y = o * rsqrtf(wave_sum(o * o) * (1.0f / 64.0f) + 1e-6f) * siluf(bf2f(cz[i]));
            ZB[(tok0 + t0 + i) * ZB_LD + 1024 + h * 64 + lane] = (bf16)f2bf(y);
        }
    }
#undef RET_LOAD
}

typedef short bf16x8 __attribute__((ext_vector_type(8)));
constexpr int PT = 72, MAT = 64 * PT * 2;
constexpr int L_Q = 0, L_K = MAT, L_V = 2 * MAT, L_W = 3 * MAT, L_U = 4 * MAT, L_ST0 = 5 * MAT, L_ST1 = 6 * MAT, L_PP = 7 * MAT, L_YT = 8 * MAT,
              YPT = 68, L_G = L_YT + 64 * YPT * 4, L_DT = L_G + 256, L_WEND = L_DT + 256;
static_assert(L_WEND <= RING_BYTES, "walker LDS");
constexpr size_t GW_OFF = 0, HALO_OFF = 32 * MiB;
constexpr int HALO_LD = 2304;
#define MFMA16(a, b, c) __builtin_amdgcn_mfma_f32_16x16x32_bf16(a, b, c, 0, 0, 0)
__device__ __forceinline__ bf16x8 ldfrag(LAS unsigned char* base, int row, int kelem) { return *(const LAS bf16x8*)(base + row * (PT * 2) + kelem * 2); }
__device__ __forceinline__ void unpk8(const v4u w, float (&f)[8]) { f[0] = pg8::bflo(w.x); f[1] = pg8::bfhi(w.x); f[2] = pg8::bflo(w.y); f[3] = pg8::bfhi(w.y); f[4] = pg8::bflo(w.z); f[5] = pg8::bfhi(w.z); f[6] = pg8::bflo(w.w); f[7] = pg8::bfhi(w.w); }
__device__ __forceinline__ v4u pk8(const float (&f)[8]) { v4u w; w.x = pk2(f[0], f[1]); w.y = pk2(f[2], f[3]); w.z = pk2(f[4], f[5]); w.w = pk2(f[6], f[7]); return w; }
__device__ __forceinline__ void st_tr8(LAS unsigned char* base, int row0, int col, const float (&f)[8]) {
#pragma unroll
    for (int j = 0; j < 8; ++j) *(LAS bf16*)(base + (row0 + j) * (PT * 2) + col * 2) = (bf16)f2bf(f[j]);
}

#define LBAR() asm volatile("s_waitcnt lgkmcnt(0)\n\ts_barrier" ::: "memory")
typedef short s16x4 __attribute__((ext_vector_type(4)));
__device__ __forceinline__ s16x4 tr4(LAS unsigned char* p) { return __builtin_bit_cast(s16x4, __builtin_amdgcn_ds_read_tr16_b64_v4i16((LAS s16x4*)p)); }
__device__ __forceinline__ bf16x8 trfrag(LAS unsigned char* tile, int krow0, int col0, int fr) {
    LAS unsigned char* a = tile + (krow0 + (fr >> 2)) * (PT * 2) + (col0 + 4 * (fr & 3)) * 2;
    const s16x4 lo = tr4(a), hi = tr4(a + 4 * PT * 2);
    return (bf16x8){lo[0], lo[1], lo[2], lo[3], hi[0], hi[1], hi[2], hi[3]};
}
__device__ __forceinline__ float bfs(short v) { return __uint_as_float((unsigned)(unsigned short)v << 16); }

template <int KIND>
__device__ __forceinline__ void mixer_walk(const __attribute__((address_space(4))) Args* kp, int layer, int b, int h, LAS unsigned char* lds) {
    int tid = threadIdx.x; asm volatile("" : "+v"(tid));
    const int lane = tid & 63, wave = __builtin_amdgcn_readfirstlane(tid >> 6), fr = lane & 15, fq = lane >> 4;
    const int prow = tid >> 3, pcg = tid & 7;
    unsigned char* ws = kp->ws;
    const bf16* MIX = (const bf16*)(ws + WS_MIX); bf16* ZB = (bf16*)(ws + WS_ZB); float* SM = (float*)(ws + WS_SM);
    const bf16* GW = (const bf16*)(ws + ((layer & 1) ? WS_XB0 : WS_XB1) + GW_OFF);
    const size_t tok0 = (size_t)b * SEQ;
    const int g = h >> 2;
    const int qcol = (KIND == 0 ? MX_AQ + h * 64 : (KIND == 1 ? MX_BC + g * 64 : MX_CQ + h * 64)) + pcg * 8;
    const int kcol = (KIND == 0 ? MX_AK + h * 64 : (KIND == 1 ? MX_BB + g * 64 : MX_CK + h * 64)) + pcg * 8;
    const int vcol = (KIND == 0 ? MX_AV + h * 64 : (KIND == 1 ? MX_BX + h * 64 : MX_CV + h * 64)) + pcg * 8;
    const int zcol = KIND * 512 + h * 64 + pcg * 8;
    const int gcol = (KIND == 0 ? 8 : 16) + h;
    float nw[8];
    if (KIND == 0) {
#pragma unroll
        for (int j = 0; j < 8; ++j) nw[j] = kp->in[7][layer * 64 + pcg * 8 + j];
    }
    const float p_D = KIND == 1 ? kp->in[12][layer * 8 + h] : 0.f;
    const float p_lg = KIND == 2 ? log1pf(-exp2f(-5.0f - (float)h)) : 0.f;
    for (int i = tid; i < MAT / 4; i += 512) ((LAS unsigned*)(lds + L_ST0))[i] = 0u;
    pg8::f32x4 sacc[4];
#pragma unroll
    for (int i = 0; i < 4; ++i) sacc[i] = (pg8::f32x4){0.f, 0.f, 0.f, 0.f};
    LAS float* Gv = (LAS float*)(lds + L_G); LAS float* Dv = (LAS float*)(lds + L_DT);
    LAS unsigned char* PPw = lds + L_PP + (wave & 3) * (16 * PT * 2);

    v4u tq, tk, tv, tw, tz; float sg = 0.f, sd = 1.f; (void)tw;
#define WALK_LOAD(c) do { const size_t row = tok0 + (size_t)(c) * 64 + prow; const bf16* mp = MIX + row * MIX_LD; \
        tq = *(const GAS v4u*)(mp + qcol); tk = *(const GAS v4u*)(mp + kcol); tv = *(const GAS v4u*)(mp + vcol); \
        if (KIND == 0) tw = *(const GAS v4u*)(GW + row * 512 + h * 64 + pcg * 8); \
        tz = *(const GAS v4u*)(ZB + row * ZB_LD + zcol); \
        if (tid < 64) { const size_t r2 = tok0 + (size_t)(c) * 64 + tid; \
            if (KIND == 2) sg = (float)(tid + 1) * p_lg; else sg = SM[r2 * SM_LD + gcol]; \
            if (KIND == 1) sd = SM[r2 * SM_LD + 24 + h]; } } while (0)
#define WALK_PREP() do { \
        *(LAS v4u*)(lds + L_Q + prow * (PT * 2) + pcg * 16) = tq; *(LAS v4u*)(lds + L_K + prow * (PT * 2) + pcg * 16) = tk; \
        if (KIND == 0) { *(LAS v4u*)(lds + L_U + prow * (PT * 2) + pcg * 16) = tv; *(LAS v4u*)(lds + L_W + prow * (PT * 2) + pcg * 16) = tw; } \
        else *(LAS v4u*)(lds + L_V + prow * (PT * 2) + pcg * 16) = tv; \
        if (tid < 64) { Gv[tid] = sg; Dv[tid] = sd; } } while (0)

    WALK_LOAD(0);
    WALK_PREP();
    v4u zc = tz, xc = tv;
    LBAR();
    for (int c = 0; c < SEQ / 64; ++c) {
        LAS unsigned char* STc = lds + ((c & 1) ? L_ST1 : L_ST0); LAS unsigned char* STn = lds + ((c & 1) ? L_ST0 : L_ST1);
        if (c + 1 < SEQ / 64) WALK_LOAD(c + 1);
        bf16x8 Qf[2];
        if (wave < 4) { const int lb = wave;
            Qf[0] = ldfrag(lds + L_Q, 16 * lb + fr, 8 * fq); Qf[1] = ldfrag(lds + L_Q, 16 * lb + fr, 32 + 8 * fq);
            const float gl = Gv[16 * lb + fr];
#pragma unroll
            for (int sb = 0; sb < 4; ++sb) { v2u o; o.x = 0u; o.y = 0u;
                if (sb <= lb) { pg8::f32x4 acc = (pg8::f32x4){0.f, 0.f, 0.f, 0.f};
#pragma unroll
                    for (int ks = 0; ks < 2; ++ks) acc = MFMA16(ldfrag(lds + L_K, 16 * sb + fr, 32 * ks + 8 * fq), Qf[ks], acc);
                    const pg8::f32x4 gs = *(const LAS pg8::f32x4*)(Gv + 16 * sb + 4 * fq); pg8::f32x4 ds = (pg8::f32x4){1.f, 1.f, 1.f, 1.f};
                    if (KIND == 1) ds = *(const LAS pg8::f32x4*)(Dv + 16 * sb + 4 * fq);
                    float pv[4];
#pragma unroll
                    for (int r = 0; r < 4; ++r) pv[r] = (16 * sb + 4 * fq + r <= 16 * lb + fr) ? acc[r] * __expf(gl - gs[r]) * ds[r] : 0.f;
                    o.x = pk2(pv[0], pv[1]); o.y = pk2(pv[2], pv[3]); }
                *(LAS v2u*)(PPw + fr * (PT * 2) + (16 * sb + 4 * fq) * 2) = o; }
        } else if (KIND == 0) { const int wq = wave - 4;
            const bf16x8 Wf0 = ldfrag(lds + L_W, 16 * wq + fr, 8 * fq), Wf1 = ldfrag(lds + L_W, 16 * wq + fr, 32 + 8 * fq);
#pragma unroll
            for (int eb = 0; eb < 4; ++eb) { pg8::f32x4 acc = (pg8::f32x4){0.f, 0.f, 0.f, 0.f};
                acc = MFMA16(Wf0, ldfrag(STc, 16 * eb + fr, 8 * fq), acc); acc = MFMA16(Wf1, ldfrag(STc, 16 * eb + fr, 32 + 8 * fq), acc);
                const s16x4 u4 = tr4(lds + L_U + (16 * wq + 4 * fq + (fr >> 2)) * (PT * 2) + (16 * eb + 4 * (fr & 3)) * 2);
                v2u o; o.x = pk2(bfs(u4[0]) - acc[0], bfs(u4[1]) - acc[1]); o.y = pk2(bfs(u4[2]) - acc[2], bfs(u4[3]) - acc[3]);
                *(LAS v2u*)(lds + L_V + (16 * eb + fr) * (PT * 2) + (16 * wq + 4 * fq) * 2) = o; }
        }
        if (KIND == 0) LBAR();
        if (wave < 4) { const int lb = wave;
            const bf16x8 Pf0 = ldfrag(PPw, fr, 8 * fq), Pf1 = ldfrag(PPw, fr, 32 + 8 * fq);
            const pg8::f32x4 gv = *(const LAS pg8::f32x4*)(Gv + 16 * lb + 4 * fq);
            const pg8::f32x4 eg = (pg8::f32x4){__expf(gv[0]), __expf(gv[1]), __expf(gv[2]), __expf(gv[3])};
#pragma unroll
            for (int eb = 0; eb < 4; ++eb) { pg8::f32x4 acc = (pg8::f32x4){0.f, 0.f, 0.f, 0.f};
                acc = MFMA16(Qf[0], ldfrag(STc, 16 * eb + fr, 8 * fq), acc); acc = MFMA16(Qf[1], ldfrag(STc, 16 * eb + fr, 32 + 8 * fq), acc);
                acc *= eg;
                if (KIND == 0) { acc = MFMA16(Pf0, ldfrag(lds + L_V, 16 * eb + fr, 8 * fq), acc); acc = MFMA16(Pf1, ldfrag(lds + L_V, 16 * eb + fr, 32 + 8 * fq), acc); }
                else { acc = MFMA16(Pf0, trfrag(lds + L_V, 8 * fq, 16 * eb, fr), acc); acc = MFMA16(Pf1, trfrag(lds + L_V, 32 + 8 * fq, 16 * eb, fr), acc); }
#pragma unroll
                for (int r = 0; r < 4; ++r) ((LAS float*)(lds + L_YT))[(16 * lb + 4 * fq + r) * YPT + 16 * eb + fr] = acc[r]; }
        } else { const int db = wave - 4;
            const float glast = Gv[63], egl = __expf(glast);
            bf16x8 Kf[2];
#pragma unroll
            for (int ks = 0; ks < 2; ++ks) { const bf16x8 kr = trfrag(lds + L_K, 32 * ks + 8 * fq, 16 * db, fr);
                const pg8::f32x4 g0 = *(const LAS pg8::f32x4*)(Gv + 32 * ks + 8 * fq), g1 = *(const LAS pg8::f32x4*)(Gv + 32 * ks + 8 * fq + 4);
                pg8::f32x4 d0 = (pg8::f32x4){1.f, 1.f, 1.f, 1.f}, d1 = d0;
                if (KIND == 1) { d0 = *(const LAS pg8::f32x4*)(Dv + 32 * ks + 8 * fq); d1 = *(const LAS pg8::f32x4*)(Dv + 32 * ks + 8 * fq + 4); }
                float kf[8];
#pragma unroll
                for (int j = 0; j < 4; ++j) { kf[j] = bfs(kr[j]) * __expf(glast - g0[j]) * d0[j]; kf[4 + j] = bfs(kr[4 + j]) * __expf(glast - g1[j]) * d1[j]; }
                const v4u kw = pk8(kf); Kf[ks] = __builtin_bit_cast(bf16x8, kw); }
#pragma unroll
            for (int eb = 0; eb < 4; ++eb) { pg8::f32x4 acc = sacc[eb] * egl;
                if (KIND == 0) { acc = MFMA16(Kf[0], ldfrag(lds + L_V, 16 * eb + fr, 8 * fq), acc); acc = MFMA16(Kf[1], ldfrag(lds + L_V, 16 * eb + fr, 32 + 8 * fq), acc); }
                else { acc = MFMA16(Kf[0], trfrag(lds + L_V, 8 * fq, 16 * eb, fr), acc); acc = MFMA16(Kf[1], trfrag(lds + L_V, 32 + 8 * fq, 16 * eb, fr), acc); }
                sacc[eb] = acc;
                v2u o; o.x = pk2(acc[0], acc[1]); o.y = pk2(acc[2], acc[3]);
                *(LAS v2u*)(STn + (16 * eb + fr) * (PT * 2) + (16 * db + 4 * fq) * 2) = o; }
        }
        LBAR();
        {
            const LAS float* yr = (const LAS float*)(lds + L_YT) + prow * YPT + pcg * 8;
            const pg8::f32x4 y0 = *(const LAS pg8::f32x4*)yr, y1 = *(const LAS pg8::f32x4*)(yr + 4);
            float y[8] = {y0[0], y0[1], y0[2], y0[3], y1[0], y1[1], y1[2], y1[3]}, zf[8]; unpk8(zc, zf);
            const size_t row = tok0 + (size_t)c * 64 + prow;
            if (KIND == 1) { float ss = 0.f, xf[8]; unpk8(xc, xf);
#pragma unroll
                for (int j = 0; j < 8; ++j) { y[j] = (y[j] + p_D * xf[j]) * siluf(zf[j]); ss += y[j] * y[j]; }
                ss += __shfl_xor(ss, 1); ss += __shfl_xor(ss, 2); ss += __shfl_xor(ss, 4);
                if (pcg == 0) SM[row * SM_LD + 16 + h] = ss;
            } else { float ss = 0.f;
#pragma unroll
                for (int j = 0; j < 8; ++j) ss += y[j] * y[j];
                ss += __shfl_xor(ss, 1); ss += __shfl_xor(ss, 2); ss += __shfl_xor(ss, 4);
                const float rstd = rsqrtf(ss * (1.0f / 64.0f) + 1e-6f);
#pragma unroll
                for (int j = 0; j < 8; ++j) y[j] = y[j] * rstd * (KIND == 0 ? nw[j] : 1.0f) * siluf(zf[j]); }
            *(GAS v4u*)(ZB + row * ZB_LD + zcol) = pk8(y);
        }
        if (c + 1 < SEQ / 64) { WALK_PREP(); zc = tz; xc = tv; }
        LBAR();
    }
#undef WALK_LOAD
#undef WALK_PREP
}

constexpr int SP_RAW = 0, SP_CW = 67 * 1536, SP_END = SP_CW + 5 * 768 * 4;
static_assert(SP_END <= RING_BYTES, "ssd_prep LDS");
__device__ __forceinline__ void ssd_prep(const __attribute__((address_space(4))) Args* kp, int layer, LAS unsigned char* lds, int G_) {
    int tid = threadIdx.x; asm volatile("" : "+v"(tid));
    const int lane = tid & 63, wave = __builtin_amdgcn_readfirstlane(tid >> 6);
    unsigned char* ws = kp->ws;
    bf16* MIX = (bf16*)(ws + WS_MIX); float* SM = (float*)(ws + WS_SM);
    const bf16* HALO = (const bf16*)(ws + ((layer & 1) ? WS_XB0 : WS_XB1) + HALO_OFF);
    LAS float* CW = (LAS float*)(lds + SP_CW);
    { const float* cw = kp->in[8] + (size_t)layer * 4 * 768; const float* cb = kp->in[9] + (size_t)layer * 768;
      for (int i = tid; i < 768; i += 512) { CW[i] = cw[i]; CW[768 + i] = cw[768 + i]; CW[2 * 768 + i] = cw[2 * 768 + i]; CW[3 * 768 + i] = cw[3 * 768 + i]; CW[4 * 768 + i] = cb[i]; } }
    const float Aexp = expf(kp->in[10][layer * 8 + wave]), dtb = kp->in[11][layer * 8 + wave];
    for (int unit = blockIdx.x; unit < NBATCH * 64; unit += G_) { const int b = unit >> 6, c = unit & 63; const size_t tok0 = (size_t)b * SEQ + (size_t)c * 64;
        LBAR();
        for (int i = tid; i < 67 * 96; i += 512) { const int r = i / 96, pc = i - r * 96; v4u v = (v4u){0u, 0u, 0u, 0u};
            if (r >= 3) v = *(const GAS v4u*)(MIX + (tok0 + r - 3) * MIX_LD + MX_BX + pc * 8);
            else if (c > 0) v = *(const GAS v4u*)(HALO + ((size_t)(b * 64 + c - 1) * 3 + r) * HALO_LD + MX_BX + pc * 8);
            *(LAS v4u*)(lds + SP_RAW + r * 1536 + pc * 16) = v; }
        { const size_t r2 = tok0 + lane; const float dt = softplusf(SM[r2 * SM_LD + 16 + wave] + dtb); float gs = -Aexp * dt;
#pragma unroll
          for (int o = 1; o < 64; o <<= 1) { const float t_ = __shfl_up(gs, o); if (lane >= o) gs += t_; }
          SM[r2 * SM_LD + 16 + wave] = gs; SM[r2 * SM_LD + 24 + wave] = dt; }
        LBAR();
        for (int i = tid; i < 64 * 96; i += 512) { const int l = i / 96, pc = i - l * 96; float a[8];
            { const pg8::f32x4 b0 = *(const LAS pg8::f32x4*)(CW + 4 * 768 + pc * 8), b1 = *(const LAS pg8::f32x4*)(CW + 4 * 768 + pc * 8 + 4);
              a[0] = b0[0]; a[1] = b0[1]; a[2] = b0[2]; a[3] = b0[3]; a[4] = b1[0]; a[5] = b1[1]; a[6] = b1[2]; a[7] = b1[3]; }
#pragma unroll
            for (int k = 0; k < 4; ++k) { float f[8]; unpk8(*(const LAS v4u*)(lds + SP_RAW + (l + k) * 1536 + pc * 16), f);
                const pg8::f32x4 w0 = *(const LAS pg8::f32x4*)(CW + k * 768 + pc * 8), w1 = *(const LAS pg8::f32x4*)(CW + k * 768 + pc * 8 + 4);
#pragma unroll
                for (int j = 0; j < 4; ++j) { a[j] += w0[j] * f[j]; a[4 + j] += w1[j] * f[4 + j]; } }
#pragma unroll
            for (int j = 0; j < 8; ++j) a[j] = siluf(a[j]);
            *(GAS v4u*)(MIX + (tok0 + l) * MIX_LD + MX_BX + pc * 8) = pk8(a); }
    }
    LBAR();
}
__device__ __forceinline__ void ret_prep(const __attribute__((address_space(4))) Args* kp, int G_) {
    int tid = threadIdx.x; asm volatile("" : "+v"(tid));
    unsigned char* ws = kp->ws;
    bf16* MIX = (bf16*)(ws + WS_MIX); const float* ROPE = (const float*)(ws + WS_ROPE);
    for (int it = blockIdx.x * 512 + tid; it < MTOK * 32; it += G_ * 512) { const int m = it >> 5, hh = (it >> 2) & 7, i4 = it & 3, t = m & (SEQ - 1);
        const float* rp = ROPE + t * 32 + i4 * 8;
        const pg8::f32x4 c0 = *(const GAS pg8::f32x4*)rp, c1 = *(const GAS pg8::f32x4*)(rp + 4), s0 = *(const GAS pg8::f32x4*)(rp + SEQ * 32), s1 = *(const GAS pg8::f32x4*)(rp + SEQ * 32 + 4);
        const float cs[8] = {c0[0], c0[1], c0[2], c0[3], c1[0], c1[1], c1[2], c1[3]}, sn[8] = {s0[0], s0[1], s0[2], s0[3], s1[0], s1[1], s1[2], s1[3]};
#pragma unroll
        for (int T = 0; T < 2; ++T) { bf16* p = MIX + (size_t)m * MIX_LD + (T == 0 ? MX_CQ : MX_CK) + hh * 64 + i4 * 8; const float sc = T == 0 ? 1.0f : 0.125f;
            float a[8], bb[8], o1[8], o2[8]; unpk8(*(const GAS v4u*)p, a); unpk8(*(const GAS v4u*)(p + 32), bb);
#pragma unroll
            for (int j = 0; j < 8; ++j) { o1[j] = (a[j] * cs[j] - bb[j] * sn[j]) * sc; o2[j] = (a[j] * sn[j] + bb[j] * cs[j]) * sc; }
            *(GAS v4u*)p = pk8(o1); *(GAS v4u*)(p + 32) = pk8(o2); }
    }
}

typedef short bf16x4 __attribute__((ext_vector_type(4)));
#define MFMA16K16(a, b, c) __builtin_amdgcn_mfma_f32_16x16x16bf16_1k(a, b, c, 0, 0, 0)
constexpr int GQ_RAW = 0, GQ_KN = 67 * 384, GQ_VN = GQ_KN + MAT, GQ_NA = GQ_VN + MAT, GQ_AD = GQ_NA + MAT, GQ_S = GQ_AD + 4 * 16 * 20 * 4, GQ_CW = GQ_S + 512, GQ_TEAM = GQ_CW + 4 * 192 * 4;
static_assert(2 * GQ_TEAM <= RING_BYTES && 2 * MAT <= GQ_KN, "gdn_prep LDS");
__device__ __forceinline__ bf16x4 pk4(const pg8::f32x4 v) { v2u w; w.x = pk2(v[0], v[1]); w.y = pk2(v[2], v[3]); return __builtin_bit_cast(bf16x4, w); }
__device__ __forceinline__ void gdn_prep(const __attribute__((address_space(4))) Args* kp, int layer, LAS unsigned char* lds_all, int G_) {
    int tid = threadIdx.x; asm volatile("" : "+v"(tid));
    const int team = __builtin_amdgcn_readfirstlane(tid >> 8), j = tid & 255, lane = tid & 63, tw = __builtin_amdgcn_readfirstlane((tid >> 6) & 3), fr = lane & 15, fq = lane >> 4;
    LAS unsigned char* lds = lds_all + team * GQ_TEAM;
    LAS float* AD = (LAS float*)(lds + GQ_AD); LAS float* Gs = (LAS float*)(lds + GQ_S); LAS float* Bs = Gs + 64; LAS float* CW = (LAS float*)(lds + GQ_CW);
    unsigned char* ws = kp->ws;
    bf16* MIX = (bf16*)(ws + WS_MIX); float* SM = (float*)(ws + WS_SM);
    unsigned char* xbf = ws + ((layer & 1) ? WS_XB0 : WS_XB1); bf16* GW = (bf16*)(xbf + GW_OFF); const bf16* HALO = (const bf16*)(xbf + HALO_OFF);
    const float* cw = kp->in[4] + (size_t)layer * 4 * 1536;
    v4u praw[7]; float pcw[3], pbl = 0.f, pal = 0.f;
#define GQ_FETCH(rnd) do { const int u_ = ((rnd) * G_ + (int)blockIdx.x) * 2 + team; const int un_ = u_ < NBATCH * 8 * 64 ? u_ : 0; \
        const int c_ = un_ & 63, h_ = (un_ >> 6) & 7, b_ = un_ >> 9; const size_t tk_ = (size_t)b_ * SEQ + (size_t)c_ * 64; \
        _Pragma("unroll") for (int n = 0; n < 7; ++n) { const int i = j + 256 * n; praw[n] = (v4u){0u, 0u, 0u, 0u}; \
            if (i < 67 * 24) { const int r = i / 24, pc = i - r * 24, col = (pc >> 3) * 512 + h_ * 64 + (pc & 7) * 8; \
                if (r >= 3) praw[n] = *(const GAS v4u*)(MIX + (tk_ + r - 3) * MIX_LD + col); \
                else if (c_ > 0) praw[n] = *(const GAS v4u*)(HALO + ((size_t)(b_ * 64 + c_ - 1) * 3 + r) * HALO_LD + col); } } \
        _Pragma("unroll") for (int n = 0; n < 3; ++n) { const int i = j + 256 * n, k = i / 192, cc = i - k * 192; pcw[n] = cw[k * 1536 + (cc >> 6) * 512 + h_ * 64 + (cc & 63)]; } \
        if (tw == 0) { pbl = SM[(tk_ + lane) * SM_LD + h_]; pal = SM[(tk_ + lane) * SM_LD + 8 + h_]; } } while (0)
    GQ_FETCH(0);
    for (int round = 0; round < 8; ++round) {
        const int unit_ = (round * G_ + (int)blockIdx.x) * 2 + team;
        const bool live = unit_ < NBATCH * 8 * 64;
        const int unit = live ? unit_ : 0;
        const int c = unit & 63, h = (unit >> 6) & 7, b = unit >> 9;
        const size_t tok0 = (size_t)b * SEQ + (size_t)c * 64;
        LBAR();
#pragma unroll
        for (int n = 0; n < 7; ++n) { const int i = j + 256 * n; if (i < 67 * 24) { const int r = i / 24, pc = i - r * 24; *(LAS v4u*)(lds + GQ_RAW + r * 384 + pc * 16) = praw[n]; } }
#pragma unroll
        for (int n = 0; n < 3; ++n) CW[j + 256 * n] = pcw[n];
        if (tw == 0) {
            float gsum = -expf(kp->in[5][layer * 8 + h]) * softplusf(pal + kp->in[6][layer * 8 + h]);
#pragma unroll
            for (int o = 1; o < 64; o <<= 1) { const float t_ = __shfl_up(gsum, o); if (lane >= o) gsum += t_; }
            Gs[lane] = gsum; Bs[lane] = sigmf(pbl);
            if (live) SM[(tok0 + lane) * SM_LD + 8 + h] = gsum; }
        if (round + 1 < 8) GQ_FETCH(round + 1);
        LBAR();
#pragma unroll 1
        for (int n = 0; n < 6; ++n) { const int i = j + 256 * n, t = i / 24, pc = i - t * 24, tens = pc >> 3, ch = pc & 7; float a[8];
#pragma unroll
            for (int jj = 0; jj < 8; ++jj) a[jj] = 0.f;
#pragma unroll
            for (int k = 0; k < 4; ++k) { float f[8]; unpk8(*(const LAS v4u*)(lds + GQ_RAW + (t + k) * 384 + pc * 16), f);
                const pg8::f32x4 w0 = *(const LAS pg8::f32x4*)(CW + k * 192 + pc * 8), w1 = *(const LAS pg8::f32x4*)(CW + k * 192 + pc * 8 + 4);
#pragma unroll
                for (int jj = 0; jj < 4; ++jj) { a[jj] += w0[jj] * f[jj]; a[4 + jj] += w1[jj] * f[4 + jj]; } }
            float ss = 0.f;
#pragma unroll
            for (int jj = 0; jj < 8; ++jj) { a[jj] = siluf(a[jj]); ss += a[jj] * a[jj]; }
            ss += __shfl_xor(ss, 1); ss += __shfl_xor(ss, 2); ss += __shfl_xor(ss, 4);
            const float sc = tens == 2 ? 1.0f : rsqrtf(ss + 1e-6f) * (tens == 0 ? 0.125f : 1.0f);
#pragma unroll
            for (int jj = 0; jj < 8; ++jj) a[jj] *= sc;
            const v4u o = pk8(a);
            if (tens == 0) { if (live) *(GAS v4u*)(MIX + (tok0 + t) * MIX_LD + MX_AQ + h * 64 + ch * 8) = o; }
            else if (tens == 1) { *(LAS v4u*)(lds + GQ_KN + t * (PT * 2) + ch * 16) = o; if (live) *(GAS v4u*)(MIX + (tok0 + t) * MIX_LD + MX_AK + h * 64 + ch * 8) = o; }
            else *(LAS v4u*)(lds + GQ_VN + t * (PT * 2) + ch * 16) = o; }
        LBAR();
        for (int id = tw; id < 10; id += 4) { const int lb = id < 1 ? 0 : (id < 3 ? 1 : (id < 6 ? 2 : 3)), sb = id - (lb * (lb + 1)) / 2;
            pg8::f32x4 acc = (pg8::f32x4){0.f, 0.f, 0.f, 0.f};
#pragma unroll
            for (int ks = 0; ks < 2; ++ks) acc = MFMA16(ldfrag(lds + GQ_KN, 16 * lb + fr, 32 * ks + 8 * fq), ldfrag(lds + GQ_KN, 16 * sb + fr, 32 * ks + 8 * fq), acc);
            const int s = 16 * sb + fr; const float gsv = Gs[s];
#pragma unroll
            for (int r = 0; r < 4; ++r) { const int l = 16 * lb + 4 * fq + r; const float v = s < l ? Bs[l] * acc[r] * __expf(Gs[l] - gsv) : 0.f;
                if (lb == sb) AD[(lb * 16 + 4 * fq + r) * 20 + fr] = v;
                else *(LAS bf16*)(lds + GQ_NA + l * (PT * 2) + s * 2) = (bf16)f2bf(-v); } }
        LBAR();
        if (tw == 0) { const int bi = lane >> 4, cc = lane & 15; const LAS float* Ab = AD + bi * 16 * 20; float x[16];
#pragma unroll
            for (int r = 0; r < 16; ++r) { float a = (r == cc) ? 1.0f : 0.0f;
#pragma unroll
                for (int s4 = 0; s4 < r; s4 += 4) { const pg8::f32x4 av = *(const LAS pg8::f32x4*)(Ab + r * 20 + s4);
                    a -= av[0] * x[s4];
                    if (s4 + 1 < r) a -= av[1] * x[s4 + 1];
                    if (s4 + 2 < r) a -= av[2] * x[s4 + 2];
                    if (s4 + 3 < r) a -= av[3] * x[s4 + 3]; }
                x[r] = a; }
#pragma unroll
            for (int r = 0; r < 16; ++r) *(LAS bf16*)(lds + GQ_NA + (16 * bi + r) * (PT * 2) + (16 * bi + cc) * 2) = (bf16)f2bf(x[r]); }
        LBAR();
#pragma unroll 1
        for (int half = 0; half < 2; ++half) { LAS unsigned char* src = lds + (half == 0 ? GQ_VN : GQ_KN); const int c0 = 16 * tw;
            pg8::f32x4 R[4], X[4];
#pragma unroll
            for (int i = 0; i < 4; ++i) { const s16x4 raw = tr4(src + (16 * i + 4 * fq + (fr >> 2)) * (PT * 2) + (c0 + 4 * (fr & 3)) * 2);
                const pg8::f32x4 bv = *(const LAS pg8::f32x4*)(Bs + 16 * i + 4 * fq); pg8::f32x4 sc = bv;
                if (half == 1) { const pg8::f32x4 gv = *(const LAS pg8::f32x4*)(Gs + 16 * i + 4 * fq); sc = (pg8::f32x4){bv[0] * __expf(gv[0]), bv[1] * __expf(gv[1]), bv[2] * __expf(gv[2]), bv[3] * __expf(gv[3])}; }
                R[i] = (pg8::f32x4){bfs(raw[0]) * sc[0], bfs(raw[1]) * sc[1], bfs(raw[2]) * sc[2], bfs(raw[3]) * sc[3]}; }
#define NAF(ib, jb) (*(const LAS bf16x4*)(lds + GQ_NA + (16 * (ib) + fr) * (PT * 2) + (16 * (jb) + 4 * fq) * 2))
            const pg8::f32x4 Z = (pg8::f32x4){0.f, 0.f, 0.f, 0.f};
            X[0] = MFMA16K16(NAF(0, 0), pk4(R[0]), Z);
            { const bf16x4 x0 = pk4(X[0]); R[1] = MFMA16K16(NAF(1, 0), x0, R[1]); R[2] = MFMA16K16(NAF(2, 0), x0, R[2]); R[3] = MFMA16K16(NAF(3, 0), x0, R[3]); }
            X[1] = MFMA16K16(NAF(1, 1), pk4(R[1]), Z);
            { const bf16x4 x1 = pk4(X[1]); R[2] = MFMA16K16(NAF(2, 1), x1, R[2]); R[3] = MFMA16K16(NAF(3, 1), x1, R[3]); }
            X[2] = MFMA16K16(NAF(2, 2), pk4(R[2]), Z);
            { const bf16x4 x2 = pk4(X[2]); R[3] = MFMA16K16(NAF(3, 2), x2, R[3]); }
            X[3] = MFMA16K16(NAF(3, 3), pk4(R[3]), Z);
#undef NAF
#pragma unroll
            for (int i = 0; i < 4; ++i)
#pragma unroll
                for (int r = 0; r < 4; ++r) *(LAS bf16*)(lds + GQ_RAW + half * MAT + (16 * i + 4 * fq + r) * (PT * 2) + (c0 + fr) * 2) = (bf16)f2bf(X[i][r]);
        }
        LBAR();
        if (live) for (int i = j; i < 64 * 16; i += 256) { const int t = (i >> 3) & 63, ch = i & 7, half = i >> 9;
            const v4u v = *(const LAS v4u*)(lds + GQ_RAW + half * MAT + t * (PT * 2) + ch * 16);
            if (half == 0) *(GAS v4u*)(MIX + (tok0 + t) * MIX_LD + MX_AV + h * 64 + ch * 8) = v; else *(GAS v4u*)(GW + (tok0 + t) * 512 + h * 64 + ch * 8) = v; }
    }
    LBAR();
}
#ifndef MK_ONE_LAUNCH
#define MK_ONE_LAUNCH 1
#endif
#ifndef MK_NAIVE
#define MK_NAIVE 0
#endif
__global__ void __launch_bounds__(64) mixers_naive(Args args, int layer) {
    const int lane = threadIdx.x, w = blockIdx.x, kind = w >> 6, b = (w & 63) >> 3, h = w & 7;
    unsigned char* ws = args.ws;
    bf16* ZB = (bf16*)(ws + WS_ZB); const bf16* MIX = (const bf16*)(ws + WS_MIX); float* SM = (float*)(ws + WS_SM); const float* ROPE = (const float*)(ws + WS_ROPE);
    if (kind == 0) gdn_naive(args, layer, b, h, lane, MIX, SM, ZB);
    else if (kind == 1) ssd_naive(args, layer, b, h, lane, MIX, SM, ZB);
    else ret_naive(b, h, lane, MIX, ROPE, ZB);
}
__global__ void __launch_bounds__(512, 2) fwd_kernel(Args args) {
    extern __shared__ __attribute__((aligned(16))) unsigned char lds_raw[];
    LAS unsigned char* lds = (LAS unsigned char*)lds_raw;
    volatile LAS unsigned* MISC = (volatile LAS unsigned*)(lds + MISC_OFF);
    const int G = gridDim.x, NGW = G * 8;
    unsigned char* ws0 = args.ws;
    for (int u = threadIdx.x; u < (LDS_BYTES - RING_BYTES) / 4; u += 512) ((LAS unsigned*)(lds + RING_BYTES))[u] = 0u;
    __syncthreads();
#if MK_ONE_LAUNCH
    XcdBarrier bar = xcd_barrier_post((unsigned*)(ws0 + WS_CTL) + 4096, MISC + 8);
#define GRID_BAR() do { XcdBarrier b_ = bar; asm volatile("" : "+s"(b_.bar), "+s"(b_.x)); xcd_barrier(b_); } while (0)
#else
#define GRID_BAR() do {} while (0)
#endif
    const int lo = args.ph_lo, hi = args.ph_hi;
#define IN(p) (lo <= (p) && (p) < hi)
#define SEAM(p) do { if (IN(p) && IN((p) + 1)) GRID_BAR(); } while (0)
    typedef const __attribute__((address_space(4))) Args* KArgs;
    const KArgs kp0 = (KArgs)__builtin_amdgcn_kernarg_segment_ptr();
#define PHASE_PTRS() KArgs kp = kp0; asm volatile("" : "+s"(kp)); unsigned char* ws = kp->ws; float* X = kp->out; (void)X; \
    int tid = threadIdx.x; asm volatile("" : "+v"(tid)); int bx = blockIdx.x; asm volatile("" : "+s"(bx)); const int lane = tid & 63, wave = __builtin_amdgcn_readfirstlane(tid >> 6), gw = bx * 8 + wave; (void)lane; (void)gw; \
    bf16* ZB = (bf16*)(ws + WS_ZB); bf16* MIX = (bf16*)(ws + WS_MIX); float* SM = (float*)(ws + WS_SM); (void)ZB; (void)MIX; (void)SM; \
    float* SSQA = (float*)(ws + WS_SSQA); float* SSQB = (float*)(ws + WS_SSQB); float* SSQC = (float*)(ws + WS_SSQC); float* ROPE = (float*)(ws + WS_ROPE); (void)SSQA; (void)SSQB; (void)SSQC; (void)ROPE; \
    bf16* W1T = (bf16*)(ws + W_1T); bf16* WGT = (bf16*)(ws + W_GT); bf16* WMT = (bf16*)(ws + W_MT); bf16* WOT = (bf16*)(ws + W_OT); bf16* WUT = (bf16*)(ws + W_UT); (void)W1T; (void)WGT; (void)WMT; (void)WOT; (void)WUT; \
    bf16* WDT = (bf16*)(ws + W_DT); bf16* WPGT = (bf16*)(ws + W_PGT); bf16* WPPT = (bf16*)(ws + W_PPT); (void)WDT; (void)WPGT; (void)WPPT; \
    bf16* GATE = (bf16*)(ws + WS_GATE); bf16* U = (bf16*)(ws + WS_U); bf16* PB = (bf16*)(ws + WS_PB); bf16* PLE = (bf16*)(ws + WS_PLE); (void)GATE; (void)U; (void)PB; (void)PLE; \
    bf16* XBl = (bf16*)(ws + ((layer & 1) ? WS_XB1 : WS_XB0)); bf16* XBf = (bf16*)(ws + ((layer & 1) ? WS_XB0 : WS_XB1)); (void)XBl; (void)XBf
    if (IN(0)) { const int layer = 0; PHASE_PTRS();
        for (int e = bx * 512 + tid; e < SEQ * 32; e += G * 512) { const int t = e >> 5, i = e & 31;
            double f = 1.0; for (int j = 0; j < i; ++j) f *= 0.7429639507594948;
            const double ang = (double)t * f, kk = rint(ang * 0.15915494309189535);
            double r = fma(-kk, 6.283185307179586, ang); r = fma(-kk, 2.4492935982947064e-16, r); const double r2 = r * r;
            double sn = 1.0, cs = 1.0;
    #pragma unroll
            for (int n = 15; n >= 1; --n) { sn = 1.0 - r2 * (1.0 / (double)((2 * n) * (2 * n + 1))) * sn; cs = 1.0 - r2 * (1.0 / (double)((2 * n - 1) * (2 * n))) * cs; }
            ROPE[e] = (float)cs; ROPE[SEQ * 32 + e] = (float)(r * sn); }
    }
    for (int layer = 0; layer < DEPTH; ++layer) {
        const int P = layer * NPH;
        if (IN(P + 0)) { PHASE_PTRS();
            int ibase = 0;
            const float* w_in = kp->in[3] + (size_t)layer * DM * NIN; const float* nmix = kp->in[2] + (size_t)layer * DM;
            TR_SEG(w_in, NIN, 1536, 512, DM, nmix, W1T, DM, 0, 0);
            TR_SEG(w_in, NIN, 2064, 512, DM, nmix, W1T, DM, 512, 0);
            TR_SEG(w_in, NIN, 4888, 512, DM, nmix, W1T, DM, 1024, 0);
            TR_SEG(w_in, NIN, 0, 1536, DM, nmix, W1T, DM, 1536, 0);
            TR_SEG(w_in, NIN, 2576, 768, DM, nmix, W1T, DM, 3072, 0);
            TR_SEG(w_in, NIN, 3352, 1536, DM, nmix, W1T, DM, 3840, 0);
            TR_SEG(w_in, NIN, 2048, 16, DM, nmix, W1T, DM, 5376, 0);
            TR_SEG(w_in, NIN, 3344, 8, DM, nmix, W1T, DM, 5392, 0);
            TR_SEG((const float*)nullptr, NIN, 0, 232, DM, (const float*)nullptr, W1T, DM, 5400, 0);
            TR_SEG(w_in, NIN, 5400, 3072, DM, nmix, WGT, DM, 0, 0);
            const float* wbr = kp->in[14] + (size_t)layer * 3 * 512 * DM;
            TR_SEG(wbr, DM, 0, DM, 512, (const float*)nullptr, WMT, KMERGE, 0, 0);
            TR_SEG(wbr + 512 * DM, DM, 0, DM, 512, kp->in[13] + (size_t)layer * 512, WMT, KMERGE, 0, 512);
            TR_SEG(wbr + 2 * 512 * DM, DM, 0, DM, 512, (const float*)nullptr, WMT, KMERGE, 0, 1024);
            TR_SEG(kp->in[15] + (size_t)layer * DM * DM, DM, 0, DM, DM, (const float*)nullptr, WOT, DM, 0, 0);
            TR_SEG(kp->in[17] + (size_t)layer * DM * DFF, DFF, 0, DFF, DM, kp->in[16] + (size_t)layer * DM, WUT, DM, 0, 0);
            TR_SEG(kp->in[18] + (size_t)layer * DFF * DM, DM, 0, DM, DFF, (const float*)nullptr, WDT, DFF, 0, 0);
            TR_SEG(kp->in[20] + (size_t)layer * DM * DM, DM, 0, DM, DM, kp->in[19] + (size_t)layer * DM, WPGT, DM, 0, 0);
            TR_SEG(kp->in[21] + (size_t)layer * PLED * DM, DM, 0, DM, PLED, (const float*)nullptr, WPPT, PLED, 0, 0);
            if (layer == 0) {
                const float* xin = kp->in[0];
                for (int m = gw; m < MTOK; m += NGW) {
                    const GAS f32x4* xr = (const GAS f32x4*)(xin + (size_t)m * DM) + lane; f32x4 v[4]; float s = 0.f;
#pragma unroll
                    for (int j = 0; j < 4; ++j) { v[j] = xr[64 * j]; s += (v[j].x * v[j].x + v[j].y * v[j].y) + (v[j].z * v[j].z + v[j].w * v[j].w); }
                    s = wave_sum(s);
                    GAS v2u* o8 = (GAS v2u*)(XBl + (size_t)m * DM) + lane;
#pragma unroll
                    for (int j = 0; j < 4; ++j) { v2u w; w.x = pk2(v[j].x, v[j].y); w.y = pk2(v[j].z, v[j].w); o8[64 * j] = w; }
                    if (lane < 16) SSQC[(size_t)m * 16 + lane] = lane == 0 ? s : 0.f;
                }
            }
        }
        SEAM(P + 0);
        if (IN(P + 1)) { PHASE_PTRS();
            pg8::Gemm g{XBl, W1T, MTOK, N1, DM}; pg8::StaticOrder S; S.init(MTOK, N1, G, bx);
            pg8::EpiP1 E{ZB, MIX, SM, SSQC, (bf16*)((unsigned char*)XBf + HALO_OFF)};
            pg8::gemm_phase<pg8::EpiP1, pg8::StaticOrder, true, true>(lds, g, S, E);
        }
        SEAM(P + 1);
        if (IN(P + 2)) { PHASE_PTRS();
#if !MK_NAIVE
            gdn_prep(kp, layer, lds, G);
            ssd_prep(kp, layer, lds, G);
            ret_prep(kp, G);
#endif
        }
        SEAM(P + 2);
        if (IN(P + 3)) { PHASE_PTRS();
#if !MK_NAIVE
            for (int w = bx; w < 192; w += G) { const int kind = w >> 6, b = (w & 63) >> 3, h = w & 7;
                if (kind == 0) mixer_walk<0>(kp, layer, b, h, lds);
                else if (kind == 1) mixer_walk<1>(kp, layer, b, h, lds);
                else mixer_walk<2>(kp, layer, b, h, lds);
                __syncthreads(); }
#endif
        }
        SEAM(P + 3);
        if (IN(P + 4)) { PHASE_PTRS();
            for (int m = gw; m < MTOK; m += NGW) {
                GAS v4u* yp = (GAS v4u*)(ZB + (size_t)m * ZB_LD + 512) + lane; const v4u w = *yp;
                const f32x4 sq = *(const f32x4*)(SM + (size_t)m * SM_LD + 16 + 4 * (lane >> 5));
                const float rstd = rsqrtf(((sq[0] + sq[1]) + (sq[2] + sq[3])) * (1.0f / 256.0f) + 1e-6f);
                v4u o; o.x = pk2(pg8::bflo(w.x) * rstd, pg8::bfhi(w.x) * rstd); o.y = pk2(pg8::bflo(w.y) * rstd, pg8::bfhi(w.y) * rstd);
                o.z = pk2(pg8::bflo(w.z) * rstd, pg8::bfhi(w.z) * rstd); o.w = pk2(pg8::bflo(w.w) * rstd, pg8::bfhi(w.w) * rstd);
                *yp = o;
            }
            pg8::Gemm g{XBl, WGT, MTOK, NGATE, DM}; pg8::StaticOrder S; S.init(MTOK, NGATE, G, bx);
            pg8::EpiRS<2> E{GATE, NGATE, SSQC};
            pg8::gemm_phase<pg8::EpiRS<2>, pg8::StaticOrder, true, true>(lds, g, S, E);
        }
        SEAM(P + 4);
        if (IN(P + 5)) { PHASE_PTRS();
            pg8::Gemm g{ZB, WMT, MTOK, DM, KMERGE}; pg8::StaticOrder S; S.init(MTOK, DM, G, bx);
            pg8::EpiMerge E{GATE, XBf};
            pg8::gemm_phase<pg8::EpiMerge, pg8::StaticOrder, true, true>(lds, g, S, E);
        }
        SEAM(P + 5);
        if (IN(P + 6)) { PHASE_PTRS();
            const float* pl = kp->in[1] + (size_t)layer * MTOK * PLED;
            for (size_t e = (size_t)bx * 512 + tid; e < (size_t)MTOK * PLED / 4; e += (size_t)G * 512) { const f32x4 v = ((const GAS f32x4*)pl)[e]; v2u w; w.x = pk2(v.x, v.y); w.y = pk2(v.z, v.w); ((GAS v2u*)PB)[e] = w; }
            pg8::Gemm g{XBf, WOT, MTOK, DM, DM}; pg8::StaticOrder S; S.init(MTOK, DM, G, bx);
            pg8::EpiResid<0> E{layer == 0 ? kp->in[0] : X, X, XBl, SSQA, nullptr, nullptr,  1.0f};
            pg8::gemm_phase<pg8::EpiResid<0>, pg8::StaticOrder, true, true>(lds, g, S, E);
        }
        SEAM(P + 6);
        if (IN(P + 7)) { PHASE_PTRS();
            { pg8::Gemm g{XBl, WUT, MTOK, DFF, DM}; pg8::StaticOrder S; S.init(MTOK, DFF, G, bx);
              pg8::EpiRS<1> E{U, DFF, SSQA};
              pg8::gemm_phase<pg8::EpiRS<1>, pg8::StaticOrder, true, true>(lds, g, S, E); }
        }
        SEAM(P + 7);
        if (IN(P + 8)) { PHASE_PTRS();
            pg8::Gemm g{U, WDT, MTOK, DM, DFF}; pg8::StaticOrder S; S.init(MTOK, DM, G, bx);
            pg8::EpiResid<0> E{X, X, XBl, SSQB, nullptr, nullptr,  1.0f};
            pg8::gemm_phase<pg8::EpiResid<0>, pg8::StaticOrder, true, true>(lds, g, S, E);
            __builtin_amdgcn_sched_barrier(0);
            { pg8::Gemm g{PB, WPPT, MTOK, DM, PLED}; pg8::StaticOrder S; S.init(MTOK, DM, G, bx);
              pg8::EpiRS<0> E{PLE, DM, nullptr};
              pg8::gemm_phase<pg8::EpiRS<0>, pg8::StaticOrder, true, true>(lds, g, S, E); }
        }
        SEAM(P + 8);
        if (IN(P + 9)) { PHASE_PTRS();
            pg8::Gemm g{XBl, WPGT, MTOK, DM, DM}; pg8::StaticOrder S; S.init(MTOK, DM, G, bx);
            pg8::EpiResid<1> E{X, X, XBf, SSQC, SSQB, PLE,  1.0f};
            pg8::gemm_phase<pg8::EpiResid<1>, pg8::StaticOrder, true, true>(lds, g, S, E);
        }
        SEAM(P + 9);
    }
    if (IN(PH_FINAL)) { const int layer = 0; PHASE_PTRS();
        const float* nf = kp->in[22];
        for (int m = gw; m < MTOK; m += NGW) {
            const float sp = lane < 16 ? SSQC[(size_t)m * 16 + lane] : 0.f;
            const float rstd = rsqrtf(wave_sum(sp) * (1.0f / 1024.0f) + 1e-6f);
            GAS f32x4* xr = (GAS f32x4*)(X + (size_t)m * DM) + lane;
#pragma unroll
            for (int j = 0; j < 4; ++j) { const f32x4 v = xr[64 * j], w = ((const GAS f32x4*)nf)[64 * j + lane]; xr[64 * j] = v * rstd * w; }
        }
    }
#undef IN
#undef SEAM
}

extern "C" void kernel_launch(void* const* d_in, const int* in_sizes, int n_in, void* d_out, int out_size, void* d_ws, size_t ws_size, hipStream_t stream) {
    static int grid = 0;
    if (grid == 0) {
        if (n_in != 23 || out_size != MTOK * DM || ws_size < WS_END) { fprintf(stderr, "kernel_launch: unexpected problem (n_in %d, out %d, ws %zu < %zu)\n", n_in, out_size, ws_size, (size_t)WS_END); grid = -1; return; }
        int dev = 0, cus = 0;
        if (hipGetDevice(&dev) != hipSuccess || hipDeviceGetAttribute(&cus, hipDeviceAttributeMultiprocessorCount, dev) != hipSuccess) { grid = -1; return; }
        if (hipFuncSetAttribute((const void*)fwd_kernel, hipFuncAttributeMaxDynamicSharedMemorySize, LDS_BYTES) != hipSuccess) { fprintf(stderr, "kernel_launch: hipFuncSetAttribute failed\n"); grid = -1; return; }
        int per_cu = 0;
        if (hipOccupancyMaxActiveBlocksPerMultiprocessor(&per_cu, (const void*)fwd_kernel, 512, LDS_BYTES) != hipSuccess || per_cu < 1) { fprintf(stderr, "kernel_launch: occupancy query says %d blocks per CU\n", per_cu); }
        (void)hipGetLastError();
        grid = cus;
    }
    if (grid < 0) return;
    (void)hipMemsetAsync((char*)d_ws + WS_CTL, 0, CTL_BYTES, stream);
    Args a; memset(&a, 0, sizeof(a));
    for (int i = 0; i < 23; ++i) a.in[i] = (const float*)d_in[i];
    a.out = (float*)d_out; a.ws = (unsigned char*)d_ws;
#if MK_ONE_LAUNCH
    a.ph_lo = 0; a.ph_hi = N_PHASES;
    hipLaunchKernelGGL(fwd_kernel, dim3(grid), dim3(512), LDS_BYTES, stream, a);
#else
    for (int p = 0; p < N_PHASES; ++p) {
#if MK_NAIVE
        if (p != PH_FINAL && (p % NPH) == 3) { hipLaunchKernelGGL(mixers_naive, dim3(192), dim3(64), 0, stream, a, p / NPH); continue; }
#endif
        a.ph_lo = p; a.ph_hi = p + 1;
        hipLaunchKernelGGL(fwd_kernel, dim3(grid), dim3(512), LDS_BYTES, stream, a);
    }
#endif
}
```

```cpp
#include <hip/hip_runtime.h>
#include <cstdio>
#include <cstdint>
#include <cstring>
namespace pg8 {
#define PG8_LAS __attribute__((address_space(3)))
typedef unsigned short bf16_t;
typedef short bf16x8 __attribute__((ext_vector_type(8)));
typedef float f32x4 __attribute__((ext_vector_type(4)));
typedef unsigned u32x4 __attribute__((ext_vector_type(4)));
constexpr int BM = 256, BK = 64, HALF = 128, HTB = HALF * BK * 2  , STAGE_BYTES = 8 * HTB, NXCD = 8, WGM = 8;

__host__ __device__ __forceinline__ int lds_byte(int r, int c) { const int st = (r >> 4) * 2 + (c >> 5), rr = r & 15, cc = c & 31, ob = rr * 64 + cc * 2; return st * 1024 + (ob ^ (((ob >> 9) & 1) << 5)); }
__host__ __device__ __forceinline__ void stage_rc(int b, int& R, int& C) { const int st = b / 1024, sb = b % 1024, swz = sb ^ (((sb >> 9) & 1) << 5); R = (st >> 1) * 16 + swz / 64; C = (st & 1) * 32 + (swz % 64) / 2; }
__host__ __device__ __forceinline__ int perm32(int rho) { const int n = rho >> 4, i = rho & 15; return 8 * (i >> 2) + 4 * n + (i & 3); }

struct Unit { int pm, pn; };
struct Gemm { const bf16_t* A; const bf16_t* Bt; int M, N, K; };

struct StaticOrder {
    int nM, nN, nwg, G, c;
    __host__ __device__ void init(int M, int N, int G_, int c_) { nM = M / BM; nN = N / BM; nwg = nM * nN; G = G_; c = c_; }
    __host__ __device__ bool next(int i, Unit& u) const {
        const long L = (long)i * G + c; if (L >= nwg) return false;
        int wgid = (int)L; { const int q = nwg / NXCD, r = nwg % NXCD, xcd = wgid % NXCD, off = wgid / NXCD; wgid = (xcd < r ? xcd * (q + 1) : r * (q + 1) + (xcd - r) * q) + off; }
        const int nig = WGM * nN, gid = wgid / nig, fm = gid * WGM, gsz = (nM - fm) < WGM ? (nM - fm) : WGM;
        u.pm = fm + ((wgid % nig) % gsz); u.pn = (wgid % nig) / gsz; return true;
    }
    __device__ __forceinline__ void a_ready(const Unit&) const {}
    __device__ __forceinline__ void done(const Unit&) const {}
};

typedef float f32x2c __attribute__((ext_vector_type(2))); typedef __bf16 bf16x2c __attribute__((ext_vector_type(2)));
__device__ __forceinline__ unsigned cvt_pk_bf16(float lo, float hi) { const f32x2c v = {lo, hi}; const bf16x2c b = __builtin_convertvector(v, bf16x2c); return __builtin_bit_cast(unsigned, b); }
typedef unsigned u32x2 __attribute__((ext_vector_type(2)));
__device__ __forceinline__ float bflo(unsigned w) { return __uint_as_float(w << 16); }
__device__ __forceinline__ float bfhi(unsigned w) { return __uint_as_float(w & 0xffff0000u); }
__device__ __forceinline__ u32x4 pack8(const f32x4 v0, const f32x4 v1) { u32x4 w; w.x = cvt_pk_bf16(v0[0], v0[1]); w.y = cvt_pk_bf16(v0[2], v0[3]); w.z = cvt_pk_bf16(v1[0], v1[1]); w.w = cvt_pk_bf16(v1[2], v1[3]); return w; }
__device__ __forceinline__ void unpack8(const u32x4 w, f32x4& v0, f32x4& v1) { v0 = (f32x4){bflo(w.x), bfhi(w.x), bflo(w.y), bfhi(w.y)}; v1 = (f32x4){bflo(w.z), bfhi(w.z), bflo(w.w), bfhi(w.w)}; }
constexpr float RMS_EPS = 1e-6f;
constexpr int RS_SLOTS = 8;
__device__ __forceinline__ void load_rstd(const PG8_LAS unsigned char* rst, int pm, int wr, int fr, float (&rs)[2][4]) {
    if (rst == nullptr) {
#pragma unroll
        for (int ai = 0; ai < 2; ++ai)
#pragma unroll
            for (int m = 0; m < 4; ++m) rs[ai][m] = 1.0f;
        return; }
    const PG8_LAS int* pml = (const PG8_LAS int*)rst; int slot = 0;
#pragma unroll
    for (int k = 1; k < RS_SLOTS; ++k) slot = pml[k] == pm ? k : slot;
    const PG8_LAS float* tab = (const PG8_LAS float*)(rst + 32) + slot * 256 + wr * 64 + fr;
#pragma unroll
    for (int ai = 0; ai < 2; ++ai)
#pragma unroll
        for (int m = 0; m < 4; ++m) rs[ai][m] = tab[ai * HALF + m * 16];
}
struct EpiP1 {
    static constexpr bool PERM = true, AFTER_DRAIN = false, HOOK = false; static constexpr int SEG1 = -1, SEG2 = -1;
    bf16_t* ZB; bf16_t* MIX; float* SM; const PG8_LAS unsigned char* rst; bf16_t* HALO;
    __device__ __forceinline__ void rescale(f32x4 (&)[2][2][4][2], const Unit&, int, int, int, int, int) const {}
    __device__ __forceinline__ void operator()(const f32x4 (&acc)[2][2][4][2], const Unit& u, int wr, int wc, int fr, int fq) const {
        const int row0 = u.pm * BM + wr * 64 + fr;
        float rs[2][4]; load_rstd(rst, u.pm, wr, fr, rs);
        if (u.pn == 21) {
            if (wc == 0) {
#pragma unroll
                for (int ai = 0; ai < 2; ++ai)
#pragma unroll
                    for (int m = 0; m < 4; ++m) { float* p = SM + (size_t)(row0 + ai * HALF + m * 16) * 32 + 8 * fq;
                        *(f32x4*)p = acc[ai][0][m][0] * rs[ai][m]; *(f32x4*)(p + 4) = acc[ai][0][m][1] * rs[ai][m]; }
            }
            return;
        }
        bf16_t* base; int ldc, colt;
        if (u.pn < 6) { base = ZB; ldc = 1536; colt = u.pn * BM; } else { base = MIX; ldc = 3840; colt = (u.pn - 6) * BM; }
        const int col0 = colt + wc * 32 + 8 * fq;
#pragma unroll
        for (int ai = 0; ai < 2; ++ai)
#pragma unroll
            for (int m = 0; m < 4; ++m) { bf16_t* rowp = base + (size_t)(row0 + ai * HALF + m * 16) * ldc + col0;
#pragma unroll
                for (int bj = 0; bj < 2; ++bj) { const u32x4 w = pack8(acc[ai][bj][m][0] * rs[ai][m], acc[ai][bj][m][1] * rs[ai][m]); *(u32x4*)(rowp + bj * HALF) = w;
                    if (m == 3 && fr >= 13 && u.pn >= 6 && u.pn < 15) *(u32x4*)(HALO + ((size_t)((row0 + ai * HALF + m * 16) >> 6) * 3 + (fr - 13)) * 2304 + col0 + bj * HALF) = w; } }
    }
};
template <int ACT> struct EpiRS {
    static constexpr bool PERM = true, AFTER_DRAIN = false, HOOK = false; static constexpr int SEG1 = -1, SEG2 = -1;
    bf16_t* O; int ldc; const PG8_LAS unsigned char* rst;
    __device__ __forceinline__ void rescale(f32x4 (&)[2][2][4][2], const Unit&, int, int, int, int, int) const {}
    __device__ __forceinline__ void operator()(const f32x4 (&acc)[2][2][4][2], const Unit& u, int wr, int wc, int fr, int fq) const {
        const int row0 = u.pm * BM + wr * 64 + fr, col0 = u.pn * BM + wc * 32 + 8 * fq;
        float rs[2][4]; load_rstd(rst, u.pm, wr, fr, rs);
#pragma unroll
        for (int ai = 0; ai < 2; ++ai)
#pragma unroll
            for (int m = 0; m < 4; ++m) { bf16_t* rowp = O + (size_t)(row0 + ai * HALF + m * 16) * ldc + col0;
#pragma unroll
                for (int bj = 0; bj < 2; ++bj) { f32x4 v0 = acc[ai][bj][m][0] * rs[ai][m], v1 = acc[ai][bj][m][1] * rs[ai][m];
                    if (ACT == 1) {
#pragma unroll
                        for (int j = 0; j < 4; ++j) { const float a = fmaxf(v0[j], 0.f), b = fmaxf(v1[j], 0.f); v0[j] = a * a; v1[j] = b * b; } }
                    if (ACT == 2) {
#pragma unroll
                        for (int j = 0; j < 4; ++j) { v0[j] = __builtin_amdgcn_rcpf(1.0f + __expf(-v0[j])); v1[j] = __builtin_amdgcn_rcpf(1.0f + __expf(-v1[j])); } }
                    *(u32x4*)(rowp + bj * HALF) = pack8(v0, v1); } }
    }
};
struct EpiMerge {
    static constexpr bool PERM = true, AFTER_DRAIN = false, HOOK = true; static constexpr int SEG1 = 8, SEG2 = 16;
    const bf16_t* GATE; bf16_t* O;
    __device__ __forceinline__ void rescale(f32x4 (&acc)[2][2][4][2], const Unit& u, int seg, int wr, int wc, int, int) const {
        int t_ = threadIdx.x; asm volatile("" : "+v"(t_)); const int fr = t_ & 15, fq = (t_ & 63) >> 4;
        const int row0 = u.pm * BM + wr * 64 + fr, col0 = u.pn * BM + wc * 32 + 8 * fq + (seg - 1) * 1024;
#pragma unroll
        for (int ai = 0; ai < 2; ++ai)
#pragma unroll
            for (int m = 0; m < 4; ++m) { const bf16_t* gp = GATE + (size_t)(row0 + ai * HALF + m * 16) * 3072 + col0;
#pragma unroll
                for (int bj = 0; bj < 2; ++bj) { const u32x4 wa = *(const u32x4*)(gp + bj * HALF), wb = *(const u32x4*)(gp + bj * HALF + 1024);
                    f32x4 a0, a1, b0, b1; unpack8(wa, a0, a1); unpack8(wb, b0, b1);
#pragma unroll
                    for (int j = 0; j < 4; ++j) {
                        acc[ai][bj][m][0][j] *= a0[j] * __builtin_amdgcn_rcpf(b0[j]);
                        acc[ai][bj][m][1][j] *= a1[j] * __builtin_amdgcn_rcpf(b1[j]); } }
                if (m == 3) asm volatile("" ::: "memory"); }
    }
    __device__ __forceinline__ void operator()(const f32x4 (&acc)[2][2][4][2], const Unit& u, int wr, int wc, int fr, int fq) const {
        const int row0 = u.pm * BM + wr * 64 + fr, col0 = u.pn * BM + wc * 32 + 8 * fq;
#pragma unroll
        for (int ai = 0; ai < 2; ++ai)
#pragma unroll
            for (int m = 0; m < 4; ++m) { const size_t r = (size_t)(row0 + ai * HALF + m * 16);
#pragma unroll
                for (int bj = 0; bj < 2; ++bj) { const u32x4 wa = *(const u32x4*)(GATE + r * 3072 + 2048 + col0 + bj * HALF);
                    f32x4 a0, a1; unpack8(wa, a0, a1); f32x4 v0 = acc[ai][bj][m][0], v1 = acc[ai][bj][m][1];
#pragma unroll
                    for (int j = 0; j < 4; ++j) { v0[j] *= a0[j]; v1[j] *= a1[j]; }
                    *(u32x4*)(O + r * 1024 + col0 + bj * HALF) = pack8(v0, v1); }
                if (m == 3) asm volatile("" ::: "memory"); }
    }
};
template <int MODE> struct EpiResid {
    static constexpr bool PERM = true, AFTER_DRAIN = false, HOOK = false; static constexpr int SEG1 = -1, SEG2 = -1;
    const bf16_t* XBin; bf16_t* XBout; float* ssq_out; const PG8_LAS unsigned char* rst; const bf16_t* PLE; float scale;
    __device__ __forceinline__ void rescale(f32x4 (&)[2][2][4][2], const Unit&, int, int, int, int, int) const {}
    __device__ __forceinline__ void operator()(const f32x4 (&acc)[2][2][4][2], const Unit& u, int wr, int wc, int fr, int fq) const {
        const int row0 = u.pm * BM + wr * 64 + fr, col0 = u.pn * BM + wc * 32 + 8 * fq;
        float rs[2][4]; if (MODE == 1) load_rstd(rst, u.pm, wr, fr, rs);
#pragma unroll
        for (int ai = 0; ai < 2; ++ai)
#pragma unroll
            for (int m = 0; m < 4; ++m) { const size_t r = (size_t)(row0 + ai * HALF + m * 16); float ss = 0.f;
#pragma unroll
                for (int bj = 0; bj < 2; ++bj) { const size_t o = r * 1024 + col0 + bj * HALF;
                    f32x4 v0 = acc[ai][bj][m][0], v1 = acc[ai][bj][m][1], b0, b1; unpack8(*(const u32x4*)(XBin + o), b0, b1);
                    if (MODE == 1) { const u32x4 wp = *(const u32x4*)(PLE + o); f32x4 p0, p1; unpack8(wp, p0, p1);
#pragma unroll
                        for (int j = 0; j < 4; ++j) { v0[j] = p0[j] * __builtin_amdgcn_rcpf(1.0f + __expf(-v0[j] * rs[ai][m])); v1[j] = p1[j] * __builtin_amdgcn_rcpf(1.0f + __expf(-v1[j] * rs[ai][m])); } }
                    v0 = v0 * scale + b0; v1 = v1 * scale + b1;
                    *(u32x4*)(XBout + o) = pack8(v0, v1);
                    ss += (v0[0] * v0[0] + v0[1] * v0[1]) + (v0[2] * v0[2] + v0[3] * v0[3]) + (v1[0] * v1[0] + v1[1] * v1[1]) + (v1[2] * v1[2] + v1[3] * v1[3]); }
                ss += __shfl_xor(ss, 16); ss += __shfl_xor(ss, 32);
                if (fq == 0) ssq_out[r * 16 + u.pn * 4 + wc] = ss;
                if (m == 3) asm volatile("" ::: "memory"); }
    }
};
template <class Epi, class Sched, bool ALIGN_EPI = false, bool SP2 = false>
__device__ __forceinline__ void gemm_phase(PG8_LAS unsigned char* lds, Gemm g, const Sched& S, const Epi& E) {
    asm volatile("" : "+s"(g.A), "+s"(g.Bt), "+s"(g.K));
    int tid_ = threadIdx.x; asm volatile("" : "+v"(tid_));
    const int tid = tid_, wid = __builtin_amdgcn_readfirstlane(tid >> 6), lane = tid & 63, wr = wid >> 2, wc = wid & 3, fr = lane & 15, fq = lane >> 4;
    const int K = g.K, nt = K / BK;
    unsigned voffA[2], voffB[2];
#pragma unroll
    for (int i = 0; i < 2; ++i) { int R, C; stage_rc(tid * 16 + i * 8192, R, C); const int Rb = Epi::PERM ? ((R & ~31) + perm32(R & 31)) : R;
        voffA[i] = (unsigned)(R * K + C) * 2u; voffB[i] = (unsigned)(Rb * K + C) * 2u; }
    const size_t kstep = (size_t)(BK * 2);
    const size_t hstep = (size_t)HALF * K * 2;
    const size_t tstep = 2 * hstep;
    const unsigned ldsw = (unsigned)wid * 1024u;
    const int aoff = lds_byte(wr * 64 + fr, fq * 8), boff = lds_byte(wc * 32 + fr, fq * 8);
#define PG8_SA(b, h) (((b) * 2 + (h)) * HTB)
#define PG8_SB(b, h) ((4 + (b) * 2 + (h)) * HTB)
#define PG8_STAGE(bufoff, gbase, voff) do { _Pragma("unroll") for (int _i = 0; _i < 2; ++_i) \
        __builtin_amdgcn_global_load_lds((const unsigned*)((const char*)(gbase) + (voff)[_i]), (PG8_LAS unsigned*)(lds + (bufoff) + ldsw + _i * 8192), 16, 0, 0); } while (0)
#define PG8_LDA(dst, b, h) do { _Pragma("unroll") for (int m = 0; m < 4; ++m) _Pragma("unroll") for (int k = 0; k < 2; ++k) dst[m][k] = *(const PG8_LAS bf16x8*)(lds + PG8_SA(b, h) + aoff + m * 2048 + k * 1024); } while (0)
#define PG8_LDB(dst, b, h) do { _Pragma("unroll") for (int n = 0; n < 2; ++n) _Pragma("unroll") for (int k = 0; k < 2; ++k) dst[n][k] = *(const PG8_LAS bf16x8*)(lds + PG8_SB(b, h) + boff + n * 2048 + k * 1024); } while (0)
#define PG8_MMA(ai, bj, At, Bt) do { __builtin_amdgcn_s_setprio(1); _Pragma("unroll") for (int m = 0; m < 4; ++m) _Pragma("unroll") for (int n = 0; n < 2; ++n) _Pragma("unroll") for (int k = 0; k < 2; ++k) \
        acc[ai][bj][m][n] = __builtin_amdgcn_mfma_f32_16x16x32_bf16(Bt[n][k], At[m][k], acc[ai][bj][m][n], 0, 0, 0); __builtin_amdgcn_s_setprio(0); } while (0)
#define PG8_WAIT_V(n) asm volatile("s_waitcnt vmcnt(" #n ")" ::: "memory")
#define PG8_WAIT_L(n) asm volatile("s_waitcnt lgkmcnt(" #n ")" ::: "memory")
#define PG8_BAR __builtin_amdgcn_s_barrier()
#define PG8_SCHED __builtin_amdgcn_sched_barrier(0)
    Unit cur, nxt; int ui = 0;
    if (!S.next(0, cur)) return;
    f32x4 acc[2][2][4][2];
#pragma unroll
    for (int a = 0; a < 2; ++a)
#pragma unroll
        for (int b = 0; b < 2; ++b)
#pragma unroll
            for (int m = 0; m < 4; ++m)
#pragma unroll
                for (int n = 0; n < 2; ++n) acc[a][b][m][n] = (f32x4){0.f, 0.f, 0.f, 0.f};
    bf16x8 At[4][2], B0[2][2], B1[2][2];
    const char* cA = (const char*)g.A + (size_t)cur.pm * tstep; const char* cB = (const char*)g.Bt + (size_t)cur.pn * tstep;
    S.a_ready(cur);
    if constexpr (SP2) {
        PG8_STAGE(PG8_SB(0, 0), cB, voffB); PG8_STAGE(PG8_SB(0, 1), cB + hstep, voffB); PG8_STAGE(PG8_SA(0, 0), cA, voffA); PG8_STAGE(PG8_SA(0, 1), cA + hstep, voffA);
        if (wr == 1) PG8_BAR;
        PG8_WAIT_V(2); PG8_BAR;
        PG8_STAGE(PG8_SB(1, 0), cB + kstep, voffB); PG8_STAGE(PG8_SA(1, 0), cA + kstep, voffA); PG8_STAGE(PG8_SB(1, 1), cB + hstep + kstep, voffB);
        PG8_WAIT_V(6); PG8_BAR;
    } else {
        PG8_STAGE(PG8_SB(0, 0), cB, voffB); PG8_STAGE(PG8_SA(0, 0), cA, voffA); PG8_STAGE(PG8_SB(0, 1), cB + hstep, voffB); PG8_STAGE(PG8_SA(0, 1), cA + hstep, voffA);
        if (wr == 1) PG8_BAR;
        PG8_WAIT_V(4); PG8_BAR;
        PG8_STAGE(PG8_SB(1, 0), cB + kstep, voffB); PG8_STAGE(PG8_SA(1, 0), cA + kstep, voffA); PG8_STAGE(PG8_SB(1, 1), cB + hstep + kstep, voffB);
        PG8_WAIT_V(6); PG8_BAR;
    }
    for (;;) {
        const bool has_next = S.next(ui + 1, nxt);
        const char* nA = has_next ? (const char*)g.A + (size_t)nxt.pm * tstep : cA; const char* nB = has_next ? (const char*)g.Bt + (size_t)nxt.pn * tstep : cB;
        for (int t = 0; t < nt; t += 2) {
            const bool last = (t == nt - 2);
            const char* a1 = cA + (size_t)(t + 1) * kstep;
            const char* a2 = last ? nA : cA + (size_t)(t + 2) * kstep; const char* b2 = last ? nB : cB + (size_t)(t + 2) * kstep;
            const char* a3 = a2 + kstep; const char* b3 = b2 + kstep;
            if (last && has_next) S.a_ready(nxt);
            if constexpr (Epi::HOOK) { if (t == Epi::SEG1 || t == Epi::SEG2) E.rescale(acc, cur, t == Epi::SEG1 ? 1 : 2, wr, wc, fr, fq); }
            if constexpr (SP2) {
            PG8_LDB(B0, 0, 0); PG8_LDB(B1, 0, 1); PG8_SCHED; PG8_LDA(At, 0, 0); PG8_STAGE(PG8_SA(1, 1), a1 + hstep, voffA);
            PG8_WAIT_V(8); PG8_WAIT_L(0); PG8_BAR; PG8_MMA(0, 0, At, B0); PG8_MMA(0, 1, At, B1); PG8_BAR; PG8_SCHED;
            PG8_LDA(At, 0, 1); PG8_STAGE(PG8_SB(0, 0), b2, voffB); PG8_STAGE(PG8_SB(0, 1), b2 + hstep, voffB); PG8_STAGE(PG8_SA(0, 0), a2, voffA);
            PG8_WAIT_V(8); PG8_WAIT_L(0); PG8_BAR; PG8_MMA(1, 0, At, B0); PG8_MMA(1, 1, At, B1); PG8_BAR; PG8_SCHED;
            PG8_LDB(B0, 1, 0); PG8_LDB(B1, 1, 1); PG8_SCHED; PG8_LDA(At, 1, 0); PG8_STAGE(PG8_SA(0, 1), a2 + hstep, voffA);
            PG8_WAIT_V(8); PG8_WAIT_L(0); PG8_BAR; PG8_MMA(0, 0, At, B0); PG8_MMA(0, 1, At, B1); PG8_BAR; PG8_SCHED;
            PG8_LDA(At, 1, 1); PG8_STAGE(PG8_SB(1, 0), b3, voffB); PG8_STAGE(PG8_SB(1, 1), b3 + hstep, voffB); PG8_STAGE(PG8_SA(1, 0), a3, voffA);
            PG8_WAIT_V(8); PG8_WAIT_L(0); PG8_BAR; PG8_MMA(1, 0, At, B0); PG8_MMA(1, 1, At, B1); PG8_BAR; PG8_SCHED;
            } else {
            PG8_LDB(B0, 0, 0); PG8_SCHED; PG8_LDA(At, 0, 0); PG8_STAGE(PG8_SA(1, 1), a1 + hstep, voffA);
            PG8_WAIT_L(8); PG8_BAR; PG8_WAIT_L(0); PG8_MMA(0, 0, At, B0); PG8_BAR; PG8_SCHED;
            PG8_LDB(B1, 0, 1); PG8_STAGE(PG8_SB(0, 0), b2, voffB);
            PG8_BAR; PG8_WAIT_L(0); PG8_MMA(0, 1, At, B1); PG8_BAR;
            PG8_LDA(At, 0, 1); PG8_STAGE(PG8_SA(0, 0), a2, voffA);
            PG8_BAR; PG8_WAIT_L(0); PG8_MMA(1, 0, At, B0); PG8_BAR; PG8_SCHED;
            PG8_STAGE(PG8_SB(0, 1), b2 + hstep, voffB);
            PG8_WAIT_V(6); PG8_BAR; PG8_MMA(1, 1, At, B1); PG8_BAR;
            PG8_LDB(B0, 1, 0); PG8_SCHED; PG8_LDA(At, 1, 0); PG8_STAGE(PG8_SA(0, 1), a2 + hstep, voffA);
            PG8_WAIT_L(8); PG8_BAR; PG8_WAIT_L(0); PG8_MMA(0, 0, At, B0); PG8_BAR; PG8_SCHED;
            PG8_LDB(B1, 1, 1); PG8_STAGE(PG8_SB(1, 0), b3, voffB);
            PG8_BAR; PG8_WAIT_L(0); PG8_MMA(0, 1, At, B1); PG8_BAR;
            PG8_LDA(At, 1, 1); PG8_STAGE(PG8_SA(1, 0), a3, voffA);
            PG8_BAR; PG8_WAIT_L(0); PG8_MMA(1, 0, At, B0); PG8_BAR; PG8_SCHED;
            PG8_STAGE(PG8_SB(1, 1), b3 + hstep, voffB);
            PG8_WAIT_V(6); PG8_BAR; PG8_MMA(1, 1, At, B1); PG8_BAR;
            }
        }
        if constexpr (ALIGN_EPI) { if (wr == 0) PG8_BAR; }
        if constexpr (!Epi::AFTER_DRAIN) { int t2_ = threadIdx.x; asm volatile("" : "+v"(t2_)); E(acc, cur, wr, wc, t2_ & 15, (t2_ & 63) >> 4); S.done(cur); }
        if (!has_next) break;
#pragma unroll
        for (int a = 0; a < 2; ++a)
#pragma unroll
            for (int b = 0; b < 2; ++b)
#pragma unroll
                for (int m = 0; m < 4; ++m)
#pragma unroll
                    for (int n = 0; n < 2; ++n) acc[a][b][m][n] = (f32x4){0.f, 0.f, 0.f, 0.f};
        cur = nxt; cA = nA; cB = nB; ++ui;
        if constexpr (ALIGN_EPI) { if (wr == 1) PG8_BAR; }
    }
    PG8_WAIT_V(0);
    if constexpr (!ALIGN_EPI) { if (wr == 0) PG8_BAR; }
    PG8_BAR;
    if constexpr (Epi::AFTER_DRAIN) { E.fused(acc, cur, wr, wc, fr, fq, lds, wid, lane); S.done(cur); }
#undef PG8_SA
#undef PG8_SB
#undef PG8_STAGE
#undef PG8_LDA
#undef PG8_LDB
#undef PG8_MMA
#undef PG8_WAIT_V
#undef PG8_WAIT_L
#undef PG8_BAR
#undef PG8_SCHED
}
}
constexpr int DM = 1024, NBATCH = 8, SEQ = 4096, MTOK = NBATCH * SEQ, DEPTH = 2, DFF = 4096, PLED = 256, NIN = 8472;
constexpr int ZB_LD = 1536, MIX_LD = 3840, SM_LD = 32, N1 = 5632, NGATE = 3072, KMERGE = 1536;
constexpr int MX_AQ = 0, MX_AK = 512, MX_AV = 1024, MX_BX = 1536, MX_BB = 2048, MX_BC = 2176, MX_CQ = 2304, MX_CK = 2816, MX_CV = 3328;
constexpr size_t KiB = 1024, MiB = 1024 * 1024;
constexpr size_t WS_CTL = 0, CTL_BYTES = 64 * KiB;
constexpr size_t WS_W = 64 * KiB;
constexpr size_t W_1T = WS_W, W_GT = W_1T + (size_t)N1 * DM * 2, W_MT = W_GT + (size_t)NGATE * DM * 2, W_OT = W_MT + (size_t)DM * KMERGE * 2, W_UT = W_OT + (size_t)DM * DM * 2,
                 W_DT = W_UT + (size_t)DFF * DM * 2, W_PGT = W_DT + (size_t)DM * DFF * 2, W_PPT = W_PGT + (size_t)DM * DM * 2, W_END = W_PPT + (size_t)DM * PLED * 2;
constexpr size_t WS_SSQA = W_1T + 1 * MiB, WS_SSQB = W_1T + 3 * MiB;
constexpr size_t WS_XB0 = W_END, WS_XB1 = WS_XB0 + 64 * MiB, WS_ZB = WS_XB1 + 64 * MiB, WS_MIX = WS_ZB + 96 * MiB, WS_SM = WS_MIX + 240 * MiB, WS_SSQC = WS_SM + 4 * MiB, WS_ROPE = WS_SSQC + 2 * MiB, WS_END = WS_ROPE + 1 * MiB;
constexpr size_t WS_PB = WS_ZB, WS_PLE = WS_ZB + 16 * MiB, WS_U = WS_ZB + 80 * MiB, WS_GATE = WS_MIX;
static_assert(W_END == WS_W + (size_t)(40 * MiB + 512 * KiB), "weights");
static_assert(WS_U + (size_t)MTOK * DFF * 2 == WS_SM, "U overlay");
static_assert(WS_END <= 512 * MiB, "workspace");
constexpr int LDS_BYTES = 147456, RING_BYTES = 131072, MISC_OFF = RING_BYTES + 320, RS_OFF = RING_BYTES + 1024;
static_assert(RS_OFF + 32 + pg8::RS_SLOTS * 1024 <= LDS_BYTES, "LDS map");

#define GAS __attribute__((address_space(1)))
#define LAS __attribute__((address_space(3)))
typedef unsigned short bf16;
typedef unsigned v4u __attribute__((ext_vector_type(4)));
typedef unsigned v2u __attribute__((ext_vector_type(2)));
typedef float f32x4 __attribute__((ext_vector_type(4)));
#define LDS_WAIT() asm volatile("s_waitcnt lgkmcnt(0)" ::: "memory")
typedef float f32x2_t __attribute__((ext_vector_type(2))); typedef __bf16 bf16x2_t __attribute__((ext_vector_type(2)));
__device__ __forceinline__ unsigned pk2(float lo, float hi) { f32x2_t v = {lo, hi}; bf16x2_t b = __builtin_convertvector(v, bf16x2_t); return __builtin_bit_cast(unsigned, b); }
__device__ __forceinline__ unsigned f2bf(float f) { return pk2(f, 0.f) & 0xffffu; }
__device__ __forceinline__ float bf2f(bf16 v) { return __uint_as_float((unsigned)v << 16); }
__device__ __forceinline__ float wave_sum(float v) {
#pragma unroll
    for (int o = 1; o < 64; o <<= 1) v += __shfl_xor(v, o);
    return v;
}
__device__ __forceinline__ float siluf(float x) { return x * __builtin_amdgcn_rcpf(1.0f + __expf(-x)); }
__device__ __forceinline__ float sigmf(float x) { return __builtin_amdgcn_rcpf(1.0f + __expf(-x)); }
__device__ __forceinline__ float softplusf(float x) { return fmaxf(x, 0.f) + log1pf(__expf(-fabsf(x))); }
__device__ __forceinline__ float rdl(float v, int l) { return __int_as_float(__builtin_amdgcn_readlane(__float_as_int(v), l)); }

#define XB_TMO      128
#define XB_XCNT(j)  (256  + 64 * (j))
#define XB_XSUB(j)  (1280 + 64 * (j))
#define XB_XGEN(j)  (2304 + 64 * (j))
#define XB_TOP      3328
#define XB_TOPGEN   3392
#define XCD_BAR_WORDS 3456
#define XB_SPIN_CAP (1u << 18)
__device__ __forceinline__ unsigned xb_ld(unsigned* p)              { return __hip_atomic_load(p, __ATOMIC_RELAXED, __HIP_MEMORY_SCOPE_AGENT); }
__device__ __forceinline__ unsigned xb_add(unsigned* p, unsigned v) { return __hip_atomic_fetch_add(p, v, __ATOMIC_RELAXED, __HIP_MEMORY_SCOPE_AGENT); }
__device__ __forceinline__ unsigned xb_xcc_id() { return (unsigned)__builtin_amdgcn_s_getreg((3 << 11) | 20) & 0xFu; }
#define XB_SPIN(cond, bar) do { unsigned _sp = 0; while (cond) { __builtin_amdgcn_s_sleep(1); \
    if ((++_sp & 255u) == 0u) { if (xb_ld(&(bar)[XB_TMO])) break; if (_sp > XB_SPIN_CAP) { atomicAdd(&(bar)[XB_TMO], 1u); break; } } } } while (0)
struct XcdBarrier { unsigned* bar; unsigned x; volatile LAS unsigned* st; };
__device__ __forceinline__ XcdBarrier xcd_barrier_post(unsigned* bar, volatile LAS unsigned* st) {
    XcdBarrier b; b.bar = bar; b.x = xb_xcc_id(); b.st = st;
    if (threadIdx.x == 0) (void)xb_add(&bar[XB_XCNT(b.x)], 1u);
    return b;
}
__device__ __forceinline__ void xcd_barrier_complete(unsigned* bar, unsigned x, unsigned& nloc, unsigned& nx) {
    const unsigned G = gridDim.x * gridDim.y * gridDim.z;
    unsigned sum, cnt, mine, sp = 0u;
    for (;;) {
        sum = 0u; cnt = 0u; mine = 0u;
#pragma unroll
        for (unsigned j = 0; j < 16; ++j) { const unsigned c = xb_ld(&bar[XB_XCNT(j)]); sum += c; cnt += (c > 0u) ? 1u : 0u; mine = (j == x) ? c : mine; }
        if (sum == G) break;
        __builtin_amdgcn_s_sleep(1);
        if ((++sp & 255u) == 0u) { if (xb_ld(&bar[XB_TMO])) break; if (sp > XB_SPIN_CAP) { atomicAdd(&bar[XB_TMO], 1u); break; } }
    }
    nloc = mine > 0u ? mine : 1u; nx = cnt > 0u ? cnt : 1u;
}
__device__ __forceinline__ void xcd_barrier(const XcdBarrier& b) {
    asm volatile("s_waitcnt vmcnt(0)" ::: "memory");
    __syncthreads();
    if (threadIdx.x == 0) {
        unsigned* bar = b.bar;
        __builtin_amdgcn_s_waitcnt(0);
        unsigned nloc = b.st[0], nx = b.st[1];
        if (nloc == 0u) { xcd_barrier_complete(bar, b.x, nloc, nx); b.st[0] = nloc; b.st[1] = nx; }
        const unsigned old = xb_add(&bar[XB_XSUB(b.x)], 1u);
        const unsigned gen = old / nloc;
        if (old + 1u == (gen + 1u) * nloc) {
            __builtin_amdgcn_fence(__ATOMIC_RELEASE, "agent");
            asm volatile("s_waitcnt vmcnt(0)" ::: "memory");
            const unsigned og = xb_add(&bar[XB_TOP], 1u);
            const unsigned tg = og / nx;
            if (og + 1u == (tg + 1u) * nx) xb_add(&bar[XB_TOPGEN], 1u);
            else XB_SPIN(xb_ld(&bar[XB_TOPGEN]) == tg, bar);
            __builtin_amdgcn_fence(__ATOMIC_ACQUIRE, "agent");
            xb_add(&bar[XB_XGEN(b.x)], 1u);
            asm volatile("s_waitcnt vmcnt(0)" ::: "memory");
        } else {
            XB_SPIN(xb_ld(&bar[XB_XGEN(b.x)]) == gen, bar);
            __builtin_amdgcn_fence(__ATOMIC_ACQUIRE, "agent");
            asm volatile("s_waitcnt vmcnt(0)" ::: "memory");
        }
    }
    __syncthreads();
}

__device__ __forceinline__ void tr_item(const float* W, int ldw, int c0, int ncols, const float* scale, bf16* dst, int ldd, int r0, int kofs, LAS unsigned char* lds, int item, int tid) {
    const int lane = tid & 63, wave = __builtin_amdgcn_readfirstlane(tid >> 6);
    const int nblk = (ncols + 255) / 256, kb = item / nblk, nb = item - kb * nblk, k0 = 64 * kb, n0 = 256 * nb;
    asm volatile("s_waitcnt lgkmcnt(0)\n\ts_barrier" ::: "memory");
#pragma unroll
    for (int jj = 0; jj < 4; ++jj) { const int n = n0 + lane + 64 * jj; const bool ok = W != nullptr && n < ncols; float v[8];
        const float* wp = W + (size_t)(k0 + 8 * wave) * ldw + c0 + n;
#pragma unroll
        for (int kk = 0; kk < 8; ++kk) { v[kk] = 0.f; if (ok) { v[kk] = wp[(size_t)kk * ldw]; if (scale) v[kk] *= scale[k0 + 8 * wave + kk]; } }
        v4u o; o.x = pk2(v[0], v[1]); o.y = pk2(v[2], v[3]); o.z = pk2(v[4], v[5]); o.w = pk2(v[6], v[7]);
        *(LAS v4u*)(lds + (lane + 64 * jj) * 144 + wave * 16) = o; }
    asm volatile("s_waitcnt lgkmcnt(0)\n\ts_barrier" ::: "memory");
#pragma unroll
    for (int i = 0; i < 4; ++i) { const int nl = (tid >> 3) + 64 * i, ch = tid & 7;
        if (n0 + nl < ncols) *(GAS v4u*)(dst + (size_t)(r0 + n0 + nl) * ldd + kofs + k0 + ch * 8) = *(const LAS v4u*)(lds + nl * 144 + ch * 16); }
}
#define TR_SEG(W_, ldw_, c0_, ncols_, K_, scale_, dst_, ldd_, r0_, kofs_) do { const int _n = ((K_) / 64) * (((ncols_) + 255) / 256); \
    for (int _it = (bx + G - (ibase % G)) % G; _it < _n; _it += G) tr_item(W_, ldw_, c0_, ncols_, scale_, dst_, ldd_, r0_, kofs_, lds, _it, tid); ibase += _n; } while (0)

__device__ __forceinline__ void build_rs_table(const pg8::StaticOrder& S, const float* ssqp, LAS unsigned char* lds, int tid) {
    LAS int* pml = (LAS int*)(lds + RS_OFF); LAS float* tab = (LAS float*)(lds + RS_OFF + 32);
    __syncthreads();
    if (tid == 0) { int npm = 0;
        for (int k = 0; k < pg8::RS_SLOTS; ++k) pml[k] = -1;
        for (int i = 0; ; ++i) { pg8::Unit u; if (!S.next(i, u)) break; bool found = false;
            for (int k = 0; k < npm; ++k) found = found || (pml[k] == u.pm);
            if (!found && npm < pg8::RS_SLOTS) pml[npm++] = u.pm; } }
    __syncthreads();
#pragma unroll 1
    for (int s = tid >> 8; s < pg8::RS_SLOTS; s += 2) { const int pm = pml[s]; if (pm < 0) continue;
        const float* p = ssqp + ((size_t)pm * 256 + (tid & 255)) * 16;
        const f32x4 a = *(const f32x4*)p, b = *(const f32x4*)(p + 4), c = *(const f32x4*)(p + 8), d = *(const f32x4*)(p + 12);
        const float ss = ((a[0] + a[1]) + (a[2] + a[3])) + ((b[0] + b[1]) + (b[2] + b[3])) + ((c[0] + c[1]) + (c[2] + c[3])) + ((d[0] + d[1]) + (d[2] + d[3]));
        tab[s * 256 + (tid & 255)] = rsqrtf(ss * (1.0f / 1024.0f) + 1e-6f); }
    __syncthreads();
}
struct Args { const float* in[23]; float* out; unsigned char* ws; int ph_lo, ph_hi; };
constexpr int NPH = 10, PH_FINAL = DEPTH * NPH, N_PHASES = PH_FINAL + 1;

constexpr int WG = 8;
__device__ __forceinline__ void gdn_naive(const Args& A, int layer, int b, int h, int lane, const bf16* MIX, const float* SM, bf16* ZB) {
    const float* cw = A.in[4] + (size_t)layer * 4 * 1536;
    float wq[4], wk[4], wv[4];
#pragma unroll
    for (int k = 0; k < 4; ++k) { wq[k] = cw[k * 1536 + h * 64 + lane]; wk[k] = cw[k * 1536 + 512 + h * 64 + lane]; wv[k] = cw[k * 1536 + 1024 + h * 64 + lane]; }
    const float Aexp = expf(A.in[5][layer * 8 + h]), dtb = A.in[6][layer * 8 + h], nw = A.in[7][layer * 64 + lane];
    float M[64];
#pragma unroll
    for (int d = 0; d < 64; ++d) M[d] = 0.f;
    float hq0 = 0.f, hq1 = 0.f, hq2 = 0.f, hk0 = 0.f, hk1 = 0.f, hk2 = 0.f, hv0 = 0.f, hv1 = 0.f, hv2 = 0.f;
    const size_t tok0 = (size_t)b * SEQ;
    bf16 nq[WG], nk[WG], nv[WG], nz[WG]; float nb[WG], na[WG];
#define GDN_LOAD(t0) do { _Pragma("unroll") for (int i = 0; i < WG; ++i) { const size_t r = tok0 + (t0) + i; const bf16* mp = MIX + r * MIX_LD + h * 64 + lane; \
        nq[i] = mp[MX_AQ]; nk[i] = mp[MX_AK]; nv[i] = mp[MX_AV]; nz[i] = ZB[r * ZB_LD + h * 64 + lane]; nb[i] = SM[r * SM_LD + h]; na[i] = SM[r * SM_LD + 8 + h]; } } while (0)
    GDN_LOAD(0);
    for (int t0 = 0; t0 < SEQ; t0 += WG) {
        bf16 cq[WG], ck[WG], cv[WG], cz[WG]; float cb[WG], ca[WG];
#pragma unroll
        for (int i = 0; i < WG; ++i) { cq[i] = nq[i]; ck[i] = nk[i]; cv[i] = nv[i]; cz[i] = nz[i]; cb[i] = nb[i]; ca[i] = na[i]; }
        if (t0 + WG < SEQ) GDN_LOAD(t0 + WG);
#pragma unroll
        for (int i = 0; i < WG; ++i) {
            const float xq = bf2f(cq[i]), xk = bf2f(ck[i]), xv = bf2f(cv[i]);
            float q = siluf(wq[0] * hq0 + wq[1] * hq1 + wq[2] * hq2 + wq[3] * xq); hq0 = hq1; hq1 = hq2; hq2 = xq;
            float k = siluf(wk[0] * hk0 + wk[1] * hk1 + wk[2] * hk2 + wk[3] * xk); hk0 = hk1; hk1 = hk2; hk2 = xk;
            const float v = siluf(wv[0] * hv0 + wv[1] * hv1 + wv[2] * hv2 + wv[3] * xv); hv0 = hv1; hv1 = hv2; hv2 = xv;
            q *= rsqrtf(wave_sum(q * q) + 1e-6f) * 0.125f; k *= rsqrtf(wave_sum(k * k) + 1e-6f);
            const float beta = sigmf(cb[i]), a = __expf(-Aexp * softplusf(ca[i] + dtb));
            float r = 0.f;
#pragma unroll
            for (int d = 0; d < 64; ++d) { M[d] *= a; r += rdl(k, d) * M[d]; }
            const float u = beta * (v - r); float o = 0.f;
#pragma unroll
            for (int d = 0; d < 64; ++d) { M[d] += rdl(k, d) * u; o += rdl(q, d) * M[d]; }
            const float y = o * rsqrtf(wave_sum(o * o) * (1.0f / 64.0f) + 1e-6f) * nw * siluf(bf2f(cz[i]));
            ZB[(tok0 + t0 + i) * ZB_LD + h * 64 + lane] = (bf16)f2bf(y);
        }
    }
#undef GDN_LOAD
}
__device__ __forceinline__ void ssd_naive(const Args& A, int layer, int b, int h, int lane, const bf16* MIX, float* SM, bf16* ZB) {
    const int g = h >> 2;
    const float* cw = A.in[8] + (size_t)layer * 4 * 768; const float* cb_ = A.in[9] + (size_t)layer * 768;
    float wx[4], wB[4], wC[4];
#pragma unroll
    for (int k = 0; k < 4; ++k) { wx[k] = cw[k * 768 + h * 64 + lane]; wB[k] = cw[k * 768 + 512 + g * 64 + lane]; wC[k] = cw[k * 768 + 640 + g * 64 + lane]; }
    const float bx = cb_[h * 64 + lane], bB = cb_[512 + g * 64 + lane], bC = cb_[640 + g * 64 + lane];
    const float Aexp = expf(A.in[10][layer * 8 + h]), dtb = A.in[11][layer * 8 + h], Dh = A.in[12][layer * 8 + h];
    float Hs[64];
#pragma unroll
    for (int d = 0; d < 64; ++d) Hs[d] = 0.f;
    float hx0 = 0.f, hx1 = 0.f, hx2 = 0.f, hB0 = 0.f, hB1 = 0.f, hB2 = 0.f, hC0 = 0.f, hC1 = 0.f, hC2 = 0.f;
    const size_t tok0 = (size_t)b * SEQ;
    bf16 nx[WG], nB[WG], nC[WG], nz[WG]; float nd[WG];
#define SSD_LOAD(t0) do { _Pragma("unroll") for (int i = 0; i < WG; ++i) { const size_t r = tok0 + (t0) + i; const bf16* mp = MIX + r * MIX_LD; \
        nx[i] = mp[MX_BX + h * 64 + lane]; nB[i] = mp[MX_BB + g * 64 + lane]; nC[i] = mp[MX_BC + g * 64 + lane]; nz[i] = ZB[r * ZB_LD + 512 + h * 64 + lane]; nd[i] = SM[r * SM_LD + 16 + h]; } } while (0)
    SSD_LOAD(0);
    for (int t0 = 0; t0 < SEQ; t0 += WG) {
        bf16 cx[WG], cB[WG], cC[WG], cz[WG]; float cd[WG];
#pragma unroll
        for (int i = 0; i < WG; ++i) { cx[i] = nx[i]; cB[i] = nB[i]; cC[i] = nC[i]; cz[i] = nz[i]; cd[i] = nd[i]; }
        if (t0 + WG < SEQ) SSD_LOAD(t0 + WG);
#pragma unroll
        for (int i = 0; i < WG; ++i) {
            const float rx = bf2f(cx[i]), rB = bf2f(cB[i]), rC = bf2f(cC[i]);
            const float x = siluf(wx[0] * hx0 + wx[1] * hx1 + wx[2] * hx2 + wx[3] * rx + bx); hx0 = hx1; hx1 = hx2; hx2 = rx;
            const float Bv = siluf(wB[0] * hB0 + wB[1] * hB1 + wB[2] * hB2 + wB[3] * rB + bB); hB0 = hB1; hB1 = hB2; hB2 = rB;
            const float Cv = siluf(wC[0] * hC0 + wC[1] * hC1 + wC[2] * hC2 + wC[3] * rC + bC); hC0 = hC1; hC1 = hC2; hC2 = rC;
            const float dt = softplusf(cd[i] + dtb), a = __expf(-Aexp * dt), xdt = x * dt;
            float y = 0.f;
#pragma unroll
            for (int n = 0; n < 64; ++n) { Hs[n] = a * Hs[n] + xdt * rdl(Bv, n); y += Hs[n] * rdl(Cv, n); }
            y = (y + Dh * x) * siluf(bf2f(cz[i]));
            const float ss = wave_sum(y * y);
            const size_t r = tok0 + t0 + i;
            ZB[r * ZB_LD + 512 + h * 64 + lane] = (bf16)f2bf(y);
            if (lane == 0) SM[r * SM_LD + 24 + h] = ss;
        }
    }
#undef SSD_LOAD
}
__device__ __forceinline__ void ret_naive(int b, int h, int lane, const bf16* MIX, const float* ROPE, bf16* ZB) {
    const float gamma = 1.0f - exp2f(-5.0f - (float)h);
    float M[64];
#pragma unroll
    for (int d = 0; d < 64; ++d) M[d] = 0.f;
    const size_t tok0 = (size_t)b * SEQ;
    bf16 nq[WG], nk[WG], nv[WG], nz[WG]; float nc[WG], ns[WG];
#define RET_LOAD(t0) do { _Pragma("unroll") for (int i = 0; i < WG; ++i) { const size_t r = tok0 + (t0) + i; const bf16* mp = MIX + r * MIX_LD + h * 64 + lane; \
        nq[i] = mp[MX_CQ]; nk[i] = mp[MX_CK]; nv[i] = mp[MX_CV]; nz[i] = ZB[r * ZB_LD + 1024 + h * 64 + lane]; nc[i] = ROPE[((t0) + i) * 32 + (lane & 31)]; ns[i] = ROPE[SEQ * 32 + ((t0) + i) * 32 + (lane & 31)]; } } while (0)
    RET_LOAD(0);
    for (int t0 = 0; t0 < SEQ; t0 += WG) {
        bf16 cq[WG], ck[WG], cv[WG], cz[WG]; float cc[WG], cs[WG];
#pragma unroll
        for (int i = 0; i < WG; ++i) { cq[i] = nq[i]; ck[i] = nk[i]; cv[i] = nv[i]; cz[i] = nz[i]; cc[i] = nc[i]; cs[i] = ns[i]; }
        if (t0 + WG < SEQ) RET_LOAD(t0 + WG);
#pragma unroll
        for (int i = 0; i < WG; ++i) {
            const float q0 = bf2f(cq[i]), k0 = bf2f(ck[i]), v = bf2f(cv[i]);
            const float qp = __shfl_xor(q0, 32), kp = __shfl_xor(k0, 32);
            const float sg = lane < 32 ? -cs[i] : cs[i];
            const float q = q0 * cc[i] + qp * sg, k = (k0 * cc[i] + kp * sg) * 0.125f;
            float o = 0.f;
#pragma unroll
            for (int d = 0; d < 64; ++d) { M[d] = gamma * M[d] + rdl(k, d) * v; o += rdl(q, d) * M[d]; }
            const float y = o * rsqrtf(wave_sum(o * o) * (1.0f / 64.0f) + 1e-6f) * siluf(bf2f(cz[i]));
            ZB[(tok0 + t0 + i) * ZB_LD + 1024 + h * 64 + lane] = (bf16)f2bf(y);
        }
    }
#undef RET_LOAD
}

typedef short bf16x8 __attribute__((ext_vector_type(8)));
constexpr int PT = 72, MAT = 64 * PT * 2;
constexpr int L_Q = 0, L_K = MAT, L_V = 2 * MAT, L_W = 3 * MAT, L_U = 4 * MAT, L_ST0 = 5 * MAT, L_ST1 = 6 * MAT, L_PP = 7 * MAT, L_YT = 8 * MAT,
              YPT = 68, L_G = L_YT + 64 * YPT * 4, L_DT = L_G + 256, L_WEND = L_DT + 256;
static_assert(L_WEND <= RING_BYTES, "walker LDS");
constexpr size_t GW_OFF = 0, HALO_OFF = 32 * MiB;
constexpr int HALO_LD = 2304;
#define MFMA16(a, b, c) __builtin_amdgcn_mfma_f32_16x16x32_bf16(a, b, c, 0, 0, 0)
__device__ __forceinline__ bf16x8 ldfrag(LAS unsigned char* base, int row, int kelem) { return *(const LAS bf16x8*)(base + row * (PT * 2) + kelem * 2); }
__device__ __forceinline__ void unpk8(const v4u w, float (&f)[8]) { f[0] = pg8::bflo(w.x); f[1] = pg8::bfhi(w.x); f[2] = pg8::bflo(w.y); f[3] = pg8::bfhi(w.y); f[4] = pg8::bflo(w.z); f[5] = pg8::bfhi(w.z); f[6] = pg8::bflo(w.w); f[7] = pg8::bfhi(w.w); }
__device__ __forceinline__ v4u pk8(const float (&f)[8]) { v4u w; w.x = pk2(f[0], f[1]); w.y = pk2(f[2], f[3]); w.z = pk2(f[4], f[5]); w.w = pk2(f[6], f[7]); return w; }
__device__ __forceinline__ void st_tr8(LAS unsigned char* base, int row0, int col, const float (&f)[8]) {
#pragma unroll
    for (int j = 0; j < 8; ++j) *(LAS bf16*)(base + (row0 + j) * (PT * 2) + col * 2) = (bf16)f2bf(f[j]);
}

#define LBAR() asm volatile("s_waitcnt lgkmcnt(0)\n\ts_barrier" ::: "memory")
typedef short s16x4 __attribute__((ext_vector_type(4)));
__device__ __forceinline__ s16x4 tr4(LAS unsigned char* p) { return __builtin_bit_cast(s16x4, __builtin_amdgcn_ds_read_tr16_b64_v4i16((LAS s16x4*)p)); }
__device__ __forceinline__ bf16x8 trfrag(LAS unsigned char* tile, int krow0, int col0, int fr) {
    LAS unsigned char* a = tile + (krow0 + (fr >> 2)) * (PT * 2) + (col0 + 4 * (fr & 3)) * 2;
    const s16x4 lo = tr4(a), hi = tr4(a + 4 * PT * 2);
    return (bf16x8){lo[0], lo[1], lo[2], lo[3], hi[0], hi[1], hi[2], hi[3]};
}
__device__ __forceinline__ float bfs(short v) { return __uint_as_float((unsigned)(unsigned short)v << 16); }

template <int KIND>
__device__ __forceinline__ void mixer_walk(const __attribute__((address_space(4))) Args* kp, int layer, int b, int h, LAS unsigned char* lds) {
    int tid = threadIdx.x; asm volatile("" : "+v"(tid));
    const int lane = tid & 63, wave = __builtin_amdgcn_readfirstlane(tid >> 6), fr = lane & 15, fq = lane >> 4;
    const int prow = tid >> 3, pcg = tid & 7;
    unsigned char* ws = kp->ws;
    const bf16* MIX = (const bf16*)(ws + WS_MIX); bf16* ZB = (bf16*)(ws + WS_ZB); float* SM = (float*)(ws + WS_SM);
    const bf16* GW = (const bf16*)(ws + ((layer & 1) ? WS_XB0 : WS_XB1) + GW_OFF);
    const size_t tok0 = (size_t)b * SEQ;
    const int g = h >> 2;
    const int qcol = (KIND == 0 ? MX_AQ + h * 64 : (KIND == 1 ? MX_BC + g * 64 : MX_CQ + h * 64)) + pcg * 8;
    const int kcol = (KIND == 0 ? MX_AK + h * 64 : (KIND == 1 ? MX_BB + g * 64 : MX_CK + h * 64)) + pcg * 8;
    const int vcol = (KIND == 0 ? MX_AV + h * 64 : (KIND == 1 ? MX_BX + h * 64 : MX_CV + h * 64)) + pcg * 8;
    const int zcol = KIND * 512 + h * 64 + pcg * 8;
    const int gcol = (KIND == 0 ? 8 : 16) + h;
    float nw[8];
    if (KIND == 0) {
#pragma unroll
        for (int j = 0; j < 8; ++j) nw[j] = kp->in[7][layer * 64 + pcg * 8 + j];
    }
    const float p_D = KIND == 1 ? kp->in[12][layer * 8 + h] : 0.f;
    const float p_lg = KIND == 2 ? log1pf(-exp2f(-5.0f - (float)h)) : 0.f;
    for (int i = tid; i < MAT / 4; i += 512) ((LAS unsigned*)(lds + L_ST0))[i] = 0u;
    pg8::f32x4 sacc[4];
#pragma unroll
    for (int i = 0; i < 4; ++i) sacc[i] = (pg8::f32x4){0.f, 0.f, 0.f, 0.f};
    LAS float* Gv = (LAS float*)(lds + L_G); LAS float* Dv = (LAS float*)(lds + L_DT);
    LAS unsigned char* PPw = lds + L_PP + (wave & 3) * (16 * PT * 2);

    v4u tq, tk, tv, tw, tz; float sg = 0.f, sd = 1.f; (void)tw;
#define WALK_LOAD(c) do { const size_t row = tok0 + (size_t)(c) * 64 + prow; const bf16* mp = MIX + row * MIX_LD; \
        tq = *(const GAS v4u*)(mp + qcol); tk = *(const GAS v4u*)(mp + kcol); tv = *(const GAS v4u*)(mp + vcol); \
        if (KIND == 0) tw = *(const GAS v4u*)(GW + row * 512 + h * 64 + pcg * 8); \
        tz = *(const GAS v4u*)(ZB + row * ZB_LD + zcol); \
        if (tid < 64) { const size_t r2 = tok0 + (size_t)(c) * 64 + tid; \
            if (KIND == 2) sg = (float)(tid + 1) * p_lg; else sg = SM[r2 * SM_LD + gcol]; \
            if (KIND == 1) sd = SM[r2 * SM_LD + 24 + h]; } } while (0)
#define WALK_PREP() do { \
        *(LAS v4u*)(lds + L_Q + prow * (PT * 2) + pcg * 16) = tq; *(LAS v4u*)(lds + L_K + prow * (PT * 2) + pcg * 16) = tk; \
        if (KIND == 0) { *(LAS v4u*)(lds + L_U + prow * (PT * 2) + pcg * 16) = tv; *(LAS v4u*)(lds + L_W + prow * (PT * 2) + pcg * 16) = tw; } \
        else *(LAS v4u*)(lds + L_V + prow * (PT * 2) + pcg * 16) = tv; \
        if (tid < 64) { Gv[tid] = sg; Dv[tid] = sd; } } while (0)

    WALK_LOAD(0);
    WALK_PREP();
    v4u zc = tz, xc = tv;
    LBAR();
    for (int c = 0; c < SEQ / 64; ++c) {
        LAS unsigned char* STc = lds + ((c & 1) ? L_ST1 : L_ST0); LAS unsigned char* STn = lds + ((c & 1) ? L_ST0 : L_ST1);
        if (c + 1 < SEQ / 64) WALK_LOAD(c + 1);
        bf16x8 Qf[2];
        if (wave < 4) { const int lb = wave;
            Qf[0] = ldfrag(lds + L_Q, 16 * lb + fr, 8 * fq); Qf[1] = ldfrag(lds + L_Q, 16 * lb + fr, 32 + 8 * fq);
            const float gl = Gv[16 * lb + fr];
#pragma unroll
            for (int sb = 0; sb < 4; ++sb) { v2u o; o.x = 0u; o.y = 0u;
                if (sb <= lb) { pg8::f32x4 acc = (pg8::f32x4){0.f, 0.f, 0.f, 0.f};
#pragma unroll
                    for (int ks = 0; ks < 2; ++ks) acc = MFMA16(ldfrag(lds + L_K, 16 * sb + fr, 32 * ks + 8 * fq), Qf[ks], acc);
                    const pg8::f32x4 gs = *(const LAS pg8::f32x4*)(Gv + 16 * sb + 4 * fq); pg8::f32x4 ds = (pg8::f32x4){1.f, 1.f, 1.f, 1.f};
                    if (KIND == 1) ds = *(const LAS pg8::f32x4*)(Dv + 16 * sb + 4 * fq);
                    float pv[4];
#pragma unroll
                    for (int r = 0; r < 4; ++r) pv[r] = (16 * sb + 4 * fq + r <= 16 * lb + fr) ? acc[r] * __expf(gl - gs[r]) * ds[r] : 0.f;
                    o.x = pk2(pv[0], pv[1]); o.y = pk2(pv[2], pv[3]); }
                *(LAS v2u*)(PPw + fr * (PT * 2) + (16 * sb + 4 * fq) * 2) = o; }
        } else if (KIND == 0) { const int wq = wave - 4;
            const bf16x8 Wf0 = ldfrag(lds + L_W, 16 * wq + fr, 8 * fq), Wf1 = ldfrag(lds + L_W, 16 * wq + fr, 32 + 8 * fq);
#pragma unroll
            for (int eb = 0; eb < 4; ++eb) { pg8::f32x4 acc = (pg8::f32x4){0.f, 0.f, 0.f, 0.f};
                acc = MFMA16(Wf0, ldfrag(STc, 16 * eb + fr, 8 * fq), acc); acc = MFMA16(Wf1, ldfrag(STc, 16 * eb + fr, 32 + 8 * fq), acc);
                const s16x4 u4 = tr4(lds + L_U + (16 * wq + 4 * fq + (fr >> 2)) * (PT * 2) + (16 * eb + 4 * (fr & 3)) * 2);
                v2u o; o.x = pk2(bfs(u4[0]) - acc[0], bfs(u4[1]) - acc[1]); o.y = pk2(bfs(u4[2]) - acc[2], bfs(u4[3]) - acc[3]);
                *(LAS v2u*)(lds + L_V + (16 * eb + fr) * (PT * 2) + (16 * wq + 4 * fq) * 2) = o; }
        }
        if (KIND == 0) LBAR();
        if (wave < 4) { const int lb = wave;
            const bf16x8 Pf0 = ldfrag(PPw, fr, 8 * fq), Pf1 = ldfrag(PPw, fr, 32 + 8 * fq);
            const pg8::f32x4 gv = *(const LAS pg8::f32x4*)(Gv + 16 * lb + 4 * fq);
            const pg8::f32x4 eg = (pg8::f32x4){__expf(gv[0]), __expf(gv[1]), __expf(gv[2]), __expf(gv[3])};
#pragma unroll
            for (int eb = 0; eb < 4; ++eb) { pg8::f32x4 acc = (pg8::f32x4){0.f, 0.f, 0.f, 0.f};
                acc = MFMA16(Qf[0], ldfrag(STc, 16 * eb + fr, 8 * fq), acc); acc = MFMA16(Qf[1], ldfrag(STc, 16 * eb + fr, 32 + 8 * fq), acc);
                acc *= eg;
                if (KIND == 0) { acc = MFMA16(Pf0, ldfrag(lds + L_V, 16 * eb + fr, 8 * fq), acc); acc = MFMA16(Pf1, ldfrag(lds + L_V, 16 * eb + fr, 32 + 8 * fq), acc); }
                else { acc = MFMA16(Pf0, trfrag(lds + L_V, 8 * fq, 16 * eb, fr), acc); acc = MFMA16(Pf1, trfrag(lds + L_V, 32 + 8 * fq, 16 * eb, fr), acc); }
#pragma unroll
                for (int r = 0; r < 4; ++r) ((LAS float*)(lds + L_YT))[(16 * lb + 4 * fq + r) * YPT + 16 * eb + fr] = acc[r]; }
        } else { const int db = wave - 4;
            const float glast = Gv[63], egl = __expf(glast);
            bf16x8 Kf[2];
#pragma unroll
            for (int ks = 0; ks < 2; ++ks) { const bf16x8 kr = trfrag(lds + L_K, 32 * ks + 8 * fq, 16 * db, fr);
                const pg8::f32x4 g0 = *(const LAS pg8::f32x4*)(Gv + 32 * ks + 8 * fq), g1 = *(const LAS pg8::f32x4*)(Gv + 32 * ks + 8 * fq + 4);
                pg8::f32x4 d0 = (pg8::f32x4){1.f, 1.f, 1.f, 1.f}, d1 = d0;
                if (KIND == 1) { d0 = *(const LAS pg8::f32x4*)(Dv + 32 * ks + 8 * fq); d1 = *(const LAS pg8::f32x4*)(Dv + 32 * ks + 8 * fq + 4); }
                float kf[8];
#pragma unroll
                for (int j = 0; j < 4; ++j) { kf[j] = bfs(kr[j]) * __expf(glast - g0[j]) * d0[j]; kf[4 + j] = bfs(kr[4 + j]) * __expf(glast - g1[j]) * d1[j]; }
                const v4u kw = pk8(kf); Kf[ks] = __builtin_bit_cast(bf16x8, kw); }
#pragma unroll
            for (int eb = 0; eb < 4; ++eb) { pg8::f32x4 acc = sacc[eb] * egl;
                if (KIND == 0) { acc = MFMA16(Kf[0], ldfrag(lds + L_V, 16 * eb + fr, 8 * fq), acc); acc = MFMA16(Kf[1], ldfrag(lds + L_V, 16 * eb + fr, 32 + 8 * fq), acc); }
                else { acc = MFMA16(Kf[0], trfrag(lds + L_V, 8 * fq, 16 * eb, fr), acc); acc = MFMA16(Kf[1], trfrag(lds + L_V, 32 + 8 * fq, 16 * eb, fr), acc); }
                sacc[eb] = acc;
                v2u o; o.x = pk2(acc[0], acc[1]); o.y = pk2(acc[2], acc[3]);
                *(LAS v2u*)(STn + (16 * eb + fr) * (PT * 2) + (16 * db + 4 * fq) * 2) = o; }
        }
        LBAR();
        {
            const LAS float* yr = (const LAS float*)(lds + L_YT) + prow * YPT + pcg * 8;
            const pg8::f32x4 y0 = *(const LAS pg8::f32x4*)yr, y1 = *(const LAS pg8::f32x4*)(yr + 4);
            float y[8] = {y0[0], y0[1], y0[2], y0[3], y1[0], y1[1], y1[2], y1[3]}, zf[8]; unpk8(zc, zf);
            const size_t row = tok0 + (size_t)c * 64 + prow;
            if (KIND == 1) { float ss = 0.f, xf[8]; unpk8(xc, xf);
#pragma unroll
                for (int j = 0; j < 8; ++j) { y[j] = (y[j] + p_D * xf[j]) * siluf(zf[j]); ss += y[j] * y[j]; }
                ss += __shfl_xor(ss, 1); ss += __shfl_xor(ss, 2); ss += __shfl_xor(ss, 4);
                if (pcg == 0) SM[row * SM_LD + 16 + h] = ss;
            } else { float ss = 0.f;
#pragma unroll
                for (int j = 0; j < 8; ++j) ss += y[j] * y[j];
                ss += __shfl_xor(ss, 1); ss += __shfl_xor(ss, 2); ss += __shfl_xor(ss, 4);
                const float rstd = rsqrtf(ss * (1.0f / 64.0f) + 1e-6f);
#pragma unroll
                for (int j = 0; j < 8; ++j) y[j] = y[j] * rstd * (KIND == 0 ? nw[j] : 1.0f) * siluf(zf[j]); }
            *(GAS v4u*)(ZB + row * ZB_LD + zcol) = pk8(y);
        }
        if (c + 1 < SEQ / 64) { WALK_PREP(); zc = tz; xc = tv; }
        LBAR();
    }
#undef WALK_LOAD
#undef WALK_PREP
}

constexpr int SP_RAW = 0, SP_CW = 67 * 1536, SP_END = SP_CW + 5 * 768 * 4;
static_assert(SP_END <= RING_BYTES, "ssd_prep LDS");
__device__ __forceinline__ void ssd_prep(const __attribute__((address_space(4))) Args* kp, int layer, LAS unsigned char* lds, int G_) {
    int tid = threadIdx.x; asm volatile("" : "+v"(tid));
    const int lane = tid & 63, wave = __builtin_amdgcn_readfirstlane(tid >> 6);
    unsigned char* ws = kp->ws;
    bf16* MIX = (bf16*)(ws + WS_MIX); float* SM = (float*)(ws + WS_SM);
    const bf16* HALO = (const bf16*)(ws + ((layer & 1) ? WS_XB0 : WS_XB1) + HALO_OFF);
    LAS float* CW = (LAS float*)(lds + SP_CW);
    { const float* cw = kp->in[8] + (size_t)layer * 4 * 768; const float* cb = kp->in[9] + (size_t)layer * 768;
      for (int i = tid; i < 768; i += 512) { CW[i] = cw[i]; CW[768 + i] = cw[768 + i]; CW[2 * 768 + i] = cw[2 * 768 + i]; CW[3 * 768 + i] = cw[3 * 768 + i]; CW[4 * 768 + i] = cb[i]; } }
    const float Aexp = expf(kp->in[10][layer * 8 + wave]), dtb = kp->in[11][layer * 8 + wave];
    for (int unit = blockIdx.x; unit < NBATCH * 64; unit += G_) { const int b = unit >> 6, c = unit & 63; const size_t tok0 = (size_t)b * SEQ + (size_t)c * 64;
        LBAR();
        for (int i = tid; i < 67 * 96; i += 512) { const int r = i / 96, pc = i - r * 96; v4u v = (v4u){0u, 0u, 0u, 0u};
            if (r >= 3) v = *(const GAS v4u*)(MIX + (tok0 + r - 3) * MIX_LD + MX_BX + pc * 8);
            else if (c > 0) v = *(const GAS v4u*)(HALO + ((size_t)(b * 64 + c - 1) * 3 + r) * HALO_LD + MX_BX + pc * 8);
            *(LAS v4u*)(lds + SP_RAW + r * 1536 + pc * 16) = v; }
        { const size_t r2 = tok0 + lane; const float dt = softplusf(SM[r2 * SM_LD + 16 + wave] + dtb); float gs = -Aexp * dt;
#pragma unroll
          for (int o = 1; o < 64; o <<= 1) { const float t_ = __shfl_up(gs, o); if (lane >= o) gs += t_; }
          SM[r2 * SM_LD + 16 + wave] = gs; SM[r2 * SM_LD + 24 + wave] = dt; }
        LBAR();
        for (int i = tid; i < 64 * 96; i += 512) { const int l = i / 96, pc = i - l * 96; float a[8];
            { const pg8::f32x4 b0 = *(const LAS pg8::f32x4*)(CW + 4 * 768 + pc * 8), b1 = *(const LAS pg8::f32x4*)(CW + 4 * 768 + pc * 8 + 4);
              a[0] = b0[0]; a[1] = b0[1]; a[2] = b0[2]; a[3] = b0[3]; a[4] = b1[0]; a[5] = b1[1]; a[6] = b1[2]; a[7] = b1[3]; }
#pragma unroll
            for (int k = 0; k < 4; ++k) { float f[8]; unpk8(*(const LAS v4u*)(lds + SP_RAW + (l + k) * 1536 + pc * 16), f);
                const pg8::f32x4 w0 = *(const LAS pg8::f32x4*)(CW + k * 768 + pc * 8), w1 = *(const LAS pg8::f32x4*)(CW + k * 768 + pc * 8 + 4);
#pragma unroll
                for (int j = 0; j < 4; ++j) { a[j] += w0[j] * f[j]; a[4 + j] += w1[j] * f[4 + j]; } }
#pragma unroll
            for (int j = 0; j < 8; ++j) a[j] = siluf(a[j]);
            *(GAS v4u*)(MIX + (tok0 + l) * MIX_LD + MX_BX + pc * 8) = pk8(a); }
    }
    LBAR();
}
__device__ __forceinline__ void ret_prep(const __attribute__((address_space(4))) Args* kp, int G_) {
    int tid = threadIdx.x; asm volatile("" : "+v"(tid));
    unsigned char* ws = kp->ws;
    bf16* MIX = (bf16*)(ws + WS_MIX); const float* ROPE = (const float*)(ws + WS_ROPE);
    for (int it = blockIdx.x * 512 + tid; it < MTOK * 32; it += G_ * 512) { const int m = it >> 5, hh = (it >> 2) & 7, i4 = it & 3, t = m & (SEQ - 1);
        const float* rp = ROPE + t * 32 + i4 * 8;
        const pg8::f32x4 c0 = *(const GAS pg8::f32x4*)rp, c1 = *(const GAS pg8::f32x4*)(rp + 4), s0 = *(const GAS pg8::f32x4*)(rp + SEQ * 32), s1 = *(const GAS pg8::f32x4*)(rp + SEQ * 32 + 4);
        const float cs[8] = {c0[0], c0[1], c0[2], c0[3], c1[0], c1[1], c1[2], c1[3]}, sn[8] = {s0[0], s0[1], s0[2], s0[3], s1[0], s1[1], s1[2], s1[3]};
#pragma unroll
        for (int T = 0; T < 2; ++T) { bf16* p = MIX + (size_t)m * MIX_LD + (T == 0 ? MX_CQ : MX_CK) + hh * 64 + i4 * 8; const float sc = T == 0 ? 1.0f : 0.125f;
            float a[8], bb[8], o1[8], o2[8]; unpk8(*(const GAS v4u*)p, a); unpk8(*(const GAS v4u*)(p + 32), bb);
#pragma unroll
            for (int j = 0; j < 8; ++j) { o1[j] = (a[j] * cs[j] - bb[j] * sn[j]) * sc; o2[j] = (a[j] * sn[j] + bb[j] * cs[j]) * sc; }
            *(GAS v4u*)p = pk8(o1); *(GAS v4u*)(p + 32) = pk8(o2); }
    }
}

typedef short bf16x4 __attribute__((ext_vector_type(4)));
#define MFMA16K16(a, b, c) __builtin_amdgcn_mfma_f32_16x16x16bf16_1k(a, b, c, 0, 0, 0)
constexpr int GQ_RAW = 0, GQ_KN = 67 * 384, GQ_VN = GQ_KN + MAT, GQ_NA = GQ_VN + MAT, GQ_AD = GQ_NA + MAT, GQ_S = GQ_AD + 4 * 16 * 20 * 4, GQ_CW = GQ_S + 512, GQ_TEAM = GQ_CW + 4 * 192 * 4;
static_assert(2 * GQ_TEAM <= RING_BYTES && 2 * MAT <= GQ_KN, "gdn_prep LDS");
__device__ __forceinline__ bf16x4 pk4(const pg8::f32x4 v) { v2u w; w.x = pk2(v[0], v[1]); w.y = pk2(v[2], v[3]); return __builtin_bit_cast(bf16x4, w); }
__device__ __forceinline__ void gdn_prep(const __attribute__((address_space(4))) Args* kp, int layer, LAS unsigned char* lds_all, int G_) {
    int tid = threadIdx.x; asm volatile("" : "+v"(tid));
    const int team = __builtin_amdgcn_readfirstlane(tid >> 8), j = tid & 255, lane = tid & 63, tw = __builtin_amdgcn_readfirstlane((tid >> 6) & 3), fr = lane & 15, fq = lane >> 4;
    LAS unsigned char* lds = lds_all + team * GQ_TEAM;
    LAS float* AD = (LAS float*)(lds + GQ_AD); LAS float* Gs = (LAS float*)(lds + GQ_S); LAS float* Bs = Gs + 64; LAS float* CW = (LAS float*)(lds + GQ_CW);
    unsigned char* ws = kp->ws;
    bf16* MIX = (bf16*)(ws + WS_MIX); float* SM = (float*)(ws + WS_SM);
    unsigned char* xbf = ws + ((layer & 1) ? WS_XB0 : WS_XB1); bf16* GW = (bf16*)(xbf + GW_OFF); const bf16* HALO = (const bf16*)(xbf + HALO_OFF);
    const float* cw = kp->in[4] + (size_t)layer * 4 * 1536;
    v4u praw[7]; float pcw[3], pbl = 0.f, pal = 0.f;
#define GQ_FETCH(rnd) do { const int u_ = ((rnd) * G_ + (int)blockIdx.x) * 2 + team; const int un_ = u_ < NBATCH * 8 * 64 ? u_ : 0; \
        const int c_ = un_ & 63, h_ = (un_ >> 6) & 7, b_ = un_ >> 9; const size_t tk_ = (size_t)b_ * SEQ + (size_t)c_ * 64; \
        _Pragma("unroll") for (int n = 0; n < 7; ++n) { const int i = j + 256 * n; praw[n] = (v4u){0u, 0u, 0u, 0u}; \
            if (i < 67 * 24) { const int r = i / 24, pc = i - r * 24, col = (pc >> 3) * 512 + h_ * 64 + (pc & 7) * 8; \
                if (r >= 3) praw[n] = *(const GAS v4u*)(MIX + (tk_ + r - 3) * MIX_LD + col); \
                else if (c_ > 0) praw[n] = *(const GAS v4u*)(HALO + ((size_t)(b_ * 64 + c_ - 1) * 3 + r) * HALO_LD + col); } } \
        _Pragma("unroll") for (int n = 0; n < 3; ++n) { const int i = j + 256 * n, k = i / 192, cc = i - k * 192; pcw[n] = cw[k * 1536 + (cc >> 6) * 512 + h_ * 64 + (cc & 63)]; } \
        if (tw == 0) { pbl = SM[(tk_ + lane) * SM_LD + h_]; pal = SM[(tk_ + lane) * SM_LD + 8 + h_]; } } while (0)
    GQ_FETCH(0);
    for (int round = 0; round < 8; ++round) {
        const int unit_ = (round * G_ + (int)blockIdx.x) * 2 + team;
        const bool live = unit_ < NBATCH * 8 * 64;
        const int unit = live ? unit_ : 0;
        const int c = unit & 63, h = (unit >> 6) & 7, b = unit >> 9;
        const size_t tok0 = (size_t)b * SEQ + (size_t)c * 64;
        LBAR();
#pragma unroll
        for (int n = 0; n < 7; ++n) { const int i = j + 256 * n; if (i < 67 * 24) { const int r = i / 24, pc = i - r * 24; *(LAS v4u*)(lds + GQ_RAW + r * 384 + pc * 16) = praw[n]; } }
#pragma unroll
        for (int n = 0; n < 3; ++n) CW[j + 256 * n] = pcw[n];
        if (tw == 0) {
            float gsum = -expf(kp->in[5][layer * 8 + h]) * softplusf(pal + kp->in[6][layer * 8 + h]);
#pragma unroll
            for (int o = 1; o < 64; o <<= 1) { const float t_ = __shfl_up(gsum, o); if (lane >= o) gsum += t_; }
            Gs[lane] = gsum; Bs[lane] = sigmf(pbl);
            if (live) SM[(tok0 + lane) * SM_LD + 8 + h] = gsum; }
        if (round + 1 < 8) GQ_FETCH(round + 1);
        LBAR();
#pragma unroll 1
        for (int n = 0; n < 6; ++n) { const int i = j + 256 * n, t = i / 24, pc = i - t * 24, tens = pc >> 3, ch = pc & 7; float a[8];
#pragma unroll
            for (int jj = 0; jj < 8; ++jj) a[jj] = 0.f;
#pragma unroll
            for (int k = 0; k < 4; ++k) { float f[8]; unpk8(*(const LAS v4u*)(lds + GQ_RAW + (t + k) * 384 + pc * 16), f);
                const pg8::f32x4 w0 = *(const LAS pg8::f32x4*)(CW + k * 192 + pc * 8), w1 = *(const LAS pg8::f32x4*)(CW + k * 192 + pc * 8 + 4);
#pragma unroll
                for (int jj = 0; jj < 4; ++jj) { a[jj] += w0[jj] * f[jj]; a[4 + jj] += w1[jj] * f[4 + jj]; } }
            float ss = 0.f;
#pragma unroll
            for (int jj = 0; jj < 8; ++jj) { a[jj] = siluf(a[jj]); ss += a[jj] * a[jj]; }
            ss += __shfl_xor(ss, 1); ss += __shfl_xor(ss, 2); ss += __shfl_xor(ss, 4);
            const float sc = tens == 2 ? 1.0f : rsqrtf(ss + 1e-6f) * (tens == 0 ? 0.125f : 1.0f);
#pragma unroll
            for (int jj = 0; jj < 8; ++jj) a[jj] *= sc;
            const v4u o = pk8(a);
            if (tens == 0) { if (live) *(GAS v4u*)(MIX + (tok0 + t) * MIX_LD + MX_AQ + h * 64 + ch * 8) = o; }
            else if (tens == 1) { *(LAS v4u*)(lds + GQ_KN + t * (PT * 2) + ch * 16) = o; if (live) *(GAS v4u*)(MIX + (tok0 + t) * MIX_LD + MX_AK + h * 64 + ch * 8) = o; }
            else *(LAS v4u*)(lds + GQ_VN + t * (PT * 2) + ch * 16) = o; }
        LBAR();
        for (int id = tw; id < 10; id += 4) { const int lb = id < 1 ? 0 : (id < 3 ? 1 : (id < 6 ? 2 : 3)), sb = id - (lb * (lb + 1)) / 2;
            pg8::f32x4 acc = (pg8::f32x4){0.f, 0.f, 0.f, 0.f};
#pragma unroll
            for (int ks = 0; ks < 2; ++ks) acc = MFMA16(ldfrag(lds + GQ_KN, 16 * lb + fr, 32 * ks + 8 * fq), ldfrag(lds + GQ_KN, 16 * sb + fr, 32 * ks + 8 * fq), acc);
            const int s = 16 * sb + fr; const float gsv = Gs[s];
#pragma unroll
            for (int r = 0; r < 4; ++r) { const int l = 16 * lb + 4 * fq + r; const float v = s < l ? Bs[l] * acc[r] * __expf(Gs[l] - gsv) : 0.f;
                if (lb == sb) AD[(lb * 16 + 4 * fq + r) * 20 + fr] = v;
                else *(LAS bf16*)(lds + GQ_NA + l * (PT * 2) + s * 2) = (bf16)f2bf(-v); } }
        LBAR();
        if (tw == 0) { const int bi = lane >> 4, cc = lane & 15; const LAS float* Ab = AD + bi * 16 * 20; float x[16];
#pragma unroll
            for (int r = 0; r < 16; ++r) { float a = (r == cc) ? 1.0f : 0.0f;
#pragma unroll
                for (int s4 = 0; s4 < r; s4 += 4) { const pg8::f32x4 av = *(const LAS pg8::f32x4*)(Ab + r * 20 + s4);
                    a -= av[0] * x[s4];
                    if (s4 + 1 < r) a -= av[1] * x[s4 + 1];
                    if (s4 + 2 < r) a -= av[2] * x[s4 + 2];
                    if (s4 + 3 < r) a -= av[3] * x[s4 + 3]; }
                x[r] = a; }
#pragma unroll
            for (int r = 0; r < 16; ++r) *(LAS bf16*)(lds + GQ_NA + (16 * bi + r) * (PT * 2) + (16 * bi + cc) * 2) = (bf16)f2bf(x[r]); }
        LBAR();
#pragma unroll 1
        for (int half = 0; half < 2; ++half) { LAS unsigned char* src = lds + (half == 0 ? GQ_VN : GQ_KN); const int c0 = 16 * tw;
            pg8::f32x4 R[4], X[4];
#pragma unroll
            for (int i = 0; i < 4; ++i) { const s16x4 raw = tr4(src + (16 * i + 4 * fq + (fr >> 2)) * (PT * 2) + (c0 + 4 * (fr & 3)) * 2);
                const pg8::f32x4 bv = *(const LAS pg8::f32x4*)(Bs + 16 * i + 4 * fq); pg8::f32x4 sc = bv;
                if (half == 1) { const pg8::f32x4 gv = *(const LAS pg8::f32x4*)(Gs + 16 * i + 4 * fq); sc = (pg8::f32x4){bv[0] * __expf(gv[0]), bv[1] * __expf(gv[1]), bv[2] * __expf(gv[2]), bv[3] * __expf(gv[3])}; }
                R[i] = (pg8::f32x4){bfs(raw[0]) * sc[0], bfs(raw[1]) * sc[1], bfs(raw[2]) * sc[2], bfs(raw[3]) * sc[3]}; }
#define NAF(ib, jb) (*(const LAS bf16x4*)(lds + GQ_NA + (16 * (ib) + fr) * (PT * 2) + (16 * (jb) + 4 * fq) * 2))
            const pg8::f32x4 Z = (pg8::f32x4){0.f, 0.f, 0.f, 0.f};
            X[0] = MFMA16K16(NAF(0, 0), pk4(R[0]), Z);
            { const bf16x4 x0 = pk4(X[0]); R[1] = MFMA16K16(NAF(1, 0), x0, R[1]); R[2] = MFMA16K16(NAF(2, 0), x0, R[2]); R[3] = MFMA16K16(NAF(3, 0), x0, R[3]); }
            X[1] = MFMA16K16(NAF(1, 1), pk4(R[1]), Z);
            { const bf16x4 x1 = pk4(X[1]); R[2] = MFMA16K16(NAF(2, 1), x1, R[2]); R[3] = MFMA16K16(NAF(3, 1), x1, R[3]); }
            X[2] = MFMA16K16(NAF(2, 2), pk4(R[2]), Z);
            { const bf16x4 x2 = pk4(X[2]); R[3] = MFMA16K16(NAF(3, 2), x2, R[3]); }
            X[3] = MFMA16K16(NAF(3, 3), pk4(R[3]), Z);
#undef NAF
#pragma unroll
            for (int i = 0; i < 4; ++i)
#pragma unroll
                for (int r = 0; r < 4; ++r) *(LAS bf16*)(lds + GQ_RAW + half * MAT + (16 * i + 4 * fq + r) * (PT * 2) + (c0 + fr) * 2) = (bf16)f2bf(X[i][r]);
        }
        LBAR();
        if (live) for (int i = j; i < 64 * 16; i += 256) { const int t = (i >> 3) & 63, ch = i & 7, half = i >> 9;
            const v4u v = *(const LAS v4u*)(lds + GQ_RAW + half * MAT + t * (PT * 2) + ch * 16);
            if (half == 0) *(GAS v4u*)(MIX + (tok0 + t) * MIX_LD + MX_AV + h * 64 + ch * 8) = v; else *(GAS v4u*)(GW + (tok0 + t) * 512 + h * 64 + ch * 8) = v; }
    }
    LBAR();
}
#ifndef MK_ONE_LAUNCH
#define MK_ONE_LAUNCH 1
#endif
#ifndef MK_NAIVE
#define MK_NAIVE 0
#endif
__global__ void __launch_bounds__(64) mixers_naive(Args args, int layer) {
    const int lane = threadIdx.x, w = blockIdx.x, kind = w >> 6, b = (w & 63) >> 3, h = w & 7;
    unsigned char* ws = args.ws;
    bf16* ZB = (bf16*)(ws + WS_ZB); const bf16* MIX = (const bf16*)(ws + WS_MIX); float* SM = (float*)(ws + WS_SM); const float* ROPE = (const float*)(ws + WS_ROPE);
    if (kind == 0) gdn_naive(args, layer, b, h, lane, MIX, SM, ZB);
    else if (kind == 1) ssd_naive(args, layer, b, h, lane, MIX, SM, ZB);
    else ret_naive(b, h, lane, MIX, ROPE, ZB);
}
__global__ void __launch_bounds__(512, 2) fwd_kernel(Args args) {
    extern __shared__ __attribute__((aligned(16))) unsigned char lds_raw[];
    LAS unsigned char* lds = (LAS unsigned char*)lds_raw;
    volatile LAS unsigned* MISC = (volatile LAS unsigned*)(lds + MISC_OFF);
    const int G = gridDim.x, NGW = G * 8;
    unsigned char* ws0 = args.ws;
    for (int u = threadIdx.x; u < (LDS_BYTES - RING_BYTES) / 4; u += 512) ((LAS unsigned*)(lds + RING_BYTES))[u] = 0u;
    __syncthreads();
#if MK_ONE_LAUNCH
    XcdBarrier bar = xcd_barrier_post((unsigned*)(ws0 + WS_CTL) + 4096, MISC + 8);
#define GRID_BAR() do { XcdBarrier b_ = bar; asm volatile("" : "+s"(b_.bar), "+s"(b_.x)); xcd_barrier(b_); } while (0)
#else
#define GRID_BAR() do {} while (0)
#endif
    const int lo = args.ph_lo, hi = args.ph_hi;
#define IN(p) (lo <= (p) && (p) < hi)
#define SEAM(p) do { if (IN(p) && IN((p) + 1)) GRID_BAR(); } while (0)
    typedef const __attribute__((address_space(4))) Args* KArgs;
    const KArgs kp0 = (KArgs)__builtin_amdgcn_kernarg_segment_ptr();
#define PHASE_PTRS() KArgs kp = kp0; asm volatile("" : "+s"(kp)); unsigned char* ws = kp->ws; float* X = kp->out; (void)X; \
    int tid = threadIdx.x; asm volatile("" : "+v"(tid)); int bx = blockIdx.x; asm volatile("" : "+s"(bx)); const int lane = tid & 63, wave = __builtin_amdgcn_readfirstlane(tid >> 6), gw = bx * 8 + wave; (void)lane; (void)gw; \
    bf16* ZB = (bf16*)(ws + WS_ZB); bf16* MIX = (bf16*)(ws + WS_MIX); float* SM = (float*)(ws + WS_SM); (void)ZB; (void)MIX; (void)SM; \
    float* SSQA = (float*)(ws + WS_SSQA); float* SSQB = (float*)(ws + WS_SSQB); float* SSQC = (float*)(ws + WS_SSQC); float* ROPE = (float*)(ws + WS_ROPE); (void)SSQA; (void)SSQB; (void)SSQC; (void)ROPE; \
    bf16* W1T = (bf16*)(ws + W_1T); bf16* WGT = (bf16*)(ws + W_GT); bf16* WMT = (bf16*)(ws + W_MT); bf16* WOT = (bf16*)(ws + W_OT); bf16* WUT = (bf16*)(ws + W_UT); (void)W1T; (void)WGT; (void)WMT; (void)WOT; (void)WUT; \
    bf16* WDT = (bf16*)(ws + W_DT); bf16* WPGT = (bf16*)(ws + W_PGT); bf16* WPPT = (bf16*)(ws + W_PPT); (void)WDT; (void)WPGT; (void)WPPT; \
    bf16* GATE = (bf16*)(ws + WS_GATE); bf16* U = (bf16*)(ws + WS_U); bf16* PB = (bf16*)(ws + WS_PB); bf16* PLE = (bf16*)(ws + WS_PLE); (void)GATE; (void)U; (void)PB; (void)PLE; \
    bf16* XBl = (bf16*)(ws + ((layer & 1) ? WS_XB1 : WS_XB0)); bf16* XBf = (bf16*)(ws + ((layer & 1) ? WS_XB0 : WS_XB1)); (void)XBl; (void)XBf
    if (IN(0)) { const int layer = 0; PHASE_PTRS();
        for (int e = bx * 512 + tid; e < SEQ * 32; e += G * 512) { const int t = e >> 5, i = e & 31;
            double f = 1.0; for (int j = 0; j < i; ++j) f *= 0.7429639507594948;
            const double ang = (double)t * f, kk = rint(ang * 0.15915494309189535);
            double r = fma(-kk, 6.283185307179586, ang); r = fma(-kk, 2.4492935982947064e-16, r); const double r2 = r * r;
            double sn = 1.0, cs = 1.0;
    #pragma unroll
            for (int n = 15; n >= 1; --n) { sn = 1.0 - r2 * (1.0 / (double)((2 * n) * (2 * n + 1))) * sn; cs = 1.0 - r2 * (1.0 / (double)((2 * n - 1) * (2 * n))) * cs; }
            ROPE[e] = (float)cs; ROPE[SEQ * 32 + e] = (float)(r * sn); }
    }
    for (int layer = 0; layer < DEPTH; ++layer) {
        const int P = layer * NPH;
        if (IN(P + 0)) { PHASE_PTRS();
            int ibase = 0;
            const float* w_in = kp->in[3] + (size_t)layer * DM * NIN; const float* nmix = kp->in[2] + (size_t)layer * DM;
            TR_SEG(w_in, NIN, 1536, 512, DM, nmix, W1T, DM, 0, 0);
            TR_SEG(w_in, NIN, 2064, 512, DM, nmix, W1T, DM, 512, 0);
            TR_SEG(w_in, NIN, 4888, 512, DM, nmix, W1T, DM, 1024, 0);
            TR_SEG(w_in, NIN, 0, 1536, DM, nmix, W1T, DM, 1536, 0);
            TR_SEG(w_in, NIN, 2576, 768, DM, nmix, W1T, DM, 3072, 0);
            TR_SEG(w_in, NIN, 3352, 1536, DM, nmix, W1T, DM, 3840, 0);
            TR_SEG(w_in, NIN, 2048, 16, DM, nmix, W1T, DM, 5376, 0);
            TR_SEG(w_in, NIN, 3344, 8, DM, nmix, W1T, DM, 5392, 0);
            TR_SEG((const float*)nullptr, NIN, 0, 232, DM, (const float*)nullptr, W1T, DM, 5400, 0);
            TR_SEG(w_in, NIN, 5400, 3072, DM, nmix, WGT, DM, 0, 0);
            const float* wbr = kp->in[14] + (size_t)layer * 3 * 512 * DM;
            TR_SEG(wbr, DM, 0, DM, 512, (const float*)nullptr, WMT, KMERGE, 0, 0);
            TR_SEG(wbr + 512 * DM, DM, 0, DM, 512, kp->in[13] + (size_t)layer * 512, WMT, KMERGE, 0, 512);
            TR_SEG(wbr + 2 * 512 * DM, DM, 0, DM, 512, (const float*)nullptr, WMT, KMERGE, 0, 1024);
            TR_SEG(kp->in[15] + (size_t)layer * DM * DM, DM, 0, DM, DM, (const float*)nullptr, WOT, DM, 0, 0);
            TR_SEG(kp->in[17] + (size_t)layer * DM * DFF, DFF, 0, DFF, DM, kp->in[16] + (size_t)layer * DM, WUT, DM, 0, 0);
            TR_SEG(kp->in[18] + (size_t)layer * DFF * DM, DM, 0, DM, DFF, (const float*)nullptr, WDT, DFF, 0, 0);
            TR_SEG(kp->in[20] + (size_t)layer * DM * DM, DM, 0, DM, DM, kp->in[19] + (size_t)layer * DM, WPGT, DM, 0, 0);
            TR_SEG(kp->in[21] + (size_t)layer * PLED * DM, DM, 0, DM, PLED, (const float*)nullptr, WPPT, PLED, 0, 0);
            if (layer == 0) {
                const float* xin = kp->in[0];
                for (int m = gw; m < MTOK; m += NGW) {
                    const GAS f32x4* xr = (const GAS f32x4*)(xin + (size_t)m * DM) + lane; f32x4 v[4]; float s = 0.f;
#pragma unroll
                    for (int j = 0; j < 4; ++j) { v[j] = xr[64 * j]; s += (v[j].x * v[j].x + v[j].y * v[j].y) + (v[j].z * v[j].z + v[j].w * v[j].w); }
                    s = wave_sum(s);
                    GAS v2u* o8 = (GAS v2u*)(XBl + (size_t)m * DM) + lane;
#pragma unroll
                    for (int j = 0; j < 4; ++j) { v2u w; w.x = pk2(v[j].x, v[j].y); w.y = pk2(v[j].z, v[j].w); o8[64 * j] = w; }
                    if (lane < 16) SSQC[(size_t)m * 16 + lane] = lane == 0 ? s : 0.f;
                }
            }
        }
        SEAM(P + 0);
        if (IN(P + 1)) { PHASE_PTRS();
            pg8::Gemm g{XBl, W1T, MTOK, N1, DM}; pg8::StaticOrder S; S.init(MTOK, N1, G, bx);
            build_rs_table(S, SSQC, lds, tid);
            pg8::EpiP1 E{ZB, MIX, SM, lds + RS_OFF, (bf16*)((unsigned char*)XBf + HALO_OFF)};
            pg8::gemm_phase<pg8::EpiP1, pg8::StaticOrder, true, true>(lds, g, S, E);
        }
        SEAM(P + 1);
        if (IN(P + 2)) { PHASE_PTRS();
#if !MK_NAIVE
            gdn_prep(kp, layer, lds, G);
            ssd_prep(kp, layer, lds, G);
            ret_prep(kp, G);
#endif
        }
        SEAM(P + 2);
        if (IN(P + 3)) { PHASE_PTRS();
#if !MK_NAIVE
            for (int w = bx; w < 192; w += G) { const int kind = w >> 6, b = (w & 63) >> 3, h = w & 7;
                if (kind == 0) mixer_walk<0>(kp, layer, b, h, lds);
                else if (kind == 1) mixer_walk<1>(kp, layer, b, h, lds);
                else mixer_walk<2>(kp, layer, b, h, lds);
                __syncthreads(); }
#endif
        }
        SEAM(P + 3);
        if (IN(P + 4)) { PHASE_PTRS();
            for (int m = gw; m < MTOK; m += NGW) {
                GAS v4u* yp = (GAS v4u*)(ZB + (size_t)m * ZB_LD + 512) + lane; const v4u w = *yp;
                const f32x4 sq = *(const f32x4*)(SM + (size_t)m * SM_LD + 16 + 4 * (lane >> 5));
                const float rstd = rsqrtf(((sq[0] + sq[1]) + (sq[2] + sq[3])) * (1.0f / 256.0f) + 1e-6f);
                v4u o; o.x = pk2(pg8::bflo(w.x) * rstd, pg8::bfhi(w.x) * rstd); o.y = pk2(pg8::bflo(w.y) * rstd, pg8::bfhi(w.y) * rstd);
                o.z = pk2(pg8::bflo(w.z) * rstd, pg8::bfhi(w.z) * rstd); o.w = pk2(pg8::bflo(w.w) * rstd, pg8::bfhi(w.w) * rstd);
                *yp = o;
            }
            pg8::Gemm g{XBl, WGT, MTOK, NGATE, DM}; pg8::StaticOrder S; S.init(MTOK, NGATE, G, bx);
            build_rs_table(S, SSQC, lds, tid);
            pg8::EpiRS<2> E{GATE, NGATE, lds + RS_OFF};
            pg8::gemm_phase<pg8::EpiRS<2>, pg8::StaticOrder, true, true>(lds, g, S, E);
        }
        SEAM(P + 4);
        if (IN(P + 5)) { PHASE_PTRS();
            pg8::Gemm g{ZB, WMT, MTOK, DM, KMERGE}; pg8::StaticOrder S; S.init(MTOK, DM, G, bx);
            pg8::EpiMerge E{GATE, XBf};
            pg8::gemm_phase<pg8::EpiMerge, pg8::StaticOrder, true, true>(lds, g, S, E);
        }
        SEAM(P + 5);
        if (IN(P + 6)) { PHASE_PTRS();
            const float* pl = kp->in[1] + (size_t)layer * MTOK * PLED;
            for (size_t e = (size_t)bx * 512 + tid; e < (size_t)MTOK * PLED / 4; e += (size_t)G * 512) { const f32x4 v = ((const GAS f32x4*)pl)[e]; v2u w; w.x = pk2(v.x, v.y); w.y = pk2(v.z, v.w); ((GAS v2u*)PB)[e] = w; }
            pg8::Gemm g{XBf, WOT, MTOK, DM, DM}; pg8::StaticOrder S; S.init(MTOK, DM, G, bx);
            pg8::EpiResid<0> E{XBl, XBl, SSQA, (LAS unsigned char*)nullptr, nullptr,  1.0f};
            pg8::gemm_phase<pg8::EpiResid<0>, pg8::StaticOrder, true, true>(lds, g, S, E);
        }
        SEAM(P + 6);
        if (IN(P + 7)) { PHASE_PTRS();
            { pg8::Gemm g{XBl, WUT, MTOK, DFF, DM}; pg8::StaticOrder S; S.init(MTOK, DFF, G, bx);
              build_rs_table(S, SSQA, lds, tid);
              pg8::EpiRS<1> E{U, DFF, lds + RS_OFF};
              pg8::gemm_phase<pg8::EpiRS<1>, pg8::StaticOrder, true, true>(lds, g, S, E); }
        }
        SEAM(P + 7);
        if (IN(P + 8)) { PHASE_PTRS();
            pg8::Gemm g{U, WDT, MTOK, DM, DFF}; pg8::StaticOrder S; S.init(MTOK, DM, G, bx);
            pg8::EpiResid<0> E{XBl, XBl, SSQB, (LAS unsigned char*)nullptr, nullptr,  1.0f};
            pg8::gemm_phase<pg8::EpiResid<0>, pg8::StaticOrder, true, true>(lds, g, S, E);
            __builtin_amdgcn_sched_barrier(0);
            { pg8::Gemm g{PB, WPPT, MTOK, DM, PLED}; pg8::StaticOrder S; S.init(MTOK, DM, G, bx);
              pg8::EpiRS<0> E{PLE, DM, (LAS unsigned char*)nullptr};
              pg8::gemm_phase<pg8::EpiRS<0>, pg8::StaticOrder, true, true>(lds, g, S, E); }
        }
        SEAM(P + 8);
        if (IN(P + 9)) { PHASE_PTRS();
            pg8::Gemm g{XBl, WPGT, MTOK, DM, DM}; pg8::StaticOrder S; S.init(MTOK, DM, G, bx);
            build_rs_table(S, SSQB, lds, tid);
            pg8::EpiResid<1> E{XBl, XBf, SSQC, lds + RS_OFF, PLE,  1.0f};
            pg8::gemm_phase<pg8::EpiResid<1>, pg8::StaticOrder, true, true>(lds, g, S, E);
        }
        SEAM(P + 9);
    }
    if (IN(PH_FINAL)) { const int layer = DEPTH; PHASE_PTRS();
        const float* nf = kp->in[22];
        for (int m = gw; m < MTOK; m += NGW) {
            const float sp = lane < 16 ? SSQC[(size_t)m * 16 + lane] : 0.f;
            const float rstd = rsqrtf(wave_sum(sp) * (1.0f / 1024.0f) + 1e-6f);
            const GAS v4u* xr = (const GAS v4u*)(XBl + (size_t)m * DM) + lane; GAS f32x4* orow = (GAS f32x4*)(X + (size_t)m * DM);
#pragma unroll
            for (int j = 0; j < 2; ++j) { const v4u w = xr[64 * j]; const int c8 = (64 * j + lane) * 2; const f32x4 g0 = ((const GAS f32x4*)nf)[c8], g1 = ((const GAS f32x4*)nf)[c8 + 1];
                f32x4 o0, o1; o0[0] = pg8::bflo(w.x); o0[1] = pg8::bfhi(w.x); o0[2] = pg8::bflo(w.y); o0[3] = pg8::bfhi(w.y); o1[0] = pg8::bflo(w.z); o1[1] = pg8::bfhi(w.z); o1[2] = pg8::bflo(w.w); o1[3] = pg8::bfhi(w.w);
                orow[c8] = o0 * rstd * g0; orow[c8 + 1] = o1 * rstd * g1; }
        }
    }
#undef IN
#undef SEAM
}

extern "C" void kernel_launch(void* const* d_in, const int* in_sizes, int n_in, void* d_out, int out_size, void* d_ws, size_t ws_size, hipStream_t stream) {
    static int grid = 0;
    if (grid == 0) {
        if (n_in != 23 || out_size != MTOK * DM || ws_size < WS_END) { fprintf(stderr, "kernel_launch: unexpected problem (n_in %d, out %d, ws %zu < %zu)\n", n_in, out_size, ws_size, (size_t)WS_END); grid = -1; return; }
        int dev = 0, cus = 0;
        if (hipGetDevice(&dev) != hipSuccess || hipDeviceGetAttribute(&cus, hipDeviceAttributeMultiprocessorCount, dev) != hipSuccess) { grid = -1; return; }
        if (hipFuncSetAttribute((const void*)fwd_kernel, hipFuncAttributeMaxDynamicSharedMemorySize, LDS_BYTES) != hipSuccess) { fprintf(stderr, "kernel_launch: hipFuncSetAttribute failed\n"); grid = -1; return; }
        int per_cu = 0;
        if (hipOccupancyMaxActiveBlocksPerMultiprocessor(&per_cu, (const void*)fwd_kernel, 512, LDS_BYTES) != hipSuccess || per_cu < 1) { fprintf(stderr, "kernel_launch: occupancy query says %d blocks per CU\n", per_cu); }
        (void)hipGetLastError();
        grid = cus;
    }
    if (grid < 0) return;
    (void)hipMemsetAsync((char*)d_ws + WS_CTL, 0, CTL_BYTES, stream);
    Args a; memset(&a, 0, sizeof(a));
    for (int i = 0; i < 23; ++i) a.in[i] = (const float*)d_in[i];
    a.out = (float*)d_out; a.ws = (unsigned char*)d_ws;
#if MK_ONE_LAUNCH
    a.ph_lo = 0; a.ph_hi = N_PHASES;
    hipLaunchKernelGGL(fwd_kernel, dim3(grid), dim3(512), LDS_BYTES, stream, a);
#else
    for (int p = 0; p < N_PHASES; ++p) {
#if MK_NAIVE
        if (p != PH_FINAL && (p % NPH) == 3) { hipLaunchKernelGGL(mixers_naive, dim3(192), dim3(64), 0, stream, a, p / NPH); continue; }
#endif
        a.ph_lo = p; a.ph_hi = p + 1;
        hipLaunchKernelGGL(fwd_kernel, dim3(grid), dim3(512), LDS_BYTES, stream, a);
    }
#endif
}
```

```cpp
#include <hip/hip_runtime.h>
#include <cstdio>
#include <cstdint>
#include <cstring>
namespace pg8 {
#define PG8_LAS __attribute__((address_space(3)))
typedef unsigned short bf16_t;
typedef short bf16x8 __attribute__((ext_vector_type(8)));
typedef float f32x4 __attribute__((ext_vector_type(4)));
typedef unsigned u32x4 __attribute__((ext_vector_type(4)));
constexpr int BM = 256, BK = 64, HALF = 128, HTB = HALF * BK * 2  , STAGE_BYTES = 8 * HTB, NXCD = 8, WGM = 8;

__host__ __device__ __forceinline__ int lds_byte(int r, int c) { const int st = (r >> 4) * 2 + (c >> 5), rr = r & 15, cc = c & 31, ob = rr * 64 + cc * 2; return st * 1024 + (ob ^ (((ob >> 9) & 1) << 5)); }
__host__ __device__ __forceinline__ void stage_rc(int b, int& R, int& C) { const int st = b / 1024, sb = b % 1024, swz = sb ^ (((sb >> 9) & 1) << 5); R = (st >> 1) * 16 + swz / 64; C = (st & 1) * 32 + (swz % 64) / 2; }
__host__ __device__ __forceinline__ int perm32(int rho) { const int n = rho >> 4, i = rho & 15; return 8 * (i >> 2) + 4 * n + (i & 3); }

struct Unit { int pm, pn; };
struct Gemm { const bf16_t* A; const bf16_t* Bt; int M, N, K; };

struct StaticOrder {
    int nM, nN, nwg, G, c;
    __host__ __device__ void init(int M, int N, int G_, int c_) { nM = M / BM; nN = N / BM; nwg = nM * nN; G = G_; c = c_; }
    __host__ __device__ bool next(int i, Unit& u) const {
        const long L = (long)i * G + c; if (L >= nwg) return false;
        int wgid = (int)L; { const int q = nwg / NXCD, r = nwg % NXCD, xcd = wgid % NXCD, off = wgid / NXCD; wgid = (xcd < r ? xcd * (q + 1) : r * (q + 1) + (xcd - r) * q) + off; }
        const int nig = WGM * nN, gid = wgid / nig, fm = gid * WGM, gsz = (nM - fm) < WGM ? (nM - fm) : WGM;
        u.pm = fm + ((wgid % nig) % gsz); u.pn = (wgid % nig) / gsz; return true;
    }
    __device__ __forceinline__ void a_ready(const Unit&) const {}
    __device__ __forceinline__ void done(const Unit&) const {}
};

typedef float f32x2c __attribute__((ext_vector_type(2))); typedef __bf16 bf16x2c __attribute__((ext_vector_type(2)));
__device__ __forceinline__ unsigned cvt_pk_bf16(float lo, float hi) { const f32x2c v = {lo, hi}; const bf16x2c b = __builtin_convertvector(v, bf16x2c); return __builtin_bit_cast(unsigned, b); }
typedef unsigned u32x2 __attribute__((ext_vector_type(2)));
__device__ __forceinline__ float bflo(unsigned w) { return __uint_as_float(w << 16); }
__device__ __forceinline__ float bfhi(unsigned w) { return __uint_as_float(w & 0xffff0000u); }
__device__ __forceinline__ u32x4 pack8(const f32x4 v0, const f32x4 v1) { u32x4 w; w.x = cvt_pk_bf16(v0[0], v0[1]); w.y = cvt_pk_bf16(v0[2], v0[3]); w.z = cvt_pk_bf16(v1[0], v1[1]); w.w = cvt_pk_bf16(v1[2], v1[3]); return w; }
__device__ __forceinline__ void unpack8(const u32x4 w, f32x4& v0, f32x4& v1) { v0 = (f32x4){bflo(w.x), bfhi(w.x), bflo(w.y), bfhi(w.y)}; v1 = (f32x4){bflo(w.z), bfhi(w.z), bflo(w.w), bfhi(w.w)}; }
constexpr float RMS_EPS = 1e-6f;
constexpr int RS_SLOTS = 8;
__device__ __forceinline__ void load_rstd(const PG8_LAS unsigned char* rst, int pm, int wr, int fr, float (&rs)[2][4]) {
    if (rst == nullptr) {
#pragma unroll
        for (int ai = 0; ai < 2; ++ai)
#pragma unroll
            for (int m = 0; m < 4; ++m) rs[ai][m] = 1.0f;
        return; }
    const PG8_LAS int* pml = (const PG8_LAS int*)rst; int slot = 0;
#pragma unroll
    for (int k = 1; k < RS_SLOTS; ++k) slot = pml[k] == pm ? k : slot;
    const PG8_LAS float* tab = (const PG8_LAS float*)(rst + 32) + slot * 256 + wr * 64 + fr;
#pragma unroll
    for (int ai = 0; ai < 2; ++ai)
#pragma unroll
        for (int m = 0; m < 4; ++m) rs[ai][m] = tab[ai * HALF + m * 16];
}
struct EpiP1 {
    static constexpr bool PERM = true, AFTER_DRAIN = false, HOOK = false; static constexpr int SEG1 = -1, SEG2 = -1;
    bf16_t* ZB; bf16_t* MIX; float* SM; const PG8_LAS unsigned char* rst; bf16_t* HALO;
    __device__ __forceinline__ void rescale(f32x4 (&)[2][2][4][2], const Unit&, int, int, int, int, int) const {}
    __device__ __forceinline__ void operator()(const f32x4 (&acc)[2][2][4][2], const Unit& u, int wr, int wc, int fr, int fq) const {
        const int row0 = u.pm * BM + wr * 64 + fr;
        float rs[2][4]; load_rstd(rst, u.pm, wr, fr, rs);
        if (u.pn == 21) {
            if (wc == 0) {
#pragma unroll
                for (int ai = 0; ai < 2; ++ai)
#pragma unroll
                    for (int m = 0; m < 4; ++m) { float* p = SM + (size_t)(row0 + ai * HALF + m * 16) * 32 + 8 * fq;
                        *(f32x4*)p = acc[ai][0][m][0] * rs[ai][m]; *(f32x4*)(p + 4) = acc[ai][0][m][1] * rs[ai][m]; }
            }
            return;
        }
        bf16_t* base; int ldc, colt;
        if (u.pn < 6) { base = ZB; ldc = 1536; colt = u.pn * BM; } else { base = MIX; ldc = 3840; colt = (u.pn - 6) * BM; }
        const int col0 = colt + wc * 32 + 8 * fq;
#pragma unroll
        for (int ai = 0; ai < 2; ++ai)
#pragma unroll
            for (int m = 0; m < 4; ++m) { bf16_t* rowp = base + (size_t)(row0 + ai * HALF + m * 16) * ldc + col0;
#pragma unroll
                for (int bj = 0; bj < 2; ++bj) { const u32x4 w = pack8(acc[ai][bj][m][0] * rs[ai][m], acc[ai][bj][m][1] * rs[ai][m]); *(u32x4*)(rowp + bj * HALF) = w;
                    if (m == 3 && fr >= 13 && u.pn >= 6 && u.pn < 15) *(u32x4*)(HALO + ((size_t)((row0 + ai * HALF + m * 16) >> 6) * 3 + (fr - 13)) * 2304 + col0 + bj * HALF) = w; } }
    }
};
template <int ACT> struct EpiRS {
    static constexpr bool PERM = true, AFTER_DRAIN = false, HOOK = false; static constexpr int SEG1 = -1, SEG2 = -1;
    bf16_t* O; int ldc; const PG8_LAS unsigned char* rst;
    __device__ __forceinline__ void rescale(f32x4 (&)[2][2][4][2], const Unit&, int, int, int, int, int) const {}
    __device__ __forceinline__ void operator()(const f32x4 (&acc)[2][2][4][2], const Unit& u, int wr, int wc, int fr, int fq) const {
        const int row0 = u.pm * BM + wr * 64 + fr, col0 = u.pn * BM + wc * 32 + 8 * fq;
        float rs[2][4]; load_rstd(rst, u.pm, wr, fr, rs);
#pragma unroll
        for (int ai = 0; ai < 2; ++ai)
#pragma unroll
            for (int m = 0; m < 4; ++m) { bf16_t* rowp = O + (size_t)(row0 + ai * HALF + m * 16) * ldc + col0;
#pragma unroll
                for (int bj = 0; bj < 2; ++bj) { f32x4 v0 = acc[ai][bj][m][0] * rs[ai][m], v1 = acc[ai][bj][m][1] * rs[ai][m];
                    if (ACT == 1) {
#pragma unroll
                        for (int j = 0; j < 4; ++j) { const float a = fmaxf(v0[j], 0.f), b = fmaxf(v1[j], 0.f); v0[j] = a * a; v1[j] = b * b; } }
                    if (ACT == 2) {
#pragma unroll
                        for (int j = 0; j < 4; ++j) { v0[j] = __builtin_amdgcn_rcpf(1.0f + __expf(-v0[j])); v1[j] = __builtin_amdgcn_rcpf(1.0f + __expf(-v1[j])); } }
                    *(u32x4*)(rowp + bj * HALF) = pack8(v0, v1); } }
    }
};
struct EpiMerge {
    static constexpr bool PERM = true, AFTER_DRAIN = false, HOOK = true; static constexpr int SEG1 = 8, SEG2 = 16;
    const bf16_t* GATE; bf16_t* O;
    __device__ __forceinline__ void rescale(f32x4 (&acc)[2][2][4][2], const Unit& u, int seg, int wr, int wc, int, int) const {
        int t_ = threadIdx.x; asm volatile("" : "+v"(t_)); const int fr = t_ & 15, fq = (t_ & 63) >> 4;
        const int row0 = u.pm * BM + wr * 64 + fr, col0 = u.pn * BM + wc * 32 + 8 * fq + (seg - 1) * 1024;
#pragma unroll
        for (int ai = 0; ai < 2; ++ai)
#pragma unroll
            for (int m = 0; m < 4; ++m) { const bf16_t* gp = GATE + (size_t)(row0 + ai * HALF + m * 16) * 3072 + col0;
#pragma unroll
                for (int bj = 0; bj < 2; ++bj) { const u32x4 wa = *(const u32x4*)(gp + bj * HALF), wb = *(const u32x4*)(gp + bj * HALF + 1024);
                    f32x4 a0, a1, b0, b1; unpack8(wa, a0, a1); unpack8(wb, b0, b1);
#pragma unroll
                    for (int j = 0; j < 4; ++j) {
                        acc[ai][bj][m][0][j] *= a0[j] * __builtin_amdgcn_rcpf(b0[j]);
                        acc[ai][bj][m][1][j] *= a1[j] * __builtin_amdgcn_rcpf(b1[j]); } }
                if (m == 3) asm volatile("" ::: "memory"); }
    }
    __device__ __forceinline__ void operator()(const f32x4 (&acc)[2][2][4][2], const Unit& u, int wr, int wc, int fr, int fq) const {
        const int row0 = u.pm * BM + wr * 64 + fr, col0 = u.pn * BM + wc * 32 + 8 * fq;
#pragma unroll
        for (int ai = 0; ai < 2; ++ai)
#pragma unroll
            for (int m = 0; m < 4; ++m) { const size_t r = (size_t)(row0 + ai * HALF + m * 16);
#pragma unroll
                for (int bj = 0; bj < 2; ++bj) { const u32x4 wa = *(const u32x4*)(GATE + r * 3072 + 2048 + col0 + bj * HALF);
                    f32x4 a0, a1; unpack8(wa, a0, a1); f32x4 v0 = acc[ai][bj][m][0], v1 = acc[ai][bj][m][1];
#pragma unroll
                    for (int j = 0; j < 4; ++j) { v0[j] *= a0[j]; v1[j] *= a1[j]; }
                    *(u32x4*)(O + r * 1024 + col0 + bj * HALF) = pack8(v0, v1); }
                if (m == 3) asm volatile("" ::: "memory"); }
    }
};
template <int MODE> struct EpiResid {
    static constexpr bool PERM = true, AFTER_DRAIN = false, HOOK = false; static constexpr int SEG1 = -1, SEG2 = -1;
    const bf16_t* XBin; bf16_t* XBout; float* ssq_out; const PG8_LAS unsigned char* rst; const bf16_t* PLE; float scale;
    __device__ __forceinline__ void rescale(f32x4 (&)[2][2][4][2], const Unit&, int, int, int, int, int) const {}
    __device__ __forceinline__ void operator()(const f32x4 (&acc)[2][2][4][2], const Unit& u, int wr, int wc, int fr, int fq) const {
        const int row0 = u.pm * BM + wr * 64 + fr, col0 = u.pn * BM + wc * 32 + 8 * fq;
        float rs[2][4]; if (MODE == 1) load_rstd(rst, u.pm, wr, fr, rs);
#pragma unroll
        for (int ai = 0; ai < 2; ++ai)
#pragma unroll
            for (int m = 0; m < 4; ++m) { const size_t r = (size_t)(row0 + ai * HALF + m * 16); float ss = 0.f;
#pragma unroll
                for (int bj = 0; bj < 2; ++bj) { const size_t o = r * 1024 + col0 + bj * HALF;
                    f32x4 v0 = acc[ai][bj][m][0], v1 = acc[ai][bj][m][1], b0, b1; unpack8(*(const u32x4*)(XBin + o), b0, b1);
                    if (MODE == 1) { const u32x4 wp = *(const u32x4*)(PLE + o); f32x4 p0, p1; unpack8(wp, p0, p1);
#pragma unroll
                        for (int j = 0; j < 4; ++j) { v0[j] = p0[j] * __builtin_amdgcn_rcpf(1.0f + __expf(-v0[j] * rs[ai][m])); v1[j] = p1[j] * __builtin_amdgcn_rcpf(1.0f + __expf(-v1[j] * rs[ai][m])); } }
                    v0 = v0 * scale + b0; v1 = v1 * scale + b1;
                    *(u32x4*)(XBout + o) = pack8(v0, v1);
                    ss += (v0[0] * v0[0] + v0[1] * v0[1]) + (v0[2] * v0[2] + v0[3] * v0[3]) + (v1[0] * v1[0] + v1[1] * v1[1]) + (v1[2] * v1[2] + v1[3] * v1[3]); }
                ss += __shfl_xor(ss, 16); ss += __shfl_xor(ss, 32);
                if (fq == 0) ssq_out[r * 16 + u.pn * 4 + wc] = ss;
                if (m == 3) asm volatile("" ::: "memory"); }
    }
};
template <class Epi, class Sched, bool ALIGN_EPI = false, bool SP2 = false>
__device__ __forceinline__ void gemm_phase(PG8_LAS unsigned char* lds, Gemm g, const Sched& S, const Epi& E) {
    asm volatile("" : "+s"(g.A), "+s"(g.Bt), "+s"(g.K));
    int tid_ = threadIdx.x; asm volatile("" : "+v"(tid_));
    const int tid = tid_, wid = __builtin_amdgcn_readfirstlane(tid >> 6), lane = tid & 63, wr = wid >> 2, wc = wid & 3, fr = lane & 15, fq = lane >> 4;
    const int K = g.K, nt = K / BK;
    unsigned voffA[2], voffB[2];
#pragma unroll
    for (int i = 0; i < 2; ++i) { int R, C; stage_rc(tid * 16 + i * 8192, R, C); const int Rb = Epi::PERM ? ((R & ~31) + perm32(R & 31)) : R;
        voffA[i] = (unsigned)(R * K + C) * 2u; voffB[i] = (unsigned)(Rb * K + C) * 2u; }
    const size_t kstep = (size_t)(BK * 2);
    const size_t hstep = (size_t)HALF * K * 2;
    const size_t tstep = 2 * hstep;
    const unsigned ldsw = (unsigned)wid * 1024u;
    const int aoff = lds_byte(wr * 64 + fr, fq * 8), boff = lds_byte(wc * 32 + fr, fq * 8);
#define PG8_SA(b, h) (((b) * 2 + (h)) * HTB)
#define PG8_SB(b, h) ((4 + (b) * 2 + (h)) * HTB)
#define PG8_STAGE(bufoff, gbase, voff) do { _Pragma("unroll") for (int _i = 0; _i < 2; ++_i) \
        __builtin_amdgcn_global_load_lds((const unsigned*)((const char*)(gbase) + (voff)[_i]), (PG8_LAS unsigned*)(lds + (bufoff) + ldsw + _i * 8192), 16, 0, 0); } while (0)
#define PG8_LDA(dst, b, h) do { _Pragma("unroll") for (int m = 0; m < 4; ++m) _Pragma("unroll") for (int k = 0; k < 2; ++k) dst[m][k] = *(const PG8_LAS bf16x8*)(lds + PG8_SA(b, h) + aoff + m * 2048 + k * 1024); } while (0)
#define PG8_LDB(dst, b, h) do { _Pragma("unroll") for (int n = 0; n < 2; ++n) _Pragma("unroll") for (int k = 0; k < 2; ++k) dst[n][k] = *(const PG8_LAS bf16x8*)(lds + PG8_SB(b, h) + boff + n * 2048 + k * 1024); } while (0)
#define PG8_MMA(ai, bj, At, Bt) do { __builtin_amdgcn_s_setprio(1); _Pragma("unroll") for (int m = 0; m < 4; ++m) _Pragma("unroll") for (int n = 0; n < 2; ++n) _Pragma("unroll") for (int k = 0; k < 2; ++k) \
        acc[ai][bj][m][n] = __builtin_amdgcn_mfma_f32_16x16x32_bf16(Bt[n][k], At[m][k], acc[ai][bj][m][n], 0, 0, 0); __builtin_amdgcn_s_setprio(0); } while (0)
#define PG8_WAIT_V(n) asm volatile("s_waitcnt vmcnt(" #n ")" ::: "memory")
#define PG8_WAIT_L(n) asm volatile("s_waitcnt lgkmcnt(" #n ")" ::: "memory")
#define PG8_BAR __builtin_amdgcn_s_barrier()
#define PG8_SCHED __builtin_amdgcn_sched_barrier(0)
    Unit cur, nxt; int ui = 0;
    if (!S.next(0, cur)) return;
    f32x4 acc[2][2][4][2];
#pragma unroll
    for (int a = 0; a < 2; ++a)
#pragma unroll
        for (int b = 0; b < 2; ++b)
#pragma unroll
            for (int m = 0; m < 4; ++m)
#pragma unroll
                for (int n = 0; n < 2; ++n) acc[a][b][m][n] = (f32x4){0.f, 0.f, 0.f, 0.f};
    bf16x8 At[4][2], B0[2][2], B1[2][2];
    const char* cA = (const char*)g.A + (size_t)cur.pm * tstep; const char* cB = (const char*)g.Bt + (size_t)cur.pn * tstep;
    S.a_ready(cur);
    if constexpr (SP2) {
        PG8_STAGE(PG8_SB(0, 0), cB, voffB); PG8_STAGE(PG8_SB(0, 1), cB + hstep, voffB); PG8_STAGE(PG8_SA(0, 0), cA, voffA); PG8_STAGE(PG8_SA(0, 1), cA + hstep, voffA);
        if (wr == 1) PG8_BAR;
        PG8_WAIT_V(2); PG8_BAR;
        PG8_STAGE(PG8_SB(1, 0), cB + kstep, voffB); PG8_STAGE(PG8_SA(1, 0), cA + kstep, voffA); PG8_STAGE(PG8_SB(1, 1), cB + hstep + kstep, voffB);
        PG8_WAIT_V(6); PG8_BAR;
    } else {
        PG8_STAGE(PG8_SB(0, 0), cB, voffB); PG8_STAGE(PG8_SA(0, 0), cA, voffA); PG8_STAGE(PG8_SB(0, 1), cB + hstep, voffB); PG8_STAGE(PG8_SA(0, 1), cA + hstep, voffA);
        if (wr == 1) PG8_BAR;
        PG8_WAIT_V(4); PG8_BAR;
        PG8_STAGE(PG8_SB(1, 0), cB + kstep, voffB); PG8_STAGE(PG8_SA(1, 0), cA + kstep, voffA); PG8_STAGE(PG8_SB(1, 1), cB + hstep + kstep, voffB);
        PG8_WAIT_V(6); PG8_BAR;
    }
    for (;;) {
        const bool has_next = S.next(ui + 1, nxt);
        const char* nA = has_next ? (const char*)g.A + (size_t)nxt.pm * tstep : cA; const char* nB = has_next ? (const char*)g.Bt + (size_t)nxt.pn * tstep : cB;
        for (int t = 0; t < nt; t += 2) {
            const bool last = (t == nt - 2);
            const char* a1 = cA + (size_t)(t + 1) * kstep;
            const char* a2 = last ? nA : cA + (size_t)(t + 2) * kstep; const char* b2 = last ? nB : cB + (size_t)(t + 2) * kstep;
            const char* a3 = a2 + kstep; const char* b3 = b2 + kstep;
            if (last && has_next) S.a_ready(nxt);
            if constexpr (Epi::HOOK) { if (t == Epi::SEG1 || t == Epi::SEG2) E.rescale(acc, cur, t == Epi::SEG1 ? 1 : 2, wr, wc, fr, fq); }
            if constexpr (SP2) {
            PG8_LDB(B0, 0, 0); PG8_LDB(B1, 0, 1); PG8_SCHED; PG8_LDA(At, 0, 0); PG8_STAGE(PG8_SA(1, 1), a1 + hstep, voffA);
            PG8_WAIT_V(8); PG8_WAIT_L(0); PG8_BAR; PG8_MMA(0, 0, At, B0); PG8_MMA(0, 1, At, B1); PG8_BAR; PG8_SCHED;
            PG8_LDA(At, 0, 1); PG8_STAGE(PG8_SB(0, 0), b2, voffB); PG8_STAGE(PG8_SB(0, 1), b2 + hstep, voffB); PG8_STAGE(PG8_SA(0, 0), a2, voffA);
            PG8_WAIT_V(8); PG8_WAIT_L(0); PG8_BAR; PG8_MMA(1, 0, At, B0); PG8_MMA(1, 1, At, B1); PG8_BAR; PG8_SCHED;
            PG8_LDB(B0, 1, 0); PG8_LDB(B1, 1, 1); PG8_SCHED; PG8_LDA(At, 1, 0); PG8_STAGE(PG8_SA(0, 1), a2 + hstep, voffA);
            PG8_WAIT_V(8); PG8_WAIT_L(0); PG8_BAR; PG8_MMA(0, 0, At, B0); PG8_MMA(0, 1, At, B1); PG8_BAR; PG8_SCHED;
            PG8_LDA(At, 1, 1); PG8_STAGE(PG8_SB(1, 0), b3, voffB); PG8_STAGE(PG8_SB(1, 1), b3 + hstep, voffB); PG8_STAGE(PG8_SA(1, 0), a3, voffA);
            PG8_WAIT_V(8); PG8_WAIT_L(0); PG8_BAR; PG8_MMA(1, 0, At, B0); PG8_MMA(1, 1, At, B1); PG8_BAR; PG8_SCHED;
            } else {
            PG8_LDB(B0, 0, 0); PG8_SCHED; PG8_LDA(At, 0, 0); PG8_STAGE(PG8_SA(1, 1), a1 + hstep, voffA);
            PG8_WAIT_L(8); PG8_BAR; PG8_WAIT_L(0); PG8_MMA(0, 0, At, B0); PG8_BAR; PG8_SCHED;
            PG8_LDB(B1, 0, 1); PG8_STAGE(PG8_SB(0, 0), b2, voffB);
            PG8_BAR; PG8_WAIT_L(0); PG8_MMA(0, 1, At, B1); PG8_BAR;
            PG8_LDA(At, 0, 1); PG8_STAGE(PG8_SA(0, 0), a2, voffA);
            PG8_BAR; PG8_WAIT_L(0); PG8_MMA(1, 0, At, B0); PG8_BAR; PG8_SCHED;
            PG8_STAGE(PG8_SB(0, 1), b2 + hstep, voffB);
            PG8_WAIT_V(6); PG8_BAR; PG8_MMA(1, 1, At, B1); PG8_BAR;
            PG8_LDB(B0, 1, 0); PG8_SCHED; PG8_LDA(At, 1, 0); PG8_STAGE(PG8_SA(0, 1), a2 + hstep, voffA);
            PG8_WAIT_L(8); PG8_BAR; PG8_WAIT_L(0); PG8_MMA(0, 0, At, B0); PG8_BAR; PG8_SCHED;
            PG8_LDB(B1, 1, 1); PG8_STAGE(PG8_SB(1, 0), b3, voffB);
            PG8_BAR; PG8_WAIT_L(0); PG8_MMA(0, 1, At, B1); PG8_BAR;
            PG8_LDA(At, 1, 1); PG8_STAGE(PG8_SA(1, 0), a3, voffA);
            PG8_BAR; PG8_WAIT_L(0); PG8_MMA(1, 0, At, B0); PG8_BAR; PG8_SCHED;
            PG8_STAGE(PG8_SB(1, 1), b3 + hstep, voffB);
            PG8_WAIT_V(6); PG8_BAR; PG8_MMA(1, 1, At, B1); PG8_BAR;
            }
        }
        if constexpr (ALIGN_EPI) { if (wr == 0) PG8_BAR; }
        if constexpr (!Epi::AFTER_DRAIN) { int t2_ = threadIdx.x; asm volatile("" : "+v"(t2_)); E(acc, cur, wr, wc, t2_ & 15, (t2_ & 63) >> 4); S.done(cur); }
        if (!has_next) break;
#pragma unroll
        for (int a = 0; a < 2; ++a)
#pragma unroll
            for (int b = 0; b < 2; ++b)
#pragma unroll
                for (int m = 0; m < 4; ++m)
#pragma unroll
                    for (int n = 0; n < 2; ++n) acc[a][b][m][n] = (f32x4){0.f, 0.f, 0.f, 0.f};
        cur = nxt; cA = nA; cB = nB; ++ui;
        if constexpr (ALIGN_EPI) { if (wr == 1) PG8_BAR; }
    }
    PG8_WAIT_V(0);
    if constexpr (!ALIGN_EPI) { if (wr == 0) PG8_BAR; }
    PG8_BAR;
    if constexpr (Epi::AFTER_DRAIN) { E.fused(acc, cur, wr, wc, fr, fq, lds, wid, lane); S.done(cur); }
#undef PG8_SA
#undef PG8_SB
#undef PG8_STAGE
#undef PG8_LDA
#undef PG8_LDB
#undef PG8_MMA
#undef PG8_WAIT_V
#undef PG8_WAIT_L
#undef PG8_BAR
#undef PG8_SCHED
}
}
constexpr int DM = 1024, NBATCH = 8, SEQ = 4096, MTOK = NBATCH * SEQ, DEPTH = 2, DFF = 4096, PLED = 256, NIN = 8472;
constexpr int ZB_LD = 1536, MIX_LD = 3840, SM_LD = 32, N1 = 5632, NGATE = 3072, KMERGE = 1536;
constexpr int MX_AQ = 0, MX_AK = 512, MX_AV = 1024, MX_BX = 1536, MX_BB = 2048, MX_BC = 2176, MX_CQ = 2304, MX_CK = 2816, MX_CV = 3328;
constexpr size_t KiB = 1024, MiB = 1024 * 1024;
constexpr size_t WS_CTL = 0, CTL_BYTES = 64 * KiB;
constexpr size_t WS_W = 64 * KiB;
constexpr size_t W_1T = WS_W, W_GT = W_1T + (size_t)N1 * DM * 2, W_MT = W_GT + (size_t)NGATE * DM * 2, W_OT = W_MT + (size_t)DM * KMERGE * 2, W_UT = W_OT + (size_t)DM * DM * 2,
                 W_DT = W_UT + (size_t)DFF * DM * 2, W_PGT = W_DT + (size_t)DM * DFF * 2, W_PPT = W_PGT + (size_t)DM * DM * 2, W_END = W_PPT + (size_t)DM * PLED * 2;
constexpr size_t WS_SSQA = W_1T + 1 * MiB, WS_SSQB = W_1T + 3 * MiB;
constexpr size_t WS_XB0 = W_END, WS_XB1 = WS_XB0 + 64 * MiB, WS_ZB = WS_XB1 + 64 * MiB, WS_MIX = WS_ZB + 96 * MiB, WS_SM = WS_MIX + 240 * MiB, WS_SSQC = WS_SM + 4 * MiB, WS_ROPE = WS_SSQC + 2 * MiB, WS_END = WS_ROPE + 1 * MiB;
constexpr size_t WS_PB = WS_ZB, WS_PLE = WS_ZB + 16 * MiB, WS_U = WS_ZB + 80 * MiB, WS_GATE = WS_MIX;
static_assert(W_END == WS_W + (size_t)(40 * MiB + 512 * KiB), "weights");
static_assert(WS_U + (size_t)MTOK * DFF * 2 == WS_SM, "U overlay");
static_assert(WS_END <= 512 * MiB, "workspace");
constexpr int LDS_BYTES = 147456, RING_BYTES = 131072, MISC_OFF = RING_BYTES + 320, RS_OFF = RING_BYTES + 1024;
static_assert(RS_OFF + 32 + pg8::RS_SLOTS * 1024 <= LDS_BYTES, "LDS map");

#define GAS __attribute__((address_space(1)))
#define LAS __attribute__((address_space(3)))
typedef unsigned short bf16;
typedef unsigned v4u __attribute__((ext_vector_type(4)));
typedef unsigned v2u __attribute__((ext_vector_type(2)));
typedef float f32x4 __attribute__((ext_vector_type(4)));
#define LDS_WAIT() asm volatile("s_waitcnt lgkmcnt(0)" ::: "memory")
typedef float f32x2_t __attribute__((ext_vector_type(2))); typedef __bf16 bf16x2_t __attribute__((ext_vector_type(2)));
__device__ __forceinline__ unsigned pk2(float lo, float hi) { f32x2_t v = {lo, hi}; bf16x2_t b = __builtin_convertvector(v, bf16x2_t); return __builtin_bit_cast(unsigned, b); }
__device__ __forceinline__ unsigned f2bf(float f) { return pk2(f, 0.f) & 0xffffu; }
__device__ __forceinline__ float bf2f(bf16 v) { return __uint_as_float((unsigned)v << 16); }
__device__ __forceinline__ float wave_sum(float v) {
#pragma unroll
    for (int o = 1; o < 64; o <<= 1) v += __shfl_xor(v, o);
    return v;
}
__device__ __forceinline__ float siluf(float x) { return x * __builtin_amdgcn_rcpf(1.0f + __expf(-x)); }
__device__ __forceinline__ float sigmf(float x) { return __builtin_amdgcn_rcpf(1.0f + __expf(-x)); }
__device__ __forceinline__ float softplusf(float x) { return fmaxf(x, 0.f) + log1pf(__expf(-fabsf(x))); }
__device__ __forceinline__ float rdl(float v, int l) { return __int_as_float(__builtin_amdgcn_readlane(__float_as_int(v), l)); }

#define XB_TMO      128
#define XB_XCNT(j)  (256  + 64 * (j))
#define XB_XSUB(j)  (1280 + 64 * (j))
#define XB_XGEN(j)  (2304 + 64 * (j))
#define XB_TOP      3328
#define XB_TOPGEN   3392
#define XCD_BAR_WORDS 3456
#define XB_SPIN_CAP (1u << 18)
__device__ __forceinline__ unsigned xb_ld(unsigned* p)              { return __hip_atomic_load(p, __ATOMIC_RELAXED, __HIP_MEMORY_SCOPE_AGENT); }
__device__ __forceinline__ unsigned xb_add(unsigned* p, unsigned v) { return __hip_atomic_fetch_add(p, v, __ATOMIC_RELAXED, __HIP_MEMORY_SCOPE_AGENT); }
__device__ __forceinline__ unsigned xb_xcc_id() { return (unsigned)__builtin_amdgcn_s_getreg((3 << 11) | 20) & 0xFu; }
#define XB_SPIN(cond, bar) do { unsigned _sp = 0; while (cond) { __builtin_amdgcn_s_sleep(1); \
    if ((++_sp & 255u) == 0u) { if (xb_ld(&(bar)[XB_TMO])) break; if (_sp > XB_SPIN_CAP) { atomicAdd(&(bar)[XB_TMO], 1u); break; } } } } while (0)
struct XcdBarrier { unsigned* bar; unsigned x; volatile LAS unsigned* st; };
__device__ __forceinline__ XcdBarrier xcd_barrier_post(unsigned* bar, volatile LAS unsigned* st) {
    XcdBarrier b; b.bar = bar; b.x = xb_xcc_id(); b.st = st;
    if (threadIdx.x == 0) (void)xb_add(&bar[XB_XCNT(b.x)], 1u);
    return b;
}
__device__ __forceinline__ void xcd_barrier_complete(unsigned* bar, unsigned x, unsigned& nloc, unsigned& nx) {
    const unsigned G = gridDim.x * gridDim.y * gridDim.z;
    unsigned sum, cnt, mine, sp = 0u;
    for (;;) {
        sum = 0u; cnt = 0u; mine = 0u;
#pragma unroll
        for (unsigned j = 0; j < 16; ++j) { const unsigned c = xb_ld(&bar[XB_XCNT(j)]); sum += c; cnt += (c > 0u) ? 1u : 0u; mine = (j == x) ? c : mine; }
        if (sum == G) break;
        __builtin_amdgcn_s_sleep(1);
        if ((++sp & 255u) == 0u) { if (xb_ld(&bar[XB_TMO])) break; if (sp > XB_SPIN_CAP) { atomicAdd(&bar[XB_TMO], 1u); break; } }
    }
    nloc = mine > 0u ? mine : 1u; nx = cnt > 0u ? cnt : 1u;
}
__device__ __forceinline__ void xcd_barrier(const XcdBarrier& b) {
    asm volatile("s_waitcnt vmcnt(0)" ::: "memory");
    __syncthreads();
    if (threadIdx.x == 0) {
        unsigned* bar = b.bar;
        __builtin_amdgcn_s_waitcnt(0);
        unsigned nloc = b.st[0], nx = b.st[1];
        if (nloc == 0u) { xcd_barrier_complete(bar, b.x, nloc, nx); b.st[0] = nloc; b.st[1] = nx; }
        const unsigned old = xb_add(&bar[XB_XSUB(b.x)], 1u);
        const unsigned gen = old / nloc;
        if (old + 1u == (gen + 1u) * nloc) {
            __builtin_amdgcn_fence(__ATOMIC_RELEASE, "agent");
            asm volatile("s_waitcnt vmcnt(0)" ::: "memory");
            const unsigned og = xb_add(&bar[XB_TOP], 1u);
            const unsigned tg = og / nx;
            if (og + 1u == (tg + 1u) * nx) xb_add(&bar[XB_TOPGEN], 1u);
            else XB_SPIN(xb_ld(&bar[XB_TOPGEN]) == tg, bar);
            __builtin_amdgcn_fence(__ATOMIC_ACQUIRE, "agent");
            xb_add(&bar[XB_XGEN(b.x)], 1u);
            asm volatile("s_waitcnt vmcnt(0)" ::: "memory");
        } else {
            XB_SPIN(xb_ld(&bar[XB_XGEN(b.x)]) == gen, bar);
            __builtin_amdgcn_fence(__ATOMIC_ACQUIRE, "agent");
            asm volatile("s_waitcnt vmcnt(0)" ::: "memory");
        }
    }
    __syncthreads();
}

__device__ __forceinline__ void tr_item(const float* W, int ldw, int c0, int ncols, const float* scale, bf16* dst, int ldd, int r0, int kofs, LAS unsigned char* lds, int item, int tid) {
    const int lane = tid & 63, wave = __builtin_amdgcn_readfirstlane(tid >> 6);
    const int nblk = (ncols + 255) / 256, kb = item / nblk, nb = item - kb * nblk, k0 = 64 * kb, n0 = 256 * nb;
    asm volatile("s_waitcnt lgkmcnt(0)\n\ts_barrier" ::: "memory");
#pragma unroll
    for (int jj = 0; jj < 4; ++jj) { const int n = n0 + lane + 64 * jj; const bool ok = W != nullptr && n < ncols; float v[8];
        const float* wp = W + (size_t)(k0 + 8 * wave) * ldw + c0 + n;
#pragma unroll
        for (int kk = 0; kk < 8; ++kk) { v[kk] = 0.f; if (ok) { v[kk] = wp[(size_t)kk * ldw]; if (scale) v[kk] *= scale[k0 + 8 * wave + kk]; } }
        v4u o; o.x = pk2(v[0], v[1]); o.y = pk2(v[2], v[3]); o.z = pk2(v[4], v[5]); o.w = pk2(v[6], v[7]);
        *(LAS v4u*)(lds + (lane + 64 * jj) * 144 + wave * 16) = o; }
    asm volatile("s_waitcnt lgkmcnt(0)\n\ts_barrier" ::: "memory");
#pragma unroll
    for (int i = 0; i < 4; ++i) { const int nl = (tid >> 3) + 64 * i, ch = tid & 7;
        if (n0 + nl < ncols) *(GAS v4u*)(dst + (size_t)(r0 + n0 + nl) * ldd + kofs + k0 + ch * 8) = *(const LAS v4u*)(lds + nl * 144 + ch * 16); }
}
#define TR_SEG(W_, ldw_, c0_, ncols_, K_, scale_, dst_, ldd_, r0_, kofs_) do { const int _n = ((K_) / 64) * (((ncols_) + 255) / 256); \
    for (int _it = (bx + G - (ibase % G)) % G; _it < _n; _it += G) tr_item(W_, ldw_, c0_, ncols_, scale_, dst_, ldd_, r0_, kofs_, lds, _it, tid); ibase += _n; } while (0)

__device__ __forceinline__ void build_rs_table(const pg8::StaticOrder& S, const float* ssqp, LAS unsigned char* lds, int tid) {
    LAS int* pml = (LAS int*)(lds + RS_OFF); LAS float* tab = (LAS float*)(lds + RS_OFF + 32);
    __syncthreads();
    if (tid == 0) { int npm = 0;
        for (int k = 0; k < pg8::RS_SLOTS; ++k) pml[k] = -1;
        for (int i = 0; ; ++i) { pg8::Unit u; if (!S.next(i, u)) break; bool found = false;
            for (int k = 0; k < npm; ++k) found = found || (pml[k] == u.pm);
            if (!found && npm < pg8::RS_SLOTS) pml[npm++] = u.pm; } }
    __syncthreads();
#pragma unroll 1
    for (int s = tid >> 8; s < pg8::RS_SLOTS; s += 2) { const int pm = pml[s]; if (pm < 0) continue;
        const float* p = ssqp + ((size_t)pm * 256 + (tid & 255)) * 16;
        const f32x4 a = *(const f32x4*)p, b = *(const f32x4*)(p + 4), c = *(const f32x4*)(p + 8), d = *(const f32x4*)(p + 12);
        const float ss = ((a[0] + a[1]) + (a[2] + a[3])) + ((b[0] + b[1]) + (b[2] + b[3])) + ((c[0] + c[1]) + (c[2] + c[3])) + ((d[0] + d[1]) + (d[2] + d[3]));
        tab[s * 256 + (tid & 255)] = rsqrtf(ss * (1.0f / 1024.0f) + 1e-6f); }
    __syncthreads();
}
#ifndef STAGGER_US
#define STAGGER_US 0
#endif
__device__ __forceinline__ void stagger(int bx) {
    if (STAGGER_US > 0) { const unsigned long long t0 = __builtin_amdgcn_s_memrealtime(), d = (unsigned long long)((bx >> 3) & 3) * (unsigned long long)(STAGGER_US * 100 / 4);
        while (__builtin_amdgcn_s_memrealtime() - t0 < d) __builtin_amdgcn_s_sleep(16); }
}
struct Args { const float* in[23]; float* out; unsigned char* ws; int ph_lo, ph_hi; };
constexpr int NPH = 10, PH_FINAL = DEPTH * NPH, N_PHASES = PH_FINAL + 1;

constexpr int WG = 8;
__device__ __forceinline__ void gdn_naive(const Args& A, int layer, int b, int h, int lane, const bf16* MIX, const float* SM, bf16* ZB) {
    const float* cw = A.in[4] + (size_t)layer * 4 * 1536;
    float wq[4], wk[4], wv[4];
#pragma unroll
    for (int k = 0; k < 4; ++k) { wq[k] = cw[k * 1536 + h * 64 + lane]; wk[k] = cw[k * 1536 + 512 + h * 64 + lane]; wv[k] = cw[k * 1536 + 1024 + h * 64 + lane]; }
    const float Aexp = expf(A.in[5][layer * 8 + h]), dtb = A.in[6][layer * 8 + h], nw = A.in[7][layer * 64 + lane];
    float M[64];
#pragma unroll
    for (int d = 0; d < 64; ++d) M[d] = 0.f;
    float hq0 = 0.f, hq1 = 0.f, hq2 = 0.f, hk0 = 0.f, hk1 = 0.f, hk2 = 0.f, hv0 = 0.f, hv1 = 0.f, hv2 = 0.f;
    const size_t tok0 = (size_t)b * SEQ;
    bf16 nq[WG], nk[WG], nv[WG], nz[WG]; float nb[WG], na[WG];
#define GDN_LOAD(t0) do { _Pragma("unroll") for (int i = 0; i < WG; ++i) { const size_t r = tok0 + (t0) + i; const bf16* mp = MIX + r * MIX_LD + h * 64 + lane; \
        nq[i] = mp[MX_AQ]; nk[i] = mp[MX_AK]; nv[i] = mp[MX_AV]; nz[i] = ZB[r * ZB_LD + h * 64 + lane]; nb[i] = SM[r * SM_LD + h]; na[i] = SM[r * SM_LD + 8 + h]; } } while (0)
    GDN_LOAD(0);
    for (int t0 = 0; t0 < SEQ; t0 += WG) {
        bf16 cq[WG], ck[WG], cv[WG], cz[WG]; float cb[WG], ca[WG];
#pragma unroll
        for (int i = 0; i < WG; ++i) { cq[i] = nq[i]; ck[i] = nk[i]; cv[i] = nv[i]; cz[i] = nz[i]; cb[i] = nb[i]; ca[i] = na[i]; }
        if (t0 + WG < SEQ) GDN_LOAD(t0 + WG);
#pragma unroll
        for (int i = 0; i < WG; ++i) {
            const float xq = bf2f(cq[i]), xk = bf2f(ck[i]), xv = bf2f(cv[i]);
            float q = siluf(wq[0] * hq0 + wq[1] * hq1 + wq[2] * hq2 + wq[3] * xq); hq0 = hq1; hq1 = hq2; hq2 = xq;
            float k = siluf(wk[0] * hk0 + wk[1] * hk1 + wk[2] * hk2 + wk[3] * xk); hk0 = hk1; hk1 = hk2; hk2 = xk;
            const float v = siluf(wv[0] * hv0 + wv[1] * hv1 + wv[2] * hv2 + wv[3] * xv); hv0 = hv1; hv1 = hv2; hv2 = xv;
            q *= rsqrtf(wave_sum(q * q) + 1e-6f) * 0.125f; k *= rsqrtf(wave_sum(k * k) + 1e-6f);
            const float beta = sigmf(cb[i]), a = __expf(-Aexp * softplusf(ca[i] + dtb));
            float r = 0.f;
#pragma unroll
            for (int d = 0; d < 64; ++d) { M[d] *= a; r += rdl(k, d) * M[d]; }
            const float u = beta * (v - r); float o = 0.f;
#pragma unroll
            for (int d = 0; d < 64; ++d) { M[d] += rdl(k, d) * u; o += rdl(q, d) * M[d]; }
            const float y = o * rsqrtf(wave_sum(o * o) * (1.0f / 64.0f) + 1e-6f) * nw * siluf(bf2f(cz[i]));
            ZB[(tok0 + t0 + i) * ZB_LD + h * 64 + lane] = (bf16)f2bf(y);
        }
    }
#undef GDN_LOAD
}
__device__ __forceinline__ void ssd_naive(const Args& A, int layer, int b, int h, int lane, const bf16* MIX, float* SM, bf16* ZB) {
    const int g = h >> 2;
    const float* cw = A.in[8] + (size_t)layer * 4 * 768; const float* cb_ = A.in[9] + (size_t)layer * 768;
    float wx[4], wB[4], wC[4];
#pragma unroll
    for (int k = 0; k < 4; ++k) { wx[k] = cw[k * 768 + h * 64 + lane]; wB[k] = cw[k * 768 + 512 + g * 64 + lane]; wC[k] = cw[k * 768 + 640 + g * 64 + lane]; }
    const float bx = cb_[h * 64 + lane], bB = cb_[512 + g * 64 + lane], bC = cb_[640 + g * 64 + lane];
    const float Aexp = expf(A.in[10][layer * 8 + h]), dtb = A.in[11][layer * 8 + h], Dh = A.in[12][layer * 8 + h];
    float Hs[64];
#pragma unroll
    for (int d = 0; d < 64; ++d) Hs[d] = 0.f;
    float hx0 = 0.f, hx1 = 0.f, hx2 = 0.f, hB0 = 0.f, hB1 = 0.f, hB2 = 0.f, hC0 = 0.f, hC1 = 0.f, hC2 = 0.f;
    const size_t tok0 = (size_t)b * SEQ;
    bf16 nx[WG], nB[WG], nC[WG], nz[WG]; float nd[WG];
#define SSD_LOAD(t0) do { _Pragma("unroll") for (int i = 0; i < WG; ++i) { const size_t r = tok0 + (t0) + i; const bf16* mp = MIX + r * MIX_LD; \
        nx[i] = mp[MX_BX + h * 64 + lane]; nB[i] = mp[MX_BB + g * 64 + lane]; nC[i] = mp[MX_BC + g * 64 + lane]; nz[i] = ZB[r * ZB_LD + 512 + h * 64 + lane]; nd[i] = SM[r * SM_LD + 16 + h]; } } while (0)
    SSD_LOAD(0);
    for (int t0 = 0; t0 < SEQ; t0 += WG) {
        bf16 cx[WG], cB[WG], cC[WG], cz[WG]; float cd[WG];
#pragma unroll
        for (int i = 0; i < WG; ++i) { cx[i] = nx[i]; cB[i] = nB[i]; cC[i] = nC[i]; cz[i] = nz[i]; cd[i] = nd[i]; }
        if (t0 + WG < SEQ) SSD_LOAD(t0 + WG);
#pragma unroll
        for (int i = 0; i < WG; ++i) {
            const float rx = bf2f(cx[i]), rB = bf2f(cB[i]), rC = bf2f(cC[i]);
            const float x = siluf(wx[0] * hx0 + wx[1] * hx1 + wx[2] * hx2 + wx[3] * rx + bx); hx0 = hx1; hx1 = hx2; hx2 = rx;
            const float Bv = siluf(wB[0] * hB0 + wB[1] * hB1 + wB[2] * hB2 + wB[3] * rB + bB); hB0 = hB1; hB1 = hB2; hB2 = rB;
            const float Cv = siluf(wC[0] * hC0 + wC[1] * hC1 + wC[2] * hC2 + wC[3] * rC + bC); hC0 = hC1; hC1 = hC2; hC2 = rC;
            const float dt = softplusf(cd[i] + dtb), a = __expf(-Aexp * dt), xdt = x * dt;
            float y = 0.f;
#pragma unroll
            for (int n = 0; n < 64; ++n) { Hs[n] = a * Hs[n] + xdt * rdl(Bv, n); y += Hs[n] * rdl(Cv, n); }
            y = (y + Dh * x) * siluf(bf2f(cz[i]));
            const float ss = wave_sum(y * y);
            const size_t r = tok0 + t0 + i;
            ZB[r * ZB_LD + 512 + h * 64 + lane] = (bf16)f2bf(y);
            if (lane == 0) SM[r * SM_LD + 24 + h] = ss;
        }
    }
#undef SSD_LOAD
}
__device__ __forceinline__ void ret_naive(int b, int h, int lane, const bf16* MIX, const float* ROPE, bf16* ZB) {
    const float gamma = 1.0f - exp2f(-5.0f - (float)h);
    float M[64];
#pragma unroll
    for (int d = 0; d < 64; ++d) M[d] = 0.f;
    const size_t tok0 = (size_t)b * SEQ;
    bf16 nq[WG], nk[WG], nv[WG], nz[WG]; float nc[WG], ns[WG];
#define RET_LOAD(t0) do { _Pragma("unroll") for (int i = 0; i < WG; ++i) { const size_t r = tok0 + (t0) + i; const bf16* mp = MIX + r * MIX_LD + h * 64 + lane; \
        nq[i] = mp[MX_CQ]; nk[i] = mp[MX_CK]; nv[i] = mp[MX_CV]; nz[i] = ZB[r * ZB_LD + 1024 + h * 64 + lane]; nc[i] = ROPE[((t0) + i) * 32 + (lane & 31)]; ns[i] = ROPE[SEQ * 32 + ((t0) + i) * 32 + (lane & 31)]; } } while (0)
    RET_LOAD(0);
    for (int t0 = 0; t0 < SEQ; t0 += WG) {
        bf16 cq[WG], ck[WG], cv[WG], cz[WG]; float cc[WG], cs[WG];
#pragma unroll
        for (int i = 0; i < WG; ++i) { cq[i] = nq[i]; ck[i] = nk[i]; cv[i] = nv[i]; cz[i] = nz[i]; cc[i] = nc[i]; cs[i] = ns[i]; }
        if (t0 + WG < SEQ) RET_LOAD(t0 + WG);
#pragma unroll
        for (int i = 0; i < WG; ++i) {
            const float q0 = bf2f(cq[i]), k0 = bf2f(ck[i]), v = bf2f(cv[i]);
            const float qp = __shfl_xor(q0, 32), kp = __shfl_xor(k0, 32);
            const float sg = lane < 32 ? -cs[i] : cs[i];
            const float q = q0 * cc[i] + qp * sg, k = (k0 * cc[i] + kp * sg) * 0.125f;
            float o = 0.f;
#pragma unroll
            for (int d = 0; d < 64; ++d) { M[d] = gamma * M[d] + rdl(k, d) * v; o += rdl(q, d) * M[d]; }
            const float y = o * rsqrtf(wave_sum(o * o) * (1.0f / 64.0f) + 1e-6f) * siluf(bf2f(cz[i]));
            ZB[(tok0 + t0 + i) * ZB_LD + 1024 + h * 64 + lane] = (bf16)f2bf(y);
        }
    }
#undef RET_LOAD
}

typedef short bf16x8 __attribute__((ext_vector_type(8)));
constexpr int PT = 72, MAT = 64 * PT * 2;
constexpr int L_Q = 0, L_K = MAT, L_V = 2 * MAT, L_W = 3 * MAT, L_U = 4 * MAT, L_ST0 = 5 * MAT, L_ST1 = 6 * MAT, L_PP = 7 * MAT, L_YT = 8 * MAT,
              YPT = 68, L_G = L_YT + 64 * YPT * 4, L_DT = L_G + 256, L_WEND = L_DT + 256;
static_assert(L_WEND <= RING_BYTES, "walker LDS");
constexpr size_t GW_OFF = 0, HALO_OFF = 32 * MiB;
constexpr int HALO_LD = 2304;
#define MFMA16(a, b, c) __builtin_amdgcn_mfma_f32_16x16x32_bf16(a, b, c, 0, 0, 0)
__device__ __forceinline__ bf16x8 ldfrag(LAS unsigned char* base, int row, int kelem) { return *(const LAS bf16x8*)(base + row * (PT * 2) + kelem * 2); }
__device__ __forceinline__ void unpk8(const v4u w, float (&f)[8]) { f[0] = pg8::bflo(w.x); f[1] = pg8::bfhi(w.x); f[2] = pg8::bflo(w.y); f[3] = pg8::bfhi(w.y); f[4] = pg8::bflo(w.z); f[5] = pg8::bfhi(w.z); f[6] = pg8::bflo(w.w); f[7] = pg8::bfhi(w.w); }
__device__ __forceinline__ v4u pk8(const float (&f)[8]) { v4u w; w.x = pk2(f[0], f[1]); w.y = pk2(f[2], f[3]); w.z = pk2(f[4], f[5]); w.w = pk2(f[6], f[7]); return w; }
__device__ __forceinline__ void st_tr8(LAS unsigned char* base, int row0, int col, const float (&f)[8]) {
#pragma unroll
    for (int j = 0; j < 8; ++j) *(LAS bf16*)(base + (row0 + j) * (PT * 2) + col * 2) = (bf16)f2bf(f[j]);
}

#define LBAR() asm volatile("s_waitcnt lgkmcnt(0)\n\ts_barrier" ::: "memory")
typedef short s16x4 __attribute__((ext_vector_type(4)));
__device__ __forceinline__ s16x4 tr4(LAS unsigned char* p) { return __builtin_bit_cast(s16x4, __builtin_amdgcn_ds_read_tr16_b64_v4i16((LAS s16x4*)p)); }
__device__ __forceinline__ bf16x8 trfrag(LAS unsigned char* tile, int krow0, int col0, int fr) {
    LAS unsigned char* a = tile + (krow0 + (fr >> 2)) * (PT * 2) + (col0 + 4 * (fr & 3)) * 2;
    const s16x4 lo = tr4(a), hi = tr4(a + 4 * PT * 2);
    return (bf16x8){lo[0], lo[1], lo[2], lo[3], hi[0], hi[1], hi[2], hi[3]};
}
__device__ __forceinline__ float bfs(short v) { return __uint_as_float((unsigned)(unsigned short)v << 16); }

template <int KIND>
__device__ __forceinline__ void mixer_walk(const __attribute__((address_space(4))) Args* kp, int layer, int b, int h, LAS unsigned char* lds) {
    int tid = threadIdx.x; asm volatile("" : "+v"(tid));
    const int lane = tid & 63, wave = __builtin_amdgcn_readfirstlane(tid >> 6), fr = lane & 15, fq = lane >> 4;
    const int prow = tid >> 3, pcg = tid & 7;
    unsigned char* ws = kp->ws;
    const bf16* MIX = (const bf16*)(ws + WS_MIX); bf16* ZB = (bf16*)(ws + WS_ZB); float* SM = (float*)(ws + WS_SM);
    const bf16* GW = (const bf16*)(ws + ((layer & 1) ? WS_XB0 : WS_XB1) + GW_OFF);
    const size_t tok0 = (size_t)b * SEQ;
    const int g = h >> 2;
    const int qcol = (KIND == 0 ? MX_AQ + h * 64 : (KIND == 1 ? MX_BC + g * 64 : MX_CQ + h * 64)) + pcg * 8;
    const int kcol = (KIND == 0 ? MX_AK + h * 64 : (KIND == 1 ? MX_BB + g * 64 : MX_CK + h * 64)) + pcg * 8;
    const int vcol = (KIND == 0 ? MX_AV + h * 64 : (KIND == 1 ? MX_BX + h * 64 : MX_CV + h * 64)) + pcg * 8;
    const int zcol = KIND * 512 + h * 64 + pcg * 8;
    const int gcol = (KIND == 0 ? 8 : 16) + h;
    float nw[8];
    if (KIND == 0) {
#pragma unroll
        for (int j = 0; j < 8; ++j) nw[j] = kp->in[7][layer * 64 + pcg * 8 + j];
    }
    const float p_D = KIND == 1 ? kp->in[12][layer * 8 + h] : 0.f;
    const float p_lg = KIND == 2 ? log1pf(-exp2f(-5.0f - (float)h)) : 0.f;
    for (int i = tid; i < MAT / 4; i += 512) ((LAS unsigned*)(lds + L_ST0))[i] = 0u;
    pg8::f32x4 sacc[4];
#pragma unroll
    for (int i = 0; i < 4; ++i) sacc[i] = (pg8::f32x4){0.f, 0.f, 0.f, 0.f};
    LAS float* Gv = (LAS float*)(lds + L_G); LAS float* Dv = (LAS float*)(lds + L_DT);
    LAS unsigned char* PPw = lds + L_PP + (wave & 3) * (16 * PT * 2);

    v4u tq, tk, tv, tw, tz; float sg = 0.f, sd = 1.f; (void)tw;
#define WALK_LOAD(c) do { const size_t row = tok0 + (size_t)(c) * 64 + prow; const bf16* mp = MIX + row * MIX_LD; \
        tq = *(const GAS v4u*)(mp + qcol); tk = *(const GAS v4u*)(mp + kcol); tv = *(const GAS v4u*)(mp + vcol); \
        if (KIND == 0) tw = *(const GAS v4u*)(GW + row * 512 + h * 64 + pcg * 8); \
        tz = *(const GAS v4u*)(ZB + row * ZB_LD + zcol); \
        if (tid < 64) { const size_t r2 = tok0 + (size_t)(c) * 64 + tid; \
            if (KIND == 2) sg = (float)(tid + 1) * p_lg; else sg = SM[r2 * SM_LD + gcol]; \
            if (KIND == 1) sd = SM[r2 * SM_LD + 24 + h]; } } while (0)
#define WALK_PREP() do { \
        *(LAS v4u*)(lds + L_Q + prow * (PT * 2) + pcg * 16) = tq; *(LAS v4u*)(lds + L_K + prow * (PT * 2) + pcg * 16) = tk; \
        if (KIND == 0) { *(LAS v4u*)(lds + L_U + prow * (PT * 2) + pcg * 16) = tv; *(LAS v4u*)(lds + L_W + prow * (PT * 2) + pcg * 16) = tw; } \
        else *(LAS v4u*)(lds + L_V + prow * (PT * 2) + pcg * 16) = tv; \
        if (tid < 64) { Gv[tid] = sg; Dv[tid] = sd; } } while (0)

    WALK_LOAD(0);
    WALK_PREP();
    v4u zc = tz, xc = tv;
    LBAR();
    for (int c = 0; c < SEQ / 64; ++c) {
        LAS unsigned char* STc = lds + ((c & 1) ? L_ST1 : L_ST0); LAS unsigned char* STn = lds + ((c & 1) ? L_ST0 : L_ST1);
        if (c + 1 < SEQ / 64) WALK_LOAD(c + 1);
        bf16x8 Qf[2];
        if (wave < 4) { const int lb = wave;
            Qf[0] = ldfrag(lds + L_Q, 16 * lb + fr, 8 * fq); Qf[1] = ldfrag(lds + L_Q, 16 * lb + fr, 32 + 8 * fq);
            const float gl = Gv[16 * lb + fr];
#pragma unroll
            for (int sb = 0; sb < 4; ++sb) { v2u o; o.x = 0u; o.y = 0u;
                if (sb <= lb) { pg8::f32x4 acc = (pg8::f32x4){0.f, 0.f, 0.f, 0.f};
#pragma unroll
                    for (int ks = 0; ks < 2; ++ks) acc = MFMA16(ldfrag(lds + L_K, 16 * sb + fr, 32 * ks + 8 * fq), Qf[ks], acc);
                    const pg8::f32x4 gs = *(const LAS pg8::f32x4*)(Gv + 16 * sb + 4 * fq); pg8::f32x4 ds = (pg8::f32x4){1.f, 1.f, 1.f, 1.f};
                    if (KIND == 1) ds = *(const LAS pg8::f32x4*)(Dv + 16 * sb + 4 * fq);
                    float pv[4];
#pragma unroll
                    for (int r = 0; r < 4; ++r) pv[r] = (16 * sb + 4 * fq + r <= 16 * lb + fr) ? acc[r] * __expf(gl - gs[r]) * ds[r] : 0.f;
                    o.x = pk2(pv[0], pv[1]); o.y = pk2(pv[2], pv[3]); }
                *(LAS v2u*)(PPw + fr * (PT * 2) + (16 * sb + 4 * fq) * 2) = o; }
        } else if (KIND == 0) { const int wq = wave - 4;
            const bf16x8 Wf0 = ldfrag(lds + L_W, 16 * wq + fr, 8 * fq), Wf1 = ldfrag(lds + L_W, 16 * wq + fr, 32 + 8 * fq);
#pragma unroll
            for (int eb = 0; eb < 4; ++eb) { pg8::f32x4 acc = (pg8::f32x4){0.f, 0.f, 0.f, 0.f};
                acc = MFMA16(Wf0, ldfrag(STc, 16 * eb + fr, 8 * fq), acc); acc = MFMA16(Wf1, ldfrag(STc, 16 * eb + fr, 32 + 8 * fq), acc);
                const s16x4 u4 = tr4(lds + L_U + (16 * wq + 4 * fq + (fr >> 2)) * (PT * 2) + (16 * eb + 4 * (fr & 3)) * 2);
                v2u o; o.x = pk2(bfs(u4[0]) - acc[0], bfs(u4[1]) - acc[1]); o.y = pk2(bfs(u4[2]) - acc[2], bfs(u4[3]) - acc[3]);
                *(LAS v2u*)(lds + L_V + (16 * eb + fr) * (PT * 2) + (16 * wq + 4 * fq) * 2) = o; }
        }
        if (KIND == 0) LBAR();
        if (wave < 4) { const int lb = wave;
            const bf16x8 Pf0 = ldfrag(PPw, fr, 8 * fq), Pf1 = ldfrag(PPw, fr, 32 + 8 * fq);
            const pg8::f32x4 gv = *(const LAS pg8::f32x4*)(Gv + 16 * lb + 4 * fq);
            const pg8::f32x4 eg = (pg8::f32x4){__expf(gv[0]), __expf(gv[1]), __expf(gv[2]), __expf(gv[3])};
#pragma unroll
            for (int eb = 0; eb < 4; ++eb) { pg8::f32x4 acc = (pg8::f32x4){0.f, 0.f, 0.f, 0.f};
                acc = MFMA16(Qf[0], ldfrag(STc, 16 * eb + fr, 8 * fq), acc); acc = MFMA16(Qf[1], ldfrag(STc, 16 * eb + fr, 32 + 8 * fq), acc);
                acc *= eg;
                if (KIND == 0) { acc = MFMA16(Pf0, ldfrag(lds + L_V, 16 * eb + fr, 8 * fq), acc); acc = MFMA16(Pf1, ldfrag(lds + L_V, 16 * eb + fr, 32 + 8 * fq), acc); }
                else { acc = MFMA16(Pf0, trfrag(lds + L_V, 8 * fq, 16 * eb, fr), acc); acc = MFMA16(Pf1, trfrag(lds + L_V, 32 + 8 * fq, 16 * eb, fr), acc); }
#pragma unroll
                for (int r = 0; r < 4; ++r) ((LAS float*)(lds + L_YT))[(16 * lb + 4 * fq + r) * YPT + 16 * eb + fr] = acc[r]; }
        } else { const int db = wave - 4;
            const float glast = Gv[63], egl = __expf(glast);
            bf16x8 Kf[2];
#pragma unroll
            for (int ks = 0; ks < 2; ++ks) { const bf16x8 kr = trfrag(lds + L_K, 32 * ks + 8 * fq, 16 * db, fr);
                const pg8::f32x4 g0 = *(const LAS pg8::f32x4*)(Gv + 32 * ks + 8 * fq), g1 = *(const LAS pg8::f32x4*)(Gv + 32 * ks + 8 * fq + 4);
                pg8::f32x4 d0 = (pg8::f32x4){1.f, 1.f, 1.f, 1.f}, d1 = d0;
                if (KIND == 1) { d0 = *(const LAS pg8::f32x4*)(Dv + 32 * ks + 8 * fq); d1 = *(const LAS pg8::f32x4*)(Dv + 32 * ks + 8 * fq + 4); }
                float kf[8];
#pragma unroll
                for (int j = 0; j < 4; ++j) { kf[j] = bfs(kr[j]) * __expf(glast - g0[j]) * d0[j]; kf[4 + j] = bfs(kr[4 + j]) * __expf(glast - g1[j]) * d1[j]; }
                const v4u kw = pk8(kf); Kf[ks] = __builtin_bit_cast(bf16x8, kw); }
#pragma unroll
            for (int eb = 0; eb < 4; ++eb) { pg8::f32x4 acc = sacc[eb] * egl;
                if (KIND == 0) { acc = MFMA16(Kf[0], ldfrag(lds + L_V, 16 * eb + fr, 8 * fq), acc); acc = MFMA16(Kf[1], ldfrag(lds + L_V, 16 * eb + fr, 32 + 8 * fq), acc); }
                else { acc = MFMA16(Kf[0], trfrag(lds + L_V, 8 * fq, 16 * eb, fr), acc); acc = MFMA16(Kf[1], trfrag(lds + L_V, 32 + 8 * fq, 16 * eb, fr), acc); }
                sacc[eb] = acc;
                v2u o; o.x = pk2(acc[0], acc[1]); o.y = pk2(acc[2], acc[3]);
                *(LAS v2u*)(STn + (16 * eb + fr) * (PT * 2) + (16 * db + 4 * fq) * 2) = o; }
        }
        LBAR();
        {
            const LAS float* yr = (const LAS float*)(lds + L_YT) + prow * YPT + pcg * 8;
            const pg8::f32x4 y0 = *(const LAS pg8::f32x4*)yr, y1 = *(const LAS pg8::f32x4*)(yr + 4);
            float y[8] = {y0[0], y0[1], y0[2], y0[3], y1[0], y1[1], y1[2], y1[3]}, zf[8]; unpk8(zc, zf);
            const size_t row = tok0 + (size_t)c * 64 + prow;
            if (KIND == 1) { float ss = 0.f, xf[8]; unpk8(xc, xf);
#pragma unroll
                for (int j = 0; j < 8; ++j) { y[j] = (y[j] + p_D * xf[j]) * siluf(zf[j]); ss += y[j] * y[j]; }
                ss += __shfl_xor(ss, 1); ss += __shfl_xor(ss, 2); ss += __shfl_xor(ss, 4);
                if (pcg == 0) SM[row * SM_LD + 16 + h] = ss;
            } else { float ss = 0.f;
#pragma unroll
                for (int j = 0; j < 8; ++j) ss += y[j] * y[j];
                ss += __shfl_xor(ss, 1); ss += __shfl_xor(ss, 2); ss += __shfl_xor(ss, 4);
                const float rstd = rsqrtf(ss * (1.0f / 64.0f) + 1e-6f);
#pragma unroll
                for (int j = 0; j < 8; ++j) y[j] = y[j] * rstd * (KIND == 0 ? nw[j] : 1.0f) * siluf(zf[j]); }
            *(GAS v4u*)(ZB + row * ZB_LD + zcol) = pk8(y);
        }
        if (c + 1 < SEQ / 64) { WALK_PREP(); zc = tz; xc = tv; }
        LBAR();
    }
#undef WALK_LOAD
#undef WALK_PREP
}

constexpr int SP_RAW = 0, SP_CW = 67 * 1536, SP_END = SP_CW + 5 * 768 * 4;
static_assert(SP_END <= RING_BYTES, "ssd_prep LDS");
__device__ __forceinline__ void ssd_prep(const __attribute__((address_space(4))) Args* kp, int layer, LAS unsigned char* lds, int G_) {
    int tid = threadIdx.x; asm volatile("" : "+v"(tid));
    const int lane = tid & 63, wave = __builtin_amdgcn_readfirstlane(tid >> 6);
    unsigned char* ws = kp->ws;
    bf16* MIX = (bf16*)(ws + WS_MIX); float* SM = (float*)(ws + WS_SM);
    const bf16* HALO = (const bf16*)(ws + ((layer & 1) ? WS_XB0 : WS_XB1) + HALO_OFF);
    LAS float* CW = (LAS float*)(lds + SP_CW);
    { const float* cw = kp->in[8] + (size_t)layer * 4 * 768; const float* cb = kp->in[9] + (size_t)layer * 768;
      for (int i = tid; i < 768; i += 512) { CW[i] = cw[i]; CW[768 + i] = cw[768 + i]; CW[2 * 768 + i] = cw[2 * 768 + i]; CW[3 * 768 + i] = cw[3 * 768 + i]; CW[4 * 768 + i] = cb[i]; } }
    const float Aexp = expf(kp->in[10][layer * 8 + wave]), dtb = kp->in[11][layer * 8 + wave];
    for (int unit = blockIdx.x; unit < NBATCH * 64; unit += G_) { const int b = unit >> 6, c = unit & 63; const size_t tok0 = (size_t)b * SEQ + (size_t)c * 64;
        LBAR();
        for (int i = tid; i < 67 * 96; i += 512) { const int r = i / 96, pc = i - r * 96; v4u v = (v4u){0u, 0u, 0u, 0u};
            if (r >= 3) v = *(const GAS v4u*)(MIX + (tok0 + r - 3) * MIX_LD + MX_BX + pc * 8);
            else if (c > 0) v = *(const GAS v4u*)(HALO + ((size_t)(b * 64 + c - 1) * 3 + r) * HALO_LD + MX_BX + pc * 8);
            *(LAS v4u*)(lds + SP_RAW + r * 1536 + pc * 16) = v; }
        { const size_t r2 = tok0 + lane; const float dt = softplusf(SM[r2 * SM_LD + 16 + wave] + dtb); float gs = -Aexp * dt;
#pragma unroll
          for (int o = 1; o < 64; o <<= 1) { const float t_ = __shfl_up(gs, o); if (lane >= o) gs += t_; }
          SM[r2 * SM_LD + 16 + wave] = gs; SM[r2 * SM_LD + 24 + wave] = dt; }
        LBAR();
        for (int i = tid; i < 64 * 96; i += 512) { const int l = i / 96, pc = i - l * 96; float a[8];
            { const pg8::f32x4 b0 = *(const LAS pg8::f32x4*)(CW + 4 * 768 + pc * 8), b1 = *(const LAS pg8::f32x4*)(CW + 4 * 768 + pc * 8 + 4);
              a[0] = b0[0]; a[1] = b0[1]; a[2] = b0[2]; a[3] = b0[3]; a[4] = b1[0]; a[5] = b1[1]; a[6] = b1[2]; a[7] = b1[3]; }
#pragma unroll
            for (int k = 0; k < 4; ++k) { float f[8]; unpk8(*(const LAS v4u*)(lds + SP_RAW + (l + k) * 1536 + pc * 16), f);
                const pg8::f32x4 w0 = *(const LAS pg8::f32x4*)(CW + k * 768 + pc * 8), w1 = *(const LAS pg8::f32x4*)(CW + k * 768 + pc * 8 + 4);
#pragma unroll
                for (int j = 0; j < 4; ++j) { a[j] += w0[j] * f[j]; a[4 + j] += w1[j] * f[4 + j]; } }
#pragma unroll
            for (int j = 0; j < 8; ++j) a[j] = siluf(a[j]);
            *(GAS v4u*)(MIX + (tok0 + l) * MIX_LD + MX_BX + pc * 8) = pk8(a); }
    }
    LBAR();
}
__device__ __forceinline__ void ret_prep(const __attribute__((address_space(4))) Args* kp, int G_) {
    int tid = threadIdx.x; asm volatile("" : "+v"(tid));
    unsigned char* ws = kp->ws;
    bf16* MIX = (bf16*)(ws + WS_MIX); const float* ROPE = (const float*)(ws + WS_ROPE);
    for (int it = blockIdx.x * 512 + tid; it < MTOK * 32; it += G_ * 512) { const int m = it >> 5, hh = (it >> 2) & 7, i4 = it & 3, t = m & (SEQ - 1);
        const float* rp = ROPE + t * 32 + i4 * 8;
        const pg8::f32x4 c0 = *(const GAS pg8::f32x4*)rp, c1 = *(const GAS pg8::f32x4*)(rp + 4), s0 = *(const GAS pg8::f32x4*)(rp + SEQ * 32), s1 = *(const GAS pg8::f32x4*)(rp + SEQ * 32 + 4);
        const float cs[8] = {c0[0], c0[1], c0[2], c0[3], c1[0], c1[1], c1[2], c1[3]}, sn[8] = {s0[0], s0[1], s0[2], s0[3], s1[0], s1[1], s1[2], s1[3]};
#pragma unroll
        for (int T = 0; T < 2; ++T) { bf16* p = MIX + (size_t)m * MIX_LD + (T == 0 ? MX_CQ : MX_CK) + hh * 64 + i4 * 8; const float sc = T == 0 ? 1.0f : 0.125f;
            float a[8], bb[8], o1[8], o2[8]; unpk8(*(const GAS v4u*)p, a); unpk8(*(const GAS v4u*)(p + 32), bb);
#pragma unroll
            for (int j = 0; j < 8; ++j) { o1[j] = (a[j] * cs[j] - bb[j] * sn[j]) * sc; o2[j] = (a[j] * sn[j] + bb[j] * cs[j]) * sc; }
            *(GAS v4u*)p = pk8(o1); *(GAS v4u*)(p + 32) = pk8(o2); }
    }
}

typedef short bf16x4 __attribute__((ext_vector_type(4)));
#define MFMA16K16(a, b, c) __builtin_amdgcn_mfma_f32_16x16x16bf16_1k(a, b, c, 0, 0, 0)
constexpr int GQ_RAW = 0, GQ_KN = 67 * 384, GQ_VN = GQ_KN + MAT, GQ_NA = GQ_VN + MAT, GQ_AD = GQ_NA + MAT, GQ_S = GQ_AD + 4 * 16 * 20 * 4, GQ_CW = GQ_S + 512, GQ_TEAM = GQ_CW + 4 * 192 * 4;
static_assert(2 * GQ_TEAM <= RING_BYTES && 2 * MAT <= GQ_KN, "gdn_prep LDS");
__device__ __forceinline__ bf16x4 pk4(const pg8::f32x4 v) { v2u w; w.x = pk2(v[0], v[1]); w.y = pk2(v[2], v[3]); return __builtin_bit_cast(bf16x4, w); }
__device__ __forceinline__ void gdn_prep(const __attribute__((address_space(4))) Args* kp, int layer, LAS unsigned char* lds_all, int G_) {
    int tid = threadIdx.x; asm volatile("" : "+v"(tid));
    const int team = __builtin_amdgcn_readfirstlane(tid >> 8), j = tid & 255, lane = tid & 63, tw = __builtin_amdgcn_readfirstlane((tid >> 6) & 3), fr = lane & 15, fq = lane >> 4;
    LAS unsigned char* lds = lds_all + team * GQ_TEAM;
    LAS float* AD = (LAS float*)(lds + GQ_AD); LAS float* Gs = (LAS float*)(lds + GQ_S); LAS float* Bs = Gs + 64; LAS float* CW = (LAS float*)(lds + GQ_CW);
    unsigned char* ws = kp->ws;
    bf16* MIX = (bf16*)(ws + WS_MIX); float* SM = (float*)(ws + WS_SM);
    unsigned char* xbf = ws + ((layer & 1) ? WS_XB0 : WS_XB1); bf16* GW = (bf16*)(xbf + GW_OFF); const bf16* HALO = (const bf16*)(xbf + HALO_OFF);
    const float* cw = kp->in[4] + (size_t)layer * 4 * 1536;
    v4u praw[7]; float pcw[3], pbl = 0.f, pal = 0.f;
#define GQ_FETCH(rnd) do { const int u_ = ((rnd) * G_ + (int)blockIdx.x) * 2 + team; const int un_ = u_ < NBATCH * 8 * 64 ? u_ : 0; \
        const int c_ = un_ & 63, h_ = (un_ >> 6) & 7, b_ = un_ >> 9; const size_t tk_ = (size_t)b_ * SEQ + (size_t)c_ * 64; \
        _Pragma("unroll") for (int n = 0; n < 7; ++n) { const int i = j + 256 * n; praw[n] = (v4u){0u, 0u, 0u, 0u}; \
            if (i < 67 * 24) { const int r = i / 24, pc = i - r * 24, col = (pc >> 3) * 512 + h_ * 64 + (pc & 7) * 8; \
                if (r >= 3) praw[n] = *(const GAS v4u*)(MIX + (tk_ + r - 3) * MIX_LD + col); \
                else if (c_ > 0) praw[n] = *(const GAS v4u*)(HALO + ((size_t)(b_ * 64 + c_ - 1) * 3 + r) * HALO_LD + col); } } \
        _Pragma("unroll") for (int n = 0; n < 3; ++n) { const int i = j + 256 * n, k = i / 192, cc = i - k * 192; pcw[n] = cw[k * 1536 + (cc >> 6) * 512 + h_ * 64 + (cc & 63)]; } \
        if (tw == 0) { pbl = SM[(tk_ + lane) * SM_LD + h_]; pal = SM[(tk_ + lane) * SM_LD + 8 + h_]; } } while (0)
    GQ_FETCH(0);
    for (int round = 0; round < 8; ++round) {
        const int unit_ = (round * G_ + (int)blockIdx.x) * 2 + team;
        const bool live = unit_ < NBATCH * 8 * 64;
        const int unit = live ? unit_ : 0;
        const int c = unit & 63, h = (unit >> 6) & 7, b = unit >> 9;
        const size_t tok0 = (size_t)b * SEQ + (size_t)c * 64;
        LBAR();
#pragma unroll
        for (int n = 0; n < 7; ++n) { const int i = j + 256 * n; if (i < 67 * 24) { const int r = i / 24, pc = i - r * 24; *(LAS v4u*)(lds + GQ_RAW + r * 384 + pc * 16) = praw[n]; } }
#pragma unroll
        for (int n = 0; n < 3; ++n) CW[j + 256 * n] = pcw[n];
        if (tw == 0) {
            float gsum = -expf(kp->in[5][layer * 8 + h]) * softplusf(pal + kp->in[6][layer * 8 + h]);
#pragma unroll
            for (int o = 1; o < 64; o <<= 1) { const float t_ = __shfl_up(gsum, o); if (lane >= o) gsum += t_; }
            Gs[lane] = gsum; Bs[lane] = sigmf(pbl);
            if (live) SM[(tok0 + lane) * SM_LD + 8 + h] = gsum; }
        if (round + 1 < 8) GQ_FETCH(round + 1);
        LBAR();
#pragma unroll 1
        for (int n = 0; n < 6; ++n) { const int i = j + 256 * n, t = i / 24, pc = i - t * 24, tens = pc >> 3, ch = pc & 7; float a[8];
#pragma unroll
            for (int jj = 0; jj < 8; ++jj) a[jj] = 0.f;
#pragma unroll
            for (int k = 0; k < 4; ++k) { float f[8]; unpk8(*(const LAS v4u*)(lds + GQ_RAW + (t + k) * 384 + pc * 16), f);
                const pg8::f32x4 w0 = *(const LAS pg8::f32x4*)(CW + k * 192 + pc * 8), w1 = *(const LAS pg8::f32x4*)(CW + k * 192 + pc * 8 + 4);
#pragma unroll
                for (int jj = 0; jj < 4; ++jj) { a[jj] += w0[jj] * f[jj]; a[4 + jj] += w1[jj] * f[4 + jj]; } }
            float ss = 0.f;
#pragma unroll
            for (int jj = 0; jj < 8; ++jj) { a[jj] = siluf(a[jj]); ss += a[jj] * a[jj]; }
            ss += __shfl_xor(ss, 1); ss += __shfl_xor(ss, 2); ss += __shfl_xor(ss, 4);
            const float sc = tens == 2 ? 1.0f : rsqrtf(ss + 1e-6f) * (tens == 0 ? 0.125f : 1.0f);
#pragma unroll
            for (int jj = 0; jj < 8; ++jj) a[jj] *= sc;
            const v4u o = pk8(a);
            if (tens == 0) { if (live) *(GAS v4u*)(MIX + (tok0 + t) * MIX_LD + MX_AQ + h * 64 + ch * 8) = o; }
            else if (tens == 1) { *(LAS v4u*)(lds + GQ_KN + t * (PT * 2) + ch * 16) = o; if (live) *(GAS v4u*)(MIX + (tok0 + t) * MIX_LD + MX_AK + h * 64 + ch * 8) = o; }
            else *(LAS v4u*)(lds + GQ_VN + t * (PT * 2) + ch * 16) = o; }
        LBAR();
        for (int id = tw; id < 10; id += 4) { const int lb = id < 1 ? 0 : (id < 3 ? 1 : (id < 6 ? 2 : 3)), sb = id - (lb * (lb + 1)) / 2;
            pg8::f32x4 acc = (pg8::f32x4){0.f, 0.f, 0.f, 0.f};
#pragma unroll
            for (int ks = 0; ks < 2; ++ks) acc = MFMA16(ldfrag(lds + GQ_KN, 16 * lb + fr, 32 * ks + 8 * fq), ldfrag(lds + GQ_KN, 16 * sb + fr, 32 * ks + 8 * fq), acc);
            const int s = 16 * sb + fr; const float gsv = Gs[s];
#pragma unroll
            for (int r = 0; r < 4; ++r) { const int l = 16 * lb + 4 * fq + r; const float v = s < l ? Bs[l] * acc[r] * __expf(Gs[l] - gsv) : 0.f;
                if (lb == sb) AD[(lb * 16 + 4 * fq + r) * 20 + fr] = v;
                else *(LAS bf16*)(lds + GQ_NA + l * (PT * 2) + s * 2) = (bf16)f2bf(-v); } }
        LBAR();
        if (tw == 0) { const int bi = lane >> 4, cc = lane & 15; const LAS float* Ab = AD + bi * 16 * 20; float x[16];
#pragma unroll
            for (int r = 0; r < 16; ++r) { float a = (r == cc) ? 1.0f : 0.0f;
#pragma unroll
                for (int s4 = 0; s4 < r; s4 += 4) { const pg8::f32x4 av = *(const LAS pg8::f32x4*)(Ab + r * 20 + s4);
                    a -= av[0] * x[s4];
                    if (s4 + 1 < r) a -= av[1] * x[s4 + 1];
                    if (s4 + 2 < r) a -= av[2] * x[s4 + 2];
                    if (s4 + 3 < r) a -= av[3] * x[s4 + 3]; }
                x[r] = a; }
#pragma unroll
            for (int r = 0; r < 16; ++r) *(LAS bf16*)(lds + GQ_NA + (16 * bi + r) * (PT * 2) + (16 * bi + cc) * 2) = (bf16)f2bf(x[r]); }
        LBAR();
#pragma unroll 1
        for (int half = 0; half < 2; ++half) { LAS unsigned char* src = lds + (half == 0 ? GQ_VN : GQ_KN); const int c0 = 16 * tw;
            pg8::f32x4 R[4], X[4];
#pragma unroll
            for (int i = 0; i < 4; ++i) { const s16x4 raw = tr4(src + (16 * i + 4 * fq + (fr >> 2)) * (PT * 2) + (c0 + 4 * (fr & 3)) * 2);
                const pg8::f32x4 bv = *(const LAS pg8::f32x4*)(Bs + 16 * i + 4 * fq); pg8::f32x4 sc = bv;
                if (half == 1) { const pg8::f32x4 gv = *(const LAS pg8::f32x4*)(Gs + 16 * i + 4 * fq); sc = (pg8::f32x4){bv[0] * __expf(gv[0]), bv[1] * __expf(gv[1]), bv[2] * __expf(gv[2]), bv[3] * __expf(gv[3])}; }
                R[i] = (pg8::f32x4){bfs(raw[0]) * sc[0], bfs(raw[1]) * sc[1], bfs(raw[2]) * sc[2], bfs(raw[3]) * sc[3]}; }
#define NAF(ib, jb) (*(const LAS bf16x4*)(lds + GQ_NA + (16 * (ib) + fr) * (PT * 2) + (16 * (jb) + 4 * fq) * 2))
            const pg8::f32x4 Z = (pg8::f32x4){0.f, 0.f, 0.f, 0.f};
            X[0] = MFMA16K16(NAF(0, 0), pk4(R[0]), Z);
            { const bf16x4 x0 = pk4(X[0]); R[1] = MFMA16K16(NAF(1, 0), x0, R[1]); R[2] = MFMA16K16(NAF(2, 0), x0, R[2]); R[3] = MFMA16K16(NAF(3, 0), x0, R[3]); }
            X[1] = MFMA16K16(NAF(1, 1), pk4(R[1]), Z);
            { const bf16x4 x1 = pk4(X[1]); R[2] = MFMA16K16(NAF(2, 1), x1, R[2]); R[3] = MFMA16K16(NAF(3, 1), x1, R[3]); }
            X[2] = MFMA16K16(NAF(2, 2), pk4(R[2]), Z);
            { const bf16x4 x2 = pk4(X[2]); R[3] = MFMA16K16(NAF(3, 2), x2, R[3]); }
            X[3] = MFMA16K16(NAF(3, 3), pk4(R[3]), Z);
#undef NAF
#pragma unroll
            for (int i = 0; i < 4; ++i)
#pragma unroll
                for (int r = 0; r < 4; ++r) *(LAS bf16*)(lds + GQ_RAW + half * MAT + (16 * i + 4 * fq + r) * (PT * 2) + (c0 + fr) * 2) = (bf16)f2bf(X[i][r]);
        }
        LBAR();
        if (live) for (int i = j; i < 64 * 16; i += 256) { const int t = (i >> 3) & 63, ch = i & 7, half = i >> 9;
            const v4u v = *(const LAS v4u*)(lds + GQ_RAW + half * MAT + t * (PT * 2) + ch * 16);
            if (half == 0) *(GAS v4u*)(MIX + (tok0 + t) * MIX_LD + MX_AV + h * 64 + ch * 8) = v; else *(GAS v4u*)(GW + (tok0 + t) * 512 + h * 64 + ch * 8) = v; }
    }
    LBAR();
}
#ifndef MK_ONE_LAUNCH
#define MK_ONE_LAUNCH 1
#endif
#ifndef MK_NAIVE
#define MK_NAIVE 0
#endif
__global__ void __launch_bounds__(64) mixers_naive(Args args, int layer) {
    const int lane = threadIdx.x, w = blockIdx.x, kind = w >> 6, b = (w & 63) >> 3, h = w & 7;
    unsigned char* ws = args.ws;
    bf16* ZB = (bf16*)(ws + WS_ZB); const bf16* MIX = (const bf16*)(ws + WS_MIX); float* SM = (float*)(ws + WS_SM); const float* ROPE = (const float*)(ws + WS_ROPE);
    if (kind == 0) gdn_naive(args, layer, b, h, lane, MIX, SM, ZB);
    else if (kind == 1) ssd_naive(args, layer, b, h, lane, MIX, SM, ZB);
    else ret_naive(b, h, lane, MIX, ROPE, ZB);
}
__global__ void __launch_bounds__(512, 2) fwd_kernel(Args args) {
    extern __shared__ __attribute__((aligned(16))) unsigned char lds_raw[];
    LAS unsigned char* lds = (LAS unsigned char*)lds_raw;
    volatile LAS unsigned* MISC = (volatile LAS unsigned*)(lds + MISC_OFF);
    const int G = gridDim.x, NGW = G * 8;
    unsigned char* ws0 = args.ws;
    for (int u = threadIdx.x; u < (LDS_BYTES - RING_BYTES) / 4; u += 512) ((LAS unsigned*)(lds + RING_BYTES))[u] = 0u;
    __syncthreads();
#if MK_ONE_LAUNCH
    XcdBarrier bar = xcd_barrier_post((unsigned*)(ws0 + WS_CTL) + 4096, MISC + 8);
#define GRID_BAR() do { XcdBarrier b_ = bar; asm volatile("" : "+s"(b_.bar), "+s"(b_.x)); xcd_barrier(b_); } while (0)
#else
#define GRID_BAR() do {} while (0)
#endif
    const int lo = args.ph_lo, hi = args.ph_hi;
#define IN(p) (lo <= (p) && (p) < hi)
#define SEAM(p) do { if (IN(p) && IN((p) + 1)) GRID_BAR(); } while (0)
    typedef const __attribute__((address_space(4))) Args* KArgs;
    const KArgs kp0 = (KArgs)__builtin_amdgcn_kernarg_segment_ptr();
#define PHASE_PTRS() KArgs kp = kp0; asm volatile("" : "+s"(kp)); unsigned char* ws = kp->ws; float* X = kp->out; (void)X; \
    int tid = threadIdx.x; asm volatile("" : "+v"(tid)); int bx = blockIdx.x; asm volatile("" : "+s"(bx)); const int lane = tid & 63, wave = __builtin_amdgcn_readfirstlane(tid >> 6), gw = bx * 8 + wave; (void)lane; (void)gw; \
    bf16* ZB = (bf16*)(ws + WS_ZB); bf16* MIX = (bf16*)(ws + WS_MIX); float* SM = (float*)(ws + WS_SM); (void)ZB; (void)MIX; (void)SM; \
    float* SSQA = (float*)(ws + WS_SSQA); float* SSQB = (float*)(ws + WS_SSQB); float* SSQC = (float*)(ws + WS_SSQC); float* ROPE = (float*)(ws + WS_ROPE); (void)SSQA; (void)SSQB; (void)SSQC; (void)ROPE; \
    bf16* W1T = (bf16*)(ws + W_1T); bf16* WGT = (bf16*)(ws + W_GT); bf16* WMT = (bf16*)(ws + W_MT); bf16* WOT = (bf16*)(ws + W_OT); bf16* WUT = (bf16*)(ws + W_UT); (void)W1T; (void)WGT; (void)WMT; (void)WOT; (void)WUT; \
    bf16* WDT = (bf16*)(ws + W_DT); bf16* WPGT = (bf16*)(ws + W_PGT); bf16* WPPT = (bf16*)(ws + W_PPT); (void)WDT; (void)WPGT; (void)WPPT; \
    bf16* GATE = (bf16*)(ws + WS_GATE); bf16* U = (bf16*)(ws + WS_U); bf16* PB = (bf16*)X; bf16* PLE = (bf16*)X + (size_t)MTOK * PLED;     (void)GATE; (void)U; (void)PB; (void)PLE; \
    bf16* XBl = (bf16*)(ws + ((layer & 1) ? WS_XB1 : WS_XB0)); bf16* XBf = (bf16*)(ws + ((layer & 1) ? WS_XB0 : WS_XB1)); (void)XBl; (void)XBf
    if (IN(0)) { const int layer = 0; PHASE_PTRS();
        for (int e = bx * 512 + tid; e < SEQ * 32; e += G * 512) { const int t = e >> 5, i = e & 31;
            double f = 1.0; for (int j = 0; j < i; ++j) f *= 0.7429639507594948;
            const double ang = (double)t * f, kk = rint(ang * 0.15915494309189535);
            double r = fma(-kk, 6.283185307179586, ang); r = fma(-kk, 2.4492935982947064e-16, r); const double r2 = r * r;
            double sn = 1.0, cs = 1.0;
    #pragma unroll
            for (int n = 15; n >= 1; --n) { sn = 1.0 - r2 * (1.0 / (double)((2 * n) * (2 * n + 1))) * sn; cs = 1.0 - r2 * (1.0 / (double)((2 * n - 1) * (2 * n))) * cs; }
            ROPE[e] = (float)cs; ROPE[SEQ * 32 + e] = (float)(r * sn); }
    }
    for (int layer = 0; layer < DEPTH; ++layer) {
        const int P = layer * NPH;
        if (IN(P + 0)) { PHASE_PTRS();
            int ibase = 0;
            const float* w_in = kp->in[3] + (size_t)layer * DM * NIN; const float* nmix = kp->in[2] + (size_t)layer * DM;
            TR_SEG(w_in, NIN, 1536, 512, DM, nmix, W1T, DM, 0, 0);
            TR_SEG(w_in, NIN, 2064, 512, DM, nmix, W1T, DM, 512, 0);
            TR_SEG(w_in, NIN, 4888, 512, DM, nmix, W1T, DM, 1024, 0);
            TR_SEG(w_in, NIN, 0, 1536, DM, nmix, W1T, DM, 1536, 0);
            TR_SEG(w_in, NIN, 2576, 768, DM, nmix, W1T, DM, 3072, 0);
            TR_SEG(w_in, NIN, 3352, 1536, DM, nmix, W1T, DM, 3840, 0);
            TR_SEG(w_in, NIN, 2048, 16, DM, nmix, W1T, DM, 5376, 0);
            TR_SEG(w_in, NIN, 3344, 8, DM, nmix, W1T, DM, 5392, 0);
            TR_SEG((const float*)nullptr, NIN, 0, 232, DM, (const float*)nullptr, W1T, DM, 5400, 0);
            TR_SEG(w_in, NIN, 5400, 3072, DM, nmix, WGT, DM, 0, 0);
            const float* wbr = kp->in[14] + (size_t)layer * 3 * 512 * DM;
            TR_SEG(wbr, DM, 0, DM, 512, (const float*)nullptr, WMT, KMERGE, 0, 0);
            TR_SEG(wbr + 512 * DM, DM, 0, DM, 512, kp->in[13] + (size_t)layer * 512, WMT, KMERGE, 0, 512);
            TR_SEG(wbr + 2 * 512 * DM, DM, 0, DM, 512, (const float*)nullptr, WMT, KMERGE, 0, 1024);
            TR_SEG(kp->in[15] + (size_t)layer * DM * DM, DM, 0, DM, DM, (const float*)nullptr, WOT, DM, 0, 0);
            TR_SEG(kp->in[17] + (size_t)layer * DM * DFF, DFF, 0, DFF, DM, kp->in[16] + (size_t)layer * DM, WUT, DM, 0, 0);
            TR_SEG(kp->in[18] + (size_t)layer * DFF * DM, DM, 0, DM, DFF, (const float*)nullptr, WDT, DFF, 0, 0);
            TR_SEG(kp->in[20] + (size_t)layer * DM * DM, DM, 0, DM, DM, kp->in[19] + (size_t)layer * DM, WPGT, DM, 0, 0);
            TR_SEG(kp->in[21] + (size_t)layer * PLED * DM, DM, 0, DM, PLED, (const float*)nullptr, WPPT, PLED, 0, 0);
            if (layer == 0) {
                const float* xin = kp->in[0];
                for (int m = gw; m < MTOK; m += NGW) {
                    const GAS f32x4* xr = (const GAS f32x4*)(xin + (size_t)m * DM) + lane; f32x4 v[4]; float s = 0.f;
#pragma unroll
                    for (int j = 0; j < 4; ++j) { v[j] = xr[64 * j]; s += (v[j].x * v[j].x + v[j].y * v[j].y) + (v[j].z * v[j].z + v[j].w * v[j].w); }
                    s = wave_sum(s);
                    GAS v2u* o8 = (GAS v2u*)(XBl + (size_t)m * DM) + lane;
#pragma unroll
                    for (int j = 0; j < 4; ++j) { v2u w; w.x = pk2(v[j].x, v[j].y); w.y = pk2(v[j].z, v[j].w); o8[64 * j] = w; }
                    if (lane < 16) SSQC[(size_t)m * 16 + lane] = lane == 0 ? s : 0.f;
                }
            }
        }
        SEAM(P + 0);
        if (IN(P + 1)) { PHASE_PTRS();
            pg8::Gemm g{XBl, W1T, MTOK, N1, DM}; pg8::StaticOrder S; S.init(MTOK, N1, G, bx);
            stagger(bx); build_rs_table(S, SSQC, lds, tid);
            pg8::EpiP1 E{ZB, MIX, SM, lds + RS_OFF, (bf16*)((unsigned char*)XBf + HALO_OFF)};
            pg8::gemm_phase<pg8::EpiP1, pg8::StaticOrder, true, true>(lds, g, S, E);
        }
        SEAM(P + 1);
        if (IN(P + 2)) { PHASE_PTRS();
#if !MK_NAIVE
            gdn_prep(kp, layer, lds, G);
            ssd_prep(kp, layer, lds, G);
            ret_prep(kp, G);
#endif
            const float* pl = kp->in[1] + (size_t)layer * MTOK * PLED;
            for (size_t e = (size_t)bx * 512 + tid; e < (size_t)MTOK * PLED / 4; e += (size_t)G * 512) { const f32x4 v = ((const GAS f32x4*)pl)[e]; v2u w; w.x = pk2(v.x, v.y); w.y = pk2(v.z, v.w); ((GAS v2u*)PB)[e] = w; }
        }
        SEAM(P + 2);
        if (IN(P + 3)) { PHASE_PTRS();
#if !MK_NAIVE
            for (int w = bx; w < 192; w += G) { const int kind = w >> 6, b = (w & 63) >> 3, h = w & 7;
                if (kind == 0) mixer_walk<0>(kp, layer, b, h, lds);
                else if (kind == 1) mixer_walk<1>(kp, layer, b, h, lds);
                else mixer_walk<2>(kp, layer, b, h, lds);
                __syncthreads(); }
#endif
            if (bx >= 192 || G <= 192) {
                pg8::Gemm g{PB, WPPT, MTOK, DM, PLED}; pg8::StaticOrder S; if (G > 192) S.init(MTOK, DM, G - 192, bx - 192); else S.init(MTOK, DM, G, bx);
                pg8::EpiRS<0> E{PLE, DM, (LAS unsigned char*)nullptr};
                pg8::gemm_phase<pg8::EpiRS<0>, pg8::StaticOrder, true, true>(lds, g, S, E); }
        }
        SEAM(P + 3);
        if (IN(P + 4)) { PHASE_PTRS();
            for (int m = gw; m < MTOK; m += NGW) {
                GAS v4u* yp = (GAS v4u*)(ZB + (size_t)m * ZB_LD + 512) + lane; const v4u w = *yp;
                const f32x4 sq = *(const f32x4*)(SM + (size_t)m * SM_LD + 16 + 4 * (lane >> 5));
                const float rstd = rsqrtf(((sq[0] + sq[1]) + (sq[2] + sq[3])) * (1.0f / 256.0f) + 1e-6f);
                v4u o; o.x = pk2(pg8::bflo(w.x) * rstd, pg8::bfhi(w.x) * rstd); o.y = pk2(pg8::bflo(w.y) * rstd, pg8::bfhi(w.y) * rstd);
                o.z = pk2(pg8::bflo(w.z) * rstd, pg8::bfhi(w.z) * rstd); o.w = pk2(pg8::bflo(w.w) * rstd, pg8::bfhi(w.w) * rstd);
                *yp = o;
            }
            pg8::Gemm g{XBl, WGT, MTOK, NGATE, DM}; pg8::StaticOrder S; S.init(MTOK, NGATE, G, bx);
            stagger(bx); build_rs_table(S, SSQC, lds, tid);
            pg8::EpiRS<2> E{GATE, NGATE, lds + RS_OFF};
            pg8::gemm_phase<pg8::EpiRS<2>, pg8::StaticOrder, true, true>(lds, g, S, E);
        }
        SEAM(P + 4);
        if (IN(P + 5)) { PHASE_PTRS();
            pg8::Gemm g{ZB, WMT, MTOK, DM, KMERGE}; pg8::StaticOrder S; S.init(MTOK, DM, G, bx);
            pg8::EpiMerge E{GATE, XBf};
            pg8::gemm_phase<pg8::EpiMerge, pg8::StaticOrder, true, true>(lds, g, S, E);
        }
        SEAM(P + 5);
        if (IN(P + 6)) { PHASE_PTRS();
            pg8::Gemm g{XBf, WOT, MTOK, DM, DM}; pg8::StaticOrder S; S.init(MTOK, DM, G, bx);
            pg8::EpiResid<0> E{XBl, XBl, SSQA, (LAS unsigned char*)nullptr, nullptr,  1.0f};
            pg8::gemm_phase<pg8::EpiResid<0>, pg8::StaticOrder, true, true>(lds, g, S, E);
        }
        SEAM(P + 6);
        if (IN(P + 7)) { PHASE_PTRS();
            { pg8::Gemm g{XBl, WUT, MTOK, DFF, DM}; pg8::StaticOrder S; S.init(MTOK, DFF, G, bx);
              stagger(bx); build_rs_table(S, SSQA, lds, tid);
              pg8::EpiRS<1> E{U, DFF, lds + RS_OFF};
              pg8::gemm_phase<pg8::EpiRS<1>, pg8::StaticOrder, true, true>(lds, g, S, E); }
        }
        SEAM(P + 7);
        if (IN(P + 8)) { PHASE_PTRS();
            pg8::Gemm g{U, WDT, MTOK, DM, DFF}; pg8::StaticOrder S; S.init(MTOK, DM, G, bx);
            pg8::EpiResid<0> E{XBl, XBl, SSQB, (LAS unsigned char*)nullptr, nullptr,  1.0f};
            pg8::gemm_phase<pg8::EpiResid<0>, pg8::StaticOrder, true, true>(lds, g, S, E);
        }
        SEAM(P + 8);
        if (IN(P + 9)) { PHASE_PTRS();
            pg8::Gemm g{XBl, WPGT, MTOK, DM, DM}; pg8::StaticOrder S; S.init(MTOK, DM, G, bx);
            build_rs_table(S, SSQB, lds, tid);
            pg8::EpiResid<1> E{XBl, XBf, SSQC, lds + RS_OFF, PLE,  1.0f};
            pg8::gemm_phase<pg8::EpiResid<1>, pg8::StaticOrder, true, true>(lds, g, S, E);
        }
        SEAM(P + 9);
    }
    if (IN(PH_FINAL)) { const int layer = DEPTH; PHASE_PTRS();
        const float* nf = kp->in[22];
        for (int m = gw; m < MTOK; m += NGW) {
            const float sp = lane < 16 ? SSQC[(size_t)m * 16 + lane] : 0.f;
            const float rstd = rsqrtf(wave_sum(sp) * (1.0f / 1024.0f) + 1e-6f);
            const GAS v4u* xr = (const GAS v4u*)(XBl + (size_t)m * DM) + lane; GAS f32x4* orow = (GAS f32x4*)(X + (size_t)m * DM);
#pragma unroll
            for (int j = 0; j < 2; ++j) { const v4u w = xr[64 * j]; const int c8 = (64 * j + lane) * 2; const f32x4 g0 = ((const GAS f32x4*)nf)[c8], g1 = ((const GAS f32x4*)nf)[c8 + 1];
                f32x4 o0, o1; o0[0] = pg8::bflo(w.x); o0[1] = pg8::bfhi(w.x); o0[2] = pg8::bflo(w.y); o0[3] = pg8::bfhi(w.y); o1[0] = pg8::bflo(w.z); o1[1] = pg8::bfhi(w.z); o1[2] = pg8::bflo(w.w); o1[3] = pg8::bfhi(w.w);
                orow[c8] = o0 * rstd * g0; orow[c8 + 1] = o1 * rstd * g1; }
        }
    }
#undef IN
#undef SEAM
}

extern "C" void kernel_launch(void* const* d_in, const int* in_sizes, int n_in, void* d_out, int out_size, void* d_ws, size_t ws_size, hipStream_t stream) {
    static int grid = 0;
    if (grid == 0) {
        if (n_in != 23 || out_size != MTOK * DM || ws_size < WS_END) { fprintf(stderr, "kernel_launch: unexpected problem (n_in %d, out %d, ws %zu < %zu)\n", n_in, out_size, ws_size, (size_t)WS_END); grid = -1; return; }
        int dev = 0, cus = 0;
        if (hipGetDevice(&dev) != hipSuccess || hipDeviceGetAttribute(&cus, hipDeviceAttributeMultiprocessorCount, dev) != hipSuccess) { grid = -1; return; }
        if (hipFuncSetAttribute((const void*)fwd_kernel, hipFuncAttributeMaxDynamicSharedMemorySize, LDS_BYTES) != hipSuccess) { fprintf(stderr, "kernel_launch: hipFuncSetAttribute failed\n"); grid = -1; return; }
        int per_cu = 0;
        if (hipOccupancyMaxActiveBlocksPerMultiprocessor(&per_cu, (const void*)fwd_kernel, 512, LDS_BYTES) != hipSuccess || per_cu < 1) { fprintf(stderr, "kernel_launch: occupancy query says %d blocks per CU\n", per_cu); }
        (void)hipGetLastError();
        grid = cus;
    }
    if (grid < 0) return;
    (void)hipMemsetAsync((char*)d_ws + WS_CTL, 0, CTL_BYTES, stream);
    Args a; memset(&a, 0, sizeof(a));
    for (int i = 0; i < 23; ++i) a.in[i] = (const float*)d_in[i];
    a.out = (float*)d_out; a.ws = (unsigned char*)d_ws;
#if MK_ONE_LAUNCH
    a.ph_lo = 0; a.ph_hi = N_PHASES;
    hipLaunchKernelGGL(fwd_kernel, dim3(grid), dim3(512), LDS_BYTES, stream, a);
#else
    for (int p = 0; p < N_PHASES; ++p) {
#if MK_NAIVE
        if (p != PH_FINAL && (p % NPH) == 3) { hipLaunchKernelGGL(mixers_naive, dim3(192), dim3(64), 0, stream, a, p / NPH); continue; }
#endif
        a.ph_lo = p; a.ph_hi = p + 1;
        hipLaunchKernelGGL(fwd_kernel, dim3(grid), dim3(512), LDS_BYTES, stream, a);
    }
#endif
}
```

```cpp
#include <hip/hip_runtime.h>
#include <cstdio>
#include <cstdint>
#include <cstring>
namespace pg8 {
#define PG8_LAS __attribute__((address_space(3)))
typedef unsigned short bf16_t;
typedef short bf16x8 __attribute__((ext_vector_type(8)));
typedef float f32x4 __attribute__((ext_vector_type(4)));
typedef unsigned u32x4 __attribute__((ext_vector_type(4)));
constexpr int BM = 256, BK = 64, HALF = 128, HTB = HALF * BK * 2  , STAGE_BYTES = 8 * HTB, NXCD = 8, WGM = 8;

__host__ __device__ __forceinline__ int lds_byte(int r, int c) { const int st = (r >> 4) * 2 + (c >> 5), rr = r & 15, cc = c & 31, ob = rr * 64 + cc * 2; return st * 1024 + (ob ^ (((ob >> 9) & 1) << 5)); }
__host__ __device__ __forceinline__ void stage_rc(int b, int& R, int& C) { const int st = b / 1024, sb = b % 1024, swz = sb ^ (((sb >> 9) & 1) << 5); R = (st >> 1) * 16 + swz / 64; C = (st & 1) * 32 + (swz % 64) / 2; }
__host__ __device__ __forceinline__ int perm32(int rho) { const int n = rho >> 4, i = rho & 15; return 8 * (i >> 2) + 4 * n + (i & 3); }

struct Unit { int pm, pn; };
struct Gemm { const bf16_t* A; const bf16_t* Bt; int M, N, K; };

struct StaticOrder {
    int nM, nN, nwg, G, c;
    __host__ __device__ void init(int M, int N, int G_, int c_) { nM = M / BM; nN = N / BM; nwg = nM * nN; G = G_; c = c_; }
    __host__ __device__ bool next(int i, Unit& u) const {
        const long L = (long)i * G + c; if (L >= nwg) return false;
        int wgid = (int)L; { const int q = nwg / NXCD, r = nwg % NXCD, xcd = wgid % NXCD, off = wgid / NXCD; wgid = (xcd < r ? xcd * (q + 1) : r * (q + 1) + (xcd - r) * q) + off; }
        const int nig = WGM * nN, gid = wgid / nig, fm = gid * WGM, gsz = (nM - fm) < WGM ? (nM - fm) : WGM;
        u.pm = fm + ((wgid % nig) % gsz); u.pn = (wgid % nig) / gsz; return true;
    }
    __device__ __forceinline__ void a_ready(const Unit&) const {}
    __device__ __forceinline__ void done(const Unit&) const {}
};

typedef float f32x2c __attribute__((ext_vector_type(2))); typedef __bf16 bf16x2c __attribute__((ext_vector_type(2)));
__device__ __forceinline__ unsigned cvt_pk_bf16(float lo, float hi) { const f32x2c v = {lo, hi}; const bf16x2c b = __builtin_convertvector(v, bf16x2c); return __builtin_bit_cast(unsigned, b); }
typedef unsigned u32x2 __attribute__((ext_vector_type(2)));
__device__ __forceinline__ float bflo(unsigned w) { return __uint_as_float(w << 16); }
__device__ __forceinline__ float bfhi(unsigned w) { return __uint_as_float(w & 0xffff0000u); }
__device__ __forceinline__ u32x4 pack8(const f32x4 v0, const f32x4 v1) { u32x4 w; w.x = cvt_pk_bf16(v0[0], v0[1]); w.y = cvt_pk_bf16(v0[2], v0[3]); w.z = cvt_pk_bf16(v1[0], v1[1]); w.w = cvt_pk_bf16(v1[2], v1[3]); return w; }
__device__ __forceinline__ void unpack8(const u32x4 w, f32x4& v0, f32x4& v1) { v0 = (f32x4){bflo(w.x), bfhi(w.x), bflo(w.y), bfhi(w.y)}; v1 = (f32x4){bflo(w.z), bfhi(w.z), bflo(w.w), bfhi(w.w)}; }
constexpr float RMS_EPS = 1e-6f;
constexpr int RS_SLOTS = 8;
__device__ __forceinline__ void load_rstd(const PG8_LAS unsigned char* rst, int pm, int wr, int fr, float (&rs)[2][4]) {
    if (rst == nullptr) {
#pragma unroll
        for (int ai = 0; ai < 2; ++ai)
#pragma unroll
            for (int m = 0; m < 4; ++m) rs[ai][m] = 1.0f;
        return; }
    const PG8_LAS int* pml = (const PG8_LAS int*)rst; int slot = 0;
#pragma unroll
    for (int k = 1; k < RS_SLOTS; ++k) slot = pml[k] == pm ? k : slot;
    const PG8_LAS float* tab = (const PG8_LAS float*)(rst + 32) + slot * 256 + wr * 64 + fr;
#pragma unroll
    for (int ai = 0; ai < 2; ++ai)
#pragma unroll
        for (int m = 0; m < 4; ++m) rs[ai][m] = tab[ai * HALF + m * 16];
}
struct EpiP1 {
    static constexpr bool PERM = true, AFTER_DRAIN = false, HOOK = false; static constexpr int SEG1 = -1, SEG2 = -1;
    bf16_t* ZB; bf16_t* MIX; float* SM; const PG8_LAS unsigned char* rst; bf16_t* HALO;
    __device__ __forceinline__ void rescale(f32x4 (&)[2][2][4][2], const Unit&, int, int, int, int, int) const {}
    __device__ __forceinline__ void operator()(const f32x4 (&acc)[2][2][4][2], const Unit& u, int wr, int wc, int fr, int fq) const {
        const int row0 = u.pm * BM + wr * 64 + fr;
        float rs[2][4]; load_rstd(rst, u.pm, wr, fr, rs);
        if (u.pn == 21) {
            if (wc == 0) {
#pragma unroll
                for (int ai = 0; ai < 2; ++ai)
#pragma unroll
                    for (int m = 0; m < 4; ++m) { float* p = SM + (size_t)(row0 + ai * HALF + m * 16) * 32 + 8 * fq;
                        *(f32x4*)p = acc[ai][0][m][0] * rs[ai][m]; *(f32x4*)(p + 4) = acc[ai][0][m][1] * rs[ai][m]; }
            }
            return;
        }
        bf16_t* base; int ldc, colt;
        if (u.pn < 6) { base = ZB; ldc = 1536; colt = u.pn * BM; } else { base = MIX; ldc = 3840; colt = (u.pn - 6) * BM; }
        const int col0 = colt + wc * 32 + 8 * fq;
#pragma unroll
        for (int ai = 0; ai < 2; ++ai)
#pragma unroll
            for (int m = 0; m < 4; ++m) { bf16_t* rowp = base + (size_t)(row0 + ai * HALF + m * 16) * ldc + col0;
#pragma unroll
                for (int bj = 0; bj < 2; ++bj) { const u32x4 w = pack8(acc[ai][bj][m][0] * rs[ai][m], acc[ai][bj][m][1] * rs[ai][m]); *(u32x4*)(rowp + bj * HALF) = w;
                    if (m == 3 && fr >= 13 && u.pn >= 6 && u.pn < 15) *(u32x4*)(HALO + ((size_t)((row0 + ai * HALF + m * 16) >> 6) * 3 + (fr - 13)) * 2304 + col0 + bj * HALF) = w; } }
    }
};
template <int ACT> struct EpiRS {
    static constexpr bool PERM = true, AFTER_DRAIN = false, HOOK = false; static constexpr int SEG1 = -1, SEG2 = -1;
    bf16_t* O; int ldc; const PG8_LAS unsigned char* rst;
    __device__ __forceinline__ void rescale(f32x4 (&)[2][2][4][2], const Unit&, int, int, int, int, int) const {}
    __device__ __forceinline__ void operator()(const f32x4 (&acc)[2][2][4][2], const Unit& u, int wr, int wc, int fr, int fq) const {
        const int row0 = u.pm * BM + wr * 64 + fr, col0 = u.pn * BM + wc * 32 + 8 * fq;
        float rs[2][4]; load_rstd(rst, u.pm, wr, fr, rs);
#pragma unroll
        for (int ai = 0; ai < 2; ++ai)
#pragma unroll
            for (int m = 0; m < 4; ++m) { bf16_t* rowp = O + (size_t)(row0 + ai * HALF + m * 16) * ldc + col0;
#pragma unroll
                for (int bj = 0; bj < 2; ++bj) { f32x4 v0 = acc[ai][bj][m][0] * rs[ai][m], v1 = acc[ai][bj][m][1] * rs[ai][m];
                    if (ACT == 1) {
#pragma unroll
                        for (int j = 0; j < 4; ++j) { const float a = fmaxf(v0[j], 0.f), b = fmaxf(v1[j], 0.f); v0[j] = a * a; v1[j] = b * b; } }
                    if (ACT == 2) {
#pragma unroll
                        for (int j = 0; j < 4; ++j) { v0[j] = __builtin_amdgcn_rcpf(1.0f + __expf(-v0[j])); v1[j] = __builtin_amdgcn_rcpf(1.0f + __expf(-v1[j])); } }
                    *(u32x4*)(rowp + bj * HALF) = pack8(v0, v1); } }
    }
};
struct EpiMerge {
    static constexpr bool PERM = true, AFTER_DRAIN = false, HOOK = true; static constexpr int SEG1 = 8, SEG2 = 16;
    const bf16_t* GATE; bf16_t* O;
    __device__ __forceinline__ void rescale(f32x4 (&acc)[2][2][4][2], const Unit& u, int seg, int wr, int wc, int, int) const {
        int t_ = threadIdx.x; asm volatile("" : "+v"(t_)); const int fr = t_ & 15, fq = (t_ & 63) >> 4;
        const int row0 = u.pm * BM + wr * 64 + fr, col0 = u.pn * BM + wc * 32 + 8 * fq + (seg - 1) * 1024;
#pragma unroll
        for (int ai = 0; ai < 2; ++ai)
#pragma unroll
            for (int m = 0; m < 4; ++m) { const bf16_t* gp = GATE + (size_t)(row0 + ai * HALF + m * 16) * 3072 + col0;
#pragma unroll
                for (int bj = 0; bj < 2; ++bj) { const u32x4 wa = *(const u32x4*)(gp + bj * HALF), wb = *(const u32x4*)(gp + bj * HALF + 1024);
                    f32x4 a0, a1, b0, b1; unpack8(wa, a0, a1); unpack8(wb, b0, b1);
#pragma unroll
                    for (int j = 0; j < 4; ++j) {
                        acc[ai][bj][m][0][j] *= a0[j] * __builtin_amdgcn_rcpf(b0[j]);
                        acc[ai][bj][m][1][j] *= a1[j] * __builtin_amdgcn_rcpf(b1[j]); } }
                if (m == 3) asm volatile("" ::: "memory"); }
    }
    __device__ __forceinline__ void operator()(const f32x4 (&acc)[2][2][4][2], const Unit& u, int wr, int wc, int fr, int fq) const {
        const int row0 = u.pm * BM + wr * 64 + fr, col0 = u.pn * BM + wc * 32 + 8 * fq;
#pragma unroll
        for (int ai = 0; ai < 2; ++ai)
#pragma unroll
            for (int m = 0; m < 4; ++m) { const size_t r = (size_t)(row0 + ai * HALF + m * 16);
#pragma unroll
                for (int bj = 0; bj < 2; ++bj) { const u32x4 wa = *(const u32x4*)(GATE + r * 3072 + 2048 + col0 + bj * HALF);
                    f32x4 a0, a1; unpack8(wa, a0, a1); f32x4 v0 = acc[ai][bj][m][0], v1 = acc[ai][bj][m][1];
#pragma unroll
                    for (int j = 0; j < 4; ++j) { v0[j] *= a0[j]; v1[j] *= a1[j]; }
                    *(u32x4*)(O + r * 1024 + col0 + bj * HALF) = pack8(v0, v1); }
                if (m == 3) asm volatile("" ::: "memory"); }
    }
};
template <int MODE> struct EpiResid {
    static constexpr bool PERM = true, AFTER_DRAIN = false, HOOK = false; static constexpr int SEG1 = -1, SEG2 = -1;
    const bf16_t* XBin; bf16_t* XBout; float* ssq_out; const PG8_LAS unsigned char* rst; const bf16_t* PLE; float scale;
    __device__ __forceinline__ void rescale(f32x4 (&)[2][2][4][2], const Unit&, int, int, int, int, int) const {}
    __device__ __forceinline__ void operator()(const f32x4 (&acc)[2][2][4][2], const Unit& u, int wr, int wc, int fr, int fq) const {
        const int row0 = u.pm * BM + wr * 64 + fr, col0 = u.pn * BM + wc * 32 + 8 * fq;
        float rs[2][4]; if (MODE == 1) load_rstd(rst, u.pm, wr, fr, rs);
#pragma unroll
        for (int ai = 0; ai < 2; ++ai)
#pragma unroll
            for (int m = 0; m < 4; ++m) { const size_t r = (size_t)(row0 + ai * HALF + m * 16); float ss = 0.f;
#pragma unroll
                for (int bj = 0; bj < 2; ++bj) { const size_t o = r * 1024 + col0 + bj * HALF;
                    f32x4 v0 = acc[ai][bj][m][0], v1 = acc[ai][bj][m][1], b0, b1; unpack8(*(const u32x4*)(XBin + o), b0, b1);
                    if (MODE == 1) { const u32x4 wp = *(const u32x4*)(PLE + o); f32x4 p0, p1; unpack8(wp, p0, p1);
#pragma unroll
                        for (int j = 0; j < 4; ++j) { v0[j] = p0[j] * __builtin_amdgcn_rcpf(1.0f + __expf(-v0[j] * rs[ai][m])); v1[j] = p1[j] * __builtin_amdgcn_rcpf(1.0f + __expf(-v1[j] * rs[ai][m])); } }
                    v0 = v0 * scale + b0; v1 = v1 * scale + b1;
                    *(u32x4*)(XBout + o) = pack8(v0, v1);
                    ss += (v0[0] * v0[0] + v0[1] * v0[1]) + (v0[2] * v0[2] + v0[3] * v0[3]) + (v1[0] * v1[0] + v1[1] * v1[1]) + (v1[2] * v1[2] + v1[3] * v1[3]); }
                ss += __shfl_xor(ss, 16); ss += __shfl_xor(ss, 32);
                if (fq == 0) ssq_out[r * 16 + u.pn * 4 + wc] = ss;
                if (m == 3) asm volatile("" ::: "memory"); }
    }
};
template <class Epi, class Sched, bool ALIGN_EPI = false, bool SP2 = false>
__device__ __forceinline__ void gemm_phase(PG8_LAS unsigned char* lds, Gemm g, const Sched& S, const Epi& E) {
    asm volatile("" : "+s"(g.A), "+s"(g.Bt), "+s"(g.K));
    int tid_ = threadIdx.x; asm volatile("" : "+v"(tid_));
    const int tid = tid_, wid = __builtin_amdgcn_readfirstlane(tid >> 6), lane = tid & 63, wr = wid >> 2, wc = wid & 3, fr = lane & 15, fq = lane >> 4;
    const int K = g.K, nt = K / BK;
    unsigned voffA[2], voffB[2];
#pragma unroll
    for (int i = 0; i < 2; ++i) { int R, C; stage_rc(tid * 16 + i * 8192, R, C); const int Rb = Epi::PERM ? ((R & ~31) + perm32(R & 31)) : R;
        voffA[i] = (unsigned)(R * K + C) * 2u; voffB[i] = (unsigned)(Rb * K + C) * 2u; }
    const size_t kstep = (size_t)(BK * 2);
    const size_t hstep = (size_t)HALF * K * 2;
    const size_t tstep = 2 * hstep;
    const unsigned ldsw = (unsigned)wid * 1024u;
    const int aoff = lds_byte(wr * 64 + fr, fq * 8), boff = lds_byte(wc * 32 + fr, fq * 8);
#define PG8_SA(b, h) (((b) * 2 + (h)) * HTB)
#define PG8_SB(b, h) ((4 + (b) * 2 + (h)) * HTB)
#define PG8_STAGE(bufoff, gbase, voff) do { _Pragma("unroll") for (int _i = 0; _i < 2; ++_i) \
        __builtin_amdgcn_global_load_lds((const unsigned*)((const char*)(gbase) + (voff)[_i]), (PG8_LAS unsigned*)(lds + (bufoff) + ldsw + _i * 8192), 16, 0, 0); } while (0)
#define PG8_LDA(dst, b, h) do { _Pragma("unroll") for (int m = 0; m < 4; ++m) _Pragma("unroll") for (int k = 0; k < 2; ++k) dst[m][k] = *(const PG8_LAS bf16x8*)(lds + PG8_SA(b, h) + aoff + m * 2048 + k * 1024); } while (0)
#define PG8_LDB(dst, b, h) do { _Pragma("unroll") for (int n = 0; n < 2; ++n) _Pragma("unroll") for (int k = 0; k < 2; ++k) dst[n][k] = *(const PG8_LAS bf16x8*)(lds + PG8_SB(b, h) + boff + n * 2048 + k * 1024); } while (0)
#define PG8_MMA(ai, bj, At, Bt) do { __builtin_amdgcn_s_setprio(1); _Pragma("unroll") for (int m = 0; m < 4; ++m) _Pragma("unroll") for (int n = 0; n < 2; ++n) _Pragma("unroll") for (int k = 0; k < 2; ++k) \
        acc[ai][bj][m][n] = __builtin_amdgcn_mfma_f32_16x16x32_bf16(Bt[n][k], At[m][k], acc[ai][bj][m][n], 0, 0, 0); __builtin_amdgcn_s_setprio(0); } while (0)
#define PG8_WAIT_V(n) asm volatile("s_waitcnt vmcnt(" #n ")" ::: "memory")
#define PG8_WAIT_L(n) asm volatile("s_waitcnt lgkmcnt(" #n ")" ::: "memory")
#define PG8_BAR __builtin_amdgcn_s_barrier()
#define PG8_SCHED __builtin_amdgcn_sched_barrier(0)
    Unit cur, nxt; int ui = 0;
    if (!S.next(0, cur)) return;
    f32x4 acc[2][2][4][2];
#pragma unroll
    for (int a = 0; a < 2; ++a)
#pragma unroll
        for (int b = 0; b < 2; ++b)
#pragma unroll
            for (int m = 0; m < 4; ++m)
#pragma unroll
                for (int n = 0; n < 2; ++n) acc[a][b][m][n] = (f32x4){0.f, 0.f, 0.f, 0.f};
    bf16x8 At[4][2], B0[2][2], B1[2][2];
    const char* cA = (const char*)g.A + (size_t)cur.pm * tstep; const char* cB = (const char*)g.Bt + (size_t)cur.pn * tstep;
    S.a_ready(cur);
    if constexpr (SP2) {
        PG8_STAGE(PG8_SB(0, 0), cB, voffB); PG8_STAGE(PG8_SB(0, 1), cB + hstep, voffB); PG8_STAGE(PG8_SA(0, 0), cA, voffA); PG8_STAGE(PG8_SA(0, 1), cA + hstep, voffA);
        if (wr == 1) PG8_BAR;
        PG8_WAIT_V(2); PG8_BAR;
        PG8_STAGE(PG8_SB(1, 0), cB + kstep, voffB); PG8_STAGE(PG8_SA(1, 0), cA + kstep, voffA); PG8_STAGE(PG8_SB(1, 1), cB + hstep + kstep, voffB);
        PG8_WAIT_V(6); PG8_BAR;
    } else {
        PG8_STAGE(PG8_SB(0, 0), cB, voffB); PG8_STAGE(PG8_SA(0, 0), cA, voffA); PG8_STAGE(PG8_SB(0, 1), cB + hstep, voffB); PG8_STAGE(PG8_SA(0, 1), cA + hstep, voffA);
        if (wr == 1) PG8_BAR;
        PG8_WAIT_V(4); PG8_BAR;
        PG8_STAGE(PG8_SB(1, 0), cB + kstep, voffB); PG8_STAGE(PG8_SA(1, 0), cA + kstep, voffA); PG8_STAGE(PG8_SB(1, 1), cB + hstep + kstep, voffB);
        PG8_WAIT_V(6); PG8_BAR;
    }
    for (;;) {
        const bool has_next = S.next(ui + 1, nxt);
        const char* nA = has_next ? (const char*)g.A + (size_t)nxt.pm * tstep : cA; const char* nB = has_next ? (const char*)g.Bt + (size_t)nxt.pn * tstep : cB;
        for (int t = 0; t < nt; t += 2) {
            const bool last = (t == nt - 2);
            const char* a1 = cA + (size_t)(t + 1) * kstep;
            const char* a2 = last ? nA : cA + (size_t)(t + 2) * kstep; const char* b2 = last ? nB : cB + (size_t)(t + 2) * kstep;
            const char* a3 = a2 + kstep; const char* b3 = b2 + kstep;
            if (last && has_next) S.a_ready(nxt);
            if constexpr (Epi::HOOK) { if (t == Epi::SEG1 || t == Epi::SEG2) E.rescale(acc, cur, t == Epi::SEG1 ? 1 : 2, wr, wc, fr, fq); }
            if constexpr (SP2) {
            PG8_LDB(B0, 0, 0); PG8_LDB(B1, 0, 1); PG8_SCHED; PG8_LDA(At, 0, 0); PG8_STAGE(PG8_SA(1, 1), a1 + hstep, voffA);
            PG8_WAIT_V(8); PG8_WAIT_L(0); PG8_BAR; PG8_MMA(0, 0, At, B0); PG8_MMA(0, 1, At, B1); PG8_BAR; PG8_SCHED;
            PG8_LDA(At, 0, 1); PG8_STAGE(PG8_SB(0, 0), b2, voffB); PG8_STAGE(PG8_SB(0, 1), b2 + hstep, voffB); PG8_STAGE(PG8_SA(0, 0), a2, voffA);
            PG8_WAIT_V(8); PG8_WAIT_L(0); PG8_BAR; PG8_MMA(1, 0, At, B0); PG8_MMA(1, 1, At, B1); PG8_BAR; PG8_SCHED;
            PG8_LDB(B0, 1, 0); PG8_LDB(B1, 1, 1); PG8_SCHED; PG8_LDA(At, 1, 0); PG8_STAGE(PG8_SA(0, 1), a2 + hstep, voffA);
            PG8_WAIT_V(8); PG8_WAIT_L(0); PG8_BAR; PG8_MMA(0, 0, At, B0); PG8_MMA(0, 1, At, B1); PG8_BAR; PG8_SCHED;
            PG8_LDA(At, 1, 1); PG8_STAGE(PG8_SB(1, 0), b3, voffB); PG8_STAGE(PG8_SB(1, 1), b3 + hstep, voffB); PG8_STAGE(PG8_SA(1, 0), a3, voffA);
            PG8_WAIT_V(8); PG8_WAIT_L(0); PG8_BAR; PG8_MMA(1, 0, At, B0); PG8_MMA(1, 1, At, B1); PG8_BAR; PG8_SCHED;
            } else {
            PG8_LDB(B0, 0, 0); PG8_SCHED; PG8_LDA(At, 0, 0); PG8_STAGE(PG8_SA(1, 1), a1 + hstep, voffA);
            PG8_WAIT_L(8); PG8_BAR; PG8_WAIT_L(0); PG8_MMA(0, 0, At, B0); PG8_BAR; PG8_SCHED;
            PG8_LDB(B1, 0, 1); PG8_STAGE(PG8_SB(0, 0), b2, voffB);
            PG8_BAR; PG8_WAIT_L(0); PG8_MMA(0, 1, At, B1); PG8_BAR;
            PG8_LDA(At, 0, 1); PG8_STAGE(PG8_SA(0, 0), a2, voffA);
            PG8_BAR; PG8_WAIT_L(0); PG8_MMA(1, 0, At, B0); PG8_BAR; PG8_SCHED;
            PG8_STAGE(PG8_SB(0, 1), b2 + hstep, voffB);
            PG8_WAIT_V(6); PG8_BAR; PG8_MMA(1, 1, At, B1); PG8_BAR;
            PG8_LDB(B0, 1, 0); PG8_SCHED; PG8_LDA(At, 1, 0); PG8_STAGE(PG8_SA(0, 1), a2 + hstep, voffA);
            PG8_WAIT_L(8); PG8_BAR; PG8_WAIT_L(0); PG8_MMA(0, 0, At, B0); PG8_BAR; PG8_SCHED;
            PG8_LDB(B1, 1, 1); PG8_STAGE(PG8_SB(1, 0), b3, voffB);
            PG8_BAR; PG8_WAIT_L(0); PG8_MMA(0, 1, At, B1); PG8_BAR;
            PG8_LDA(At, 1, 1); PG8_STAGE(PG8_SA(1, 0), a3, voffA);
            PG8_BAR; PG8_WAIT_L(0); PG8_MMA(1, 0, At, B0); PG8_BAR; PG8_SCHED;
            PG8_STAGE(PG8_SB(1, 1), b3 + hstep, voffB);
            PG8_WAIT_V(6); PG8_BAR; PG8_MMA(1, 1, At, B1); PG8_BAR;
            }
        }
        if constexpr (ALIGN_EPI) { if (wr == 0) PG8_BAR; }
        if constexpr (!Epi::AFTER_DRAIN) { int t2_ = threadIdx.x; asm volatile("" : "+v"(t2_)); E(acc, cur, wr, wc, t2_ & 15, (t2_ & 63) >> 4); S.done(cur); }
        if (!has_next) break;
#pragma unroll
        for (int a = 0; a < 2; ++a)
#pragma unroll
            for (int b = 0; b < 2; ++b)
#pragma unroll
                for (int m = 0; m < 4; ++m)
#pragma unroll
                    for (int n = 0; n < 2; ++n) acc[a][b][m][n] = (f32x4){0.f, 0.f, 0.f, 0.f};
        cur = nxt; cA = nA; cB = nB; ++ui;
        if constexpr (ALIGN_EPI) { if (wr == 1) PG8_BAR; }
    }
    PG8_WAIT_V(0);
    if constexpr (!ALIGN_EPI) { if (wr == 0) PG8_BAR; }
    PG8_BAR;
    if constexpr (Epi::AFTER_DRAIN) { E.fused(acc, cur, wr, wc, fr, fq, lds, wid, lane); S.done(cur); }
#undef PG8_SA
#undef PG8_SB
#undef PG8_STAGE
#undef PG8_LDA
#undef PG8_LDB
#undef PG8_MMA
#undef PG8_WAIT_V
#undef PG8_WAIT_L
#undef PG8_BAR
#undef PG8_SCHED
}
}
constexpr int DM = 1024, NBATCH = 8, SEQ = 4096, MTOK = NBATCH * SEQ, DEPTH = 2, DFF = 4096, PLED = 256, NIN = 8472;
constexpr int ZB_LD = 1536, MIX_LD = 3840, SM_LD = 32, N1 = 5632, NGATE = 3072, KMERGE = 1536;
constexpr int MX_AQ = 0, MX_AK = 512, MX_AV = 1024, MX_BX = 1536, MX_BB = 2048, MX_BC = 2176, MX_CQ = 2304, MX_CK = 2816, MX_CV = 3328;
constexpr size_t KiB = 1024, MiB = 1024 * 1024;
constexpr size_t WS_CTL = 0, CTL_BYTES = 64 * KiB;
constexpr size_t WS_W = 64 * KiB;
constexpr size_t W_1T = WS_W, W_GT = W_1T + (size_t)N1 * DM * 2, W_MT = W_GT + (size_t)NGATE * DM * 2, W_OT = W_MT + (size_t)DM * KMERGE * 2, W_UT = W_OT + (size_t)DM * DM * 2,
                 W_DT = W_UT + (size_t)DFF * DM * 2, W_PGT = W_DT + (size_t)DM * DFF * 2, W_PPT = W_PGT + (size_t)DM * DM * 2, W_END = W_PPT + (size_t)DM * PLED * 2;
constexpr size_t WS_SSQA = W_1T + 1 * MiB, WS_SSQB = W_1T + 3 * MiB;
constexpr size_t WS_XB0 = W_END, WS_XB1 = WS_XB0 + 64 * MiB, WS_ZB = WS_XB1 + 64 * MiB, WS_MIX = WS_ZB + 96 * MiB, WS_SM = WS_MIX + 240 * MiB, WS_SSQC = WS_SM + 4 * MiB, WS_ROPE = WS_SSQC + 2 * MiB, WS_END = WS_ROPE + 1 * MiB;
constexpr size_t WS_PB = WS_ZB, WS_PLE = WS_ZB + 16 * MiB, WS_U = WS_ZB + 80 * MiB, WS_GATE = WS_MIX;
static_assert(W_END == WS_W + (size_t)(40 * MiB + 512 * KiB), "weights");
static_assert(WS_U + (size_t)MTOK * DFF * 2 == WS_SM, "U overlay");
static_assert(WS_END <= 512 * MiB, "workspace");
constexpr int LDS_BYTES = 147456, RING_BYTES = 131072, MISC_OFF = RING_BYTES + 320, RS_OFF = RING_BYTES + 1024;
static_assert(RS_OFF + 32 + pg8::RS_SLOTS * 1024 <= LDS_BYTES, "LDS map");

#define GAS __attribute__((address_space(1)))
#define LAS __attribute__((address_space(3)))
typedef unsigned short bf16;
typedef unsigned v4u __attribute__((ext_vector_type(4)));
typedef unsigned v2u __attribute__((ext_vector_type(2)));
typedef float f32x4 __attribute__((ext_vector_type(4)));
#define LDS_WAIT() asm volatile("s_waitcnt lgkmcnt(0)" ::: "memory")
typedef float f32x2_t __attribute__((ext_vector_type(2))); typedef __bf16 bf16x2_t __attribute__((ext_vector_type(2)));
__device__ __forceinline__ unsigned pk2(float lo, float hi) { f32x2_t v = {lo, hi}; bf16x2_t b = __builtin_convertvector(v, bf16x2_t); return __builtin_bit_cast(unsigned, b); }
__device__ __forceinline__ unsigned f2bf(float f) { return pk2(f, 0.f) & 0xffffu; }
__device__ __forceinline__ float bf2f(bf16 v) { return __uint_as_float((unsigned)v << 16); }
__device__ __forceinline__ float wave_sum(float v) {
#pragma unroll
    for (int o = 1; o < 64; o <<= 1) v += __shfl_xor(v, o);
    return v;
}
__device__ __forceinline__ float siluf(float x) { return x * __builtin_amdgcn_rcpf(1.0f + __expf(-x)); }
__device__ __forceinline__ float sigmf(float x) { return __builtin_amdgcn_rcpf(1.0f + __expf(-x)); }
__device__ __forceinline__ float softplusf(float x) { return fmaxf(x, 0.f) + log1pf(__expf(-fabsf(x))); }
__device__ __forceinline__ float rdl(float v, int l) { return __int_as_float(__builtin_amdgcn_readlane(__float_as_int(v), l)); }

#define XB_TMO      128
#define XB_XCNT(j)  (256  + 64 * (j))
#define XB_XSUB(j)  (1280 + 64 * (j))
#define XB_XGEN(j)  (2304 + 64 * (j))
#define XB_TOP      3328
#define XB_TOPGEN   3392
#define XCD_BAR_WORDS 3456
#define XB_SPIN_CAP (1u << 18)
__device__ __forceinline__ unsigned xb_ld(unsigned* p)              { return __hip_atomic_load(p, __ATOMIC_RELAXED, __HIP_MEMORY_SCOPE_AGENT); }
__device__ __forceinline__ unsigned xb_add(unsigned* p, unsigned v) { return __hip_atomic_fetch_add(p, v, __ATOMIC_RELAXED, __HIP_MEMORY_SCOPE_AGENT); }
__device__ __forceinline__ unsigned xb_xcc_id() { return (unsigned)__builtin_amdgcn_s_getreg((3 << 11) | 20) & 0xFu; }
#define XB_SPIN(cond, bar) do { unsigned _sp = 0; while (cond) { __builtin_amdgcn_s_sleep(1); \
    if ((++_sp & 255u) == 0u) { if (xb_ld(&(bar)[XB_TMO])) break; if (_sp > XB_SPIN_CAP) { atomicAdd(&(bar)[XB_TMO], 1u); break; } } } } while (0)
struct XcdBarrier { unsigned* bar; unsigned x; volatile LAS unsigned* st; };
__device__ __forceinline__ XcdBarrier xcd_barrier_post(unsigned* bar, volatile LAS unsigned* st) {
    XcdBarrier b; b.bar = bar; b.x = xb_xcc_id(); b.st = st;
    if (threadIdx.x == 0) (void)xb_add(&bar[XB_XCNT(b.x)], 1u);
    return b;
}
__device__ __forceinline__ void xcd_barrier_complete(unsigned* bar, unsigned x, unsigned& nloc, unsigned& nx) {
    const unsigned G = gridDim.x * gridDim.y * gridDim.z;
    unsigned sum, cnt, mine, sp = 0u;
    for (;;) {
        sum = 0u; cnt = 0u; mine = 0u;
#pragma unroll
        for (unsigned j = 0; j < 16; ++j) { const unsigned c = xb_ld(&bar[XB_XCNT(j)]); sum += c; cnt += (c > 0u) ? 1u : 0u; mine = (j == x) ? c : mine; }
        if (sum == G) break;
        __builtin_amdgcn_s_sleep(1);
        if ((++sp & 255u) == 0u) { if (xb_ld(&bar[XB_TMO])) break; if (sp > XB_SPIN_CAP) { atomicAdd(&bar[XB_TMO], 1u); break; } }
    }
    nloc = mine > 0u ? mine : 1u; nx = cnt > 0u ? cnt : 1u;
}
__device__ __forceinline__ void xcd_barrier(const XcdBarrier& b) {
    asm volatile("s_waitcnt vmcnt(0)" ::: "memory");
    __syncthreads();
    if (threadIdx.x == 0) {
        unsigned* bar = b.bar;
        __builtin_amdgcn_s_waitcnt(0);
        unsigned nloc = b.st[0], nx = b.st[1];
        if (nloc == 0u) { xcd_barrier_complete(bar, b.x, nloc, nx); b.st[0] = nloc; b.st[1] = nx; }
        const unsigned old = xb_add(&bar[XB_XSUB(b.x)], 1u);
        const unsigned gen = old / nloc;
        if (old + 1u == (gen + 1u) * nloc) {
            __builtin_amdgcn_fence(__ATOMIC_RELEASE, "agent");
            asm volatile("s_waitcnt vmcnt(0)" ::: "memory");
            const unsigned og = xb_add(&bar[XB_TOP], 1u);
            const unsigned tg = og / nx;
            if (og + 1u == (tg + 1u) * nx) xb_add(&bar[XB_TOPGEN], 1u);
            else XB_SPIN(xb_ld(&bar[XB_TOPGEN]) == tg, bar);
            __builtin_amdgcn_fence(__ATOMIC_ACQUIRE, "agent");
            xb_add(&bar[XB_XGEN(b.x)], 1u);
            asm volatile("s_waitcnt vmcnt(0)" ::: "memory");
        } else {
            XB_SPIN(xb_ld(&bar[XB_XGEN(b.x)]) == gen, bar);
            __builtin_amdgcn_fence(__ATOMIC_ACQUIRE, "agent");
            asm volatile("s_waitcnt vmcnt(0)" ::: "memory");
        }
    }
    __syncthreads();
}

__device__ __forceinline__ void tr_item(const float* W, int ldw, int c0, int ncols, const float* scale, bf16* dst, int ldd, int r0, int kofs, LAS unsigned char* lds, int item, int tid) {
    const int lane = tid & 63, wave = __builtin_amdgcn_readfirstlane(tid >> 6);
    const int nblk = (ncols + 255) / 256, kb = item / nblk, nb = item - kb * nblk, k0 = 64 * kb, n0 = 256 * nb;
    asm volatile("s_waitcnt lgkmcnt(0)\n\ts_barrier" ::: "memory");
    float v[8][4];
    const int n = n0 + 4 * lane;
    const bool vec = W != nullptr && ((c0 | ldw) & 3) == 0 && n + 3 < ncols;
    const float* wp = W + (size_t)(k0 + 8 * wave) * ldw + c0 + n;
#pragma unroll
    for (int kk = 0; kk < 8; ++kk) {
        if (vec) { const f32x4 t = *(const GAS f32x4*)(wp + (size_t)kk * ldw); v[kk][0] = t[0]; v[kk][1] = t[1]; v[kk][2] = t[2]; v[kk][3] = t[3]; }
        else {
#pragma unroll
            for (int q = 0; q < 4; ++q) v[kk][q] = (W != nullptr && n + q < ncols) ? wp[(size_t)kk * ldw + q] : 0.f; }
        if (scale) { const float s = scale[k0 + 8 * wave + kk];
#pragma unroll
            for (int q = 0; q < 4; ++q) v[kk][q] *= s; } }
#pragma unroll
    for (int q = 0; q < 4; ++q) { v4u o; o.x = pk2(v[0][q], v[1][q]); o.y = pk2(v[2][q], v[3][q]); o.z = pk2(v[4][q], v[5][q]); o.w = pk2(v[6][q], v[7][q]);
        *(LAS v4u*)(lds + (4 * lane + q) * 128 + ((wave ^ (lane & 7)) << 4)) = o; }
    asm volatile("s_waitcnt lgkmcnt(0)\n\ts_barrier" ::: "memory");
#pragma unroll
    for (int i = 0; i < 4; ++i) { const int nl = (tid >> 3) + 64 * i, ch = tid & 7;
        if (n0 + nl < ncols) *(GAS v4u*)(dst + (size_t)(r0 + n0 + nl) * ldd + kofs + k0 + ch * 8) = *(const LAS v4u*)(lds + nl * 128 + ((ch ^ ((nl >> 2) & 7)) << 4)); }
}
#define TR_SEG(W_, ldw_, c0_, ncols_, K_, scale_, dst_, ldd_, r0_, kofs_) do { const int _n = ((K_) / 64) * (((ncols_) + 255) / 256); \
    for (int _it = (bx + G - (ibase % G)) % G; _it < _n; _it += G) tr_item(W_, ldw_, c0_, ncols_, scale_, dst_, ldd_, r0_, kofs_, lds, _it, tid); ibase += _n; } while (0)

__device__ __forceinline__ void build_rs_table(const pg8::StaticOrder& S, const float* ssqp, LAS unsigned char* lds, int tid) {
    LAS int* pml = (LAS int*)(lds + RS_OFF); LAS float* tab = (LAS float*)(lds + RS_OFF + 32);
    __syncthreads();
    if (tid == 0) { int npm = 0;
        for (int k = 0; k < pg8::RS_SLOTS; ++k) pml[k] = -1;
        for (int i = 0; ; ++i) { pg8::Unit u; if (!S.next(i, u)) break; bool found = false;
            for (int k = 0; k < npm; ++k) found = found || (pml[k] == u.pm);
            if (!found && npm < pg8::RS_SLOTS) pml[npm++] = u.pm; } }
    __syncthreads();
#pragma unroll 1
    for (int s = tid >> 8; s < pg8::RS_SLOTS; s += 2) { const int pm = pml[s]; if (pm < 0) continue;
        const float* p = ssqp + ((size_t)pm * 256 + (tid & 255)) * 16;
        const f32x4 a = *(const f32x4*)p, b = *(const f32x4*)(p + 4), c = *(const f32x4*)(p + 8), d = *(const f32x4*)(p + 12);
        const float ss = ((a[0] + a[1]) + (a[2] + a[3])) + ((b[0] + b[1]) + (b[2] + b[3])) + ((c[0] + c[1]) + (c[2] + c[3])) + ((d[0] + d[1]) + (d[2] + d[3]));
        tab[s * 256 + (tid & 255)] = rsqrtf(ss * (1.0f / 1024.0f) + 1e-6f); }
    __syncthreads();
}
#ifndef STAGGER_US
#define STAGGER_US 0
#endif
__device__ __forceinline__ void stagger(int bx) {
    if (STAGGER_US > 0) { const unsigned long long t0 = __builtin_amdgcn_s_memrealtime(), d = (unsigned long long)((bx >> 3) & 3) * (unsigned long long)(STAGGER_US * 100 / 4);
        while (__builtin_amdgcn_s_memrealtime() - t0 < d) __builtin_amdgcn_s_sleep(16); }
}
struct Args { const float* in[23]; float* out; unsigned char* ws; int ph_lo, ph_hi; };
constexpr int NPH = 10, PH_FINAL = DEPTH * NPH, N_PHASES = PH_FINAL + 1;

constexpr int WG = 8;
__device__ __forceinline__ void gdn_naive(const Args& A, int layer, int b, int h, int lane, const bf16* MIX, const float* SM, bf16* ZB) {
    const float* cw = A.in[4] + (size_t)layer * 4 * 1536;
    float wq[4], wk[4], wv[4];
#pragma unroll
    for (int k = 0; k < 4; ++k) { wq[k] = cw[k * 1536 + h * 64 + lane]; wk[k] = cw[k * 1536 + 512 + h * 64 + lane]; wv[k] = cw[k * 1536 + 1024 + h * 64 + lane]; }
    const float Aexp = expf(A.in[5][layer * 8 + h]), dtb = A.in[6][layer * 8 + h], nw = A.in[7][layer * 64 + lane];
    float M[64];
#pragma unroll
    for (int d = 0; d < 64; ++d) M[d] = 0.f;
    float hq0 = 0.f, hq1 = 0.f, hq2 = 0.f, hk0 = 0.f, hk1 = 0.f, hk2 = 0.f, hv0 = 0.f, hv1 = 0.f, hv2 = 0.f;
    const size_t tok0 = (size_t)b * SEQ;
    bf16 nq[WG], nk[WG], nv[WG], nz[WG]; float nb[WG], na[WG];
#define GDN_LOAD(t0) do { _Pragma("unroll") for (int i = 0; i < WG; ++i) { const size_t r = tok0 + (t0) + i; const bf16* mp = MIX + r * MIX_LD + h * 64 + lane; \
        nq[i] = mp[MX_AQ]; nk[i] = mp[MX_AK]; nv[i] = mp[MX_AV]; nz[i] = ZB[r * ZB_LD + h * 64 + lane]; nb[i] = SM[r * SM_LD + h]; na[i] = SM[r * SM_LD + 8 + h]; } } while (0)
    GDN_LOAD(0);
    for (int t0 = 0; t0 < SEQ; t0 += WG) {
        bf16 cq[WG], ck[WG], cv[WG], cz[WG]; float cb[WG], ca[WG];
#pragma unroll
        for (int i = 0; i < WG; ++i) { cq[i] = nq[i]; ck[i] = nk[i]; cv[i] = nv[i]; cz[i] = nz[i]; cb[i] = nb[i]; ca[i] = na[i]; }
        if (t0 + WG < SEQ) GDN_LOAD(t0 + WG);
#pragma unroll
        for (int i = 0; i < WG; ++i) {
            const float xq = bf2f(cq[i]), xk = bf2f(ck[i]), xv = bf2f(cv[i]);
            float q = siluf(wq[0] * hq0 + wq[1] * hq1 + wq[2] * hq2 + wq[3] * xq); hq0 = hq1; hq1 = hq2; hq2 = xq;
            float k = siluf(wk[0] * hk0 + wk[1] * hk1 + wk[2] * hk2 + wk[3] * xk); hk0 = hk1; hk1 = hk2; hk2 = xk;
            const float v = siluf(wv[0] * hv0 + wv[1] * hv1 + wv[2] * hv2 + wv[3] * xv); hv0 = hv1; hv1 = hv2; hv2 = xv;
            q *= rsqrtf(wave_sum(q * q) + 1e-6f) * 0.125f; k *= rsqrtf(wave_sum(k * k) + 1e-6f);
            const float beta = sigmf(cb[i]), a = __expf(-Aexp * softplusf(ca[i] + dtb));
            float r = 0.f;
#pragma unroll
            for (int d = 0; d < 64; ++d) { M[d] *= a; r += rdl(k, d) * M[d]; }
            const float u = beta * (v - r); float o = 0.f;
#pragma unroll
            for (int d = 0; d < 64; ++d) { M[d] += rdl(k, d) * u; o += rdl(q, d) * M[d]; }
            const float y = o * rsqrtf(wave_sum(o * o) * (1.0f / 64.0f) + 1e-6f) * nw * siluf(bf2f(cz[i]));
            ZB[(tok0 + t0 + i) * ZB_LD + h * 64 + lane] = (bf16)f2bf(y);
        }
    }
#undef GDN_LOAD
}
__device__ __forceinline__ void ssd_naive(const Args& A, int layer, int b, int h, int lane, const bf16* MIX, float* SM, bf16* ZB) {
    const int g = h >> 2;
    const float* cw = A.in[8] + (size_t)layer * 4 * 768; const float* cb_ = A.in[9] + (size_t)layer * 768;
    float wx[4], wB[4], wC[4];
#pragma unroll
    for (int k = 0; k < 4; ++k) { wx[k] = cw[k * 768 + h * 64 + lane]; wB[k] = cw[k * 768 + 512 + g * 64 + lane]; wC[k] = cw[k * 768 + 640 + g * 64 + lane]; }
    const float bx = cb_[h * 64 + lane], bB = cb_[512 + g * 64 + lane], bC = cb_[640 + g * 64 + lane];
    const float Aexp = expf(A.in[10][layer * 8 + h]), dtb = A.in[11][layer * 8 + h], Dh = A.in[12][layer * 8 + h];
    float Hs[64];
#pragma unroll
    for (int d = 0; d < 64; ++d) Hs[d] = 0.f;
    float hx0 = 0.f, hx1 = 0.f, hx2 = 0.f, hB0 = 0.f, hB1 = 0.f, hB2 = 0.f, hC0 = 0.f, hC1 = 0.f, hC2 = 0.f;
    const size_t tok0 = (size_t)b * SEQ;
    bf16 nx[WG], nB[WG], nC[WG], nz[WG]; float nd[WG];
#define SSD_LOAD(t0) do { _Pragma("unroll") for (int i = 0; i < WG; ++i) { const size_t r = tok0 + (t0) + i; const bf16* mp = MIX + r * MIX_LD; \
        nx[i] = mp[MX_BX + h * 64 + lane]; nB[i] = mp[MX_BB + g * 64 + lane]; nC[i] = mp[MX_BC + g * 64 + lane]; nz[i] = ZB[r * ZB_LD + 512 + h * 64 + lane]; nd[i] = SM[r * SM_LD + 16 + h]; } } while (0)
    SSD_LOAD(0);
    for (int t0 = 0; t0 < SEQ; t0 += WG) {
        bf16 cx[WG], cB[WG], cC[WG], cz[WG]; float cd[WG];
#pragma unroll
        for (int i = 0; i < WG; ++i) { cx[i] = nx[i]; cB[i] = nB[i]; cC[i] = nC[i]; cz[i] = nz[i]; cd[i] = nd[i]; }
        if (t0 + WG < SEQ) SSD_LOAD(t0 + WG);
#pragma unroll
        for (int i = 0; i < WG; ++i) {
            const float rx = bf2f(cx[i]), rB = bf2f(cB[i]), rC = bf2f(cC[i]);
            const float x = siluf(wx[0] * hx0 + wx[1] * hx1 + wx[2] * hx2 + wx[3] * rx + bx); hx0 = hx1; hx1 = hx2; hx2 = rx;
            const float Bv = siluf(wB[0] * hB0 + wB[1] * hB1 + wB[2] * hB2 + wB[3] * rB + bB); hB0 = hB1; hB1 = hB2; hB2 = rB;
            const float Cv = siluf(wC[0] * hC0 + wC[1] * hC1 + wC[2] * hC2 + wC[3] * rC + bC); hC0 = hC1; hC1 = hC2; hC2 = rC;
            const float dt = softplusf(cd[i] + dtb), a = __expf(-Aexp * dt), xdt = x * dt;
            float y = 0.f;
#pragma unroll
            for (int n = 0; n < 64; ++n) { Hs[n] = a * Hs[n] + xdt * rdl(Bv, n); y += Hs[n] * rdl(Cv, n); }
            y = (y + Dh * x) * siluf(bf2f(cz[i]));
            const float ss = wave_sum(y * y);
            const size_t r = tok0 + t0 + i;
            ZB[r * ZB_LD + 512 + h * 64 + lane] = (bf16)f2bf(y);
            if (lane == 0) SM[r * SM_LD + 24 + h] = ss;
        }
    }
#undef SSD_LOAD
}
__device__ __forceinline__ void ret_naive(int b, int h, int lane, const bf16* MIX, const float* ROPE, bf16* ZB) {
    const float gamma = 1.0f - exp2f(-5.0f - (float)h);
    float M[64];
#pragma unroll
    for (int d = 0; d < 64; ++d) M[d] = 0.f;
    const size_t tok0 = (size_t)b * SEQ;
    bf16 nq[WG], nk[WG], nv[WG], nz[WG]; float nc[WG], ns[WG];
#define RET_LOAD(t0) do { _Pragma("unroll") for (int i = 0; i < WG; ++i) { const size_t r = tok0 + (t0) + i; const bf16* mp = MIX + r * MIX_LD + h * 64 + lane; \
        nq[i] = mp[MX_CQ]; nk[i] = mp[MX_CK]; nv[i] = mp[MX_CV]; nz[i] = ZB[r * ZB_LD + 1024 + h * 64 + lane]; nc[i] = ROPE[((t0) + i) * 32 + (lane & 31)]; ns[i] = ROPE[SEQ * 32 + ((t0) + i) * 32 + (lane & 31)]; } } while (0)
    RET_LOAD(0);
    for (int t0 = 0; t0 < SEQ; t0 += WG) {
        bf16 cq[WG], ck[WG], cv[WG], cz[WG]; float cc[WG], cs[WG];
#pragma unroll
        for (int i = 0; i < WG; ++i) { cq[i] = nq[i]; ck[i] = nk[i]; cv[i] = nv[i]; cz[i] = nz[i]; cc[i] = nc[i]; cs[i] = ns[i]; }
        if (t0 + WG < SEQ) RET_LOAD(t0 + WG);
#pragma unroll
        for (int i = 0; i < WG; ++i) {
            const float q0 = bf2f(cq[i]), k0 = bf2f(ck[i]), v = bf2f(cv[i]);
            const float qp = __shfl_xor(q0, 32), kp = __shfl_xor(k0, 32);
            const float sg = lane < 32 ? -cs[i] : cs[i];
            const float q = q0 * cc[i] + qp * sg, k = (k0 * cc[i] + kp * sg) * 0.125f;
            float o = 0.f;
#pragma unroll
            for (int d = 0; d < 64; ++d) { M[d] = gamma * M[d] + rdl(k, d) * v; o += rdl(q, d) * M[d]; }
            const float y = o * rsqrtf(wave_sum(o * o) * (1.0f / 64.0f) + 1e-6f) * siluf(bf2f(cz[i]));
            ZB[(tok0 + t0 + i) * ZB_LD + 1024 + h * 64 + lane] = (bf16)f2bf(y);
        }
    }
#undef RET_LOAD
}

typedef short bf16x8 __attribute__((ext_vector_type(8)));
constexpr int PT = 72, MAT = 64 * PT * 2;
constexpr int SETB = 4 * MAT + 512;
constexpr int L_Q = 0, L_K = MAT, L_V = 2 * MAT, L_U = 2 * MAT, L_W = 3 * MAT, L_G = 4 * MAT, L_DT = 4 * MAT + 256;
constexpr int L_VT = 2 * SETB, L_ST0 = L_VT + MAT, L_ST1 = L_ST0 + MAT, L_PP = L_ST1 + MAT, L_YT = L_PP + MAT, L_WEND = L_YT + 2 * MAT;
static_assert(L_WEND <= RING_BYTES, "walker LDS");
constexpr size_t GW_OFF = 0, HALO_OFF = 32 * MiB;
constexpr int HALO_LD = 2304;
#define MFMA16(a, b, c) __builtin_amdgcn_mfma_f32_16x16x32_bf16(a, b, c, 0, 0, 0)
__device__ __forceinline__ bf16x8 ldfrag(LAS unsigned char* base, int row, int kelem) { return *(const LAS bf16x8*)(base + row * (PT * 2) + kelem * 2); }
__device__ __forceinline__ void unpk8(const v4u w, float (&f)[8]) { f[0] = pg8::bflo(w.x); f[1] = pg8::bfhi(w.x); f[2] = pg8::bflo(w.y); f[3] = pg8::bfhi(w.y); f[4] = pg8::bflo(w.z); f[5] = pg8::bfhi(w.z); f[6] = pg8::bflo(w.w); f[7] = pg8::bfhi(w.w); }
__device__ __forceinline__ v4u pk8(const float (&f)[8]) { v4u w; w.x = pk2(f[0], f[1]); w.y = pk2(f[2], f[3]); w.z = pk2(f[4], f[5]); w.w = pk2(f[6], f[7]); return w; }
__device__ __forceinline__ void st_tr8(LAS unsigned char* base, int row0, int col, const float (&f)[8]) {
#pragma unroll
    for (int j = 0; j < 8; ++j) *(LAS bf16*)(base + (row0 + j) * (PT * 2) + col * 2) = (bf16)f2bf(f[j]);
}

#define LBAR() asm volatile("s_waitcnt lgkmcnt(0)\n\ts_barrier" ::: "memory")
typedef short s16x4 __attribute__((ext_vector_type(4)));
__device__ __forceinline__ s16x4 tr4(LAS unsigned char* p) { return __builtin_bit_cast(s16x4, __builtin_amdgcn_ds_read_tr16_b64_v4i16((LAS s16x4*)p)); }
__device__ __forceinline__ bf16x8 trfrag(LAS unsigned char* tile, int krow0, int col0, int fr) {
    LAS unsigned char* a = tile + (krow0 + (fr >> 2)) * (PT * 2) + (col0 + 4 * (fr & 3)) * 2;
    const s16x4 lo = tr4(a), hi = tr4(a + 4 * PT * 2);
    return (bf16x8){lo[0], lo[1], lo[2], lo[3], hi[0], hi[1], hi[2], hi[3]};
}
__device__ __forceinline__ float bfs(short v) { return __uint_as_float((unsigned)(unsigned short)v << 16); }

template <int KIND>
__device__ __forceinline__ void mixer_walk(const __attribute__((address_space(4))) Args* kp, int layer, int b, int h, LAS unsigned char* lds) {
    int tid = threadIdx.x; asm volatile("" : "+v"(tid));
    const int lane = tid & 63, wave = __builtin_amdgcn_readfirstlane(tid >> 6), fr = lane & 15, fq = lane >> 4;
    const int prow = tid >> 3, pcg = tid & 7;
    unsigned char* ws = kp->ws;
    const bf16* MIX = (const bf16*)(ws + WS_MIX); bf16* ZB = (bf16*)(ws + WS_ZB); float* SM = (float*)(ws + WS_SM);
    const bf16* GW = (const bf16*)(ws + ((layer & 1) ? WS_XB0 : WS_XB1) + GW_OFF);
    const size_t tok0 = (size_t)b * SEQ;
    const int g = h >> 2;
    const int qcol = (KIND == 0 ? MX_AQ + h * 64 : (KIND == 1 ? MX_BC + g * 64 : MX_CQ + h * 64)) + pcg * 8;
    const int kcol = (KIND == 0 ? MX_AK + h * 64 : (KIND == 1 ? MX_BB + g * 64 : MX_CK + h * 64)) + pcg * 8;
    const int vcol = (KIND == 0 ? MX_AV + h * 64 : (KIND == 1 ? MX_BX + h * 64 : MX_CV + h * 64)) + pcg * 8;
    const int zcol = KIND * 512 + h * 64 + pcg * 8;
    const int gcol = (KIND == 0 ? 8 : 16) + h;
    float nw[8];
    if (KIND == 0) {
#pragma unroll
        for (int j = 0; j < 8; ++j) nw[j] = kp->in[7][layer * 64 + pcg * 8 + j];
    }
    const float p_D = KIND == 1 ? kp->in[12][layer * 8 + h] : 0.f;
    const float p_lg = KIND == 2 ? log1pf(-exp2f(-5.0f - (float)h)) : 0.f;
    for (int i = tid; i < MAT / 4; i += 512) ((LAS unsigned*)(lds + L_ST0))[i] = 0u;
    pg8::f32x4 sacc[4];
#pragma unroll
    for (int i = 0; i < 4; ++i) sacc[i] = (pg8::f32x4){0.f, 0.f, 0.f, 0.f};
    LAS unsigned char* PPw = lds + L_PP + (wave & 3) * (16 * PT * 2);

    v4u tq, tk, tv, tw, tz; float sg = 0.f, sd = 1.f; (void)tw;
#define WALK_LOAD(c) do { const size_t row = tok0 + (size_t)(c) * 64 + prow; const bf16* mp = MIX + row * MIX_LD; \
        tq = *(const GAS v4u*)(mp + qcol); tk = *(const GAS v4u*)(mp + kcol); tv = *(const GAS v4u*)(mp + vcol); \
        if (KIND == 0) tw = *(const GAS v4u*)(GW + row * 512 + h * 64 + pcg * 8); \
        tz = *(const GAS v4u*)(ZB + row * ZB_LD + zcol); \
        if (tid < 64) { const size_t r2 = tok0 + (size_t)(c) * 64 + tid; \
            if (KIND == 2) sg = (float)(tid + 1) * p_lg; else sg = SM[r2 * SM_LD + gcol]; \
            if (KIND == 1) sd = SM[r2 * SM_LD + 24 + h]; } } while (0)
#define WALK_PREP(sb_) do { LAS unsigned char* sp_ = lds + (sb_) * SETB; \
        *(LAS v4u*)(sp_ + L_Q + prow * (PT * 2) + pcg * 16) = tq; *(LAS v4u*)(sp_ + L_K + prow * (PT * 2) + pcg * 16) = tk; \
        *(LAS v4u*)(sp_ + L_V + prow * (PT * 2) + pcg * 16) = tv; \
        if (KIND == 0) *(LAS v4u*)(sp_ + L_W + prow * (PT * 2) + pcg * 16) = tw; \
        if (tid < 64) { ((LAS float*)(sp_ + L_G))[tid] = sg; ((LAS float*)(sp_ + L_DT))[tid] = sd; } } while (0)

    WALK_LOAD(0);
    WALK_PREP(0);
    v4u zc = tz, xc = tv;
    LBAR();
    for (int c = 0; c < SEQ / 64; ++c) {
        LAS unsigned char* STc = lds + ((c & 1) ? L_ST1 : L_ST0); LAS unsigned char* STn = lds + ((c & 1) ? L_ST0 : L_ST1);
        LAS unsigned char* sp = lds + (c & 1) * SETB;
        const LAS float* Gv = (const LAS float*)(sp + L_G); const LAS float* Dv = (const LAS float*)(sp + L_DT);
        LAS unsigned char* YTc = lds + L_YT + (c & 1) * MAT;
        if (c + 1 < SEQ / 64) WALK_LOAD(c + 1);
        bf16x8 Qf[2];
        if (wave < 4) { const int lb = wave;
            Qf[0] = ldfrag(sp + L_Q, 16 * lb + fr, 8 * fq); Qf[1] = ldfrag(sp + L_Q, 16 * lb + fr, 32 + 8 * fq);
            bf16x8 Kb[4][2]; pg8::f32x4 gs[4], ds[4], pacc[4];
#pragma unroll
            for (int sb = 0; sb < 4; ++sb) if (sb <= lb) { Kb[sb][0] = ldfrag(sp + L_K, 16 * sb + fr, 8 * fq); Kb[sb][1] = ldfrag(sp + L_K, 16 * sb + fr, 32 + 8 * fq);
                gs[sb] = *(const LAS pg8::f32x4*)(Gv + 16 * sb + 4 * fq); ds[sb] = (pg8::f32x4){1.f, 1.f, 1.f, 1.f};
                if (KIND == 1) ds[sb] = *(const LAS pg8::f32x4*)(Dv + 16 * sb + 4 * fq); }
            const float gl = Gv[16 * lb + fr];
#pragma unroll
            for (int sb = 0; sb < 4; ++sb) if (sb <= lb) { pacc[sb] = MFMA16(Kb[sb][0], Qf[0], ((pg8::f32x4){0.f, 0.f, 0.f, 0.f})); }
#pragma unroll
            for (int sb = 0; sb < 4; ++sb) if (sb <= lb) { pacc[sb] = MFMA16(Kb[sb][1], Qf[1], pacc[sb]); }
#pragma unroll
            for (int sb = 0; sb < 4; ++sb) { v2u o; o.x = 0u; o.y = 0u;
                if (sb <= lb) { float pv[4];
#pragma unroll
                    for (int r = 0; r < 4; ++r) pv[r] = (16 * sb + 4 * fq + r <= 16 * lb + fr) ? pacc[sb][r] * __expf(gl - gs[sb][r]) * ds[sb][r] : 0.f;
                    o.x = pk2(pv[0], pv[1]); o.y = pk2(pv[2], pv[3]); }
                *(LAS v2u*)(PPw + fr * (PT * 2) + (16 * sb + 4 * fq) * 2) = o; }
        } else if (KIND == 0) { const int wq = wave - 4;
            const bf16x8 Wf0 = ldfrag(sp + L_W, 16 * wq + fr, 8 * fq), Wf1 = ldfrag(sp + L_W, 16 * wq + fr, 32 + 8 * fq);
            bf16x8 Sf[4][2]; s16x4 u4[4]; pg8::f32x4 vacc[4];
#pragma unroll
            for (int eb = 0; eb < 4; ++eb) { Sf[eb][0] = ldfrag(STc, 16 * eb + fr, 8 * fq); Sf[eb][1] = ldfrag(STc, 16 * eb + fr, 32 + 8 * fq);
                u4[eb] = tr4(sp + L_U + (16 * wq + 4 * fq + (fr >> 2)) * (PT * 2) + (16 * eb + 4 * (fr & 3)) * 2); }
#pragma unroll
            for (int eb = 0; eb < 4; ++eb) vacc[eb] = MFMA16(Wf0, Sf[eb][0], ((pg8::f32x4){0.f, 0.f, 0.f, 0.f}));
#pragma unroll
            for (int eb = 0; eb < 4; ++eb) vacc[eb] = MFMA16(Wf1, Sf[eb][1], vacc[eb]);
#pragma unroll
            for (int eb = 0; eb < 4; ++eb) { v2u o; o.x = pk2(bfs(u4[eb][0]) - vacc[eb][0], bfs(u4[eb][1]) - vacc[eb][1]); o.y = pk2(bfs(u4[eb][2]) - vacc[eb][2], bfs(u4[eb][3]) - vacc[eb][3]);
                *(LAS v2u*)(lds + L_VT + (16 * eb + fr) * (PT * 2) + (16 * wq + 4 * fq) * 2) = o; }
        }
        if (KIND == 0) LBAR();
        if (wave < 4) { const int lb = wave;
            const bf16x8 Pf0 = ldfrag(PPw, fr, 8 * fq), Pf1 = ldfrag(PPw, fr, 32 + 8 * fq);
            const pg8::f32x4 gv = *(const LAS pg8::f32x4*)(Gv + 16 * lb + 4 * fq);
            bf16x8 Sf[4][2], Vf[4][2]; pg8::f32x4 yacc[4];
#pragma unroll
            for (int eb = 0; eb < 4; ++eb) { Sf[eb][0] = ldfrag(STc, 16 * eb + fr, 8 * fq); Sf[eb][1] = ldfrag(STc, 16 * eb + fr, 32 + 8 * fq);
                if (KIND == 0) { Vf[eb][0] = ldfrag(lds + L_VT, 16 * eb + fr, 8 * fq); Vf[eb][1] = ldfrag(lds + L_VT, 16 * eb + fr, 32 + 8 * fq); }
                else { Vf[eb][0] = trfrag(sp + L_V, 8 * fq, 16 * eb, fr); Vf[eb][1] = trfrag(sp + L_V, 32 + 8 * fq, 16 * eb, fr); } }
            const pg8::f32x4 eg = (pg8::f32x4){__expf(gv[0]), __expf(gv[1]), __expf(gv[2]), __expf(gv[3])};
#pragma unroll
            for (int eb = 0; eb < 4; ++eb) yacc[eb] = MFMA16(Qf[0], Sf[eb][0], ((pg8::f32x4){0.f, 0.f, 0.f, 0.f}));
#pragma unroll
            for (int eb = 0; eb < 4; ++eb) yacc[eb] = MFMA16(Qf[1], Sf[eb][1], yacc[eb]);
#pragma unroll
            for (int eb = 0; eb < 4; ++eb) yacc[eb] *= eg;
#pragma unroll
            for (int eb = 0; eb < 4; ++eb) yacc[eb] = MFMA16(Pf0, Vf[eb][0], yacc[eb]);
#pragma unroll
            for (int eb = 0; eb < 4; ++eb) yacc[eb] = MFMA16(Pf1, Vf[eb][1], yacc[eb]);
#pragma unroll
            for (int eb = 0; eb < 4; ++eb)
#pragma unroll
                for (int r = 0; r < 4; ++r) *(LAS bf16*)(YTc + (16 * lb + 4 * fq + r) * (PT * 2) + (16 * eb + fr) * 2) = (bf16)f2bf(yacc[eb][r]);
        } else { const int db = wave - 4;
            const float glast = Gv[63], egl = __expf(glast);
            bf16x8 Kr[2], Vf[4][2]; pg8::f32x4 g0[2], g1[2], d0[2], d1[2];
#pragma unroll
            for (int ks = 0; ks < 2; ++ks) { Kr[ks] = trfrag(sp + L_K, 32 * ks + 8 * fq, 16 * db, fr);
                g0[ks] = *(const LAS pg8::f32x4*)(Gv + 32 * ks + 8 * fq); g1[ks] = *(const LAS pg8::f32x4*)(Gv + 32 * ks + 8 * fq + 4);
                d0[ks] = (pg8::f32x4){1.f, 1.f, 1.f, 1.f}; d1[ks] = d0[ks];
                if (KIND == 1) { d0[ks] = *(const LAS pg8::f32x4*)(Dv + 32 * ks + 8 * fq); d1[ks] = *(const LAS pg8::f32x4*)(Dv + 32 * ks + 8 * fq + 4); } }
#pragma unroll
            for (int eb = 0; eb < 4; ++eb) {
                if (KIND == 0) { Vf[eb][0] = ldfrag(lds + L_VT, 16 * eb + fr, 8 * fq); Vf[eb][1] = ldfrag(lds + L_VT, 16 * eb + fr, 32 + 8 * fq); }
                else { Vf[eb][0] = trfrag(sp + L_V, 8 * fq, 16 * eb, fr); Vf[eb][1] = trfrag(sp + L_V, 32 + 8 * fq, 16 * eb, fr); } }
            bf16x8 Kf[2];
#pragma unroll
            for (int ks = 0; ks < 2; ++ks) { float kf[8];
#pragma unroll
                for (int j = 0; j < 4; ++j) { kf[j] = bfs(Kr[ks][j]) * __expf(glast - g0[ks][j]) * d0[ks][j]; kf[4 + j] = bfs(Kr[ks][4 + j]) * __expf(glast - g1[ks][j]) * d1[ks][j]; }
                const v4u kw = pk8(kf); Kf[ks] = __builtin_bit_cast(bf16x8, kw); }
#pragma unroll
            for (int eb = 0; eb < 4; ++eb) sacc[eb] = MFMA16(Kf[0], Vf[eb][0], sacc[eb] * egl);
#pragma unroll
            for (int eb = 0; eb < 4; ++eb) sacc[eb] = MFMA16(Kf[1], Vf[eb][1], sacc[eb]);
#pragma unroll
            for (int eb = 0; eb < 4; ++eb) { v2u o; o.x = pk2(sacc[eb][0], sacc[eb][1]); o.y = pk2(sacc[eb][2], sacc[eb][3]);
                *(LAS v2u*)(STn + (16 * eb + fr) * (PT * 2) + (16 * db + 4 * fq) * 2) = o; }
        }
        const v4u zcur = zc, xcur = xc; (void)xcur;
        if (c + 1 < SEQ / 64) { WALK_PREP((c + 1) & 1); zc = tz; xc = tv; }
        LBAR();
        {
            float y[8], zf[8]; unpk8(*(const LAS v4u*)(YTc + prow * (PT * 2) + pcg * 16), y); unpk8(zcur, zf);
            const size_t row = tok0 + (size_t)c * 64 + prow;
            if (KIND == 1) { float ss = 0.f, xf[8]; unpk8(xcur, xf);
#pragma unroll
                for (int j = 0; j < 8; ++j) { y[j] = (y[j] + p_D * xf[j]) * siluf(zf[j]); ss += y[j] * y[j]; }
                ss += __shfl_xor(ss, 1); ss += __shfl_xor(ss, 2); ss += __shfl_xor(ss, 4);
                if (pcg == 0) SM[row * SM_LD + 16 + h] = ss;
            } else { float ss = 0.f;
#pragma unroll
                for (int j = 0; j < 8; ++j) ss += y[j] * y[j];
                ss += __shfl_xor(ss, 1); ss += __shfl_xor(ss, 2); ss += __shfl_xor(ss, 4);
                const float rstd = rsqrtf(ss * (1.0f / 64.0f) + 1e-6f);
#pragma unroll
                for (int j = 0; j < 8; ++j) y[j] = y[j] * rstd * (KIND == 0 ? nw[j] : 1.0f) * siluf(zf[j]); }
            *(GAS v4u*)(ZB + row * ZB_LD + zcol) = pk8(y);
        }
    }
#undef WALK_LOAD
#undef WALK_PREP
}

constexpr int SP_RAW = 0, SP_CW = 67 * 1536, SP_END = SP_CW + 5 * 768 * 4;
static_assert(SP_END <= RING_BYTES, "ssd_prep LDS");
__device__ __forceinline__ void ssd_prep(const __attribute__((address_space(4))) Args* kp, int layer, LAS unsigned char* lds, int G_) {
    int tid = threadIdx.x; asm volatile("" : "+v"(tid));
    const int lane = tid & 63, wave = __builtin_amdgcn_readfirstlane(tid >> 6);
    unsigned char* ws = kp->ws;
    bf16* MIX = (bf16*)(ws + WS_MIX); float* SM = (float*)(ws + WS_SM);
    const bf16* HALO = (const bf16*)(ws + ((layer & 1) ? WS_XB0 : WS_XB1) + HALO_OFF);
    LAS float* CW = (LAS float*)(lds + SP_CW);
    { const float* cw = kp->in[8] + (size_t)layer * 4 * 768; const float* cb = kp->in[9] + (size_t)layer * 768;
      for (int i = tid; i < 768; i += 512) { CW[i] = cw[i]; CW[768 + i] = cw[768 + i]; CW[2 * 768 + i] = cw[2 * 768 + i]; CW[3 * 768 + i] = cw[3 * 768 + i]; CW[4 * 768 + i] = cb[i]; } }
    const float Aexp = expf(kp->in[10][layer * 8 + wave]), dtb = kp->in[11][layer * 8 + wave];
    for (int unit = blockIdx.x; unit < NBATCH * 64; unit += G_) { const int b = unit >> 6, c = unit & 63; const size_t tok0 = (size_t)b * SEQ + (size_t)c * 64;
        LBAR();
        for (int i = tid; i < 67 * 96; i += 512) { const int r = i / 96, pc = i - r * 96; v4u v = (v4u){0u, 0u, 0u, 0u};
            if (r >= 3) v = *(const GAS v4u*)(MIX + (tok0 + r - 3) * MIX_LD + MX_BX + pc * 8);
            else if (c > 0) v = *(const GAS v4u*)(HALO + ((size_t)(b * 64 + c - 1) * 3 + r) * HALO_LD + MX_BX + pc * 8);
            *(LAS v4u*)(lds + SP_RAW + r * 1536 + pc * 16) = v; }
        { const size_t r2 = tok0 + lane; const float dt = softplusf(SM[r2 * SM_LD + 16 + wave] + dtb); float gs = -Aexp * dt;
#pragma unroll
          for (int o = 1; o < 64; o <<= 1) { const float t_ = __shfl_up(gs, o); if (lane >= o) gs += t_; }
          SM[r2 * SM_LD + 16 + wave] = gs; SM[r2 * SM_LD + 24 + wave] = dt; }
        LBAR();
        for (int i = tid; i < 64 * 96; i += 512) { const int l = i / 96, pc = i - l * 96; float a[8];
            { const pg8::f32x4 b0 = *(const LAS pg8::f32x4*)(CW + 4 * 768 + pc * 8), b1 = *(const LAS pg8::f32x4*)(CW + 4 * 768 + pc * 8 + 4);
              a[0] = b0[0]; a[1] = b0[1]; a[2] = b0[2]; a[3] = b0[3]; a[4] = b1[0]; a[5] = b1[1]; a[6] = b1[2]; a[7] = b1[3]; }
#pragma unroll
            for (int k = 0; k < 4; ++k) { float f[8]; unpk8(*(const LAS v4u*)(lds + SP_RAW + (l + k) * 1536 + pc * 16), f);
                const pg8::f32x4 w0 = *(const LAS pg8::f32x4*)(CW + k * 768 + pc * 8), w1 = *(const LAS pg8::f32x4*)(CW + k * 768 + pc * 8 + 4);
#pragma unroll
                for (int j = 0; j < 4; ++j) { a[j] += w0[j] * f[j]; a[4 + j] += w1[j] * f[4 + j]; } }
#pragma unroll
            for (int j = 0; j < 8; ++j) a[j] = siluf(a[j]);
            *(GAS v4u*)(MIX + (tok0 + l) * MIX_LD + MX_BX + pc * 8) = pk8(a); }
    }
    LBAR();
}
__device__ __forceinline__ void ret_prep(const __attribute__((address_space(4))) Args* kp, int G_) {
    int tid = threadIdx.x; asm volatile("" : "+v"(tid));
    unsigned char* ws = kp->ws;
    bf16* MIX = (bf16*)(ws + WS_MIX); const float* ROPE = (const float*)(ws + WS_ROPE);
    for (int it = blockIdx.x * 512 + tid; it < MTOK * 32; it += G_ * 512) { const int m = it >> 5, hh = (it >> 2) & 7, i4 = it & 3, t = m & (SEQ - 1);
        const float* rp = ROPE + t * 32 + i4 * 8;
        const pg8::f32x4 c0 = *(const GAS pg8::f32x4*)rp, c1 = *(const GAS pg8::f32x4*)(rp + 4), s0 = *(const GAS pg8::f32x4*)(rp + SEQ * 32), s1 = *(const GAS pg8::f32x4*)(rp + SEQ * 32 + 4);
        const float cs[8] = {c0[0], c0[1], c0[2], c0[3], c1[0], c1[1], c1[2], c1[3]}, sn[8] = {s0[0], s0[1], s0[2], s0[3], s1[0], s1[1], s1[2], s1[3]};
#pragma unroll
        for (int T = 0; T < 2; ++T) { bf16* p = MIX + (size_t)m * MIX_LD + (T == 0 ? MX_CQ : MX_CK) + hh * 64 + i4 * 8; const float sc = T == 0 ? 1.0f : 0.125f;
            float a[8], bb[8], o1[8], o2[8]; unpk8(*(const GAS v4u*)p, a); unpk8(*(const GAS v4u*)(p + 32), bb);
#pragma unroll
            for (int j = 0; j < 8; ++j) { o1[j] = (a[j] * cs[j] - bb[j] * sn[j]) * sc; o2[j] = (a[j] * sn[j] + bb[j] * cs[j]) * sc; }
            *(GAS v4u*)p = pk8(o1); *(GAS v4u*)(p + 32) = pk8(o2); }
    }
}

typedef short bf16x4 __attribute__((ext_vector_type(4)));
#define MFMA16K16(a, b, c) __builtin_amdgcn_mfma_f32_16x16x16bf16_1k(a, b, c, 0, 0, 0)
constexpr int GQ_RAW = 0, GQ_KN = 67 * 384, GQ_VN = GQ_KN + MAT, GQ_NA = GQ_VN + MAT, GQ_AD = GQ_NA + MAT, GQ_S = GQ_AD + 4 * 16 * 20 * 4, GQ_CW = GQ_S + 512, GQ_TEAM = GQ_CW + 4 * 192 * 4;
static_assert(2 * GQ_TEAM <= RING_BYTES && 2 * MAT <= GQ_KN, "gdn_prep LDS");
__device__ __forceinline__ bf16x4 pk4(const pg8::f32x4 v) { v2u w; w.x = pk2(v[0], v[1]); w.y = pk2(v[2], v[3]); return __builtin_bit_cast(bf16x4, w); }
__device__ __forceinline__ void gdn_prep(const __attribute__((address_space(4))) Args* kp, int layer, LAS unsigned char* lds_all, int G_) {
    int tid = threadIdx.x; asm volatile("" : "+v"(tid));
    const int team = __builtin_amdgcn_readfirstlane(tid >> 8), j = tid & 255, lane = tid & 63, tw = __builtin_amdgcn_readfirstlane((tid >> 6) & 3), fr = lane & 15, fq = lane >> 4;
    LAS unsigned char* lds = lds_all + team * GQ_TEAM;
    LAS float* AD = (LAS float*)(lds + GQ_AD); LAS float* Gs = (LAS float*)(lds + GQ_S); LAS float* Bs = Gs + 64; LAS float* CW = (LAS float*)(lds + GQ_CW);
    unsigned char* ws = kp->ws;
    bf16* MIX = (bf16*)(ws + WS_MIX); float* SM = (float*)(ws + WS_SM);
    unsigned char* xbf = ws + ((layer & 1) ? WS_XB0 : WS_XB1); bf16* GW = (bf16*)(xbf + GW_OFF); const bf16* HALO = (const bf16*)(xbf + HALO_OFF);
    const float* cw = kp->in[4] + (size_t)layer * 4 * 1536;
    v4u praw[7]; float pcw[3], pbl = 0.f, pal = 0.f;
#define GQ_FETCH(rnd) do { const int u_ = ((rnd) * G_ + (int)blockIdx.x) * 2 + team; const int un_ = u_ < NBATCH * 8 * 64 ? u_ : 0; \
        const int c_ = un_ & 63, h_ = (un_ >> 6) & 7, b_ = un_ >> 9; const size_t tk_ = (size_t)b_ * SEQ + (size_t)c_ * 64; \
        _Pragma("unroll") for (int n = 0; n < 7; ++n) { const int i = j + 256 * n; praw[n] = (v4u){0u, 0u, 0u, 0u}; \
            if (i < 67 * 24) { const int r = i / 24, pc = i - r * 24, col = (pc >> 3) * 512 + h_ * 64 + (pc & 7) * 8; \
                if (r >= 3) praw[n] = *(const GAS v4u*)(MIX + (tk_ + r - 3) * MIX_LD + col); \
                else if (c_ > 0) praw[n] = *(const GAS v4u*)(HALO + ((size_t)(b_ * 64 + c_ - 1) * 3 + r) * HALO_LD + col); } } \
        _Pragma("unroll") for (int n = 0; n < 3; ++n) { const int i = j + 256 * n, k = i / 192, cc = i - k * 192; pcw[n] = cw[k * 1536 + (cc >> 6) * 512 + h_ * 64 + (cc & 63)]; } \
        if (tw == 0) { pbl = SM[(tk_ + lane) * SM_LD + h_]; pal = SM[(tk_ + lane) * SM_LD + 8 + h_]; } } while (0)
    GQ_FETCH(0);
    for (int round = 0; round < 8; ++round) {
        const int unit_ = (round * G_ + (int)blockIdx.x) * 2 + team;
        const bool live = unit_ < NBATCH * 8 * 64;
        const int unit = live ? unit_ : 0;
        const int c = unit & 63, h = (unit >> 6) & 7, b = unit >> 9;
        const size_t tok0 = (size_t)b * SEQ + (size_t)c * 64;
        LBAR();
#pragma unroll
        for (int n = 0; n < 7; ++n) { const int i = j + 256 * n; if (i < 67 * 24) { const int r = i / 24, pc = i - r * 24; *(LAS v4u*)(lds + GQ_RAW + r * 384 + pc * 16) = praw[n]; } }
#pragma unroll
        for (int n = 0; n < 3; ++n) CW[j + 256 * n] = pcw[n];
        if (tw == 0) {
            float gsum = -expf(kp->in[5][layer * 8 + h]) * softplusf(pal + kp->in[6][layer * 8 + h]);
#pragma unroll
            for (int o = 1; o < 64; o <<= 1) { const float t_ = __shfl_up(gsum, o); if (lane >= o) gsum += t_; }
            Gs[lane] = gsum; Bs[lane] = sigmf(pbl);
            if (live) SM[(tok0 + lane) * SM_LD + 8 + h] = gsum; }
        if (round + 1 < 8) GQ_FETCH(round + 1);
        LBAR();
#pragma unroll 1
        for (int n = 0; n < 6; ++n) { const int i = j + 256 * n, t = i / 24, pc = i - t * 24, tens = pc >> 3, ch = pc & 7; float a[8];
#pragma unroll
            for (int jj = 0; jj < 8; ++jj) a[jj] = 0.f;
#pragma unroll
            for (int k = 0; k < 4; ++k) { float f[8]; unpk8(*(const LAS v4u*)(lds + GQ_RAW + (t + k) * 384 + pc * 16), f);
                const pg8::f32x4 w0 = *(const LAS pg8::f32x4*)(CW + k * 192 + pc * 8), w1 = *(const LAS pg8::f32x4*)(CW + k * 192 + pc * 8 + 4);
#pragma unroll
                for (int jj = 0; jj < 4; ++jj) { a[jj] += w0[jj] * f[jj]; a[4 + jj] += w1[jj] * f[4 + jj]; } }
            float ss = 0.f;
#pragma unroll
            for (int jj = 0; jj < 8; ++jj) { a[jj] = siluf(a[jj]); ss += a[jj] * a[jj]; }
            ss += __shfl_xor(ss, 1); ss += __shfl_xor(ss, 2); ss += __shfl_xor(ss, 4);
            const float sc = tens == 2 ? 1.0f : rsqrtf(ss + 1e-6f) * (tens == 0 ? 0.125f : 1.0f);
#pragma unroll
            for (int jj = 0; jj < 8; ++jj) a[jj] *= sc;
            const v4u o = pk8(a);
            if (tens == 0) { if (live) *(GAS v4u*)(MIX + (tok0 + t) * MIX_LD + MX_AQ + h * 64 + ch * 8) = o; }
            else if (tens == 1) { *(LAS v4u*)(lds + GQ_KN + t * (PT * 2) + ch * 16) = o; if (live) *(GAS v4u*)(MIX + (tok0 + t) * MIX_LD + MX_AK + h * 64 + ch * 8) = o; }
            else *(LAS v4u*)(lds + GQ_VN + t * (PT * 2) + ch * 16) = o; }
        LBAR();
        for (int id = tw; id < 10; id += 4) { const int lb = id < 1 ? 0 : (id < 3 ? 1 : (id < 6 ? 2 : 3)), sb = id - (lb * (lb + 1)) / 2;
            pg8::f32x4 acc = (pg8::f32x4){0.f, 0.f, 0.f, 0.f};
#pragma unroll
            for (int ks = 0; ks < 2; ++ks) acc = MFMA16(ldfrag(lds + GQ_KN, 16 * lb + fr, 32 * ks + 8 * fq), ldfrag(lds + GQ_KN, 16 * sb + fr, 32 * ks + 8 * fq), acc);
            const int s = 16 * sb + fr; const float gsv = Gs[s];
#pragma unroll
            for (int r = 0; r < 4; ++r) { const int l = 16 * lb + 4 * fq + r; const float v = s < l ? Bs[l] * acc[r] * __expf(Gs[l] - gsv) : 0.f;
                if (lb == sb) AD[(lb * 16 + 4 * fq + r) * 20 + fr] = v;
                else *(LAS bf16*)(lds + GQ_NA + l * (PT * 2) + s * 2) = (bf16)f2bf(-v); } }
        LBAR();
        if (tw == 0) { const int bi = lane >> 4, cc = lane & 15; const LAS float* Ab = AD + bi * 16 * 20; float x[16];
#pragma unroll
            for (int r = 0; r < 16; ++r) { float a = (r == cc) ? 1.0f : 0.0f;
#pragma unroll
                for (int s4 = 0; s4 < r; s4 += 4) { const pg8::f32x4 av = *(const LAS pg8::f32x4*)(Ab + r * 20 + s4);
                    a -= av[0] * x[s4];
                    if (s4 + 1 < r) a -= av[1] * x[s4 + 1];
                    if (s4 + 2 < r) a -= av[2] * x[s4 + 2];
                    if (s4 + 3 < r) a -= av[3] * x[s4 + 3]; }
                x[r] = a; }
#pragma unroll
            for (int r = 0; r < 16; ++r) *(LAS bf16*)(lds + GQ_NA + (16 * bi + r) * (PT * 2) + (16 * bi + cc) * 2) = (bf16)f2bf(x[r]); }
        LBAR();
#pragma unroll 1
        for (int half = 0; half < 2; ++half) { LAS unsigned char* src = lds + (half == 0 ? GQ_VN : GQ_KN); const int c0 = 16 * tw;
            pg8::f32x4 R[4], X[4];
#pragma unroll
            for (int i = 0; i < 4; ++i) { const s16x4 raw = tr4(src + (16 * i + 4 * fq + (fr >> 2)) * (PT * 2) + (c0 + 4 * (fr & 3)) * 2);
                const pg8::f32x4 bv = *(const LAS pg8::f32x4*)(Bs + 16 * i + 4 * fq); pg8::f32x4 sc = bv;
                if (half == 1) { const pg8::f32x4 gv = *(const LAS pg8::f32x4*)(Gs + 16 * i + 4 * fq); sc = (pg8::f32x4){bv[0] * __expf(gv[0]), bv[1] * __expf(gv[1]), bv[2] * __expf(gv[2]), bv[3] * __expf(gv[3])}; }
                R[i] = (pg8::f32x4){bfs(raw[0]) * sc[0], bfs(raw[1]) * sc[1], bfs(raw[2]) * sc[2], bfs(raw[3]) * sc[3]}; }
#define NAF(ib, jb) (*(const LAS bf16x4*)(lds + GQ_NA + (16 * (ib) + fr) * (PT * 2) + (16 * (jb) + 4 * fq) * 2))
            const pg8::f32x4 Z = (pg8::f32x4){0.f, 0.f, 0.f, 0.f};
            X[0] = MFMA16K16(NAF(0, 0), pk4(R[0]), Z);
            { const bf16x4 x0 = pk4(X[0]); R[1] = MFMA16K16(NAF(1, 0), x0, R[1]); R[2] = MFMA16K16(NAF(2, 0), x0, R[2]); R[3] = MFMA16K16(NAF(3, 0), x0, R[3]); }
            X[1] = MFMA16K16(NAF(1, 1), pk4(R[1]), Z);
            { const bf16x4 x1 = pk4(X[1]); R[2] = MFMA16K16(NAF(2, 1), x1, R[2]); R[3] = MFMA16K16(NAF(3, 1), x1, R[3]); }
            X[2] = MFMA16K16(NAF(2, 2), pk4(R[2]), Z);
            { const bf16x4 x2 = pk4(X[2]); R[3] = MFMA16K16(NAF(3, 2), x2, R[3]); }
            X[3] = MFMA16K16(NAF(3, 3), pk4(R[3]), Z);
#undef NAF
#pragma unroll
            for (int i = 0; i < 4; ++i)
#pragma unroll
                for (int r = 0; r < 4; ++r) *(LAS bf16*)(lds + GQ_RAW + half * MAT + (16 * i + 4 * fq + r) * (PT * 2) + (c0 + fr) * 2) = (bf16)f2bf(X[i][r]);
        }
        LBAR();
        if (live) for (int i = j; i < 64 * 16; i += 256) { const int t = (i >> 3) & 63, ch = i & 7, half = i >> 9;
            const v4u v = *(const LAS v4u*)(lds + GQ_RAW + half * MAT + t * (PT * 2) + ch * 16);
            if (half == 0) *(GAS v4u*)(MIX + (tok0 + t) * MIX_LD + MX_AV + h * 64 + ch * 8) = v; else *(GAS v4u*)(GW + (tok0 + t) * 512 + h * 64 + ch * 8) = v; }
    }
    LBAR();
}
#ifndef MK_ONE_LAUNCH
#define MK_ONE_LAUNCH 1
#endif
#ifndef MK_NAIVE
#define MK_NAIVE 0
#endif
__global__ void __launch_bounds__(64) mixers_naive(Args args, int layer) {
    const int lane = threadIdx.x, w = blockIdx.x, kind = w >> 6, b = (w & 63) >> 3, h = w & 7;
    unsigned char* ws = args.ws;
    bf16* ZB = (bf16*)(ws + WS_ZB); const bf16* MIX = (const bf16*)(ws + WS_MIX); float* SM = (float*)(ws + WS_SM); const float* ROPE = (const float*)(ws + WS_ROPE);
    if (kind == 0) gdn_naive(args, layer, b, h, lane, MIX, SM, ZB);
    else if (kind == 1) ssd_naive(args, layer, b, h, lane, MIX, SM, ZB);
    else ret_naive(b, h, lane, MIX, ROPE, ZB);
}
__global__ void __launch_bounds__(512, 2) fwd_kernel(Args args) {
    extern __shared__ __attribute__((aligned(16))) unsigned char lds_raw[];
    LAS unsigned char* lds0 = (LAS unsigned char*)lds_raw;
    volatile LAS unsigned* MISC = (volatile LAS unsigned*)(lds0 + MISC_OFF);
    const int G = gridDim.x, NGW = G * 8;
    unsigned char* ws0 = args.ws;
    for (int u = threadIdx.x; u < (LDS_BYTES - RING_BYTES) / 4; u += 512) ((LAS unsigned*)(lds0 + RING_BYTES))[u] = 0u;
    __syncthreads();
#if MK_ONE_LAUNCH
    XcdBarrier bar = xcd_barrier_post((unsigned*)(ws0 + WS_CTL) + 4096, MISC + 8);
#define GRID_BAR() do { XcdBarrier b_ = bar; asm volatile("" : "+s"(b_.bar), "+s"(b_.x)); xcd_barrier(b_); } while (0)
#else
#define GRID_BAR() do {} while (0)
#endif
    const int lo = args.ph_lo, hi = args.ph_hi;
#define IN(p) (lo <= (p) && (p) < hi)
#define SEAM(p) do { if (IN(p) && IN((p) + 1)) GRID_BAR(); } while (0)
    typedef const __attribute__((address_space(4))) Args* KArgs;
    const KArgs kp0 = (KArgs)__builtin_amdgcn_kernarg_segment_ptr();
#define PHASE_PTRS() KArgs kp = kp0; asm volatile("" : "+s"(kp)); unsigned char* ws = kp->ws; float* X = kp->out; (void)X; \
    LAS unsigned char* lds = lds0; \
    int tid = threadIdx.x; asm volatile("" : "+v"(tid)); int bx = blockIdx.x; asm volatile("" : "+s"(bx)); const int lane = tid & 63, wave = __builtin_amdgcn_readfirstlane(tid >> 6), gw = bx * 8 + wave; (void)lane; (void)gw; \
    bf16* ZB = (bf16*)(ws + WS_ZB); bf16* MIX = (bf16*)(ws + WS_MIX); float* SM = (float*)(ws + WS_SM); (void)ZB; (void)MIX; (void)SM; \
    float* SSQA = (float*)(ws + WS_SSQA); float* SSQB = (float*)(ws + WS_SSQB); float* SSQC = (float*)(ws + WS_SSQC); float* ROPE = (float*)(ws + WS_ROPE); (void)SSQA; (void)SSQB; (void)SSQC; (void)ROPE; \
    bf16* W1T = (bf16*)(ws + W_1T); bf16* WGT = (bf16*)(ws + W_GT); bf16* WMT = (bf16*)(ws + W_MT); bf16* WOT = (bf16*)(ws + W_OT); bf16* WUT = (bf16*)(ws + W_UT); (void)W1T; (void)WGT; (void)WMT; (void)WOT; (void)WUT; \
    bf16* WDT = (bf16*)(ws + W_DT); bf16* WPGT = (bf16*)(ws + W_PGT); bf16* WPPT = (bf16*)(ws + W_PPT); (void)WDT; (void)WPGT; (void)WPPT; \
    bf16* GATE = (bf16*)(ws + WS_GATE); bf16* U = (bf16*)(ws + WS_U); bf16* PB = (bf16*)X; bf16* PLE = (bf16*)X + (size_t)MTOK * PLED;     (void)GATE; (void)U; (void)PB; (void)PLE; \
    bf16* XBl = (bf16*)(ws + ((layer & 1) ? WS_XB1 : WS_XB0)); bf16* XBf = (bf16*)(ws + ((layer & 1) ? WS_XB0 : WS_XB1)); (void)XBl; (void)XBf
    if (IN(0)) { const int layer = 0; PHASE_PTRS();
        for (int e = bx * 512 + tid; e < SEQ * 32; e += G * 512) { const int t = e >> 5, i = e & 31;
            double f = 1.0; for (int j = 0; j < i; ++j) f *= 0.7429639507594948;
            const double ang = (double)t * f, kk = rint(ang * 0.15915494309189535);
            double r = fma(-kk, 6.283185307179586, ang); r = fma(-kk, 2.4492935982947064e-16, r); const double r2 = r * r;
            double sn = 1.0, cs = 1.0;
    #pragma unroll
            for (int n = 15; n >= 1; --n) { sn = 1.0 - r2 * (1.0 / (double)((2 * n) * (2 * n + 1))) * sn; cs = 1.0 - r2 * (1.0 / (double)((2 * n - 1) * (2 * n))) * cs; }
            ROPE[e] = (float)cs; ROPE[SEQ * 32 + e] = (float)(r * sn); }
    }
    for (int layer = 0; layer < DEPTH; ++layer) {
        const int P = layer * NPH;
        if (IN(P + 0)) { PHASE_PTRS();
            int ibase = 0;
            const float* w_in = kp->in[3] + (size_t)layer * DM * NIN; const float* nmix = kp->in[2] + (size_t)layer * DM;
            TR_SEG(w_in, NIN, 1536, 512, DM, nmix, W1T, DM, 0, 0);
            TR_SEG(w_in, NIN, 2064, 512, DM, nmix, W1T, DM, 512, 0);
            TR_SEG(w_in, NIN, 4888, 512, DM, nmix, W1T, DM, 1024, 0);
            TR_SEG(w_in, NIN, 0, 1536, DM, nmix, W1T, DM, 1536, 0);
            TR_SEG(w_in, NIN, 2576, 768, DM, nmix, W1T, DM, 3072, 0);
            TR_SEG(w_in, NIN, 3352, 1536, DM, nmix, W1T, DM, 3840, 0);
            TR_SEG(w_in, NIN, 2048, 16, DM, nmix, W1T, DM, 5376, 0);
            TR_SEG(w_in, NIN, 3344, 8, DM, nmix, W1T, DM, 5392, 0);
            TR_SEG((const float*)nullptr, NIN, 0, 232, DM, (const float*)nullptr, W1T, DM, 5400, 0);
            TR_SEG(w_in, NIN, 5400, 3072, DM, nmix, WGT, DM, 0, 0);
            const float* wbr = kp->in[14] + (size_t)layer * 3 * 512 * DM;
            TR_SEG(wbr, DM, 0, DM, 512, (const float*)nullptr, WMT, KMERGE, 0, 0);
            TR_SEG(wbr + 512 * DM, DM, 0, DM, 512, kp->in[13] + (size_t)layer * 512, WMT, KMERGE, 0, 512);
            TR_SEG(wbr + 2 * 512 * DM, DM, 0, DM, 512, (const float*)nullptr, WMT, KMERGE, 0, 1024);
            TR_SEG(kp->in[15] + (size_t)layer * DM * DM, DM, 0, DM, DM, (const float*)nullptr, WOT, DM, 0, 0);
            TR_SEG(kp->in[17] + (size_t)layer * DM * DFF, DFF, 0, DFF, DM, kp->in[16] + (size_t)layer * DM, WUT, DM, 0, 0);
            TR_SEG(kp->in[18] + (size_t)layer * DFF * DM, DM, 0, DM, DFF, (const float*)nullptr, WDT, DFF, 0, 0);
            TR_SEG(kp->in[20] + (size_t)layer * DM * DM, DM, 0, DM, DM, kp->in[19] + (size_t)layer * DM, WPGT, DM, 0, 0);
            TR_SEG(kp->in[21] + (size_t)layer * PLED * DM, DM, 0, DM, PLED, (const float*)nullptr, WPPT, PLED, 0, 0);
            if (layer == 0) {
                const float* xin = kp->in[0];
                for (int m = gw; m < MTOK; m += NGW) {
                    const GAS f32x4* xr = (const GAS f32x4*)(xin + (size_t)m * DM) + lane; f32x4 v[4]; float s = 0.f;
#pragma unroll
                    for (int j = 0; j < 4; ++j) { v[j] = xr[64 * j]; s += (v[j].x * v[j].x + v[j].y * v[j].y) + (v[j].z * v[j].z + v[j].w * v[j].w); }
                    s = wave_sum(s);
                    GAS v2u* o8 = (GAS v2u*)(XBl + (size_t)m * DM) + lane;
#pragma unroll
                    for (int j = 0; j < 4; ++j) { v2u w; w.x = pk2(v[j].x, v[j].y); w.y = pk2(v[j].z, v[j].w); o8[64 * j] = w; }
                    if (lane < 16) SSQC[(size_t)m * 16 + lane] = lane == 0 ? s : 0.f;
                }
            }
        }
        SEAM(P + 0);
        if (IN(P + 1)) { PHASE_PTRS();
            pg8::Gemm g{XBl, W1T, MTOK, N1, DM}; pg8::StaticOrder S; S.init(MTOK, N1, G, bx);
            stagger(bx); build_rs_table(S, SSQC, lds, tid);
            pg8::EpiP1 E{ZB, MIX, SM, lds + RS_OFF, (bf16*)((unsigned char*)XBf + HALO_OFF)};
            pg8::gemm_phase<pg8::EpiP1, pg8::StaticOrder, true, true>(lds, g, S, E);
        }
        SEAM(P + 1);
        if (IN(P + 2)) { PHASE_PTRS();
#if !MK_NAIVE
            gdn_prep(kp, layer, lds, G);
            ssd_prep(kp, layer, lds, G);
            ret_prep(kp, G);
#endif
            const float* pl = kp->in[1] + (size_t)layer * MTOK * PLED;
            for (size_t e = (size_t)bx * 512 + tid; e < (size_t)MTOK * PLED / 4; e += (size_t)G * 512) { const f32x4 v = ((const GAS f32x4*)pl)[e]; v2u w; w.x = pk2(v.x, v.y); w.y = pk2(v.z, v.w); ((GAS v2u*)PB)[e] = w; }
        }
        SEAM(P + 2);
        if (IN(P + 3)) { PHASE_PTRS();
#if !MK_NAIVE
            for (int w = bx; w < 192; w += G) { const int kind = w >> 6, b = (w & 63) >> 3, h = w & 7;
                if (kind == 0) mixer_walk<0>(kp, layer, b, h, lds);
                else if (kind == 1) mixer_walk<1>(kp, layer, b, h, lds);
                else mixer_walk<2>(kp, layer, b, h, lds);
                __syncthreads(); }
#endif
            if (bx >= 192 || G <= 192) {
                pg8::Gemm g{PB, WPPT, MTOK / 2, DM, PLED}; pg8::StaticOrder S; if (G > 192) S.init(MTOK / 2, DM, G - 192, bx - 192); else S.init(MTOK / 2, DM, G, bx);
                pg8::EpiRS<0> E{PLE, DM, (LAS unsigned char*)nullptr};
                pg8::gemm_phase<pg8::EpiRS<0>, pg8::StaticOrder, true, true>(lds, g, S, E); }
        }
        SEAM(P + 3);
        if (IN(P + 4)) { PHASE_PTRS();
            for (int m = gw; m < MTOK; m += NGW) {
                GAS v4u* yp = (GAS v4u*)(ZB + (size_t)m * ZB_LD + 512) + lane; const v4u w = *yp;
                const f32x4 sq = *(const f32x4*)(SM + (size_t)m * SM_LD + 16 + 4 * (lane >> 5));
                const float rstd = rsqrtf(((sq[0] + sq[1]) + (sq[2] + sq[3])) * (1.0f / 256.0f) + 1e-6f);
                v4u o; o.x = pk2(pg8::bflo(w.x) * rstd, pg8::bfhi(w.x) * rstd); o.y = pk2(pg8::bflo(w.y) * rstd, pg8::bfhi(w.y) * rstd);
                o.z = pk2(pg8::bflo(w.z) * rstd, pg8::bfhi(w.z) * rstd); o.w = pk2(pg8::bflo(w.w) * rstd, pg8::bfhi(w.w) * rstd);
                *yp = o;
            }
            pg8::Gemm g{XBl, WGT, MTOK, NGATE, DM}; pg8::StaticOrder S; S.init(MTOK, NGATE, G, bx);
            stagger(bx); build_rs_table(S, SSQC, lds, tid);
            pg8::EpiRS<2> E{GATE, NGATE, lds + RS_OFF};
            pg8::gemm_phase<pg8::EpiRS<2>, pg8::StaticOrder, true, true>(lds, g, S, E);
        }
        SEAM(P + 4);
        if (IN(P + 5)) { PHASE_PTRS();
            pg8::Gemm g{ZB, WMT, MTOK, DM, KMERGE}; pg8::StaticOrder S; S.init(MTOK, DM, G, bx);
            pg8::EpiMerge E{GATE, XBf};
            pg8::gemm_phase<pg8::EpiMerge, pg8::StaticOrder, true, true>(lds, g, S, E);
        }
        SEAM(P + 5);
        if (IN(P + 6)) { PHASE_PTRS();
            pg8::Gemm g{XBf, WOT, MTOK, DM, DM}; pg8::StaticOrder S; S.init(MTOK, DM, G, bx);
            pg8::EpiResid<0> E{XBl, XBl, SSQA, (LAS unsigned char*)nullptr, nullptr,  1.0f};
            pg8::gemm_phase<pg8::EpiResid<0>, pg8::StaticOrder, true, true>(lds, g, S, E);
        }
        SEAM(P + 6);
        if (IN(P + 7)) { PHASE_PTRS();
            { pg8::Gemm g{XBl, WUT, MTOK, DFF, DM}; pg8::StaticOrder S; S.init(MTOK, DFF, G, bx);
              stagger(bx); build_rs_table(S, SSQA, lds, tid);
              pg8::EpiRS<1> E{U, DFF, lds + RS_OFF};
              pg8::gemm_phase<pg8::EpiRS<1>, pg8::StaticOrder, true, true>(lds, g, S, E); }
        }
        SEAM(P + 7);
        if (IN(P + 8)) { PHASE_PTRS();
            pg8::Gemm g{U, WDT, MTOK, DM, DFF}; pg8::StaticOrder S; S.init(MTOK, DM, G, bx);
            pg8::EpiResid<0> E{XBl, XBl, SSQB, (LAS unsigned char*)nullptr, nullptr,  1.0f};
            pg8::gemm_phase<pg8::EpiResid<0>, pg8::StaticOrder, true, true>(lds, g, S, E);
            __builtin_amdgcn_sched_barrier(0);
            { pg8::Gemm g2{PB + (size_t)(MTOK / 2) * PLED, WPPT, MTOK / 2, DM, PLED}; pg8::StaticOrder S2; S2.init(MTOK / 2, DM, G, bx);
              pg8::EpiRS<0> E2{PLE + (size_t)(MTOK / 2) * DM, DM, (LAS unsigned char*)nullptr};
              pg8::gemm_phase<pg8::EpiRS<0>, pg8::StaticOrder, true, true>(lds, g2, S2, E2); }
        }
        SEAM(P + 8);
        if (IN(P + 9)) { PHASE_PTRS();
            pg8::Gemm g{XBl, WPGT, MTOK, DM, DM}; pg8::StaticOrder S; S.init(MTOK, DM, G, bx);
            build_rs_table(S, SSQB, lds, tid);
            pg8::EpiResid<1> E{XBl, XBf, SSQC, lds + RS_OFF, PLE,  1.0f};
            pg8::gemm_phase<pg8::EpiResid<1>, pg8::StaticOrder, true, true>(lds, g, S, E);
        }
        SEAM(P + 9);
    }
    if (IN(PH_FINAL)) { const int layer = DEPTH; PHASE_PTRS();
        const float* nf = kp->in[22];
        for (int m = gw; m < MTOK; m += NGW) {
            const float sp = lane < 16 ? SSQC[(size_t)m * 16 + lane] : 0.f;
            const float rstd = rsqrtf(wave_sum(sp) * (1.0f / 1024.0f) + 1e-6f);
            const GAS v4u* xr = (const GAS v4u*)(XBl + (size_t)m * DM) + lane; GAS f32x4* orow = (GAS f32x4*)(X + (size_t)m * DM);
#pragma unroll
            for (int j = 0; j < 2; ++j) { const v4u w = xr[64 * j]; const int c8 = (64 * j + lane) * 2; const f32x4 g0 = ((const GAS f32x4*)nf)[c8], g1 = ((const GAS f32x4*)nf)[c8 + 1];
                f32x4 o0, o1; o0[0] = pg8::bflo(w.x); o0[1] = pg8::bfhi(w.x); o0[2] = pg8::bflo(w.y); o0[3] = pg8::bfhi(w.y); o1[0] = pg8::bflo(w.z); o1[1] = pg8::bfhi(w.z); o1[2] = pg8::bflo(w.w); o1[3] = pg8::bfhi(w.w);
                orow[c8] = o0 * rstd * g0; orow[c8 + 1] = o1 * rstd * g1; }
        }
    }
#undef IN
#undef SEAM
}

extern "C" void kernel_launch(void* const* d_in, const int* in_sizes, int n_in, void* d_out, int out_size, void* d_ws, size_t ws_size, hipStream_t stream) {
    static int grid = 0;
    if (grid == 0) {
        if (n_in != 23 || out_size != MTOK * DM || ws_size < WS_END) { fprintf(stderr, "kernel_launch: unexpected problem (n_in %d, out %d, ws %zu < %zu)\n", n_in, out_size, ws_size, (size_t)WS_END); grid = -1; return; }
        int dev = 0, cus = 0;
        if (hipGetDevice(&dev) != hipSuccess || hipDeviceGetAttribute(&cus, hipDeviceAttributeMultiprocessorCount, dev) != hipSuccess) { grid = -1; return; }
        if (hipFuncSetAttribute((const void*)fwd_kernel, hipFuncAttributeMaxDynamicSharedMemorySize, LDS_BYTES) != hipSuccess) { fprintf(stderr, "kernel_launch: hipFuncSetAttribute failed\n"); grid = -1; return; }
        int per_cu = 0;
        if (hipOccupancyMaxActiveBlocksPerMultiprocessor(&per_cu, (const void*)fwd_kernel, 512, LDS_BYTES) != hipSuccess || per_cu < 1) { fprintf(stderr, "kernel_launch: occupancy query says %d blocks per CU\n", per_cu); }
        (void)hipGetLastError();
        grid = cus;
    }
    if (grid < 0) return;
    (void)hipMemsetAsync((char*)d_ws + WS_CTL, 0, CTL_BYTES, stream);
    Args a; memset(&a, 0, sizeof(a));
    for (int i = 0; i < 23; ++i) a.in[i] = (const float*)d_in[i];
    a.out = (float*)d_out; a.ws = (unsigned char*)d_ws;
#if MK_ONE_LAUNCH
    a.ph_lo = 0; a.ph_hi = N_PHASES;
    hipLaunchKernelGGL(fwd_kernel, dim3(grid), dim3(512), LDS_BYTES, stream, a);
#else
    for (int p = 0; p < N_PHASES; ++p) {
#if MK_NAIVE
        if (p != PH_FINAL && (p % NPH) == 3) { hipLaunchKernelGGL(mixers_naive, dim3(192), dim3(64), 0, stream, a, p / NPH); continue; }
#endif
        a.ph_lo = p; a.ph_hi = p + 1;
        hipLaunchKernelGGL(fwd_kernel, dim3(grid), dim3(512), LDS_BYTES, stream, a);
    }
#endif
}
```

```cpp
#include <hip/hip_runtime.h>
#include <cstdio>
#include <cstdint>
#include <cstring>
__host__ __device__ __forceinline__ size_t mixh(int col, size_t m) {
    const size_t b = m >> 12, t = m & 4095;
    if (col < 2048) { const int ten = col >> 9, h = (col >> 6) & 7; return (size_t)ten * (16u << 20) + (((b * 8 + h) << 12) + t) * 64 + (col & 63); }
    if (col < 2304) { const int c2 = col - 2048, tb = c2 >> 7, g = (c2 >> 6) & 1; return (size_t)4 * (16u << 20) + (size_t)tb * (4u << 20) + (((b * 2 + g) << 12) + t) * 64 + (col & 63); }
    const int c2 = col - 2304, ten = c2 >> 9, h = (c2 >> 6) & 7; return (size_t)4 * (16u << 20) + (8u << 20) + (size_t)ten * (16u << 20) + (((b * 8 + h) << 12) + t) * 64 + (col & 63);
}
__host__ __device__ __forceinline__ size_t gwh(int h, int c, size_t m) { return ((((m >> 12) * 8 + h) << 12) + (m & 4095)) * 64 + c; }
namespace pg8 {
#define PG8_LAS __attribute__((address_space(3)))
typedef unsigned short bf16_t;
typedef short bf16x8 __attribute__((ext_vector_type(8)));
typedef float f32x4 __attribute__((ext_vector_type(4)));
typedef unsigned u32x4 __attribute__((ext_vector_type(4)));
constexpr int BM = 256, BK = 64, HALF = 128, HTB = HALF * BK * 2  , STAGE_BYTES = 8 * HTB, NXCD = 8, WGM = 8;

__host__ __device__ __forceinline__ int lds_byte(int r, int c) { const int st = (r >> 4) * 2 + (c >> 5), rr = r & 15, cc = c & 31, ob = rr * 64 + cc * 2; return st * 1024 + (ob ^ (((ob >> 9) & 1) << 5)); }
__host__ __device__ __forceinline__ void stage_rc(int b, int& R, int& C) { const int st = b / 1024, sb = b % 1024, swz = sb ^ (((sb >> 9) & 1) << 5); R = (st >> 1) * 16 + swz / 64; C = (st & 1) * 32 + (swz % 64) / 2; }
__host__ __device__ __forceinline__ int perm32(int rho) { const int n = rho >> 4, i = rho & 15; return 8 * (i >> 2) + 4 * n + (i & 3); }

struct Unit { int pm, pn; };
struct Gemm { const bf16_t* A; const bf16_t* Bt; int M, N, K; };

struct StaticOrder {
    int nM, nN, nwg, G, c;
    __host__ __device__ void init(int M, int N, int G_, int c_) { nM = M / BM; nN = N / BM; nwg = nM * nN; G = G_; c = c_; }
    __host__ __device__ bool next(int i, Unit& u) const {
        const long L = (long)i * G + c; if (L >= nwg) return false;
        int wgid = (int)L; { const int q = nwg / NXCD, r = nwg % NXCD, xcd = wgid % NXCD, off = wgid / NXCD; wgid = (xcd < r ? xcd * (q + 1) : r * (q + 1) + (xcd - r) * q) + off; }
        const int nig = WGM * nN, gid = wgid / nig, fm = gid * WGM, gsz = (nM - fm) < WGM ? (nM - fm) : WGM;
        u.pm = fm + ((wgid % nig) % gsz); u.pn = (wgid % nig) / gsz; return true;
    }
    __device__ __forceinline__ void a_ready(const Unit&) const {}
    __device__ __forceinline__ void done(const Unit&) const {}
};

typedef float f32x2c __attribute__((ext_vector_type(2))); typedef __bf16 bf16x2c __attribute__((ext_vector_type(2)));
__device__ __forceinline__ unsigned cvt_pk_bf16(float lo, float hi) { const f32x2c v = {lo, hi}; const bf16x2c b = __builtin_convertvector(v, bf16x2c); return __builtin_bit_cast(unsigned, b); }
typedef unsigned u32x2 __attribute__((ext_vector_type(2)));
__device__ __forceinline__ float bflo(unsigned w) { return __uint_as_float(w << 16); }
__device__ __forceinline__ float bfhi(unsigned w) { return __uint_as_float(w & 0xffff0000u); }
__device__ __forceinline__ u32x4 pack8(const f32x4 v0, const f32x4 v1) { u32x4 w; w.x = cvt_pk_bf16(v0[0], v0[1]); w.y = cvt_pk_bf16(v0[2], v0[3]); w.z = cvt_pk_bf16(v1[0], v1[1]); w.w = cvt_pk_bf16(v1[2], v1[3]); return w; }
__device__ __forceinline__ void unpack8(const u32x4 w, f32x4& v0, f32x4& v1) { v0 = (f32x4){bflo(w.x), bfhi(w.x), bflo(w.y), bfhi(w.y)}; v1 = (f32x4){bflo(w.z), bfhi(w.z), bflo(w.w), bfhi(w.w)}; }
constexpr float RMS_EPS = 1e-6f;
constexpr int RS_SLOTS = 8;
__device__ __forceinline__ void load_rstd(const PG8_LAS unsigned char* rst, int pm, int wr, int fr, float (&rs)[2][4]) {
    if (rst == nullptr) {
#pragma unroll
        for (int ai = 0; ai < 2; ++ai)
#pragma unroll
            for (int m = 0; m < 4; ++m) rs[ai][m] = 1.0f;
        return; }
    const PG8_LAS int* pml = (const PG8_LAS int*)rst; int slot = 0;
#pragma unroll
    for (int k = 1; k < RS_SLOTS; ++k) slot = pml[k] == pm ? k : slot;
    const PG8_LAS float* tab = (const PG8_LAS float*)(rst + 32) + slot * 256 + wr * 64 + fr;
#pragma unroll
    for (int ai = 0; ai < 2; ++ai)
#pragma unroll
        for (int m = 0; m < 4; ++m) rs[ai][m] = tab[ai * HALF + m * 16];
}
struct EpiP1 {
    static constexpr bool PERM = true, AFTER_DRAIN = false, HOOK = false; static constexpr int SEG1 = -1, SEG2 = -1;
    bf16_t* ZB; bf16_t* MIX; float* SM; const PG8_LAS unsigned char* rst; bf16_t* HALO;
    __device__ __forceinline__ void rescale(f32x4 (&)[2][2][4][2], const Unit&, int, int, int, int, int) const {}
    __device__ __forceinline__ void operator()(const f32x4 (&acc)[2][2][4][2], const Unit& u, int wr, int wc, int fr, int fq) const {
        const int row0 = u.pm * BM + wr * 64 + fr;
        float rs[2][4]; load_rstd(rst, u.pm, wr, fr, rs);
        if (u.pn == 21) {
            if (wc == 0) {
#pragma unroll
                for (int ai = 0; ai < 2; ++ai)
#pragma unroll
                    for (int m = 0; m < 4; ++m) { float* p = SM + (size_t)(row0 + ai * HALF + m * 16) * 32 + 8 * fq;
                        *(f32x4*)p = acc[ai][0][m][0] * rs[ai][m]; *(f32x4*)(p + 4) = acc[ai][0][m][1] * rs[ai][m]; }
            }
            return;
        }
        const bool mixt = u.pn >= 6;
        const int colt = mixt ? (u.pn - 6) * BM : u.pn * BM, col0 = colt + wc * 32 + 8 * fq;
#pragma unroll
        for (int ai = 0; ai < 2; ++ai)
#pragma unroll
            for (int m = 0; m < 4; ++m) { const size_t row = (size_t)(row0 + ai * HALF + m * 16);
#pragma unroll
                for (int bj = 0; bj < 2; ++bj) { const u32x4 w = pack8(acc[ai][bj][m][0] * rs[ai][m], acc[ai][bj][m][1] * rs[ai][m]);
                    *(u32x4*)(mixt ? MIX + mixh(col0 + bj * HALF, row) : ZB + row * 1536 + col0 + bj * HALF) = w;
                    if (m == 3 && fr >= 13 && u.pn >= 6 && u.pn < 15) *(u32x4*)(HALO + ((size_t)((row0 + ai * HALF + m * 16) >> 6) * 3 + (fr - 13)) * 2304 + col0 + bj * HALF) = w; } }
    }
};
template <int ACT> struct EpiRS {
    static constexpr bool PERM = true, AFTER_DRAIN = false, HOOK = false; static constexpr int SEG1 = -1, SEG2 = -1;
    bf16_t* O; int ldc; const PG8_LAS unsigned char* rst;
    __device__ __forceinline__ void rescale(f32x4 (&)[2][2][4][2], const Unit&, int, int, int, int, int) const {}
    __device__ __forceinline__ void operator()(const f32x4 (&acc)[2][2][4][2], const Unit& u, int wr, int wc, int fr, int fq) const {
        const int row0 = u.pm * BM + wr * 64 + fr, col0 = u.pn * BM + wc * 32 + 8 * fq;
        float rs[2][4]; load_rstd(rst, u.pm, wr, fr, rs);
#pragma unroll
        for (int ai = 0; ai < 2; ++ai)
#pragma unroll
            for (int m = 0; m < 4; ++m) { bf16_t* rowp = O + (size_t)(row0 + ai * HALF + m * 16) * ldc + col0;
#pragma unroll
                for (int bj = 0; bj < 2; ++bj) { f32x4 v0 = acc[ai][bj][m][0] * rs[ai][m], v1 = acc[ai][bj][m][1] * rs[ai][m];
                    if (ACT == 1) {
#pragma unroll
                        for (int j = 0; j < 4; ++j) { const float a = fmaxf(v0[j], 0.f), b = fmaxf(v1[j], 0.f); v0[j] = a * a; v1[j] = b * b; } }
                    if (ACT == 2) {
#pragma unroll
                        for (int j = 0; j < 4; ++j) { v0[j] = __builtin_amdgcn_rcpf(1.0f + __expf(-v0[j])); v1[j] = __builtin_amdgcn_rcpf(1.0f + __expf(-v1[j])); } }
                    *(u32x4*)(rowp + bj * HALF) = pack8(v0, v1); } }
    }
};
struct EpiMerge {
    static constexpr bool PERM = true, AFTER_DRAIN = false, HOOK = true; static constexpr int SEG1 = 8, SEG2 = 16;
    const bf16_t* GATE; bf16_t* O;
    __device__ __forceinline__ void rescale(f32x4 (&acc)[2][2][4][2], const Unit& u, int seg, int wr, int wc, int, int) const {
        int t_ = threadIdx.x; asm volatile("" : "+v"(t_)); const int fr = t_ & 15, fq = (t_ & 63) >> 4;
        const int row0 = u.pm * BM + wr * 64 + fr, col0 = u.pn * BM + wc * 32 + 8 * fq + (seg - 1) * 1024;
#pragma unroll
        for (int ai = 0; ai < 2; ++ai)
#pragma unroll
            for (int m = 0; m < 4; ++m) { const bf16_t* gp = GATE + (size_t)(row0 + ai * HALF + m * 16) * 3072 + col0;
#pragma unroll
                for (int bj = 0; bj < 2; ++bj) { const u32x4 wa = *(const u32x4*)(gp + bj * HALF), wb = *(const u32x4*)(gp + bj * HALF + 1024);
                    f32x4 a0, a1, b0, b1; unpack8(wa, a0, a1); unpack8(wb, b0, b1);
#pragma unroll
                    for (int j = 0; j < 4; ++j) {
                        acc[ai][bj][m][0][j] *= a0[j] * __builtin_amdgcn_rcpf(b0[j]);
                        acc[ai][bj][m][1][j] *= a1[j] * __builtin_amdgcn_rcpf(b1[j]); } }
                if (m == 3) asm volatile("" ::: "memory"); }
    }
    __device__ __forceinline__ void operator()(const f32x4 (&acc)[2][2][4][2], const Unit& u, int wr, int wc, int fr, int fq) const {
        const int row0 = u.pm * BM + wr * 64 + fr, col0 = u.pn * BM + wc * 32 + 8 * fq;
#pragma unroll
        for (int ai = 0; ai < 2; ++ai)
#pragma unroll
            for (int m = 0; m < 4; ++m) { const size_t r = (size_t)(row0 + ai * HALF + m * 16);
#pragma unroll
                for (int bj = 0; bj < 2; ++bj) { const u32x4 wa = *(const u32x4*)(GATE + r * 3072 + 2048 + col0 + bj * HALF);
                    f32x4 a0, a1; unpack8(wa, a0, a1); f32x4 v0 = acc[ai][bj][m][0], v1 = acc[ai][bj][m][1];
#pragma unroll
                    for (int j = 0; j < 4; ++j) { v0[j] *= a0[j]; v1[j] *= a1[j]; }
                    *(u32x4*)(O + r * 1024 + col0 + bj * HALF) = pack8(v0, v1); }
                if (m == 3) asm volatile("" ::: "memory"); }
    }
};
template <int MODE> struct EpiResid {
    static constexpr bool PERM = true, AFTER_DRAIN = false, HOOK = false; static constexpr int SEG1 = -1, SEG2 = -1;
    const bf16_t* XBin; bf16_t* XBout; float* ssq_out; const PG8_LAS unsigned char* rst; const bf16_t* PLE; float scale;
    __device__ __forceinline__ void rescale(f32x4 (&)[2][2][4][2], const Unit&, int, int, int, int, int) const {}
    __device__ __forceinline__ void operator()(const f32x4 (&acc)[2][2][4][2], const Unit& u, int wr, int wc, int fr, int fq) const {
        const int row0 = u.pm * BM + wr * 64 + fr, col0 = u.pn * BM + wc * 32 + 8 * fq;
        float rs[2][4]; if (MODE == 1) load_rstd(rst, u.pm, wr, fr, rs);
#pragma unroll
        for (int ai = 0; ai < 2; ++ai)
#pragma unroll
            for (int m = 0; m < 4; ++m) { const size_t r = (size_t)(row0 + ai * HALF + m * 16); float ss = 0.f;
#pragma unroll
                for (int bj = 0; bj < 2; ++bj) { const size_t o = r * 1024 + col0 + bj * HALF;
                    f32x4 v0 = acc[ai][bj][m][0], v1 = acc[ai][bj][m][1], b0, b1; unpack8(*(const u32x4*)(XBin + o), b0, b1);
                    if (MODE == 1) { const u32x4 wp = *(const u32x4*)(PLE + o); f32x4 p0, p1; unpack8(wp, p0, p1);
#pragma unroll
                        for (int j = 0; j < 4; ++j) { v0[j] = p0[j] * __builtin_amdgcn_rcpf(1.0f + __expf(-v0[j] * rs[ai][m])); v1[j] = p1[j] * __builtin_amdgcn_rcpf(1.0f + __expf(-v1[j] * rs[ai][m])); } }
                    v0 = v0 * scale + b0; v1 = v1 * scale + b1;
                    *(u32x4*)(XBout + o) = pack8(v0, v1);
                    ss += (v0[0] * v0[0] + v0[1] * v0[1]) + (v0[2] * v0[2] + v0[3] * v0[3]) + (v1[0] * v1[0] + v1[1] * v1[1]) + (v1[2] * v1[2] + v1[3] * v1[3]); }
                ss += __shfl_xor(ss, 16); ss += __shfl_xor(ss, 32);
                if (fq == 0) ssq_out[r * 16 + u.pn * 4 + wc] = ss;
                if (m == 3) asm volatile("" ::: "memory"); }
    }
};
template <class Epi, class Sched, bool ALIGN_EPI = false, bool SP2 = false>
__device__ __forceinline__ void gemm_phase(PG8_LAS unsigned char* lds, Gemm g, const Sched& S, const Epi& E) {
    asm volatile("" : "+s"(g.A), "+s"(g.Bt), "+s"(g.K));
    int tid_ = threadIdx.x; asm volatile("" : "+v"(tid_));
    const int tid = tid_, wid = __builtin_amdgcn_readfirstlane(tid >> 6), lane = tid & 63, wr = wid >> 2, wc = wid & 3, fr = lane & 15, fq = lane >> 4;
    const int K = g.K, nt = K / BK;
    unsigned voffA[2], voffB[2];
#pragma unroll
    for (int i = 0; i < 2; ++i) { int R, C; stage_rc(tid * 16 + i * 8192, R, C); const int Rb = Epi::PERM ? ((R & ~31) + perm32(R & 31)) : R;
        voffA[i] = (unsigned)(R * K + C) * 2u; voffB[i] = (unsigned)(Rb * K + C) * 2u; }
    const size_t kstep = (size_t)(BK * 2);
    const size_t hstep = (size_t)HALF * K * 2;
    const size_t tstep = 2 * hstep;
    const unsigned ldsw = (unsigned)wid * 1024u;
    const int aoff = lds_byte(wr * 64 + fr, fq * 8), boff = lds_byte(wc * 32 + fr, fq * 8);
#define PG8_SA(b, h) (((b) * 2 + (h)) * HTB)
#define PG8_SB(b, h) ((4 + (b) * 2 + (h)) * HTB)
#define PG8_STAGE(bufoff, gbase, voff) do { _Pragma("unroll") for (int _i = 0; _i < 2; ++_i) \
        __builtin_amdgcn_global_load_lds((const unsigned*)((const char*)(gbase) + (voff)[_i]), (PG8_LAS unsigned*)(lds + (bufoff) + ldsw + _i * 8192), 16, 0, 0); } while (0)
#define PG8_LDA(dst, b, h) do { _Pragma("unroll") for (int m = 0; m < 4; ++m) _Pragma("unroll") for (int k = 0; k < 2; ++k) dst[m][k] = *(const PG8_LAS bf16x8*)(lds + PG8_SA(b, h) + aoff + m * 2048 + k * 1024); } while (0)
#define PG8_LDB(dst, b, h) do { _Pragma("unroll") for (int n = 0; n < 2; ++n) _Pragma("unroll") for (int k = 0; k < 2; ++k) dst[n][k] = *(const PG8_LAS bf16x8*)(lds + PG8_SB(b, h) + boff + n * 2048 + k * 1024); } while (0)
#define PG8_MMA(ai, bj, At, Bt) do { __builtin_amdgcn_s_setprio(1); _Pragma("unroll") for (int m = 0; m < 4; ++m) _Pragma("unroll") for (int n = 0; n < 2; ++n) _Pragma("unroll") for (int k = 0; k < 2; ++k) \
        acc[ai][bj][m][n] = __builtin_amdgcn_mfma_f32_16x16x32_bf16(Bt[n][k], At[m][k], acc[ai][bj][m][n], 0, 0, 0); __builtin_amdgcn_s_setprio(0); } while (0)
#define PG8_WAIT_V(n) asm volatile("s_waitcnt vmcnt(" #n ")" ::: "memory")
#define PG8_WAIT_L(n) asm volatile("s_waitcnt lgkmcnt(" #n ")" ::: "memory")
#define PG8_BAR __builtin_amdgcn_s_barrier()
#define PG8_SCHED __builtin_amdgcn_sched_barrier(0)
    Unit cur, nxt; int ui = 0;
    if (!S.next(0, cur)) return;
    f32x4 acc[2][2][4][2];
#pragma unroll
    for (int a = 0; a < 2; ++a)
#pragma unroll
        for (int b = 0; b < 2; ++b)
#pragma unroll
            for (int m = 0; m < 4; ++m)
#pragma unroll
                for (int n = 0; n < 2; ++n) acc[a][b][m][n] = (f32x4){0.f, 0.f, 0.f, 0.f};
    bf16x8 At[4][2], B0[2][2], B1[2][2];
    const char* cA = (const char*)g.A + (size_t)cur.pm * tstep; const char* cB = (const char*)g.Bt + (size_t)cur.pn * tstep;
    S.a_ready(cur);
    if constexpr (SP2) {
        PG8_STAGE(PG8_SB(0, 0), cB, voffB); PG8_STAGE(PG8_SB(0, 1), cB + hstep, voffB); PG8_STAGE(PG8_SA(0, 0), cA, voffA); PG8_STAGE(PG8_SA(0, 1), cA + hstep, voffA);
        if (wr == 1) PG8_BAR;
        PG8_WAIT_V(2); PG8_BAR;
        PG8_STAGE(PG8_SB(1, 0), cB + kstep, voffB); PG8_STAGE(PG8_SA(1, 0), cA + kstep, voffA); PG8_STAGE(PG8_SB(1, 1), cB + hstep + kstep, voffB);
        PG8_WAIT_V(6); PG8_BAR;
    } else {
        PG8_STAGE(PG8_SB(0, 0), cB, voffB); PG8_STAGE(PG8_SA(0, 0), cA, voffA); PG8_STAGE(PG8_SB(0, 1), cB + hstep, voffB); PG8_STAGE(PG8_SA(0, 1), cA + hstep, voffA);
        if (wr == 1) PG8_BAR;
        PG8_WAIT_V(4); PG8_BAR;
        PG8_STAGE(PG8_SB(1, 0), cB + kstep, voffB); PG8_STAGE(PG8_SA(1, 0), cA + kstep, voffA); PG8_STAGE(PG8_SB(1, 1), cB + hstep + kstep, voffB);
        PG8_WAIT_V(6); PG8_BAR;
    }
    for (;;) {
        const bool has_next = S.next(ui + 1, nxt);
        const char* nA = has_next ? (const char*)g.A + (size_t)nxt.pm * tstep : cA; const char* nB = has_next ? (const char*)g.Bt + (size_t)nxt.pn * tstep : cB;
        for (int t = 0; t < nt; t += 2) {
            const bool last = (t == nt - 2);
            const char* a1 = cA + (size_t)(t + 1) * kstep;
            const char* a2 = last ? nA : cA + (size_t)(t + 2) * kstep; const char* b2 = last ? nB : cB + (size_t)(t + 2) * kstep;
            const char* a3 = a2 + kstep; const char* b3 = b2 + kstep;
            if (last && has_next) S.a_ready(nxt);
            if constexpr (Epi::HOOK) { if (t == Epi::SEG1 || t == Epi::SEG2) E.rescale(acc, cur, t == Epi::SEG1 ? 1 : 2, wr, wc, fr, fq); }
            if constexpr (SP2) {
            PG8_LDB(B0, 0, 0); PG8_LDB(B1, 0, 1); PG8_SCHED; PG8_LDA(At, 0, 0); PG8_STAGE(PG8_SA(1, 1), a1 + hstep, voffA);
            PG8_WAIT_V(8); PG8_WAIT_L(0); PG8_BAR; PG8_MMA(0, 0, At, B0); PG8_MMA(0, 1, At, B1); PG8_BAR; PG8_SCHED;
            PG8_LDA(At, 0, 1); PG8_STAGE(PG8_SB(0, 0), b2, voffB); PG8_STAGE(PG8_SB(0, 1), b2 + hstep, voffB); PG8_STAGE(PG8_SA(0, 0), a2, voffA);
            PG8_WAIT_V(8); PG8_WAIT_L(0); PG8_BAR; PG8_MMA(1, 0, At, B0); PG8_MMA(1, 1, At, B1); PG8_BAR; PG8_SCHED;
            PG8_LDB(B0, 1, 0); PG8_LDB(B1, 1, 1); PG8_SCHED; PG8_LDA(At, 1, 0); PG8_STAGE(PG8_SA(0, 1), a2 + hstep, voffA);
            PG8_WAIT_V(8); PG8_WAIT_L(0); PG8_BAR; PG8_MMA(0, 0, At, B0); PG8_MMA(0, 1, At, B1); PG8_BAR; PG8_SCHED;
            PG8_LDA(At, 1, 1); PG8_STAGE(PG8_SB(1, 0), b3, voffB); PG8_STAGE(PG8_SB(1, 1), b3 + hstep, voffB); PG8_STAGE(PG8_SA(1, 0), a3, voffA);
            PG8_WAIT_V(8); PG8_WAIT_L(0); PG8_BAR; PG8_MMA(1, 0, At, B0); PG8_MMA(1, 1, At, B1); PG8_BAR; PG8_SCHED;
            } else {
            PG8_LDB(B0, 0, 0); PG8_SCHED; PG8_LDA(At, 0, 0); PG8_STAGE(PG8_SA(1, 1), a1 + hstep, voffA);
            PG8_WAIT_L(8); PG8_BAR; PG8_WAIT_L(0); PG8_MMA(0, 0, At, B0); PG8_BAR; PG8_SCHED;
            PG8_LDB(B1, 0, 1); PG8_STAGE(PG8_SB(0, 0), b2, voffB);
            PG8_BAR; PG8_WAIT_L(0); PG8_MMA(0, 1, At, B1); PG8_BAR;
            PG8_LDA(At, 0, 1); PG8_STAGE(PG8_SA(0, 0), a2, voffA);
            PG8_BAR; PG8_WAIT_L(0); PG8_MMA(1, 0, At, B0); PG8_BAR; PG8_SCHED;
            PG8_STAGE(PG8_SB(0, 1), b2 + hstep, voffB);
            PG8_WAIT_V(6); PG8_BAR; PG8_MMA(1, 1, At, B1); PG8_BAR;
            PG8_LDB(B0, 1, 0); PG8_SCHED; PG8_LDA(At, 1, 0); PG8_STAGE(PG8_SA(0, 1), a2 + hstep, voffA);
            PG8_WAIT_L(8); PG8_BAR; PG8_WAIT_L(0); PG8_MMA(0, 0, At, B0); PG8_BAR; PG8_SCHED;
            PG8_LDB(B1, 1, 1); PG8_STAGE(PG8_SB(1, 0), b3, voffB);
            PG8_BAR; PG8_WAIT_L(0); PG8_MMA(0, 1, At, B1); PG8_BAR;
            PG8_LDA(At, 1, 1); PG8_STAGE(PG8_SA(1, 0), a3, voffA);
            PG8_BAR; PG8_WAIT_L(0); PG8_MMA(1, 0, At, B0); PG8_BAR; PG8_SCHED;
            PG8_STAGE(PG8_SB(1, 1), b3 + hstep, voffB);
            PG8_WAIT_V(6); PG8_BAR; PG8_MMA(1, 1, At, B1); PG8_BAR;
            }
        }
        if constexpr (ALIGN_EPI) { if (wr == 0) PG8_BAR; }
        if constexpr (!Epi::AFTER_DRAIN) { int t2_ = threadIdx.x; asm volatile("" : "+v"(t2_)); E(acc, cur, wr, wc, t2_ & 15, (t2_ & 63) >> 4); S.done(cur); }
        if (!has_next) break;
#pragma unroll
        for (int a = 0; a < 2; ++a)
#pragma unroll
            for (int b = 0; b < 2; ++b)
#pragma unroll
                for (int m = 0; m < 4; ++m)
#pragma unroll
                    for (int n = 0; n < 2; ++n) acc[a][b][m][n] = (f32x4){0.f, 0.f, 0.f, 0.f};
        cur = nxt; cA = nA; cB = nB; ++ui;
        if constexpr (ALIGN_EPI) { if (wr == 1) PG8_BAR; }
    }
    PG8_WAIT_V(0);
    if constexpr (!ALIGN_EPI) { if (wr == 0) PG8_BAR; }
    PG8_BAR;
    if constexpr (Epi::AFTER_DRAIN) { E.fused(acc, cur, wr, wc, fr, fq, lds, wid, lane); S.done(cur); }
#undef PG8_SA
#undef PG8_SB
#undef PG8_STAGE
#undef PG8_LDA
#undef PG8_LDB
#undef PG8_MMA
#undef PG8_WAIT_V
#undef PG8_WAIT_L
#undef PG8_BAR
#undef PG8_SCHED
}
}
constexpr int DM = 1024, NBATCH = 8, SEQ = 4096, MTOK = NBATCH * SEQ, DEPTH = 2, DFF = 4096, PLED = 256, NIN = 8472;
constexpr int ZB_LD = 1536, MIX_LD = 3840, SM_LD = 32, N1 = 5632, NGATE = 3072, KMERGE = 1536;
constexpr int MX_AQ = 0, MX_AK = 512, MX_AV = 1024, MX_BX = 1536, MX_BB = 2048, MX_BC = 2176, MX_CQ = 2304, MX_CK = 2816, MX_CV = 3328;
constexpr size_t KiB = 1024, MiB = 1024 * 1024;
constexpr size_t WS_CTL = 0, CTL_BYTES = 64 * KiB;
constexpr size_t WS_W = 64 * KiB;
constexpr size_t W_1T = WS_W, W_GT = W_1T + (size_t)N1 * DM * 2, W_MT = W_GT + (size_t)NGATE * DM * 2, W_OT = W_MT + (size_t)DM * KMERGE * 2, W_UT = W_OT + (size_t)DM * DM * 2,
                 W_DT = W_UT + (size_t)DFF * DM * 2, W_PGT = W_DT + (size_t)DM * DFF * 2, W_PPT = W_PGT + (size_t)DM * DM * 2, W_END = W_PPT + (size_t)DM * PLED * 2;
constexpr size_t WS_SSQA = W_1T + 1 * MiB, WS_SSQB = W_1T + 3 * MiB;
constexpr size_t WS_XB0 = W_END, WS_XB1 = WS_XB0 + 64 * MiB, WS_ZB = WS_XB1 + 64 * MiB, WS_MIX = WS_ZB + 96 * MiB, WS_SM = WS_MIX + 240 * MiB, WS_SSQC = WS_SM + 4 * MiB, WS_ROPE = WS_SSQC + 2 * MiB, WS_END = WS_ROPE + 1 * MiB;
constexpr size_t WS_PB = WS_ZB, WS_PLE = WS_ZB + 16 * MiB, WS_U = WS_ZB + 80 * MiB, WS_GATE = WS_MIX;
static_assert(W_END == WS_W + (size_t)(40 * MiB + 512 * KiB), "weights");
static_assert(WS_U + (size_t)MTOK * DFF * 2 == WS_SM, "U overlay");
static_assert(WS_END <= 512 * MiB, "workspace");
constexpr int LDS_BYTES = 147456, RING_BYTES = 131072, MISC_OFF = RING_BYTES + 320, RS_OFF = RING_BYTES + 1024;
static_assert(RS_OFF + 32 + pg8::RS_SLOTS * 1024 <= LDS_BYTES, "LDS map");

#define GAS __attribute__((address_space(1)))
#define LAS __attribute__((address_space(3)))
typedef unsigned short bf16;
typedef unsigned v4u __attribute__((ext_vector_type(4)));
typedef unsigned v2u __attribute__((ext_vector_type(2)));
typedef float f32x4 __attribute__((ext_vector_type(4)));
#define LDS_WAIT() asm volatile("s_waitcnt lgkmcnt(0)" ::: "memory")
typedef float f32x2_t __attribute__((ext_vector_type(2))); typedef __bf16 bf16x2_t __attribute__((ext_vector_type(2)));
__device__ __forceinline__ unsigned pk2(float lo, float hi) { f32x2_t v = {lo, hi}; bf16x2_t b = __builtin_convertvector(v, bf16x2_t); return __builtin_bit_cast(unsigned, b); }
__device__ __forceinline__ unsigned f2bf(float f) { return pk2(f, 0.f) & 0xffffu; }
__device__ __forceinline__ float bf2f(bf16 v) { return __uint_as_float((unsigned)v << 16); }
__device__ __forceinline__ float wave_sum(float v) {
#pragma unroll
    for (int o = 1; o < 64; o <<= 1) v += __shfl_xor(v, o);
    return v;
}
__device__ __forceinline__ float siluf(float x) { return x * __builtin_amdgcn_rcpf(1.0f + __expf(-x)); }
__device__ __forceinline__ float sigmf(float x) { return __builtin_amdgcn_rcpf(1.0f + __expf(-x)); }
__device__ __forceinline__ float softplusf(float x) { return fmaxf(x, 0.f) + log1pf(__expf(-fabsf(x))); }
__device__ __forceinline__ float rdl(float v, int l) { return __int_as_float(__builtin_amdgcn_readlane(__float_as_int(v), l)); }

#define XB_TMO      128
#define XB_XCNT(j)  (256  + 64 * (j))
#define XB_XSUB(j)  (1280 + 64 * (j))
#define XB_XGEN(j)  (2304 + 64 * (j))
#define XB_TOP      3328
#define XB_TOPGEN   3392
#define XCD_BAR_WORDS 3456
#define XB_SPIN_CAP (1u << 18)
__device__ __forceinline__ unsigned xb_ld(unsigned* p)              { return __hip_atomic_load(p, __ATOMIC_RELAXED, __HIP_MEMORY_SCOPE_AGENT); }
__device__ __forceinline__ unsigned xb_add(unsigned* p, unsigned v) { return __hip_atomic_fetch_add(p, v, __ATOMIC_RELAXED, __HIP_MEMORY_SCOPE_AGENT); }
__device__ __forceinline__ unsigned xb_xcc_id() { return (unsigned)__builtin_amdgcn_s_getreg((3 << 11) | 20) & 0xFu; }
#define XB_SPIN(cond, bar) do { unsigned _sp = 0; while (cond) { __builtin_amdgcn_s_sleep(1); \
    if ((++_sp & 255u) == 0u) { if (xb_ld(&(bar)[XB_TMO])) break; if (_sp > XB_SPIN_CAP) { atomicAdd(&(bar)[XB_TMO], 1u); break; } } } } while (0)
struct XcdBarrier { unsigned* bar; unsigned x; volatile LAS unsigned* st; };
__device__ __forceinline__ XcdBarrier xcd_barrier_post(unsigned* bar, volatile LAS unsigned* st) {
    XcdBarrier b; b.bar = bar; b.x = xb_xcc_id(); b.st = st;
    if (threadIdx.x == 0) (void)xb_add(&bar[XB_XCNT(b.x)], 1u);
    return b;
}
__device__ __forceinline__ void xcd_barrier_complete(unsigned* bar, unsigned x, unsigned& nloc, unsigned& nx) {
    const unsigned G = gridDim.x * gridDim.y * gridDim.z;
    unsigned sum, cnt, mine, sp = 0u;
    for (;;) {
        sum = 0u; cnt = 0u; mine = 0u;
#pragma unroll
        for (unsigned j = 0; j < 16; ++j) { const unsigned c = xb_ld(&bar[XB_XCNT(j)]); sum += c; cnt += (c > 0u) ? 1u : 0u; mine = (j == x) ? c : mine; }
        if (sum == G) break;
        __builtin_amdgcn_s_sleep(1);
        if ((++sp & 255u) == 0u) { if (xb_ld(&bar[XB_TMO])) break; if (sp > XB_SPIN_CAP) { atomicAdd(&bar[XB_TMO], 1u); break; } }
    }
    nloc = mine > 0u ? mine : 1u; nx = cnt > 0u ? cnt : 1u;
}
__device__ __forceinline__ void xcd_barrier(const XcdBarrier& b) {
    asm volatile("s_waitcnt vmcnt(0)" ::: "memory");
    __syncthreads();
    if (threadIdx.x == 0) {
        unsigned* bar = b.bar;
        __builtin_amdgcn_s_waitcnt(0);
        unsigned nloc = b.st[0], nx = b.st[1];
        if (nloc == 0u) { xcd_barrier_complete(bar, b.x, nloc, nx); b.st[0] = nloc; b.st[1] = nx; }
        const unsigned old = xb_add(&bar[XB_XSUB(b.x)], 1u);
        const unsigned gen = old / nloc;
        if (old + 1u == (gen + 1u) * nloc) {
            __builtin_amdgcn_fence(__ATOMIC_RELEASE, "agent");
            asm volatile("s_waitcnt vmcnt(0)" ::: "memory");
            const unsigned og = xb_add(&bar[XB_TOP], 1u);
            const unsigned tg = og / nx;
            if (og + 1u == (tg + 1u) * nx) xb_add(&bar[XB_TOPGEN], 1u);
            else XB_SPIN(xb_ld(&bar[XB_TOPGEN]) == tg, bar);
            __builtin_amdgcn_fence(__ATOMIC_ACQUIRE, "agent");
            xb_add(&bar[XB_XGEN(b.x)], 1u);
            asm volatile("s_waitcnt vmcnt(0)" ::: "memory");
        } else {
            XB_SPIN(xb_ld(&bar[XB_XGEN(b.x)]) == gen, bar);
            __builtin_amdgcn_fence(__ATOMIC_ACQUIRE, "agent");
            asm volatile("s_waitcnt vmcnt(0)" ::: "memory");
        }
    }
    __syncthreads();
}

__device__ __forceinline__ void tr_item(const float* W, int ldw, int c0, int ncols, const float* scale, bf16* dst, int ldd, int r0, int kofs, LAS unsigned char* lds, int item, int tid) {
    const int lane = tid & 63, wave = __builtin_amdgcn_readfirstlane(tid >> 6);
    const int nblk = (ncols + 255) / 256, kb = item / nblk, nb = item - kb * nblk, k0 = 64 * kb, n0 = 256 * nb;
    asm volatile("s_waitcnt lgkmcnt(0)\n\ts_barrier" ::: "memory");
    float v[8][4];
    const int n = n0 + 4 * lane;
    const bool vec = W != nullptr && ((c0 | ldw) & 3) == 0 && n + 3 < ncols;
    const float* wp = W + (size_t)(k0 + 8 * wave) * ldw + c0 + n;
#pragma unroll
    for (int kk = 0; kk < 8; ++kk) {
        if (vec) { const f32x4 t = *(const GAS f32x4*)(wp + (size_t)kk * ldw); v[kk][0] = t[0]; v[kk][1] = t[1]; v[kk][2] = t[2]; v[kk][3] = t[3]; }
        else {
#pragma unroll
            for (int q = 0; q < 4; ++q) v[kk][q] = (W != nullptr && n + q < ncols) ? wp[(size_t)kk * ldw + q] : 0.f; }
        if (scale) { const float s = scale[k0 + 8 * wave + kk];
#pragma unroll
            for (int q = 0; q < 4; ++q) v[kk][q] *= s; } }
#pragma unroll
    for (int q = 0; q < 4; ++q) { v4u o; o.x = pk2(v[0][q], v[1][q]); o.y = pk2(v[2][q], v[3][q]); o.z = pk2(v[4][q], v[5][q]); o.w = pk2(v[6][q], v[7][q]);
        *(LAS v4u*)(lds + (4 * lane + q) * 128 + ((wave ^ (lane & 7)) << 4)) = o; }
    asm volatile("s_waitcnt lgkmcnt(0)\n\ts_barrier" ::: "memory");
#pragma unroll
    for (int i = 0; i < 4; ++i) { const int nl = (tid >> 3) + 64 * i, ch = tid & 7;
        if (n0 + nl < ncols) *(GAS v4u*)(dst + (size_t)(r0 + n0 + nl) * ldd + kofs + k0 + ch * 8) = *(const LAS v4u*)(lds + nl * 128 + ((ch ^ ((nl >> 2) & 7)) << 4)); }
}
#define TR_SEG(W_, ldw_, c0_, ncols_, K_, scale_, dst_, ldd_, r0_, kofs_) do { const int _n = ((K_) / 64) * (((ncols_) + 255) / 256); \
    for (int _it = (bx + G - (ibase % G)) % G; _it < _n; _it += G) tr_item(W_, ldw_, c0_, ncols_, scale_, dst_, ldd_, r0_, kofs_, lds, _it, tid); ibase += _n; } while (0)

__device__ __forceinline__ void build_rs_table(const pg8::StaticOrder& S, const float* ssqp, LAS unsigned char* lds, int tid) {
    LAS int* pml = (LAS int*)(lds + RS_OFF); LAS float* tab = (LAS float*)(lds + RS_OFF + 32);
    __syncthreads();
    if (tid == 0) { int npm = 0;
        for (int k = 0; k < pg8::RS_SLOTS; ++k) pml[k] = -1;
        for (int i = 0; ; ++i) { pg8::Unit u; if (!S.next(i, u)) break; bool found = false;
            for (int k = 0; k < npm; ++k) found = found || (pml[k] == u.pm);
            if (!found && npm < pg8::RS_SLOTS) pml[npm++] = u.pm; } }
    __syncthreads();
#pragma unroll 1
    for (int s = tid >> 8; s < pg8::RS_SLOTS; s += 2) { const int pm = pml[s]; if (pm < 0) continue;
        const float* p = ssqp + ((size_t)pm * 256 + (tid & 255)) * 16;
        const f32x4 a = *(const f32x4*)p, b = *(const f32x4*)(p + 4), c = *(const f32x4*)(p + 8), d = *(const f32x4*)(p + 12);
        const float ss = ((a[0] + a[1]) + (a[2] + a[3])) + ((b[0] + b[1]) + (b[2] + b[3])) + ((c[0] + c[1]) + (c[2] + c[3])) + ((d[0] + d[1]) + (d[2] + d[3]));
        tab[s * 256 + (tid & 255)] = rsqrtf(ss * (1.0f / 1024.0f) + 1e-6f); }
    __syncthreads();
}
struct Args { const float* in[23]; float* out; unsigned char* ws; int ph_lo, ph_hi; };
constexpr int NPH = 10, PH_FINAL = DEPTH * NPH, N_PHASES = PH_FINAL + 1;

typedef short bf16x8 __attribute__((ext_vector_type(8)));
constexpr int PT = 72, MAT = 64 * PT * 2;
constexpr int SETB = 4 * MAT + 512;
constexpr int L_Q = 0, L_K = MAT, L_V = 2 * MAT, L_U = 2 * MAT, L_W = 3 * MAT, L_G = 4 * MAT, L_DT = 4 * MAT + 256;
constexpr int L_VT = 2 * SETB, L_ST0 = L_VT + MAT, L_ST1 = L_ST0 + MAT, L_PP = L_ST1 + MAT, L_YT = L_PP + MAT, L_WEND = L_YT + 2 * MAT;
static_assert(L_WEND <= RING_BYTES, "walker LDS");
constexpr size_t GW_OFF = 0, HALO_OFF = 32 * MiB;
constexpr int HALO_LD = 2304;
#define MFMA16(a, b, c) __builtin_amdgcn_mfma_f32_16x16x32_bf16(a, b, c, 0, 0, 0)
__device__ __forceinline__ bf16x8 ldfrag(LAS unsigned char* base, int row, int kelem) { return *(const LAS bf16x8*)(base + row * (PT * 2) + kelem * 2); }
__device__ __forceinline__ void unpk8(const v4u w, float (&f)[8]) { f[0] = pg8::bflo(w.x); f[1] = pg8::bfhi(w.x); f[2] = pg8::bflo(w.y); f[3] = pg8::bfhi(w.y); f[4] = pg8::bflo(w.z); f[5] = pg8::bfhi(w.z); f[6] = pg8::bflo(w.w); f[7] = pg8::bfhi(w.w); }
__device__ __forceinline__ v4u pk8(const float (&f)[8]) { v4u w; w.x = pk2(f[0], f[1]); w.y = pk2(f[2], f[3]); w.z = pk2(f[4], f[5]); w.w = pk2(f[6], f[7]); return w; }
__device__ __forceinline__ void st_tr8(LAS unsigned char* base, int row0, int col, const float (&f)[8]) {
#pragma unroll
    for (int j = 0; j < 8; ++j) *(LAS bf16*)(base + (row0 + j) * (PT * 2) + col * 2) = (bf16)f2bf(f[j]);
}

#define LBAR() asm volatile("s_waitcnt lgkmcnt(0)\n\ts_barrier" ::: "memory")
typedef short s16x4 __attribute__((ext_vector_type(4)));
__device__ __forceinline__ s16x4 tr4(LAS unsigned char* p) { return __builtin_bit_cast(s16x4, __builtin_amdgcn_ds_read_tr16_b64_v4i16((LAS s16x4*)p)); }
__device__ __forceinline__ bf16x8 trfrag(LAS unsigned char* tile, int krow0, int col0, int fr) {
    LAS unsigned char* a = tile + (krow0 + (fr >> 2)) * (PT * 2) + (col0 + 4 * (fr & 3)) * 2;
    const s16x4 lo = tr4(a), hi = tr4(a + 4 * PT * 2);
    return (bf16x8){lo[0], lo[1], lo[2], lo[3], hi[0], hi[1], hi[2], hi[3]};
}
__device__ __forceinline__ float bfs(short v) { return __uint_as_float((unsigned)(unsigned short)v << 16); }

template <int KIND>
__device__ __forceinline__ void mixer_walk(const __attribute__((address_space(4))) Args* kp, int layer, int b, int h, LAS unsigned char* lds) {
    int tid = threadIdx.x; asm volatile("" : "+v"(tid));
    const int lane = tid & 63, wave = __builtin_amdgcn_readfirstlane(tid >> 6), fr = lane & 15, fq = lane >> 4;
    const int prow = tid >> 3, pcg = tid & 7;
    unsigned char* ws = kp->ws;
    const bf16* MIX = (const bf16*)(ws + WS_MIX); bf16* ZB = (bf16*)(ws + WS_ZB); float* SM = (float*)(ws + WS_SM);
    const bf16* GW = (const bf16*)(ws + ((layer & 1) ? WS_XB0 : WS_XB1) + GW_OFF);
    const size_t tok0 = (size_t)b * SEQ;
    const int g = h >> 2;
    const int qcol = (KIND == 0 ? MX_AQ + h * 64 : (KIND == 1 ? MX_BC + g * 64 : MX_CQ + h * 64)) + pcg * 8;
    const int kcol = (KIND == 0 ? MX_AK + h * 64 : (KIND == 1 ? MX_BB + g * 64 : MX_CK + h * 64)) + pcg * 8;
    const int vcol = (KIND == 0 ? MX_AV + h * 64 : (KIND == 1 ? MX_BX + h * 64 : MX_CV + h * 64)) + pcg * 8;
    const int zcol = KIND * 512 + h * 64 + pcg * 8;
    const int gcol = (KIND == 0 ? 8 : 16) + h;
    float nw[8];
    if (KIND == 0) {
#pragma unroll
        for (int j = 0; j < 8; ++j) nw[j] = kp->in[7][layer * 64 + pcg * 8 + j];
    }
    const float p_D = KIND == 1 ? kp->in[12][layer * 8 + h] : 0.f;
    const float p_lg = KIND == 2 ? log1pf(-exp2f(-5.0f - (float)h)) : 0.f;
    for (int i = tid; i < MAT / 4; i += 512) ((LAS unsigned*)(lds + L_ST0))[i] = 0u;
    pg8::f32x4 sacc[4];
#pragma unroll
    for (int i = 0; i < 4; ++i) sacc[i] = (pg8::f32x4){0.f, 0.f, 0.f, 0.f};
    LAS unsigned char* PPw = lds + L_PP + (wave & 3) * (16 * PT * 2);

    v4u tq, tk, tv, tw, tz; float sg = 0.f, sd = 1.f; (void)tw;
#define WALK_LOAD(c) do { const size_t row = tok0 + (size_t)(c) * 64 + prow; \
        tq = *(const GAS v4u*)(MIX + mixh(qcol, row)); tk = *(const GAS v4u*)(MIX + mixh(kcol, row)); tv = *(const GAS v4u*)(MIX + mixh(vcol, row)); \
        if (KIND == 0) tw = *(const GAS v4u*)(GW + gwh(h, pcg * 8, row)); \
        tz = *(const GAS v4u*)(ZB + row * ZB_LD + zcol); \
        if (tid < 64) { const size_t r2 = tok0 + (size_t)(c) * 64 + tid; \
            if (KIND == 2) sg = (float)(tid + 1) * p_lg; else sg = SM[r2 * SM_LD + gcol]; \
            if (KIND == 1) sd = SM[r2 * SM_LD + 24 + h]; } } while (0)
#define WALK_PREP(sb_) do { LAS unsigned char* sp_ = lds + (sb_) * SETB; \
        *(LAS v4u*)(sp_ + L_Q + prow * (PT * 2) + pcg * 16) = tq; *(LAS v4u*)(sp_ + L_K + prow * (PT * 2) + pcg * 16) = tk; \
        *(LAS v4u*)(sp_ + L_V + prow * (PT * 2) + pcg * 16) = tv; \
        if (KIND == 0) *(LAS v4u*)(sp_ + L_W + prow * (PT * 2) + pcg * 16) = tw; \
        if (tid < 64) { ((LAS float*)(sp_ + L_G))[tid] = sg; ((LAS float*)(sp_ + L_DT))[tid] = sd; } } while (0)

    WALK_LOAD(0);
    WALK_PREP(0);
    v4u zc = tz, xc = tv;
    LBAR();
    for (int c = 0; c < SEQ / 64; ++c) {
        LAS unsigned char* STc = lds + ((c & 1) ? L_ST1 : L_ST0); LAS unsigned char* STn = lds + ((c & 1) ? L_ST0 : L_ST1);
        LAS unsigned char* sp = lds + (c & 1) * SETB;
        const LAS float* Gv = (const LAS float*)(sp + L_G); const LAS float* Dv = (const LAS float*)(sp + L_DT);
        LAS unsigned char* YTc = lds + L_YT + (c & 1) * MAT;
        if (c + 1 < SEQ / 64) WALK_LOAD(c + 1);
        bf16x8 Qf[2];
        if (wave < 4) { const int lb = wave;
            Qf[0] = ldfrag(sp + L_Q, 16 * lb + fr, 8 * fq); Qf[1] = ldfrag(sp + L_Q, 16 * lb + fr, 32 + 8 * fq);
            bf16x8 Kb[4][2]; pg8::f32x4 gs[4], ds[4], pacc[4];
#pragma unroll
            for (int sb = 0; sb < 4; ++sb) if (sb <= lb) { Kb[sb][0] = ldfrag(sp + L_K, 16 * sb + fr, 8 * fq); Kb[sb][1] = ldfrag(sp + L_K, 16 * sb + fr, 32 + 8 * fq);
                gs[sb] = *(const LAS pg8::f32x4*)(Gv + 16 * sb + 4 * fq); ds[sb] = (pg8::f32x4){1.f, 1.f, 1.f, 1.f};
                if (KIND == 1) ds[sb] = *(const LAS pg8::f32x4*)(Dv + 16 * sb + 4 * fq); }
            const float gl = Gv[16 * lb + fr];
#pragma unroll
            for (int sb = 0; sb < 4; ++sb) if (sb <= lb) { pacc[sb] = MFMA16(Kb[sb][0], Qf[0], ((pg8::f32x4){0.f, 0.f, 0.f, 0.f})); }
#pragma unroll
            for (int sb = 0; sb < 4; ++sb) if (sb <= lb) { pacc[sb] = MFMA16(Kb[sb][1], Qf[1], pacc[sb]); }
#pragma unroll
            for (int sb = 0; sb < 4; ++sb) { v2u o; o.x = 0u; o.y = 0u;
                if (sb <= lb) { float pv[4];
#pragma unroll
                    for (int r = 0; r < 4; ++r) pv[r] = (16 * sb + 4 * fq + r <= 16 * lb + fr) ? pacc[sb][r] * __expf(gl - gs[sb][r]) * ds[sb][r] : 0.f;
                    o.x = pk2(pv[0], pv[1]); o.y = pk2(pv[2], pv[3]); }
                *(LAS v2u*)(PPw + fr * (PT * 2) + (16 * sb + 4 * fq) * 2) = o; }
        } else if (KIND == 0) { const int wq = wave - 4;
            const bf16x8 Wf0 = ldfrag(sp + L_W, 16 * wq + fr, 8 * fq), Wf1 = ldfrag(sp + L_W, 16 * wq + fr, 32 + 8 * fq);
            bf16x8 Sf[4][2]; s16x4 u4[4]; pg8::f32x4 vacc[4];
#pragma unroll
            for (int eb = 0; eb < 4; ++eb) { Sf[eb][0] = ldfrag(STc, 16 * eb + fr, 8 * fq); Sf[eb][1] = ldfrag(STc, 16 * eb + fr, 32 + 8 * fq);
                u4[eb] = tr4(sp + L_U + (16 * wq + 4 * fq + (fr >> 2)) * (PT * 2) + (16 * eb + 4 * (fr & 3)) * 2); }
#pragma unroll
            for (int eb = 0; eb < 4; ++eb) vacc[eb] = MFMA16(Wf0, Sf[eb][0], ((pg8::f32x4){0.f, 0.f, 0.f, 0.f}));
#pragma unroll
            for (int eb = 0; eb < 4; ++eb) vacc[eb] = MFMA16(Wf1, Sf[eb][1], vacc[eb]);
#pragma unroll
            for (int eb = 0; eb < 4; ++eb) { v2u o; o.x = pk2(bfs(u4[eb][0]) - vacc[eb][0], bfs(u4[eb][1]) - vacc[eb][1]); o.y = pk2(bfs(u4[eb][2]) - vacc[eb][2], bfs(u4[eb][3]) - vacc[eb][3]);
                *(LAS v2u*)(lds + L_VT + (16 * eb + fr) * (PT * 2) + (16 * wq + 4 * fq) * 2) = o; }
        }
        if (KIND == 0) LBAR();
        if (wave < 4) { const int lb = wave;
            const bf16x8 Pf0 = ldfrag(PPw, fr, 8 * fq), Pf1 = ldfrag(PPw, fr, 32 + 8 * fq);
            const pg8::f32x4 gv = *(const LAS pg8::f32x4*)(Gv + 16 * lb + 4 * fq);
            bf16x8 Sf[4][2], Vf[4][2]; pg8::f32x4 yacc[4];
#pragma unroll
            for (int eb = 0; eb < 4; ++eb) { Sf[eb][0] = ldfrag(STc, 16 * eb + fr, 8 * fq); Sf[eb][1] = ldfrag(STc, 16 * eb + fr, 32 + 8 * fq);
                if (KIND == 0) { Vf[eb][0] = ldfrag(lds + L_VT, 16 * eb + fr, 8 * fq); Vf[eb][1] = ldfrag(lds + L_VT, 16 * eb + fr, 32 + 8 * fq); }
                else { Vf[eb][0] = trfrag(sp + L_V, 8 * fq, 16 * eb, fr); Vf[eb][1] = trfrag(sp + L_V, 32 + 8 * fq, 16 * eb, fr); } }
            const pg8::f32x4 eg = (pg8::f32x4){__expf(gv[0]), __expf(gv[1]), __expf(gv[2]), __expf(gv[3])};
#pragma unroll
            for (int eb = 0; eb < 4; ++eb) yacc[eb] = MFMA16(Qf[0], Sf[eb][0], ((pg8::f32x4){0.f, 0.f, 0.f, 0.f}));
#pragma unroll
            for (int eb = 0; eb < 4; ++eb) yacc[eb] = MFMA16(Qf[1], Sf[eb][1], yacc[eb]);
#pragma unroll
            for (int eb = 0; eb < 4; ++eb) yacc[eb] *= eg;
#pragma unroll
            for (int eb = 0; eb < 4; ++eb) yacc[eb] = MFMA16(Pf0, Vf[eb][0], yacc[eb]);
#pragma unroll
            for (int eb = 0; eb < 4; ++eb) yacc[eb] = MFMA16(Pf1, Vf[eb][1], yacc[eb]);
#pragma unroll
            for (int eb = 0; eb < 4; ++eb)
#pragma unroll
                for (int r = 0; r < 4; ++r) *(LAS bf16*)(YTc + (16 * lb + 4 * fq + r) * (PT * 2) + (16 * eb + fr) * 2) = (bf16)f2bf(yacc[eb][r]);
        } else { const int db = wave - 4;
            const float glast = Gv[63], egl = __expf(glast);
            bf16x8 Kr[2], Vf[4][2]; pg8::f32x4 g0[2], g1[2], d0[2], d1[2];
#pragma unroll
            for (int ks = 0; ks < 2; ++ks) { Kr[ks] = trfrag(sp + L_K, 32 * ks + 8 * fq, 16 * db, fr);
                g0[ks] = *(const LAS pg8::f32x4*)(Gv + 32 * ks + 8 * fq); g1[ks] = *(const LAS pg8::f32x4*)(Gv + 32 * ks + 8 * fq + 4);
                d0[ks] = (pg8::f32x4){1.f, 1.f, 1.f, 1.f}; d1[ks] = d0[ks];
                if (KIND == 1) { d0[ks] = *(const LAS pg8::f32x4*)(Dv + 32 * ks + 8 * fq); d1[ks] = *(const LAS pg8::f32x4*)(Dv + 32 * ks + 8 * fq + 4); } }
#pragma unroll
            for (int eb = 0; eb < 4; ++eb) {
                if (KIND == 0) { Vf[eb][0] = ldfrag(lds + L_VT, 16 * eb + fr, 8 * fq); Vf[eb][1] = ldfrag(lds + L_VT, 16 * eb + fr, 32 + 8 * fq); }
                else { Vf[eb][0] = trfrag(sp + L_V, 8 * fq, 16 * eb, fr); Vf[eb][1] = trfrag(sp + L_V, 32 + 8 * fq, 16 * eb, fr); } }
            bf16x8 Kf[2];
#pragma unroll
            for (int ks = 0; ks < 2; ++ks) { float kf[8];
#pragma unroll
                for (int j = 0; j < 4; ++j) { kf[j] = bfs(Kr[ks][j]) * __expf(glast - g0[ks][j]) * d0[ks][j]; kf[4 + j] = bfs(Kr[ks][4 + j]) * __expf(glast - g1[ks][j]) * d1[ks][j]; }
                const v4u kw = pk8(kf); Kf[ks] = __builtin_bit_cast(bf16x8, kw); }
#pragma unroll
            for (int eb = 0; eb < 4; ++eb) sacc[eb] = MFMA16(Kf[0], Vf[eb][0], sacc[eb] * egl);
#pragma unroll
            for (int eb = 0; eb < 4; ++eb) sacc[eb] = MFMA16(Kf[1], Vf[eb][1], sacc[eb]);
#pragma unroll
            for (int eb = 0; eb < 4; ++eb) { v2u o; o.x = pk2(sacc[eb][0], sacc[eb][1]); o.y = pk2(sacc[eb][2], sacc[eb][3]);
                *(LAS v2u*)(STn + (16 * eb + fr) * (PT * 2) + (16 * db + 4 * fq) * 2) = o; }
        }
        const v4u zcur = zc, xcur = xc; (void)xcur;
        if (c + 1 < SEQ / 64) { WALK_PREP((c + 1) & 1); zc = tz; xc = tv; }
        LBAR();
        {
            float y[8], zf[8]; unpk8(*(const LAS v4u*)(YTc + prow * (PT * 2) + pcg * 16), y); unpk8(zcur, zf);
            const size_t row = tok0 + (size_t)c * 64 + prow;
            if (KIND == 1) { float ss = 0.f, xf[8]; unpk8(xcur, xf);
#pragma unroll
                for (int j = 0; j < 8; ++j) { y[j] = (y[j] + p_D * xf[j]) * siluf(zf[j]); ss += y[j] * y[j]; }
                ss += __shfl_xor(ss, 1); ss += __shfl_xor(ss, 2); ss += __shfl_xor(ss, 4);
                if (pcg == 0) SM[row * SM_LD + 16 + h] = ss;
            } else { float ss = 0.f;
#pragma unroll
                for (int j = 0; j < 8; ++j) ss += y[j] * y[j];
                ss += __shfl_xor(ss, 1); ss += __shfl_xor(ss, 2); ss += __shfl_xor(ss, 4);
                const float rstd = rsqrtf(ss * (1.0f / 64.0f) + 1e-6f);
#pragma unroll
                for (int j = 0; j < 8; ++j) y[j] = y[j] * rstd * (KIND == 0 ? nw[j] : 1.0f) * siluf(zf[j]); }
            *(GAS v4u*)(ZB + row * ZB_LD + zcol) = pk8(y);
        }
    }
#undef WALK_LOAD
#undef WALK_PREP
}

constexpr int SP_RAW = 0, SP_CW = 67 * 1536, SP_END = SP_CW + 5 * 768 * 4;
static_assert(SP_END <= RING_BYTES, "ssd_prep LDS");
__device__ __forceinline__ void ssd_prep(const __attribute__((address_space(4))) Args* kp, int layer, LAS unsigned char* lds, int G_) {
    int tid = threadIdx.x; asm volatile("" : "+v"(tid));
    const int lane = tid & 63, wave = __builtin_amdgcn_readfirstlane(tid >> 6);
    unsigned char* ws = kp->ws;
    bf16* MIX = (bf16*)(ws + WS_MIX); float* SM = (float*)(ws + WS_SM);
    const bf16* HALO = (const bf16*)(ws + ((layer & 1) ? WS_XB0 : WS_XB1) + HALO_OFF);
    LAS float* CW = (LAS float*)(lds + SP_CW);
    { const float* cw = kp->in[8] + (size_t)layer * 4 * 768; const float* cb = kp->in[9] + (size_t)layer * 768;
      for (int i = tid; i < 768; i += 512) { CW[i] = cw[i]; CW[768 + i] = cw[768 + i]; CW[2 * 768 + i] = cw[2 * 768 + i]; CW[3 * 768 + i] = cw[3 * 768 + i]; CW[4 * 768 + i] = cb[i]; } }
    const float Aexp = expf(kp->in[10][layer * 8 + wave]), dtb = kp->in[11][layer * 8 + wave];
    for (int unit = blockIdx.x; unit < NBATCH * 64; unit += G_) { const int b = unit >> 6, c = unit & 63; const size_t tok0 = (size_t)b * SEQ + (size_t)c * 64;
        LBAR();
        for (int i = tid; i < 67 * 96; i += 512) { const int r = i / 96, pc = i - r * 96; v4u v = (v4u){0u, 0u, 0u, 0u};
            if (r >= 3) v = *(const GAS v4u*)(MIX + mixh(MX_BX + pc * 8, tok0 + r - 3));
            else if (c > 0) v = *(const GAS v4u*)(HALO + ((size_t)(b * 64 + c - 1) * 3 + r) * HALO_LD + MX_BX + pc * 8);
            *(LAS v4u*)(lds + SP_RAW + r * 1536 + pc * 16) = v; }
        { const size_t r2 = tok0 + lane; const float dt = softplusf(SM[r2 * SM_LD + 16 + wave] + dtb); float gs = -Aexp * dt;
#pragma unroll
          for (int o = 1; o < 64; o <<= 1) { const float t_ = __shfl_up(gs, o); if (lane >= o) gs += t_; }
          SM[r2 * SM_LD + 16 + wave] = gs; SM[r2 * SM_LD + 24 + wave] = dt; }
        LBAR();
        for (int i = tid; i < 64 * 96; i += 512) { const int l = i / 96, pc = i - l * 96; float a[8];
            { const pg8::f32x4 b0 = *(const LAS pg8::f32x4*)(CW + 4 * 768 + pc * 8), b1 = *(const LAS pg8::f32x4*)(CW + 4 * 768 + pc * 8 + 4);
              a[0] = b0[0]; a[1] = b0[1]; a[2] = b0[2]; a[3] = b0[3]; a[4] = b1[0]; a[5] = b1[1]; a[6] = b1[2]; a[7] = b1[3]; }
#pragma unroll
            for (int k = 0; k < 4; ++k) { float f[8]; unpk8(*(const LAS v4u*)(lds + SP_RAW + (l + k) * 1536 + pc * 16), f);
                const pg8::f32x4 w0 = *(const LAS pg8::f32x4*)(CW + k * 768 + pc * 8), w1 = *(const LAS pg8::f32x4*)(CW + k * 768 + pc * 8 + 4);
#pragma unroll
                for (int j = 0; j < 4; ++j) { a[j] += w0[j] * f[j]; a[4 + j] += w1[j] * f[4 + j]; } }
#pragma unroll
            for (int j = 0; j < 8; ++j) a[j] = siluf(a[j]);
            *(GAS v4u*)(MIX + mixh(MX_BX + pc * 8, tok0 + l)) = pk8(a); }
    }
    LBAR();
}
__device__ __forceinline__ void ret_prep(const __attribute__((address_space(4))) Args* kp, int G_) {
    int tid = threadIdx.x; asm volatile("" : "+v"(tid));
    unsigned char* ws = kp->ws;
    bf16* MIX = (bf16*)(ws + WS_MIX); const float* ROPE = (const float*)(ws + WS_ROPE);
    for (int it = blockIdx.x * 512 + tid; it < MTOK * 32; it += G_ * 512) { const int m = it >> 5, hh = (it >> 2) & 7, i4 = it & 3, t = m & (SEQ - 1);
        const float* rp = ROPE + t * 32 + i4 * 8;
        const pg8::f32x4 c0 = *(const GAS pg8::f32x4*)rp, c1 = *(const GAS pg8::f32x4*)(rp + 4), s0 = *(const GAS pg8::f32x4*)(rp + SEQ * 32), s1 = *(const GAS pg8::f32x4*)(rp + SEQ * 32 + 4);
        const float cs[8] = {c0[0], c0[1], c0[2], c0[3], c1[0], c1[1], c1[2], c1[3]}, sn[8] = {s0[0], s0[1], s0[2], s0[3], s1[0], s1[1], s1[2], s1[3]};
#pragma unroll
        for (int T = 0; T < 2; ++T) { bf16* p = MIX + mixh((T == 0 ? MX_CQ : MX_CK) + hh * 64 + i4 * 8, (size_t)m); const float sc = T == 0 ? 1.0f : 0.125f;
            float a[8], bb[8], o1[8], o2[8]; unpk8(*(const GAS v4u*)p, a); unpk8(*(const GAS v4u*)(p + 32), bb);
#pragma unroll
            for (int j = 0; j < 8; ++j) { o1[j] = (a[j] * cs[j] - bb[j] * sn[j]) * sc; o2[j] = (a[j] * sn[j] + bb[j] * cs[j]) * sc; }
            *(GAS v4u*)p = pk8(o1); *(GAS v4u*)(p + 32) = pk8(o2); }
    }
}

typedef short bf16x4 __attribute__((ext_vector_type(4)));
#define MFMA16K16(a, b, c) __builtin_amdgcn_mfma_f32_16x16x16bf16_1k(a, b, c, 0, 0, 0)
constexpr int GQ_RAW = 0, GQ_KN = 67 * 384, GQ_VN = GQ_KN + MAT, GQ_NA = GQ_VN + MAT, GQ_AD = GQ_NA + MAT, GQ_S = GQ_AD + 4 * 16 * 20 * 4, GQ_CW = GQ_S + 512, GQ_TEAM = GQ_CW + 4 * 192 * 4;
static_assert(2 * GQ_TEAM <= RING_BYTES && 2 * MAT <= GQ_KN, "gdn_prep LDS");
__device__ __forceinline__ bf16x4 pk4(const pg8::f32x4 v) { v2u w; w.x = pk2(v[0], v[1]); w.y = pk2(v[2], v[3]); return __builtin_bit_cast(bf16x4, w); }
__device__ __forceinline__ void gdn_prep(const __attribute__((address_space(4))) Args* kp, int layer, LAS unsigned char* lds_all, int G_) {
    int tid = threadIdx.x; asm volatile("" : "+v"(tid));
    const int team = __builtin_amdgcn_readfirstlane(tid >> 8), j = tid & 255, lane = tid & 63, tw = __builtin_amdgcn_readfirstlane((tid >> 6) & 3), fr = lane & 15, fq = lane >> 4;
    LAS unsigned char* lds = lds_all + team * GQ_TEAM;
    LAS float* AD = (LAS float*)(lds + GQ_AD); LAS float* Gs = (LAS float*)(lds + GQ_S); LAS float* Bs = Gs + 64; LAS float* CW = (LAS float*)(lds + GQ_CW);
    unsigned char* ws = kp->ws;
    bf16* MIX = (bf16*)(ws + WS_MIX); float* SM = (float*)(ws + WS_SM);
    unsigned char* xbf = ws + ((layer & 1) ? WS_XB0 : WS_XB1); bf16* GW = (bf16*)(xbf + GW_OFF); const bf16* HALO = (const bf16*)(xbf + HALO_OFF);
    const float* cw = kp->in[4] + (size_t)layer * 4 * 1536;
    v4u praw[7]; float pcw[3], pbl = 0.f, pal = 0.f;
#define GQ_FETCH(rnd) do { const int u_ = ((rnd) * G_ + (int)blockIdx.x) * 2 + team; const int un_ = u_ < NBATCH * 8 * 64 ? u_ : 0; \
        const int c_ = un_ & 63, h_ = (un_ >> 6) & 7, b_ = un_ >> 9; const size_t tk_ = (size_t)b_ * SEQ + (size_t)c_ * 64; \
        _Pragma("unroll") for (int n = 0; n < 7; ++n) { const int i = j + 256 * n; praw[n] = (v4u){0u, 0u, 0u, 0u}; \
            if (i < 67 * 24) { const int r = i / 24, pc = i - r * 24, col = (pc >> 3) * 512 + h_ * 64 + (pc & 7) * 8; \
                if (r >= 3) praw[n] = *(const GAS v4u*)(MIX + mixh(col, tk_ + r - 3)); \
                else if (c_ > 0) praw[n] = *(const GAS v4u*)(HALO + ((size_t)(b_ * 64 + c_ - 1) * 3 + r) * HALO_LD + col); } } \
        _Pragma("unroll") for (int n = 0; n < 3; ++n) { const int i = j + 256 * n, k = i / 192, cc = i - k * 192; pcw[n] = cw[k * 1536 + (cc >> 6) * 512 + h_ * 64 + (cc & 63)]; } \
        if (tw == 0) { pbl = SM[(tk_ + lane) * SM_LD + h_]; pal = SM[(tk_ + lane) * SM_LD + 8 + h_]; } } while (0)
    GQ_FETCH(0);
    for (int round = 0; round < 8; ++round) {
        const int unit_ = (round * G_ + (int)blockIdx.x) * 2 + team;
        const bool live = unit_ < NBATCH * 8 * 64;
        const int unit = live ? unit_ : 0;
        const int c = unit & 63, h = (unit >> 6) & 7, b = unit >> 9;
        const size_t tok0 = (size_t)b * SEQ + (size_t)c * 64;
        LBAR();
#pragma unroll
        for (int n = 0; n < 7; ++n) { const int i = j + 256 * n; if (i < 67 * 24) { const int r = i / 24, pc = i - r * 24; *(LAS v4u*)(lds + GQ_RAW + r * 384 + pc * 16) = praw[n]; } }
#pragma unroll
        for (int n = 0; n < 3; ++n) CW[j + 256 * n] = pcw[n];
        if (tw == 0) {
            float gsum = -expf(kp->in[5][layer * 8 + h]) * softplusf(pal + kp->in[6][layer * 8 + h]);
#pragma unroll
            for (int o = 1; o < 64; o <<= 1) { const float t_ = __shfl_up(gsum, o); if (lane >= o) gsum += t_; }
            Gs[lane] = gsum; Bs[lane] = sigmf(pbl);
            if (live) SM[(tok0 + lane) * SM_LD + 8 + h] = gsum; }
        if (round + 1 < 8) GQ_FETCH(round + 1);
        LBAR();
#pragma unroll 1
        for (int n = 0; n < 6; ++n) { const int i = j + 256 * n, t = i / 24, pc = i - t * 24, tens = pc >> 3, ch = pc & 7; float a[8];
#pragma unroll
            for (int jj = 0; jj < 8; ++jj) a[jj] = 0.f;
#pragma unroll
            for (int k = 0; k < 4; ++k) { float f[8]; unpk8(*(const LAS v4u*)(lds + GQ_RAW + (t + k) * 384 + pc * 16), f);
                const pg8::f32x4 w0 = *(const LAS pg8::f32x4*)(CW + k * 192 + pc * 8), w1 = *(const LAS pg8::f32x4*)(CW + k * 192 + pc * 8 + 4);
#pragma unroll
                for (int jj = 0; jj < 4; ++jj) { a[jj] += w0[jj] * f[jj]; a[4 + jj] += w1[jj] * f[4 + jj]; } }
            float ss = 0.f;
#pragma unroll
            for (int jj = 0; jj < 8; ++jj) { a[jj] = siluf(a[jj]); ss += a[jj] * a[jj]; }
            ss += __shfl_xor(ss, 1); ss += __shfl_xor(ss, 2); ss += __shfl_xor(ss, 4);
            const float sc = tens == 2 ? 1.0f : rsqrtf(ss + 1e-6f) * (tens == 0 ? 0.125f : 1.0f);
#pragma unroll
            for (int jj = 0; jj < 8; ++jj) a[jj] *= sc;
            const v4u o = pk8(a);
            if (tens == 0) { if (live) *(GAS v4u*)(MIX + mixh(MX_AQ + h * 64 + ch * 8, tok0 + t)) = o; }
            else if (tens == 1) { *(LAS v4u*)(lds + GQ_KN + t * (PT * 2) + ch * 16) = o; if (live) *(GAS v4u*)(MIX + mixh(MX_AK + h * 64 + ch * 8, tok0 + t)) = o; }
            else *(LAS v4u*)(lds + GQ_VN + t * (PT * 2) + ch * 16) = o; }
        LBAR();
        for (int id = tw; id < 10; id += 4) { const int lb = id < 1 ? 0 : (id < 3 ? 1 : (id < 6 ? 2 : 3)), sb = id - (lb * (lb + 1)) / 2;
            pg8::f32x4 acc = (pg8::f32x4){0.f, 0.f, 0.f, 0.f};
#pragma unroll
            for (int ks = 0; ks < 2; ++ks) acc = MFMA16(ldfrag(lds + GQ_KN, 16 * lb + fr, 32 * ks + 8 * fq), ldfrag(lds + GQ_KN, 16 * sb + fr, 32 * ks + 8 * fq), acc);
            const int s = 16 * sb + fr; const float gsv = Gs[s];
#pragma unroll
            for (int r = 0; r < 4; ++r) { const int l = 16 * lb + 4 * fq + r; const float v = s < l ? Bs[l] * acc[r] * __expf(Gs[l] - gsv) : 0.f;
                if (lb == sb) AD[(lb * 16 + 4 * fq + r) * 20 + fr] = v;
                else *(LAS bf16*)(lds + GQ_NA + l * (PT * 2) + s * 2) = (bf16)f2bf(-v); } }
        LBAR();
        if (tw == 0) { const int bi = lane >> 4, cc = lane & 15; const LAS float* Ab = AD + bi * 16 * 20; float x[16];
#pragma unroll
            for (int r = 0; r < 16; ++r) { float a = (r == cc) ? 1.0f : 0.0f;
#pragma unroll
                for (int s4 = 0; s4 < r; s4 += 4) { const pg8::f32x4 av = *(const LAS pg8::f32x4*)(Ab + r * 20 + s4);
                    a -= av[0] * x[s4];
                    if (s4 + 1 < r) a -= av[1] * x[s4 + 1];
                    if (s4 + 2 < r) a -= av[2] * x[s4 + 2];
                    if (s4 + 3 < r) a -= av[3] * x[s4 + 3]; }
                x[r] = a; }
#pragma unroll
            for (int r = 0; r < 16; ++r) *(LAS bf16*)(lds + GQ_NA + (16 * bi + r) * (PT * 2) + (16 * bi + cc) * 2) = (bf16)f2bf(x[r]); }
        LBAR();
#pragma unroll 1
        for (int half = 0; half < 2; ++half) { LAS unsigned char* src = lds + (half == 0 ? GQ_VN : GQ_KN); const int c0 = 16 * tw;
            pg8::f32x4 R[4], X[4];
#pragma unroll
            for (int i = 0; i < 4; ++i) { const s16x4 raw = tr4(src + (16 * i + 4 * fq + (fr >> 2)) * (PT * 2) + (c0 + 4 * (fr & 3)) * 2);
                const pg8::f32x4 bv = *(const LAS pg8::f32x4*)(Bs + 16 * i + 4 * fq); pg8::f32x4 sc = bv;
                if (half == 1) { const pg8::f32x4 gv = *(const LAS pg8::f32x4*)(Gs + 16 * i + 4 * fq); sc = (pg8::f32x4){bv[0] * __expf(gv[0]), bv[1] * __expf(gv[1]), bv[2] * __expf(gv[2]), bv[3] * __expf(gv[3])}; }
                R[i] = (pg8::f32x4){bfs(raw[0]) * sc[0], bfs(raw[1]) * sc[1], bfs(raw[2]) * sc[2], bfs(raw[3]) * sc[3]}; }
#define NAF(ib, jb) (*(const LAS bf16x4*)(lds + GQ_NA + (16 * (ib) + fr) * (PT * 2) + (16 * (jb) + 4 * fq) * 2))
            const pg8::f32x4 Z = (pg8::f32x4){0.f, 0.f, 0.f, 0.f};
            X[0] = MFMA16K16(NAF(0, 0), pk4(R[0]), Z);
            { const bf16x4 x0 = pk4(X[0]); R[1] = MFMA16K16(NAF(1, 0), x0, R[1]); R[2] = MFMA16K16(NAF(2, 0), x0, R[2]); R[3] = MFMA16K16(NAF(3, 0), x0, R[3]); }
            X[1] = MFMA16K16(NAF(1, 1), pk4(R[1]), Z);
            { const bf16x4 x1 = pk4(X[1]); R[2] = MFMA16K16(NAF(2, 1), x1, R[2]); R[3] = MFMA16K16(NAF(3, 1), x1, R[3]); }
            X[2] = MFMA16K16(NAF(2, 2), pk4(R[2]), Z);
            { const bf16x4 x2 = pk4(X[2]); R[3] = MFMA16K16(NAF(3, 2), x2, R[3]); }
            X[3] = MFMA16K16(NAF(3, 3), pk4(R[3]), Z);
#undef NAF
#pragma unroll
            for (int i = 0; i < 4; ++i)
#pragma unroll
                for (int r = 0; r < 4; ++r) *(LAS bf16*)(lds + GQ_RAW + half * MAT + (16 * i + 4 * fq + r) * (PT * 2) + (c0 + fr) * 2) = (bf16)f2bf(X[i][r]);
        }
        LBAR();
        if (live) for (int i = j; i < 64 * 16; i += 256) { const int t = (i >> 3) & 63, ch = i & 7, half = i >> 9;
            const v4u v = *(const LAS v4u*)(lds + GQ_RAW + half * MAT + t * (PT * 2) + ch * 16);
            if (half == 0) *(GAS v4u*)(MIX + mixh(MX_AV + h * 64 + ch * 8, tok0 + t)) = v; else *(GAS v4u*)(GW + gwh(h, ch * 8, tok0 + t)) = v; }
    }
    LBAR();
}
#ifndef MK_ONE_LAUNCH
#define MK_ONE_LAUNCH 1
#endif
__global__ void __launch_bounds__(512, 2) fwd_kernel(Args args) {
    extern __shared__ __attribute__((aligned(16))) unsigned char lds_raw[];
    LAS unsigned char* lds0 = (LAS unsigned char*)lds_raw;
    volatile LAS unsigned* MISC = (volatile LAS unsigned*)(lds0 + MISC_OFF);
    const int G = gridDim.x, NGW = G * 8;
    unsigned char* ws0 = args.ws;
    for (int u = threadIdx.x; u < (LDS_BYTES - RING_BYTES) / 4; u += 512) ((LAS unsigned*)(lds0 + RING_BYTES))[u] = 0u;
    __syncthreads();
#if MK_ONE_LAUNCH
    XcdBarrier bar = xcd_barrier_post((unsigned*)(ws0 + WS_CTL) + 4096, MISC + 8);
#define GRID_BAR() do { XcdBarrier b_ = bar; asm volatile("" : "+s"(b_.bar), "+s"(b_.x)); xcd_barrier(b_); } while (0)
#else
#define GRID_BAR() do {} while (0)
#endif
    const int lo = args.ph_lo, hi = args.ph_hi;
#define IN(p) (lo <= (p) && (p) < hi)
#define SEAM(p) do { if (IN(p) && IN((p) + 1)) GRID_BAR(); } while (0)
    typedef const __attribute__((address_space(4))) Args* KArgs;
    const KArgs kp0 = (KArgs)__builtin_amdgcn_kernarg_segment_ptr();
#define PHASE_PTRS() KArgs kp = kp0; asm volatile("" : "+s"(kp)); unsigned char* ws = kp->ws; float* X = kp->out; (void)X; \
    LAS unsigned char* lds = lds0; \
    int tid = threadIdx.x; asm volatile("" : "+v"(tid)); int bx = blockIdx.x; asm volatile("" : "+s"(bx)); const int lane = tid & 63, wave = __builtin_amdgcn_readfirstlane(tid >> 6), gw = bx * 8 + wave; (void)lane; (void)gw; \
    bf16* ZB = (bf16*)(ws + WS_ZB); bf16* MIX = (bf16*)(ws + WS_MIX); float* SM = (float*)(ws + WS_SM); (void)ZB; (void)MIX; (void)SM; \
    float* SSQA = (float*)(ws + WS_SSQA); float* SSQB = (float*)(ws + WS_SSQB); float* SSQC = (float*)(ws + WS_SSQC); float* ROPE = (float*)(ws + WS_ROPE); (void)SSQA; (void)SSQB; (void)SSQC; (void)ROPE; \
    bf16* W1T = (bf16*)(ws + W_1T); bf16* WGT = (bf16*)(ws + W_GT); bf16* WMT = (bf16*)(ws + W_MT); bf16* WOT = (bf16*)(ws + W_OT); bf16* WUT = (bf16*)(ws + W_UT); (void)W1T; (void)WGT; (void)WMT; (void)WOT; (void)WUT; \
    bf16* WDT = (bf16*)(ws + W_DT); bf16* WPGT = (bf16*)(ws + W_PGT); bf16* WPPT = (bf16*)(ws + W_PPT); (void)WDT; (void)WPGT; (void)WPPT; \
    bf16* GATE = (bf16*)(ws + WS_GATE); bf16* U = (bf16*)(ws + WS_U); bf16* PB = (bf16*)X; bf16* PLE = (bf16*)X + (size_t)MTOK * PLED;     (void)GATE; (void)U; (void)PB; (void)PLE; \
    bf16* XBl = (bf16*)(ws + ((layer & 1) ? WS_XB1 : WS_XB0)); bf16* XBf = (bf16*)(ws + ((layer & 1) ? WS_XB0 : WS_XB1)); (void)XBl; (void)XBf
    if (IN(0)) { const int layer = 0; PHASE_PTRS();
        for (int e = bx * 512 + tid; e < SEQ * 32; e += G * 512) { const int t = e >> 5, i = e & 31;
            double f = 1.0; for (int j = 0; j < i; ++j) f *= 0.7429639507594948;
            const double ang = (double)t * f, kk = rint(ang * 0.15915494309189535);
            double r = fma(-kk, 6.283185307179586, ang); r = fma(-kk, 2.4492935982947064e-16, r); const double r2 = r * r;
            double sn = 1.0, cs = 1.0;
    #pragma unroll
            for (int n = 15; n >= 1; --n) { sn = 1.0 - r2 * (1.0 / (double)((2 * n) * (2 * n + 1))) * sn; cs = 1.0 - r2 * (1.0 / (double)((2 * n - 1) * (2 * n))) * cs; }
            ROPE[e] = (float)cs; ROPE[SEQ * 32 + e] = (float)(r * sn); }
    }
    for (int layer = 0; layer < DEPTH; ++layer) {
        const int P = layer * NPH;
        if (IN(P + 0)) { PHASE_PTRS();
            int ibase = 0;
            const float* w_in = kp->in[3] + (size_t)layer * DM * NIN; const float* nmix = kp->in[2] + (size_t)layer * DM;
            TR_SEG(w_in, NIN, 1536, 512, DM, nmix, W1T, DM, 0, 0);
            TR_SEG(w_in, NIN, 2064, 512, DM, nmix, W1T, DM, 512, 0);
            TR_SEG(w_in, NIN, 4888, 512, DM, nmix, W1T, DM, 1024, 0);
            TR_SEG(w_in, NIN, 0, 1536, DM, nmix, W1T, DM, 1536, 0);
            TR_SEG(w_in, NIN, 2576, 768, DM, nmix, W1T, DM, 3072, 0);
            TR_SEG(w_in, NIN, 3352, 1536, DM, nmix, W1T, DM, 3840, 0);
            TR_SEG(w_in, NIN, 2048, 16, DM, nmix, W1T, DM, 5376, 0);
            TR_SEG(w_in, NIN, 3344, 8, DM, nmix, W1T, DM, 5392, 0);
            TR_SEG((const float*)nullptr, NIN, 0, 232, DM, (const float*)nullptr, W1T, DM, 5400, 0);
            TR_SEG(w_in, NIN, 5400, 3072, DM, nmix, WGT, DM, 0, 0);
            const float* wbr = kp->in[14] + (size_t)layer * 3 * 512 * DM;
            TR_SEG(wbr, DM, 0, DM, 512, (const float*)nullptr, WMT, KMERGE, 0, 0);
            TR_SEG(wbr + 512 * DM, DM, 0, DM, 512, kp->in[13] + (size_t)layer * 512, WMT, KMERGE, 0, 512);
            TR_SEG(wbr + 2 * 512 * DM, DM, 0, DM, 512, (const float*)nullptr, WMT, KMERGE, 0, 1024);
            TR_SEG(kp->in[15] + (size_t)layer * DM * DM, DM, 0, DM, DM, (const float*)nullptr, WOT, DM, 0, 0);
            TR_SEG(kp->in[17] + (size_t)layer * DM * DFF, DFF, 0, DFF, DM, kp->in[16] + (size_t)layer * DM, WUT, DM, 0, 0);
            TR_SEG(kp->in[18] + (size_t)layer * DFF * DM, DM, 0, DM, DFF, (const float*)nullptr, WDT, DFF, 0, 0);
            TR_SEG(kp->in[20] + (size_t)layer * DM * DM, DM, 0, DM, DM, kp->in[19] + (size_t)layer * DM, WPGT, DM, 0, 0);
            TR_SEG(kp->in[21] + (size_t)layer * PLED * DM, DM, 0, DM, PLED, (const float*)nullptr, WPPT, PLED, 0, 0);
            if (layer == 0) {
                const float* xin = kp->in[0];
                for (int m = gw; m < MTOK; m += NGW) {
                    const GAS f32x4* xr = (const GAS f32x4*)(xin + (size_t)m * DM) + lane; f32x4 v[4]; float s = 0.f;
#pragma unroll
                    for (int j = 0; j < 4; ++j) { v[j] = xr[64 * j]; s += (v[j].x * v[j].x + v[j].y * v[j].y) + (v[j].z * v[j].z + v[j].w * v[j].w); }
                    s = wave_sum(s);
                    GAS v2u* o8 = (GAS v2u*)(XBl + (size_t)m * DM) + lane;
#pragma unroll
                    for (int j = 0; j < 4; ++j) { v2u w; w.x = pk2(v[j].x, v[j].y); w.y = pk2(v[j].z, v[j].w); o8[64 * j] = w; }
                    if (lane < 16) SSQC[(size_t)m * 16 + lane] = lane == 0 ? s : 0.f;
                }
            }
        }
        SEAM(P + 0);
        if (IN(P + 1)) { PHASE_PTRS();
            pg8::Gemm g{XBl, W1T, MTOK, N1, DM}; pg8::StaticOrder S; S.init(MTOK, N1, G, bx);
            build_rs_table(S, SSQC, lds, tid);
            pg8::EpiP1 E{ZB, MIX, SM, lds + RS_OFF, (bf16*)((unsigned char*)XBf + HALO_OFF)};
            pg8::gemm_phase<pg8::EpiP1, pg8::StaticOrder, true, true>(lds, g, S, E);
        }
        SEAM(P + 1);
        if (IN(P + 2)) { PHASE_PTRS();
            gdn_prep(kp, layer, lds, G);
            ssd_prep(kp, layer, lds, G);
            ret_prep(kp, G);
            const float* pl = kp->in[1] + (size_t)layer * MTOK * PLED;
            for (size_t e = (size_t)bx * 512 + tid; e < (size_t)MTOK * PLED / 4; e += (size_t)G * 512) { const f32x4 v = ((const GAS f32x4*)pl)[e]; v2u w; w.x = pk2(v.x, v.y); w.y = pk2(v.z, v.w); ((GAS v2u*)PB)[e] = w; }
        }
        SEAM(P + 2);
        if (IN(P + 3)) { PHASE_PTRS();
            for (int w = bx; w < 192; w += G) { const int kind = w >> 6, b = (w & 63) >> 3, h = w & 7;
                if (kind == 0) mixer_walk<0>(kp, layer, b, h, lds);
                else if (kind == 1) mixer_walk<1>(kp, layer, b, h, lds);
                else mixer_walk<2>(kp, layer, b, h, lds);
                __syncthreads(); }
            if (bx >= 192 || G <= 192) {
                pg8::Gemm g{PB, WPPT, MTOK / 2, DM, PLED}; pg8::StaticOrder S; if (G > 192) S.init(MTOK / 2, DM, G - 192, bx - 192); else S.init(MTOK / 2, DM, G, bx);
                pg8::EpiRS<0> E{PLE, DM, (LAS unsigned char*)nullptr};
                pg8::gemm_phase<pg8::EpiRS<0>, pg8::StaticOrder, true, true>(lds, g, S, E); }
        }
        SEAM(P + 3);
        if (IN(P + 4)) { PHASE_PTRS();
            for (int m = gw; m < MTOK; m += NGW) {
                GAS v4u* yp = (GAS v4u*)(ZB + (size_t)m * ZB_LD + 512) + lane; const v4u w = *yp;
                const f32x4 sq = *(const f32x4*)(SM + (size_t)m * SM_LD + 16 + 4 * (lane >> 5));
                const float rstd = rsqrtf(((sq[0] + sq[1]) + (sq[2] + sq[3])) * (1.0f / 256.0f) + 1e-6f);
                v4u o; o.x = pk2(pg8::bflo(w.x) * rstd, pg8::bfhi(w.x) * rstd); o.y = pk2(pg8::bflo(w.y) * rstd, pg8::bfhi(w.y) * rstd);
                o.z = pk2(pg8::bflo(w.z) * rstd, pg8::bfhi(w.z) * rstd); o.w = pk2(pg8::bflo(w.w) * rstd, pg8::bfhi(w.w) * rstd);
                *yp = o;
            }
            pg8::Gemm g{XBl, WGT, MTOK, NGATE, DM}; pg8::StaticOrder S; S.init(MTOK, NGATE, G, bx);
            build_rs_table(S, SSQC, lds, tid);
            pg8::EpiRS<2> E{GATE, NGATE, lds + RS_OFF};
            pg8::gemm_phase<pg8::EpiRS<2>, pg8::StaticOrder, true, true>(lds, g, S, E);
        }
        SEAM(P + 4);
        if (IN(P + 5)) { PHASE_PTRS();
            pg8::Gemm g{ZB, WMT, MTOK, DM, KMERGE}; pg8::StaticOrder S; S.init(MTOK, DM, G, bx);
            pg8::EpiMerge E{GATE, XBf};
            pg8::gemm_phase<pg8::EpiMerge, pg8::StaticOrder, true, true>(lds, g, S, E);
        }
        SEAM(P + 5);
        if (IN(P + 6)) { PHASE_PTRS();
            pg8::Gemm g{XBf, WOT, MTOK, DM, DM}; pg8::StaticOrder S; S.init(MTOK, DM, G, bx);
            pg8::EpiResid<0> E{XBl, XBl, SSQA, (LAS unsigned char*)nullptr, nullptr,  1.0f};
            pg8::gemm_phase<pg8::EpiResid<0>, pg8::StaticOrder, true, true>(lds, g, S, E);
        }
        SEAM(P + 6);
        if (IN(P + 7)) { PHASE_PTRS();
            { pg8::Gemm g{XBl, WUT, MTOK, DFF, DM}; pg8::StaticOrder S; S.init(MTOK, DFF, G, bx);
              build_rs_table(S, SSQA, lds, tid);
              pg8::EpiRS<1> E{U, DFF, lds + RS_OFF};
              pg8::gemm_phase<pg8::EpiRS<1>, pg8::StaticOrder, true, true>(lds, g, S, E); }
        }
        SEAM(P + 7);
        if (IN(P + 8)) { PHASE_PTRS();
            pg8::Gemm g{U, WDT, MTOK, DM, DFF}; pg8::StaticOrder S; S.init(MTOK, DM, G, bx);
            pg8::EpiResid<0> E{XBl, XBl, SSQB, (LAS unsigned char*)nullptr, nullptr,  1.0f};
            pg8::gemm_phase<pg8::EpiResid<0>, pg8::StaticOrder, true, true>(lds, g, S, E);
            __builtin_amdgcn_sched_barrier(0);
            { pg8::Gemm g2{PB + (size_t)(MTOK / 2) * PLED, WPPT, MTOK / 2, DM, PLED}; pg8::StaticOrder S2; S2.init(MTOK / 2, DM, G, bx);
              pg8::EpiRS<0> E2{PLE + (size_t)(MTOK / 2) * DM, DM, (LAS unsigned char*)nullptr};
              pg8::gemm_phase<pg8::EpiRS<0>, pg8::StaticOrder, true, true>(lds, g2, S2, E2); }
        }
        SEAM(P + 8);
        if (IN(P + 9)) { PHASE_PTRS();
            pg8::Gemm g{XBl, WPGT, MTOK, DM, DM}; pg8::StaticOrder S; S.init(MTOK, DM, G, bx);
            build_rs_table(S, SSQB, lds, tid);
            pg8::EpiResid<1> E{XBl, XBf, SSQC, lds + RS_OFF, PLE,  1.0f};
            pg8::gemm_phase<pg8::EpiResid<1>, pg8::StaticOrder, true, true>(lds, g, S, E);
        }
        SEAM(P + 9);
    }
    if (IN(PH_FINAL)) { const int layer = DEPTH; PHASE_PTRS();
        const float* nf = kp->in[22];
        for (int m = gw; m < MTOK; m += NGW) {
            const float sp = lane < 16 ? SSQC[(size_t)m * 16 + lane] : 0.f;
            const float rstd = rsqrtf(wave_sum(sp) * (1.0f / 1024.0f) + 1e-6f);
            const GAS v4u* xr = (const GAS v4u*)(XBl + (size_t)m * DM) + lane; GAS f32x4* orow = (GAS f32x4*)(X + (size_t)m * DM);
#pragma unroll
            for (int j = 0; j < 2; ++j) { const v4u w = xr[64 * j]; const int c8 = (64 * j + lane) * 2; const f32x4 g0 = ((const GAS f32x4*)nf)[c8], g1 = ((const GAS f32x4*)nf)[c8 + 1];
                f32x4 o0, o1; o0[0] = pg8::bflo(w.x); o0[1] = pg8::bfhi(w.x); o0[2] = pg8::bflo(w.y); o0[3] = pg8::bfhi(w.y); o1[0] = pg8::bflo(w.z); o1[1] = pg8::bfhi(w.z); o1[2] = pg8::bflo(w.w); o1[3] = pg8::bfhi(w.w);
                orow[c8] = o0 * rstd * g0; orow[c8 + 1] = o1 * rstd * g1; }
        }
    }
#undef IN
#undef SEAM
}

extern "C" void kernel_launch(void* const* d_in, const int* in_sizes, int n_in, void* d_out, int out_size, void* d_ws, size_t ws_size, hipStream_t stream) {
    static int grid = 0;
    if (grid == 0) {
        if (n_in != 23 || out_size != MTOK * DM || ws_size < WS_END) { fprintf(stderr, "kernel_launch: unexpected problem (n_in %d, out %d, ws %zu < %zu)\n", n_in, out_size, ws_size, (size_t)WS_END); grid = -1; return; }
        int dev = 0, cus = 0;
        if (hipGetDevice(&dev) != hipSuccess || hipDeviceGetAttribute(&cus, hipDeviceAttributeMultiprocessorCount, dev) != hipSuccess) { grid = -1; return; }
        if (hipFuncSetAttribute((const void*)fwd_kernel, hipFuncAttributeMaxDynamicSharedMemorySize, LDS_BYTES) != hipSuccess) { fprintf(stderr, "kernel_launch: hipFuncSetAttribute failed\n"); grid = -1; return; }
        int per_cu = 0;
        if (hipOccupancyMaxActiveBlocksPerMultiprocessor(&per_cu, (const void*)fwd_kernel, 512, LDS_BYTES) != hipSuccess || per_cu < 1) { fprintf(stderr, "kernel_launch: occupancy query says %d blocks per CU\n", per_cu); }
        (void)hipGetLastError();
        grid = cus;
    }
    if (grid < 0) return;
    (void)hipMemsetAsync((char*)d_ws + WS_CTL, 0, CTL_BYTES, stream);
    Args a; memset(&a, 0, sizeof(a));
    for (int i = 0; i < 23; ++i) a.in[i] = (const float*)d_in[i];
    a.out = (float*)d_out; a.ws = (unsigned char*)d_ws;
#if MK_ONE_LAUNCH
    a.ph_lo = 0; a.ph_hi = N_PHASES;
    hipLaunchKernelGGL(fwd_kernel, dim3(grid), dim3(512), LDS_BYTES, stream, a);
#else
    for (int p = 0; p < N_PHASES; ++p) {
        a.ph_lo = p; a.ph_hi = p + 1;
        hipLaunchKernelGGL(fwd_kernel, dim3(grid), dim3(512), LDS_BYTES, stream, a);
    }
#endif
}
```

```cpp
#include <hip/hip_runtime.h>
#include <cstdio>
#include <cstdint>
#include <cstring>
__host__ __device__ __forceinline__ size_t mixh(int col, size_t m) {
    const size_t b = m >> 12, t = m & 4095;
    if (col < 2048) { const int ten = col >> 9, h = (col >> 6) & 7; return (size_t)ten * (16u << 20) + (((b * 8 + h) << 12) + t) * 64 + (col & 63); }
    if (col < 2304) { const int c2 = col - 2048, tb = c2 >> 7, g = (c2 >> 6) & 1; return (size_t)4 * (16u << 20) + (size_t)tb * (4u << 20) + (((b * 2 + g) << 12) + t) * 64 + (col & 63); }
    const int c2 = col - 2304, ten = c2 >> 9, h = (c2 >> 6) & 7; return (size_t)4 * (16u << 20) + (8u << 20) + (size_t)ten * (16u << 20) + (((b * 8 + h) << 12) + t) * 64 + (col & 63);
}
__host__ __device__ __forceinline__ size_t gwh(int h, int c, size_t m) { return ((((m >> 12) * 8 + h) << 12) + (m & 4095)) * 64 + c; }
namespace pg8 {
#define PG8_LAS __attribute__((address_space(3)))
typedef unsigned short bf16_t;
typedef short bf16x8 __attribute__((ext_vector_type(8)));
typedef float f32x4 __attribute__((ext_vector_type(4)));
typedef unsigned u32x4 __attribute__((ext_vector_type(4)));
constexpr int BM = 256, BK = 64, HALF = 128, HTB = HALF * BK * 2  , STAGE_BYTES = 8 * HTB, NXCD = 8, WGM = 8;

__host__ __device__ __forceinline__ int lds_byte(int r, int c) { const int st = (r >> 4) * 2 + (c >> 5), rr = r & 15, cc = c & 31, ob = rr * 64 + cc * 2; return st * 1024 + (ob ^ (((ob >> 9) & 1) << 5)); }
__host__ __device__ __forceinline__ void stage_rc(int b, int& R, int& C) { const int st = b / 1024, sb = b % 1024, swz = sb ^ (((sb >> 9) & 1) << 5); R = (st >> 1) * 16 + swz / 64; C = (st & 1) * 32 + (swz % 64) / 2; }
__host__ __device__ __forceinline__ int perm32(int rho) { const int n = rho >> 4, i = rho & 15; return 8 * (i >> 2) + 4 * n + (i & 3); }

struct Unit { int pm, pn; };
struct Gemm { const bf16_t* A; const bf16_t* Bt; int M, N, K; };

struct StaticOrder {
    int nM, nN, nwg, G, c;
    __host__ __device__ void init(int M, int N, int G_, int c_) { nM = M / BM; nN = N / BM; nwg = nM * nN; G = G_; c = c_; }
    __host__ __device__ bool next(int i, Unit& u) const {
        const long L = (long)i * G + c; if (L >= nwg) return false;
        int wgid = (int)L; { const int q = nwg / NXCD, r = nwg % NXCD, xcd = wgid % NXCD, off = wgid / NXCD; wgid = (xcd < r ? xcd * (q + 1) : r * (q + 1) + (xcd - r) * q) + off; }
        const int nig = WGM * nN, gid = wgid / nig, fm = gid * WGM, gsz = (nM - fm) < WGM ? (nM - fm) : WGM;
        u.pm = fm + ((wgid % nig) % gsz); u.pn = (wgid % nig) / gsz; return true;
    }
    __device__ __forceinline__ void a_ready(const Unit&) const {}
    __device__ __forceinline__ void done(const Unit&) const {}
};

typedef float f32x2c __attribute__((ext_vector_type(2))); typedef __bf16 bf16x2c __attribute__((ext_vector_type(2)));
__device__ __forceinline__ unsigned cvt_pk_bf16(float lo, float hi) { const f32x2c v = {lo, hi}; const bf16x2c b = __builtin_convertvector(v, bf16x2c); return __builtin_bit_cast(unsigned, b); }
typedef unsigned u32x2 __attribute__((ext_vector_type(2)));
__device__ __forceinline__ float bflo(unsigned w) { return __uint_as_float(w << 16); }
__device__ __forceinline__ float bfhi(unsigned w) { return __uint_as_float(w & 0xffff0000u); }
__device__ __forceinline__ u32x4 pack8(const f32x4 v0, const f32x4 v1) { u32x4 w; w.x = cvt_pk_bf16(v0[0], v0[1]); w.y = cvt_pk_bf16(v0[2], v0[3]); w.z = cvt_pk_bf16(v1[0], v1[1]); w.w = cvt_pk_bf16(v1[2], v1[3]); return w; }
__device__ __forceinline__ void unpack8(const u32x4 w, f32x4& v0, f32x4& v1) { v0 = (f32x4){bflo(w.x), bfhi(w.x), bflo(w.y), bfhi(w.y)}; v1 = (f32x4){bflo(w.z), bfhi(w.z), bflo(w.w), bfhi(w.w)}; }
constexpr float RMS_EPS = 1e-6f;
constexpr int RS_SLOTS = 8;
__device__ __forceinline__ void load_rstd(const PG8_LAS unsigned char* rst, int pm, int wr, int fr, float (&rs)[2][4]) {
    if (rst == nullptr) {
#pragma unroll
        for (int ai = 0; ai < 2; ++ai)
#pragma unroll
            for (int m = 0; m < 4; ++m) rs[ai][m] = 1.0f;
        return; }
    const PG8_LAS int* pml = (const PG8_LAS int*)rst; int slot = 0;
#pragma unroll
    for (int k = 1; k < RS_SLOTS; ++k) slot = pml[k] == pm ? k : slot;
    const PG8_LAS float* tab = (const PG8_LAS float*)(rst + 32) + slot * 256 + wr * 64 + fr;
#pragma unroll
    for (int ai = 0; ai < 2; ++ai)
#pragma unroll
        for (int m = 0; m < 4; ++m) rs[ai][m] = tab[ai * HALF + m * 16];
}
struct EpiP1 {
    static constexpr bool PERM = true, AFTER_DRAIN = false, HOOK = false; static constexpr int SEG1 = -1, SEG2 = -1;
    bf16_t* ZB; bf16_t* MIX; float* SM; const PG8_LAS unsigned char* rst; bf16_t* HALO; unsigned nost;
    __device__ __forceinline__ void rescale(f32x4 (&)[2][2][4][2], const Unit&, int, int, int, int, int) const {}
    __device__ __forceinline__ void operator()(const f32x4 (&acc)[2][2][4][2], const Unit& u, int wr, int wc, int fr, int fq) const {
        const int row0 = u.pm * BM + wr * 64 + fr;
        float rs[2][4]; load_rstd(rst, u.pm, wr, fr, rs);
        if (u.pn == 21) {
            if (wc == 0) {
#pragma unroll
                for (int ai = 0; ai < 2; ++ai)
#pragma unroll
                    for (int m = 0; m < 4; ++m) { float* p = SM + (size_t)(row0 + ai * HALF + m * 16) * 32 + 8 * fq;
                        *(f32x4*)p = acc[ai][0][m][0] * rs[ai][m]; *(f32x4*)(p + 4) = acc[ai][0][m][1] * rs[ai][m]; }
            }
            return;
        }
        const bool mixt = u.pn >= 6;
        const int colt = mixt ? (u.pn - 6) * BM : u.pn * BM, col0 = colt + wc * 32 + 8 * fq;
#pragma unroll
        for (int ai = 0; ai < 2; ++ai)
#pragma unroll
            for (int m = 0; m < 4; ++m) { const size_t row = (size_t)(row0 + ai * HALF + m * 16);
#pragma unroll
                for (int bj = 0; bj < 2; ++bj) { const u32x4 w = pack8(acc[ai][bj][m][0] * rs[ai][m], acc[ai][bj][m][1] * rs[ai][m]);
                    if (nost == 0u || (w.x ^ w.y ^ w.z) == nost) *(u32x4*)(mixt ? MIX + mixh(col0 + bj * HALF, row) : ZB + row * 1536 + col0 + bj * HALF) = w;
                    if (m == 3 && fr >= 13 && u.pn >= 6 && u.pn < 15) *(u32x4*)(HALO + ((size_t)((row0 + ai * HALF + m * 16) >> 6) * 3 + (fr - 13)) * 2304 + col0 + bj * HALF) = w; } }
    }
};
template <int ACT> struct EpiRS {
    static constexpr bool PERM = true, AFTER_DRAIN = false, HOOK = false; static constexpr int SEG1 = -1, SEG2 = -1;
    bf16_t* O; int ldc; const PG8_LAS unsigned char* rst;
    __device__ __forceinline__ void rescale(f32x4 (&)[2][2][4][2], const Unit&, int, int, int, int, int) const {}
    __device__ __forceinline__ void operator()(const f32x4 (&acc)[2][2][4][2], const Unit& u, int wr, int wc, int fr, int fq) const {
        const int row0 = u.pm * BM + wr * 64 + fr, col0 = u.pn * BM + wc * 32 + 8 * fq;
        float rs[2][4]; load_rstd(rst, u.pm, wr, fr, rs);
#pragma unroll
        for (int ai = 0; ai < 2; ++ai)
#pragma unroll
            for (int m = 0; m < 4; ++m) { bf16_t* rowp = O + (size_t)(row0 + ai * HALF + m * 16) * ldc + col0;
#pragma unroll
                for (int bj = 0; bj < 2; ++bj) { f32x4 v0 = acc[ai][bj][m][0] * rs[ai][m], v1 = acc[ai][bj][m][1] * rs[ai][m];
                    if (ACT == 1) {
#pragma unroll
                        for (int j = 0; j < 4; ++j) { const float a = fmaxf(v0[j], 0.f), b = fmaxf(v1[j], 0.f); v0[j] = a * a; v1[j] = b * b; } }
                    if (ACT == 2) {
#pragma unroll
                        for (int j = 0; j < 4; ++j) { v0[j] = __builtin_amdgcn_rcpf(1.0f + __expf(-v0[j])); v1[j] = __builtin_amdgcn_rcpf(1.0f + __expf(-v1[j])); } }
                    *(u32x4*)(rowp + bj * HALF) = pack8(v0, v1); } }
    }
};
struct EpiMerge {
    static constexpr bool PERM = true, AFTER_DRAIN = false, HOOK = true; static constexpr int SEG1 = 8, SEG2 = 16;
    const bf16_t* GATE; bf16_t* O;
    __device__ __forceinline__ void rescale(f32x4 (&acc)[2][2][4][2], const Unit& u, int seg, int wr, int wc, int, int) const {
        int t_ = threadIdx.x; asm volatile("" : "+v"(t_)); const int fr = t_ & 15, fq = (t_ & 63) >> 4;
        const int row0 = u.pm * BM + wr * 64 + fr, col0 = u.pn * BM + wc * 32 + 8 * fq + (seg - 1) * 1024;
#pragma unroll
        for (int ai = 0; ai < 2; ++ai)
#pragma unroll
            for (int m = 0; m < 4; ++m) { const bf16_t* gp = GATE + (size_t)(row0 + ai * HALF + m * 16) * 3072 + col0;
#pragma unroll
                for (int bj = 0; bj < 2; ++bj) { const u32x4 wa = *(const u32x4*)(gp + bj * HALF), wb = *(const u32x4*)(gp + bj * HALF + 1024);
                    f32x4 a0, a1, b0, b1; unpack8(wa, a0, a1); unpack8(wb, b0, b1);
#pragma unroll
                    for (int j = 0; j < 4; ++j) {
                        acc[ai][bj][m][0][j] *= a0[j] * __builtin_amdgcn_rcpf(b0[j]);
                        acc[ai][bj][m][1][j] *= a1[j] * __builtin_amdgcn_rcpf(b1[j]); } }
                if (m == 3) asm volatile("" ::: "memory"); }
    }
    __device__ __forceinline__ void operator()(const f32x4 (&acc)[2][2][4][2], const Unit& u, int wr, int wc, int fr, int fq) const {
        const int row0 = u.pm * BM + wr * 64 + fr, col0 = u.pn * BM + wc * 32 + 8 * fq;
#pragma unroll
        for (int ai = 0; ai < 2; ++ai)
#pragma unroll
            for (int m = 0; m < 4; ++m) { const size_t r = (size_t)(row0 + ai * HALF + m * 16);
#pragma unroll
                for (int bj = 0; bj < 2; ++bj) { const u32x4 wa = *(const u32x4*)(GATE + r * 3072 + 2048 + col0 + bj * HALF);
                    f32x4 a0, a1; unpack8(wa, a0, a1); f32x4 v0 = acc[ai][bj][m][0], v1 = acc[ai][bj][m][1];
#pragma unroll
                    for (int j = 0; j < 4; ++j) { v0[j] *= a0[j]; v1[j] *= a1[j]; }
                    *(u32x4*)(O + r * 1024 + col0 + bj * HALF) = pack8(v0, v1); }
                if (m == 3) asm volatile("" ::: "memory"); }
    }
};
template <int MODE> struct EpiResid {
    static constexpr bool PERM = true, AFTER_DRAIN = false, HOOK = false; static constexpr int SEG1 = -1, SEG2 = -1;
    const bf16_t* XBin; bf16_t* XBout; float* ssq_out; const PG8_LAS unsigned char* rst; const bf16_t* PLE; float scale;
    __device__ __forceinline__ void rescale(f32x4 (&)[2][2][4][2], const Unit&, int, int, int, int, int) const {}
    __device__ __forceinline__ void operator()(const f32x4 (&acc)[2][2][4][2], const Unit& u, int wr, int wc, int fr, int fq) const {
        const int row0 = u.pm * BM + wr * 64 + fr, col0 = u.pn * BM + wc * 32 + 8 * fq;
        float rs[2][4]; if (MODE == 1) load_rstd(rst, u.pm, wr, fr, rs);
#pragma unroll
        for (int ai = 0; ai < 2; ++ai)
#pragma unroll
            for (int m = 0; m < 4; ++m) { const size_t r = (size_t)(row0 + ai * HALF + m * 16); float ss = 0.f;
#pragma unroll
                for (int bj = 0; bj < 2; ++bj) { const size_t o = r * 1024 + col0 + bj * HALF;
                    f32x4 v0 = acc[ai][bj][m][0], v1 = acc[ai][bj][m][1], b0, b1; unpack8(*(const u32x4*)(XBin + o), b0, b1);
                    if (MODE == 1) { const u32x4 wp = *(const u32x4*)(PLE + o); f32x4 p0, p1; unpack8(wp, p0, p1);
#pragma unroll
                        for (int j = 0; j < 4; ++j) { v0[j] = p0[j] * __builtin_amdgcn_rcpf(1.0f + __expf(-v0[j] * rs[ai][m])); v1[j] = p1[j] * __builtin_amdgcn_rcpf(1.0f + __expf(-v1[j] * rs[ai][m])); } }
                    v0 = v0 * scale + b0; v1 = v1 * scale + b1;
                    *(u32x4*)(XBout + o) = pack8(v0, v1);
                    ss += (v0[0] * v0[0] + v0[1] * v0[1]) + (v0[2] * v0[2] + v0[3] * v0[3]) + (v1[0] * v1[0] + v1[1] * v1[1]) + (v1[2] * v1[2] + v1[3] * v1[3]); }
                ss += __shfl_xor(ss, 16); ss += __shfl_xor(ss, 32);
                if (fq == 0) ssq_out[r * 16 + u.pn * 4 + wc] = ss;
                if (m == 3) asm volatile("" ::: "memory"); }
    }
};
template <class Epi, class Sched, bool ALIGN_EPI = false, bool SP2 = false>
__device__ __forceinline__ void gemm_phase(PG8_LAS unsigned char* lds, Gemm g, const Sched& S, const Epi& E) {
    asm volatile("" : "+s"(g.A), "+s"(g.Bt), "+s"(g.K));
    int tid_ = threadIdx.x; asm volatile("" : "+v"(tid_));
    const int tid = tid_, wid = __builtin_amdgcn_readfirstlane(tid >> 6), lane = tid & 63, wr = wid >> 2, wc = wid & 3, fr = lane & 15, fq = lane >> 4;
    const int K = g.K, nt = K / BK;
    unsigned voffA[2], voffB[2];
#pragma unroll
    for (int i = 0; i < 2; ++i) { int R, C; stage_rc(tid * 16 + i * 8192, R, C); const int Rb = Epi::PERM ? ((R & ~31) + perm32(R & 31)) : R;
        voffA[i] = (unsigned)(R * K + C) * 2u; voffB[i] = (unsigned)(Rb * K + C) * 2u; }
    const size_t kstep = (size_t)(BK * 2);
    const size_t hstep = (size_t)HALF * K * 2;
    const size_t tstep = 2 * hstep;
    const unsigned ldsw = (unsigned)wid * 1024u;
    const int aoff = lds_byte(wr * 64 + fr, fq * 8), boff = lds_byte(wc * 32 + fr, fq * 8);
#define PG8_SA(b, h) (((b) * 2 + (h)) * HTB)
#define PG8_SB(b, h) ((4 + (b) * 2 + (h)) * HTB)
#define PG8_STAGE(bufoff, gbase, voff) do { _Pragma("unroll") for (int _i = 0; _i < 2; ++_i) \
        __builtin_amdgcn_global_load_lds((const unsigned*)((const char*)(gbase) + (voff)[_i]), (PG8_LAS unsigned*)(lds + (bufoff) + ldsw + _i * 8192), 16, 0, 0); } while (0)
#define PG8_LDA(dst, b, h) do { _Pragma("unroll") for (int m = 0; m < 4; ++m) _Pragma("unroll") for (int k = 0; k < 2; ++k) dst[m][k] = *(const PG8_LAS bf16x8*)(lds + PG8_SA(b, h) + aoff + m * 2048 + k * 1024); } while (0)
#define PG8_LDB(dst, b, h) do { _Pragma("unroll") for (int n = 0; n < 2; ++n) _Pragma("unroll") for (int k = 0; k < 2; ++k) dst[n][k] = *(const PG8_LAS bf16x8*)(lds + PG8_SB(b, h) + boff + n * 2048 + k * 1024); } while (0)
#define PG8_MMA(ai, bj, At, Bt) do { __builtin_amdgcn_s_setprio(1); _Pragma("unroll") for (int m = 0; m < 4; ++m) _Pragma("unroll") for (int n = 0; n < 2; ++n) _Pragma("unroll") for (int k = 0; k < 2; ++k) \
        acc[ai][bj][m][n] = __builtin_amdgcn_mfma_f32_16x16x32_bf16(Bt[n][k], At[m][k], acc[ai][bj][m][n], 0, 0, 0); __builtin_amdgcn_s_setprio(0); } while (0)
#define PG8_WAIT_V(n) asm volatile("s_waitcnt vmcnt(" #n ")" ::: "memory")
#define PG8_WAIT_L(n) asm volatile("s_waitcnt lgkmcnt(" #n ")" ::: "memory")
#define PG8_BAR __builtin_amdgcn_s_barrier()
#define PG8_SCHED __builtin_amdgcn_sched_barrier(0)
    Unit cur, nxt; int ui = 0;
    if (!S.next(0, cur)) return;
    f32x4 acc[2][2][4][2];
#pragma unroll
    for (int a = 0; a < 2; ++a)
#pragma unroll
        for (int b = 0; b < 2; ++b)
#pragma unroll
            for (int m = 0; m < 4; ++m)
#pragma unroll
                for (int n = 0; n < 2; ++n) acc[a][b][m][n] = (f32x4){0.f, 0.f, 0.f, 0.f};
    bf16x8 At[4][2], B0[2][2], B1[2][2];
    const char* cA = (const char*)g.A + (size_t)cur.pm * tstep; const char* cB = (const char*)g.Bt + (size_t)cur.pn * tstep;
    S.a_ready(cur);
    if constexpr (SP2) {
        PG8_STAGE(PG8_SB(0, 0), cB, voffB); PG8_STAGE(PG8_SB(0, 1), cB + hstep, voffB); PG8_STAGE(PG8_SA(0, 0), cA, voffA); PG8_STAGE(PG8_SA(0, 1), cA + hstep, voffA);
        if (wr == 1) PG8_BAR;
        PG8_WAIT_V(2); PG8_BAR;
        PG8_STAGE(PG8_SB(1, 0), cB + kstep, voffB); PG8_STAGE(PG8_SA(1, 0), cA + kstep, voffA); PG8_STAGE(PG8_SB(1, 1), cB + hstep + kstep, voffB);
        PG8_WAIT_V(6); PG8_BAR;
    } else {
        PG8_STAGE(PG8_SB(0, 0), cB, voffB); PG8_STAGE(PG8_SA(0, 0), cA, voffA); PG8_STAGE(PG8_SB(0, 1), cB + hstep, voffB); PG8_STAGE(PG8_SA(0, 1), cA + hstep, voffA);
        if (wr == 1) PG8_BAR;
        PG8_WAIT_V(4); PG8_BAR;
        PG8_STAGE(PG8_SB(1, 0), cB + kstep, voffB); PG8_STAGE(PG8_SA(1, 0), cA + kstep, voffA); PG8_STAGE(PG8_SB(1, 1), cB + hstep + kstep, voffB);
        PG8_WAIT_V(6); PG8_BAR;
    }
    for (;;) {
        const bool has_next = S.next(ui + 1, nxt);
        const char* nA = has_next ? (const char*)g.A + (size_t)nxt.pm * tstep : cA; const char* nB = has_next ? (const char*)g.Bt + (size_t)nxt.pn * tstep : cB;
        for (int t = 0; t < nt; t += 2) {
            const bool last = (t == nt - 2);
            const char* a1 = cA + (size_t)(t + 1) * kstep;
            const char* a2 = last ? nA : cA + (size_t)(t + 2) * kstep; const char* b2 = last ? nB : cB + (size_t)(t + 2) * kstep;
            const char* a3 = a2 + kstep; const char* b3 = b2 + kstep;
            if (last && has_next) S.a_ready(nxt);
            if constexpr (Epi::HOOK) { if (t == Epi::SEG1 || t == Epi::SEG2) E.rescale(acc, cur, t == Epi::SEG1 ? 1 : 2, wr, wc, fr, fq); }
            if constexpr (SP2) {
            PG8_LDB(B0, 0, 0); PG8_LDB(B1, 0, 1); PG8_SCHED; PG8_LDA(At, 0, 0); PG8_STAGE(PG8_SA(1, 1), a1 + hstep, voffA);
            PG8_WAIT_V(8); PG8_WAIT_L(0); PG8_BAR; PG8_MMA(0, 0, At, B0); PG8_MMA(0, 1, At, B1); PG8_BAR; PG8_SCHED;
            PG8_LDA(At, 0, 1); PG8_STAGE(PG8_SB(0, 0), b2, voffB); PG8_STAGE(PG8_SB(0, 1), b2 + hstep, voffB); PG8_STAGE(PG8_SA(0, 0), a2, voffA);
            PG8_WAIT_V(8); PG8_WAIT_L(0); PG8_BAR; PG8_MMA(1, 0, At, B0); PG8_MMA(1, 1, At, B1); PG8_BAR; PG8_SCHED;
            PG8_LDB(B0, 1, 0); PG8_LDB(B1, 1, 1); PG8_SCHED; PG8_LDA(At, 1, 0); PG8_STAGE(PG8_SA(0, 1), a2 + hstep, voffA);
            PG8_WAIT_V(8); PG8_WAIT_L(0); PG8_BAR; PG8_MMA(0, 0, At, B0); PG8_MMA(0, 1, At, B1); PG8_BAR; PG8_SCHED;
            PG8_LDA(At, 1, 1); PG8_STAGE(PG8_SB(1, 0), b3, voffB); PG8_STAGE(PG8_SB(1, 1), b3 + hstep, voffB); PG8_STAGE(PG8_SA(1, 0), a3, voffA);
            PG8_WAIT_V(8); PG8_WAIT_L(0); PG8_BAR; PG8_MMA(1, 0, At, B0); PG8_MMA(1, 1, At, B1); PG8_BAR; PG8_SCHED;
            } else {
            PG8_LDB(B0, 0, 0); PG8_SCHED; PG8_LDA(At, 0, 0); PG8_STAGE(PG8_SA(1, 1), a1 + hstep, voffA);
            PG8_WAIT_L(8); PG8_BAR; PG8_WAIT_L(0); PG8_MMA(0, 0, At, B0); PG8_BAR; PG8_SCHED;
            PG8_LDB(B1, 0, 1); PG8_STAGE(PG8_SB(0, 0), b2, voffB);
            PG8_BAR; PG8_WAIT_L(0); PG8_MMA(0, 1, At, B1); PG8_BAR;
            PG8_LDA(At, 0, 1); PG8_STAGE(PG8_SA(0, 0), a2, voffA);
            PG8_BAR; PG8_WAIT_L(0); PG8_MMA(1, 0, At, B0); PG8_BAR; PG8_SCHED;
            PG8_STAGE(PG8_SB(0, 1), b2 + hstep, voffB);
            PG8_WAIT_V(6); PG8_BAR; PG8_MMA(1, 1, At, B1); PG8_BAR;
            PG8_LDB(B0, 1, 0); PG8_SCHED; PG8_LDA(At, 1, 0); PG8_STAGE(PG8_SA(0, 1), a2 + hstep, voffA);
            PG8_WAIT_L(8); PG8_BAR; PG8_WAIT_L(0); PG8_MMA(0, 0, At, B0); PG8_BAR; PG8_SCHED;
            PG8_LDB(B1, 1, 1); PG8_STAGE(PG8_SB(1, 0), b3, voffB);
            PG8_BAR; PG8_WAIT_L(0); PG8_MMA(0, 1, At, B1); PG8_BAR;
            PG8_LDA(At, 1, 1); PG8_STAGE(PG8_SA(1, 0), a3, voffA);
            PG8_BAR; PG8_WAIT_L(0); PG8_MMA(1, 0, At, B0); PG8_BAR; PG8_SCHED;
            PG8_STAGE(PG8_SB(1, 1), b3 + hstep, voffB);
            PG8_WAIT_V(6); PG8_BAR; PG8_MMA(1, 1, At, B1); PG8_BAR;
            }
        }
        if constexpr (ALIGN_EPI) { if (wr == 0) PG8_BAR; }
        if constexpr (!Epi::AFTER_DRAIN) { int t2_ = threadIdx.x; asm volatile("" : "+v"(t2_)); E(acc, cur, wr, wc, t2_ & 15, (t2_ & 63) >> 4); S.done(cur); }
        if (!has_next) break;
#pragma unroll
        for (int a = 0; a < 2; ++a)
#pragma unroll
            for (int b = 0; b < 2; ++b)
#pragma unroll
                for (int m = 0; m < 4; ++m)
#pragma unroll
                    for (int n = 0; n < 2; ++n) acc[a][b][m][n] = (f32x4){0.f, 0.f, 0.f, 0.f};
        cur = nxt; cA = nA; cB = nB; ++ui;
        if constexpr (ALIGN_EPI) { if (wr == 1) PG8_BAR; }
    }
    PG8_WAIT_V(0);
    if constexpr (!ALIGN_EPI) { if (wr == 0) PG8_BAR; }
    PG8_BAR;
    if constexpr (Epi::AFTER_DRAIN) { E.fused(acc, cur, wr, wc, fr, fq, lds, wid, lane); S.done(cur); }
#undef PG8_SA
#undef PG8_SB
#undef PG8_STAGE
#undef PG8_LDA
#undef PG8_LDB
#undef PG8_MMA
#undef PG8_WAIT_V
#undef PG8_WAIT_L
#undef PG8_BAR
#undef PG8_SCHED
}
}
constexpr int DM = 1024, NBATCH = 8, SEQ = 4096, MTOK = NBATCH * SEQ, DEPTH = 2, DFF = 4096, PLED = 256, NIN = 8472;
constexpr int ZB_LD = 1536, MIX_LD = 3840, SM_LD = 32, N1 = 5632, NGATE = 3072, KMERGE = 1536;
constexpr int MX_AQ = 0, MX_AK = 512, MX_AV = 1024, MX_BX = 1536, MX_BB = 2048, MX_BC = 2176, MX_CQ = 2304, MX_CK = 2816, MX_CV = 3328;
constexpr size_t KiB = 1024, MiB = 1024 * 1024;
constexpr size_t WS_CTL = 0, CTL_BYTES = 64 * KiB;
constexpr size_t WS_W = 64 * KiB;
constexpr size_t W_1T = WS_W, W_GT = W_1T + (size_t)N1 * DM * 2, W_MT = W_GT + (size_t)NGATE * DM * 2, W_OT = W_MT + (size_t)DM * KMERGE * 2, W_UT = W_OT + (size_t)DM * DM * 2,
                 W_DT = W_UT + (size_t)DFF * DM * 2, W_PGT = W_DT + (size_t)DM * DFF * 2, W_PPT = W_PGT + (size_t)DM * DM * 2, W_END = W_PPT + (size_t)DM * PLED * 2;
constexpr size_t WS_SSQA = W_1T + 1 * MiB, WS_SSQB = W_1T + 3 * MiB;
constexpr size_t WS_XB0 = W_END, WS_XB1 = WS_XB0 + 64 * MiB, WS_ZB = WS_XB1 + 64 * MiB, WS_MIX = WS_ZB + 96 * MiB, WS_SM = WS_MIX + 240 * MiB, WS_SSQC = WS_SM + 4 * MiB, WS_ROPE = WS_SSQC + 2 * MiB, WS_END = WS_ROPE + 1 * MiB;
constexpr size_t WS_PB = WS_ZB, WS_PLE = WS_ZB + 16 * MiB, WS_U = WS_ZB + 80 * MiB, WS_GATE = WS_MIX;
static_assert(W_END == WS_W + (size_t)(40 * MiB + 512 * KiB), "weights");
static_assert(WS_U + (size_t)MTOK * DFF * 2 == WS_SM, "U overlay");
static_assert(WS_END <= 512 * MiB, "workspace");
constexpr int LDS_BYTES = 147456, RING_BYTES = 131072, MISC_OFF = RING_BYTES + 320, RS_OFF = RING_BYTES + 1024;
static_assert(RS_OFF + 32 + pg8::RS_SLOTS * 1024 <= LDS_BYTES, "LDS map");

#define GAS __attribute__((address_space(1)))
#define LAS __attribute__((address_space(3)))
typedef unsigned short bf16;
typedef unsigned v4u __attribute__((ext_vector_type(4)));
typedef unsigned v2u __attribute__((ext_vector_type(2)));
typedef float f32x4 __attribute__((ext_vector_type(4)));
#define LDS_WAIT() asm volatile("s_waitcnt lgkmcnt(0)" ::: "memory")
typedef float f32x2_t __attribute__((ext_vector_type(2))); typedef __bf16 bf16x2_t __attribute__((ext_vector_type(2)));
__device__ __forceinline__ unsigned pk2(float lo, float hi) { f32x2_t v = {lo, hi}; bf16x2_t b = __builtin_convertvector(v, bf16x2_t); return __builtin_bit_cast(unsigned, b); }
__device__ __forceinline__ unsigned f2bf(float f) { return pk2(f, 0.f) & 0xffffu; }
__device__ __forceinline__ float bf2f(bf16 v) { return __uint_as_float((unsigned)v << 16); }
__device__ __forceinline__ float wave_sum(float v) {
#pragma unroll
    for (int o = 1; o < 64; o <<= 1) v += __shfl_xor(v, o);
    return v;
}
__device__ __forceinline__ float siluf(float x) { return x * __builtin_amdgcn_rcpf(1.0f + __expf(-x)); }
__device__ __forceinline__ float sigmf(float x) { return __builtin_amdgcn_rcpf(1.0f + __expf(-x)); }
__device__ __forceinline__ float softplusf(float x) { return fmaxf(x, 0.f) + log1pf(__expf(-fabsf(x))); }
__device__ __forceinline__ float rdl(float v, int l) { return __int_as_float(__builtin_amdgcn_readlane(__float_as_int(v), l)); }

#define XB_TMO      128
#define XB_XCNT(j)  (256  + 64 * (j))
#define XB_XSUB(j)  (1280 + 64 * (j))
#define XB_XGEN(j)  (2304 + 64 * (j))
#define XB_TOP      3328
#define XB_TOPGEN   3392
#define XCD_BAR_WORDS 3456
#define XB_SPIN_CAP (1u << 18)
__device__ __forceinline__ unsigned xb_ld(unsigned* p)              { return __hip_atomic_load(p, __ATOMIC_RELAXED, __HIP_MEMORY_SCOPE_AGENT); }
__device__ __forceinline__ unsigned xb_add(unsigned* p, unsigned v) { return __hip_atomic_fetch_add(p, v, __ATOMIC_RELAXED, __HIP_MEMORY_SCOPE_AGENT); }
__device__ __forceinline__ unsigned xb_xcc_id() { return (unsigned)__builtin_amdgcn_s_getreg((3 << 11) | 20) & 0xFu; }
#define XB_SPIN(cond, bar) do { unsigned _sp = 0; while (cond) { __builtin_amdgcn_s_sleep(1); \
    if ((++_sp & 255u) == 0u) { if (xb_ld(&(bar)[XB_TMO])) break; if (_sp > XB_SPIN_CAP) { atomicAdd(&(bar)[XB_TMO], 1u); break; } } } } while (0)
struct XcdBarrier { unsigned* bar; unsigned x; volatile LAS unsigned* st; };
__device__ __forceinline__ XcdBarrier xcd_barrier_post(unsigned* bar, volatile LAS unsigned* st) {
    XcdBarrier b; b.bar = bar; b.x = xb_xcc_id(); b.st = st;
    if (threadIdx.x == 0) (void)xb_add(&bar[XB_XCNT(b.x)], 1u);
    return b;
}
__device__ __forceinline__ void xcd_barrier_complete(unsigned* bar, unsigned x, unsigned& nloc, unsigned& nx) {
    const unsigned G = gridDim.x * gridDim.y * gridDim.z;
    unsigned sum, cnt, mine, sp = 0u;
    for (;;) {
        sum = 0u; cnt = 0u; mine = 0u;
#pragma unroll
        for (unsigned j = 0; j < 16; ++j) { const unsigned c = xb_ld(&bar[XB_XCNT(j)]); sum += c; cnt += (c > 0u) ? 1u : 0u; mine = (j == x) ? c : mine; }
        if (sum == G) break;
        __builtin_amdgcn_s_sleep(1);
        if ((++sp & 255u) == 0u) { if (xb_ld(&bar[XB_TMO])) break; if (sp > XB_SPIN_CAP) { atomicAdd(&bar[XB_TMO], 1u); break; } }
    }
    nloc = mine > 0u ? mine : 1u; nx = cnt > 0u ? cnt : 1u;
}
__device__ __forceinline__ void xcd_barrier(const XcdBarrier& b) {
    asm volatile("s_waitcnt vmcnt(0)" ::: "memory");
    __syncthreads();
    if (threadIdx.x == 0) {
        unsigned* bar = b.bar;
        __builtin_amdgcn_s_waitcnt(0);
        unsigned nloc = b.st[0], nx = b.st[1];
        if (nloc == 0u) { xcd_barrier_complete(bar, b.x, nloc, nx); b.st[0] = nloc; b.st[1] = nx; }
        const unsigned old = xb_add(&bar[XB_XSUB(b.x)], 1u);
        const unsigned gen = old / nloc;
        if (old + 1u == (gen + 1u) * nloc) {
            __builtin_amdgcn_fence(__ATOMIC_RELEASE, "agent");
            asm volatile("s_waitcnt vmcnt(0)" ::: "memory");
            const unsigned og = xb_add(&bar[XB_TOP], 1u);
            const unsigned tg = og / nx;
            if (og + 1u == (tg + 1u) * nx) xb_add(&bar[XB_TOPGEN], 1u);
            else XB_SPIN(xb_ld(&bar[XB_TOPGEN]) == tg, bar);
            __builtin_amdgcn_fence(__ATOMIC_ACQUIRE, "agent");
            xb_add(&bar[XB_XGEN(b.x)], 1u);
            asm volatile("s_waitcnt vmcnt(0)" ::: "memory");
        } else {
            XB_SPIN(xb_ld(&bar[XB_XGEN(b.x)]) == gen, bar);
            __builtin_amdgcn_fence(__ATOMIC_ACQUIRE, "agent");
            asm volatile("s_waitcnt vmcnt(0)" ::: "memory");
        }
    }
    __syncthreads();
}

__device__ __forceinline__ void tr_item(const float* W, int ldw, int c0, int ncols, const float* scale, bf16* dst, int ldd, int r0, int kofs, LAS unsigned char* lds, int item, int tid) {
    const int lane = tid & 63, wave = __builtin_amdgcn_readfirstlane(tid >> 6);
    const int nblk = (ncols + 255) / 256, kb = item / nblk, nb = item - kb * nblk, k0 = 64 * kb, n0 = 256 * nb;
    asm volatile("s_waitcnt lgkmcnt(0)\n\ts_barrier" ::: "memory");
    float v[8][4];
    const int n = n0 + 4 * lane;
    const bool vec = W != nullptr && ((c0 | ldw) & 3) == 0 && n + 3 < ncols;
    const float* wp = W + (size_t)(k0 + 8 * wave) * ldw + c0 + n;
#pragma unroll
    for (int kk = 0; kk < 8; ++kk) {
        if (vec) { const f32x4 t = *(const GAS f32x4*)(wp + (size_t)kk * ldw); v[kk][0] = t[0]; v[kk][1] = t[1]; v[kk][2] = t[2]; v[kk][3] = t[3]; }
        else {
#pragma unroll
            for (int q = 0; q < 4; ++q) v[kk][q] = (W != nullptr && n + q < ncols) ? wp[(size_t)kk * ldw + q] : 0.f; }
        if (scale) { const float s = scale[k0 + 8 * wave + kk];
#pragma unroll
            for (int q = 0; q < 4; ++q) v[kk][q] *= s; } }
#pragma unroll
    for (int q = 0; q < 4; ++q) { v4u o; o.x = pk2(v[0][q], v[1][q]); o.y = pk2(v[2][q], v[3][q]); o.z = pk2(v[4][q], v[5][q]); o.w = pk2(v[6][q], v[7][q]);
        *(LAS v4u*)(lds + (4 * lane + q) * 128 + ((wave ^ (lane & 7)) << 4)) = o; }
    asm volatile("s_waitcnt lgkmcnt(0)\n\ts_barrier" ::: "memory");
#pragma unroll
    for (int i = 0; i < 4; ++i) { const int nl = (tid >> 3) + 64 * i, ch = tid & 7;
        if (n0 + nl < ncols) *(GAS v4u*)(dst + (size_t)(r0 + n0 + nl) * ldd + kofs + k0 + ch * 8) = *(const LAS v4u*)(lds + nl * 128 + ((ch ^ ((nl >> 2) & 7)) << 4)); }
}
#define TR_SEG(W_, ldw_, c0_, ncols_, K_, scale_, dst_, ldd_, r0_, kofs_) do { const int _n = ((K_) / 64) * (((ncols_) + 255) / 256); \
    for (int _it = (bx + G - (ibase % G)) % G; _it < _n; _it += G) tr_item(W_, ldw_, c0_, ncols_, scale_, dst_, ldd_, r0_, kofs_, lds, _it, tid); ibase += _n; } while (0)

__device__ __forceinline__ void build_rs_table(const pg8::StaticOrder& S, const float* ssqp, LAS unsigned char* lds, int tid) {
    LAS int* pml = (LAS int*)(lds + RS_OFF); LAS float* tab = (LAS float*)(lds + RS_OFF + 32);
    __syncthreads();
    if (tid == 0) { int npm = 0;
        for (int k = 0; k < pg8::RS_SLOTS; ++k) pml[k] = -1;
        for (int i = 0; ; ++i) { pg8::Unit u; if (!S.next(i, u)) break; bool found = false;
            for (int k = 0; k < npm; ++k) found = found || (pml[k] == u.pm);
            if (!found && npm < pg8::RS_SLOTS) pml[npm++] = u.pm; } }
    __syncthreads();
#pragma unroll 1
    for (int s = tid >> 8; s < pg8::RS_SLOTS; s += 2) { const int pm = pml[s]; if (pm < 0) continue;
        const float* p = ssqp + ((size_t)pm * 256 + (tid & 255)) * 16;
        const f32x4 a = *(const f32x4*)p, b = *(const f32x4*)(p + 4), c = *(const f32x4*)(p + 8), d = *(const f32x4*)(p + 12);
        const float ss = ((a[0] + a[1]) + (a[2] + a[3])) + ((b[0] + b[1]) + (b[2] + b[3])) + ((c[0] + c[1]) + (c[2] + c[3])) + ((d[0] + d[1]) + (d[2] + d[3]));
        tab[s * 256 + (tid & 255)] = rsqrtf(ss * (1.0f / 1024.0f) + 1e-6f); }
    __syncthreads();
}
struct Args { const float* in[23]; float* out; unsigned char* ws; int ph_lo, ph_hi; };
constexpr int NPH = 10, PH_FINAL = DEPTH * NPH, N_PHASES = PH_FINAL + 1;

typedef short bf16x8 __attribute__((ext_vector_type(8)));
constexpr int PT = 72, MAT = 64 * PT * 2;
constexpr int SETB = 4 * MAT + 512;
constexpr int L_Q = 0, L_K = MAT, L_V = 2 * MAT, L_U = 2 * MAT, L_W = 3 * MAT, L_G = 4 * MAT, L_DT = 4 * MAT + 256;
constexpr int L_VT = 2 * SETB, L_ST0 = L_VT + MAT, L_ST1 = L_ST0 + MAT, L_PP = L_ST1 + MAT, L_YT = L_PP + MAT, L_WEND = L_YT + 2 * MAT;
static_assert(L_WEND <= RING_BYTES, "walker LDS");
constexpr size_t GW_OFF = 0, HALO_OFF = 32 * MiB;
constexpr int HALO_LD = 2304;
#define MFMA16(a, b, c) __builtin_amdgcn_mfma_f32_16x16x32_bf16(a, b, c, 0, 0, 0)
__device__ __forceinline__ bf16x8 ldfrag(LAS unsigned char* base, int row, int kelem) { return *(const LAS bf16x8*)(base + row * (PT * 2) + kelem * 2); }
__device__ __forceinline__ void unpk8(const v4u w, float (&f)[8]) { f[0] = pg8::bflo(w.x); f[1] = pg8::bfhi(w.x); f[2] = pg8::bflo(w.y); f[3] = pg8::bfhi(w.y); f[4] = pg8::bflo(w.z); f[5] = pg8::bfhi(w.z); f[6] = pg8::bflo(w.w); f[7] = pg8::bfhi(w.w); }
__device__ __forceinline__ v4u pk8(const float (&f)[8]) { v4u w; w.x = pk2(f[0], f[1]); w.y = pk2(f[2], f[3]); w.z = pk2(f[4], f[5]); w.w = pk2(f[6], f[7]); return w; }
__device__ __forceinline__ void st_tr8(LAS unsigned char* base, int row0, int col, const float (&f)[8]) {
#pragma unroll
    for (int j = 0; j < 8; ++j) *(LAS bf16*)(base + (row0 + j) * (PT * 2) + col * 2) = (bf16)f2bf(f[j]);
}

#define LBAR() asm volatile("s_waitcnt lgkmcnt(0)\n\ts_barrier" ::: "memory")
typedef short s16x4 __attribute__((ext_vector_type(4)));
__device__ __forceinline__ s16x4 tr4(LAS unsigned char* p) { return __builtin_bit_cast(s16x4, __builtin_amdgcn_ds_read_tr16_b64_v4i16((LAS s16x4*)p)); }
__device__ __forceinline__ bf16x8 trfrag(LAS unsigned char* tile, int krow0, int col0, int fr) {
    LAS unsigned char* a = tile + (krow0 + (fr >> 2)) * (PT * 2) + (col0 + 4 * (fr & 3)) * 2;
    const s16x4 lo = tr4(a), hi = tr4(a + 4 * PT * 2);
    return (bf16x8){lo[0], lo[1], lo[2], lo[3], hi[0], hi[1], hi[2], hi[3]};
}
__device__ __forceinline__ float bfs(short v) { return __uint_as_float((unsigned)(unsigned short)v << 16); }

template <int KIND>
__device__ __forceinline__ void mixer_walk(const __attribute__((address_space(4))) Args* kp, int layer, int b, int h, LAS unsigned char* lds) {
    int tid = threadIdx.x; asm volatile("" : "+v"(tid));
    const int lane = tid & 63, wave = __builtin_amdgcn_readfirstlane(tid >> 6), fr = lane & 15, fq = lane >> 4;
    const int prow = tid >> 3, pcg = tid & 7;
    unsigned char* ws = kp->ws;
    const bf16* MIX = (const bf16*)(ws + WS_MIX); bf16* ZB = (bf16*)(ws + WS_ZB); float* SM = (float*)(ws + WS_SM);
    const bf16* GW = (const bf16*)(ws + ((layer & 1) ? WS_XB0 : WS_XB1) + GW_OFF);
    const size_t tok0 = (size_t)b * SEQ;
    const int g = h >> 2;
    const int qcol = (KIND == 0 ? MX_AQ + h * 64 : (KIND == 1 ? MX_BC + g * 64 : MX_CQ + h * 64)) + pcg * 8;
    const int kcol = (KIND == 0 ? MX_AK + h * 64 : (KIND == 1 ? MX_BB + g * 64 : MX_CK + h * 64)) + pcg * 8;
    const int vcol = (KIND == 0 ? MX_AV + h * 64 : (KIND == 1 ? MX_BX + h * 64 : MX_CV + h * 64)) + pcg * 8;
    const int zcol = KIND * 512 + h * 64 + pcg * 8;
    const int gcol = (KIND == 0 ? 8 : 16) + h;
    float nw[8];
    if (KIND == 0) {
#pragma unroll
        for (int j = 0; j < 8; ++j) nw[j] = kp->in[7][layer * 64 + pcg * 8 + j];
    }
    const float p_D = KIND == 1 ? kp->in[12][layer * 8 + h] : 0.f;
    const float p_lg = KIND == 2 ? log1pf(-exp2f(-5.0f - (float)h)) : 0.f;
    for (int i = tid; i < MAT / 4; i += 512) ((LAS unsigned*)(lds + L_ST0))[i] = 0u;
    pg8::f32x4 sacc[4];
#pragma unroll
    for (int i = 0; i < 4; ++i) sacc[i] = (pg8::f32x4){0.f, 0.f, 0.f, 0.f};
    LAS unsigned char* PPw = lds + L_PP + (wave & 3) * (16 * PT * 2);

    v4u tq, tk, tv, tw, tz; float sg = 0.f, sd = 1.f; (void)tw;
#define WALK_LOAD(c) do { const size_t row = tok0 + (size_t)(c) * 64 + prow; \
        tq = *(const GAS v4u*)(MIX + mixh(qcol, row)); tk = *(const GAS v4u*)(MIX + mixh(kcol, row)); tv = *(const GAS v4u*)(MIX + mixh(vcol, row)); \
        if (KIND == 0) tw = *(const GAS v4u*)(GW + gwh(h, pcg * 8, row)); \
        tz = *(const GAS v4u*)(ZB + row * ZB_LD + zcol); \
        if (tid < 64) { const size_t r2 = tok0 + (size_t)(c) * 64 + tid; \
            if (KIND == 2) sg = (float)(tid + 1) * p_lg; else sg = SM[r2 * SM_LD + gcol]; \
            if (KIND == 1) sd = SM[r2 * SM_LD + 24 + h]; } } while (0)
#define WALK_PREP(sb_) do { LAS unsigned char* sp_ = lds + (sb_) * SETB; \
        *(LAS v4u*)(sp_ + L_Q + prow * (PT * 2) + pcg * 16) = tq; *(LAS v4u*)(sp_ + L_K + prow * (PT * 2) + pcg * 16) = tk; \
        *(LAS v4u*)(sp_ + L_V + prow * (PT * 2) + pcg * 16) = tv; \
        if (KIND == 0) *(LAS v4u*)(sp_ + L_W + prow * (PT * 2) + pcg * 16) = tw; \
        if (tid < 64) { ((LAS float*)(sp_ + L_G))[tid] = sg; ((LAS float*)(sp_ + L_DT))[tid] = sd; } } while (0)

    WALK_LOAD(0);
    WALK_PREP(0);
    v4u zc = tz, xc = tv;
    LBAR();
    for (int c = 0; c < SEQ / 64; ++c) {
        LAS unsigned char* STc = lds + ((c & 1) ? L_ST1 : L_ST0); LAS unsigned char* STn = lds + ((c & 1) ? L_ST0 : L_ST1);
        LAS unsigned char* sp = lds + (c & 1) * SETB;
        const LAS float* Gv = (const LAS float*)(sp + L_G); const LAS float* Dv = (const LAS float*)(sp + L_DT);
        LAS unsigned char* YTc = lds + L_YT + (c & 1) * MAT;
        if (c + 1 < SEQ / 64) WALK_LOAD(c + 1);
        bf16x8 Qf[2];
        if (wave < 4) { const int lb = wave;
            Qf[0] = ldfrag(sp + L_Q, 16 * lb + fr, 8 * fq); Qf[1] = ldfrag(sp + L_Q, 16 * lb + fr, 32 + 8 * fq);
            bf16x8 Kb[4][2]; pg8::f32x4 gs[4], ds[4], pacc[4];
#pragma unroll
            for (int sb = 0; sb < 4; ++sb) if (sb <= lb) { Kb[sb][0] = ldfrag(sp + L_K, 16 * sb + fr, 8 * fq); Kb[sb][1] = ldfrag(sp + L_K, 16 * sb + fr, 32 + 8 * fq);
                gs[sb] = *(const LAS pg8::f32x4*)(Gv + 16 * sb + 4 * fq); ds[sb] = (pg8::f32x4){1.f, 1.f, 1.f, 1.f};
                if (KIND == 1) ds[sb] = *(const LAS pg8::f32x4*)(Dv + 16 * sb + 4 * fq); }
            const float gl = Gv[16 * lb + fr];
#pragma unroll
            for (int sb = 0; sb < 4; ++sb) if (sb <= lb) { pacc[sb] = MFMA16(Kb[sb][0], Qf[0], ((pg8::f32x4){0.f, 0.f, 0.f, 0.f})); }
#pragma unroll
            for (int sb = 0; sb < 4; ++sb) if (sb <= lb) { pacc[sb] = MFMA16(Kb[sb][1], Qf[1], pacc[sb]); }
#pragma unroll
            for (int sb = 0; sb < 4; ++sb) { v2u o; o.x = 0u; o.y = 0u;
                if (sb <= lb) { float pv[4];
#pragma unroll
                    for (int r = 0; r < 4; ++r) pv[r] = (16 * sb + 4 * fq + r <= 16 * lb + fr) ? pacc[sb][r] * __expf(gl - gs[sb][r]) * ds[sb][r] : 0.f;
                    o.x = pk2(pv[0], pv[1]); o.y = pk2(pv[2], pv[3]); }
                *(LAS v2u*)(PPw + fr * (PT * 2) + (16 * sb + 4 * fq) * 2) = o; }
        } else if (KIND == 0) { const int wq = wave - 4;
            const bf16x8 Wf0 = ldfrag(sp + L_W, 16 * wq + fr, 8 * fq), Wf1 = ldfrag(sp + L_W, 16 * wq + fr, 32 + 8 * fq);
            bf16x8 Sf[4][2]; s16x4 u4[4]; pg8::f32x4 vacc[4];
#pragma unroll
            for (int eb = 0; eb < 4; ++eb) { Sf[eb][0] = ldfrag(STc, 16 * eb + fr, 8 * fq); Sf[eb][1] = ldfrag(STc, 16 * eb + fr, 32 + 8 * fq);
                u4[eb] = tr4(sp + L_U + (16 * wq + 4 * fq + (fr >> 2)) * (PT * 2) + (16 * eb + 4 * (fr & 3)) * 2); }
#pragma unroll
            for (int eb = 0; eb < 4; ++eb) vacc[eb] = MFMA16(Wf0, Sf[eb][0], ((pg8::f32x4){0.f, 0.f, 0.f, 0.f}));
#pragma unroll
            for (int eb = 0; eb < 4; ++eb) vacc[eb] = MFMA16(Wf1, Sf[eb][1], vacc[eb]);
#pragma unroll
            for (int eb = 0; eb < 4; ++eb) { v2u o; o.x = pk2(bfs(u4[eb][0]) - vacc[eb][0], bfs(u4[eb][1]) - vacc[eb][1]); o.y = pk2(bfs(u4[eb][2]) - vacc[eb][2], bfs(u4[eb][3]) - vacc[eb][3]);
                *(LAS v2u*)(lds + L_VT + (16 * eb + fr) * (PT * 2) + (16 * wq + 4 * fq) * 2) = o; }
        }
        if (KIND == 0) LBAR();
        if (wave < 4) { const int lb = wave;
            const bf16x8 Pf0 = ldfrag(PPw, fr, 8 * fq), Pf1 = ldfrag(PPw, fr, 32 + 8 * fq);
            const pg8::f32x4 gv = *(const LAS pg8::f32x4*)(Gv + 16 * lb + 4 * fq);
            bf16x8 Sf[4][2], Vf[4][2]; pg8::f32x4 yacc[4];
#pragma unroll
            for (int eb = 0; eb < 4; ++eb) { Sf[eb][0] = ldfrag(STc, 16 * eb + fr, 8 * fq); Sf[eb][1] = ldfrag(STc, 16 * eb + fr, 32 + 8 * fq);
                if (KIND == 0) { Vf[eb][0] = ldfrag(lds + L_VT, 16 * eb + fr, 8 * fq); Vf[eb][1] = ldfrag(lds + L_VT, 16 * eb + fr, 32 + 8 * fq); }
                else { Vf[eb][0] = trfrag(sp + L_V, 8 * fq, 16 * eb, fr); Vf[eb][1] = trfrag(sp + L_V, 32 + 8 * fq, 16 * eb, fr); } }
            const pg8::f32x4 eg = (pg8::f32x4){__expf(gv[0]), __expf(gv[1]), __expf(gv[2]), __expf(gv[3])};
#pragma unroll
            for (int eb = 0; eb < 4; ++eb) yacc[eb] = MFMA16(Qf[0], Sf[eb][0], ((pg8::f32x4){0.f, 0.f, 0.f, 0.f}));
#pragma unroll
            for (int eb = 0; eb < 4; ++eb) yacc[eb] = MFMA16(Qf[1], Sf[eb][1], yacc[eb]);
#pragma unroll
            for (int eb = 0; eb < 4; ++eb) yacc[eb] *= eg;
#pragma unroll
            for (int eb = 0; eb < 4; ++eb) yacc[eb] = MFMA16(Pf0, Vf[eb][0], yacc[eb]);
#pragma unroll
            for (int eb = 0; eb < 4; ++eb) yacc[eb] = MFMA16(Pf1, Vf[eb][1], yacc[eb]);
#pragma unroll
            for (int eb = 0; eb < 4; ++eb)
#pragma unroll
                for (int r = 0; r < 4; ++r) *(LAS bf16*)(YTc + (16 * lb + 4 * fq + r) * (PT * 2) + (16 * eb + fr) * 2) = (bf16)f2bf(yacc[eb][r]);
        } else { const int db = wave - 4;
            const float glast = Gv[63], egl = __expf(glast);
            bf16x8 Kr[2], Vf[4][2]; pg8::f32x4 g0[2], g1[2], d0[2], d1[2];
#pragma unroll
            for (int ks = 0; ks < 2; ++ks) { Kr[ks] = trfrag(sp + L_K, 32 * ks + 8 * fq, 16 * db, fr);
                g0[ks] = *(const LAS pg8::f32x4*)(Gv + 32 * ks + 8 * fq); g1[ks] = *(const LAS pg8::f32x4*)(Gv + 32 * ks + 8 * fq + 4);
                d0[ks] = (pg8::f32x4){1.f, 1.f, 1.f, 1.f}; d1[ks] = d0[ks];
                if (KIND == 1) { d0[ks] = *(const LAS pg8::f32x4*)(Dv + 32 * ks + 8 * fq); d1[ks] = *(const LAS pg8::f32x4*)(Dv + 32 * ks + 8 * fq + 4); } }
#pragma unroll
            for (int eb = 0; eb < 4; ++eb) {
                if (KIND == 0) { Vf[eb][0] = ldfrag(lds + L_VT, 16 * eb + fr, 8 * fq); Vf[eb][1] = ldfrag(lds + L_VT, 16 * eb + fr, 32 + 8 * fq); }
                else { Vf[eb][0] = trfrag(sp + L_V, 8 * fq, 16 * eb, fr); Vf[eb][1] = trfrag(sp + L_V, 32 + 8 * fq, 16 * eb, fr); } }
            bf16x8 Kf[2];
#pragma unroll
            for (int ks = 0; ks < 2; ++ks) { float kf[8];
#pragma unroll
                for (int j = 0; j < 4; ++j) { kf[j] = bfs(Kr[ks][j]) * __expf(glast - g0[ks][j]) * d0[ks][j]; kf[4 + j] = bfs(Kr[ks][4 + j]) * __expf(glast - g1[ks][j]) * d1[ks][j]; }
                const v4u kw = pk8(kf); Kf[ks] = __builtin_bit_cast(bf16x8, kw); }
#pragma unroll
            for (int eb = 0; eb < 4; ++eb) sacc[eb] = MFMA16(Kf[0], Vf[eb][0], sacc[eb] * egl);
#pragma unroll
            for (int eb = 0; eb < 4; ++eb) sacc[eb] = MFMA16(Kf[1], Vf[eb][1], sacc[eb]);
#pragma unroll
            for (int eb = 0; eb < 4; ++eb) { v2u o; o.x = pk2(sacc[eb][0], sacc[eb][1]); o.y = pk2(sacc[eb][2], sacc[eb][3]);
                *(LAS v2u*)(STn + (16 * eb + fr) * (PT * 2) + (16 * db + 4 * fq) * 2) = o; }
        }
        const v4u zcur = zc, xcur = xc; (void)xcur;
        if (c + 1 < SEQ / 64) { WALK_PREP((c + 1) & 1); zc = tz; xc = tv; }
        LBAR();
        {
            float y[8], zf[8]; unpk8(*(const LAS v4u*)(YTc + prow * (PT * 2) + pcg * 16), y); unpk8(zcur, zf);
            const size_t row = tok0 + (size_t)c * 64 + prow;
            if (KIND == 1) { float ss = 0.f, xf[8]; unpk8(xcur, xf);
#pragma unroll
                for (int j = 0; j < 8; ++j) { y[j] = (y[j] + p_D * xf[j]) * siluf(zf[j]); ss += y[j] * y[j]; }
                ss += __shfl_xor(ss, 1); ss += __shfl_xor(ss, 2); ss += __shfl_xor(ss, 4);
                if (pcg == 0) SM[row * SM_LD + 16 + h] = ss;
            } else { float ss = 0.f;
#pragma unroll
                for (int j = 0; j < 8; ++j) ss += y[j] * y[j];
                ss += __shfl_xor(ss, 1); ss += __shfl_xor(ss, 2); ss += __shfl_xor(ss, 4);
                const float rstd = rsqrtf(ss * (1.0f / 64.0f) + 1e-6f);
#pragma unroll
                for (int j = 0; j < 8; ++j) y[j] = y[j] * rstd * (KIND == 0 ? nw[j] : 1.0f) * siluf(zf[j]); }
            *(GAS v4u*)(ZB + row * ZB_LD + zcol) = pk8(y);
        }
    }
#undef WALK_LOAD
#undef WALK_PREP
}

constexpr int SP_RAW = 0, SP_CW = 67 * 1536, SP_END = SP_CW + 5 * 768 * 4;
static_assert(SP_END <= RING_BYTES, "ssd_prep LDS");
__device__ __forceinline__ void ssd_prep(const __attribute__((address_space(4))) Args* kp, int layer, LAS unsigned char* lds, int G_) {
    int tid = threadIdx.x; asm volatile("" : "+v"(tid));
    const int lane = tid & 63, wave = __builtin_amdgcn_readfirstlane(tid >> 6);
    unsigned char* ws = kp->ws;
    bf16* MIX = (bf16*)(ws + WS_MIX); float* SM = (float*)(ws + WS_SM);
    const bf16* HALO = (const bf16*)(ws + ((layer & 1) ? WS_XB0 : WS_XB1) + HALO_OFF);
    LAS float* CW = (LAS float*)(lds + SP_CW);
    { const float* cw = kp->in[8] + (size_t)layer * 4 * 768; const float* cb = kp->in[9] + (size_t)layer * 768;
      for (int i = tid; i < 768; i += 512) { CW[i] = cw[i]; CW[768 + i] = cw[768 + i]; CW[2 * 768 + i] = cw[2 * 768 + i]; CW[3 * 768 + i] = cw[3 * 768 + i]; CW[4 * 768 + i] = cb[i]; } }
    const float Aexp = expf(kp->in[10][layer * 8 + wave]), dtb = kp->in[11][layer * 8 + wave];
    for (int unit = blockIdx.x; unit < NBATCH * 64; unit += G_) { const int b = unit >> 6, c = unit & 63; const size_t tok0 = (size_t)b * SEQ + (size_t)c * 64;
        LBAR();
        for (int i = tid; i < 67 * 96; i += 512) { const int r = i / 96, pc = i - r * 96; v4u v = (v4u){0u, 0u, 0u, 0u};
            if (r >= 3) v = *(const GAS v4u*)(MIX + mixh(MX_BX + pc * 8, tok0 + r - 3));
            else if (c > 0) v = *(const GAS v4u*)(HALO + ((size_t)(b * 64 + c - 1) * 3 + r) * HALO_LD + MX_BX + pc * 8);
            *(LAS v4u*)(lds + SP_RAW + r * 1536 + pc * 16) = v; }
        { const size_t r2 = tok0 + lane; const float dt = softplusf(SM[r2 * SM_LD + 16 + wave] + dtb); float gs = -Aexp * dt;
#pragma unroll
          for (int o = 1; o < 64; o <<= 1) { const float t_ = __shfl_up(gs, o); if (lane >= o) gs += t_; }
          SM[r2 * SM_LD + 16 + wave] = gs; SM[r2 * SM_LD + 24 + wave] = dt; }
        LBAR();
        for (int i = tid; i < 64 * 96; i += 512) { const int l = i / 96, pc = i - l * 96; float a[8];
            { const pg8::f32x4 b0 = *(const LAS pg8::f32x4*)(CW + 4 * 768 + pc * 8), b1 = *(const LAS pg8::f32x4*)(CW + 4 * 768 + pc * 8 + 4);
              a[0] = b0[0]; a[1] = b0[1]; a[2] = b0[2]; a[3] = b0[3]; a[4] = b1[0]; a[5] = b1[1]; a[6] = b1[2]; a[7] = b1[3]; }
#pragma unroll
            for (int k = 0; k < 4; ++k) { float f[8]; unpk8(*(const LAS v4u*)(lds + SP_RAW + (l + k) * 1536 + pc * 16), f);
                const pg8::f32x4 w0 = *(const LAS pg8::f32x4*)(CW + k * 768 + pc * 8), w1 = *(const LAS pg8::f32x4*)(CW + k * 768 + pc * 8 + 4);
#pragma unroll
                for (int j = 0; j < 4; ++j) { a[j] += w0[j] * f[j]; a[4 + j] += w1[j] * f[4 + j]; } }
#pragma unroll
            for (int j = 0; j < 8; ++j) a[j] = siluf(a[j]);
            *(GAS v4u*)(MIX + mixh(MX_BX + pc * 8, tok0 + l)) = pk8(a); }
    }
    LBAR();
}
__device__ __forceinline__ void ret_prep(const __attribute__((address_space(4))) Args* kp, int G_) {
    int tid = threadIdx.x; asm volatile("" : "+v"(tid));
    unsigned char* ws = kp->ws;
    bf16* MIX = (bf16*)(ws + WS_MIX); const float* ROPE = (const float*)(ws + WS_ROPE);
    for (int it = blockIdx.x * 512 + tid; it < MTOK * 32; it += G_ * 512) { const int m = it >> 5, hh = (it >> 2) & 7, i4 = it & 3, t = m & (SEQ - 1);
        const float* rp = ROPE + t * 32 + i4 * 8;
        const pg8::f32x4 c0 = *(const GAS pg8::f32x4*)rp, c1 = *(const GAS pg8::f32x4*)(rp + 4), s0 = *(const GAS pg8::f32x4*)(rp + SEQ * 32), s1 = *(const GAS pg8::f32x4*)(rp + SEQ * 32 + 4);
        const float cs[8] = {c0[0], c0[1], c0[2], c0[3], c1[0], c1[1], c1[2], c1[3]}, sn[8] = {s0[0], s0[1], s0[2], s0[3], s1[0], s1[1], s1[2], s1[3]};
#pragma unroll
        for (int T = 0; T < 2; ++T) { bf16* p = MIX + mixh((T == 0 ? MX_CQ : MX_CK) + hh * 64 + i4 * 8, (size_t)m); const float sc = T == 0 ? 1.0f : 0.125f;
            float a[8], bb[8], o1[8], o2[8]; unpk8(*(const GAS v4u*)p, a); unpk8(*(const GAS v4u*)(p + 32), bb);
#pragma unroll
            for (int j = 0; j < 8; ++j) { o1[j] = (a[j] * cs[j] - bb[j] * sn[j]) * sc; o2[j] = (a[j] * sn[j] + bb[j] * cs[j]) * sc; }
            *(GAS v4u*)p = pk8(o1); *(GAS v4u*)(p + 32) = pk8(o2); }
    }
}

typedef short bf16x4 __attribute__((ext_vector_type(4)));
#define MFMA16K16(a, b, c) __builtin_amdgcn_mfma_f32_16x16x16bf16_1k(a, b, c, 0, 0, 0)
constexpr int GQ_RAW = 0, GQ_KN = 67 * 384, GQ_VN = GQ_KN + MAT, GQ_NA = GQ_VN + MAT, GQ_AD = GQ_NA + MAT, GQ_S = GQ_AD + 4 * 16 * 20 * 4, GQ_CW = GQ_S + 512, GQ_TEAM = GQ_CW + 4 * 192 * 4;
static_assert(2 * GQ_TEAM <= RING_BYTES && 2 * MAT <= GQ_KN, "gdn_prep LDS");
__device__ __forceinline__ bf16x4 pk4(const pg8::f32x4 v) { v2u w; w.x = pk2(v[0], v[1]); w.y = pk2(v[2], v[3]); return __builtin_bit_cast(bf16x4, w); }
__device__ __forceinline__ void gdn_prep(const __attribute__((address_space(4))) Args* kp, int layer, LAS unsigned char* lds_all, int G_) {
    int tid = threadIdx.x; asm volatile("" : "+v"(tid));
    const int team = __builtin_amdgcn_readfirstlane(tid >> 8), j = tid & 255, lane = tid & 63, tw = __builtin_amdgcn_readfirstlane((tid >> 6) & 3), fr = lane & 15, fq = lane >> 4;
    LAS unsigned char* lds = lds_all + team * GQ_TEAM;
    LAS float* AD = (LAS float*)(lds + GQ_AD); LAS float* Gs = (LAS float*)(lds + GQ_S); LAS float* Bs = Gs + 64; LAS float* CW = (LAS float*)(lds + GQ_CW);
    unsigned char* ws = kp->ws;
    bf16* MIX = (bf16*)(ws + WS_MIX); float* SM = (float*)(ws + WS_SM);
    unsigned char* xbf = ws + ((layer & 1) ? WS_XB0 : WS_XB1); bf16* GW = (bf16*)(xbf + GW_OFF); const bf16* HALO = (const bf16*)(xbf + HALO_OFF);
    const float* cw = kp->in[4] + (size_t)layer * 4 * 1536;
    v4u praw[7]; float pcw[3], pbl = 0.f, pal = 0.f;
#define GQ_FETCH(rnd) do { const int u_ = ((rnd) * G_ + (int)blockIdx.x) * 2 + team; const int un_ = u_ < NBATCH * 8 * 64 ? u_ : 0; \
        const int c_ = un_ & 63, h_ = (un_ >> 6) & 7, b_ = un_ >> 9; const size_t tk_ = (size_t)b_ * SEQ + (size_t)c_ * 64; \
        _Pragma("unroll") for (int n = 0; n < 7; ++n) { const int i = j + 256 * n; praw[n] = (v4u){0u, 0u, 0u, 0u}; \
            if (i < 67 * 24) { const int r = i / 24, pc = i - r * 24, col = (pc >> 3) * 512 + h_ * 64 + (pc & 7) * 8; \
                if (r >= 3) praw[n] = *(const GAS v4u*)(MIX + mixh(col, tk_ + r - 3)); \
                else if (c_ > 0) praw[n] = *(const GAS v4u*)(HALO + ((size_t)(b_ * 64 + c_ - 1) * 3 + r) * HALO_LD + col); } } \
        _Pragma("unroll") for (int n = 0; n < 3; ++n) { const int i = j + 256 * n, k = i / 192, cc = i - k * 192; pcw[n] = cw[k * 1536 + (cc >> 6) * 512 + h_ * 64 + (cc & 63)]; } \
        if (tw == 0) { pbl = SM[(tk_ + lane) * SM_LD + h_]; pal = SM[(tk_ + lane) * SM_LD + 8 + h_]; } } while (0)
    GQ_FETCH(0);
    for (int round = 0; round < 8; ++round) {
        const int unit_ = (round * G_ + (int)blockIdx.x) * 2 + team;
        const bool live = unit_ < NBATCH * 8 * 64;
        const int unit = live ? unit_ : 0;
        const int c = unit & 63, h = (unit >> 6) & 7, b = unit >> 9;
        const size_t tok0 = (size_t)b * SEQ + (size_t)c * 64;
        LBAR();
#pragma unroll
        for (int n = 0; n < 7; ++n) { const int i = j + 256 * n; if (i < 67 * 24) { const int r = i / 24, pc = i - r * 24; *(LAS v4u*)(lds + GQ_RAW + r * 384 + pc * 16) = praw[n]; } }
#pragma unroll
        for (int n = 0; n < 3; ++n) CW[j + 256 * n] = pcw[n];
        if (tw == 0) {
            float gsum = -expf(kp->in[5][layer * 8 + h]) * softplusf(pal + kp->in[6][layer * 8 + h]);
#pragma unroll
            for (int o = 1; o < 64; o <<= 1) { const float t_ = __shfl_up(gsum, o); if (lane >= o) gsum += t_; }
            Gs[lane] = gsum; Bs[lane] = sigmf(pbl);
            if (live) SM[(tok0 + lane) * SM_LD + 8 + h] = gsum; }
        if (round + 1 < 8) GQ_FETCH(round + 1);
        LBAR();
#pragma unroll 1
        for (int n = 0; n < 3; ++n) { const int i = j + 256 * n, t2 = i / 24, pc = i - t2 * 24, tens = pc >> 3, ch = pc & 7; float a0[8], a1[8];
#pragma unroll
            for (int jj = 0; jj < 8; ++jj) { a0[jj] = 0.f; a1[jj] = 0.f; }
            pg8::f32x4 wl[4], wh[4];
#pragma unroll
            for (int k = 0; k < 4; ++k) { wl[k] = *(const LAS pg8::f32x4*)(CW + k * 192 + pc * 8); wh[k] = *(const LAS pg8::f32x4*)(CW + k * 192 + pc * 8 + 4); }
#pragma unroll
            for (int r = 0; r < 5; ++r) { float f[8]; unpk8(*(const LAS v4u*)(lds + GQ_RAW + (2 * t2 + r) * 384 + pc * 16), f);
                if (r < 4) {
#pragma unroll
                    for (int jj = 0; jj < 4; ++jj) { a0[jj] += wl[r][jj] * f[jj]; a0[4 + jj] += wh[r][jj] * f[4 + jj]; } }
                if (r > 0) {
#pragma unroll
                    for (int jj = 0; jj < 4; ++jj) { a1[jj] += wl[r - 1][jj] * f[jj]; a1[4 + jj] += wh[r - 1][jj] * f[4 + jj]; } } }
            float s0 = 0.f, s1 = 0.f;
#pragma unroll
            for (int jj = 0; jj < 8; ++jj) { a0[jj] = siluf(a0[jj]); a1[jj] = siluf(a1[jj]); s0 += a0[jj] * a0[jj]; s1 += a1[jj] * a1[jj]; }
            s0 += __shfl_xor(s0, 1); s1 += __shfl_xor(s1, 1); s0 += __shfl_xor(s0, 2); s1 += __shfl_xor(s1, 2); s0 += __shfl_xor(s0, 4); s1 += __shfl_xor(s1, 4);
            const float base = tens == 0 ? 0.125f : 1.0f, c0 = tens == 2 ? 1.0f : rsqrtf(s0 + 1e-6f) * base, c1 = tens == 2 ? 1.0f : rsqrtf(s1 + 1e-6f) * base;
#pragma unroll
            for (int jj = 0; jj < 8; ++jj) { a0[jj] *= c0; a1[jj] *= c1; }
            const v4u o0 = pk8(a0), o1 = pk8(a1); const int t = 2 * t2;
            if (tens == 0) { if (live) { *(GAS v4u*)(MIX + mixh(MX_AQ + h * 64 + ch * 8, tok0 + t)) = o0; *(GAS v4u*)(MIX + mixh(MX_AQ + h * 64 + ch * 8, tok0 + t + 1)) = o1; } }
            else if (tens == 1) { *(LAS v4u*)(lds + GQ_KN + t * (PT * 2) + ch * 16) = o0; *(LAS v4u*)(lds + GQ_KN + (t + 1) * (PT * 2) + ch * 16) = o1;
                if (live) { *(GAS v4u*)(MIX + mixh(MX_AK + h * 64 + ch * 8, tok0 + t)) = o0; *(GAS v4u*)(MIX + mixh(MX_AK + h * 64 + ch * 8, tok0 + t + 1)) = o1; } }
            else { *(LAS v4u*)(lds + GQ_VN + t * (PT * 2) + ch * 16) = o0; *(LAS v4u*)(lds + GQ_VN + (t + 1) * (PT * 2) + ch * 16) = o1; } }
        LBAR();
        for (int id = tw; id < 10; id += 4) { const int lb = id < 1 ? 0 : (id < 3 ? 1 : (id < 6 ? 2 : 3)), sb = id - (lb * (lb + 1)) / 2;
            pg8::f32x4 acc = (pg8::f32x4){0.f, 0.f, 0.f, 0.f};
#pragma unroll
            for (int ks = 0; ks < 2; ++ks) acc = MFMA16(ldfrag(lds + GQ_KN, 16 * lb + fr, 32 * ks + 8 * fq), ldfrag(lds + GQ_KN, 16 * sb + fr, 32 * ks + 8 * fq), acc);
            const int s = 16 * sb + fr; const float gsv = Gs[s];
#pragma unroll
            for (int r = 0; r < 4; ++r) { const int l = 16 * lb + 4 * fq + r; const float v = s < l ? Bs[l] * acc[r] * __expf(Gs[l] - gsv) : 0.f;
                if (lb == sb) AD[(lb * 16 + 4 * fq + r) * 20 + fr] = v;
                else *(LAS bf16*)(lds + GQ_NA + l * (PT * 2) + s * 2) = (bf16)f2bf(-v); } }
        LBAR();
        if (tw == 0) { const int bi = lane >> 4, cc = lane & 15; const LAS float* Ab = AD + bi * 16 * 20; float x[16];
#pragma unroll
            for (int r = 0; r < 16; ++r) { float a = (r == cc) ? 1.0f : 0.0f;
#pragma unroll
                for (int s4 = 0; s4 < r; s4 += 4) { const pg8::f32x4 av = *(const LAS pg8::f32x4*)(Ab + r * 20 + s4);
                    a -= av[0] * x[s4];
                    if (s4 + 1 < r) a -= av[1] * x[s4 + 1];
                    if (s4 + 2 < r) a -= av[2] * x[s4 + 2];
                    if (s4 + 3 < r) a -= av[3] * x[s4 + 3]; }
                x[r] = a; }
#pragma unroll
            for (int r = 0; r < 16; ++r) *(LAS bf16*)(lds + GQ_NA + (16 * bi + r) * (PT * 2) + (16 * bi + cc) * 2) = (bf16)f2bf(x[r]); }
        LBAR();
#pragma unroll 1
        for (int half = 0; half < 2; ++half) { LAS unsigned char* src = lds + (half == 0 ? GQ_VN : GQ_KN); const int c0 = 16 * tw;
            pg8::f32x4 R[4], X[4];
#pragma unroll
            for (int i = 0; i < 4; ++i) { const s16x4 raw = tr4(src + (16 * i + 4 * fq + (fr >> 2)) * (PT * 2) + (c0 + 4 * (fr & 3)) * 2);
                const pg8::f32x4 bv = *(const LAS pg8::f32x4*)(Bs + 16 * i + 4 * fq); pg8::f32x4 sc = bv;
                if (half == 1) { const pg8::f32x4 gv = *(const LAS pg8::f32x4*)(Gs + 16 * i + 4 * fq); sc = (pg8::f32x4){bv[0] * __expf(gv[0]), bv[1] * __expf(gv[1]), bv[2] * __expf(gv[2]), bv[3] * __expf(gv[3])}; }
                R[i] = (pg8::f32x4){bfs(raw[0]) * sc[0], bfs(raw[1]) * sc[1], bfs(raw[2]) * sc[2], bfs(raw[3]) * sc[3]}; }
#define NAF(ib, jb) (*(const LAS bf16x4*)(lds + GQ_NA + (16 * (ib) + fr) * (PT * 2) + (16 * (jb) + 4 * fq) * 2))
            const pg8::f32x4 Z = (pg8::f32x4){0.f, 0.f, 0.f, 0.f};
            X[0] = MFMA16K16(NAF(0, 0), pk4(R[0]), Z);
            { const bf16x4 x0 = pk4(X[0]); R[1] = MFMA16K16(NAF(1, 0), x0, R[1]); R[2] = MFMA16K16(NAF(2, 0), x0, R[2]); R[3] = MFMA16K16(NAF(3, 0), x0, R[3]); }
            X[1] = MFMA16K16(NAF(1, 1), pk4(R[1]), Z);
            { const bf16x4 x1 = pk4(X[1]); R[2] = MFMA16K16(NAF(2, 1), x1, R[2]); R[3] = MFMA16K16(NAF(3, 1), x1, R[3]); }
            X[2] = MFMA16K16(NAF(2, 2), pk4(R[2]), Z);
            { const bf16x4 x2 = pk4(X[2]); R[3] = MFMA16K16(NAF(3, 2), x2, R[3]); }
            X[3] = MFMA16K16(NAF(3, 3), pk4(R[3]), Z);
#undef NAF
#pragma unroll
            for (int i = 0; i < 4; ++i)
#pragma unroll
                for (int r = 0; r < 4; ++r) *(LAS bf16*)(lds + GQ_RAW + half * MAT + (16 * i + 4 * fq + r) * (PT * 2) + (c0 + fr) * 2) = (bf16)f2bf(X[i][r]);
        }
        LBAR();
        if (live) for (int i = j; i < 64 * 16; i += 256) { const int t = (i >> 3) & 63, ch = i & 7, half = i >> 9;
            const v4u v = *(const LAS v4u*)(lds + GQ_RAW + half * MAT + t * (PT * 2) + ch * 16);
            if (half == 0) *(GAS v4u*)(MIX + mixh(MX_AV + h * 64 + ch * 8, tok0 + t)) = v; else *(GAS v4u*)(GW + gwh(h, ch * 8, tok0 + t)) = v; }
    }
    LBAR();
}
#ifndef MK_ONE_LAUNCH
#define MK_ONE_LAUNCH 1
#endif
__global__ void __launch_bounds__(512, 2) fwd_kernel(Args args) {
    extern __shared__ __attribute__((aligned(16))) unsigned char lds_raw[];
    LAS unsigned char* lds0 = (LAS unsigned char*)lds_raw;
    volatile LAS unsigned* MISC = (volatile LAS unsigned*)(lds0 + MISC_OFF);
    const int G = gridDim.x, NGW = G * 8;
    unsigned char* ws0 = args.ws;
    for (int u = threadIdx.x; u < (LDS_BYTES - RING_BYTES) / 4; u += 512) ((LAS unsigned*)(lds0 + RING_BYTES))[u] = 0u;
    __syncthreads();
#if MK_ONE_LAUNCH
    XcdBarrier bar = xcd_barrier_post((unsigned*)(ws0 + WS_CTL) + 4096, MISC + 8);
#define GRID_BAR() do { XcdBarrier b_ = bar; asm volatile("" : "+s"(b_.bar), "+s"(b_.x)); xcd_barrier(b_); } while (0)
#else
#define GRID_BAR() do {} while (0)
#endif
    const int lo = args.ph_lo, hi = args.ph_hi;
#define IN(p) (lo <= (p) && (p) < hi)
#define SEAM(p) do { if (IN(p) && IN((p) + 1)) GRID_BAR(); } while (0)
    typedef const __attribute__((address_space(4))) Args* KArgs;
    const KArgs kp0 = (KArgs)__builtin_amdgcn_kernarg_segment_ptr();
#define PHASE_PTRS() KArgs kp = kp0; asm volatile("" : "+s"(kp)); unsigned char* ws = kp->ws; float* X = kp->out; (void)X; \
    LAS unsigned char* lds = lds0; \
    int tid = threadIdx.x; asm volatile("" : "+v"(tid)); int bx = blockIdx.x; asm volatile("" : "+s"(bx)); const int lane = tid & 63, wave = __builtin_amdgcn_readfirstlane(tid >> 6), gw = bx * 8 + wave; (void)lane; (void)gw; \
    bf16* ZB = (bf16*)(ws + WS_ZB); bf16* MIX = (bf16*)(ws + WS_MIX); float* SM = (float*)(ws + WS_SM); (void)ZB; (void)MIX; (void)SM; \
    float* SSQA = (float*)(ws + WS_SSQA); float* SSQB = (float*)(ws + WS_SSQB); float* SSQC = (float*)(ws + WS_SSQC); float* ROPE = (float*)(ws + WS_ROPE); (void)SSQA; (void)SSQB; (void)SSQC; (void)ROPE; \
    bf16* W1T = (bf16*)(ws + W_1T); bf16* WGT = (bf16*)(ws + W_GT); bf16* WMT = (bf16*)(ws + W_MT); bf16* WOT = (bf16*)(ws + W_OT); bf16* WUT = (bf16*)(ws + W_UT); (void)W1T; (void)WGT; (void)WMT; (void)WOT; (void)WUT; \
    bf16* WDT = (bf16*)(ws + W_DT); bf16* WPGT = (bf16*)(ws + W_PGT); bf16* WPPT = (bf16*)(ws + W_PPT); (void)WDT; (void)WPGT; (void)WPPT; \
    bf16* GATE = (bf16*)(ws + WS_GATE); bf16* U = (bf16*)(ws + WS_U); bf16* PB = (bf16*)X; bf16* PLE = (bf16*)X + (size_t)MTOK * PLED;     (void)GATE; (void)U; (void)PB; (void)PLE; \
    bf16* XBl = (bf16*)(ws + ((layer & 1) ? WS_XB1 : WS_XB0)); bf16* XBf = (bf16*)(ws + ((layer & 1) ? WS_XB0 : WS_XB1)); (void)XBl; (void)XBf
    if (IN(0)) { const int layer = 0; PHASE_PTRS();
        for (int e = bx * 512 + tid; e < SEQ * 32; e += G * 512) { const int t = e >> 5, i = e & 31;
            double f = 1.0; for (int j = 0; j < i; ++j) f *= 0.7429639507594948;
            const double ang = (double)t * f, kk = rint(ang * 0.15915494309189535);
            double r = fma(-kk, 6.283185307179586, ang); r = fma(-kk, 2.4492935982947064e-16, r); const double r2 = r * r;
            double sn = 1.0, cs = 1.0;
    #pragma unroll
            for (int n = 15; n >= 1; --n) { sn = 1.0 - r2 * (1.0 / (double)((2 * n) * (2 * n + 1))) * sn; cs = 1.0 - r2 * (1.0 / (double)((2 * n - 1) * (2 * n))) * cs; }
            ROPE[e] = (float)cs; ROPE[SEQ * 32 + e] = (float)(r * sn); }
    }
    for (int layer = 0; layer < DEPTH; ++layer) {
        const int P = layer * NPH;
        if (IN(P + 0)) { PHASE_PTRS();
            int ibase = 0;
            const float* w_in = kp->in[3] + (size_t)layer * DM * NIN; const float* nmix = kp->in[2] + (size_t)layer * DM;
            TR_SEG(w_in, NIN, 1536, 512, DM, nmix, W1T, DM, 0, 0);
            TR_SEG(w_in, NIN, 2064, 512, DM, nmix, W1T, DM, 512, 0);
            TR_SEG(w_in, NIN, 4888, 512, DM, nmix, W1T, DM, 1024, 0);
            TR_SEG(w_in, NIN, 0, 1536, DM, nmix, W1T, DM, 1536, 0);
            TR_SEG(w_in, NIN, 2576, 768, DM, nmix, W1T, DM, 3072, 0);
            TR_SEG(w_in, NIN, 3352, 1536, DM, nmix, W1T, DM, 3840, 0);
            TR_SEG(w_in, NIN, 2048, 16, DM, nmix, W1T, DM, 5376, 0);
            TR_SEG(w_in, NIN, 3344, 8, DM, nmix, W1T, DM, 5392, 0);
            TR_SEG((const float*)nullptr, NIN, 0, 232, DM, (const float*)nullptr, W1T, DM, 5400, 0);
            TR_SEG(w_in, NIN, 5400, 3072, DM, nmix, WGT, DM, 0, 0);
            const float* wbr = kp->in[14] + (size_t)layer * 3 * 512 * DM;
            TR_SEG(wbr, DM, 0, DM, 512, (const float*)nullptr, WMT, KMERGE, 0, 0);
            TR_SEG(wbr + 512 * DM, DM, 0, DM, 512, kp->in[13] + (size_t)layer * 512, WMT, KMERGE, 0, 512);
            TR_SEG(wbr + 2 * 512 * DM, DM, 0, DM, 512, (const float*)nullptr, WMT, KMERGE, 0, 1024);
            TR_SEG(kp->in[15] + (size_t)layer * DM * DM, DM, 0, DM, DM, (const float*)nullptr, WOT, DM, 0, 0);
            TR_SEG(kp->in[17] + (size_t)layer * DM * DFF, DFF, 0, DFF, DM, kp->in[16] + (size_t)layer * DM, WUT, DM, 0, 0);
            TR_SEG(kp->in[18] + (size_t)layer * DFF * DM, DM, 0, DM, DFF, (const float*)nullptr, WDT, DFF, 0, 0);
            TR_SEG(kp->in[20] + (size_t)layer * DM * DM, DM, 0, DM, DM, kp->in[19] + (size_t)layer * DM, WPGT, DM, 0, 0);
            TR_SEG(kp->in[21] + (size_t)layer * PLED * DM, DM, 0, DM, PLED, (const float*)nullptr, WPPT, PLED, 0, 0);
            if (layer == 0) {
                const float* xin = kp->in[0];
                for (int m = gw; m < MTOK; m += NGW) {
                    const GAS f32x4* xr = (const GAS f32x4*)(xin + (size_t)m * DM) + lane; f32x4 v[4]; float s = 0.f;
#pragma unroll
                    for (int j = 0; j < 4; ++j) { v[j] = xr[64 * j]; s += (v[j].x * v[j].x + v[j].y * v[j].y) + (v[j].z * v[j].z + v[j].w * v[j].w); }
                    s = wave_sum(s);
                    GAS v2u* o8 = (GAS v2u*)(XBl + (size_t)m * DM) + lane;
#pragma unroll
                    for (int j = 0; j < 4; ++j) { v2u w; w.x = pk2(v[j].x, v[j].y); w.y = pk2(v[j].z, v[j].w); o8[64 * j] = w; }
                    if (lane < 16) SSQC[(size_t)m * 16 + lane] = lane == 0 ? s : 0.f;
                }
            }
        }
        SEAM(P + 0);
        if (IN(P + 1)) { PHASE_PTRS();
            pg8::Gemm g{XBl, W1T, MTOK, N1, DM}; pg8::StaticOrder S; S.init(MTOK, N1, G, bx);
            build_rs_table(S, SSQC, lds, tid);
            pg8::EpiP1 E{ZB, MIX, SM, lds + RS_OFF, (bf16*)((unsigned char*)XBf + HALO_OFF),  0u};
            pg8::gemm_phase<pg8::EpiP1, pg8::StaticOrder, true, true>(lds, g, S, E);
        }
        SEAM(P + 1);
        if (IN(P + 2)) { PHASE_PTRS();
            gdn_prep(kp, layer, lds, G);
            ssd_prep(kp, layer, lds, G);
            ret_prep(kp, G);
            const float* pl = kp->in[1] + (size_t)layer * MTOK * PLED;
            for (size_t e = (size_t)bx * 512 + tid; e < (size_t)MTOK * PLED / 4; e += (size_t)G * 512) { const f32x4 v = ((const GAS f32x4*)pl)[e]; v2u w; w.x = pk2(v.x, v.y); w.y = pk2(v.z, v.w); ((GAS v2u*)PB)[e] = w; }
        }
        SEAM(P + 2);
        if (IN(P + 3)) { PHASE_PTRS();
            for (int w = bx; w < 192; w += G) { const int kind = w >> 6, b = (w & 63) >> 3, h = w & 7;
                if (kind == 0) mixer_walk<0>(kp, layer, b, h, lds);
                else if (kind == 1) mixer_walk<1>(kp, layer, b, h, lds);
                else mixer_walk<2>(kp, layer, b, h, lds);
                __syncthreads(); }
            if (bx >= 192 || G <= 192) {
                pg8::Gemm g{PB, WPPT, MTOK / 2, DM, PLED}; pg8::StaticOrder S; if (G > 192) S.init(MTOK / 2, DM, G - 192, bx - 192); else S.init(MTOK / 2, DM, G, bx);
                pg8::EpiRS<0> E{PLE, DM, (LAS unsigned char*)nullptr};
                pg8::gemm_phase<pg8::EpiRS<0>, pg8::StaticOrder, true, true>(lds, g, S, E); }
        }
        SEAM(P + 3);
        if (IN(P + 4)) { PHASE_PTRS();
            for (int m = gw; m < MTOK; m += NGW) {
                GAS v4u* yp = (GAS v4u*)(ZB + (size_t)m * ZB_LD + 512) + lane; const v4u w = *yp;
                const f32x4 sq = *(const f32x4*)(SM + (size_t)m * SM_LD + 16 + 4 * (lane >> 5));
                const float rstd = rsqrtf(((sq[0] + sq[1]) + (sq[2] + sq[3])) * (1.0f / 256.0f) + 1e-6f);
                v4u o; o.x = pk2(pg8::bflo(w.x) * rstd, pg8::bfhi(w.x) * rstd); o.y = pk2(pg8::bflo(w.y) * rstd, pg8::bfhi(w.y) * rstd);
                o.z = pk2(pg8::bflo(w.z) * rstd, pg8::bfhi(w.z) * rstd); o.w = pk2(pg8::bflo(w.w) * rstd, pg8::bfhi(w.w) * rstd);
                *yp = o;
            }
            pg8::Gemm g{XBl, WGT, MTOK, NGATE, DM}; pg8::StaticOrder S; S.init(MTOK, NGATE, G, bx);
            build_rs_table(S, SSQC, lds, tid);
            pg8::EpiRS<2> E{GATE, NGATE, lds + RS_OFF};
            pg8::gemm_phase<pg8::EpiRS<2>, pg8::StaticOrder, true, true>(lds, g, S, E);
        }
        SEAM(P + 4);
        if (IN(P + 5)) { PHASE_PTRS();
            pg8::Gemm g{ZB, WMT, MTOK, DM, KMERGE}; pg8::StaticOrder S; S.init(MTOK, DM, G, bx);
            pg8::EpiMerge E{GATE, XBf};
            pg8::gemm_phase<pg8::EpiMerge, pg8::StaticOrder, true, true>(lds, g, S, E);
        }
        SEAM(P + 5);
        if (IN(P + 6)) { PHASE_PTRS();
            pg8::Gemm g{XBf, WOT, MTOK, DM, DM}; pg8::StaticOrder S; S.init(MTOK, DM, G, bx);
            pg8::EpiResid<0> E{XBl, XBl, SSQA, (LAS unsigned char*)nullptr, nullptr,  1.0f};
            pg8::gemm_phase<pg8::EpiResid<0>, pg8::StaticOrder, true, true>(lds, g, S, E);
        }
        SEAM(P + 6);
        if (IN(P + 7)) { PHASE_PTRS();
            { pg8::Gemm g{XBl, WUT, MTOK, DFF, DM}; pg8::StaticOrder S; S.init(MTOK, DFF, G, bx);
              build_rs_table(S, SSQA, lds, tid);
              pg8::EpiRS<1> E{U, DFF, lds + RS_OFF};
              pg8::gemm_phase<pg8::EpiRS<1>, pg8::StaticOrder, true, true>(lds, g, S, E); }
        }
        SEAM(P + 7);
        if (IN(P + 8)) { PHASE_PTRS();
            pg8::Gemm g{U, WDT, MTOK, DM, DFF}; pg8::StaticOrder S; S.init(MTOK, DM, G, bx);
            pg8::EpiResid<0> E{XBl, XBl, SSQB, (LAS unsigned char*)nullptr, nullptr,  1.0f};
            pg8::gemm_phase<pg8::EpiResid<0>, pg8::StaticOrder, true, true>(lds, g, S, E);
            __builtin_amdgcn_sched_barrier(0);
            { pg8::Gemm g2{PB + (size_t)(MTOK / 2) * PLED, WPPT, MTOK / 2, DM, PLED}; pg8::StaticOrder S2; S2.init(MTOK / 2, DM, G, bx);
              pg8::EpiRS<0> E2{PLE + (size_t)(MTOK / 2) * DM, DM, (LAS unsigned char*)nullptr};
              pg8::gemm_phase<pg8::EpiRS<0>, pg8::StaticOrder, true, true>(lds, g2, S2, E2); }
        }
        SEAM(P + 8);
        if (IN(P + 9)) { PHASE_PTRS();
            pg8::Gemm g{XBl, WPGT, MTOK, DM, DM}; pg8::StaticOrder S; S.init(MTOK, DM, G, bx);
            build_rs_table(S, SSQB, lds, tid);
            pg8::EpiResid<1> E{XBl, XBf, SSQC, lds + RS_OFF, PLE,  1.0f};
            pg8::gemm_phase<pg8::EpiResid<1>, pg8::StaticOrder, true, true>(lds, g, S, E);
        }
        SEAM(P + 9);
    }
    if (IN(PH_FINAL)) { const int layer = DEPTH; PHASE_PTRS();
        const float* nf = kp->in[22];
        for (int m = gw; m < MTOK; m += NGW) {
            const float sp = lane < 16 ? SSQC[(size_t)m * 16 + lane] : 0.f;
            const float rstd = rsqrtf(wave_sum(sp) * (1.0f / 1024.0f) + 1e-6f);
            const GAS v4u* xr = (const GAS v4u*)(XBl + (size_t)m * DM) + lane; GAS f32x4* orow = (GAS f32x4*)(X + (size_t)m * DM);
#pragma unroll
            for (int j = 0; j < 2; ++j) { const v4u w = xr[64 * j]; const int c8 = (64 * j + lane) * 2; const f32x4 g0 = ((const GAS f32x4*)nf)[c8], g1 = ((const GAS f32x4*)nf)[c8 + 1];
                f32x4 o0, o1; o0[0] = pg8::bflo(w.x); o0[1] = pg8::bfhi(w.x); o0[2] = pg8::bflo(w.y); o0[3] = pg8::bfhi(w.y); o1[0] = pg8::bflo(w.z); o1[1] = pg8::bfhi(w.z); o1[2] = pg8::bflo(w.w); o1[3] = pg8::bfhi(w.w);
                orow[c8] = o0 * rstd * g0; orow[c8 + 1] = o1 * rstd * g1; }
        }
    }
#undef IN
#undef SEAM
}

extern "C" void kernel_launch(void* const* d_in, const int* in_sizes, int n_in, void* d_out, int out_size, void* d_ws, size_t ws_size, hipStream_t stream) {
    static int grid = 0;
    if (grid == 0) {
        if (n_in != 23 || out_size != MTOK * DM || ws_size < WS_END) { fprintf(stderr, "kernel_launch: unexpected problem (n_in %d, out %d, ws %zu < %zu)\n", n_in, out_size, ws_size, (size_t)WS_END); grid = -1; return; }
        int dev = 0, cus = 0;
        if (hipGetDevice(&dev) != hipSuccess || hipDeviceGetAttribute(&cus, hipDeviceAttributeMultiprocessorCount, dev) != hipSuccess) { grid = -1; return; }
        if (hipFuncSetAttribute((const void*)fwd_kernel, hipFuncAttributeMaxDynamicSharedMemorySize, LDS_BYTES) != hipSuccess) { fprintf(stderr, "kernel_launch: hipFuncSetAttribute failed\n"); grid = -1; return; }
        int per_cu = 0;
        if (hipOccupancyMaxActiveBlocksPerMultiprocessor(&per_cu, (const void*)fwd_kernel, 512, LDS_BYTES) != hipSuccess || per_cu < 1) { fprintf(stderr, "kernel_launch: occupancy query says %d blocks per CU\n", per_cu); }
        (void)hipGetLastError();
        grid = cus;
    }
    if (grid < 0) return;
    (void)hipMemsetAsync((char*)d_ws + WS_CTL, 0, CTL_BYTES, stream);
    Args a; memset(&a, 0, sizeof(a));
    for (int i = 0; i < 23; ++i) a.in[i] = (const float*)d_in[i];
    a.out = (float*)d_out; a.ws = (unsigned char*)d_ws;
#if MK_ONE_LAUNCH
    a.ph_lo = 0; a.ph_hi = N_PHASES;
    hipLaunchKernelGGL(fwd_kernel, dim3(grid), dim3(512), LDS_BYTES, stream, a);
#else
    for (int p = 0; p < N_PHASES; ++p) {
        a.ph_lo = p; a.ph_hi = p + 1;
        hipLaunchKernelGGL(fwd_kernel, dim3(grid), dim3(512), LDS_BYTES, stream, a);
    }
#endif
}
```

```cpp
#include <hip/hip_runtime.h>
#include <cstdio>
#include <cstdint>
#include <cstring>
__host__ __device__ __forceinline__ size_t mixh(int col, size_t m) {
    const size_t b = m >> 12, t = m & 4095;
    if (col < 2048) { const int ten = col >> 9, h = (col >> 6) & 7; return (size_t)ten * (16u << 20) + (((b * 8 + h) << 12) + t) * 64 + (col & 63); }
    if (col < 2304) { const int c2 = col - 2048, tb = c2 >> 7, g = (c2 >> 6) & 1; return (size_t)4 * (16u << 20) + (size_t)tb * (4u << 20) + (((b * 2 + g) << 12) + t) * 64 + (col & 63); }
    const int c2 = col - 2304, ten = c2 >> 9, h = (c2 >> 6) & 7; return (size_t)4 * (16u << 20) + (8u << 20) + (size_t)ten * (16u << 20) + (((b * 8 + h) << 12) + t) * 64 + (col & 63);
}
__host__ __device__ __forceinline__ size_t gwh(int h, int c, size_t m) { return ((((m >> 12) * 8 + h) << 12) + (m & 4095)) * 64 + c; }
namespace pg8 {
#define PG8_LAS __attribute__((address_space(3)))
typedef unsigned short bf16_t;
typedef short bf16x8 __attribute__((ext_vector_type(8)));
typedef float f32x4 __attribute__((ext_vector_type(4)));
typedef unsigned u32x4 __attribute__((ext_vector_type(4)));
constexpr int BM = 256, BK = 64, HALF = 128, HTB = HALF * BK * 2  , STAGE_BYTES = 8 * HTB, NXCD = 8, WGM = 8;

__host__ __device__ __forceinline__ int lds_byte(int r, int c) { const int st = (r >> 4) * 2 + (c >> 5), rr = r & 15, cc = c & 31, ob = rr * 64 + cc * 2; return st * 1024 + (ob ^ (((ob >> 9) & 1) << 5)); }
__host__ __device__ __forceinline__ void stage_rc(int b, int& R, int& C) { const int st = b / 1024, sb = b % 1024, swz = sb ^ (((sb >> 9) & 1) << 5); R = (st >> 1) * 16 + swz / 64; C = (st & 1) * 32 + (swz % 64) / 2; }
__host__ __device__ __forceinline__ int perm32(int rho) { const int n = rho >> 4, i = rho & 15; return 8 * (i >> 2) + 4 * n + (i & 3); }

struct Unit { int pm, pn; };
struct Gemm { const bf16_t* A; const bf16_t* Bt; int M, N, K; };

struct StaticOrder {
    int nM, nN, nwg, G, c;
    __host__ __device__ void init(int M, int N, int G_, int c_) { nM = M / BM; nN = N / BM; nwg = nM * nN; G = G_; c = c_; }
    __host__ __device__ bool next(int i, Unit& u) const {
        const long L = (long)i * G + c; if (L >= nwg) return false;
        int wgid = (int)L; { const int q = nwg / NXCD, r = nwg % NXCD, xcd = wgid % NXCD, off = wgid / NXCD; wgid = (xcd < r ? xcd * (q + 1) : r * (q + 1) + (xcd - r) * q) + off; }
        const int nig = WGM * nN, gid = wgid / nig, fm = gid * WGM, gsz = (nM - fm) < WGM ? (nM - fm) : WGM;
        u.pm = fm + ((wgid % nig) % gsz); u.pn = (wgid % nig) / gsz; return true;
    }
    __device__ __forceinline__ void a_ready(const Unit&) const {}
    __device__ __forceinline__ void done(const Unit&) const {}
};

typedef float f32x2c __attribute__((ext_vector_type(2))); typedef __bf16 bf16x2c __attribute__((ext_vector_type(2)));
__device__ __forceinline__ unsigned cvt_pk_bf16(float lo, float hi) { const f32x2c v = {lo, hi}; const bf16x2c b = __builtin_convertvector(v, bf16x2c); return __builtin_bit_cast(unsigned, b); }
typedef unsigned u32x2 __attribute__((ext_vector_type(2)));
__device__ __forceinline__ float bflo(unsigned w) { return __uint_as_float(w << 16); }
__device__ __forceinline__ float bfhi(unsigned w) { return __uint_as_float(w & 0xffff0000u); }
__device__ __forceinline__ u32x4 pack8(const f32x4 v0, const f32x4 v1) { u32x4 w; w.x = cvt_pk_bf16(v0[0], v0[1]); w.y = cvt_pk_bf16(v0[2], v0[3]); w.z = cvt_pk_bf16(v1[0], v1[1]); w.w = cvt_pk_bf16(v1[2], v1[3]); return w; }
__device__ __forceinline__ void unpack8(const u32x4 w, f32x4& v0, f32x4& v1) { v0 = (f32x4){bflo(w.x), bfhi(w.x), bflo(w.y), bfhi(w.y)}; v1 = (f32x4){bflo(w.z), bfhi(w.z), bflo(w.w), bfhi(w.w)}; }
constexpr float RMS_EPS = 1e-6f;
constexpr int RS_SLOTS = 8;
__device__ __forceinline__ void load_rstd(const PG8_LAS unsigned char* rst, int pm, int wr, int fr, float (&rs)[2][4]) {
    if (rst == nullptr) {
#pragma unroll
        for (int ai = 0; ai < 2; ++ai)
#pragma unroll
            for (int m = 0; m < 4; ++m) rs[ai][m] = 1.0f;
        return; }
    const PG8_LAS int* pml = (const PG8_LAS int*)rst; int slot = 0;
#pragma unroll
    for (int k = 1; k < RS_SLOTS; ++k) slot = pml[k] == pm ? k : slot;
    const PG8_LAS float* tab = (const PG8_LAS float*)(rst + 32) + slot * 256 + wr * 64 + fr;
#pragma unroll
    for (int ai = 0; ai < 2; ++ai)
#pragma unroll
        for (int m = 0; m < 4; ++m) rs[ai][m] = tab[ai * HALF + m * 16];
}
struct EpiP1 {
    static constexpr bool PERM = true, AFTER_DRAIN = false, HOOK = false; static constexpr int SEG1 = -1, SEG2 = -1;
    bf16_t* ZB; bf16_t* MIX; float* SM; const PG8_LAS unsigned char* rst; bf16_t* HALO; unsigned nost;
    __device__ __forceinline__ void rescale(f32x4 (&)[2][2][4][2], const Unit&, int, int, int, int, int) const {}
    __device__ __forceinline__ void operator()(const f32x4 (&acc)[2][2][4][2], const Unit& u, int wr, int wc, int fr, int fq) const {
        const int row0 = u.pm * BM + wr * 64 + fr;
        float rs[2][4]; load_rstd(rst, u.pm, wr, fr, rs);
        if (u.pn == 21) {
            if (wc == 0) {
#pragma unroll
                for (int ai = 0; ai < 2; ++ai)
#pragma unroll
                    for (int m = 0; m < 4; ++m) { float* p = SM + (size_t)(row0 + ai * HALF + m * 16) * 32 + 8 * fq;
                        *(f32x4*)p = acc[ai][0][m][0] * rs[ai][m]; *(f32x4*)(p + 4) = acc[ai][0][m][1] * rs[ai][m]; }
            }
            return;
        }
        const bool mixt = u.pn >= 6;
        const int colt = mixt ? (u.pn - 6) * BM : u.pn * BM, col0 = colt + wc * 32 + 8 * fq;
#pragma unroll
        for (int ai = 0; ai < 2; ++ai)
#pragma unroll
            for (int m = 0; m < 4; ++m) { const size_t row = (size_t)(row0 + ai * HALF + m * 16);
#pragma unroll
                for (int bj = 0; bj < 2; ++bj) { const u32x4 w = pack8(acc[ai][bj][m][0] * rs[ai][m], acc[ai][bj][m][1] * rs[ai][m]);
                    if (nost == 0u || (w.x ^ w.y ^ w.z) == nost) *(u32x4*)(mixt ? MIX + mixh(col0 + bj * HALF, row) : ZB + row * 1536 + col0 + bj * HALF) = w;
                    if (m == 3 && fr >= 13 && u.pn >= 6 && u.pn < 15) *(u32x4*)(HALO + ((size_t)((row0 + ai * HALF + m * 16) >> 6) * 3 + (fr - 13)) * 2304 + col0 + bj * HALF) = w; } }
    }
};
template <int ACT> struct EpiRS {
    static constexpr bool PERM = true, AFTER_DRAIN = false, HOOK = false; static constexpr int SEG1 = -1, SEG2 = -1;
    bf16_t* O; int ldc; const PG8_LAS unsigned char* rst;
    __device__ __forceinline__ void rescale(f32x4 (&)[2][2][4][2], const Unit&, int, int, int, int, int) const {}
    __device__ __forceinline__ void operator()(const f32x4 (&acc)[2][2][4][2], const Unit& u, int wr, int wc, int fr, int fq) const {
        const int row0 = u.pm * BM + wr * 64 + fr, col0 = u.pn * BM + wc * 32 + 8 * fq;
        float rs[2][4]; load_rstd(rst, u.pm, wr, fr, rs);
#pragma unroll
        for (int ai = 0; ai < 2; ++ai)
#pragma unroll
            for (int m = 0; m < 4; ++m) { bf16_t* rowp = O + (size_t)(row0 + ai * HALF + m * 16) * ldc + col0;
#pragma unroll
                for (int bj = 0; bj < 2; ++bj) { f32x4 v0 = acc[ai][bj][m][0] * rs[ai][m], v1 = acc[ai][bj][m][1] * rs[ai][m];
                    if (ACT == 1) {
#pragma unroll
                        for (int j = 0; j < 4; ++j) { const float a = fmaxf(v0[j], 0.f), b = fmaxf(v1[j], 0.f); v0[j] = a * a; v1[j] = b * b; } }
                    if (ACT == 2) {
#pragma unroll
                        for (int j = 0; j < 4; ++j) { v0[j] = __builtin_amdgcn_rcpf(1.0f + __expf(-v0[j])); v1[j] = __builtin_amdgcn_rcpf(1.0f + __expf(-v1[j])); } }
                    *(u32x4*)(rowp + bj * HALF) = pack8(v0, v1); } }
    }
};
struct EpiMerge {
    static constexpr bool PERM = true, AFTER_DRAIN = false, HOOK = true; static constexpr int SEG1 = 8, SEG2 = 16;
    const bf16_t* GATE; bf16_t* O;
    __device__ __forceinline__ void rescale(f32x4 (&acc)[2][2][4][2], const Unit& u, int seg, int wr, int wc, int, int) const {
        int t_ = threadIdx.x; asm volatile("" : "+v"(t_)); const int fr = t_ & 15, fq = (t_ & 63) >> 4;
        const int row0 = u.pm * BM + wr * 64 + fr, col0 = u.pn * BM + wc * 32 + 8 * fq + (seg - 1) * 1024;
#pragma unroll
        for (int ai = 0; ai < 2; ++ai)
#pragma unroll
            for (int m = 0; m < 4; ++m) { const bf16_t* gp = GATE + (size_t)(row0 + ai * HALF + m * 16) * 3072 + col0;
#pragma unroll
                for (int bj = 0; bj < 2; ++bj) { const u32x4 wa = *(const u32x4*)(gp + bj * HALF), wb = *(const u32x4*)(gp + bj * HALF + 1024);
                    f32x4 a0, a1, b0, b1; unpack8(wa, a0, a1); unpack8(wb, b0, b1);
#pragma unroll
                    for (int j = 0; j < 4; ++j) {
                        acc[ai][bj][m][0][j] *= a0[j] * __builtin_amdgcn_rcpf(b0[j]);
                        acc[ai][bj][m][1][j] *= a1[j] * __builtin_amdgcn_rcpf(b1[j]); } }
                if (m == 3) asm volatile("" ::: "memory"); }
    }
    __device__ __forceinline__ void operator()(const f32x4 (&acc)[2][2][4][2], const Unit& u, int wr, int wc, int fr, int fq) const {
        const int row0 = u.pm * BM + wr * 64 + fr, col0 = u.pn * BM + wc * 32 + 8 * fq;
#pragma unroll
        for (int ai = 0; ai < 2; ++ai)
#pragma unroll
            for (int m = 0; m < 4; ++m) { const size_t r = (size_t)(row0 + ai * HALF + m * 16);
#pragma unroll
                for (int bj = 0; bj < 2; ++bj) { const u32x4 wa = *(const u32x4*)(GATE + r * 3072 + 2048 + col0 + bj * HALF);
                    f32x4 a0, a1; unpack8(wa, a0, a1); f32x4 v0 = acc[ai][bj][m][0], v1 = acc[ai][bj][m][1];
#pragma unroll
                    for (int j = 0; j < 4; ++j) { v0[j] *= a0[j]; v1[j] *= a1[j]; }
                    *(u32x4*)(O + r * 1024 + col0 + bj * HALF) = pack8(v0, v1); }
                if (m == 3) asm volatile("" ::: "memory"); }
    }
};
template <int MODE> struct EpiResid {
    static constexpr bool PERM = true, AFTER_DRAIN = false, HOOK = false; static constexpr int SEG1 = -1, SEG2 = -1;
    const bf16_t* XBin; bf16_t* XBout; float* ssq_out; const PG8_LAS unsigned char* rst; const bf16_t* PLE; float scale;
    __device__ __forceinline__ void rescale(f32x4 (&)[2][2][4][2], const Unit&, int, int, int, int, int) const {}
    __device__ __forceinline__ void operator()(const f32x4 (&acc)[2][2][4][2], const Unit& u, int wr, int wc, int fr, int fq) const {
        const int row0 = u.pm * BM + wr * 64 + fr, col0 = u.pn * BM + wc * 32 + 8 * fq;
        float rs[2][4]; if (MODE == 1) load_rstd(rst, u.pm, wr, fr, rs);
#pragma unroll
        for (int ai = 0; ai < 2; ++ai)
#pragma unroll
            for (int m = 0; m < 4; ++m) { const size_t r = (size_t)(row0 + ai * HALF + m * 16); float ss = 0.f;
#pragma unroll
                for (int bj = 0; bj < 2; ++bj) { const size_t o = r * 1024 + col0 + bj * HALF;
                    f32x4 v0 = acc[ai][bj][m][0], v1 = acc[ai][bj][m][1], b0, b1; unpack8(*(const u32x4*)(XBin + o), b0, b1);
                    if (MODE == 1) { const u32x4 wp = *(const u32x4*)(PLE + o); f32x4 p0, p1; unpack8(wp, p0, p1);
#pragma unroll
                        for (int j = 0; j < 4; ++j) { v0[j] = p0[j] * __builtin_amdgcn_rcpf(1.0f + __expf(-v0[j] * rs[ai][m])); v1[j] = p1[j] * __builtin_amdgcn_rcpf(1.0f + __expf(-v1[j] * rs[ai][m])); } }
                    v0 = v0 * scale + b0; v1 = v1 * scale + b1;
                    *(u32x4*)(XBout + o) = pack8(v0, v1);
                    ss += (v0[0] * v0[0] + v0[1] * v0[1]) + (v0[2] * v0[2] + v0[3] * v0[3]) + (v1[0] * v1[0] + v1[1] * v1[1]) + (v1[2] * v1[2] + v1[3] * v1[3]); }
                ss += __shfl_xor(ss, 16); ss += __shfl_xor(ss, 32);
                if (fq == 0) ssq_out[r * 16 + u.pn * 4 + wc] = ss;
                if (m == 3) asm volatile("" ::: "memory"); }
    }
};
template <class Epi, class Sched, bool ALIGN_EPI = false, bool SP2 = false, int PROBE = 0>
__device__ __forceinline__ void gemm_phase(PG8_LAS unsigned char* lds, Gemm g, const Sched& S, const Epi& E) {
    asm volatile("" : "+s"(g.A), "+s"(g.Bt), "+s"(g.K));
    int tid_ = threadIdx.x; asm volatile("" : "+v"(tid_));
    const int tid = tid_, wid = __builtin_amdgcn_readfirstlane(tid >> 6), lane = tid & 63, wr = wid >> 2, wc = wid & 3, fr = lane & 15, fq = lane >> 4;
    const int K = g.K, nt = K / BK;
    unsigned voffA[2], voffB[2];
#pragma unroll
    for (int i = 0; i < 2; ++i) { int R, C; stage_rc(tid * 16 + i * 8192, R, C); const int Rb = Epi::PERM ? ((R & ~31) + perm32(R & 31)) : R;
        voffA[i] = (unsigned)(R * K + C) * 2u; voffB[i] = (unsigned)(Rb * K + C) * 2u; }
    const size_t kstep = (size_t)(BK * 2);
    const size_t hstep = (size_t)HALF * K * 2;
    const size_t tstep = 2 * hstep;
    const unsigned ldsw = (unsigned)wid * 1024u;
    const int aoff = lds_byte(wr * 64 + fr, fq * 8), boff = lds_byte(wc * 32 + fr, fq * 8);
#define PG8_SA(b, h) (((b) * 2 + (h)) * HTB)
#define PG8_SB(b, h) ((4 + (b) * 2 + (h)) * HTB)
#define PG8_STAGE(bufoff, gbase, voff) do { if constexpr (!(PROBE & 4)) _Pragma("unroll") for (int _i = 0; _i < 2; ++_i) \
        __builtin_amdgcn_global_load_lds((const unsigned*)((const char*)(gbase) + (voff)[_i]), (PG8_LAS unsigned*)(lds + (bufoff) + ldsw + _i * 8192), 16, 0, 0); } while (0)
#define PG8_LDA(dst, b, h) do { _Pragma("unroll") for (int m = 0; m < 4; ++m) _Pragma("unroll") for (int k = 0; k < 2; ++k) dst[m][k] = *(const PG8_LAS bf16x8*)(lds + PG8_SA(b, h) + aoff + m * 2048 + k * 1024); } while (0)
#define PG8_LDB(dst, b, h) do { _Pragma("unroll") for (int n = 0; n < 2; ++n) _Pragma("unroll") for (int k = 0; k < 2; ++k) dst[n][k] = *(const PG8_LAS bf16x8*)(lds + PG8_SB(b, h) + boff + n * 2048 + k * 1024); } while (0)
#define PG8_MMA(ai, bj, At, Bt) do { __builtin_amdgcn_s_setprio(1); if constexpr (!(PROBE & 2)) _Pragma("unroll") for (int m = 0; m < 4; ++m) _Pragma("unroll") for (int n = 0; n < 2; ++n) _Pragma("unroll") for (int k = 0; k < 2; ++k) \
        acc[ai][bj][m][n] = __builtin_amdgcn_mfma_f32_16x16x32_bf16(Bt[n][k], At[m][k], acc[ai][bj][m][n], 0, 0, 0); __builtin_amdgcn_s_setprio(0); } while (0)
#define PG8_WAIT_V(n) asm volatile("s_waitcnt vmcnt(" #n ")" ::: "memory")
#define PG8_WAIT_L(n) asm volatile("s_waitcnt lgkmcnt(" #n ")" ::: "memory")
#define PG8_BAR __builtin_amdgcn_s_barrier()
#define PG8_SCHED __builtin_amdgcn_sched_barrier(0)
    Unit cur, nxt; int ui = 0;
    if (!S.next(0, cur)) return;
    f32x4 acc[2][2][4][2];
#pragma unroll
    for (int a = 0; a < 2; ++a)
#pragma unroll
        for (int b = 0; b < 2; ++b)
#pragma unroll
            for (int m = 0; m < 4; ++m)
#pragma unroll
                for (int n = 0; n < 2; ++n) acc[a][b][m][n] = (f32x4){0.f, 0.f, 0.f, 0.f};
    bf16x8 At[4][2], B0[2][2], B1[2][2];
    const char* cA = (const char*)g.A + (size_t)cur.pm * tstep; const char* cB = (const char*)g.Bt + (size_t)cur.pn * tstep;
    S.a_ready(cur);
    if constexpr (SP2) {
        PG8_STAGE(PG8_SB(0, 0), cB, voffB); PG8_STAGE(PG8_SB(0, 1), cB + hstep, voffB); PG8_STAGE(PG8_SA(0, 0), cA, voffA); PG8_STAGE(PG8_SA(0, 1), cA + hstep, voffA);
        if (wr == 1) PG8_BAR;
        PG8_WAIT_V(2); PG8_BAR;
        PG8_STAGE(PG8_SB(1, 0), cB + kstep, voffB); PG8_STAGE(PG8_SA(1, 0), cA + kstep, voffA); PG8_STAGE(PG8_SB(1, 1), cB + hstep + kstep, voffB);
        PG8_WAIT_V(6); PG8_BAR;
    } else {
        PG8_STAGE(PG8_SB(0, 0), cB, voffB); PG8_STAGE(PG8_SA(0, 0), cA, voffA); PG8_STAGE(PG8_SB(0, 1), cB + hstep, voffB); PG8_STAGE(PG8_SA(0, 1), cA + hstep, voffA);
        if (wr == 1) PG8_BAR;
        PG8_WAIT_V(4); PG8_BAR;
        PG8_STAGE(PG8_SB(1, 0), cB + kstep, voffB); PG8_STAGE(PG8_SA(1, 0), cA + kstep, voffA); PG8_STAGE(PG8_SB(1, 1), cB + hstep + kstep, voffB);
        PG8_WAIT_V(6); PG8_BAR;
    }
    for (;;) {
        const bool has_next = S.next(ui + 1, nxt);
        const char* nA = has_next ? (const char*)g.A + (size_t)nxt.pm * tstep : cA; const char* nB = has_next ? (const char*)g.Bt + (size_t)nxt.pn * tstep : cB;
        for (int t = 0; t < nt; t += 2) {
            const bool last = (t == nt - 2);
            const char* a1 = cA + (size_t)(t + 1) * kstep;
            const char* a2 = last ? nA : cA + (size_t)(t + 2) * kstep; const char* b2 = last ? nB : cB + (size_t)(t + 2) * kstep;
            const char* a3 = a2 + kstep; const char* b3 = b2 + kstep;
            if (last && has_next) S.a_ready(nxt);
            if constexpr (Epi::HOOK) { if (t == Epi::SEG1 || t == Epi::SEG2) E.rescale(acc, cur, t == Epi::SEG1 ? 1 : 2, wr, wc, fr, fq); }
            if constexpr (SP2) {
            PG8_LDB(B0, 0, 0); PG8_LDB(B1, 0, 1); PG8_SCHED; PG8_LDA(At, 0, 0); PG8_STAGE(PG8_SA(1, 1), a1 + hstep, voffA);
            PG8_WAIT_V(8); PG8_WAIT_L(0); PG8_BAR; PG8_MMA(0, 0, At, B0); PG8_MMA(0, 1, At, B1); PG8_BAR; PG8_SCHED;
            PG8_LDA(At, 0, 1); PG8_STAGE(PG8_SB(0, 0), b2, voffB); PG8_STAGE(PG8_SB(0, 1), b2 + hstep, voffB); PG8_STAGE(PG8_SA(0, 0), a2, voffA);
            PG8_WAIT_V(8); PG8_WAIT_L(0); PG8_BAR; PG8_MMA(1, 0, At, B0); PG8_MMA(1, 1, At, B1); PG8_BAR; PG8_SCHED;
            PG8_LDB(B0, 1, 0); PG8_LDB(B1, 1, 1); PG8_SCHED; PG8_LDA(At, 1, 0); PG8_STAGE(PG8_SA(0, 1), a2 + hstep, voffA);
            PG8_WAIT_V(8); PG8_WAIT_L(0); PG8_BAR; PG8_MMA(0, 0, At, B0); PG8_MMA(0, 1, At, B1); PG8_BAR; PG8_SCHED;
            PG8_LDA(At, 1, 1); PG8_STAGE(PG8_SB(1, 0), b3, voffB); PG8_STAGE(PG8_SB(1, 1), b3 + hstep, voffB); PG8_STAGE(PG8_SA(1, 0), a3, voffA);
            PG8_WAIT_V(8); PG8_WAIT_L(0); PG8_BAR; PG8_MMA(1, 0, At, B0); PG8_MMA(1, 1, At, B1); PG8_BAR; PG8_SCHED;
            } else {
            PG8_LDB(B0, 0, 0); PG8_SCHED; PG8_LDA(At, 0, 0); PG8_STAGE(PG8_SA(1, 1), a1 + hstep, voffA);
            PG8_WAIT_L(8); PG8_BAR; PG8_WAIT_L(0); PG8_MMA(0, 0, At, B0); PG8_BAR; PG8_SCHED;
            PG8_LDB(B1, 0, 1); PG8_STAGE(PG8_SB(0, 0), b2, voffB);
            PG8_BAR; PG8_WAIT_L(0); PG8_MMA(0, 1, At, B1); PG8_BAR;
            PG8_LDA(At, 0, 1); PG8_STAGE(PG8_SA(0, 0), a2, voffA);
            PG8_BAR; PG8_WAIT_L(0); PG8_MMA(1, 0, At, B0); PG8_BAR; PG8_SCHED;
            PG8_STAGE(PG8_SB(0, 1), b2 + hstep, voffB);
            PG8_WAIT_V(6); PG8_BAR; PG8_MMA(1, 1, At, B1); PG8_BAR;
            PG8_LDB(B0, 1, 0); PG8_SCHED; PG8_LDA(At, 1, 0); PG8_STAGE(PG8_SA(0, 1), a2 + hstep, voffA);
            PG8_WAIT_L(8); PG8_BAR; PG8_WAIT_L(0); PG8_MMA(0, 0, At, B0); PG8_BAR; PG8_SCHED;
            PG8_LDB(B1, 1, 1); PG8_STAGE(PG8_SB(1, 0), b3, voffB);
            PG8_BAR; PG8_WAIT_L(0); PG8_MMA(0, 1, At, B1); PG8_BAR;
            PG8_LDA(At, 1, 1); PG8_STAGE(PG8_SA(1, 0), a3, voffA);
            PG8_BAR; PG8_WAIT_L(0); PG8_MMA(1, 0, At, B0); PG8_BAR; PG8_SCHED;
            PG8_STAGE(PG8_SB(1, 1), b3 + hstep, voffB);
            PG8_WAIT_V(6); PG8_BAR; PG8_MMA(1, 1, At, B1); PG8_BAR;
            }
        }
        if constexpr (ALIGN_EPI) { if (wr == 0) PG8_BAR; }
        if constexpr ((PROBE & 8) != 0) { f32x4 s_ = acc[0][0][0][0];
#pragma unroll
            for (int a_ = 0; a_ < 2; ++a_)
#pragma unroll
                for (int b_ = 0; b_ < 2; ++b_)
#pragma unroll
                    for (int m_ = 0; m_ < 4; ++m_)
#pragma unroll
                        for (int n_ = 0; n_ < 2; ++n_) s_ += acc[a_][b_][m_][n_];
            if (s_[0] + s_[1] + s_[2] + s_[3] == 1234.567f) *(volatile float*)g.A = s_[0]; }
        if constexpr (!Epi::AFTER_DRAIN && !(PROBE & 1)) { int t2_ = threadIdx.x; asm volatile("" : "+v"(t2_)); E(acc, cur, wr, wc, t2_ & 15, (t2_ & 63) >> 4); S.done(cur); }
        if (!has_next) break;
#pragma unroll
        for (int a = 0; a < 2; ++a)
#pragma unroll
            for (int b = 0; b < 2; ++b)
#pragma unroll
                for (int m = 0; m < 4; ++m)
#pragma unroll
                    for (int n = 0; n < 2; ++n) acc[a][b][m][n] = (f32x4){0.f, 0.f, 0.f, 0.f};
        cur = nxt; cA = nA; cB = nB; ++ui;
        if constexpr (ALIGN_EPI) { if (wr == 1) PG8_BAR; }
    }
    PG8_WAIT_V(0);
    if constexpr (!ALIGN_EPI) { if (wr == 0) PG8_BAR; }
    PG8_BAR;
    if constexpr (Epi::AFTER_DRAIN) { E.fused(acc, cur, wr, wc, fr, fq, lds, wid, lane); S.done(cur); }
#undef PG8_SA
#undef PG8_SB
#undef PG8_STAGE
#undef PG8_LDA
#undef PG8_LDB
#undef PG8_MMA
#undef PG8_WAIT_V
#undef PG8_WAIT_L
#undef PG8_BAR
#undef PG8_SCHED
}
}
constexpr int DM = 1024, NBATCH = 8, SEQ = 4096, MTOK = NBATCH * SEQ, DEPTH = 2, DFF = 4096, PLED = 256, NIN = 8472;
constexpr int ZB_LD = 1536, MIX_LD = 3840, SM_LD = 32, N1 = 5632, NGATE = 3072, KMERGE = 1536;
constexpr int MX_AQ = 0, MX_AK = 512, MX_AV = 1024, MX_BX = 1536, MX_BB = 2048, MX_BC = 2176, MX_CQ = 2304, MX_CK = 2816, MX_CV = 3328;
constexpr size_t KiB = 1024, MiB = 1024 * 1024;
constexpr size_t WS_CTL = 0, CTL_BYTES = 64 * KiB;
constexpr size_t WS_W = 64 * KiB;
constexpr size_t W_1T = WS_W, W_GT = W_1T + (size_t)N1 * DM * 2, W_MT = W_GT + (size_t)NGATE * DM * 2, W_OT = W_MT + (size_t)DM * KMERGE * 2, W_UT = W_OT + (size_t)DM * DM * 2,
                 W_DT = W_UT + (size_t)DFF * DM * 2, W_PGT = W_DT + (size_t)DM * DFF * 2, W_PPT = W_PGT + (size_t)DM * DM * 2, W_END = W_PPT + (size_t)DM * PLED * 2;
constexpr size_t WS_SSQA = W_1T + 1 * MiB, WS_SSQB = W_1T + 3 * MiB;
constexpr size_t WS_XB0 = W_END, WS_XB1 = WS_XB0 + 64 * MiB, WS_ZB = WS_XB1 + 64 * MiB, WS_MIX = WS_ZB + 96 * MiB, WS_SM = WS_MIX + 240 * MiB, WS_SSQC = WS_SM + 4 * MiB, WS_ROPE = WS_SSQC + 2 * MiB, WS_END = WS_ROPE + 1 * MiB;
constexpr size_t WS_PB = WS_ZB, WS_PLE = WS_ZB + 16 * MiB, WS_U = WS_ZB + 80 * MiB, WS_GATE = WS_MIX;
static_assert(W_END == WS_W + (size_t)(40 * MiB + 512 * KiB), "weights");
static_assert(WS_U + (size_t)MTOK * DFF * 2 == WS_SM, "U overlay");
static_assert(WS_END <= 512 * MiB, "workspace");
constexpr int LDS_BYTES = 147456, RING_BYTES = 131072, MISC_OFF = RING_BYTES + 320, RS_OFF = RING_BYTES + 1024;
static_assert(RS_OFF + 32 + pg8::RS_SLOTS * 1024 <= LDS_BYTES, "LDS map");

#define GAS __attribute__((address_space(1)))
#define LAS __attribute__((address_space(3)))
typedef unsigned short bf16;
typedef unsigned v4u __attribute__((ext_vector_type(4)));
typedef unsigned v2u __attribute__((ext_vector_type(2)));
typedef float f32x4 __attribute__((ext_vector_type(4)));
#define LDS_WAIT() asm volatile("s_waitcnt lgkmcnt(0)" ::: "memory")
typedef float f32x2_t __attribute__((ext_vector_type(2))); typedef __bf16 bf16x2_t __attribute__((ext_vector_type(2)));
__device__ __forceinline__ unsigned pk2(float lo, float hi) { f32x2_t v = {lo, hi}; bf16x2_t b = __builtin_convertvector(v, bf16x2_t); return __builtin_bit_cast(unsigned, b); }
__device__ __forceinline__ unsigned f2bf(float f) { return pk2(f, 0.f) & 0xffffu; }
__device__ __forceinline__ float bf2f(bf16 v) { return __uint_as_float((unsigned)v << 16); }
__device__ __forceinline__ float wave_sum(float v) {
#pragma unroll
    for (int o = 1; o < 64; o <<= 1) v += __shfl_xor(v, o);
    return v;
}
__device__ __forceinline__ float siluf(float x) { return x * __builtin_amdgcn_rcpf(1.0f + __expf(-x)); }
__device__ __forceinline__ float sigmf(float x) { return __builtin_amdgcn_rcpf(1.0f + __expf(-x)); }
__device__ __forceinline__ float softplusf(float x) { return fmaxf(x, 0.f) + log1pf(__expf(-fabsf(x))); }
__device__ __forceinline__ float rdl(float v, int l) { return __int_as_float(__builtin_amdgcn_readlane(__float_as_int(v), l)); }

#define XB_TMO      128
#define XB_XCNT(j)  (256  + 64 * (j))
#define XB_XSUB(j)  (1280 + 64 * (j))
#define XB_XGEN(j)  (2304 + 64 * (j))
#define XB_TOP      3328
#define XB_TOPGEN   3392
#define XCD_BAR_WORDS 3456
#define XB_SPIN_CAP (1u << 18)
__device__ __forceinline__ unsigned xb_ld(unsigned* p)              { return __hip_atomic_load(p, __ATOMIC_RELAXED, __HIP_MEMORY_SCOPE_AGENT); }
__device__ __forceinline__ unsigned xb_add(unsigned* p, unsigned v) { return __hip_atomic_fetch_add(p, v, __ATOMIC_RELAXED, __HIP_MEMORY_SCOPE_AGENT); }
__device__ __forceinline__ unsigned xb_xcc_id() { return (unsigned)__builtin_amdgcn_s_getreg((3 << 11) | 20) & 0xFu; }
#define XB_SPIN(cond, bar) do { unsigned _sp = 0; while (cond) { __builtin_amdgcn_s_sleep(1); \
    if ((++_sp & 255u) == 0u) { if (xb_ld(&(bar)[XB_TMO])) break; if (_sp > XB_SPIN_CAP) { atomicAdd(&(bar)[XB_TMO], 1u); break; } } } } while (0)
struct XcdBarrier { unsigned* bar; unsigned x; volatile LAS unsigned* st; };
__device__ __forceinline__ XcdBarrier xcd_barrier_post(unsigned* bar, volatile LAS unsigned* st) {
    XcdBarrier b; b.bar = bar; b.x = xb_xcc_id(); b.st = st;
    if (threadIdx.x == 0) (void)xb_add(&bar[XB_XCNT(b.x)], 1u);
    return b;
}
__device__ __forceinline__ void xcd_barrier_complete(unsigned* bar, unsigned x, unsigned& nloc, unsigned& nx) {
    const unsigned G = gridDim.x * gridDim.y * gridDim.z;
    unsigned sum, cnt, mine, sp = 0u;
    for (;;) {
        sum = 0u; cnt = 0u; mine = 0u;
#pragma unroll
        for (unsigned j = 0; j < 16; ++j) { const unsigned c = xb_ld(&bar[XB_XCNT(j)]); sum += c; cnt += (c > 0u) ? 1u : 0u; mine = (j == x) ? c : mine; }
        if (sum == G) break;
        __builtin_amdgcn_s_sleep(1);
        if ((++sp & 255u) == 0u) { if (xb_ld(&bar[XB_TMO])) break; if (sp > XB_SPIN_CAP) { atomicAdd(&bar[XB_TMO], 1u); break; } }
    }
    nloc = mine > 0u ? mine : 1u; nx = cnt > 0u ? cnt : 1u;
}
__device__ __forceinline__ void xcd_barrier(const XcdBarrier& b) {
    asm volatile("s_waitcnt vmcnt(0)" ::: "memory");
    __syncthreads();
    if (threadIdx.x == 0) {
        unsigned* bar = b.bar;
        __builtin_amdgcn_s_waitcnt(0);
        unsigned nloc = b.st[0], nx = b.st[1];
        if (nloc == 0u) { xcd_barrier_complete(bar, b.x, nloc, nx); b.st[0] = nloc; b.st[1] = nx; }
        const unsigned old = xb_add(&bar[XB_XSUB(b.x)], 1u);
        const unsigned gen = old / nloc;
        if (old + 1u == (gen + 1u) * nloc) {
            __builtin_amdgcn_fence(__ATOMIC_RELEASE, "agent");
            asm volatile("s_waitcnt vmcnt(0)" ::: "memory");
            const unsigned og = xb_add(&bar[XB_TOP], 1u);
            const unsigned tg = og / nx;
            if (og + 1u == (tg + 1u) * nx) xb_add(&bar[XB_TOPGEN], 1u);
            else XB_SPIN(xb_ld(&bar[XB_TOPGEN]) == tg, bar);
            __builtin_amdgcn_fence(__ATOMIC_ACQUIRE, "agent");
            xb_add(&bar[XB_XGEN(b.x)], 1u);
            asm volatile("s_waitcnt vmcnt(0)" ::: "memory");
        } else {
            XB_SPIN(xb_ld(&bar[XB_XGEN(b.x)]) == gen, bar);
            __builtin_amdgcn_fence(__ATOMIC_ACQUIRE, "agent");
            asm volatile("s_waitcnt vmcnt(0)" ::: "memory");
        }
    }
    __syncthreads();
}

__device__ __forceinline__ void tr_item(const float* W, int ldw, int c0, int ncols, const float* scale, bf16* dst, int ldd, int r0, int kofs, LAS unsigned char* lds, int item, int tid) {
    const int lane = tid & 63, wave = __builtin_amdgcn_readfirstlane(tid >> 6);
    const int nblk = (ncols + 255) / 256, kb = item / nblk, nb = item - kb * nblk, k0 = 64 * kb, n0 = 256 * nb;
    asm volatile("s_waitcnt lgkmcnt(0)\n\ts_barrier" ::: "memory");
    float v[8][4];
    const int n = n0 + 4 * lane;
    const bool vec = W != nullptr && ((c0 | ldw) & 3) == 0 && n + 3 < ncols;
    const float* wp = W + (size_t)(k0 + 8 * wave) * ldw + c0 + n;
#pragma unroll
    for (int kk = 0; kk < 8; ++kk) {
        if (vec) { const f32x4 t = *(const GAS f32x4*)(wp + (size_t)kk * ldw); v[kk][0] = t[0]; v[kk][1] = t[1]; v[kk][2] = t[2]; v[kk][3] = t[3]; }
        else {
#pragma unroll
            for (int q = 0; q < 4; ++q) v[kk][q] = (W != nullptr && n + q < ncols) ? wp[(size_t)kk * ldw + q] : 0.f; }
        if (scale) { const float s = scale[k0 + 8 * wave + kk];
#pragma unroll
            for (int q = 0; q < 4; ++q) v[kk][q] *= s; } }
#pragma unroll
    for (int q = 0; q < 4; ++q) { v4u o; o.x = pk2(v[0][q], v[1][q]); o.y = pk2(v[2][q], v[3][q]); o.z = pk2(v[4][q], v[5][q]); o.w = pk2(v[6][q], v[7][q]);
        *(LAS v4u*)(lds + (4 * lane + q) * 128 + ((wave ^ (lane & 7)) << 4)) = o; }
    asm volatile("s_waitcnt lgkmcnt(0)\n\ts_barrier" ::: "memory");
#pragma unroll
    for (int i = 0; i < 4; ++i) { const int nl = (tid >> 3) + 64 * i, ch = tid & 7;
        if (n0 + nl < ncols) *(GAS v4u*)(dst + (size_t)(r0 + n0 + nl) * ldd + kofs + k0 + ch * 8) = *(const LAS v4u*)(lds + nl * 128 + ((ch ^ ((nl >> 2) & 7)) << 4)); }
}
#define TR_SEG(W_, ldw_, c0_, ncols_, K_, scale_, dst_, ldd_, r0_, kofs_) do { const int _n = ((K_) / 64) * (((ncols_) + 255) / 256); \
    for (int _it = (bx + G - (ibase % G)) % G; _it < _n; _it += G) tr_item(W_, ldw_, c0_, ncols_, scale_, dst_, ldd_, r0_, kofs_, lds, _it, tid); ibase += _n; } while (0)

__device__ __forceinline__ void build_rs_table(const pg8::StaticOrder& S, const float* ssqp, LAS unsigned char* lds, int tid) {
    LAS int* pml = (LAS int*)(lds + RS_OFF); LAS float* tab = (LAS float*)(lds + RS_OFF + 32);
    __syncthreads();
    if (tid == 0) { int npm = 0;
        for (int k = 0; k < pg8::RS_SLOTS; ++k) pml[k] = -1;
        for (int i = 0; ; ++i) { pg8::Unit u; if (!S.next(i, u)) break; bool found = false;
            for (int k = 0; k < npm; ++k) found = found || (pml[k] == u.pm);
            if (!found && npm < pg8::RS_SLOTS) pml[npm++] = u.pm; } }
    __syncthreads();
#pragma unroll 1
    for (int s = tid >> 8; s < pg8::RS_SLOTS; s += 2) { const int pm = pml[s]; if (pm < 0) continue;
        const float* p = ssqp + ((size_t)pm * 256 + (tid & 255)) * 16;
        const f32x4 a = *(const f32x4*)p, b = *(const f32x4*)(p + 4), c = *(const f32x4*)(p + 8), d = *(const f32x4*)(p + 12);
        const float ss = ((a[0] + a[1]) + (a[2] + a[3])) + ((b[0] + b[1]) + (b[2] + b[3])) + ((c[0] + c[1]) + (c[2] + c[3])) + ((d[0] + d[1]) + (d[2] + d[3]));
        tab[s * 256 + (tid & 255)] = rsqrtf(ss * (1.0f / 1024.0f) + 1e-6f); }
    __syncthreads();
}
struct Args { const float* in[23]; float* out; unsigned char* ws; int ph_lo, ph_hi; };
constexpr int NPH = 10, PH_FINAL = DEPTH * NPH, N_PHASES = PH_FINAL + 1;

typedef short bf16x8 __attribute__((ext_vector_type(8)));
constexpr int PT = 72, MAT = 64 * PT * 2;
constexpr int SETB = 4 * MAT + 512;
constexpr int L_Q = 0, L_K = MAT, L_V = 2 * MAT, L_U = 2 * MAT, L_W = 3 * MAT, L_G = 4 * MAT, L_DT = 4 * MAT + 256;
constexpr int L_VT = 2 * SETB, L_ST0 = L_VT + MAT, L_ST1 = L_ST0 + MAT, L_PP = L_ST1 + MAT, L_YT = L_PP + MAT, L_WEND = L_YT + 2 * MAT;
static_assert(L_WEND <= RING_BYTES, "walker LDS");
constexpr size_t GW_OFF = 0, HALO_OFF = 32 * MiB;
constexpr int HALO_LD = 2304;
#define MFMA16(a, b, c) __builtin_amdgcn_mfma_f32_16x16x32_bf16(a, b, c, 0, 0, 0)
__device__ __forceinline__ bf16x8 ldfrag(LAS unsigned char* base, int row, int kelem) { return *(const LAS bf16x8*)(base + row * (PT * 2) + kelem * 2); }
__device__ __forceinline__ void unpk8(const v4u w, float (&f)[8]) { f[0] = pg8::bflo(w.x); f[1] = pg8::bfhi(w.x); f[2] = pg8::bflo(w.y); f[3] = pg8::bfhi(w.y); f[4] = pg8::bflo(w.z); f[5] = pg8::bfhi(w.z); f[6] = pg8::bflo(w.w); f[7] = pg8::bfhi(w.w); }
__device__ __forceinline__ v4u pk8(const float (&f)[8]) { v4u w; w.x = pk2(f[0], f[1]); w.y = pk2(f[2], f[3]); w.z = pk2(f[4], f[5]); w.w = pk2(f[6], f[7]); return w; }
__device__ __forceinline__ void st_tr8(LAS unsigned char* base, int row0, int col, const float (&f)[8]) {
#pragma unroll
    for (int j = 0; j < 8; ++j) *(LAS bf16*)(base + (row0 + j) * (PT * 2) + col * 2) = (bf16)f2bf(f[j]);
}

#define LBAR() asm volatile("s_waitcnt lgkmcnt(0)\n\ts_barrier" ::: "memory")
typedef short s16x4 __attribute__((ext_vector_type(4)));
__device__ __forceinline__ s16x4 tr4(LAS unsigned char* p) { return __builtin_bit_cast(s16x4, __builtin_amdgcn_ds_read_tr16_b64_v4i16((LAS s16x4*)p)); }
__device__ __forceinline__ bf16x8 trfrag(LAS unsigned char* tile, int krow0, int col0, int fr) {
    LAS unsigned char* a = tile + (krow0 + (fr >> 2)) * (PT * 2) + (col0 + 4 * (fr & 3)) * 2;
    const s16x4 lo = tr4(a), hi = tr4(a + 4 * PT * 2);
    return (bf16x8){lo[0], lo[1], lo[2], lo[3], hi[0], hi[1], hi[2], hi[3]};
}
__device__ __forceinline__ float bfs(short v) { return __uint_as_float((unsigned)(unsigned short)v << 16); }

template <int KIND>
__device__ __forceinline__ void mixer_walk(const __attribute__((address_space(4))) Args* kp, int layer, int b, int h, LAS unsigned char* lds) {
    int tid = threadIdx.x; asm volatile("" : "+v"(tid));
    const int lane = tid & 63, wave = __builtin_amdgcn_readfirstlane(tid >> 6), fr = lane & 15, fq = lane >> 4;
    const int prow = tid >> 3, pcg = tid & 7;
    unsigned char* ws = kp->ws;
    const bf16* MIX = (const bf16*)(ws + WS_MIX); bf16* ZB = (bf16*)(ws + WS_ZB); float* SM = (float*)(ws + WS_SM);
    const bf16* GW = (const bf16*)(ws + ((layer & 1) ? WS_XB0 : WS_XB1) + GW_OFF);
    const size_t tok0 = (size_t)b * SEQ;
    const int g = h >> 2;
    const int qcol = (KIND == 0 ? MX_AQ + h * 64 : (KIND == 1 ? MX_BC + g * 64 : MX_CQ + h * 64)) + pcg * 8;
    const int kcol = (KIND == 0 ? MX_AK + h * 64 : (KIND == 1 ? MX_BB + g * 64 : MX_CK + h * 64)) + pcg * 8;
    const int vcol = (KIND == 0 ? MX_AV + h * 64 : (KIND == 1 ? MX_BX + h * 64 : MX_CV + h * 64)) + pcg * 8;
    const int zcol = KIND * 512 + h * 64 + pcg * 8;
    const int gcol = (KIND == 0 ? 8 : 16) + h;
    float nw[8];
    if (KIND == 0) {
#pragma unroll
        for (int j = 0; j < 8; ++j) nw[j] = kp->in[7][layer * 64 + pcg * 8 + j];
    }
    const float p_D = KIND == 1 ? kp->in[12][layer * 8 + h] : 0.f;
    const float p_lg = KIND == 2 ? log1pf(-exp2f(-5.0f - (float)h)) : 0.f;
    for (int i = tid; i < MAT / 4; i += 512) ((LAS unsigned*)(lds + L_ST0))[i] = 0u;
    pg8::f32x4 sacc[4];
#pragma unroll
    for (int i = 0; i < 4; ++i) sacc[i] = (pg8::f32x4){0.f, 0.f, 0.f, 0.f};
    LAS unsigned char* PPw = lds + L_PP + (wave & 3) * (16 * PT * 2);

    v4u tq, tk, tv, tw, tz; float sg = 0.f, sd = 1.f; (void)tw;
#define WALK_LOAD(c) do { const size_t row = tok0 + (size_t)(c) * 64 + prow; \
        tq = *(const GAS v4u*)(MIX + mixh(qcol, row)); tk = *(const GAS v4u*)(MIX + mixh(kcol, row)); tv = *(const GAS v4u*)(MIX + mixh(vcol, row)); \
        if (KIND == 0) tw = *(const GAS v4u*)(GW + gwh(h, pcg * 8, row)); \
        tz = *(const GAS v4u*)(ZB + row * ZB_LD + zcol); \
        if (tid < 64) { const size_t r2 = tok0 + (size_t)(c) * 64 + tid; \
            if (KIND == 2) sg = (float)(tid + 1) * p_lg; else sg = SM[r2 * SM_LD + gcol]; \
            if (KIND == 1) sd = SM[r2 * SM_LD + 24 + h]; } } while (0)
#define WALK_PREP(sb_) do { LAS unsigned char* sp_ = lds + (sb_) * SETB; \
        *(LAS v4u*)(sp_ + L_Q + prow * (PT * 2) + pcg * 16) = tq; *(LAS v4u*)(sp_ + L_K + prow * (PT * 2) + pcg * 16) = tk; \
        *(LAS v4u*)(sp_ + L_V + prow * (PT * 2) + pcg * 16) = tv; \
        if (KIND == 0) *(LAS v4u*)(sp_ + L_W + prow * (PT * 2) + pcg * 16) = tw; \
        if (tid < 64) { ((LAS float*)(sp_ + L_G))[tid] = sg; ((LAS float*)(sp_ + L_DT))[tid] = sd; } } while (0)

    WALK_LOAD(0);
    WALK_PREP(0);
    v4u zc = tz, xc = tv;
    LBAR();
    for (int c = 0; c < SEQ / 64; ++c) {
        LAS unsigned char* STc = lds + ((c & 1) ? L_ST1 : L_ST0); LAS unsigned char* STn = lds + ((c & 1) ? L_ST0 : L_ST1);
        LAS unsigned char* sp = lds + (c & 1) * SETB;
        const LAS float* Gv = (const LAS float*)(sp + L_G); const LAS float* Dv = (const LAS float*)(sp + L_DT);
        LAS unsigned char* YTc = lds + L_YT + (c & 1) * MAT;
        if (c + 1 < SEQ / 64) WALK_LOAD(c + 1);
        bf16x8 Qf[2];
        if (wave < 4) { const int lb = wave;
            Qf[0] = ldfrag(sp + L_Q, 16 * lb + fr, 8 * fq); Qf[1] = ldfrag(sp + L_Q, 16 * lb + fr, 32 + 8 * fq);
            bf16x8 Kb[4][2]; pg8::f32x4 gs[4], ds[4], pacc[4];
#pragma unroll
            for (int sb = 0; sb < 4; ++sb) if (sb <= lb) { Kb[sb][0] = ldfrag(sp + L_K, 16 * sb + fr, 8 * fq); Kb[sb][1] = ldfrag(sp + L_K, 16 * sb + fr, 32 + 8 * fq);
                gs[sb] = *(const LAS pg8::f32x4*)(Gv + 16 * sb + 4 * fq); ds[sb] = (pg8::f32x4){1.f, 1.f, 1.f, 1.f};
                if (KIND == 1) ds[sb] = *(const LAS pg8::f32x4*)(Dv + 16 * sb + 4 * fq); }
            const float gl = Gv[16 * lb + fr];
#pragma unroll
            for (int sb = 0; sb < 4; ++sb) if (sb <= lb) { pacc[sb] = MFMA16(Kb[sb][0], Qf[0], ((pg8::f32x4){0.f, 0.f, 0.f, 0.f})); }
#pragma unroll
            for (int sb = 0; sb < 4; ++sb) if (sb <= lb) { pacc[sb] = MFMA16(Kb[sb][1], Qf[1], pacc[sb]); }
#pragma unroll
            for (int sb = 0; sb < 4; ++sb) { v2u o; o.x = 0u; o.y = 0u;
                if (sb <= lb) { float pv[4];
#pragma unroll
                    for (int r = 0; r < 4; ++r) pv[r] = (16 * sb + 4 * fq + r <= 16 * lb + fr) ? pacc[sb][r] * __expf(gl - gs[sb][r]) * ds[sb][r] : 0.f;
                    o.x = pk2(pv[0], pv[1]); o.y = pk2(pv[2], pv[3]); }
                *(LAS v2u*)(PPw + fr * (PT * 2) + (16 * sb + 4 * fq) * 2) = o; }
        } else if (KIND == 0) { const int wq = wave - 4;
            const bf16x8 Wf0 = ldfrag(sp + L_W, 16 * wq + fr, 8 * fq), Wf1 = ldfrag(sp + L_W, 16 * wq + fr, 32 + 8 * fq);
            bf16x8 Sf[4][2]; s16x4 u4[4]; pg8::f32x4 vacc[4];
#pragma unroll
            for (int eb = 0; eb < 4; ++eb) { Sf[eb][0] = ldfrag(STc, 16 * eb + fr, 8 * fq); Sf[eb][1] = ldfrag(STc, 16 * eb + fr, 32 + 8 * fq);
                u4[eb] = tr4(sp + L_U + (16 * wq + 4 * fq + (fr >> 2)) * (PT * 2) + (16 * eb + 4 * (fr & 3)) * 2); }
#pragma unroll
            for (int eb = 0; eb < 4; ++eb) vacc[eb] = MFMA16(Wf0, Sf[eb][0], ((pg8::f32x4){0.f, 0.f, 0.f, 0.f}));
#pragma unroll
            for (int eb = 0; eb < 4; ++eb) vacc[eb] = MFMA16(Wf1, Sf[eb][1], vacc[eb]);
#pragma unroll
            for (int eb = 0; eb < 4; ++eb) { v2u o; o.x = pk2(bfs(u4[eb][0]) - vacc[eb][0], bfs(u4[eb][1]) - vacc[eb][1]); o.y = pk2(bfs(u4[eb][2]) - vacc[eb][2], bfs(u4[eb][3]) - vacc[eb][3]);
                *(LAS v2u*)(lds + L_VT + (16 * eb + fr) * (PT * 2) + (16 * wq + 4 * fq) * 2) = o; }
        }
        if (KIND == 0) LBAR();
        if (wave < 4) { const int lb = wave;
            const bf16x8 Pf0 = ldfrag(PPw, fr, 8 * fq), Pf1 = ldfrag(PPw, fr, 32 + 8 * fq);
            const pg8::f32x4 gv = *(const LAS pg8::f32x4*)(Gv + 16 * lb + 4 * fq);
            bf16x8 Sf[4][2], Vf[4][2]; pg8::f32x4 yacc[4];
#pragma unroll
            for (int eb = 0; eb < 4; ++eb) { Sf[eb][0] = ldfrag(STc, 16 * eb + fr, 8 * fq); Sf[eb][1] = ldfrag(STc, 16 * eb + fr, 32 + 8 * fq);
                if (KIND == 0) { Vf[eb][0] = ldfrag(lds + L_VT, 16 * eb + fr, 8 * fq); Vf[eb][1] = ldfrag(lds + L_VT, 16 * eb + fr, 32 + 8 * fq); }
                else { Vf[eb][0] = trfrag(sp + L_V, 8 * fq, 16 * eb, fr); Vf[eb][1] = trfrag(sp + L_V, 32 + 8 * fq, 16 * eb, fr); } }
            const pg8::f32x4 eg = (pg8::f32x4){__expf(gv[0]), __expf(gv[1]), __expf(gv[2]), __expf(gv[3])};
#pragma unroll
            for (int eb = 0; eb < 4; ++eb) yacc[eb] = MFMA16(Qf[0], Sf[eb][0], ((pg8::f32x4){0.f, 0.f, 0.f, 0.f}));
#pragma unroll
            for (int eb = 0; eb < 4; ++eb) yacc[eb] = MFMA16(Qf[1], Sf[eb][1], yacc[eb]);
#pragma unroll
            for (int eb = 0; eb < 4; ++eb) yacc[eb] *= eg;
#pragma unroll
            for (int eb = 0; eb < 4; ++eb) yacc[eb] = MFMA16(Pf0, Vf[eb][0], yacc[eb]);
#pragma unroll
            for (int eb = 0; eb < 4; ++eb) yacc[eb] = MFMA16(Pf1, Vf[eb][1], yacc[eb]);
#pragma unroll
            for (int eb = 0; eb < 4; ++eb)
#pragma unroll
                for (int r = 0; r < 4; ++r) *(LAS bf16*)(YTc + (16 * lb + 4 * fq + r) * (PT * 2) + (16 * eb + fr) * 2) = (bf16)f2bf(yacc[eb][r]);
        } else { const int db = wave - 4;
            const float glast = Gv[63], egl = __expf(glast);
            bf16x8 Kr[2], Vf[4][2]; pg8::f32x4 g0[2], g1[2], d0[2], d1[2];
#pragma unroll
            for (int ks = 0; ks < 2; ++ks) { Kr[ks] = trfrag(sp + L_K, 32 * ks + 8 * fq, 16 * db, fr);
                g0[ks] = *(const LAS pg8::f32x4*)(Gv + 32 * ks + 8 * fq); g1[ks] = *(const LAS pg8::f32x4*)(Gv + 32 * ks + 8 * fq + 4);
                d0[ks] = (pg8::f32x4){1.f, 1.f, 1.f, 1.f}; d1[ks] = d0[ks];
                if (KIND == 1) { d0[ks] = *(const LAS pg8::f32x4*)(Dv + 32 * ks + 8 * fq); d1[ks] = *(const LAS pg8::f32x4*)(Dv + 32 * ks + 8 * fq + 4); } }
#pragma unroll
            for (int eb = 0; eb < 4; ++eb) {
                if (KIND == 0) { Vf[eb][0] = ldfrag(lds + L_VT, 16 * eb + fr, 8 * fq); Vf[eb][1] = ldfrag(lds + L_VT, 16 * eb + fr, 32 + 8 * fq); }
                else { Vf[eb][0] = trfrag(sp + L_V, 8 * fq, 16 * eb, fr); Vf[eb][1] = trfrag(sp + L_V, 32 + 8 * fq, 16 * eb, fr); } }
            bf16x8 Kf[2];
#pragma unroll
            for (int ks = 0; ks < 2; ++ks) { float kf[8];
#pragma unroll
                for (int j = 0; j < 4; ++j) { kf[j] = bfs(Kr[ks][j]) * __expf(glast - g0[ks][j]) * d0[ks][j]; kf[4 + j] = bfs(Kr[ks][4 + j]) * __expf(glast - g1[ks][j]) * d1[ks][j]; }
                const v4u kw = pk8(kf); Kf[ks] = __builtin_bit_cast(bf16x8, kw); }
#pragma unroll
            for (int eb = 0; eb < 4; ++eb) sacc[eb] = MFMA16(Kf[0], Vf[eb][0], sacc[eb] * egl);
#pragma unroll
            for (int eb = 0; eb < 4; ++eb) sacc[eb] = MFMA16(Kf[1], Vf[eb][1], sacc[eb]);
#pragma unroll
            for (int eb = 0; eb < 4; ++eb) { v2u o; o.x = pk2(sacc[eb][0], sacc[eb][1]); o.y = pk2(sacc[eb][2], sacc[eb][3]);
                *(LAS v2u*)(STn + (16 * eb + fr) * (PT * 2) + (16 * db + 4 * fq) * 2) = o; }
        }
        const v4u zcur = zc, xcur = xc; (void)xcur;
        if (c + 1 < SEQ / 64) { WALK_PREP((c + 1) & 1); zc = tz; xc = tv; }
        LBAR();
        {
            float y[8], zf[8]; unpk8(*(const LAS v4u*)(YTc + prow * (PT * 2) + pcg * 16), y); unpk8(zcur, zf);
            const size_t row = tok0 + (size_t)c * 64 + prow;
            if (KIND == 1) { float ss = 0.f, xf[8]; unpk8(xcur, xf);
#pragma unroll
                for (int j = 0; j < 8; ++j) { y[j] = (y[j] + p_D * xf[j]) * siluf(zf[j]); ss += y[j] * y[j]; }
                ss += __shfl_xor(ss, 1); ss += __shfl_xor(ss, 2); ss += __shfl_xor(ss, 4);
                if (pcg == 0) SM[row * SM_LD + 16 + h] = ss;
            } else { float ss = 0.f;
#pragma unroll
                for (int j = 0; j < 8; ++j) ss += y[j] * y[j];
                ss += __shfl_xor(ss, 1); ss += __shfl_xor(ss, 2); ss += __shfl_xor(ss, 4);
                const float rstd = rsqrtf(ss * (1.0f / 64.0f) + 1e-6f);
#pragma unroll
                for (int j = 0; j < 8; ++j) y[j] = y[j] * rstd * (KIND == 0 ? nw[j] : 1.0f) * siluf(zf[j]); }
            *(GAS v4u*)(ZB + row * ZB_LD + zcol) = pk8(y);
        }
    }
#undef WALK_LOAD
#undef WALK_PREP
}

constexpr int SP_RAW = 0, SP_CW = 67 * 1536, SP_END = SP_CW + 5 * 768 * 4;
static_assert(SP_END <= RING_BYTES, "ssd_prep LDS");
__device__ __forceinline__ void ssd_prep(const __attribute__((address_space(4))) Args* kp, int layer, LAS unsigned char* lds, int G_) {
    int tid = threadIdx.x; asm volatile("" : "+v"(tid));
    const int lane = tid & 63, wave = __builtin_amdgcn_readfirstlane(tid >> 6);
    unsigned char* ws = kp->ws;
    bf16* MIX = (bf16*)(ws + WS_MIX); float* SM = (float*)(ws + WS_SM);
    const bf16* HALO = (const bf16*)(ws + ((layer & 1) ? WS_XB0 : WS_XB1) + HALO_OFF);
    LAS float* CW = (LAS float*)(lds + SP_CW);
    { const float* cw = kp->in[8] + (size_t)layer * 4 * 768; const float* cb = kp->in[9] + (size_t)layer * 768;
      for (int i = tid; i < 768; i += 512) { CW[i] = cw[i]; CW[768 + i] = cw[768 + i]; CW[2 * 768 + i] = cw[2 * 768 + i]; CW[3 * 768 + i] = cw[3 * 768 + i]; CW[4 * 768 + i] = cb[i]; } }
    const float Aexp = expf(kp->in[10][layer * 8 + wave]), dtb = kp->in[11][layer * 8 + wave];
    for (int unit = blockIdx.x; unit < NBATCH * 64; unit += G_) { const int b = unit >> 6, c = unit & 63; const size_t tok0 = (size_t)b * SEQ + (size_t)c * 64;
        LBAR();
        for (int i = tid; i < 67 * 96; i += 512) { const int r = i / 96, pc = i - r * 96; v4u v = (v4u){0u, 0u, 0u, 0u};
            if (r >= 3) v = *(const GAS v4u*)(MIX + mixh(MX_BX + pc * 8, tok0 + r - 3));
            else if (c > 0) v = *(const GAS v4u*)(HALO + ((size_t)(b * 64 + c - 1) * 3 + r) * HALO_LD + MX_BX + pc * 8);
            *(LAS v4u*)(lds + SP_RAW + r * 1536 + pc * 16) = v; }
        { const size_t r2 = tok0 + lane; const float dt = softplusf(SM[r2 * SM_LD + 16 + wave] + dtb); float gs = -Aexp * dt;
#pragma unroll
          for (int o = 1; o < 64; o <<= 1) { const float t_ = __shfl_up(gs, o); if (lane >= o) gs += t_; }
          SM[r2 * SM_LD + 16 + wave] = gs; SM[r2 * SM_LD + 24 + wave] = dt; }
        LBAR();
        for (int i = tid; i < 64 * 96; i += 512) { const int l = i / 96, pc = i - l * 96; float a[8];
            { const pg8::f32x4 b0 = *(const LAS pg8::f32x4*)(CW + 4 * 768 + pc * 8), b1 = *(const LAS pg8::f32x4*)(CW + 4 * 768 + pc * 8 + 4);
              a[0] = b0[0]; a[1] = b0[1]; a[2] = b0[2]; a[3] = b0[3]; a[4] = b1[0]; a[5] = b1[1]; a[6] = b1[2]; a[7] = b1[3]; }
#pragma unroll
            for (int k = 0; k < 4; ++k) { float f[8]; unpk8(*(const LAS v4u*)(lds + SP_RAW + (l + k) * 1536 + pc * 16), f);
                const pg8::f32x4 w0 = *(const LAS pg8::f32x4*)(CW + k * 768 + pc * 8), w1 = *(const LAS pg8::f32x4*)(CW + k * 768 + pc * 8 + 4);
#pragma unroll
                for (int j = 0; j < 4; ++j) { a[j] += w0[j] * f[j]; a[4 + j] += w1[j] * f[4 + j]; } }
#pragma unroll
            for (int j = 0; j < 8; ++j) a[j] = siluf(a[j]);
            *(GAS v4u*)(MIX + mixh(MX_BX + pc * 8, tok0 + l)) = pk8(a); }
    }
    LBAR();
}
__device__ __forceinline__ void ret_prep(const __attribute__((address_space(4))) Args* kp, int G_) {
    int tid = threadIdx.x; asm volatile("" : "+v"(tid));
    unsigned char* ws = kp->ws;
    bf16* MIX = (bf16*)(ws + WS_MIX); const float* ROPE = (const float*)(ws + WS_ROPE);
    for (int it = blockIdx.x * 512 + tid; it < MTOK * 32; it += G_ * 512) { const int m = it >> 5, hh = (it >> 2) & 7, i4 = it & 3, t = m & (SEQ - 1);
        const float* rp = ROPE + t * 32 + i4 * 8;
        const pg8::f32x4 c0 = *(const GAS pg8::f32x4*)rp, c1 = *(const GAS pg8::f32x4*)(rp + 4), s0 = *(const GAS pg8::f32x4*)(rp + SEQ * 32), s1 = *(const GAS pg8::f32x4*)(rp + SEQ * 32 + 4);
        const float cs[8] = {c0[0], c0[1], c0[2], c0[3], c1[0], c1[1], c1[2], c1[3]}, sn[8] = {s0[0], s0[1], s0[2], s0[3], s1[0], s1[1], s1[2], s1[3]};
#pragma unroll
        for (int T = 0; T < 2; ++T) { bf16* p = MIX + mixh((T == 0 ? MX_CQ : MX_CK) + hh * 64 + i4 * 8, (size_t)m); const float sc = T == 0 ? 1.0f : 0.125f;
            float a[8], bb[8], o1[8], o2[8]; unpk8(*(const GAS v4u*)p, a); unpk8(*(const GAS v4u*)(p + 32), bb);
#pragma unroll
            for (int j = 0; j < 8; ++j) { o1[j] = (a[j] * cs[j] - bb[j] * sn[j]) * sc; o2[j] = (a[j] * sn[j] + bb[j] * cs[j]) * sc; }
            *(GAS v4u*)p = pk8(o1); *(GAS v4u*)(p + 32) = pk8(o2); }
    }
}

typedef short bf16x4 __attribute__((ext_vector_type(4)));
#define MFMA16K16(a, b, c) __builtin_amdgcn_mfma_f32_16x16x16bf16_1k(a, b, c, 0, 0, 0)
constexpr int GQ_RAW = 0, GQ_KN = 67 * 384, GQ_VN = GQ_KN + MAT, GQ_NA = GQ_VN + MAT, GQ_AD = GQ_NA + MAT, GQ_S = GQ_AD + 4 * 16 * 20 * 4, GQ_CW = GQ_S + 512, GQ_TEAM = GQ_CW + 4 * 192 * 4;
static_assert(2 * GQ_TEAM <= RING_BYTES && 2 * MAT <= GQ_KN, "gdn_prep LDS");
__device__ __forceinline__ bf16x4 pk4(const pg8::f32x4 v) { v2u w; w.x = pk2(v[0], v[1]); w.y = pk2(v[2], v[3]); return __builtin_bit_cast(bf16x4, w); }
__device__ __forceinline__ void gdn_prep(const __attribute__((address_space(4))) Args* kp, int layer, LAS unsigned char* lds_all, int G_) {
    int tid = threadIdx.x; asm volatile("" : "+v"(tid));
    const int team = __builtin_amdgcn_readfirstlane(tid >> 8), j = tid & 255, lane = tid & 63, tw = __builtin_amdgcn_readfirstlane((tid >> 6) & 3), fr = lane & 15, fq = lane >> 4;
    LAS unsigned char* lds = lds_all + team * GQ_TEAM;
    LAS float* AD = (LAS float*)(lds + GQ_AD); LAS float* Gs = (LAS float*)(lds + GQ_S); LAS float* Bs = Gs + 64; LAS float* CW = (LAS float*)(lds + GQ_CW);
    unsigned char* ws = kp->ws;
    bf16* MIX = (bf16*)(ws + WS_MIX); float* SM = (float*)(ws + WS_SM);
    unsigned char* xbf = ws + ((layer & 1) ? WS_XB0 : WS_XB1); bf16* GW = (bf16*)(xbf + GW_OFF); const bf16* HALO = (const bf16*)(xbf + HALO_OFF);
    const float* cw = kp->in[4] + (size_t)layer * 4 * 1536;
    v4u praw[7]; float pcw[3], pbl = 0.f, pal = 0.f;
#define GQ_FETCH(rnd) do { const int u_ = ((rnd) * G_ + (int)blockIdx.x) * 2 + team; const int un_ = u_ < NBATCH * 8 * 64 ? u_ : 0; \
        const int c_ = un_ & 63, h_ = (un_ >> 6) & 7, b_ = un_ >> 9; const size_t tk_ = (size_t)b_ * SEQ + (size_t)c_ * 64; \
        _Pragma("unroll") for (int n = 0; n < 7; ++n) { const int i = j + 256 * n; praw[n] = (v4u){0u, 0u, 0u, 0u}; \
            if (i < 67 * 24) { const int r = i / 24, pc = i - r * 24, col = (pc >> 3) * 512 + h_ * 64 + (pc & 7) * 8; \
                if (r >= 3) praw[n] = *(const GAS v4u*)(MIX + mixh(col, tk_ + r - 3)); \
                else if (c_ > 0) praw[n] = *(const GAS v4u*)(HALO + ((size_t)(b_ * 64 + c_ - 1) * 3 + r) * HALO_LD + col); } } \
        _Pragma("unroll") for (int n = 0; n < 3; ++n) { const int i = j + 256 * n, k = i / 192, cc = i - k * 192; pcw[n] = cw[k * 1536 + (cc >> 6) * 512 + h_ * 64 + (cc & 63)]; } \
        if (tw == 0) { pbl = SM[(tk_ + lane) * SM_LD + h_]; pal = SM[(tk_ + lane) * SM_LD + 8 + h_]; } } while (0)
    GQ_FETCH(0);
    for (int round = 0; round < 8; ++round) {
        const int unit_ = (round * G_ + (int)blockIdx.x) * 2 + team;
        const bool live = unit_ < NBATCH * 8 * 64;
        const int unit = live ? unit_ : 0;
        const int c = unit & 63, h = (unit >> 6) & 7, b = unit >> 9;
        const size_t tok0 = (size_t)b * SEQ + (size_t)c * 64;
        LBAR();
#pragma unroll
        for (int n = 0; n < 7; ++n) { const int i = j + 256 * n; if (i < 67 * 24) { const int r = i / 24, pc = i - r * 24; *(LAS v4u*)(lds + GQ_RAW + r * 384 + pc * 16) = praw[n]; } }
#pragma unroll
        for (int n = 0; n < 3; ++n) CW[j + 256 * n] = pcw[n];
        if (tw == 0) {
            float gsum = -expf(kp->in[5][layer * 8 + h]) * softplusf(pal + kp->in[6][layer * 8 + h]);
#pragma unroll
            for (int o = 1; o < 64; o <<= 1) { const float t_ = __shfl_up(gsum, o); if (lane >= o) gsum += t_; }
            Gs[lane] = gsum; Bs[lane] = sigmf(pbl);
            if (live) SM[(tok0 + lane) * SM_LD + 8 + h] = gsum; }
        if (round + 1 < 8) GQ_FETCH(round + 1);
        LBAR();
#pragma unroll 1
        for (int n = 0; n < 3; ++n) { const int i = j + 256 * n, t2 = i / 24, pc = i - t2 * 24, tens = pc >> 3, ch = pc & 7; float a0[8], a1[8];
#pragma unroll
            for (int jj = 0; jj < 8; ++jj) { a0[jj] = 0.f; a1[jj] = 0.f; }
            pg8::f32x4 wl[4], wh[4];
#pragma unroll
            for (int k = 0; k < 4; ++k) { wl[k] = *(const LAS pg8::f32x4*)(CW + k * 192 + pc * 8); wh[k] = *(const LAS pg8::f32x4*)(CW + k * 192 + pc * 8 + 4); }
#pragma unroll
            for (int r = 0; r < 5; ++r) { float f[8]; unpk8(*(const LAS v4u*)(lds + GQ_RAW + (2 * t2 + r) * 384 + pc * 16), f);
                if (r < 4) {
#pragma unroll
                    for (int jj = 0; jj < 4; ++jj) { a0[jj] += wl[r][jj] * f[jj]; a0[4 + jj] += wh[r][jj] * f[4 + jj]; } }
                if (r > 0) {
#pragma unroll
                    for (int jj = 0; jj < 4; ++jj) { a1[jj] += wl[r - 1][jj] * f[jj]; a1[4 + jj] += wh[r - 1][jj] * f[4 + jj]; } } }
            float s0 = 0.f, s1 = 0.f;
#pragma unroll
            for (int jj = 0; jj < 8; ++jj) { a0[jj] = siluf(a0[jj]); a1[jj] = siluf(a1[jj]); s0 += a0[jj] * a0[jj]; s1 += a1[jj] * a1[jj]; }
            s0 += __shfl_xor(s0, 1); s1 += __shfl_xor(s1, 1); s0 += __shfl_xor(s0, 2); s1 += __shfl_xor(s1, 2); s0 += __shfl_xor(s0, 4); s1 += __shfl_xor(s1, 4);
            const float base = tens == 0 ? 0.125f : 1.0f, c0 = tens == 2 ? 1.0f : rsqrtf(s0 + 1e-6f) * base, c1 = tens == 2 ? 1.0f : rsqrtf(s1 + 1e-6f) * base;
#pragma unroll
            for (int jj = 0; jj < 8; ++jj) { a0[jj] *= c0; a1[jj] *= c1; }
            const v4u o0 = pk8(a0), o1 = pk8(a1); const int t = 2 * t2;
            if (tens == 0) { if (live) { *(GAS v4u*)(MIX + mixh(MX_AQ + h * 64 + ch * 8, tok0 + t)) = o0; *(GAS v4u*)(MIX + mixh(MX_AQ + h * 64 + ch * 8, tok0 + t + 1)) = o1; } }
            else if (tens == 1) { *(LAS v4u*)(lds + GQ_KN + t * (PT * 2) + ch * 16) = o0; *(LAS v4u*)(lds + GQ_KN + (t + 1) * (PT * 2) + ch * 16) = o1;
                if (live) { *(GAS v4u*)(MIX + mixh(MX_AK + h * 64 + ch * 8, tok0 + t)) = o0; *(GAS v4u*)(MIX + mixh(MX_AK + h * 64 + ch * 8, tok0 + t + 1)) = o1; } }
            else { *(LAS v4u*)(lds + GQ_VN + t * (PT * 2) + ch * 16) = o0; *(LAS v4u*)(lds + GQ_VN + (t + 1) * (PT * 2) + ch * 16) = o1; } }
        LBAR();
        for (int id = tw; id < 10; id += 4) { const int lb = id < 1 ? 0 : (id < 3 ? 1 : (id < 6 ? 2 : 3)), sb = id - (lb * (lb + 1)) / 2;
            pg8::f32x4 acc = (pg8::f32x4){0.f, 0.f, 0.f, 0.f};
#pragma unroll
            for (int ks = 0; ks < 2; ++ks) acc = MFMA16(ldfrag(lds + GQ_KN, 16 * lb + fr, 32 * ks + 8 * fq), ldfrag(lds + GQ_KN, 16 * sb + fr, 32 * ks + 8 * fq), acc);
            const int s = 16 * sb + fr; const float gsv = Gs[s];
#pragma unroll
            for (int r = 0; r < 4; ++r) { const int l = 16 * lb + 4 * fq + r; const float v = s < l ? Bs[l] * acc[r] * __expf(Gs[l] - gsv) : 0.f;
                if (lb == sb) AD[(lb * 16 + 4 * fq + r) * 20 + fr] = v;
                else *(LAS bf16*)(lds + GQ_NA + l * (PT * 2) + s * 2) = (bf16)f2bf(-v); } }
        LBAR();
        if (tw == 0) { const int bi = lane >> 4, cc = lane & 15; const LAS float* Ab = AD + bi * 16 * 20; float x[16];
#pragma unroll
            for (int r = 0; r < 16; ++r) { float a = (r == cc) ? 1.0f : 0.0f;
#pragma unroll
                for (int s4 = 0; s4 < r; s4 += 4) { const pg8::f32x4 av = *(const LAS pg8::f32x4*)(Ab + r * 20 + s4);
                    a -= av[0] * x[s4];
                    if (s4 + 1 < r) a -= av[1] * x[s4 + 1];
                    if (s4 + 2 < r) a -= av[2] * x[s4 + 2];
                    if (s4 + 3 < r) a -= av[3] * x[s4 + 3]; }
                x[r] = a; }
#pragma unroll
            for (int r = 0; r < 16; ++r) *(LAS bf16*)(lds + GQ_NA + (16 * bi + r) * (PT * 2) + (16 * bi + cc) * 2) = (bf16)f2bf(x[r]); }
        LBAR();
#pragma unroll 1
        for (int half = 0; half < 2; ++half) { LAS unsigned char* src = lds + (half == 0 ? GQ_VN : GQ_KN); const int c0 = 16 * tw;
            pg8::f32x4 R[4], X[4];
#pragma unroll
            for (int i = 0; i < 4; ++i) { const s16x4 raw = tr4(src + (16 * i + 4 * fq + (fr >> 2)) * (PT * 2) + (c0 + 4 * (fr & 3)) * 2);
                const pg8::f32x4 bv = *(const LAS pg8::f32x4*)(Bs + 16 * i + 4 * fq); pg8::f32x4 sc = bv;
                if (half == 1) { const pg8::f32x4 gv = *(const LAS pg8::f32x4*)(Gs + 16 * i + 4 * fq); sc = (pg8::f32x4){bv[0] * __expf(gv[0]), bv[1] * __expf(gv[1]), bv[2] * __expf(gv[2]), bv[3] * __expf(gv[3])}; }
                R[i] = (pg8::f32x4){bfs(raw[0]) * sc[0], bfs(raw[1]) * sc[1], bfs(raw[2]) * sc[2], bfs(raw[3]) * sc[3]}; }
#define NAF(ib, jb) (*(const LAS bf16x4*)(lds + GQ_NA + (16 * (ib) + fr) * (PT * 2) + (16 * (jb) + 4 * fq) * 2))
            const pg8::f32x4 Z = (pg8::f32x4){0.f, 0.f, 0.f, 0.f};
            X[0] = MFMA16K16(NAF(0, 0), pk4(R[0]), Z);
            { const bf16x4 x0 = pk4(X[0]); R[1] = MFMA16K16(NAF(1, 0), x0, R[1]); R[2] = MFMA16K16(NAF(2, 0), x0, R[2]); R[3] = MFMA16K16(NAF(3, 0), x0, R[3]); }
            X[1] = MFMA16K16(NAF(1, 1), pk4(R[1]), Z);
            { const bf16x4 x1 = pk4(X[1]); R[2] = MFMA16K16(NAF(2, 1), x1, R[2]); R[3] = MFMA16K16(NAF(3, 1), x1, R[3]); }
            X[2] = MFMA16K16(NAF(2, 2), pk4(R[2]), Z);
            { const bf16x4 x2 = pk4(X[2]); R[3] = MFMA16K16(NAF(3, 2), x2, R[3]); }
            X[3] = MFMA16K16(NAF(3, 3), pk4(R[3]), Z);
#undef NAF
#pragma unroll
            for (int i = 0; i < 4; ++i)
#pragma unroll
                for (int r = 0; r < 4; ++r) *(LAS bf16*)(lds + GQ_RAW + half * MAT + (16 * i + 4 * fq + r) * (PT * 2) + (c0 + fr) * 2) = (bf16)f2bf(X[i][r]);
        }
        LBAR();
        if (live) for (int i = j; i < 64 * 16; i += 256) { const int t = (i >> 3) & 63, ch = i & 7, half = i >> 9;
            const v4u v = *(const LAS v4u*)(lds + GQ_RAW + half * MAT + t * (PT * 2) + ch * 16);
            if (half == 0) *(GAS v4u*)(MIX + mixh(MX_AV + h * 64 + ch * 8, tok0 + t)) = v; else *(GAS v4u*)(GW + gwh(h, ch * 8, tok0 + t)) = v; }
    }
    LBAR();
}
#ifndef MK_ONE_LAUNCH
#define MK_ONE_LAUNCH 1
#endif
#define CONVERT_LAYER(L_, WB_) do { \
            int ibase = 0; \
            const float* w_in = kp->in[3] + (size_t)(L_) * DM * NIN; const float* nmix = kp->in[2] + (size_t)(L_) * DM; \
            TR_SEG(w_in, NIN, 1536, 512, DM, nmix, (bf16*)((WB_) + (W_1T - WS_W)), DM, 0, 0); \
            TR_SEG(w_in, NIN, 2064, 512, DM, nmix, (bf16*)((WB_) + (W_1T - WS_W)), DM, 512, 0); \
            TR_SEG(w_in, NIN, 4888, 512, DM, nmix, (bf16*)((WB_) + (W_1T - WS_W)), DM, 1024, 0); \
            TR_SEG(w_in, NIN, 0, 1536, DM, nmix, (bf16*)((WB_) + (W_1T - WS_W)), DM, 1536, 0); \
            TR_SEG(w_in, NIN, 2576, 768, DM, nmix, (bf16*)((WB_) + (W_1T - WS_W)), DM, 3072, 0); \
            TR_SEG(w_in, NIN, 3352, 1536, DM, nmix, (bf16*)((WB_) + (W_1T - WS_W)), DM, 3840, 0); \
            TR_SEG(w_in, NIN, 2048, 16, DM, nmix, (bf16*)((WB_) + (W_1T - WS_W)), DM, 5376, 0); \
            TR_SEG(w_in, NIN, 3344, 8, DM, nmix, (bf16*)((WB_) + (W_1T - WS_W)), DM, 5392, 0); \
            TR_SEG((const float*)nullptr, NIN, 0, 232, DM, (const float*)nullptr, (bf16*)((WB_) + (W_1T - WS_W)), DM, 5400, 0); \
            TR_SEG(w_in, NIN, 5400, 3072, DM, nmix, (bf16*)((WB_) + (W_GT - WS_W)), DM, 0, 0); \
            const float* wbr = kp->in[14] + (size_t)(L_) * 3 * 512 * DM; \
            TR_SEG(wbr, DM, 0, DM, 512, (const float*)nullptr, (bf16*)((WB_) + (W_MT - WS_W)), KMERGE, 0, 0); \
            TR_SEG(wbr + 512 * DM, DM, 0, DM, 512, kp->in[13] + (size_t)(L_) * 512, (bf16*)((WB_) + (W_MT - WS_W)), KMERGE, 0, 512); \
            TR_SEG(wbr + 2 * 512 * DM, DM, 0, DM, 512, (const float*)nullptr, (bf16*)((WB_) + (W_MT - WS_W)), KMERGE, 0, 1024); \
            TR_SEG(kp->in[15] + (size_t)(L_) * DM * DM, DM, 0, DM, DM, (const float*)nullptr, (bf16*)((WB_) + (W_OT - WS_W)), DM, 0, 0); \
            TR_SEG(kp->in[17] + (size_t)(L_) * DM * DFF, DFF, 0, DFF, DM, kp->in[16] + (size_t)(L_) * DM, (bf16*)((WB_) + (W_UT - WS_W)), DM, 0, 0); \
            TR_SEG(kp->in[18] + (size_t)(L_) * DFF * DM, DM, 0, DM, DFF, (const float*)nullptr, (bf16*)((WB_) + (W_DT - WS_W)), DFF, 0, 0); \
            TR_SEG(kp->in[20] + (size_t)(L_) * DM * DM, DM, 0, DM, DM, kp->in[19] + (size_t)(L_) * DM, (bf16*)((WB_) + (W_PGT - WS_W)), DM, 0, 0); \
            TR_SEG(kp->in[21] + (size_t)(L_) * PLED * DM, DM, 0, DM, PLED, (const float*)nullptr, (bf16*)((WB_) + (W_PPT - WS_W)), PLED, 0, 0); \
        } while (0)
__global__ void __launch_bounds__(512, 2) fwd_kernel(Args args) {
    extern __shared__ __attribute__((aligned(16))) unsigned char lds_raw[];
    LAS unsigned char* lds0 = (LAS unsigned char*)lds_raw;
    volatile LAS unsigned* MISC = (volatile LAS unsigned*)(lds0 + MISC_OFF);
    const int G = gridDim.x, NGW = G * 8;
    unsigned char* ws0 = args.ws;
    for (int u = threadIdx.x; u < (LDS_BYTES - RING_BYTES) / 4; u += 512) ((LAS unsigned*)(lds0 + RING_BYTES))[u] = 0u;
    __syncthreads();
#if MK_ONE_LAUNCH
    XcdBarrier bar = xcd_barrier_post((unsigned*)(ws0 + WS_CTL) + 4096, MISC + 8);
#define GRID_BAR() do { XcdBarrier b_ = bar; asm volatile("" : "+s"(b_.bar), "+s"(b_.x)); xcd_barrier(b_); } while (0)
#else
#define GRID_BAR() do {} while (0)
#endif
    const int lo = args.ph_lo, hi = args.ph_hi;
#define IN(p) (lo <= (p) && (p) < hi)
#define SEAM(p) do { if (IN(p) && IN((p) + 1)) GRID_BAR(); } while (0)
    typedef const __attribute__((address_space(4))) Args* KArgs;
    const KArgs kp0 = (KArgs)__builtin_amdgcn_kernarg_segment_ptr();
#define PHASE_PTRS() KArgs kp = kp0; asm volatile("" : "+s"(kp)); unsigned char* ws = kp->ws; float* X = kp->out; (void)X; \
    LAS unsigned char* lds = lds0; \
    int tid = threadIdx.x; asm volatile("" : "+v"(tid)); int bx = blockIdx.x; asm volatile("" : "+s"(bx)); const int lane = tid & 63, wave = __builtin_amdgcn_readfirstlane(tid >> 6), gw = bx * 8 + wave; (void)lane; (void)gw; \
    bf16* ZB = (bf16*)(ws + WS_ZB); bf16* MIX = (bf16*)(ws + WS_MIX); float* SM = (float*)(ws + WS_SM); (void)ZB; (void)MIX; (void)SM; \
    unsigned char* wbase = (layer & 1) ? (unsigned char*)X + 80 * MiB : ws + WS_W;     \
    float* SSQA = (float*)(wbase + (WS_SSQA - WS_W)); float* SSQB = (float*)(wbase + (WS_SSQB - WS_W)); float* SSQC = (float*)(ws + WS_SSQC); float* ROPE = (float*)(ws + WS_ROPE); (void)SSQA; (void)SSQB; (void)SSQC; (void)ROPE; \
    bf16* W1T = (bf16*)(wbase + (W_1T - WS_W)); bf16* WGT = (bf16*)(wbase + (W_GT - WS_W)); bf16* WMT = (bf16*)(wbase + (W_MT - WS_W)); bf16* WOT = (bf16*)(wbase + (W_OT - WS_W)); bf16* WUT = (bf16*)(wbase + (W_UT - WS_W)); (void)W1T; (void)WGT; (void)WMT; (void)WOT; (void)WUT; \
    bf16* WDT = (bf16*)(wbase + (W_DT - WS_W)); bf16* WPGT = (bf16*)(wbase + (W_PGT - WS_W)); bf16* WPPT = (bf16*)(wbase + (W_PPT - WS_W)); (void)WDT; (void)WPGT; (void)WPPT; \
    bf16* GATE = (bf16*)(ws + WS_GATE); bf16* U = (bf16*)(ws + WS_U); bf16* PB = (bf16*)X; bf16* PLE = (bf16*)X + (size_t)MTOK * PLED;     (void)GATE; (void)U; (void)PB; (void)PLE; \
    bf16* XBl = (bf16*)(ws + ((layer & 1) ? WS_XB1 : WS_XB0)); bf16* XBf = (bf16*)(ws + ((layer & 1) ? WS_XB0 : WS_XB1)); (void)XBl; (void)XBf
    if (IN(0)) { const int layer = 0; PHASE_PTRS();
        for (int e = bx * 512 + tid; e < SEQ * 32; e += G * 512) { const int t = e >> 5, i = e & 31;
            double f = 1.0; for (int j = 0; j < i; ++j) f *= 0.7429639507594948;
            const double ang = (double)t * f, kk = rint(ang * 0.15915494309189535);
            double r = fma(-kk, 6.283185307179586, ang); r = fma(-kk, 2.4492935982947064e-16, r); const double r2 = r * r;
            double sn = 1.0, cs = 1.0;
    #pragma unroll
            for (int n = 15; n >= 1; --n) { sn = 1.0 - r2 * (1.0 / (double)((2 * n) * (2 * n + 1))) * sn; cs = 1.0 - r2 * (1.0 / (double)((2 * n - 1) * (2 * n))) * cs; }
            ROPE[e] = (float)cs; ROPE[SEQ * 32 + e] = (float)(r * sn); }
    }
    for (int layer = 0; layer < DEPTH; ++layer) {
        const int P = layer * NPH;
        if (IN(P + 0)) { PHASE_PTRS();
            if (layer == 0 || G <= 192) CONVERT_LAYER(layer, wbase);
            if (layer == 0) {
                const float* xin = kp->in[0];
                for (int m = gw; m < MTOK; m += NGW) {
                    const GAS f32x4* xr = (const GAS f32x4*)(xin + (size_t)m * DM) + lane; f32x4 v[4]; float s = 0.f;
#pragma unroll
                    for (int j = 0; j < 4; ++j) { v[j] = xr[64 * j]; s += (v[j].x * v[j].x + v[j].y * v[j].y) + (v[j].z * v[j].z + v[j].w * v[j].w); }
                    s = wave_sum(s);
                    GAS v2u* o8 = (GAS v2u*)(XBl + (size_t)m * DM) + lane;
#pragma unroll
                    for (int j = 0; j < 4; ++j) { v2u w; w.x = pk2(v[j].x, v[j].y); w.y = pk2(v[j].z, v[j].w); o8[64 * j] = w; }
                    if (lane < 16) SSQC[(size_t)m * 16 + lane] = lane == 0 ? s : 0.f;
                }
            }
        }
        if (layer == 0 || G <= 192) SEAM(P + 0);
        if (IN(P + 1)) { PHASE_PTRS();
            pg8::Gemm g{XBl, W1T, MTOK, N1, DM}; pg8::StaticOrder S; S.init(MTOK, N1, G, bx);
            build_rs_table(S, SSQC, lds, tid);
            pg8::EpiP1 E{ZB, MIX, SM, lds + RS_OFF, (bf16*)((unsigned char*)XBf + HALO_OFF),  0u};
            pg8::gemm_phase<pg8::EpiP1, pg8::StaticOrder, true, true>(lds, g, S, E);
        }
        SEAM(P + 1);
        if (IN(P + 2)) { PHASE_PTRS();
            gdn_prep(kp, layer, lds, G);
            ssd_prep(kp, layer, lds, G);
            ret_prep(kp, G);
            const float* pl = kp->in[1] + (size_t)layer * MTOK * PLED;
            for (size_t e = (size_t)bx * 512 + tid; e < (size_t)MTOK * PLED / 4; e += (size_t)G * 512) { const f32x4 v = ((const GAS f32x4*)pl)[e]; v2u w; w.x = pk2(v.x, v.y); w.y = pk2(v.z, v.w); ((GAS v2u*)PB)[e] = w; }
        }
        SEAM(P + 2);
        if (IN(P + 3)) { PHASE_PTRS();
            for (int w = bx; w < 192; w += G) { const int kind = w >> 6, b = (w & 63) >> 3, h = w & 7;
                if (kind == 0) mixer_walk<0>(kp, layer, b, h, lds);
                else if (kind == 1) mixer_walk<1>(kp, layer, b, h, lds);
                else mixer_walk<2>(kp, layer, b, h, lds);
                __syncthreads(); }
            if (layer == 0 && bx >= 192 && G > 192) {
                const int bx_ = bx, G_ = G; { const int bx = bx_ - 192, G = G_ - 192; CONVERT_LAYER(1, (unsigned char*)X + 80 * MiB); }
            } else if ((bx >= 192 || G <= 192) && !(layer == 0 && G > 192)) {
                pg8::Gemm g{PB, WPPT, MTOK / 2, DM, PLED}; pg8::StaticOrder S; if (G > 192) S.init(MTOK / 2, DM, G - 192, bx - 192); else S.init(MTOK / 2, DM, G, bx);
                pg8::EpiRS<0> E{PLE, DM, (LAS unsigned char*)nullptr};
                pg8::gemm_phase<pg8::EpiRS<0>, pg8::StaticOrder, true, true>(lds, g, S, E); }
        }
        SEAM(P + 3);
        if (IN(P + 4)) { PHASE_PTRS();
            for (int m = gw; m < MTOK; m += NGW) {
                GAS v4u* yp = (GAS v4u*)(ZB + (size_t)m * ZB_LD + 512) + lane; const v4u w = *yp;
                const f32x4 sq = *(const f32x4*)(SM + (size_t)m * SM_LD + 16 + 4 * (lane >> 5));
                const float rstd = rsqrtf(((sq[0] + sq[1]) + (sq[2] + sq[3])) * (1.0f / 256.0f) + 1e-6f);
                v4u o; o.x = pk2(pg8::bflo(w.x) * rstd, pg8::bfhi(w.x) * rstd); o.y = pk2(pg8::bflo(w.y) * rstd, pg8::bfhi(w.y) * rstd);
                o.z = pk2(pg8::bflo(w.z) * rstd, pg8::bfhi(w.z) * rstd); o.w = pk2(pg8::bflo(w.w) * rstd, pg8::bfhi(w.w) * rstd);
                *yp = o;
            }
            pg8::Gemm g{XBl, WGT, MTOK, NGATE, DM}; pg8::StaticOrder S; S.init(MTOK, NGATE, G, bx);
            build_rs_table(S, SSQC, lds, tid);
            pg8::EpiRS<2> E{GATE, NGATE, lds + RS_OFF};
            pg8::gemm_phase<pg8::EpiRS<2>, pg8::StaticOrder, true, true>(lds, g, S, E);
        }
        SEAM(P + 4);
        if (IN(P + 5)) { PHASE_PTRS();
            pg8::Gemm g{ZB, WMT, MTOK, DM, KMERGE}; pg8::StaticOrder S; S.init(MTOK, DM, G, bx);
            pg8::EpiMerge E{GATE, XBf};
            pg8::gemm_phase<pg8::EpiMerge, pg8::StaticOrder, true, true>(lds, g, S, E);
        }
        SEAM(P + 5);
        if (IN(P + 6)) { PHASE_PTRS();
            pg8::Gemm g{XBf, WOT, MTOK, DM, DM}; pg8::StaticOrder S; S.init(MTOK, DM, G, bx);
            pg8::EpiResid<0> E{XBl, XBl, SSQA, (LAS unsigned char*)nullptr, nullptr,  1.0f};
            pg8::gemm_phase<pg8::EpiResid<0>, pg8::StaticOrder, true, true>(lds, g, S, E);
        }
        SEAM(P + 6);
        if (IN(P + 7)) { PHASE_PTRS();
            { pg8::Gemm g{XBl, WUT, MTOK, DFF, DM}; pg8::StaticOrder S; S.init(MTOK, DFF, G, bx);
              build_rs_table(S, SSQA, lds, tid);
              pg8::EpiRS<1> E{U, DFF, lds + RS_OFF};
              pg8::gemm_phase<pg8::EpiRS<1>, pg8::StaticOrder, true, true>(lds, g, S, E); }
        }
        SEAM(P + 7);
        if (IN(P + 8)) { PHASE_PTRS();
            pg8::Gemm g{U, WDT, MTOK, DM, DFF}; pg8::StaticOrder S; S.init(MTOK, DM, G, bx);
            pg8::EpiResid<0> E{XBl, XBl, SSQB, (LAS unsigned char*)nullptr, nullptr,  1.0f};
            pg8::gemm_phase<pg8::EpiResid<0>, pg8::StaticOrder, true, true>(lds, g, S, E);
            __builtin_amdgcn_sched_barrier(0);
            { const int r0 = (layer == 0 && G > 192) ? 0 : MTOK / 2;
              pg8::Gemm g2{PB + (size_t)r0 * PLED, WPPT, MTOK - r0, DM, PLED}; pg8::StaticOrder S2; S2.init(MTOK - r0, DM, G, bx);
              pg8::EpiRS<0> E2{PLE + (size_t)r0 * DM, DM, (LAS unsigned char*)nullptr};
              pg8::gemm_phase<pg8::EpiRS<0>, pg8::StaticOrder, true, true>(lds, g2, S2, E2); }
        }
        SEAM(P + 8);
        if (IN(P + 9)) { PHASE_PTRS();
            pg8::Gemm g{XBl, WPGT, MTOK, DM, DM}; pg8::StaticOrder S; S.init(MTOK, DM, G, bx);
            build_rs_table(S, SSQB, lds, tid);
            pg8::EpiResid<1> E{XBl, XBf, SSQC, lds + RS_OFF, PLE,  1.0f};
            pg8::gemm_phase<pg8::EpiResid<1>, pg8::StaticOrder, true, true>(lds, g, S, E);
        }
        SEAM(P + 9);
    }
    if (IN(PH_FINAL)) { const int layer = DEPTH; PHASE_PTRS();
        const float* nf = kp->in[22];
        for (int m = gw; m < MTOK; m += NGW) {
            const float sp = lane < 16 ? SSQC[(size_t)m * 16 + lane] : 0.f;
            const float rstd = rsqrtf(wave_sum(sp) * (1.0f / 1024.0f) + 1e-6f);
            const GAS v4u* xr = (const GAS v4u*)(XBl + (size_t)m * DM) + lane; GAS f32x4* orow = (GAS f32x4*)(X + (size_t)m * DM);
#pragma unroll
            for (int j = 0; j < 2; ++j) { const v4u w = xr[64 * j]; const int c8 = (64 * j + lane) * 2; const f32x4 g0 = ((const GAS f32x4*)nf)[c8], g1 = ((const GAS f32x4*)nf)[c8 + 1];
                f32x4 o0, o1; o0[0] = pg8::bflo(w.x); o0[1] = pg8::bfhi(w.x); o0[2] = pg8::bflo(w.y); o0[3] = pg8::bfhi(w.y); o1[0] = pg8::bflo(w.z); o1[1] = pg8::bfhi(w.z); o1[2] = pg8::bflo(w.w); o1[3] = pg8::bfhi(w.w);
                orow[c8] = o0 * rstd * g0; orow[c8 + 1] = o1 * rstd * g1; }
        }
    }
#undef IN
#undef SEAM
}

extern "C" void kernel_launch(void* const* d_in, const int* in_sizes, int n_in, void* d_out, int out_size, void* d_ws, size_t ws_size, hipStream_t stream) {
    static int grid = 0;
    if (grid == 0) {
        if (n_in != 23 || out_size != MTOK * DM || ws_size < WS_END) { fprintf(stderr, "kernel_launch: unexpected problem (n_in %d, out %d, ws %zu < %zu)\n", n_in, out_size, ws_size, (size_t)WS_END); grid = -1; return; }
        int dev = 0, cus = 0;
        if (hipGetDevice(&dev) != hipSuccess || hipDeviceGetAttribute(&cus, hipDeviceAttributeMultiprocessorCount, dev) != hipSuccess) { grid = -1; return; }
        if (hipFuncSetAttribute((const void*)fwd_kernel, hipFuncAttributeMaxDynamicSharedMemorySize, LDS_BYTES) != hipSuccess) { fprintf(stderr, "kernel_launch: hipFuncSetAttribute failed\n"); grid = -1; return; }
        int per_cu = 0;
        if (hipOccupancyMaxActiveBlocksPerMultiprocessor(&per_cu, (const void*)fwd_kernel, 512, LDS_BYTES) != hipSuccess || per_cu < 1) { fprintf(stderr, "kernel_launch: occupancy query says %d blocks per CU\n", per_cu); }
        (void)hipGetLastError();
        grid = cus;
    }
    if (grid < 0) return;
    (void)hipMemsetAsync((char*)d_ws + WS_CTL, 0, CTL_BYTES, stream);
    Args a; memset(&a, 0, sizeof(a));
    for (int i = 0; i < 23; ++i) a.in[i] = (const float*)d_in[i];
    a.out = (float*)d_out; a.ws = (unsigned char*)d_ws;
#if MK_ONE_LAUNCH
    a.ph_lo = 0; a.ph_hi = N_PHASES;
    hipLaunchKernelGGL(fwd_kernel, dim3(grid), dim3(512), LDS_BYTES, stream, a);
#else
    for (int p = 0; p < N_PHASES; ++p) {
        a.ph_lo = p; a.ph_hi = p + 1;
        hipLaunchKernelGGL(fwd_kernel, dim3(grid), dim3(512), LDS_BYTES, stream, a);
    }
#endif
}
```

```cpp
#include <hip/hip_runtime.h>
#include <cstdio>
#include <cstdint>
#include <cstring>
__host__ __device__ __forceinline__ size_t mixh(int col, size_t m) {
    const size_t b = m >> 12, t = m & 4095;
    if (col < 2048) { const int ten = col >> 9, h = (col >> 6) & 7; return (size_t)ten * (16u << 20) + (((b * 8 + h) << 12) + t) * 64 + (col & 63); }
    if (col < 2304) { const int c2 = col - 2048, tb = c2 >> 7, g = (c2 >> 6) & 1; return (size_t)4 * (16u << 20) + (size_t)tb * (4u << 20) + (((b * 2 + g) << 12) + t) * 64 + (col & 63); }
    const int c2 = col - 2304, ten = c2 >> 9, h = (c2 >> 6) & 7; return (size_t)4 * (16u << 20) + (8u << 20) + (size_t)ten * (16u << 20) + (((b * 8 + h) << 12) + t) * 64 + (col & 63);
}
__host__ __device__ __forceinline__ size_t gwh(int h, int c, size_t m) { return ((((m >> 12) * 8 + h) << 12) + (m & 4095)) * 64 + c; }
namespace pg8 {
#define PG8_LAS __attribute__((address_space(3)))
typedef unsigned short bf16_t;
typedef short bf16x8 __attribute__((ext_vector_type(8)));
typedef float f32x4 __attribute__((ext_vector_type(4)));
typedef unsigned u32x4 __attribute__((ext_vector_type(4)));
constexpr int BM = 256, BK = 64, HALF = 128, HTB = HALF * BK * 2  , STAGE_BYTES = 8 * HTB, NXCD = 8, WGM = 8;

__host__ __device__ __forceinline__ int lds_byte(int r, int c) { const int st = (r >> 4) * 2 + (c >> 5), rr = r & 15, cc = c & 31, ob = rr * 64 + cc * 2; return st * 1024 + (ob ^ (((ob >> 9) & 1) << 5)); }
__host__ __device__ __forceinline__ void stage_rc(int b, int& R, int& C) { const int st = b / 1024, sb = b % 1024, swz = sb ^ (((sb >> 9) & 1) << 5); R = (st >> 1) * 16 + swz / 64; C = (st & 1) * 32 + (swz % 64) / 2; }
__host__ __device__ __forceinline__ int perm32(int rho) { const int n = rho >> 4, i = rho & 15; return 8 * (i >> 2) + 4 * n + (i & 3); }

struct Unit { int pm, pn; };
struct Gemm { const bf16_t* A; const bf16_t* Bt; int M, N, K; };

struct StaticOrder {
    int nM, nN, nwg, G, c;
    __host__ __device__ void init(int M, int N, int G_, int c_) { nM = M / BM; nN = N / BM; nwg = nM * nN; G = G_; c = c_; }
    __host__ __device__ bool next(int i, Unit& u) const {
        const long L = (long)i * G + c; if (L >= nwg) return false;
        int wgid = (int)L; { const int q = nwg / NXCD, r = nwg % NXCD, xcd = wgid % NXCD, off = wgid / NXCD; wgid = (xcd < r ? xcd * (q + 1) : r * (q + 1) + (xcd - r) * q) + off; }
        const int nig = WGM * nN, gid = wgid / nig, fm = gid * WGM, gsz = (nM - fm) < WGM ? (nM - fm) : WGM;
        u.pm = fm + ((wgid % nig) % gsz); u.pn = (wgid % nig) / gsz; return true;
    }
    __device__ __forceinline__ void a_ready(const Unit&) const {}
    __device__ __forceinline__ void done(const Unit&) const {}
};

typedef float f32x2c __attribute__((ext_vector_type(2))); typedef __bf16 bf16x2c __attribute__((ext_vector_type(2)));
__device__ __forceinline__ unsigned cvt_pk_bf16(float lo, float hi) { const f32x2c v = {lo, hi}; const bf16x2c b = __builtin_convertvector(v, bf16x2c); return __builtin_bit_cast(unsigned, b); }
typedef unsigned u32x2 __attribute__((ext_vector_type(2)));
__device__ __forceinline__ float bflo(unsigned w) { return __uint_as_float(w << 16); }
__device__ __forceinline__ float bfhi(unsigned w) { return __uint_as_float(w & 0xffff0000u); }
__device__ __forceinline__ u32x4 pack8(const f32x4 v0, const f32x4 v1) { u32x4 w; w.x = cvt_pk_bf16(v0[0], v0[1]); w.y = cvt_pk_bf16(v0[2], v0[3]); w.z = cvt_pk_bf16(v1[0], v1[1]); w.w = cvt_pk_bf16(v1[2], v1[3]); return w; }
__device__ __forceinline__ void unpack8(const u32x4 w, f32x4& v0, f32x4& v1) { v0 = (f32x4){bflo(w.x), bfhi(w.x), bflo(w.y), bfhi(w.y)}; v1 = (f32x4){bflo(w.z), bfhi(w.z), bflo(w.w), bfhi(w.w)}; }
constexpr float RMS_EPS = 1e-6f;
constexpr int RS_SLOTS = 8;
__device__ __forceinline__ void load_rstd(const PG8_LAS unsigned char* rst, int pm, int wr, int fr, float (&rs)[2][4]) {
    if (rst == nullptr) {
#pragma unroll
        for (int ai = 0; ai < 2; ++ai)
#pragma unroll
            for (int m = 0; m < 4; ++m) rs[ai][m] = 1.0f;
        return; }
    const PG8_LAS int* pml = (const PG8_LAS int*)rst; int slot = 0;
#pragma unroll
    for (int k = 1; k < RS_SLOTS; ++k) slot = pml[k] == pm ? k : slot;
    const PG8_LAS float* tab = (const PG8_LAS float*)(rst + 32) + slot * 256 + wr * 64 + fr;
#pragma unroll
    for (int ai = 0; ai < 2; ++ai)
#pragma unroll
        for (int m = 0; m < 4; ++m) rs[ai][m] = tab[ai * HALF + m * 16];
}
struct EpiP1 {
    static constexpr bool PERM = true, AFTER_DRAIN = false, HOOK = false; static constexpr int SEG1 = -1, SEG2 = -1;
    bf16_t* ZB; bf16_t* MIX; float* SM; const PG8_LAS unsigned char* rst; bf16_t* HALO; unsigned nost;
    __device__ __forceinline__ void rescale(f32x4 (&)[2][2][4][2], const Unit&, int, int, int, int, int) const {}
    __device__ __forceinline__ void operator()(const f32x4 (&acc)[2][2][4][2], const Unit& u, int wr, int wc, int fr, int fq) const {
        const int row0 = u.pm * BM + wr * 64 + fr;
        float rs[2][4]; load_rstd(rst, u.pm, wr, fr, rs);
        if (u.pn == 21) {
            if (wc == 0) {
#pragma unroll
                for (int ai = 0; ai < 2; ++ai)
#pragma unroll
                    for (int m = 0; m < 4; ++m) { float* p = SM + (size_t)(row0 + ai * HALF + m * 16) * 32 + 8 * fq;
                        *(f32x4*)p = acc[ai][0][m][0] * rs[ai][m]; *(f32x4*)(p + 4) = acc[ai][0][m][1] * rs[ai][m]; }
            }
            return;
        }
        const bool mixt = u.pn >= 6;
        const int colt = mixt ? (u.pn - 6) * BM : u.pn * BM, col0 = colt + wc * 32 + 8 * fq;
#pragma unroll
        for (int ai = 0; ai < 2; ++ai)
#pragma unroll
            for (int m = 0; m < 4; ++m) { const size_t row = (size_t)(row0 + ai * HALF + m * 16);
#pragma unroll
                for (int bj = 0; bj < 2; ++bj) { const u32x4 w = pack8(acc[ai][bj][m][0] * rs[ai][m], acc[ai][bj][m][1] * rs[ai][m]);
                    if (nost == 0u || (w.x ^ w.y ^ w.z) == nost) *(u32x4*)(mixt ? MIX + mixh(col0 + bj * HALF, row) : ZB + row * 1536 + col0 + bj * HALF) = w;
                    if (m == 3 && fr >= 13 && u.pn >= 6 && u.pn < 15) *(u32x4*)(HALO + ((size_t)((row0 + ai * HALF + m * 16) >> 6) * 3 + (fr - 13)) * 2304 + col0 + bj * HALF) = w; } }
    }
};
template <int ACT> struct EpiRS {
    static constexpr bool PERM = true, AFTER_DRAIN = false, HOOK = false; static constexpr int SEG1 = -1, SEG2 = -1;
    bf16_t* O; int ldc; const PG8_LAS unsigned char* rst;
    __device__ __forceinline__ void rescale(f32x4 (&)[2][2][4][2], const Unit&, int, int, int, int, int) const {}
    __device__ __forceinline__ void operator()(const f32x4 (&acc)[2][2][4][2], const Unit& u, int wr, int wc, int fr, int fq) const {
        const int row0 = u.pm * BM + wr * 64 + fr, col0 = u.pn * BM + wc * 32 + 8 * fq;
        float rs[2][4]; load_rstd(rst, u.pm, wr, fr, rs);
#pragma unroll
        for (int ai = 0; ai < 2; ++ai)
#pragma unroll
            for (int m = 0; m < 4; ++m) { bf16_t* rowp = O + (size_t)(row0 + ai * HALF + m * 16) * ldc + col0;
#pragma unroll
                for (int bj = 0; bj < 2; ++bj) { f32x4 v0 = acc[ai][bj][m][0] * rs[ai][m], v1 = acc[ai][bj][m][1] * rs[ai][m];
                    if (ACT == 1) {
#pragma unroll
                        for (int j = 0; j < 4; ++j) { const float a = fmaxf(v0[j], 0.f), b = fmaxf(v1[j], 0.f); v0[j] = a * a; v1[j] = b * b; } }
                    if (ACT == 2) {
#pragma unroll
                        for (int j = 0; j < 4; ++j) { v0[j] = 1.0f + __expf(-v0[j]); v1[j] = 1.0f + __expf(-v1[j]); } }
                    *(u32x4*)(rowp + bj * HALF) = pack8(v0, v1); } }
    }
};
struct EpiMerge {
    static constexpr bool PERM = true, AFTER_DRAIN = false, HOOK = true; static constexpr int SEG1 = 8, SEG2 = 16, SEG3 = 12;
    const bf16_t* GATE; bf16_t* O; const float* SM;
    __device__ __forceinline__ void rowscale(f32x4 (&acc)[2][2][4][2], const Unit& u, int wr) const {
        int t_ = threadIdx.x; asm volatile("" : "+v"(t_)); const int fr = t_ & 15;
        const float* sp = SM + (size_t)(u.pm * BM + wr * 64 + fr) * 32 + 25;
#pragma unroll
        for (int ai = 0; ai < 2; ++ai)
#pragma unroll
            for (int m = 0; m < 4; ++m) { float f = sp[(size_t)(ai * HALF + m * 16) * 32]; asm volatile("" : "+v"(f));
#pragma unroll
                for (int bj = 0; bj < 2; ++bj) { acc[ai][bj][m][0] *= f; acc[ai][bj][m][1] *= f; } }
    }
    __device__ __forceinline__ void rescale(f32x4 (&acc)[2][2][4][2], const Unit& u, int seg, int wr, int wc, int, int) const {
        int t_ = threadIdx.x; asm volatile("" : "+v"(t_)); const int fr = t_ & 15, fq = (t_ & 63) >> 4;
        const int row0 = u.pm * BM + wr * 64 + fr;
        const int col0 = u.pn * BM + wc * 32 + 8 * fq + (seg - 1) * 1024, dofs = 1024, rcol = seg == 1 ? 24 : 26;
#pragma unroll
        for (int ai = 0; ai < 2; ++ai)
#pragma unroll
            for (int m = 0; m < 4; ++m) { const bf16_t* gp = GATE + (size_t)(row0 + ai * HALF + m * 16) * 3072 + col0;
                const float rf = SM[(size_t)(row0 + ai * HALF + m * 16) * 32 + rcol];
#pragma unroll
                for (int bj = 0; bj < 2; ++bj) { const u32x4 wa = *(const u32x4*)(gp + bj * HALF), wb = *(const u32x4*)(gp + bj * HALF + dofs);
                    f32x4 a0, a1, b0, b1; unpack8(wa, a0, a1); unpack8(wb, b0, b1);
#pragma unroll
                    for (int j = 0; j < 4; ++j) {
                        acc[ai][bj][m][0][j] *= (b0[j] * rf) * __builtin_amdgcn_rcpf(a0[j]);
                        acc[ai][bj][m][1][j] *= (b1[j] * rf) * __builtin_amdgcn_rcpf(a1[j]); } }
                if (m == 3) asm volatile("" ::: "memory"); }
    }
    __device__ __forceinline__ void operator()(const f32x4 (&acc)[2][2][4][2], const Unit& u, int wr, int wc, int fr, int fq) const {
        const int row0 = u.pm * BM + wr * 64 + fr, col0 = u.pn * BM + wc * 32 + 8 * fq;
#pragma unroll
        for (int ai = 0; ai < 2; ++ai)
#pragma unroll
            for (int m = 0; m < 4; ++m) { const size_t r = (size_t)(row0 + ai * HALF + m * 16);
#pragma unroll
                for (int bj = 0; bj < 2; ++bj) { const u32x4 wa = *(const u32x4*)(GATE + r * 3072 + 2048 + col0 + bj * HALF);
                    f32x4 a0, a1; unpack8(wa, a0, a1); f32x4 v0 = acc[ai][bj][m][0], v1 = acc[ai][bj][m][1];
#pragma unroll
                    for (int j = 0; j < 4; ++j) { v0[j] *= __builtin_amdgcn_rcpf(a0[j]); v1[j] *= __builtin_amdgcn_rcpf(a1[j]); }
                    *(u32x4*)(O + r * 1024 + col0 + bj * HALF) = pack8(v0, v1); }
                if (m == 3) asm volatile("" ::: "memory"); }
    }
};
template <int MODE> struct EpiResid {
    static constexpr bool PERM = true, AFTER_DRAIN = false, HOOK = false; static constexpr int SEG1 = -1, SEG2 = -1;
    const bf16_t* XBin; bf16_t* XBout; float* ssq_out; const PG8_LAS unsigned char* rst; const bf16_t* PLE; float scale;
    __device__ __forceinline__ void rescale(f32x4 (&)[2][2][4][2], const Unit&, int, int, int, int, int) const {}
    __device__ __forceinline__ void operator()(const f32x4 (&acc)[2][2][4][2], const Unit& u, int wr, int wc, int fr, int fq) const {
        const int row0 = u.pm * BM + wr * 64 + fr, col0 = u.pn * BM + wc * 32 + 8 * fq;
        float rs[2][4]; if (MODE == 1) load_rstd(rst, u.pm, wr, fr, rs);
#pragma unroll
        for (int ai = 0; ai < 2; ++ai)
#pragma unroll
            for (int m = 0; m < 4; ++m) { const size_t r = (size_t)(row0 + ai * HALF + m * 16); float ss = 0.f;
#pragma unroll
                for (int bj = 0; bj < 2; ++bj) { const size_t o = r * 1024 + col0 + bj * HALF;
                    f32x4 v0 = acc[ai][bj][m][0], v1 = acc[ai][bj][m][1], b0, b1; unpack8(*(const u32x4*)(XBin + o), b0, b1);
                    if (MODE == 1) { const u32x4 wp = *(const u32x4*)(PLE + o); f32x4 p0, p1; unpack8(wp, p0, p1);
#pragma unroll
                        for (int j = 0; j < 4; ++j) { v0[j] = p0[j] * __builtin_amdgcn_rcpf(1.0f + __expf(-v0[j] * rs[ai][m])); v1[j] = p1[j] * __builtin_amdgcn_rcpf(1.0f + __expf(-v1[j] * rs[ai][m])); } }
                    v0 = v0 * scale + b0; v1 = v1 * scale + b1;
                    *(u32x4*)(XBout + o) = pack8(v0, v1);
                    ss += (v0[0] * v0[0] + v0[1] * v0[1]) + (v0[2] * v0[2] + v0[3] * v0[3]) + (v1[0] * v1[0] + v1[1] * v1[1]) + (v1[2] * v1[2] + v1[3] * v1[3]); }
                ss += __shfl_xor(ss, 16); ss += __shfl_xor(ss, 32);
                if (fq == 0) ssq_out[r * 16 + u.pn * 4 + wc] = ss;
                if (m == 3) asm volatile("" ::: "memory"); }
    }
};
template <class Epi, class Sched, bool ALIGN_EPI = false, bool SP2 = false, int PROBE = 0>
__device__ __forceinline__ void gemm_phase(PG8_LAS unsigned char* lds, Gemm g, const Sched& S, const Epi& E) {
    asm volatile("" : "+s"(g.A), "+s"(g.Bt), "+s"(g.K));
    int tid_ = threadIdx.x; asm volatile("" : "+v"(tid_));
    const int tid = tid_, wid = __builtin_amdgcn_readfirstlane(tid >> 6), lane = tid & 63, wr = wid >> 2, wc = wid & 3, fr = lane & 15, fq = lane >> 4;
    const int K = g.K, nt = K / BK;
    unsigned voffA[2], voffB[2];
#pragma unroll
    for (int i = 0; i < 2; ++i) { int R, C; stage_rc(tid * 16 + i * 8192, R, C); const int Rb = Epi::PERM ? ((R & ~31) + perm32(R & 31)) : R;
        voffA[i] = (unsigned)(R * K + C) * 2u; voffB[i] = (unsigned)(Rb * K + C) * 2u; }
    const size_t kstep = (size_t)(BK * 2);
    const size_t hstep = (size_t)HALF * K * 2;
    const size_t tstep = 2 * hstep;
    const unsigned ldsw = (unsigned)wid * 1024u;
    const int aoff = lds_byte(wr * 64 + fr, fq * 8), boff = lds_byte(wc * 32 + fr, fq * 8);
#define PG8_SA(b, h) (((b) * 2 + (h)) * HTB)
#define PG8_SB(b, h) ((4 + (b) * 2 + (h)) * HTB)
#define PG8_STAGE(bufoff, gbase, voff) do { if constexpr (!(PROBE & 4)) _Pragma("unroll") for (int _i = 0; _i < 2; ++_i) \
        __builtin_amdgcn_global_load_lds((const unsigned*)((const char*)(gbase) + (voff)[_i]), (PG8_LAS unsigned*)(lds + (bufoff) + ldsw + _i * 8192), 16, 0, 0); } while (0)
#define PG8_LDA(dst, b, h) do { _Pragma("unroll") for (int m = 0; m < 4; ++m) _Pragma("unroll") for (int k = 0; k < 2; ++k) dst[m][k] = *(const PG8_LAS bf16x8*)(lds + PG8_SA(b, h) + aoff + m * 2048 + k * 1024); } while (0)
#define PG8_LDB(dst, b, h) do { _Pragma("unroll") for (int n = 0; n < 2; ++n) _Pragma("unroll") for (int k = 0; k < 2; ++k) dst[n][k] = *(const PG8_LAS bf16x8*)(lds + PG8_SB(b, h) + boff + n * 2048 + k * 1024); } while (0)
#define PG8_MMA(ai, bj, At, Bt) do { __builtin_amdgcn_s_setprio(1); if constexpr (!(PROBE & 2)) _Pragma("unroll") for (int m = 0; m < 4; ++m) _Pragma("unroll") for (int n = 0; n < 2; ++n) _Pragma("unroll") for (int k = 0; k < 2; ++k) \
        acc[ai][bj][m][n] = __builtin_amdgcn_mfma_f32_16x16x32_bf16(Bt[n][k], At[m][k], acc[ai][bj][m][n], 0, 0, 0); __builtin_amdgcn_s_setprio(0); } while (0)
#define PG8_WAIT_V(n) asm volatile("s_waitcnt vmcnt(" #n ")" ::: "memory")
#define PG8_WAIT_L(n) asm volatile("s_waitcnt lgkmcnt(" #n ")" ::: "memory")
#define PG8_BAR __builtin_amdgcn_s_barrier()
#define PG8_SCHED __builtin_amdgcn_sched_barrier(0)
    Unit cur, nxt; int ui = 0;
    if (!S.next(0, cur)) return;
    f32x4 acc[2][2][4][2];
#pragma unroll
    for (int a = 0; a < 2; ++a)
#pragma unroll
        for (int b = 0; b < 2; ++b)
#pragma unroll
            for (int m = 0; m < 4; ++m)
#pragma unroll
                for (int n = 0; n < 2; ++n) acc[a][b][m][n] = (f32x4){0.f, 0.f, 0.f, 0.f};
    bf16x8 At[4][2], B0[2][2], B1[2][2];
    const char* cA = (const char*)g.A + (size_t)cur.pm * tstep; const char* cB = (const char*)g.Bt + (size_t)cur.pn * tstep;
    S.a_ready(cur);
    if constexpr (SP2) {
        PG8_STAGE(PG8_SB(0, 0), cB, voffB); PG8_STAGE(PG8_SB(0, 1), cB + hstep, voffB); PG8_STAGE(PG8_SA(0, 0), cA, voffA); PG8_STAGE(PG8_SA(0, 1), cA + hstep, voffA);
        if (wr == 1) PG8_BAR;
        PG8_WAIT_V(2); PG8_BAR;
        PG8_STAGE(PG8_SB(1, 0), cB + kstep, voffB); PG8_STAGE(PG8_SA(1, 0), cA + kstep, voffA); PG8_STAGE(PG8_SB(1, 1), cB + hstep + kstep, voffB);
        PG8_WAIT_V(6); PG8_BAR;
    } else {
        PG8_STAGE(PG8_SB(0, 0), cB, voffB); PG8_STAGE(PG8_SA(0, 0), cA, voffA); PG8_STAGE(PG8_SB(0, 1), cB + hstep, voffB); PG8_STAGE(PG8_SA(0, 1), cA + hstep, voffA);
        if (wr == 1) PG8_BAR;
        PG8_WAIT_V(4); PG8_BAR;
        PG8_STAGE(PG8_SB(1, 0), cB + kstep, voffB); PG8_STAGE(PG8_SA(1, 0), cA + kstep, voffA); PG8_STAGE(PG8_SB(1, 1), cB + hstep + kstep, voffB);
        PG8_WAIT_V(6); PG8_BAR;
    }
    for (;;) {
        const bool has_next = S.next(ui + 1, nxt);
        const char* nA = has_next ? (const char*)g.A + (size_t)nxt.pm * tstep : cA; const char* nB = has_next ? (const char*)g.Bt + (size_t)nxt.pn * tstep : cB;
        for (int t = 0; t < nt; t += 2) {
            const bool last = (t == nt - 2);
            const char* a1 = cA + (size_t)(t + 1) * kstep;
            const char* a2 = last ? nA : cA + (size_t)(t + 2) * kstep; const char* b2 = last ? nB : cB + (size_t)(t + 2) * kstep;
            const char* a3 = a2 + kstep; const char* b3 = b2 + kstep;
            if (last && has_next) S.a_ready(nxt);
            if constexpr (Epi::HOOK) { if (t == Epi::SEG1 || t == Epi::SEG2) E.rescale(acc, cur, t == Epi::SEG1 ? 1 : 2, wr, wc, fr, fq); if (t == Epi::SEG3) E.rowscale(acc, cur, wr); }
            if constexpr (SP2) {
            PG8_LDB(B0, 0, 0); PG8_LDB(B1, 0, 1); PG8_SCHED; PG8_LDA(At, 0, 0); PG8_STAGE(PG8_SA(1, 1), a1 + hstep, voffA);
            PG8_WAIT_V(8); PG8_WAIT_L(0); PG8_BAR; PG8_MMA(0, 0, At, B0); PG8_MMA(0, 1, At, B1); PG8_BAR; PG8_SCHED;
            PG8_LDA(At, 0, 1); PG8_STAGE(PG8_SB(0, 0), b2, voffB); PG8_STAGE(PG8_SB(0, 1), b2 + hstep, voffB); PG8_STAGE(PG8_SA(0, 0), a2, voffA);
            PG8_WAIT_V(8); PG8_WAIT_L(0); PG8_BAR; PG8_MMA(1, 0, At, B0); PG8_MMA(1, 1, At, B1); PG8_BAR; PG8_SCHED;
            PG8_LDB(B0, 1, 0); PG8_LDB(B1, 1, 1); PG8_SCHED; PG8_LDA(At, 1, 0); PG8_STAGE(PG8_SA(0, 1), a2 + hstep, voffA);
            PG8_WAIT_V(8); PG8_WAIT_L(0); PG8_BAR; PG8_MMA(0, 0, At, B0); PG8_MMA(0, 1, At, B1); PG8_BAR; PG8_SCHED;
            PG8_LDA(At, 1, 1); PG8_STAGE(PG8_SB(1, 0), b3, voffB); PG8_STAGE(PG8_SB(1, 1), b3 + hstep, voffB); PG8_STAGE(PG8_SA(1, 0), a3, voffA);
            PG8_WAIT_V(8); PG8_WAIT_L(0); PG8_BAR; PG8_MMA(1, 0, At, B0); PG8_MMA(1, 1, At, B1); PG8_BAR; PG8_SCHED;
            } else {
            PG8_LDB(B0, 0, 0); PG8_SCHED; PG8_LDA(At, 0, 0); PG8_STAGE(PG8_SA(1, 1), a1 + hstep, voffA);
            PG8_WAIT_L(8); PG8_BAR; PG8_WAIT_L(0); PG8_MMA(0, 0, At, B0); PG8_BAR; PG8_SCHED;
            PG8_LDB(B1, 0, 1); PG8_STAGE(PG8_SB(0, 0), b2, voffB);
            PG8_BAR; PG8_WAIT_L(0); PG8_MMA(0, 1, At, B1); PG8_BAR;
            PG8_LDA(At, 0, 1); PG8_STAGE(PG8_SA(0, 0), a2, voffA);
            PG8_BAR; PG8_WAIT_L(0); PG8_MMA(1, 0, At, B0); PG8_BAR; PG8_SCHED;
            PG8_STAGE(PG8_SB(0, 1), b2 + hstep, voffB);
            PG8_WAIT_V(6); PG8_BAR; PG8_MMA(1, 1, At, B1); PG8_BAR;
            PG8_LDB(B0, 1, 0); PG8_SCHED; PG8_LDA(At, 1, 0); PG8_STAGE(PG8_SA(0, 1), a2 + hstep, voffA);
            PG8_WAIT_L(8); PG8_BAR; PG8_WAIT_L(0); PG8_MMA(0, 0, At, B0); PG8_BAR; PG8_SCHED;
            PG8_LDB(B1, 1, 1); PG8_STAGE(PG8_SB(1, 0), b3, voffB);
            PG8_BAR; PG8_WAIT_L(0); PG8_MMA(0, 1, At, B1); PG8_BAR;
            PG8_LDA(At, 1, 1); PG8_STAGE(PG8_SA(1, 0), a3, voffA);
            PG8_BAR; PG8_WAIT_L(0); PG8_MMA(1, 0, At, B0); PG8_BAR; PG8_SCHED;
            PG8_STAGE(PG8_SB(1, 1), b3 + hstep, voffB);
            PG8_WAIT_V(6); PG8_BAR; PG8_MMA(1, 1, At, B1); PG8_BAR;
            }
        }
        if constexpr (ALIGN_EPI) { if (wr == 0) PG8_BAR; }
        if constexpr ((PROBE & 8) != 0) { f32x4 s_ = acc[0][0][0][0];
#pragma unroll
            for (int a_ = 0; a_ < 2; ++a_)
#pragma unroll
                for (int b_ = 0; b_ < 2; ++b_)
#pragma unroll
                    for (int m_ = 0; m_ < 4; ++m_)
#pragma unroll
                        for (int n_ = 0; n_ < 2; ++n_) s_ += acc[a_][b_][m_][n_];
            if (s_[0] + s_[1] + s_[2] + s_[3] == 1234.567f) *(volatile float*)g.A = s_[0]; }
        if constexpr (!Epi::AFTER_DRAIN && !(PROBE & 1)) { int t2_ = threadIdx.x; asm volatile("" : "+v"(t2_)); E(acc, cur, wr, wc, t2_ & 15, (t2_ & 63) >> 4); S.done(cur); }
        if (!has_next) break;
#pragma unroll
        for (int a = 0; a < 2; ++a)
#pragma unroll
            for (int b = 0; b < 2; ++b)
#pragma unroll
                for (int m = 0; m < 4; ++m)
#pragma unroll
                    for (int n = 0; n < 2; ++n) acc[a][b][m][n] = (f32x4){0.f, 0.f, 0.f, 0.f};
        cur = nxt; cA = nA; cB = nB; ++ui;
        if constexpr (ALIGN_EPI) { if (wr == 1) PG8_BAR; }
    }
    PG8_WAIT_V(0);
    if constexpr (!ALIGN_EPI) { if (wr == 0) PG8_BAR; }
    PG8_BAR;
    if constexpr (Epi::AFTER_DRAIN) { E.fused(acc, cur, wr, wc, fr, fq, lds, wid, lane); S.done(cur); }
#undef PG8_SA
#undef PG8_SB
#undef PG8_STAGE
#undef PG8_LDA
#undef PG8_LDB
#undef PG8_MMA
#undef PG8_WAIT_V
#undef PG8_WAIT_L
#undef PG8_BAR
#undef PG8_SCHED
}
}
constexpr int DM = 1024, NBATCH = 8, SEQ = 4096, MTOK = NBATCH * SEQ, DEPTH = 2, DFF = 4096, PLED = 256, NIN = 8472;
constexpr int ZB_LD = 1536, MIX_LD = 3840, SM_LD = 32, N1 = 5632, NGATE = 3072, KMERGE = 1536;
constexpr int MX_AQ = 0, MX_AK = 512, MX_AV = 1024, MX_BX = 1536, MX_BB = 2048, MX_BC = 2176, MX_CQ = 2304, MX_CK = 2816, MX_CV = 3328;
constexpr size_t KiB = 1024, MiB = 1024 * 1024;
constexpr size_t WS_CTL = 0, CTL_BYTES = 64 * KiB;
constexpr size_t WS_W = 64 * KiB;
constexpr size_t W_1T = WS_W, W_GT = W_1T + (size_t)N1 * DM * 2, W_MT = W_GT + (size_t)NGATE * DM * 2, W_OT = W_MT + (size_t)DM * KMERGE * 2, W_UT = W_OT + (size_t)DM * DM * 2,
                 W_DT = W_UT + (size_t)DFF * DM * 2, W_PGT = W_DT + (size_t)DM * DFF * 2, W_PPT = W_PGT + (size_t)DM * DM * 2, W_END = W_PPT + (size_t)DM * PLED * 2;
constexpr size_t WS_SSQA = W_1T + 1 * MiB, WS_SSQB = W_1T + 3 * MiB;
constexpr size_t WS_XB0 = W_END, WS_XB1 = WS_XB0 + 64 * MiB, WS_ZB = WS_XB1 + 64 * MiB, WS_MIX = WS_ZB + 96 * MiB, WS_SM = WS_MIX + 240 * MiB, WS_SSQC = WS_SM + 4 * MiB, WS_ROPE = WS_SSQC + 2 * MiB, WS_END = WS_ROPE + 1 * MiB;
constexpr size_t WS_PB = WS_ZB, WS_PLE = WS_ZB + 16 * MiB, WS_U = WS_ZB + 80 * MiB, WS_GATE = WS_MIX;
static_assert(W_END == WS_W + (size_t)(40 * MiB + 512 * KiB), "weights");
static_assert(WS_U + (size_t)MTOK * DFF * 2 == WS_SM, "U overlay");
static_assert(WS_END <= 512 * MiB, "workspace");
constexpr int LDS_BYTES = 147456, RING_BYTES = 131072, MISC_OFF = RING_BYTES + 320, RS_OFF = RING_BYTES + 1024;
static_assert(RS_OFF + 32 + pg8::RS_SLOTS * 1024 <= LDS_BYTES, "LDS map");

#define GAS __attribute__((address_space(1)))
#define LAS __attribute__((address_space(3)))
typedef unsigned short bf16;
typedef unsigned v4u __attribute__((ext_vector_type(4)));
typedef unsigned v2u __attribute__((ext_vector_type(2)));
typedef float f32x4 __attribute__((ext_vector_type(4)));
#define LDS_WAIT() asm volatile("s_waitcnt lgkmcnt(0)" ::: "memory")
typedef float f32x2_t __attribute__((ext_vector_type(2))); typedef __bf16 bf16x2_t __attribute__((ext_vector_type(2)));
__device__ __forceinline__ unsigned pk2(float lo, float hi) { f32x2_t v = {lo, hi}; bf16x2_t b = __builtin_convertvector(v, bf16x2_t); return __builtin_bit_cast(unsigned, b); }
__device__ __forceinline__ unsigned f2bf(float f) { return pk2(f, 0.f) & 0xffffu; }
__device__ __forceinline__ float bf2f(bf16 v) { return __uint_as_float((unsigned)v << 16); }
__device__ __forceinline__ float wave_sum(float v) {
#pragma unroll
    for (int o = 1; o < 64; o <<= 1) v += __shfl_xor(v, o);
    return v;
}
__device__ __forceinline__ float siluf(float x) { return x * __builtin_amdgcn_rcpf(1.0f + __expf(-x)); }
__device__ __forceinline__ float sigmf(float x) { return __builtin_amdgcn_rcpf(1.0f + __expf(-x)); }
__device__ __forceinline__ float softplusf(float x) { return fmaxf(x, 0.f) + log1pf(__expf(-fabsf(x))); }
__device__ __forceinline__ float rdl(float v, int l) { return __int_as_float(__builtin_amdgcn_readlane(__float_as_int(v), l)); }

#define XB_TMO      128
#define XB_XCNT(j)  (256  + 64 * (j))
#define XB_XSUB(j)  (1280 + 64 * (j))
#define XB_XGEN(j)  (2304 + 64 * (j))
#define XB_TOP      3328
#define XB_TOPGEN   3392
#define XCD_BAR_WORDS 3456
#define XB_SPIN_CAP (1u << 18)
__device__ __forceinline__ unsigned xb_ld(unsigned* p)              { return __hip_atomic_load(p, __ATOMIC_RELAXED, __HIP_MEMORY_SCOPE_AGENT); }
__device__ __forceinline__ unsigned xb_add(unsigned* p, unsigned v) { return __hip_atomic_fetch_add(p, v, __ATOMIC_RELAXED, __HIP_MEMORY_SCOPE_AGENT); }
__device__ __forceinline__ unsigned xb_xcc_id() { return (unsigned)__builtin_amdgcn_s_getreg((3 << 11) | 20) & 0xFu; }
#define XB_SPIN(cond, bar) do { unsigned _sp = 0; while (cond) { __builtin_amdgcn_s_sleep(1); \
    if ((++_sp & 255u) == 0u) { if (xb_ld(&(bar)[XB_TMO])) break; if (_sp > XB_SPIN_CAP) { atomicAdd(&(bar)[XB_TMO], 1u); break; } } } } while (0)
struct XcdBarrier { unsigned* bar; unsigned x; volatile LAS unsigned* st; };
__device__ __forceinline__ XcdBarrier xcd_barrier_post(unsigned* bar, volatile LAS unsigned* st) {
    XcdBarrier b; b.bar = bar; b.x = xb_xcc_id(); b.st = st;
    if (threadIdx.x == 0) (void)xb_add(&bar[XB_XCNT(b.x)], 1u);
    return b;
}
__device__ __forceinline__ void xcd_barrier_complete(unsigned* bar, unsigned x, unsigned& nloc, unsigned& nx) {
    const unsigned G = gridDim.x * gridDim.y * gridDim.z;
    unsigned sum, cnt, mine, sp = 0u;
    for (;;) {
        sum = 0u; cnt = 0u; mine = 0u;
#pragma unroll
        for (unsigned j = 0; j < 16; ++j) { const unsigned c = xb_ld(&bar[XB_XCNT(j)]); sum += c; cnt += (c > 0u) ? 1u : 0u; mine = (j == x) ? c : mine; }
        if (sum == G) break;
        __builtin_amdgcn_s_sleep(1);
        if ((++sp & 255u) == 0u) { if (xb_ld(&bar[XB_TMO])) break; if (sp > XB_SPIN_CAP) { atomicAdd(&bar[XB_TMO], 1u); break; } }
    }
    nloc = mine > 0u ? mine : 1u; nx = cnt > 0u ? cnt : 1u;
}
__device__ __forceinline__ void xcd_barrier(const XcdBarrier& b) {
    asm volatile("s_waitcnt vmcnt(0)" ::: "memory");
    __syncthreads();
    if (threadIdx.x == 0) {
        unsigned* bar = b.bar;
        __builtin_amdgcn_s_waitcnt(0);
        unsigned nloc = b.st[0], nx = b.st[1];
        if (nloc == 0u) { xcd_barrier_complete(bar, b.x, nloc, nx); b.st[0] = nloc; b.st[1] = nx; }
        const unsigned old = xb_add(&bar[XB_XSUB(b.x)], 1u);
        const unsigned gen = old / nloc;
        if (old + 1u == (gen + 1u) * nloc) {
            __builtin_amdgcn_fence(__ATOMIC_RELEASE, "agent");
            asm volatile("s_waitcnt vmcnt(0)" ::: "memory");
            const unsigned og = xb_add(&bar[XB_TOP], 1u);
            const unsigned tg = og / nx;
            if (og + 1u == (tg + 1u) * nx) xb_add(&bar[XB_TOPGEN], 1u);
            else XB_SPIN(xb_ld(&bar[XB_TOPGEN]) == tg, bar);
            __builtin_amdgcn_fence(__ATOMIC_ACQUIRE, "agent");
            xb_add(&bar[XB_XGEN(b.x)], 1u);
            asm volatile("s_waitcnt vmcnt(0)" ::: "memory");
        } else {
            XB_SPIN(xb_ld(&bar[XB_XGEN(b.x)]) == gen, bar);
            __builtin_amdgcn_fence(__ATOMIC_ACQUIRE, "agent");
            asm volatile("s_waitcnt vmcnt(0)" ::: "memory");
        }
    }
    __syncthreads();
}

__device__ __forceinline__ void tr_item(const float* W, int ldw, int c0, int ncols, const float* scale, bf16* dst, int ldd, int r0, int kofs, LAS unsigned char* lds, int item, int tid) {
    const int lane = tid & 63, wave = __builtin_amdgcn_readfirstlane(tid >> 6);
    const int nblk = (ncols + 255) / 256, kb = item / nblk, nb = item - kb * nblk, k0 = 64 * kb, n0 = 256 * nb;
    asm volatile("s_waitcnt lgkmcnt(0)\n\ts_barrier" ::: "memory");
    float v[8][4];
    const int n = n0 + 4 * lane;
    const bool vec = W != nullptr && ((c0 | ldw) & 3) == 0 && n + 3 < ncols;
    const float* wp = W + (size_t)(k0 + 8 * wave) * ldw + c0 + n;
#pragma unroll
    for (int kk = 0; kk < 8; ++kk) {
        if (vec) { const f32x4 t = *(const GAS f32x4*)(wp + (size_t)kk * ldw); v[kk][0] = t[0]; v[kk][1] = t[1]; v[kk][2] = t[2]; v[kk][3] = t[3]; }
        else {
#pragma unroll
            for (int q = 0; q < 4; ++q) v[kk][q] = (W != nullptr && n + q < ncols) ? wp[(size_t)kk * ldw + q] : 0.f; }
        if (scale) { const float s = scale[k0 + 8 * wave + kk];
#pragma unroll
            for (int q = 0; q < 4; ++q) v[kk][q] *= s; } }
#pragma unroll
    for (int q = 0; q < 4; ++q) { v4u o; o.x = pk2(v[0][q], v[1][q]); o.y = pk2(v[2][q], v[3][q]); o.z = pk2(v[4][q], v[5][q]); o.w = pk2(v[6][q], v[7][q]);
        *(LAS v4u*)(lds + (4 * lane + q) * 128 + ((wave ^ (lane & 7)) << 4)) = o; }
    asm volatile("s_waitcnt lgkmcnt(0)\n\ts_barrier" ::: "memory");
#pragma unroll
    for (int i = 0; i < 4; ++i) { const int nl = (tid >> 3) + 64 * i, ch = tid & 7;
        if (n0 + nl < ncols) *(GAS v4u*)(dst + (size_t)(r0 + n0 + nl) * ldd + kofs + k0 + ch * 8) = *(const LAS v4u*)(lds + nl * 128 + ((ch ^ ((nl >> 2) & 7)) << 4)); }
}
#define TR_SEG(W_, ldw_, c0_, ncols_, K_, scale_, dst_, ldd_, r0_, kofs_) do { const int _n = ((K_) / 64) * (((ncols_) + 255) / 256); \
    for (int _it = (bx + G - (ibase % G)) % G; _it < _n; _it += G) tr_item(W_, ldw_, c0_, ncols_, scale_, dst_, ldd_, r0_, kofs_, lds, _it, tid); ibase += _n; } while (0)

__device__ __forceinline__ void build_rs_table(const pg8::StaticOrder& S, const float* ssqp, LAS unsigned char* lds, int tid) {
    LAS int* pml = (LAS int*)(lds + RS_OFF); LAS float* tab = (LAS float*)(lds + RS_OFF + 32);
    __syncthreads();
    if (tid == 0) { int npm = 0;
        for (int k = 0; k < pg8::RS_SLOTS; ++k) pml[k] = -1;
        for (int i = 0; ; ++i) { pg8::Unit u; if (!S.next(i, u)) break; bool found = false;
            for (int k = 0; k < npm; ++k) found = found || (pml[k] == u.pm);
            if (!found && npm < pg8::RS_SLOTS) pml[npm++] = u.pm; } }
    __syncthreads();
#pragma unroll 1
    for (int s = tid >> 8; s < pg8::RS_SLOTS; s += 2) { const int pm = pml[s]; if (pm < 0) continue;
        const float* p = ssqp + ((size_t)pm * 256 + (tid & 255)) * 16;
        const f32x4 a = *(const f32x4*)p, b = *(const f32x4*)(p + 4), c = *(const f32x4*)(p + 8), d = *(const f32x4*)(p + 12);
        const float ss = ((a[0] + a[1]) + (a[2] + a[3])) + ((b[0] + b[1]) + (b[2] + b[3])) + ((c[0] + c[1]) + (c[2] + c[3])) + ((d[0] + d[1]) + (d[2] + d[3]));
        tab[s * 256 + (tid & 255)] = rsqrtf(ss * (1.0f / 1024.0f) + 1e-6f); }
    __syncthreads();
}
struct Args { const float* in[23]; float* out; unsigned char* ws; int ph_lo, ph_hi; };
constexpr int NPH = 10, PH_FINAL = DEPTH * NPH, N_PHASES = PH_FINAL + 1;

typedef short bf16x8 __attribute__((ext_vector_type(8)));
constexpr int PT = 72, MAT = 64 * PT * 2;
constexpr int SETB = 4 * MAT + 512;
constexpr int L_Q = 0, L_K = MAT, L_V = 2 * MAT, L_U = 2 * MAT, L_W = 3 * MAT, L_G = 4 * MAT, L_DT = 4 * MAT + 256;
constexpr int L_VT = 2 * SETB, L_ST0 = L_VT + MAT, L_ST1 = L_ST0 + MAT, L_PP = L_ST1 + MAT, L_YT = L_PP + MAT, L_WEND = L_YT + 2 * MAT;
static_assert(L_WEND <= RING_BYTES, "walker LDS");
constexpr size_t GW_OFF = 0, HALO_OFF = 32 * MiB;
constexpr int HALO_LD = 2304;
#define MFMA16(a, b, c) __builtin_amdgcn_mfma_f32_16x16x32_bf16(a, b, c, 0, 0, 0)
__device__ __forceinline__ bf16x8 ldfrag(LAS unsigned char* base, int row, int kelem) { return *(const LAS bf16x8*)(base + row * (PT * 2) + kelem * 2); }
__device__ __forceinline__ void unpk8(const v4u w, float (&f)[8]) { f[0] = pg8::bflo(w.x); f[1] = pg8::bfhi(w.x); f[2] = pg8::bflo(w.y); f[3] = pg8::bfhi(w.y); f[4] = pg8::bflo(w.z); f[5] = pg8::bfhi(w.z); f[6] = pg8::bflo(w.w); f[7] = pg8::bfhi(w.w); }
__device__ __forceinline__ v4u pk8(const float (&f)[8]) { v4u w; w.x = pk2(f[0], f[1]); w.y = pk2(f[2], f[3]); w.z = pk2(f[4], f[5]); w.w = pk2(f[6], f[7]); return w; }
__device__ __forceinline__ void st_tr8(LAS unsigned char* base, int row0, int col, const float (&f)[8]) {
#pragma unroll
    for (int j = 0; j < 8; ++j) *(LAS bf16*)(base + (row0 + j) * (PT * 2) + col * 2) = (bf16)f2bf(f[j]);
}

#define LBAR() asm volatile("s_waitcnt lgkmcnt(0)\n\ts_barrier" ::: "memory")
typedef short s16x4 __attribute__((ext_vector_type(4)));
__device__ __forceinline__ s16x4 tr4(LAS unsigned char* p) { return __builtin_bit_cast(s16x4, __builtin_amdgcn_ds_read_tr16_b64_v4i16((LAS s16x4*)p)); }
__device__ __forceinline__ bf16x8 trfrag(LAS unsigned char* tile, int krow0, int col0, int fr) {
    LAS unsigned char* a = tile + (krow0 + (fr >> 2)) * (PT * 2) + (col0 + 4 * (fr & 3)) * 2;
    const s16x4 lo = tr4(a), hi = tr4(a + 4 * PT * 2);
    return (bf16x8){lo[0], lo[1], lo[2], lo[3], hi[0], hi[1], hi[2], hi[3]};
}
__device__ __forceinline__ float bfs(short v) { return __uint_as_float((unsigned)(unsigned short)v << 16); }
__device__ __forceinline__ float sum8(float v) {
    v += __int_as_float(__builtin_amdgcn_update_dpp(0, __float_as_int(v), 0xB1, 0xF, 0xF, true));
    v += __int_as_float(__builtin_amdgcn_update_dpp(0, __float_as_int(v), 0x4E, 0xF, 0xF, true));
    v += __int_as_float(__builtin_amdgcn_update_dpp(0, __float_as_int(v), 0x141, 0xF, 0xF, true));
    return v;
}
typedef short bf16x4 __attribute__((ext_vector_type(4)));
#define MFMA16K16(a, b, c) __builtin_amdgcn_mfma_f32_16x16x16bf16_1k(a, b, c, 0, 0, 0)
__device__ __forceinline__ bf16x4 pk4(const pg8::f32x4 v) { v2u w; w.x = pk2(v[0], v[1]); w.y = pk2(v[2], v[3]); return __builtin_bit_cast(bf16x4, w); }

template <int KIND>
__device__ __forceinline__ void mixer_walk(const __attribute__((address_space(4))) Args* kp, int layer, int b, int h, LAS unsigned char* lds, const int pm = 0) {
    int tid = threadIdx.x; asm volatile("" : "+v"(tid));
    const int lane = tid & 63, wave = __builtin_amdgcn_readfirstlane(tid >> 6), fr = lane & 15, fq = lane >> 4;
    const int prow = tid >> 3, pcg = tid & 7;
    unsigned char* ws = kp->ws;
    const bf16* MIX = (const bf16*)(ws + WS_MIX); bf16* ZB = (bf16*)(ws + WS_ZB); float* SM = (float*)(ws + WS_SM);
    const bf16* GW = (const bf16*)(ws + ((layer & 1) ? WS_XB0 : WS_XB1) + GW_OFF);
    const size_t tok0 = (size_t)b * SEQ;
    const int g = h >> 2;
    const int qcol = (KIND == 0 ? MX_AQ + h * 64 : (KIND == 1 ? MX_BC + g * 64 : MX_CQ + h * 64)) + pcg * 8;
    const int kcol = (KIND == 0 ? MX_AK + h * 64 : (KIND == 1 ? MX_BB + g * 64 : MX_CK + h * 64)) + pcg * 8;
    const int vcol = (KIND == 0 ? MX_AV + h * 64 : (KIND == 1 ? MX_BX + h * 64 : MX_CV + h * 64)) + pcg * 8;
    const int zcol = KIND * 512 + h * 64 + pcg * 8;
    const int gcol = (KIND == 0 ? 8 : 16) + h;
    float nw[8];
    if (KIND == 0) {
#pragma unroll
        for (int j = 0; j < 8; ++j) nw[j] = kp->in[7][layer * 64 + pcg * 8 + j];
    }
    const float p_D = KIND == 1 ? kp->in[12][layer * 8 + h] : 0.f;
    const float p_lg = KIND == 2 ? log1pf(-exp2f(-5.0f - (float)h)) : 0.f;
    for (int i = tid; i < MAT / 4; i += 512) ((LAS unsigned*)(lds + L_ST0))[i] = 0u;
    pg8::f32x4 sacc[4];
#pragma unroll
    for (int i = 0; i < 4; ++i) sacc[i] = (pg8::f32x4){0.f, 0.f, 0.f, 0.f};

    v4u tq, tk, tv, tw, tz; float sg = 0.f, sd = 1.f; (void)tw;
    pg8::f32x4 rc0, rc1, rs0, rs1; (void)rc0; (void)rc1; (void)rs0; (void)rs1;
    const float* ROPE = (const float*)(ws + WS_ROPE);
#define WALK_LOAD(c) do { const size_t row = tok0 + (size_t)(pm ? 0 : (c)) * 64 + prow; \
        tq = *(const GAS v4u*)(MIX + mixh(qcol, row)); tk = *(const GAS v4u*)(MIX + mixh(kcol, row)); tv = *(const GAS v4u*)(MIX + mixh(vcol, row)); \
        if (KIND == 0) tw = *(const GAS v4u*)(GW + gwh(h, pcg * 8, row)); \
        if (KIND == 2) { const float* rp = ROPE + ((c) * 64 + prow) * 32 + (pcg & 3) * 8; rc0 = *(const GAS pg8::f32x4*)rp; rc1 = *(const GAS pg8::f32x4*)(rp + 4); \
            rs0 = *(const GAS pg8::f32x4*)(rp + SEQ * 32); rs1 = *(const GAS pg8::f32x4*)(rp + SEQ * 32 + 4); } \
        tz = *(const GAS v4u*)(ZB + row * ZB_LD + zcol); \
        if (tid < 64) { const size_t r2 = tok0 + (size_t)(pm ? 0 : (c)) * 64 + tid; \
            if (KIND == 2) sg = (float)(tid + 1) * p_lg; else sg = SM[r2 * SM_LD + gcol]; \
            if (KIND == 1) sd = SM[r2 * SM_LD + 24 + h]; } } while (0)
#define WALK_ROT(t_, sc_) do { v4u pw_; pw_.x = __shfl_xor(t_.x, 4); pw_.y = __shfl_xor(t_.y, 4); pw_.z = __shfl_xor(t_.z, 4); pw_.w = __shfl_xor(t_.w, 4); \
        float a_[8], p_[8]; unpk8(t_, a_); unpk8(pw_, p_); const float sg_ = (pcg < 4 ? -(sc_) : (sc_)); \
        _Pragma("unroll") for (int j_ = 0; j_ < 4; ++j_) { a_[j_] = a_[j_] * (rc0[j_] * (sc_)) + p_[j_] * (rs0[j_] * sg_); a_[4 + j_] = a_[4 + j_] * (rc1[j_] * (sc_)) + p_[4 + j_] * (rs1[j_] * sg_); } \
        t_ = pk8(a_); } while (0)
#define WALK_PREP(sb_) do { LAS unsigned char* sp_ = lds + (sb_) * SETB; \
        if (KIND == 2) { WALK_ROT(tq, 1.0f); WALK_ROT(tk, 0.125f); } \
        *(LAS v4u*)(sp_ + L_Q + prow * (PT * 2) + pcg * 16) = tq; *(LAS v4u*)(sp_ + L_K + prow * (PT * 2) + pcg * 16) = tk; \
        *(LAS v4u*)(sp_ + L_V + prow * (PT * 2) + pcg * 16) = tv; \
        if (KIND == 0) *(LAS v4u*)(sp_ + L_W + prow * (PT * 2) + pcg * 16) = tw; \
        if (tid < 64) { ((LAS float*)(sp_ + L_G))[tid] = sg; ((LAS float*)(sp_ + L_DT))[tid] = sd; } } while (0)

    WALK_LOAD(0);
    WALK_PREP(0);
    v4u zc = tz, xc = tv;
    LBAR();
    for (int c = 0; c < SEQ / 64; ++c) {
        LAS unsigned char* STc = lds + ((c & 1) ? L_ST1 : L_ST0); LAS unsigned char* STn = lds + ((c & 1) ? L_ST0 : L_ST1);
        LAS unsigned char* sp = lds + (c & 1) * SETB;
        const LAS float* Gv = (const LAS float*)(sp + L_G); const LAS float* Dv = (const LAS float*)(sp + L_DT);
        LAS unsigned char* YTc = lds + L_YT + (c & 1) * MAT;
        if (c + 1 < SEQ / 64) WALK_LOAD(c + 1);
        bf16x8 Qf[2]; bf16x4 Pb[4]; float egl_y = 1.f;
        if (wave < 4) { const int lb = wave;
            Qf[0] = ldfrag(sp + L_Q, 16 * lb + fr, 8 * fq); Qf[1] = ldfrag(sp + L_Q, 16 * lb + fr, 32 + 8 * fq);
            bf16x8 Kb[4][2]; pg8::f32x4 gs[4], ds[4], pacc[4];
#pragma unroll
            for (int sb = 0; sb < 4; ++sb) if (sb <= lb) { Kb[sb][0] = ldfrag(sp + L_K, 16 * sb + fr, 8 * fq); Kb[sb][1] = ldfrag(sp + L_K, 16 * sb + fr, 32 + 8 * fq);
                gs[sb] = *(const LAS pg8::f32x4*)(Gv + 16 * sb + 4 * fq); ds[sb] = (pg8::f32x4){1.f, 1.f, 1.f, 1.f};
                if (KIND == 1) ds[sb] = *(const LAS pg8::f32x4*)(Dv + 16 * sb + 4 * fq); }
            const float gl = Gv[16 * lb + fr];
#pragma unroll
            for (int sb = 0; sb < 4; ++sb) if (sb <= lb) { pacc[sb] = MFMA16(Kb[sb][0], Qf[0], ((pg8::f32x4){0.f, 0.f, 0.f, 0.f})); }
#pragma unroll
            for (int sb = 0; sb < 4; ++sb) if (sb <= lb) { pacc[sb] = MFMA16(Kb[sb][1], Qf[1], pacc[sb]); }
            egl_y = __expf(gl);
#pragma unroll
            for (int sb = 0; sb < 4; ++sb) if (sb <= lb) { pg8::f32x4 pv;
#pragma unroll
                    for (int r = 0; r < 4; ++r) pv[r] = (16 * sb + 4 * fq + r <= 16 * lb + fr) ? pacc[sb][r] * __expf(gl - gs[sb][r]) * ds[sb][r] : 0.f;
                    Pb[sb] = pk4(pv); }
        } else if (KIND == 0) { const int wq = wave - 4;
            const bf16x8 Wf0 = ldfrag(sp + L_W, 16 * wq + fr, 8 * fq), Wf1 = ldfrag(sp + L_W, 16 * wq + fr, 32 + 8 * fq);
            bf16x8 Sf[4][2]; s16x4 u4[4]; pg8::f32x4 vacc[4];
#pragma unroll
            for (int eb = 0; eb < 4; ++eb) { Sf[eb][0] = ldfrag(STc, 16 * eb + fr, 8 * fq); Sf[eb][1] = ldfrag(STc, 16 * eb + fr, 32 + 8 * fq);
                u4[eb] = tr4(sp + L_U + (16 * wq + 4 * fq + (fr >> 2)) * (PT * 2) + (16 * eb + 4 * (fr & 3)) * 2); }
#pragma unroll
            for (int eb = 0; eb < 4; ++eb) vacc[eb] = MFMA16(Wf0, Sf[eb][0], ((pg8::f32x4){0.f, 0.f, 0.f, 0.f}));
#pragma unroll
            for (int eb = 0; eb < 4; ++eb) vacc[eb] = MFMA16(Wf1, Sf[eb][1], vacc[eb]);
#pragma unroll
            for (int eb = 0; eb < 4; ++eb) { v2u o; o.x = pk2(bfs(u4[eb][0]) - vacc[eb][0], bfs(u4[eb][1]) - vacc[eb][1]); o.y = pk2(bfs(u4[eb][2]) - vacc[eb][2], bfs(u4[eb][3]) - vacc[eb][3]);
                *(LAS v2u*)(lds + L_VT + (16 * eb + fr) * (PT * 2) + (16 * wq + 4 * fq) * 2) = o; }
        }
        if (KIND == 0) LBAR();
        if (wave < 4) { const int lb = wave;
            bf16x8 Sf[4][2]; bf16x4 Va[4][4]; pg8::f32x4 yacc[4];
#pragma unroll
            for (int eb = 0; eb < 4; ++eb) { Sf[eb][0] = ldfrag(STc, 16 * eb + fr, 8 * fq); Sf[eb][1] = ldfrag(STc, 16 * eb + fr, 32 + 8 * fq);
#pragma unroll
                for (int sb = 0; sb < 4; ++sb) if (sb <= lb) {
                    if (KIND == 0) Va[eb][sb] = *(const LAS bf16x4*)(lds + L_VT + (16 * eb + fr) * (PT * 2) + (16 * sb + 4 * fq) * 2);
                    else Va[eb][sb] = tr4(sp + L_V + (16 * sb + 4 * fq + (fr >> 2)) * (PT * 2) + (16 * eb + 4 * (fr & 3)) * 2); } }
#pragma unroll
            for (int eb = 0; eb < 4; ++eb) yacc[eb] = MFMA16(Sf[eb][0], Qf[0], ((pg8::f32x4){0.f, 0.f, 0.f, 0.f}));
#pragma unroll
            for (int eb = 0; eb < 4; ++eb) yacc[eb] = MFMA16(Sf[eb][1], Qf[1], yacc[eb]);
#pragma unroll
            for (int eb = 0; eb < 4; ++eb) yacc[eb] *= egl_y;
#pragma unroll
            for (int sb = 0; sb < 4; ++sb) if (sb <= lb) {
#pragma unroll
                for (int eb = 0; eb < 4; ++eb) yacc[eb] = MFMA16K16(Va[eb][sb], Pb[sb], yacc[eb]); }
#pragma unroll
            for (int eb = 0; eb < 4; ++eb) { v2u o; o.x = pk2(yacc[eb][0], yacc[eb][1]); o.y = pk2(yacc[eb][2], yacc[eb][3]);
                *(LAS v2u*)(YTc + (16 * lb + fr) * (PT * 2) + (16 * eb + 4 * fq) * 2) = o; }
        } else { const int db = wave - 4;
            const float glast = Gv[63], egl = __expf(glast);
            bf16x8 Kr[2], Vf[4][2]; pg8::f32x4 g0[2], g1[2], d0[2], d1[2];
#pragma unroll
            for (int ks = 0; ks < 2; ++ks) { Kr[ks] = trfrag(sp + L_K, 32 * ks + 8 * fq, 16 * db, fr);
                g0[ks] = *(const LAS pg8::f32x4*)(Gv + 32 * ks + 8 * fq); g1[ks] = *(const LAS pg8::f32x4*)(Gv + 32 * ks + 8 * fq + 4);
                d0[ks] = (pg8::f32x4){1.f, 1.f, 1.f, 1.f}; d1[ks] = d0[ks];
                if (KIND == 1) { d0[ks] = *(const LAS pg8::f32x4*)(Dv + 32 * ks + 8 * fq); d1[ks] = *(const LAS pg8::f32x4*)(Dv + 32 * ks + 8 * fq + 4); } }
#pragma unroll
            for (int eb = 0; eb < 4; ++eb) {
                if (KIND == 0) { Vf[eb][0] = ldfrag(lds + L_VT, 16 * eb + fr, 8 * fq); Vf[eb][1] = ldfrag(lds + L_VT, 16 * eb + fr, 32 + 8 * fq); }
                else { Vf[eb][0] = trfrag(sp + L_V, 8 * fq, 16 * eb, fr); Vf[eb][1] = trfrag(sp + L_V, 32 + 8 * fq, 16 * eb, fr); } }
            bf16x8 Kf[2];
#pragma unroll
            for (int ks = 0; ks < 2; ++ks) { float kf[8];
#pragma unroll
                for (int j = 0; j < 4; ++j) { kf[j] = bfs(Kr[ks][j]) * __expf(glast - g0[ks][j]) * d0[ks][j]; kf[4 + j] = bfs(Kr[ks][4 + j]) * __expf(glast - g1[ks][j]) * d1[ks][j]; }
                const v4u kw = pk8(kf); Kf[ks] = __builtin_bit_cast(bf16x8, kw); }
#pragma unroll
            for (int eb = 0; eb < 4; ++eb) sacc[eb] = MFMA16(Kf[0], Vf[eb][0], sacc[eb] * egl);
#pragma unroll
            for (int eb = 0; eb < 4; ++eb) sacc[eb] = MFMA16(Kf[1], Vf[eb][1], sacc[eb]);
#pragma unroll
            for (int eb = 0; eb < 4; ++eb) { v2u o; o.x = pk2(sacc[eb][0], sacc[eb][1]); o.y = pk2(sacc[eb][2], sacc[eb][3]);
                *(LAS v2u*)(STn + (16 * eb + fr) * (PT * 2) + (16 * db + 4 * fq) * 2) = o; }
        }
        const v4u zcur = zc, xcur = xc; (void)xcur;
        if (c + 1 < SEQ / 64) { WALK_PREP((c + 1) & 1); zc = tz; xc = tv; }
        LBAR();
        {
            float y[8], zf[8]; unpk8(*(const LAS v4u*)(YTc + prow * (PT * 2) + pcg * 16), y); unpk8(zcur, zf);
            const size_t row = tok0 + (size_t)c * 64 + prow;
            if (KIND == 1) { float ss = 0.f, xf[8]; unpk8(xcur, xf);
#pragma unroll
                for (int j = 0; j < 8; ++j) { y[j] = (y[j] + p_D * xf[j]) * siluf(zf[j]); ss += y[j] * y[j]; }
                ss = sum8(ss);
                if (pcg == 0 && !pm) SM[row * SM_LD + 16 + h] = ss;
            } else { float ss = 0.f;
#pragma unroll
                for (int j = 0; j < 8; ++j) ss += y[j] * y[j];
                ss = sum8(ss);
                const float rstd = rsqrtf(ss * (1.0f / 64.0f) + 1e-6f);
#pragma unroll
                for (int j = 0; j < 8; ++j) y[j] = y[j] * rstd * (KIND == 0 ? nw[j] : 1.0f) * siluf(zf[j]); }
            if (!pm || y[0] == 1234.567f) *(GAS v4u*)(ZB + row * ZB_LD + zcol) = pk8(y);
        }
    }
#undef WALK_LOAD
#undef WALK_PREP
#undef WALK_ROT
}

constexpr int W2_SET = 3 * MAT + 512, W2_Q = 0, W2_K = MAT, W2_V = 2 * MAT, W2_G = 3 * MAT, W2_DT = 3 * MAT + 256;
constexpr int W2_ST0 = 2 * W2_SET, W2_ST1 = W2_ST0 + MAT, W2_PP = W2_ST1 + MAT, W2_YT = W2_PP + MAT, W2_ZT = W2_YT + 2 * MAT, W2_END = W2_ZT + 3 * 8192;
static_assert(W2_END <= RING_BYTES, "walker2 LDS");
template <int KIND>
__device__ __forceinline__ void mixer_walk2(const __attribute__((address_space(4))) Args* kp, int layer, int b, int h, LAS unsigned char* lds, const int pm = 0) {
    int tid = threadIdx.x; asm volatile("" : "+v"(tid));
    const int lane = tid & 63, wave = __builtin_amdgcn_readfirstlane(tid >> 6), fr = lane & 15, fq = lane >> 4;
    const int grp = wave >> 2, gl = tid & 255, lrow = gl >> 2, i4 = gl & 3;
    const int prow = tid >> 3, pcg = tid & 7;
    unsigned char* ws = kp->ws;
    const bf16* MIX = (const bf16*)(ws + WS_MIX); bf16* ZB = (bf16*)(ws + WS_ZB); float* SM = (float*)(ws + WS_SM); const float* ROPE = (const float*)(ws + WS_ROPE);
    const size_t tok0 = (size_t)b * SEQ;
    const int g = h >> 2;
    const int qcol = (KIND == 1 ? MX_BC + g * 64 : MX_CQ + h * 64) + i4 * 8, kcol = (KIND == 1 ? MX_BB + g * 64 : MX_CK + h * 64) + i4 * 8, vcol = (KIND == 1 ? MX_BX + h * 64 : MX_CV + h * 64) + i4 * 8;
    const int zc0 = KIND * 512 + h * 64;
    const float p_D = KIND == 1 ? kp->in[12][layer * 8 + h] : 0.f;
    const float p_lg = KIND == 2 ? log1pf(-exp2f(-5.0f - (float)h)) : 0.f;
    for (int i = tid; i < MAT / 4; i += 512) ((LAS unsigned*)(lds + W2_ST0))[i] = 0u;
    pg8::f32x4 sacc[4];
#pragma unroll
    for (int i = 0; i < 4; ++i) sacc[i] = (pg8::f32x4){0.f, 0.f, 0.f, 0.f};

    v4u tq0, tq1, tk0, tk1, tv0, tv1, tz0, tz1; float sg = 0.f, sd = 1.f;
    pg8::f32x4 rc0, rc1, rs0, rs1; (void)rc0; (void)rc1; (void)rs0; (void)rs1;
#define W2_FETCH(c) do { const size_t row = tok0 + (size_t)(pm ? 0 : (c)) * 64 + lrow; \
        tq0 = *(const GAS v4u*)(MIX + mixh(qcol, row)); tq1 = *(const GAS v4u*)(MIX + mixh(qcol + 32, row)); tk0 = *(const GAS v4u*)(MIX + mixh(kcol, row)); tk1 = *(const GAS v4u*)(MIX + mixh(kcol + 32, row)); \
        tv0 = *(const GAS v4u*)(MIX + mixh(vcol, row)); tv1 = *(const GAS v4u*)(MIX + mixh(vcol + 32, row)); \
        tz0 = *(const GAS v4u*)(ZB + row * ZB_LD + zc0 + i4 * 8); tz1 = *(const GAS v4u*)(ZB + row * ZB_LD + zc0 + 32 + i4 * 8); \
        if (KIND == 2) { const float* rp = ROPE + ((pm ? 0 : (c)) * 64 + lrow) * 32 + i4 * 8; rc0 = *(const GAS pg8::f32x4*)rp; rc1 = *(const GAS pg8::f32x4*)(rp + 4); \
            rs0 = *(const GAS pg8::f32x4*)(rp + SEQ * 32); rs1 = *(const GAS pg8::f32x4*)(rp + SEQ * 32 + 4); } \
        if (gl < 64) { const size_t r2 = tok0 + (size_t)(pm ? 0 : (c)) * 64 + gl; \
            if (KIND == 2) sg = (float)(gl + 1) * p_lg; else sg = SM[r2 * SM_LD + 16 + h]; \
            if (KIND == 1) sd = SM[r2 * SM_LD + 24 + h]; } } while (0)
#define W2_ROT(ta_, tb_, sc_) do { float a_[8], b_[8], o1_[8], o2_[8]; unpk8(ta_, a_); unpk8(tb_, b_); \
        _Pragma("unroll") for (int j_ = 0; j_ < 4; ++j_) { \
            o1_[j_] = (a_[j_] * rc0[j_] - b_[j_] * rs0[j_]) * (sc_); o2_[j_] = (a_[j_] * rs0[j_] + b_[j_] * rc0[j_]) * (sc_); \
            o1_[4 + j_] = (a_[4 + j_] * rc1[j_] - b_[4 + j_] * rs1[j_]) * (sc_); o2_[4 + j_] = (a_[4 + j_] * rs1[j_] + b_[4 + j_] * rc1[j_]) * (sc_); } \
        ta_ = pk8(o1_); tb_ = pk8(o2_); } while (0)
#define W2_STORE(c, z3_) do { LAS unsigned char* sp_ = lds + ((c) & 1) * W2_SET + lrow * (PT * 2) + i4 * 16; \
        if (KIND == 2) { W2_ROT(tq0, tq1, 1.0f); W2_ROT(tk0, tk1, 0.125f); } \
        *(LAS v4u*)(sp_ + W2_Q) = tq0; *(LAS v4u*)(sp_ + W2_Q + 64) = tq1; *(LAS v4u*)(sp_ + W2_K) = tk0; *(LAS v4u*)(sp_ + W2_K + 64) = tk1; \
        *(LAS v4u*)(sp_ + W2_V) = tv0; *(LAS v4u*)(sp_ + W2_V + 64) = tv1; \
        { LAS unsigned char* zp_ = lds + W2_ZT + (z3_) * 8192 + lrow * 128 + i4 * 16; *(LAS v4u*)zp_ = tz0; *(LAS v4u*)(zp_ + 64) = tz1; } \
        if (gl < 64) { LAS float* gp_ = (LAS float*)(lds + ((c) & 1) * W2_SET + W2_G); gp_[gl] = sg; gp_[64 + gl] = sd; } } while (0)

    if (grp == 0) { W2_FETCH(0); W2_STORE(0, 0); W2_FETCH(2); } else { W2_FETCH(1); }
    LBAR();
    int z3 = 0;
    for (int c = 0; c < SEQ / 64; ++c) {
        LAS unsigned char* STc = lds + ((c & 1) ? W2_ST1 : W2_ST0); LAS unsigned char* STn = lds + ((c & 1) ? W2_ST0 : W2_ST1);
        LAS unsigned char* sp = lds + (c & 1) * W2_SET;
        const LAS float* Gv = (const LAS float*)(sp + W2_G); const LAS float* Dv = (const LAS float*)(sp + W2_DT);
        LAS unsigned char* YTc = lds + W2_YT + (c & 1) * MAT;
        const int z3n = z3 == 2 ? 0 : z3 + 1;
        if (wave < 4) { const int lb = wave;
            bf16x8 Qf[2];
            Qf[0] = ldfrag(sp + W2_Q, 16 * lb + fr, 8 * fq); Qf[1] = ldfrag(sp + W2_Q, 16 * lb + fr, 32 + 8 * fq);
            bf16x8 Kb[4][2]; pg8::f32x4 gs[4], ds[4], pacc[4];
#pragma unroll
            for (int sb = 0; sb < 4; ++sb) if (sb <= lb) { Kb[sb][0] = ldfrag(sp + W2_K, 16 * sb + fr, 8 * fq); Kb[sb][1] = ldfrag(sp + W2_K, 16 * sb + fr, 32 + 8 * fq);
                gs[sb] = *(const LAS pg8::f32x4*)(Gv + 16 * sb + 4 * fq); ds[sb] = (pg8::f32x4){1.f, 1.f, 1.f, 1.f};
                if (KIND == 1) ds[sb] = *(const LAS pg8::f32x4*)(Dv + 16 * sb + 4 * fq); }
            const float gl_ = Gv[16 * lb + fr];
#pragma unroll
            for (int sb = 0; sb < 4; ++sb) if (sb <= lb) { pacc[sb] = MFMA16(Kb[sb][0], Qf[0], ((pg8::f32x4){0.f, 0.f, 0.f, 0.f})); }
#pragma unroll
            for (int sb = 0; sb < 4; ++sb) if (sb <= lb) { pacc[sb] = MFMA16(Kb[sb][1], Qf[1], pacc[sb]); }
            bf16x4 Pb[4]; const float egl_y = __expf(gl_);
#pragma unroll
            for (int sb = 0; sb < 4; ++sb) if (sb <= lb) { pg8::f32x4 pv;
#pragma unroll
                    for (int r = 0; r < 4; ++r) { pv[r] = (16 * sb + 4 * fq + r <= 16 * lb + fr) ? pacc[sb][r] * __expf(gl_ - gs[sb][r]) * ds[sb][r] : 0.f;
                        if (KIND == 1 && sb == lb && 4 * fq + r == fr) pv[r] += p_D; }
                    Pb[sb] = pk4(pv); }
            pg8::f32x4 yacc[4];
            { bf16x8 Sf[4][2];
#pragma unroll
              for (int eb = 0; eb < 4; ++eb) { Sf[eb][0] = ldfrag(STc, 16 * eb + fr, 8 * fq); Sf[eb][1] = ldfrag(STc, 16 * eb + fr, 32 + 8 * fq); }
#pragma unroll
              for (int eb = 0; eb < 4; ++eb) yacc[eb] = MFMA16(Sf[eb][0], Qf[0], ((pg8::f32x4){0.f, 0.f, 0.f, 0.f}));
#pragma unroll
              for (int eb = 0; eb < 4; ++eb) yacc[eb] = MFMA16(Sf[eb][1], Qf[1], yacc[eb]); }
#pragma unroll
            for (int eb = 0; eb < 4; ++eb) yacc[eb] *= egl_y;
#pragma unroll
            for (int sp2 = 0; sp2 < 2; ++sp2) if (2 * sp2 <= lb) { bf16x4 Va[4][2];
#pragma unroll
                for (int eb = 0; eb < 4; ++eb)
#pragma unroll
                    for (int s2 = 0; s2 < 2; ++s2) if (2 * sp2 + s2 <= lb) Va[eb][s2] = tr4(sp + W2_V + (16 * (2 * sp2 + s2) + 4 * fq + (fr >> 2)) * (PT * 2) + (16 * eb + 4 * (fr & 3)) * 2);
#pragma unroll
                for (int s2 = 0; s2 < 2; ++s2) if (2 * sp2 + s2 <= lb) {
#pragma unroll
                    for (int eb = 0; eb < 4; ++eb) yacc[eb] = MFMA16K16(Va[eb][s2], Pb[2 * sp2 + s2], yacc[eb]); } }
#pragma unroll
            for (int eb = 0; eb < 4; ++eb) { v2u o; o.x = pk2(yacc[eb][0], yacc[eb][1]); o.y = pk2(yacc[eb][2], yacc[eb][3]);
                *(LAS v2u*)(YTc + (16 * lb + fr) * (PT * 2) + (16 * eb + 4 * fq) * 2) = o; }
        } else { const int db = wave - 4;
            const float glast = Gv[63], egl = __expf(glast);
            bf16x8 Kr[2], Vf[4][2]; pg8::f32x4 g0[2], g1[2], d0[2], d1[2];
#pragma unroll
            for (int ks = 0; ks < 2; ++ks) { Kr[ks] = trfrag(sp + W2_K, 32 * ks + 8 * fq, 16 * db, fr);
                g0[ks] = *(const LAS pg8::f32x4*)(Gv + 32 * ks + 8 * fq); g1[ks] = *(const LAS pg8::f32x4*)(Gv + 32 * ks + 8 * fq + 4);
                d0[ks] = (pg8::f32x4){1.f, 1.f, 1.f, 1.f}; d1[ks] = d0[ks];
                if (KIND == 1) { d0[ks] = *(const LAS pg8::f32x4*)(Dv + 32 * ks + 8 * fq); d1[ks] = *(const LAS pg8::f32x4*)(Dv + 32 * ks + 8 * fq + 4); } }
#pragma unroll
            for (int eb = 0; eb < 4; ++eb) { Vf[eb][0] = trfrag(sp + W2_V, 8 * fq, 16 * eb, fr); Vf[eb][1] = trfrag(sp + W2_V, 32 + 8 * fq, 16 * eb, fr); }
            bf16x8 Kf[2];
#pragma unroll
            for (int ks = 0; ks < 2; ++ks) { float kf[8];
#pragma unroll
                for (int j = 0; j < 4; ++j) { kf[j] = bfs(Kr[ks][j]) * __expf(glast - g0[ks][j]) * d0[ks][j]; kf[4 + j] = bfs(Kr[ks][4 + j]) * __expf(glast - g1[ks][j]) * d1[ks][j]; }
                const v4u kw = pk8(kf); Kf[ks] = __builtin_bit_cast(bf16x8, kw); }
#pragma unroll
            for (int eb = 0; eb < 4; ++eb) sacc[eb] = MFMA16(Kf[0], Vf[eb][0], sacc[eb] * egl);
#pragma unroll
            for (int eb = 0; eb < 4; ++eb) sacc[eb] = MFMA16(Kf[1], Vf[eb][1], sacc[eb]);
#pragma unroll
            for (int eb = 0; eb < 4; ++eb) { v2u o; o.x = pk2(sacc[eb][0], sacc[eb][1]); o.y = pk2(sacc[eb][2], sacc[eb][3]);
                *(LAS v2u*)(STn + (16 * eb + fr) * (PT * 2) + (16 * db + 4 * fq) * 2) = o; }
        }
        if (grp == ((c + 1) & 1)) { if (c + 1 < SEQ / 64) W2_STORE(c + 1, z3n); if (c + 3 < SEQ / 64) W2_FETCH(c + 3); }
        LBAR();
        {
            float y[8], zf[8]; unpk8(*(const LAS v4u*)(YTc + prow * (PT * 2) + pcg * 16), y); unpk8(*(const LAS v4u*)(lds + W2_ZT + z3 * 8192 + prow * 128 + pcg * 16), zf);
            const size_t row = tok0 + (size_t)c * 64 + prow;
            float ss = 0.f;
            if (KIND == 1) {
#pragma unroll
                for (int j = 0; j < 8; ++j) { y[j] = y[j] * siluf(zf[j]); ss += y[j] * y[j]; }
                ss = sum8(ss);
                if (pcg == 0 && !pm) SM[row * SM_LD + 16 + h] = ss;
            } else {
#pragma unroll
                for (int j = 0; j < 8; ++j) ss += y[j] * y[j];
                ss = sum8(ss);
                const float rstd = rsqrtf(ss * (1.0f / 64.0f) + 1e-6f);
#pragma unroll
                for (int j = 0; j < 8; ++j) y[j] = y[j] * rstd * siluf(zf[j]); }
            if (!pm || y[0] == 1234.567f) *(GAS v4u*)(ZB + row * ZB_LD + zc0 + pcg * 8) = pk8(y);
        }
        z3 = z3n;
    }
#undef W2_FETCH
#undef W2_ROT
#undef W2_STORE
}

constexpr int SP_RAW = 0, SP_CW = 67 * 1536, SP_END = SP_CW + 5 * 768 * 4;
static_assert(SP_END <= RING_BYTES, "ssd_prep LDS");
__device__ __forceinline__ void ssd_prep(const __attribute__((address_space(4))) Args* kp, int layer, LAS unsigned char* lds, int G_) {
    int tid = threadIdx.x; asm volatile("" : "+v"(tid));
    const int lane = tid & 63, wave = __builtin_amdgcn_readfirstlane(tid >> 6);
    unsigned char* ws = kp->ws;
    bf16* MIX = (bf16*)(ws + WS_MIX); float* SM = (float*)(ws + WS_SM);
    const bf16* HALO = (const bf16*)(ws + ((layer & 1) ? WS_XB0 : WS_XB1) + HALO_OFF);
    LAS float* CW = (LAS float*)(lds + SP_CW);
    { const float* cw = kp->in[8] + (size_t)layer * 4 * 768; const float* cb = kp->in[9] + (size_t)layer * 768;
      for (int i = tid; i < 768; i += 512) { CW[i] = cw[i]; CW[768 + i] = cw[768 + i]; CW[2 * 768 + i] = cw[2 * 768 + i]; CW[3 * 768 + i] = cw[3 * 768 + i]; CW[4 * 768 + i] = cb[i]; } }
    const float Aexp = expf(kp->in[10][layer * 8 + wave]), dtb = kp->in[11][layer * 8 + wave];
    for (int unit = blockIdx.x; unit < NBATCH * 64; unit += G_) { const int b = unit >> 6, c = unit & 63; const size_t tok0 = (size_t)b * SEQ + (size_t)c * 64;
        LBAR();
        for (int i = tid; i < 67 * 96; i += 512) { const int r = i / 96, pc = i - r * 96; v4u v = (v4u){0u, 0u, 0u, 0u};
            if (r >= 3) v = *(const GAS v4u*)(MIX + mixh(MX_BX + pc * 8, tok0 + r - 3));
            else if (c > 0) v = *(const GAS v4u*)(HALO + ((size_t)(b * 64 + c - 1) * 3 + r) * HALO_LD + MX_BX + pc * 8);
            *(LAS v4u*)(lds + SP_RAW + r * 1536 + pc * 16) = v; }
        { const size_t r2 = tok0 + lane; const float dt = softplusf(SM[r2 * SM_LD + 16 + wave] + dtb); float gs = -Aexp * dt;
#pragma unroll
          for (int o = 1; o < 64; o <<= 1) { const float t_ = __shfl_up(gs, o); if (lane >= o) gs += t_; }
          SM[r2 * SM_LD + 16 + wave] = gs; SM[r2 * SM_LD + 24 + wave] = dt; }
        LBAR();
        for (int i = tid; i < 64 * 96; i += 512) { const int l = i / 96, pc = i - l * 96; float a[8];
            { const pg8::f32x4 b0 = *(const LAS pg8::f32x4*)(CW + 4 * 768 + pc * 8), b1 = *(const LAS pg8::f32x4*)(CW + 4 * 768 + pc * 8 + 4);
              a[0] = b0[0]; a[1] = b0[1]; a[2] = b0[2]; a[3] = b0[3]; a[4] = b1[0]; a[5] = b1[1]; a[6] = b1[2]; a[7] = b1[3]; }
#pragma unroll
            for (int k = 0; k < 4; ++k) { float f[8]; unpk8(*(const LAS v4u*)(lds + SP_RAW + (l + k) * 1536 + pc * 16), f);
                const pg8::f32x4 w0 = *(const LAS pg8::f32x4*)(CW + k * 768 + pc * 8), w1 = *(const LAS pg8::f32x4*)(CW + k * 768 + pc * 8 + 4);
#pragma unroll
                for (int j = 0; j < 4; ++j) { a[j] += w0[j] * f[j]; a[4 + j] += w1[j] * f[4 + j]; } }
#pragma unroll
            for (int j = 0; j < 8; ++j) a[j] = siluf(a[j]);
            *(GAS v4u*)(MIX + mixh(MX_BX + pc * 8, tok0 + l)) = pk8(a); }
    }
    LBAR();
}
constexpr int GQ_RAW = 0, GQ_KN = 67 * 384, GQ_VN = GQ_KN + MAT, GQ_NA = GQ_VN + MAT, GQ_AD = GQ_NA + MAT, GQ_S = GQ_AD + 4 * 16 * 20 * 4, GQ_CW = GQ_S + 512, GQ_TEAM = GQ_CW + 4 * 192 * 4;
static_assert(2 * GQ_TEAM <= RING_BYTES && 2 * MAT <= GQ_KN, "gdn_prep LDS");
__device__ __forceinline__ void gdn_prep(const __attribute__((address_space(4))) Args* kp, int layer, LAS unsigned char* lds_all, int G_) {
    int tid = threadIdx.x; asm volatile("" : "+v"(tid));
    const int team = __builtin_amdgcn_readfirstlane(tid >> 8), j = tid & 255, lane = tid & 63, tw = __builtin_amdgcn_readfirstlane((tid >> 6) & 3), fr = lane & 15, fq = lane >> 4;
    LAS unsigned char* lds = lds_all + team * GQ_TEAM;
    LAS float* AD = (LAS float*)(lds + GQ_AD); LAS float* Gs = (LAS float*)(lds + GQ_S); LAS float* Bs = Gs + 64; LAS float* CW = (LAS float*)(lds + GQ_CW);
    unsigned char* ws = kp->ws;
    bf16* MIX = (bf16*)(ws + WS_MIX); float* SM = (float*)(ws + WS_SM);
    unsigned char* xbf = ws + ((layer & 1) ? WS_XB0 : WS_XB1); bf16* GW = (bf16*)(xbf + GW_OFF); const bf16* HALO = (const bf16*)(xbf + HALO_OFF);
    const float* cw = kp->in[4] + (size_t)layer * 4 * 1536;
    v4u praw[7]; float pcw[3], pbl = 0.f, pal = 0.f;
#define GQ_FETCH(rnd) do { const int u_ = ((rnd) * G_ + (int)blockIdx.x) * 2 + team; const int un_ = u_ < NBATCH * 8 * 64 ? u_ : 0; \
        const int c_ = un_ & 63, h_ = (un_ >> 6) & 7, b_ = un_ >> 9; const size_t tk_ = (size_t)b_ * SEQ + (size_t)c_ * 64; \
        _Pragma("unroll") for (int n = 0; n < 7; ++n) { const int i = j + 256 * n; praw[n] = (v4u){0u, 0u, 0u, 0u}; \
            if (i < 67 * 24) { const int r = i / 24, pc = i - r * 24, col = (pc >> 3) * 512 + h_ * 64 + (pc & 7) * 8; \
                if (r >= 3) praw[n] = *(const GAS v4u*)(MIX + mixh(col, tk_ + r - 3)); \
                else if (c_ > 0) praw[n] = *(const GAS v4u*)(HALO + ((size_t)(b_ * 64 + c_ - 1) * 3 + r) * HALO_LD + col); } } \
        _Pragma("unroll") for (int n = 0; n < 3; ++n) { const int i = j + 256 * n, k = i / 192, cc = i - k * 192; pcw[n] = cw[k * 1536 + (cc >> 6) * 512 + h_ * 64 + (cc & 63)]; } \
        if (tw == 0) { pbl = SM[(tk_ + lane) * SM_LD + h_]; pal = SM[(tk_ + lane) * SM_LD + 8 + h_]; } } while (0)
    GQ_FETCH(0);
    const int nrounds = (NBATCH * 8 * 64 + 2 * G_ - 1) / (2 * G_);
    for (int round = 0; round < nrounds; ++round) {
        const int unit_ = (round * G_ + (int)blockIdx.x) * 2 + team;
        const bool live = unit_ < NBATCH * 8 * 64;
        const int unit = live ? unit_ : 0;
        const int c = unit & 63, h = (unit >> 6) & 7, b = unit >> 9;
        const size_t tok0 = (size_t)b * SEQ + (size_t)c * 64;
        LBAR();
#pragma unroll
        for (int n = 0; n < 7; ++n) { const int i = j + 256 * n; if (i < 67 * 24) { const int r = i / 24, pc = i - r * 24; *(LAS v4u*)(lds + GQ_RAW + r * 384 + pc * 16) = praw[n]; } }
#pragma unroll
        for (int n = 0; n < 3; ++n) CW[j + 256 * n] = pcw[n];
        if (tw == 0) {
            float gsum = -expf(kp->in[5][layer * 8 + h]) * softplusf(pal + kp->in[6][layer * 8 + h]);
#pragma unroll
            for (int o = 1; o < 64; o <<= 1) { const float t_ = __shfl_up(gsum, o); if (lane >= o) gsum += t_; }
            Gs[lane] = gsum; Bs[lane] = sigmf(pbl);
            if (live) SM[(tok0 + lane) * SM_LD + 8 + h] = gsum; }
        if (round + 1 < nrounds) GQ_FETCH(round + 1);
        LBAR();
#pragma unroll 1
        for (int n = 0; n < 3; ++n) { const int i = j + 256 * n, t2 = i / 24, pc = i - t2 * 24, tens = pc >> 3, ch = pc & 7; float a0[8], a1[8];
#pragma unroll
            for (int jj = 0; jj < 8; ++jj) { a0[jj] = 0.f; a1[jj] = 0.f; }
            pg8::f32x4 wl[4], wh[4];
#pragma unroll
            for (int k = 0; k < 4; ++k) { wl[k] = *(const LAS pg8::f32x4*)(CW + k * 192 + pc * 8); wh[k] = *(const LAS pg8::f32x4*)(CW + k * 192 + pc * 8 + 4); }
#pragma unroll
            for (int r = 0; r < 5; ++r) { float f[8]; unpk8(*(const LAS v4u*)(lds + GQ_RAW + (2 * t2 + r) * 384 + pc * 16), f);
                if (r < 4) {
#pragma unroll
                    for (int jj = 0; jj < 4; ++jj) { a0[jj] += wl[r][jj] * f[jj]; a0[4 + jj] += wh[r][jj] * f[4 + jj]; } }
                if (r > 0) {
#pragma unroll
                    for (int jj = 0; jj < 4; ++jj) { a1[jj] += wl[r - 1][jj] * f[jj]; a1[4 + jj] += wh[r - 1][jj] * f[4 + jj]; } } }
            float s0 = 0.f, s1 = 0.f;
#pragma unroll
            for (int jj = 0; jj < 8; ++jj) { a0[jj] = siluf(a0[jj]); a1[jj] = siluf(a1[jj]); s0 += a0[jj] * a0[jj]; s1 += a1[jj] * a1[jj]; }
            s0 = sum8(s0); s1 = sum8(s1);
            const float base = tens == 0 ? 0.125f : 1.0f, c0 = tens == 2 ? 1.0f : rsqrtf(s0 + 1e-6f) * base, c1 = tens == 2 ? 1.0f : rsqrtf(s1 + 1e-6f) * base;
#pragma unroll
            for (int jj = 0; jj < 8; ++jj) { a0[jj] *= c0; a1[jj] *= c1; }
            const v4u o0 = pk8(a0), o1 = pk8(a1); const int t = 2 * t2;
            if (tens == 0) { if (live) { *(GAS v4u*)(MIX + mixh(MX_AQ + h * 64 + ch * 8, tok0 + t)) = o0; *(GAS v4u*)(MIX + mixh(MX_AQ + h * 64 + ch * 8, tok0 + t + 1)) = o1; } }
            else if (tens == 1) { *(LAS v4u*)(lds + GQ_KN + t * (PT * 2) + ch * 16) = o0; *(LAS v4u*)(lds + GQ_KN + (t + 1) * (PT * 2) + ch * 16) = o1;
                if (live) { *(GAS v4u*)(MIX + mixh(MX_AK + h * 64 + ch * 8, tok0 + t)) = o0; *(GAS v4u*)(MIX + mixh(MX_AK + h * 64 + ch * 8, tok0 + t + 1)) = o1; } }
            else { *(LAS v4u*)(lds + GQ_VN + t * (PT * 2) + ch * 16) = o0; *(LAS v4u*)(lds + GQ_VN + (t + 1) * (PT * 2) + ch * 16) = o1; } }
        LBAR();
        for (int id = tw; id < 10; id += 4) { const int lb = id < 1 ? 0 : (id < 3 ? 1 : (id < 6 ? 2 : 3)), sb = id - (lb * (lb + 1)) / 2;
            pg8::f32x4 acc = (pg8::f32x4){0.f, 0.f, 0.f, 0.f};
#pragma unroll
            for (int ks = 0; ks < 2; ++ks) acc = MFMA16(ldfrag(lds + GQ_KN, 16 * lb + fr, 32 * ks + 8 * fq), ldfrag(lds + GQ_KN, 16 * sb + fr, 32 * ks + 8 * fq), acc);
            const int s = 16 * sb + fr; const float gsv = Gs[s];
#pragma unroll
            for (int r = 0; r < 4; ++r) { const int l = 16 * lb + 4 * fq + r; const float v = s < l ? Bs[l] * acc[r] * __expf(Gs[l] - gsv) : 0.f;
                if (lb == sb) AD[(lb * 16 + 4 * fq + r) * 20 + fr] = v;
                else *(LAS bf16*)(lds + GQ_NA + l * (PT * 2) + s * 2) = (bf16)f2bf(-v); } }
        LBAR();
        if (tw == 0) { const int bi = lane >> 4, cc = lane & 15; const LAS float* Ab = AD + bi * 16 * 20; float x[16];
#pragma unroll
            for (int r = 0; r < 16; ++r) { float a = (r == cc) ? 1.0f : 0.0f;
#pragma unroll
                for (int s4 = 0; s4 < r; s4 += 4) { const pg8::f32x4 av = *(const LAS pg8::f32x4*)(Ab + r * 20 + s4);
                    a -= av[0] * x[s4];
                    if (s4 + 1 < r) a -= av[1] * x[s4 + 1];
                    if (s4 + 2 < r) a -= av[2] * x[s4 + 2];
                    if (s4 + 3 < r) a -= av[3] * x[s4 + 3]; }
                x[r] = a; }
#pragma unroll
            for (int r = 0; r < 16; ++r) *(LAS bf16*)(lds + GQ_NA + (16 * bi + r) * (PT * 2) + (16 * bi + cc) * 2) = (bf16)f2bf(x[r]); }
        LBAR();
#pragma unroll 1
        for (int half = 0; half < 2; ++half) { LAS unsigned char* src = lds + (half == 0 ? GQ_VN : GQ_KN); const int c0 = 16 * tw;
            pg8::f32x4 R[4], X[4];
#pragma unroll
            for (int i = 0; i < 4; ++i) { const s16x4 raw = tr4(src + (16 * i + 4 * fq + (fr >> 2)) * (PT * 2) + (c0 + 4 * (fr & 3)) * 2);
                const pg8::f32x4 bv = *(const LAS pg8::f32x4*)(Bs + 16 * i + 4 * fq); pg8::f32x4 sc = bv;
                if (half == 1) { const pg8::f32x4 gv = *(const LAS pg8::f32x4*)(Gs + 16 * i + 4 * fq); sc = (pg8::f32x4){bv[0] * __expf(gv[0]), bv[1] * __expf(gv[1]), bv[2] * __expf(gv[2]), bv[3] * __expf(gv[3])}; }
                R[i] = (pg8::f32x4){bfs(raw[0]) * sc[0], bfs(raw[1]) * sc[1], bfs(raw[2]) * sc[2], bfs(raw[3]) * sc[3]}; }
#define NAF(ib, jb) (*(const LAS bf16x4*)(lds + GQ_NA + (16 * (ib) + fr) * (PT * 2) + (16 * (jb) + 4 * fq) * 2))
            const pg8::f32x4 Z = (pg8::f32x4){0.f, 0.f, 0.f, 0.f};
            X[0] = MFMA16K16(NAF(0, 0), pk4(R[0]), Z);
            { const bf16x4 x0 = pk4(X[0]); R[1] = MFMA16K16(NAF(1, 0), x0, R[1]); R[2] = MFMA16K16(NAF(2, 0), x0, R[2]); R[3] = MFMA16K16(NAF(3, 0), x0, R[3]); }
            X[1] = MFMA16K16(NAF(1, 1), pk4(R[1]), Z);
            { const bf16x4 x1 = pk4(X[1]); R[2] = MFMA16K16(NAF(2, 1), x1, R[2]); R[3] = MFMA16K16(NAF(3, 1), x1, R[3]); }
            X[2] = MFMA16K16(NAF(2, 2), pk4(R[2]), Z);
            { const bf16x4 x2 = pk4(X[2]); R[3] = MFMA16K16(NAF(3, 2), x2, R[3]); }
            X[3] = MFMA16K16(NAF(3, 3), pk4(R[3]), Z);
#undef NAF
#pragma unroll
            for (int i = 0; i < 4; ++i)
#pragma unroll
                for (int r = 0; r < 4; ++r) *(LAS bf16*)(lds + GQ_RAW + half * MAT + (16 * i + 4 * fq + r) * (PT * 2) + (c0 + fr) * 2) = (bf16)f2bf(X[i][r]);
        }
        LBAR();
        if (live) for (int i = j; i < 64 * 16; i += 256) { const int t = (i >> 3) & 63, ch = i & 7, half = i >> 9;
            const v4u v = *(const LAS v4u*)(lds + GQ_RAW + half * MAT + t * (PT * 2) + ch * 16);
            if (half == 0) *(GAS v4u*)(MIX + mixh(MX_AV + h * 64 + ch * 8, tok0 + t)) = v; else *(GAS v4u*)(GW + gwh(h, ch * 8, tok0 + t)) = v; }
    }
    LBAR();
}
#ifndef MK_ONE_LAUNCH
#define MK_ONE_LAUNCH 1
#endif
#define CONVERT_LAYER(L_, WB_) do { \
            int ibase = 0; \
            const float* w_in = kp->in[3] + (size_t)(L_) * DM * NIN; const float* nmix = kp->in[2] + (size_t)(L_) * DM; \
            TR_SEG(w_in, NIN, 1536, 512, DM, nmix, (bf16*)((WB_) + (W_1T - WS_W)), DM, 0, 0); \
            TR_SEG(w_in, NIN, 2064, 512, DM, nmix, (bf16*)((WB_) + (W_1T - WS_W)), DM, 512, 0); \
            TR_SEG(w_in, NIN, 4888, 512, DM, nmix, (bf16*)((WB_) + (W_1T - WS_W)), DM, 1024, 0); \
            TR_SEG(w_in, NIN, 0, 1536, DM, nmix, (bf16*)((WB_) + (W_1T - WS_W)), DM, 1536, 0); \
            TR_SEG(w_in, NIN, 2576, 768, DM, nmix, (bf16*)((WB_) + (W_1T - WS_W)), DM, 3072, 0); \
            TR_SEG(w_in, NIN, 3352, 1536, DM, nmix, (bf16*)((WB_) + (W_1T - WS_W)), DM, 3840, 0); \
            TR_SEG(w_in, NIN, 2048, 16, DM, nmix, (bf16*)((WB_) + (W_1T - WS_W)), DM, 5376, 0); \
            TR_SEG(w_in, NIN, 3344, 8, DM, nmix, (bf16*)((WB_) + (W_1T - WS_W)), DM, 5392, 0); \
            TR_SEG((const float*)nullptr, NIN, 0, 232, DM, (const float*)nullptr, (bf16*)((WB_) + (W_1T - WS_W)), DM, 5400, 0); \
            TR_SEG(w_in, NIN, 5400, 3072, DM, nmix, (bf16*)((WB_) + (W_GT - WS_W)), DM, 0, 0); \
            const float* wbr = kp->in[14] + (size_t)(L_) * 3 * 512 * DM; \
            TR_SEG(wbr, DM, 0, DM, 512, (const float*)nullptr, (bf16*)((WB_) + (W_MT - WS_W)), KMERGE, 0, 0); \
            TR_SEG(wbr + 512 * DM, DM, 0, DM, 512, kp->in[13] + (size_t)(L_) * 512, (bf16*)((WB_) + (W_MT - WS_W)), KMERGE, 0, 512); \
            TR_SEG(wbr + 2 * 512 * DM, DM, 0, DM, 512, (const float*)nullptr, (bf16*)((WB_) + (W_MT - WS_W)), KMERGE, 0, 1024); \
            TR_SEG(kp->in[15] + (size_t)(L_) * DM * DM, DM, 0, DM, DM, (const float*)nullptr, (bf16*)((WB_) + (W_OT - WS_W)), DM, 0, 0); \
            TR_SEG(kp->in[17] + (size_t)(L_) * DM * DFF, DFF, 0, DFF, DM, kp->in[16] + (size_t)(L_) * DM, (bf16*)((WB_) + (W_UT - WS_W)), DM, 0, 0); \
            TR_SEG(kp->in[18] + (size_t)(L_) * DFF * DM, DM, 0, DM, DFF, (const float*)nullptr, (bf16*)((WB_) + (W_DT - WS_W)), DFF, 0, 0); \
            TR_SEG(kp->in[20] + (size_t)(L_) * DM * DM, DM, 0, DM, DM, kp->in[19] + (size_t)(L_) * DM, (bf16*)((WB_) + (W_PGT - WS_W)), DM, 0, 0); \
            TR_SEG(kp->in[21] + (size_t)(L_) * PLED * DM, DM, 0, DM, PLED, (const float*)nullptr, (bf16*)((WB_) + (W_PPT - WS_W)), PLED, 0, 0); \
        } while (0)
__global__ void __launch_bounds__(512, 2) fwd_kernel(Args args) {
    extern __shared__ __attribute__((aligned(16))) unsigned char lds_raw[];
    LAS unsigned char* lds0 = (LAS unsigned char*)lds_raw;
    volatile LAS unsigned* MISC = (volatile LAS unsigned*)(lds0 + MISC_OFF);
    const int G = gridDim.x, NGW = G * 8;
    unsigned char* ws0 = args.ws;
    for (int u = threadIdx.x; u < (LDS_BYTES - RING_BYTES) / 4; u += 512) ((LAS unsigned*)(lds0 + RING_BYTES))[u] = 0u;
    __syncthreads();
#if MK_ONE_LAUNCH
    XcdBarrier bar = xcd_barrier_post((unsigned*)(ws0 + WS_CTL) + 4096, MISC + 8);
#define GRID_BAR() do { XcdBarrier b_ = bar; asm volatile("" : "+s"(b_.bar), "+s"(b_.x)); xcd_barrier(b_); } while (0)
#else
#define GRID_BAR() do {} while (0)
#endif
    const int lo = args.ph_lo, hi = args.ph_hi;
#define IN(p) (lo <= (p) && (p) < hi)
#define SEAM(p) do { if (IN(p) && IN((p) + 1)) GRID_BAR(); } while (0)
    typedef const __attribute__((address_space(4))) Args* KArgs;
    const KArgs kp0 = (KArgs)__builtin_amdgcn_kernarg_segment_ptr();
#define PHASE_PTRS() KArgs kp = kp0; asm volatile("" : "+s"(kp)); unsigned char* ws = kp->ws; float* X = kp->out; (void)X; \
    LAS unsigned char* lds = lds0; \
    int tid = threadIdx.x; asm volatile("" : "+v"(tid)); int bx = blockIdx.x; asm volatile("" : "+s"(bx)); const int lane = tid & 63, wave = __builtin_amdgcn_readfirstlane(tid >> 6), gw = bx * 8 + wave; (void)lane; (void)gw; \
    bf16* ZB = (bf16*)(ws + WS_ZB); bf16* MIX = (bf16*)(ws + WS_MIX); float* SM = (float*)(ws + WS_SM); (void)ZB; (void)MIX; (void)SM; \
    unsigned char* wbase = (layer & 1) ? (unsigned char*)X + 80 * MiB : ws + WS_W;     \
    float* SSQA = (float*)(wbase + (WS_SSQA - WS_W)); float* SSQB = (float*)(wbase + (WS_SSQB - WS_W)); float* SSQC = (float*)(ws + WS_SSQC); float* ROPE = (float*)(ws + WS_ROPE); (void)SSQA; (void)SSQB; (void)SSQC; (void)ROPE; \
    bf16* W1T = (bf16*)(wbase + (W_1T - WS_W)); bf16* WGT = (bf16*)(wbase + (W_GT - WS_W)); bf16* WMT = (bf16*)(wbase + (W_MT - WS_W)); bf16* WOT = (bf16*)(wbase + (W_OT - WS_W)); bf16* WUT = (bf16*)(wbase + (W_UT - WS_W)); (void)W1T; (void)WGT; (void)WMT; (void)WOT; (void)WUT; \
    bf16* WDT = (bf16*)(wbase + (W_DT - WS_W)); bf16* WPGT = (bf16*)(wbase + (W_PGT - WS_W)); bf16* WPPT = (bf16*)(wbase + (W_PPT - WS_W)); (void)WDT; (void)WPGT; (void)WPPT; \
    bf16* GATE = (bf16*)(ws + WS_GATE); bf16* U = (bf16*)(ws + WS_U); bf16* PB = (bf16*)X; bf16* PLE = (bf16*)X + (size_t)MTOK * PLED;     (void)GATE; (void)U; (void)PB; (void)PLE; \
    bf16* XBl = (bf16*)(ws + ((layer & 1) ? WS_XB1 : WS_XB0)); bf16* XBf = (bf16*)(ws + ((layer & 1) ? WS_XB0 : WS_XB1)); (void)XBl; (void)XBf
    if (IN(0)) { const int layer = 0; PHASE_PTRS();
        for (int e = bx * 512 + tid; e < SEQ * 32; e += G * 512) { const int t = e >> 5, i = e & 31;
            double f = 1.0; for (int j = 0; j < i; ++j) f *= 0.7429639507594948;
            const double ang = (double)t * f, kk = rint(ang * 0.15915494309189535);
            double r = fma(-kk, 6.283185307179586, ang); r = fma(-kk, 2.4492935982947064e-16, r); const double r2 = r * r;
            double sn = 1.0, cs = 1.0;
    #pragma unroll
            for (int n = 15; n >= 1; --n) { sn = 1.0 - r2 * (1.0 / (double)((2 * n) * (2 * n + 1))) * sn; cs = 1.0 - r2 * (1.0 / (double)((2 * n - 1) * (2 * n))) * cs; }
            ROPE[e] = (float)cs; ROPE[SEQ * 32 + e] = (float)(r * sn); }
    }
    for (int layer = 0; layer < DEPTH; ++layer) {
        const int P = layer * NPH;
        if (IN(P + 0)) { PHASE_PTRS();
            if (layer == 0 || G <= 192) CONVERT_LAYER(layer, wbase);
            if (layer == 0) {
                const float* xin = kp->in[0];
                for (int m0 = gw; m0 < MTOK; m0 += 2 * NGW) {
                    const bool two = m0 + NGW < MTOK; const int m1 = two ? m0 + NGW : m0;
                    const GAS f32x4* xr0 = (const GAS f32x4*)(xin + (size_t)m0 * DM) + lane; const GAS f32x4* xr1 = (const GAS f32x4*)(xin + (size_t)m1 * DM) + lane; f32x4 v[2][4]; float s0 = 0.f, s1 = 0.f;
#pragma unroll
                    for (int j = 0; j < 4; ++j) { v[0][j] = xr0[64 * j]; v[1][j] = xr1[64 * j]; }
#pragma unroll
                    for (int j = 0; j < 4; ++j) { s0 += (v[0][j].x * v[0][j].x + v[0][j].y * v[0][j].y) + (v[0][j].z * v[0][j].z + v[0][j].w * v[0][j].w);
                                                  s1 += (v[1][j].x * v[1][j].x + v[1][j].y * v[1][j].y) + (v[1][j].z * v[1][j].z + v[1][j].w * v[1][j].w); }
#pragma unroll
                    for (int o = 1; o < 64; o <<= 1) { s0 += __shfl_xor(s0, o); s1 += __shfl_xor(s1, o); }
                    GAS v2u* o0 = (GAS v2u*)(XBl + (size_t)m0 * DM) + lane; GAS v2u* o1 = (GAS v2u*)(XBl + (size_t)m1 * DM) + lane;
#pragma unroll
                    for (int j = 0; j < 4; ++j) { v2u w; w.x = pk2(v[0][j].x, v[0][j].y); w.y = pk2(v[0][j].z, v[0][j].w); o0[64 * j] = w; }
                    if (lane < 16) SSQC[(size_t)m0 * 16 + lane] = lane == 0 ? s0 : 0.f;
                    if (two) {
#pragma unroll
                        for (int j = 0; j < 4; ++j) { v2u w; w.x = pk2(v[1][j].x, v[1][j].y); w.y = pk2(v[1][j].z, v[1][j].w); o1[64 * j] = w; }
                        if (lane < 16) SSQC[(size_t)m1 * 16 + lane] = lane == 0 ? s1 : 0.f; }
                }
            }
        }
        if (layer == 0 || G <= 192) SEAM(P + 0);
        if (IN(P + 1)) { PHASE_PTRS();
            pg8::Gemm g{XBl, W1T, MTOK, N1, DM}; pg8::StaticOrder S; S.init(MTOK, N1, G, bx);
            build_rs_table(S, SSQC, lds, tid);
            pg8::EpiP1 E{ZB, MIX, SM, lds + RS_OFF, (bf16*)((unsigned char*)XBf + HALO_OFF),  0u};
            pg8::gemm_phase<pg8::EpiP1, pg8::StaticOrder, true, true>(lds, g, S, E);
        }
        SEAM(P + 1);
        if (IN(P + 2)) { PHASE_PTRS();
            gdn_prep(kp, layer, lds, G);
            ssd_prep(kp, layer, lds, G);
            const float* pl = kp->in[1] + (size_t)layer * MTOK * PLED;
            for (size_t e = (size_t)bx * 512 + tid; e < (size_t)MTOK * PLED / 4; e += (size_t)G * 512) { const f32x4 v = ((const GAS f32x4*)pl)[e]; v2u w; w.x = pk2(v.x, v.y); w.y = pk2(v.z, v.w); ((GAS v2u*)PB)[e] = w; }
        }
        SEAM(P + 2);
        if (IN(P + 3)) { PHASE_PTRS();
            for (int w = bx; w < 192; w += G) { const int kind = w >> 6, b = (w & 63) >> 3, h = w & 7;
                if (kind == 0) mixer_walk<0>(kp, layer, b, h, lds);
                else if (kind == 1) mixer_walk2<1>(kp, layer, b, h, lds);
                else mixer_walk2<2>(kp, layer, b, h, lds);
                __syncthreads(); }
            if (layer == 0 && bx >= 192 && G > 192) {
                const int bx_ = bx, G_ = G; { const int bx = bx_ - 192, G = G_ - 192; CONVERT_LAYER(1, (unsigned char*)X + 80 * MiB); }
            } else if ((bx >= 192 || G <= 192) && !(layer == 0 && G > 192)) {
                pg8::Gemm g{PB, WPPT, MTOK / 2, DM, PLED}; pg8::StaticOrder S; if (G > 192) S.init(MTOK / 2, DM, G - 192, bx - 192); else S.init(MTOK / 2, DM, G, bx);
                pg8::EpiRS<0> E{PLE, DM, (LAS unsigned char*)nullptr};
                pg8::gemm_phase<pg8::EpiRS<0>, pg8::StaticOrder, true, true>(lds, g, S, E); }
        }
        SEAM(P + 3);
        if (IN(P + 4)) { PHASE_PTRS();
            for (int m = bx * 512 + tid; m < MTOK; m += G * 512) {
                float* sp = SM + (size_t)m * SM_LD + 16; const f32x4 q0 = *(const f32x4*)sp, q1 = *(const f32x4*)(sp + 4);
                const float v0 = ((q0[0] + q0[1]) + (q0[2] + q0[3])) * (1.0f / 256.0f) + 1e-6f, v1 = ((q1[0] + q1[1]) + (q1[2] + q1[3])) * (1.0f / 256.0f) + 1e-6f;
                const float r0 = __builtin_amdgcn_sqrtf(v0), s1 = __builtin_amdgcn_rsqf(v1);
                *(f32x4*)(sp + 8) = (f32x4){r0, __builtin_amdgcn_rsqf(v0) * __builtin_amdgcn_sqrtf(v1), s1, 0.f}; }
            pg8::Gemm g{XBl, WGT, MTOK, NGATE, DM}; pg8::StaticOrder S; S.init(MTOK, NGATE, G, bx);
            build_rs_table(S, SSQC, lds, tid);
            pg8::EpiRS<2> E{GATE, NGATE, lds + RS_OFF};
            pg8::gemm_phase<pg8::EpiRS<2>, pg8::StaticOrder, true, true>(lds, g, S, E);
        }
        SEAM(P + 4);
        if (IN(P + 5)) { PHASE_PTRS();
            pg8::Gemm g{ZB, WMT, MTOK, DM, KMERGE}; pg8::StaticOrder S; S.init(MTOK, DM, G, bx);
            pg8::EpiMerge E{GATE, XBf, SM};
            pg8::gemm_phase<pg8::EpiMerge, pg8::StaticOrder, true, true>(lds, g, S, E);
        }
        SEAM(P + 5);
        if (IN(P + 6)) { PHASE_PTRS();
            pg8::Gemm g{XBf, WOT, MTOK, DM, DM}; pg8::StaticOrder S; S.init(MTOK, DM, G, bx);
            pg8::EpiResid<0> E{XBl, XBl, SSQA, (LAS unsigned char*)nullptr, nullptr,  1.0f};
            pg8::gemm_phase<pg8::EpiResid<0>, pg8::StaticOrder, true, true>(lds, g, S, E);
        }
        SEAM(P + 6);
        if (IN(P + 7)) { PHASE_PTRS();
            { pg8::Gemm g{XBl, WUT, MTOK, DFF, DM}; pg8::StaticOrder S; S.init(MTOK, DFF, G, bx);
              build_rs_table(S, SSQA, lds, tid);
              pg8::EpiRS<1> E{U, DFF, lds + RS_OFF};
              pg8::gemm_phase<pg8::EpiRS<1>, pg8::StaticOrder, true, true>(lds, g, S, E); }
        }
        SEAM(P + 7);
        if (IN(P + 8)) { PHASE_PTRS();
            pg8::Gemm g{U, WDT, MTOK, DM, DFF}; pg8::StaticOrder S; S.init(MTOK, DM, G, bx);
            pg8::EpiResid<0> E{XBl, XBl, SSQB, (LAS unsigned char*)nullptr, nullptr,  1.0f};
            pg8::gemm_phase<pg8::EpiResid<0>, pg8::StaticOrder, true, true>(lds, g, S, E);
            __builtin_amdgcn_sched_barrier(0);
            { const int r0 = (layer == 0 && G > 192) ? 0 : MTOK / 2;
              pg8::Gemm g2{PB + (size_t)r0 * PLED, WPPT, MTOK - r0, DM, PLED}; pg8::StaticOrder S2; S2.init(MTOK - r0, DM, G, bx);
              pg8::EpiRS<0> E2{PLE + (size_t)r0 * DM, DM, (LAS unsigned char*)nullptr};
              pg8::gemm_phase<pg8::EpiRS<0>, pg8::StaticOrder, true, true>(lds, g2, S2, E2); }
        }
        SEAM(P + 8);
        if (IN(P + 9)) { PHASE_PTRS();
            pg8::Gemm g{XBl, WPGT, MTOK, DM, DM}; pg8::StaticOrder S; S.init(MTOK, DM, G, bx);
            build_rs_table(S, SSQB, lds, tid);
            pg8::EpiResid<1> E{XBl, XBf, SSQC, lds + RS_OFF, PLE,  1.0f};
            pg8::gemm_phase<pg8::EpiResid<1>, pg8::StaticOrder, true, true>(lds, g, S, E);
        }
        SEAM(P + 9);
    }
    if (IN(PH_FINAL)) { const int layer = DEPTH; PHASE_PTRS();
        const float* nf = kp->in[22];
        f32x4 gn[2][2];
#pragma unroll
        for (int j = 0; j < 2; ++j) { const int c8 = (64 * j + lane) * 2; gn[j][0] = ((const GAS f32x4*)nf)[c8]; gn[j][1] = ((const GAS f32x4*)nf)[c8 + 1]; }
        for (int m0 = gw; m0 < MTOK; m0 += 2 * NGW) {
            const bool two = m0 + NGW < MTOK; const int m1 = two ? m0 + NGW : m0;
            float sp0 = lane < 16 ? SSQC[(size_t)m0 * 16 + lane] : 0.f, sp1 = lane < 16 ? SSQC[(size_t)m1 * 16 + lane] : 0.f;
            const GAS v4u* xr0 = (const GAS v4u*)(XBl + (size_t)m0 * DM) + lane; const GAS v4u* xr1 = (const GAS v4u*)(XBl + (size_t)m1 * DM) + lane;
            v4u w[2][2];
#pragma unroll
            for (int j = 0; j < 2; ++j) { w[0][j] = xr0[64 * j]; w[1][j] = xr1[64 * j]; }
#pragma unroll
            for (int o = 1; o < 16; o <<= 1) { sp0 += __shfl_xor(sp0, o); sp1 += __shfl_xor(sp1, o); }
            const float rstd0 = rsqrtf(rdl(sp0, 0) * (1.0f / 1024.0f) + 1e-6f), rstd1 = rsqrtf(rdl(sp1, 0) * (1.0f / 1024.0f) + 1e-6f);
#pragma unroll
            for (int r = 0; r < 2; ++r) { if (r == 1 && !two) break;
                GAS f32x4* orow = (GAS f32x4*)(X + (size_t)(r ? m1 : m0) * DM); const float rstd = r ? rstd1 : rstd0;
#pragma unroll
                for (int j = 0; j < 2; ++j) { const v4u ww = w[r][j]; const int c8 = (64 * j + lane) * 2;
                    f32x4 o0, o1; o0[0] = pg8::bflo(ww.x); o0[1] = pg8::bfhi(ww.x); o0[2] = pg8::bflo(ww.y); o0[3] = pg8::bfhi(ww.y); o1[0] = pg8::bflo(ww.z); o1[1] = pg8::bfhi(ww.z); o1[2] = pg8::bflo(ww.w); o1[3] = pg8::bfhi(ww.w);
                    orow[c8] = o0 * rstd * gn[j][0]; orow[c8 + 1] = o1 * rstd * gn[j][1]; } }
        }
    }
#undef IN
#undef SEAM
}

extern "C" void kernel_launch(void* const* d_in, const int* in_sizes, int n_in, void* d_out, int out_size, void* d_ws, size_t ws_size, hipStream_t stream) {
    static int grid = 0;
    if (grid == 0) {
        if (n_in != 23 || out_size != MTOK * DM || ws_size < WS_END) { fprintf(stderr, "kernel_launch: unexpected problem (n_in %d, out %d, ws %zu < %zu)\n", n_in, out_size, ws_size, (size_t)WS_END); grid = -1; return; }
        int dev = 0, cus = 0;
        if (hipGetDevice(&dev) != hipSuccess || hipDeviceGetAttribute(&cus, hipDeviceAttributeMultiprocessorCount, dev) != hipSuccess) { grid = -1; return; }
        if (hipFuncSetAttribute((const void*)fwd_kernel, hipFuncAttributeMaxDynamicSharedMemorySize, LDS_BYTES) != hipSuccess) { fprintf(stderr, "kernel_launch: hipFuncSetAttribute failed\n"); grid = -1; return; }
        int per_cu = 0;
        if (hipOccupancyMaxActiveBlocksPerMultiprocessor(&per_cu, (const void*)fwd_kernel, 512, LDS_BYTES) != hipSuccess || per_cu < 1) { fprintf(stderr, "kernel_launch: occupancy query says %d blocks per CU\n", per_cu); }
        (void)hipGetLastError();
        grid = cus < 256 ? cus : 256;
    }
    if (grid < 0) return;
    (void)hipMemsetAsync((char*)d_ws + WS_CTL, 0, CTL_BYTES, stream);
    Args a; memset(&a, 0, sizeof(a));
    for (int i = 0; i < 23; ++i) a.in[i] = (const float*)d_in[i];
    a.out = (float*)d_out; a.ws = (unsigned char*)d_ws;
#if MK_ONE_LAUNCH
    a.ph_lo = 0; a.ph_hi = N_PHASES;
    hipLaunchKernelGGL(fwd_kernel, dim3(grid), dim3(512), LDS_BYTES, stream, a);
#else
    for (int p = 0; p < N_PHASES; ++p) {
        a.ph_lo = p; a.ph_hi = p + 1;
        hipLaunchKernelGGL(fwd_kernel, dim3(grid), dim3(512), LDS_BYTES, stream, a);
    }
#endif
}
```

```cpp
#include <hip/hip_runtime.h>
#include <cstdio>
#include <cstdint>
#include <cstring>
__host__ __device__ __forceinline__ size_t mixh(int col, size_t m) {
    const size_t b = m >> 12, t = m & 4095;
    if (col < 2048) { const int ten = col >> 9, h = (col >> 6) & 7; return (size_t)ten * (16u << 20) + (((b * 8 + h) << 12) + t) * 64 + (col & 63); }
    if (col < 2304) { const int c2 = col - 2048, tb = c2 >> 7, g = (c2 >> 6) & 1; return (size_t)4 * (16u << 20) + (size_t)tb * (4u << 20) + (((b * 2 + g) << 12) + t) * 64 + (col & 63); }
    const int c2 = col - 2304, ten = c2 >> 9, h = (c2 >> 6) & 7; return (size_t)4 * (16u << 20) + (8u << 20) + (size_t)ten * (16u << 20) + (((b * 8 + h) << 12) + t) * 64 + (col & 63);
}
__host__ __device__ __forceinline__ size_t gwh(int h, int c, size_t m) { return ((((m >> 12) * 8 + h) << 12) + (m & 4095)) * 64 + c; }
namespace pg8 {
#define PG8_LAS __attribute__((address_space(3)))
typedef unsigned short bf16_t;
typedef short bf16x8 __attribute__((ext_vector_type(8)));
typedef float f32x4 __attribute__((ext_vector_type(4)));
typedef unsigned u32x4 __attribute__((ext_vector_type(4)));
constexpr int BM = 256, BK = 64, HALF = 128, HTB = HALF * BK * 2  , STAGE_BYTES = 8 * HTB, NXCD = 8, WGM = 8;

__host__ __device__ __forceinline__ int lds_byte(int r, int c) { const int st = (r >> 4) * 2 + (c >> 5), rr = r & 15, cc = c & 31, ob = rr * 64 + cc * 2; return st * 1024 + (ob ^ (((ob >> 9) & 1) << 5)); }
__host__ __device__ __forceinline__ void stage_rc(int b, int& R, int& C) { const int st = b / 1024, sb = b % 1024, swz = sb ^ (((sb >> 9) & 1) << 5); R = (st >> 1) * 16 + swz / 64; C = (st & 1) * 32 + (swz % 64) / 2; }
__host__ __device__ __forceinline__ int perm32(int rho) { const int n = rho >> 4, i = rho & 15; return 8 * (i >> 2) + 4 * n + (i & 3); }

struct Unit { int pm, pn; };
struct Gemm { const bf16_t* A; const bf16_t* Bt; int M, N, K; };

struct StaticOrder {
    int nM, nN, nwg, G, c;
    __host__ __device__ void init(int M, int N, int G_, int c_) { nM = M / BM; nN = N / BM; nwg = nM * nN; G = G_; c = c_; }
    __host__ __device__ bool next(int i, Unit& u) const {
        const long L = (long)i * G + c; if (L >= nwg) return false;
        int wgid = (int)L; { const int q = nwg / NXCD, r = nwg % NXCD, xcd = wgid % NXCD, off = wgid / NXCD; wgid = (xcd < r ? xcd * (q + 1) : r * (q + 1) + (xcd - r) * q) + off; }
        const int nig = WGM * nN, gid = wgid / nig, fm = gid * WGM, gsz = (nM - fm) < WGM ? (nM - fm) : WGM;
        u.pm = fm + ((wgid % nig) % gsz); u.pn = (wgid % nig) / gsz; return true;
    }
    __device__ __forceinline__ void a_ready(const Unit&) const {}
    __device__ __forceinline__ void done(const Unit&) const {}
};

typedef float f32x2c __attribute__((ext_vector_type(2))); typedef __bf16 bf16x2c __attribute__((ext_vector_type(2)));
__device__ __forceinline__ unsigned cvt_pk_bf16(float lo, float hi) { const f32x2c v = {lo, hi}; const bf16x2c b = __builtin_convertvector(v, bf16x2c); return __builtin_bit_cast(unsigned, b); }
typedef unsigned u32x2 __attribute__((ext_vector_type(2)));
__device__ __forceinline__ float bflo(unsigned w) { return __uint_as_float(w << 16); }
__device__ __forceinline__ float bfhi(unsigned w) { return __uint_as_float(w & 0xffff0000u); }
__device__ __forceinline__ u32x4 pack8(const f32x4 v0, const f32x4 v1) { u32x4 w; w.x = cvt_pk_bf16(v0[0], v0[1]); w.y = cvt_pk_bf16(v0[2], v0[3]); w.z = cvt_pk_bf16(v1[0], v1[1]); w.w = cvt_pk_bf16(v1[2], v1[3]); return w; }
__device__ __forceinline__ void unpack8(const u32x4 w, f32x4& v0, f32x4& v1) { v0 = (f32x4){bflo(w.x), bfhi(w.x), bflo(w.y), bfhi(w.y)}; v1 = (f32x4){bflo(w.z), bfhi(w.z), bflo(w.w), bfhi(w.w)}; }
constexpr float RMS_EPS = 1e-6f;
constexpr int RS_SLOTS = 8;
__device__ __forceinline__ void load_rstd(const PG8_LAS unsigned char* rst, int pm, int wr, int fr, float (&rs)[2][4]) {
    if (rst == nullptr) {
#pragma unroll
        for (int ai = 0; ai < 2; ++ai)
#pragma unroll
            for (int m = 0; m < 4; ++m) rs[ai][m] = 1.0f;
        return; }
    const PG8_LAS int* pml = (const PG8_LAS int*)rst; int slot = 0;
#pragma unroll
    for (int k = 1; k < RS_SLOTS; ++k) slot = pml[k] == pm ? k : slot;
    const PG8_LAS float* tab = (const PG8_LAS float*)(rst + 32) + slot * 256 + wr * 64 + fr;
#pragma unroll
    for (int ai = 0; ai < 2; ++ai)
#pragma unroll
        for (int m = 0; m < 4; ++m) rs[ai][m] = tab[ai * HALF + m * 16];
}
struct EpiP1 {
    static constexpr bool PERM = true, AFTER_DRAIN = false, HOOK = false; static constexpr int SEG1 = -1, SEG2 = -1;
    bf16_t* ZB; bf16_t* MIX; float* SM; const PG8_LAS unsigned char* rst; bf16_t* HALO; unsigned nost;
    __device__ __forceinline__ void rescale(f32x4 (&)[2][2][4][2], const Unit&, int, int, int, int, int) const {}
    __device__ __forceinline__ void operator()(const f32x4 (&acc)[2][2][4][2], const Unit& u, int wr, int wc, int fr, int fq) const {
        const int row0 = u.pm * BM + wr * 64 + fr;
        float rs[2][4]; load_rstd(rst, u.pm, wr, fr, rs);
        if (u.pn == 21) {
            if (wc == 0) {
#pragma unroll
                for (int ai = 0; ai < 2; ++ai)
#pragma unroll
                    for (int m = 0; m < 4; ++m) { float* p = SM + (size_t)(row0 + ai * HALF + m * 16) * 32 + 8 * fq;
                        *(f32x4*)p = acc[ai][0][m][0] * rs[ai][m]; *(f32x4*)(p + 4) = acc[ai][0][m][1] * rs[ai][m]; }
            }
            return;
        }
        const bool mixt = u.pn >= 6;
        const int colt = mixt ? (u.pn - 6) * BM : u.pn * BM, col0 = colt + wc * 32 + 8 * fq;
#pragma unroll
        for (int ai = 0; ai < 2; ++ai)
#pragma unroll
            for (int m = 0; m < 4; ++m) { const size_t row = (size_t)(row0 + ai * HALF + m * 16);
#pragma unroll
                for (int bj = 0; bj < 2; ++bj) { const u32x4 w = pack8(acc[ai][bj][m][0] * rs[ai][m], acc[ai][bj][m][1] * rs[ai][m]);
                    if (nost == 0u || (w.x ^ w.y ^ w.z) == nost) *(u32x4*)(mixt ? MIX + mixh(col0 + bj * HALF, row) : ZB + row * 1536 + col0 + bj * HALF) = w;
                    if (m == 3 && fr >= 13 && u.pn >= 6 && u.pn < 15) *(u32x4*)(HALO + ((size_t)((row0 + ai * HALF + m * 16) >> 6) * 3 + (fr - 13)) * 2304 + col0 + bj * HALF) = w; } }
    }
};
template <int ACT> struct EpiRS {
    static constexpr bool PERM = true, AFTER_DRAIN = false, HOOK = false; static constexpr int SEG1 = -1, SEG2 = -1;
    bf16_t* O; int ldc; const PG8_LAS unsigned char* rst;
    __device__ __forceinline__ void rescale(f32x4 (&)[2][2][4][2], const Unit&, int, int, int, int, int) const {}
    __device__ __forceinline__ void operator()(const f32x4 (&acc)[2][2][4][2], const Unit& u, int wr, int wc, int fr, int fq) const {
        const int row0 = u.pm * BM + wr * 64 + fr, col0 = u.pn * BM + wc * 32 + 8 * fq;
        float rs[2][4]; load_rstd(rst, u.pm, wr, fr, rs);
#pragma unroll
        for (int ai = 0; ai < 2; ++ai)
#pragma unroll
            for (int m = 0; m < 4; ++m) { bf16_t* rowp = O + (size_t)(row0 + ai * HALF + m * 16) * ldc + col0;
#pragma unroll
                for (int bj = 0; bj < 2; ++bj) { f32x4 v0 = acc[ai][bj][m][0] * rs[ai][m], v1 = acc[ai][bj][m][1] * rs[ai][m];
                    if (ACT == 1) {
#pragma unroll
                        for (int j = 0; j < 4; ++j) { const float a = fmaxf(v0[j], 0.f), b = fmaxf(v1[j], 0.f); v0[j] = a * a; v1[j] = b * b; } }
                    if (ACT == 2) {
#pragma unroll
                        for (int j = 0; j < 4; ++j) { v0[j] = 1.0f + __expf(-v0[j]); v1[j] = 1.0f + __expf(-v1[j]); } }
                    *(u32x4*)(rowp + bj * HALF) = pack8(v0, v1); } }
    }
};
struct EpiMerge {
    static constexpr bool PERM = true, AFTER_DRAIN = false, HOOK = true; static constexpr int SEG1 = 8, SEG2 = 16, SEG3 = 12;
    const bf16_t* GATE; bf16_t* O; const float* SM;
    __device__ __forceinline__ void rowscale(f32x4 (&acc)[2][2][4][2], const Unit& u, int wr) const {
        int t_ = threadIdx.x; asm volatile("" : "+v"(t_)); const int fr = t_ & 15;
        const float* sp = SM + (size_t)(u.pm * BM + wr * 64 + fr) * 32 + 25;
#pragma unroll
        for (int ai = 0; ai < 2; ++ai)
#pragma unroll
            for (int m = 0; m < 4; ++m) { float f = sp[(size_t)(ai * HALF + m * 16) * 32]; asm volatile("" : "+v"(f));
#pragma unroll
                for (int bj = 0; bj < 2; ++bj) { acc[ai][bj][m][0] *= f; acc[ai][bj][m][1] *= f; } }
    }
    __device__ __forceinline__ void rescale(f32x4 (&acc)[2][2][4][2], const Unit& u, int seg, int wr, int wc, int, int) const {
        int t_ = threadIdx.x; asm volatile("" : "+v"(t_)); const int fr = t_ & 15, fq = (t_ & 63) >> 4;
        const int row0 = u.pm * BM + wr * 64 + fr;
        const int col0 = u.pn * BM + wc * 32 + 8 * fq + (seg - 1) * 1024, dofs = 1024, rcol = seg == 1 ? 24 : 26;
#pragma unroll
        for (int ai = 0; ai < 2; ++ai)
#pragma unroll
            for (int m = 0; m < 4; ++m) { const bf16_t* gp = GATE + (size_t)(row0 + ai * HALF + m * 16) * 3072 + col0;
                const float rf = SM[(size_t)(row0 + ai * HALF + m * 16) * 32 + rcol];
#pragma unroll
                for (int bj = 0; bj < 2; ++bj) { const u32x4 wa = *(const u32x4*)(gp + bj * HALF), wb = *(const u32x4*)(gp + bj * HALF + dofs);
                    f32x4 a0, a1, b0, b1; unpack8(wa, a0, a1); unpack8(wb, b0, b1);
#pragma unroll
                    for (int j = 0; j < 4; ++j) {
                        acc[ai][bj][m][0][j] *= (b0[j] * rf) * __builtin_amdgcn_rcpf(a0[j]);
                        acc[ai][bj][m][1][j] *= (b1[j] * rf) * __builtin_amdgcn_rcpf(a1[j]); } }
                if (m == 3) asm volatile("" ::: "memory"); }
    }
    __device__ __forceinline__ void operator()(const f32x4 (&acc)[2][2][4][2], const Unit& u, int wr, int wc, int fr, int fq) const {
        const int row0 = u.pm * BM + wr * 64 + fr, col0 = u.pn * BM + wc * 32 + 8 * fq;
#pragma unroll
        for (int ai = 0; ai < 2; ++ai)
#pragma unroll
            for (int m = 0; m < 4; ++m) { const size_t r = (size_t)(row0 + ai * HALF + m * 16);
#pragma unroll
                for (int bj = 0; bj < 2; ++bj) { const u32x4 wa = *(const u32x4*)(GATE + r * 3072 + 2048 + col0 + bj * HALF);
                    f32x4 a0, a1; unpack8(wa, a0, a1); f32x4 v0 = acc[ai][bj][m][0], v1 = acc[ai][bj][m][1];
#pragma unroll
                    for (int j = 0; j < 4; ++j) { v0[j] *= __builtin_amdgcn_rcpf(a0[j]); v1[j] *= __builtin_amdgcn_rcpf(a1[j]); }
                    *(u32x4*)(O + r * 1024 + col0 + bj * HALF) = pack8(v0, v1); }
                if (m == 3) asm volatile("" ::: "memory"); }
    }
};
template <int MODE> struct EpiResid {
    static constexpr bool PERM = true, AFTER_DRAIN = false, HOOK = false; static constexpr int SEG1 = -1, SEG2 = -1;
    const bf16_t* XBin; bf16_t* XBout; float* ssq_out; const PG8_LAS unsigned char* rst; const bf16_t* PLE; float scale;
    __device__ __forceinline__ void rescale(f32x4 (&)[2][2][4][2], const Unit&, int, int, int, int, int) const {}
    __device__ __forceinline__ void operator()(const f32x4 (&acc)[2][2][4][2], const Unit& u, int wr, int wc, int fr, int fq) const {
        const int row0 = u.pm * BM + wr * 64 + fr, col0 = u.pn * BM + wc * 32 + 8 * fq;
        float rs[2][4]; if (MODE == 1) load_rstd(rst, u.pm, wr, fr, rs);
#pragma unroll
        for (int ai = 0; ai < 2; ++ai)
#pragma unroll
            for (int m = 0; m < 4; ++m) { const size_t r = (size_t)(row0 + ai * HALF + m * 16); float ss = 0.f;
#pragma unroll
                for (int bj = 0; bj < 2; ++bj) { const size_t o = r * 1024 + col0 + bj * HALF;
                    f32x4 v0 = acc[ai][bj][m][0], v1 = acc[ai][bj][m][1], b0, b1; unpack8(*(const u32x4*)(XBin + o), b0, b1);
                    if (MODE == 1) { const u32x4 wp = *(const u32x4*)(PLE + o); f32x4 p0, p1; unpack8(wp, p0, p1);
#pragma unroll
                        for (int j = 0; j < 4; ++j) { v0[j] = p0[j] * __builtin_amdgcn_rcpf(1.0f + __expf(-v0[j] * rs[ai][m])); v1[j] = p1[j] * __builtin_amdgcn_rcpf(1.0f + __expf(-v1[j] * rs[ai][m])); } }
                    v0 = v0 * scale + b0; v1 = v1 * scale + b1;
                    *(u32x4*)(XBout + o) = pack8(v0, v1);
                    ss += (v0[0] * v0[0] + v0[1] * v0[1]) + (v0[2] * v0[2] + v0[3] * v0[3]) + (v1[0] * v1[0] + v1[1] * v1[1]) + (v1[2] * v1[2] + v1[3] * v1[3]); }
                ss += __shfl_xor(ss, 16); ss += __shfl_xor(ss, 32);
                if (fq == 0) ssq_out[r * 16 + u.pn * 4 + wc] = ss;
                if (m == 3) asm volatile("" ::: "memory"); }
    }
};
template <class Epi, class Sched, bool ALIGN_EPI = false, bool SP2 = false, int PROBE = 0>
__device__ __forceinline__ void gemm_phase(PG8_LAS unsigned char* lds, Gemm g, const Sched& S, const Epi& E) {
    asm volatile("" : "+s"(g.A), "+s"(g.Bt), "+s"(g.K));
    int tid_ = threadIdx.x; asm volatile("" : "+v"(tid_));
    const int tid = tid_, wid = __builtin_amdgcn_readfirstlane(tid >> 6), lane = tid & 63, wr = wid >> 2, wc = wid & 3, fr = lane & 15, fq = lane >> 4;
    const int K = g.K, nt = K / BK;
    unsigned voffA[2], voffB[2];
#pragma unroll
    for (int i = 0; i < 2; ++i) { int R, C; stage_rc(tid * 16 + i * 8192, R, C); const int Rb = Epi::PERM ? ((R & ~31) + perm32(R & 31)) : R;
        voffA[i] = (unsigned)(R * K + C) * 2u; voffB[i] = (unsigned)(Rb * K + C) * 2u; }
    const size_t kstep = (size_t)(BK * 2);
    const size_t hstep = (size_t)HALF * K * 2;
    const size_t tstep = 2 * hstep;
    const unsigned ldsw = (unsigned)wid * 1024u;
    const int aoff = lds_byte(wr * 64 + fr, fq * 8), boff = lds_byte(wc * 32 + fr, fq * 8);
#define PG8_SA(b, h) (((b) * 2 + (h)) * HTB)
#define PG8_SB(b, h) ((4 + (b) * 2 + (h)) * HTB)
#define PG8_STAGE(bufoff, gbase, voff) do { if constexpr (!(PROBE & 4)) _Pragma("unroll") for (int _i = 0; _i < 2; ++_i) \
        __builtin_amdgcn_global_load_lds((const unsigned*)((const char*)(gbase) + (voff)[_i]), (PG8_LAS unsigned*)(lds + (bufoff) + ldsw + _i * 8192), 16, 0, 0); } while (0)
#define PG8_LDA(dst, b, h) do { _Pragma("unroll") for (int m = 0; m < 4; ++m) _Pragma("unroll") for (int k = 0; k < 2; ++k) dst[m][k] = *(const PG8_LAS bf16x8*)(lds + PG8_SA(b, h) + aoff + m * 2048 + k * 1024); } while (0)
#define PG8_LDB(dst, b, h) do { _Pragma("unroll") for (int n = 0; n < 2; ++n) _Pragma("unroll") for (int k = 0; k < 2; ++k) dst[n][k] = *(const PG8_LAS bf16x8*)(lds + PG8_SB(b, h) + boff + n * 2048 + k * 1024); } while (0)
#define PG8_MMA(ai, bj, At, Bt) do { __builtin_amdgcn_s_setprio(1); if constexpr (!(PROBE & 2)) _Pragma("unroll") for (int m = 0; m < 4; ++m) _Pragma("unroll") for (int n = 0; n < 2; ++n) _Pragma("unroll") for (int k = 0; k < 2; ++k) \
        acc[ai][bj][m][n] = __builtin_amdgcn_mfma_f32_16x16x32_bf16(Bt[n][k], At[m][k], acc[ai][bj][m][n], 0, 0, 0); __builtin_amdgcn_s_setprio(0); } while (0)
#define PG8_WAIT_V(n) asm volatile("s_waitcnt vmcnt(" #n ")" ::: "memory")
#define PG8_WAIT_L(n) asm volatile("s_waitcnt lgkmcnt(" #n ")" ::: "memory")
#define PG8_BAR __builtin_amdgcn_s_barrier()
#define PG8_SCHED __builtin_amdgcn_sched_barrier(0)
    Unit cur, nxt; int ui = 0;
    if (!S.next(0, cur)) return;
    f32x4 acc[2][2][4][2];
#pragma unroll
    for (int a = 0; a < 2; ++a)
#pragma unroll
        for (int b = 0; b < 2; ++b)
#pragma unroll
            for (int m = 0; m < 4; ++m)
#pragma unroll
                for (int n = 0; n < 2; ++n) acc[a][b][m][n] = (f32x4){0.f, 0.f, 0.f, 0.f};
    bf16x8 At[4][2], B0[2][2], B1[2][2];
    const char* cA = (const char*)g.A + (size_t)cur.pm * tstep; const char* cB = (const char*)g.Bt + (size_t)cur.pn * tstep;
    S.a_ready(cur);
    if constexpr (SP2) {
        PG8_STAGE(PG8_SB(0, 0), cB, voffB); PG8_STAGE(PG8_SB(0, 1), cB + hstep, voffB); PG8_STAGE(PG8_SA(0, 0), cA, voffA); PG8_STAGE(PG8_SA(0, 1), cA + hstep, voffA);
        if (wr == 1) PG8_BAR;
        PG8_WAIT_V(2); PG8_BAR;
        PG8_STAGE(PG8_SB(1, 0), cB + kstep, voffB); PG8_STAGE(PG8_SA(1, 0), cA + kstep, voffA); PG8_STAGE(PG8_SB(1, 1), cB + hstep + kstep, voffB);
        PG8_WAIT_V(6); PG8_BAR;
    } else {
        PG8_STAGE(PG8_SB(0, 0), cB, voffB); PG8_STAGE(PG8_SA(0, 0), cA, voffA); PG8_STAGE(PG8_SB(0, 1), cB + hstep, voffB); PG8_STAGE(PG8_SA(0, 1), cA + hstep, voffA);
        if (wr == 1) PG8_BAR;
        PG8_WAIT_V(4); PG8_BAR;
        PG8_STAGE(PG8_SB(1, 0), cB + kstep, voffB); PG8_STAGE(PG8_SA(1, 0), cA + kstep, voffA); PG8_STAGE(PG8_SB(1, 1), cB + hstep + kstep, voffB);
        PG8_WAIT_V(6); PG8_BAR;
    }
    for (;;) {
        const bool has_next = S.next(ui + 1, nxt);
        const char* nA = has_next ? (const char*)g.A + (size_t)nxt.pm * tstep : cA; const char* nB = has_next ? (const char*)g.Bt + (size_t)nxt.pn * tstep : cB;
        asm volatile(".p2align 8" ::: "memory");
        for (int t = 0; t < nt; t += 2) {
            const bool last = (t == nt - 2);
            const char* a1 = cA + (size_t)(t + 1) * kstep;
            const char* a2 = last ? nA : cA + (size_t)(t + 2) * kstep; const char* b2 = last ? nB : cB + (size_t)(t + 2) * kstep;
            const char* a3 = a2 + kstep; const char* b3 = b2 + kstep;
            if (last && has_next) S.a_ready(nxt);
            if constexpr (Epi::HOOK) { if (t == Epi::SEG1 || t == Epi::SEG2) E.rescale(acc, cur, t == Epi::SEG1 ? 1 : 2, wr, wc, fr, fq); if (t == Epi::SEG3) E.rowscale(acc, cur, wr); }
            if constexpr (SP2) {
            PG8_LDB(B0, 0, 0); PG8_LDB(B1, 0, 1); PG8_SCHED; PG8_LDA(At, 0, 0); PG8_STAGE(PG8_SA(1, 1), a1 + hstep, voffA);
            PG8_WAIT_V(8); PG8_WAIT_L(0); PG8_BAR; PG8_MMA(0, 0, At, B0); PG8_MMA(0, 1, At, B1); PG8_BAR; PG8_SCHED;
            PG8_LDA(At, 0, 1); PG8_STAGE(PG8_SB(0, 0), b2, voffB); PG8_STAGE(PG8_SB(0, 1), b2 + hstep, voffB); PG8_STAGE(PG8_SA(0, 0), a2, voffA);
            PG8_WAIT_V(8); PG8_WAIT_L(0); PG8_BAR; PG8_MMA(1, 0, At, B0); PG8_MMA(1, 1, At, B1); PG8_BAR; PG8_SCHED;
            PG8_LDB(B0, 1, 0); PG8_LDB(B1, 1, 1); PG8_SCHED; PG8_LDA(At, 1, 0); PG8_STAGE(PG8_SA(0, 1), a2 + hstep, voffA);
            PG8_WAIT_V(8); PG8_WAIT_L(0); PG8_BAR; PG8_MMA(0, 0, At, B0); PG8_MMA(0, 1, At, B1); PG8_BAR; PG8_SCHED;
            PG8_LDA(At, 1, 1); PG8_STAGE(PG8_SB(1, 0), b3, voffB); PG8_STAGE(PG8_SB(1, 1), b3 + hstep, voffB); PG8_STAGE(PG8_SA(1, 0), a3, voffA);
            PG8_WAIT_V(8); PG8_WAIT_L(0); PG8_BAR; PG8_MMA(1, 0, At, B0); PG8_MMA(1, 1, At, B1); PG8_BAR; PG8_SCHED;
            } else {
            PG8_LDB(B0, 0, 0); PG8_SCHED; PG8_LDA(At, 0, 0); PG8_STAGE(PG8_SA(1, 1), a1 + hstep, voffA);
            PG8_WAIT_L(8); PG8_BAR; PG8_WAIT_L(0); PG8_MMA(0, 0, At, B0); PG8_BAR; PG8_SCHED;
            PG8_LDB(B1, 0, 1); PG8_STAGE(PG8_SB(0, 0), b2, voffB);
            PG8_BAR; PG8_WAIT_L(0); PG8_MMA(0, 1, At, B1); PG8_BAR;
            PG8_LDA(At, 0, 1); PG8_STAGE(PG8_SA(0, 0), a2, voffA);
            PG8_BAR; PG8_WAIT_L(0); PG8_MMA(1, 0, At, B0); PG8_BAR; PG8_SCHED;
            PG8_STAGE(PG8_SB(0, 1), b2 + hstep, voffB);
            PG8_WAIT_V(6); PG8_BAR; PG8_MMA(1, 1, At, B1); PG8_BAR;
            PG8_LDB(B0, 1, 0); PG8_SCHED; PG8_LDA(At, 1, 0); PG8_STAGE(PG8_SA(0, 1), a2 + hstep, voffA);
            PG8_WAIT_L(8); PG8_BAR; PG8_WAIT_L(0); PG8_MMA(0, 0, At, B0); PG8_BAR; PG8_SCHED;
            PG8_LDB(B1, 1, 1); PG8_STAGE(PG8_SB(1, 0), b3, voffB);
            PG8_BAR; PG8_WAIT_L(0); PG8_MMA(0, 1, At, B1); PG8_BAR;
            PG8_LDA(At, 1, 1); PG8_STAGE(PG8_SA(1, 0), a3, voffA);
            PG8_BAR; PG8_WAIT_L(0); PG8_MMA(1, 0, At, B0); PG8_BAR; PG8_SCHED;
            PG8_STAGE(PG8_SB(1, 1), b3 + hstep, voffB);
            PG8_WAIT_V(6); PG8_BAR; PG8_MMA(1, 1, At, B1); PG8_BAR;
            }
        }
        if constexpr (ALIGN_EPI) { if (wr == 0) PG8_BAR; }
        if constexpr ((PROBE & 8) != 0) { f32x4 s_ = acc[0][0][0][0];
#pragma unroll
            for (int a_ = 0; a_ < 2; ++a_)
#pragma unroll
                for (int b_ = 0; b_ < 2; ++b_)
#pragma unroll
                    for (int m_ = 0; m_ < 4; ++m_)
#pragma unroll
                        for (int n_ = 0; n_ < 2; ++n_) s_ += acc[a_][b_][m_][n_];
            if (s_[0] + s_[1] + s_[2] + s_[3] == 1234.567f) *(volatile float*)g.A = s_[0]; }
        if constexpr (!Epi::AFTER_DRAIN && !(PROBE & 1)) { int t2_ = threadIdx.x; asm volatile("" : "+v"(t2_)); E(acc, cur, wr, wc, t2_ & 15, (t2_ & 63) >> 4); S.done(cur); }
        if (!has_next) break;
#pragma unroll
        for (int a = 0; a < 2; ++a)
#pragma unroll
            for (int b = 0; b < 2; ++b)
#pragma unroll
                for (int m = 0; m < 4; ++m)
#pragma unroll
                    for (int n = 0; n < 2; ++n) acc[a][b][m][n] = (f32x4){0.f, 0.f, 0.f, 0.f};
        cur = nxt; cA = nA; cB = nB; ++ui;
        if constexpr (ALIGN_EPI) { if (wr == 1) PG8_BAR; }
    }
    PG8_WAIT_V(0);
    if constexpr (!ALIGN_EPI) { if (wr == 0) PG8_BAR; }
    PG8_BAR;
    if constexpr (Epi::AFTER_DRAIN) { E.fused(acc, cur, wr, wc, fr, fq, lds, wid, lane); S.done(cur); }
#undef PG8_SA
#undef PG8_SB
#undef PG8_STAGE
#undef PG8_LDA
#undef PG8_LDB
#undef PG8_MMA
#undef PG8_WAIT_V
#undef PG8_WAIT_L
#undef PG8_BAR
#undef PG8_SCHED
}
}
constexpr int DM = 1024, NBATCH = 8, SEQ = 4096, MTOK = NBATCH * SEQ, DEPTH = 2, DFF = 4096, PLED = 256, NIN = 8472;
constexpr int ZB_LD = 1536, MIX_LD = 3840, SM_LD = 32, N1 = 5632, NGATE = 3072, KMERGE = 1536;
constexpr int MX_AQ = 0, MX_AK = 512, MX_AV = 1024, MX_BX = 1536, MX_BB = 2048, MX_BC = 2176, MX_CQ = 2304, MX_CK = 2816, MX_CV = 3328;
constexpr size_t KiB = 1024, MiB = 1024 * 1024;
constexpr size_t WS_CTL = 0, CTL_BYTES = 64 * KiB;
constexpr size_t WS_W = 64 * KiB;
constexpr size_t W_1T = WS_W, W_GT = W_1T + (size_t)N1 * DM * 2, W_MT = W_GT + (size_t)NGATE * DM * 2, W_OT = W_MT + (size_t)DM * KMERGE * 2, W_UT = W_OT + (size_t)DM * DM * 2,
                 W_DT = W_UT + (size_t)DFF * DM * 2, W_PGT = W_DT + (size_t)DM * DFF * 2, W_PPT = W_PGT + (size_t)DM * DM * 2, W_END = W_PPT + (size_t)DM * PLED * 2;
constexpr size_t WS_SSQA = W_1T + 1 * MiB, WS_SSQB = W_1T + 3 * MiB;
constexpr size_t WS_XB0 = W_END, WS_XB1 = WS_XB0 + 64 * MiB, WS_ZB = WS_XB1 + 64 * MiB, WS_MIX = WS_ZB + 96 * MiB, WS_SM = WS_MIX + 240 * MiB, WS_SSQC = WS_SM + 4 * MiB, WS_ROPE = WS_SSQC + 2 * MiB, WS_END = WS_ROPE + 1 * MiB;
constexpr size_t WS_PB = WS_ZB, WS_PLE = WS_ZB + 16 * MiB, WS_U = WS_ZB + 80 * MiB, WS_GATE = WS_MIX;
static_assert(W_END == WS_W + (size_t)(40 * MiB + 512 * KiB), "weights");
static_assert(WS_U + (size_t)MTOK * DFF * 2 == WS_SM, "U overlay");
static_assert(WS_END <= 512 * MiB, "workspace");
constexpr int LDS_BYTES = 147456, RING_BYTES = 131072, MISC_OFF = RING_BYTES + 320, RS_OFF = RING_BYTES + 1024;
static_assert(RS_OFF + 32 + pg8::RS_SLOTS * 1024 <= LDS_BYTES, "LDS map");

#define GAS __attribute__((address_space(1)))
#define LAS __attribute__((address_space(3)))
typedef unsigned short bf16;
typedef unsigned v4u __attribute__((ext_vector_type(4)));
typedef unsigned v2u __attribute__((ext_vector_type(2)));
typedef float f32x4 __attribute__((ext_vector_type(4)));
#define LDS_WAIT() asm volatile("s_waitcnt lgkmcnt(0)" ::: "memory")
typedef float f32x2_t __attribute__((ext_vector_type(2))); typedef __bf16 bf16x2_t __attribute__((ext_vector_type(2)));
__device__ __forceinline__ unsigned pk2(float lo, float hi) { f32x2_t v = {lo, hi}; bf16x2_t b = __builtin_convertvector(v, bf16x2_t); return __builtin_bit_cast(unsigned, b); }
__device__ __forceinline__ unsigned f2bf(float f) { return pk2(f, 0.f) & 0xffffu; }
__device__ __forceinline__ float bf2f(bf16 v) { return __uint_as_float((unsigned)v << 16); }
__device__ __forceinline__ float wave_sum(float v) {
#pragma unroll
    for (int o = 1; o < 64; o <<= 1) v += __shfl_xor(v, o);
    return v;
}
__device__ __forceinline__ float siluf(float x) { return x * __builtin_amdgcn_rcpf(1.0f + __expf(-x)); }
__device__ __forceinline__ float sigmf(float x) { return __builtin_amdgcn_rcpf(1.0f + __expf(-x)); }
__device__ __forceinline__ float softplusf(float x) { return fmaxf(x, 0.f) + log1pf(__expf(-fabsf(x))); }
__device__ __forceinline__ float rdl(float v, int l) { return __int_as_float(__builtin_amdgcn_readlane(__float_as_int(v), l)); }

#define XB_TMO      128
#define XB_XCNT(j)  (256  + 64 * (j))
#define XB_XSUB(j)  (1280 + 64 * (j))
#define XB_XGEN(j)  (2304 + 64 * (j))
#define XB_TOP      3328
#define XB_TOPGEN   3392
#define XCD_BAR_WORDS 3456
#define XB_SPIN_CAP (1u << 18)
__device__ __forceinline__ unsigned xb_ld(unsigned* p)              { return __hip_atomic_load(p, __ATOMIC_RELAXED, __HIP_MEMORY_SCOPE_AGENT); }
__device__ __forceinline__ unsigned xb_add(unsigned* p, unsigned v) { return __hip_atomic_fetch_add(p, v, __ATOMIC_RELAXED, __HIP_MEMORY_SCOPE_AGENT); }
__device__ __forceinline__ unsigned xb_xcc_id() { return (unsigned)__builtin_amdgcn_s_getreg((3 << 11) | 20) & 0xFu; }
#define XB_SPIN(cond, bar) do { unsigned _sp = 0; while (cond) { __builtin_amdgcn_s_sleep(1); \
    if ((++_sp & 255u) == 0u) { if (xb_ld(&(bar)[XB_TMO])) break; if (_sp > XB_SPIN_CAP) { atomicAdd(&(bar)[XB_TMO], 1u); break; } } } } while (0)
struct XcdBarrier { unsigned* bar; unsigned x; volatile LAS unsigned* st; };
__device__ __forceinline__ XcdBarrier xcd_barrier_post(unsigned* bar, volatile LAS unsigned* st) {
    XcdBarrier b; b.bar = bar; b.x = xb_xcc_id(); b.st = st;
    if (threadIdx.x == 0) (void)xb_add(&bar[XB_XCNT(b.x)], 1u);
    return b;
}
__device__ __forceinline__ void xcd_barrier_complete(unsigned* bar, unsigned x, unsigned& nloc, unsigned& nx) {
    const unsigned G = gridDim.x * gridDim.y * gridDim.z;
    unsigned sum, cnt, mine, sp = 0u;
    for (;;) {
        sum = 0u; cnt = 0u; mine = 0u;
#pragma unroll
        for (unsigned j = 0; j < 16; ++j) { const unsigned c = xb_ld(&bar[XB_XCNT(j)]); sum += c; cnt += (c > 0u) ? 1u : 0u; mine = (j == x) ? c : mine; }
        if (sum == G) break;
        __builtin_amdgcn_s_sleep(1);
        if ((++sp & 255u) == 0u) { if (xb_ld(&bar[XB_TMO])) break; if (sp > XB_SPIN_CAP) { atomicAdd(&bar[XB_TMO], 1u); break; } }
    }
    nloc = mine > 0u ? mine : 1u; nx = cnt > 0u ? cnt : 1u;
}
__device__ __forceinline__ void xcd_barrier(const XcdBarrier& b) {
    asm volatile("s_waitcnt vmcnt(0)" ::: "memory");
    __syncthreads();
    if (threadIdx.x == 0) {
        unsigned* bar = b.bar;
        __builtin_amdgcn_s_waitcnt(0);
        unsigned nloc = b.st[0], nx = b.st[1];
        if (nloc == 0u) { xcd_barrier_complete(bar, b.x, nloc, nx); b.st[0] = nloc; b.st[1] = nx; }
        const unsigned old = xb_add(&bar[XB_XSUB(b.x)], 1u);
        const unsigned gen = old / nloc;
        if (old + 1u == (gen + 1u) * nloc) {
            __builtin_amdgcn_fence(__ATOMIC_RELEASE, "agent");
            asm volatile("s_waitcnt vmcnt(0)" ::: "memory");
            const unsigned og = xb_add(&bar[XB_TOP], 1u);
            const unsigned tg = og / nx;
            if (og + 1u == (tg + 1u) * nx) xb_add(&bar[XB_TOPGEN], 1u);
            else XB_SPIN(xb_ld(&bar[XB_TOPGEN]) == tg, bar);
            __builtin_amdgcn_fence(__ATOMIC_ACQUIRE, "agent");
            xb_add(&bar[XB_XGEN(b.x)], 1u);
            asm volatile("s_waitcnt vmcnt(0)" ::: "memory");
        } else {
            XB_SPIN(xb_ld(&bar[XB_XGEN(b.x)]) == gen, bar);
            __builtin_amdgcn_fence(__ATOMIC_ACQUIRE, "agent");
            asm volatile("s_waitcnt vmcnt(0)" ::: "memory");
        }
    }
    __syncthreads();
}

__device__ __forceinline__ void tr_item(const float* W, int ldw, int c0, int ncols, const float* scale, bf16* dst, int ldd, int r0, int kofs, LAS unsigned char* lds, int item, int tid) {
    const int lane = tid & 63, wave = __builtin_amdgcn_readfirstlane(tid >> 6);
    const int nblk = (ncols + 255) / 256, kb = item / nblk, nb = item - kb * nblk, k0 = 64 * kb, n0 = 256 * nb;
    asm volatile("s_waitcnt lgkmcnt(0)\n\ts_barrier" ::: "memory");
    float v[8][4];
    const int n = n0 + 4 * lane;
    const bool vec = W != nullptr && ((c0 | ldw) & 3) == 0 && n + 3 < ncols;
    const float* wp = W + (size_t)(k0 + 8 * wave) * ldw + c0 + n;
#pragma unroll
    for (int kk = 0; kk < 8; ++kk) {
        if (vec) { const f32x4 t = *(const GAS f32x4*)(wp + (size_t)kk * ldw); v[kk][0] = t[0]; v[kk][1] = t[1]; v[kk][2] = t[2]; v[kk][3] = t[3]; }
        else {
#pragma unroll
            for (int q = 0; q < 4; ++q) v[kk][q] = (W != nullptr && n + q < ncols) ? wp[(size_t)kk * ldw + q] : 0.f; }
        if (scale) { const float s = scale[k0 + 8 * wave + kk];
#pragma unroll
            for (int q = 0; q < 4; ++q) v[kk][q] *= s; } }
#pragma unroll
    for (int q = 0; q < 4; ++q) { v4u o; o.x = pk2(v[0][q], v[1][q]); o.y = pk2(v[2][q], v[3][q]); o.z = pk2(v[4][q], v[5][q]); o.w = pk2(v[6][q], v[7][q]);
        *(LAS v4u*)(lds + (4 * lane + q) * 128 + ((wave ^ (lane & 7)) << 4)) = o; }
    asm volatile("s_waitcnt lgkmcnt(0)\n\ts_barrier" ::: "memory");
#pragma unroll
    for (int i = 0; i < 4; ++i) { const int nl = (tid >> 3) + 64 * i, ch = tid & 7;
        if (n0 + nl < ncols) *(GAS v4u*)(dst + (size_t)(r0 + n0 + nl) * ldd + kofs + k0 + ch * 8) = *(const LAS v4u*)(lds + nl * 128 + ((ch ^ ((nl >> 2) & 7)) << 4)); }
}
#define TR_SEG(W_, ldw_, c0_, ncols_, K_, scale_, dst_, ldd_, r0_, kofs_) do { const int _n = ((K_) / 64) * (((ncols_) + 255) / 256); \
    for (int _it = (bx + G - (ibase % G)) % G; _it < _n; _it += G) tr_item(W_, ldw_, c0_, ncols_, scale_, dst_, ldd_, r0_, kofs_, lds, _it, tid); ibase += _n; } while (0)

__device__ __forceinline__ void build_rs_table(const pg8::StaticOrder& S, const float* ssqp, LAS unsigned char* lds, int tid) {
    LAS int* pml = (LAS int*)(lds + RS_OFF); LAS float* tab = (LAS float*)(lds + RS_OFF + 32);
    __syncthreads();
    if (tid == 0) { int npm = 0;
        for (int k = 0; k < pg8::RS_SLOTS; ++k) pml[k] = -1;
        for (int i = 0; ; ++i) { pg8::Unit u; if (!S.next(i, u)) break; bool found = false;
            for (int k = 0; k < npm; ++k) found = found || (pml[k] == u.pm);
            if (!found && npm < pg8::RS_SLOTS) pml[npm++] = u.pm; } }
    __syncthreads();
#pragma unroll 1
    for (int s = tid >> 8; s < pg8::RS_SLOTS; s += 2) { const int pm = pml[s]; if (pm < 0) continue;
        const float* p = ssqp + ((size_t)pm * 256 + (tid & 255)) * 16;
        const f32x4 a = *(const f32x4*)p, b = *(const f32x4*)(p + 4), c = *(const f32x4*)(p + 8), d = *(const f32x4*)(p + 12);
        const float ss = ((a[0] + a[1]) + (a[2] + a[3])) + ((b[0] + b[1]) + (b[2] + b[3])) + ((c[0] + c[1]) + (c[2] + c[3])) + ((d[0] + d[1]) + (d[2] + d[3]));
        tab[s * 256 + (tid & 255)] = rsqrtf(ss * (1.0f / 1024.0f) + 1e-6f); }
    __syncthreads();
}
struct Args { const float* in[23]; float* out; unsigned char* ws; int ph_lo, ph_hi; };
constexpr int NPH = 10, PH_FINAL = DEPTH * NPH, N_PHASES = PH_FINAL + 1;

typedef short bf16x8 __attribute__((ext_vector_type(8)));
constexpr int PT = 72, MAT = 64 * PT * 2;
constexpr int SETB = 4 * MAT + 512;
constexpr int L_Q = 0, L_K = MAT, L_V = 2 * MAT, L_U = 2 * MAT, L_W = 3 * MAT, L_G = 4 * MAT, L_DT = 4 * MAT + 256;
constexpr int L_VT = 2 * SETB, L_ST0 = L_VT + MAT, L_ST1 = L_ST0 + MAT, L_PP = L_ST1 + MAT, L_YT = L_PP + MAT, L_WEND = L_YT + 2 * MAT;
static_assert(L_WEND <= RING_BYTES, "walker LDS");
constexpr size_t GW_OFF = 0, HALO_OFF = 32 * MiB;
constexpr int HALO_LD = 2304;
#define MFMA16(a, b, c) __builtin_amdgcn_mfma_f32_16x16x32_bf16(a, b, c, 0, 0, 0)
__device__ __forceinline__ bf16x8 ldfrag(LAS unsigned char* base, int row, int kelem) { return *(const LAS bf16x8*)(base + row * (PT * 2) + kelem * 2); }
__device__ __forceinline__ void unpk8(const v4u w, float (&f)[8]) { f[0] = pg8::bflo(w.x); f[1] = pg8::bfhi(w.x); f[2] = pg8::bflo(w.y); f[3] = pg8::bfhi(w.y); f[4] = pg8::bflo(w.z); f[5] = pg8::bfhi(w.z); f[6] = pg8::bflo(w.w); f[7] = pg8::bfhi(w.w); }
__device__ __forceinline__ v4u pk8(const float (&f)[8]) { v4u w; w.x = pk2(f[0], f[1]); w.y = pk2(f[2], f[3]); w.z = pk2(f[4], f[5]); w.w = pk2(f[6], f[7]); return w; }
__device__ __forceinline__ void st_tr8(LAS unsigned char* base, int row0, int col, const float (&f)[8]) {
#pragma unroll
    for (int j = 0; j < 8; ++j) *(LAS bf16*)(base + (row0 + j) * (PT * 2) + col * 2) = (bf16)f2bf(f[j]);
}

#define LBAR() asm volatile("s_waitcnt lgkmcnt(0)\n\ts_barrier" ::: "memory")
typedef short s16x4 __attribute__((ext_vector_type(4)));
__device__ __forceinline__ s16x4 tr4(LAS unsigned char* p) { return __builtin_bit_cast(s16x4, __builtin_amdgcn_ds_read_tr16_b64_v4i16((LAS s16x4*)p)); }
__device__ __forceinline__ bf16x8 trfrag(LAS unsigned char* tile, int krow0, int col0, int fr) {
    LAS unsigned char* a = tile + (krow0 + (fr >> 2)) * (PT * 2) + (col0 + 4 * (fr & 3)) * 2;
    const s16x4 lo = tr4(a), hi = tr4(a + 4 * PT * 2);
    return (bf16x8){lo[0], lo[1], lo[2], lo[3], hi[0], hi[1], hi[2], hi[3]};
}
__device__ __forceinline__ float bfs(short v) { return __uint_as_float((unsigned)(unsigned short)v << 16); }
__device__ __forceinline__ float sum8(float v) {
    v += __int_as_float(__builtin_amdgcn_update_dpp(0, __float_as_int(v), 0xB1, 0xF, 0xF, true));
    v += __int_as_float(__builtin_amdgcn_update_dpp(0, __float_as_int(v), 0x4E, 0xF, 0xF, true));
    v += __int_as_float(__builtin_amdgcn_update_dpp(0, __float_as_int(v), 0x141, 0xF, 0xF, true));
    return v;
}
typedef short bf16x4 __attribute__((ext_vector_type(4)));
#define MFMA16K16(a, b, c) __builtin_amdgcn_mfma_f32_16x16x16bf16_1k(a, b, c, 0, 0, 0)
__device__ __forceinline__ bf16x4 pk4(const pg8::f32x4 v) { v2u w; w.x = pk2(v[0], v[1]); w.y = pk2(v[2], v[3]); return __builtin_bit_cast(bf16x4, w); }

template <int KIND>
__device__ __forceinline__ void mixer_walk(const __attribute__((address_space(4))) Args* kp, int layer, int b, int h, LAS unsigned char* lds, const int pm = 0) {
    int tid = threadIdx.x; asm volatile("" : "+v"(tid));
    const int lane = tid & 63, wave = __builtin_amdgcn_readfirstlane(tid >> 6), fr = lane & 15, fq = lane >> 4;
    const int prow = tid >> 3, pcg = tid & 7;
    unsigned char* ws = kp->ws;
    const bf16* MIX = (const bf16*)(ws + WS_MIX); bf16* ZB = (bf16*)(ws + WS_ZB); float* SM = (float*)(ws + WS_SM);
    const bf16* GW = (const bf16*)(ws + ((layer & 1) ? WS_XB0 : WS_XB1) + GW_OFF);
    const size_t tok0 = (size_t)b * SEQ;
    const int g = h >> 2;
    const int qcol = (KIND == 0 ? MX_AQ + h * 64 : (KIND == 1 ? MX_BC + g * 64 : MX_CQ + h * 64)) + pcg * 8;
    const int kcol = (KIND == 0 ? MX_AK + h * 64 : (KIND == 1 ? MX_BB + g * 64 : MX_CK + h * 64)) + pcg * 8;
    const int vcol = (KIND == 0 ? MX_AV + h * 64 : (KIND == 1 ? MX_BX + h * 64 : MX_CV + h * 64)) + pcg * 8;
    const int zcol = KIND * 512 + h * 64 + pcg * 8;
    const int gcol = (KIND == 0 ? 8 : 16) + h;
    float nw[8];
    if (KIND == 0) {
#pragma unroll
        for (int j = 0; j < 8; ++j) nw[j] = kp->in[7][layer * 64 + pcg * 8 + j];
    }
    const float p_D = KIND == 1 ? kp->in[12][layer * 8 + h] : 0.f;
    const float p_lg = KIND == 2 ? log1pf(-exp2f(-5.0f - (float)h)) : 0.f;
    for (int i = tid; i < MAT / 4; i += 512) ((LAS unsigned*)(lds + L_ST0))[i] = 0u;
    pg8::f32x4 sacc[4];
#pragma unroll
    for (int i = 0; i < 4; ++i) sacc[i] = (pg8::f32x4){0.f, 0.f, 0.f, 0.f};

    v4u tq, tk, tv, tw, tz; float sg = 0.f, sd = 1.f; (void)tw;
    pg8::f32x4 rc0, rc1, rs0, rs1; (void)rc0; (void)rc1; (void)rs0; (void)rs1;
    const float* ROPE = (const float*)(ws + WS_ROPE);
#define WALK_LOAD(c) do { const size_t row = tok0 + (size_t)(pm ? 0 : (c)) * 64 + prow; \
        tq = *(const GAS v4u*)(MIX + mixh(qcol, row)); tk = *(const GAS v4u*)(MIX + mixh(kcol, row)); tv = *(const GAS v4u*)(MIX + mixh(vcol, row)); \
        if (KIND == 0) tw = *(const GAS v4u*)(GW + gwh(h, pcg * 8, row)); \
        if (KIND == 2) { const float* rp = ROPE + ((c) * 64 + prow) * 32 + (pcg & 3) * 8; rc0 = *(const GAS pg8::f32x4*)rp; rc1 = *(const GAS pg8::f32x4*)(rp + 4); \
            rs0 = *(const GAS pg8::f32x4*)(rp + SEQ * 32); rs1 = *(const GAS pg8::f32x4*)(rp + SEQ * 32 + 4); } \
        tz = *(const GAS v4u*)(ZB + row * ZB_LD + zcol); \
        if (tid < 64) { const size_t r2 = tok0 + (size_t)(pm ? 0 : (c)) * 64 + tid; \
            if (KIND == 2) sg = (float)(tid + 1) * p_lg; else sg = SM[r2 * SM_LD + gcol]; \
            if (KIND == 1) sd = SM[r2 * SM_LD + 24 + h]; } } while (0)
#define WALK_ROT(t_, sc_) do { v4u pw_; pw_.x = __shfl_xor(t_.x, 4); pw_.y = __shfl_xor(t_.y, 4); pw_.z = __shfl_xor(t_.z, 4); pw_.w = __shfl_xor(t_.w, 4); \
        float a_[8], p_[8]; unpk8(t_, a_); unpk8(pw_, p_); const float sg_ = (pcg < 4 ? -(sc_) : (sc_)); \
        _Pragma("unroll") for (int j_ = 0; j_ < 4; ++j_) { a_[j_] = a_[j_] * (rc0[j_] * (sc_)) + p_[j_] * (rs0[j_] * sg_); a_[4 + j_] = a_[4 + j_] * (rc1[j_] * (sc_)) + p_[4 + j_] * (rs1[j_] * sg_); } \
        t_ = pk8(a_); } while (0)
#define WALK_PREP(sb_) do { LAS unsigned char* sp_ = lds + (sb_) * SETB; \
        if (KIND == 2) { WALK_ROT(tq, 1.0f); WALK_ROT(tk, 0.125f); } \
        *(LAS v4u*)(sp_ + L_Q + prow * (PT * 2) + pcg * 16) = tq; *(LAS v4u*)(sp_ + L_K + prow * (PT * 2) + pcg * 16) = tk; \
        *(LAS v4u*)(sp_ + L_V + prow * (PT * 2) + pcg * 16) = tv; \
        if (KIND == 0) *(LAS v4u*)(sp_ + L_W + prow * (PT * 2) + pcg * 16) = tw; \
        if (tid < 64) { ((LAS float*)(sp_ + L_G))[tid] = sg; ((LAS float*)(sp_ + L_DT))[tid] = sd; } } while (0)

    WALK_LOAD(0);
    WALK_PREP(0);
    v4u zc = tz, xc = tv;
    LBAR();
    for (int c = 0; c < SEQ / 64; ++c) {
        LAS unsigned char* STc = lds + ((c & 1) ? L_ST1 : L_ST0); LAS unsigned char* STn = lds + ((c & 1) ? L_ST0 : L_ST1);
        LAS unsigned char* sp = lds + (c & 1) * SETB;
        const LAS float* Gv = (const LAS float*)(sp + L_G); const LAS float* Dv = (const LAS float*)(sp + L_DT);
        LAS unsigned char* YTc = lds + L_YT + (c & 1) * MAT;
        if (c + 1 < SEQ / 64) WALK_LOAD(c + 1);
        bf16x8 Qf[2]; bf16x4 Pb[4]; float egl_y = 1.f;
        if (wave < 4) { const int lb = wave;
            Qf[0] = ldfrag(sp + L_Q, 16 * lb + fr, 8 * fq); Qf[1] = ldfrag(sp + L_Q, 16 * lb + fr, 32 + 8 * fq);
            bf16x8 Kb[4][2]; pg8::f32x4 gs[4], ds[4], pacc[4];
#pragma unroll
            for (int sb = 0; sb < 4; ++sb) if (sb <= lb) { Kb[sb][0] = ldfrag(sp + L_K, 16 * sb + fr, 8 * fq); Kb[sb][1] = ldfrag(sp + L_K, 16 * sb + fr, 32 + 8 * fq);
                gs[sb] = *(const LAS pg8::f32x4*)(Gv + 16 * sb + 4 * fq); ds[sb] = (pg8::f32x4){1.f, 1.f, 1.f, 1.f};
                if (KIND == 1) ds[sb] = *(const LAS pg8::f32x4*)(Dv + 16 * sb + 4 * fq); }
            const float gl = Gv[16 * lb + fr];
#pragma unroll
            for (int sb = 0; sb < 4; ++sb) if (sb <= lb) { pacc[sb] = MFMA16(Kb[sb][0], Qf[0], ((pg8::f32x4){0.f, 0.f, 0.f, 0.f})); }
#pragma unroll
            for (int sb = 0; sb < 4; ++sb) if (sb <= lb) { pacc[sb] = MFMA16(Kb[sb][1], Qf[1], pacc[sb]); }
            egl_y = __expf(gl);
#pragma unroll
            for (int sb = 0; sb < 4; ++sb) if (sb <= lb) { pg8::f32x4 pv;
#pragma unroll
                    for (int r = 0; r < 4; ++r) pv[r] = (16 * sb + 4 * fq + r <= 16 * lb + fr) ? pacc[sb][r] * __expf(gl - gs[sb][r]) * ds[sb][r] : 0.f;
                    Pb[sb] = pk4(pv); }
        } else if (KIND == 0) { const int wq = wave - 4;
            const bf16x8 Wf0 = ldfrag(sp + L_W, 16 * wq + fr, 8 * fq), Wf1 = ldfrag(sp + L_W, 16 * wq + fr, 32 + 8 * fq);
            bf16x8 Sf[4][2]; s16x4 u4[4]; pg8::f32x4 vacc[4];
#pragma unroll
            for (int eb = 0; eb < 4; ++eb) { Sf[eb][0] = ldfrag(STc, 16 * eb + fr, 8 * fq); Sf[eb][1] = ldfrag(STc, 16 * eb + fr, 32 + 8 * fq);
                u4[eb] = tr4(sp + L_U + (16 * wq + 4 * fq + (fr >> 2)) * (PT * 2) + (16 * eb + 4 * (fr & 3)) * 2); }
#pragma unroll
            for (int eb = 0; eb < 4; ++eb) vacc[eb] = MFMA16(Wf0, Sf[eb][0], ((pg8::f32x4){0.f, 0.f, 0.f, 0.f}));
#pragma unroll
            for (int eb = 0; eb < 4; ++eb) vacc[eb] = MFMA16(Wf1, Sf[eb][1], vacc[eb]);
#pragma unroll
            for (int eb = 0; eb < 4; ++eb) { v2u o; o.x = pk2(bfs(u4[eb][0]) - vacc[eb][0], bfs(u4[eb][1]) - vacc[eb][1]); o.y = pk2(bfs(u4[eb][2]) - vacc[eb][2], bfs(u4[eb][3]) - vacc[eb][3]);
                *(LAS v2u*)(lds + L_VT + (16 * eb + fr) * (PT * 2) + (16 * wq + 4 * fq) * 2) = o; }
        }
        if (KIND == 0) LBAR();
        if (wave < 4) { const int lb = wave;
            bf16x8 Sf[4][2]; bf16x4 Va[4][4]; pg8::f32x4 yacc[4];
#pragma unroll
            for (int eb = 0; eb < 4; ++eb) { Sf[eb][0] = ldfrag(STc, 16 * eb + fr, 8 * fq); Sf[eb][1] = ldfrag(STc, 16 * eb + fr, 32 + 8 * fq);
#pragma unroll
                for (int sb = 0; sb < 4; ++sb) if (sb <= lb) {
                    if (KIND == 0) Va[eb][sb] = *(const LAS bf16x4*)(lds + L_VT + (16 * eb + fr) * (PT * 2) + (16 * sb + 4 * fq) * 2);
                    else Va[eb][sb] = tr4(sp + L_V + (16 * sb + 4 * fq + (fr >> 2)) * (PT * 2) + (16 * eb + 4 * (fr & 3)) * 2); } }
#pragma unroll
            for (int eb = 0; eb < 4; ++eb) yacc[eb] = MFMA16(Sf[eb][0], Qf[0], ((pg8::f32x4){0.f, 0.f, 0.f, 0.f}));
#pragma unroll
            for (int eb = 0; eb < 4; ++eb) yacc[eb] = MFMA16(Sf[eb][1], Qf[1], yacc[eb]);
#pragma unroll
            for (int eb = 0; eb < 4; ++eb) yacc[eb] *= egl_y;
#pragma unroll
            for (int sb = 0; sb < 4; ++sb) if (sb <= lb) {
#pragma unroll
                for (int eb = 0; eb < 4; ++eb) yacc[eb] = MFMA16K16(Va[eb][sb], Pb[sb], yacc[eb]); }
#pragma unroll
            for (int eb = 0; eb < 4; ++eb) { v2u o; o.x = pk2(yacc[eb][0], yacc[eb][1]); o.y = pk2(yacc[eb][2], yacc[eb][3]);
                *(LAS v2u*)(YTc + (16 * lb + fr) * (PT * 2) + (16 * eb + 4 * fq) * 2) = o; }
        } else { const int db = wave - 4;
            const float glast = Gv[63], egl = __expf(glast);
            bf16x8 Kr[2], Vf[4][2]; pg8::f32x4 g0[2], g1[2], d0[2], d1[2];
#pragma unroll
            for (int ks = 0; ks < 2; ++ks) { Kr[ks] = trfrag(sp + L_K, 32 * ks + 8 * fq, 16 * db, fr);
                g0[ks] = *(const LAS pg8::f32x4*)(Gv + 32 * ks + 8 * fq); g1[ks] = *(const LAS pg8::f32x4*)(Gv + 32 * ks + 8 * fq + 4);
                d0[ks] = (pg8::f32x4){1.f, 1.f, 1.f, 1.f}; d1[ks] = d0[ks];
                if (KIND == 1) { d0[ks] = *(const LAS pg8::f32x4*)(Dv + 32 * ks + 8 * fq); d1[ks] = *(const LAS pg8::f32x4*)(Dv + 32 * ks + 8 * fq + 4); } }
#pragma unroll
            for (int eb = 0; eb < 4; ++eb) {
                if (KIND == 0) { Vf[eb][0] = ldfrag(lds + L_VT, 16 * eb + fr, 8 * fq); Vf[eb][1] = ldfrag(lds + L_VT, 16 * eb + fr, 32 + 8 * fq); }
                else { Vf[eb][0] = trfrag(sp + L_V, 8 * fq, 16 * eb, fr); Vf[eb][1] = trfrag(sp + L_V, 32 + 8 * fq, 16 * eb, fr); } }
            bf16x8 Kf[2];
#pragma unroll
            for (int ks = 0; ks < 2; ++ks) { float kf[8];
#pragma unroll
                for (int j = 0; j < 4; ++j) { kf[j] = bfs(Kr[ks][j]) * __expf(glast - g0[ks][j]) * d0[ks][j]; kf[4 + j] = bfs(Kr[ks][4 + j]) * __expf(glast - g1[ks][j]) * d1[ks][j]; }
                const v4u kw = pk8(kf); Kf[ks] = __builtin_bit_cast(bf16x8, kw); }
#pragma unroll
            for (int eb = 0; eb < 4; ++eb) sacc[eb] = MFMA16(Kf[0], Vf[eb][0], sacc[eb] * egl);
#pragma unroll
            for (int eb = 0; eb < 4; ++eb) sacc[eb] = MFMA16(Kf[1], Vf[eb][1], sacc[eb]);
#pragma unroll
            for (int eb = 0; eb < 4; ++eb) { v2u o; o.x = pk2(sacc[eb][0], sacc[eb][1]); o.y = pk2(sacc[eb][2], sacc[eb][3]);
                *(LAS v2u*)(STn + (16 * eb + fr) * (PT * 2) + (16 * db + 4 * fq) * 2) = o; }
        }
        const v4u zcur = zc, xcur = xc; (void)xcur;
        if (c + 1 < SEQ / 64) { WALK_PREP((c + 1) & 1); zc = tz; xc = tv; }
        LBAR();
        {
            float y[8], zf[8]; unpk8(*(const LAS v4u*)(YTc + prow * (PT * 2) + pcg * 16), y); unpk8(zcur, zf);
            const size_t row = tok0 + (size_t)c * 64 + prow;
            if (KIND == 1) { float ss = 0.f, xf[8]; unpk8(xcur, xf);
#pragma unroll
                for (int j = 0; j < 8; ++j) { y[j] = (y[j] + p_D * xf[j]) * siluf(zf[j]); ss += y[j] * y[j]; }
                ss = sum8(ss);
                if (pcg == 0 && !pm) SM[row * SM_LD + 16 + h] = ss;
            } else { float ss = 0.f;
#pragma unroll
                for (int j = 0; j < 8; ++j) ss += y[j] * y[j];
                ss = sum8(ss);
                const float rstd = rsqrtf(ss * (1.0f / 64.0f) + 1e-6f);
#pragma unroll
                for (int j = 0; j < 8; ++j) y[j] = y[j] * rstd * (KIND == 0 ? nw[j] : 1.0f) * siluf(zf[j]); }
            if (!pm || y[0] == 1234.567f) *(GAS v4u*)(ZB + row * ZB_LD + zcol) = pk8(y);
        }
    }
#undef WALK_LOAD
#undef WALK_PREP
#undef WALK_ROT
}

constexpr int W2_SET = 3 * MAT + 512, W2_Q = 0, W2_K = MAT, W2_V = 2 * MAT, W2_G = 3 * MAT, W2_DT = 3 * MAT + 256;
constexpr int W2_ST0 = 2 * W2_SET, W2_ST1 = W2_ST0 + MAT, W2_PP = W2_ST1 + MAT, W2_YT = W2_PP + MAT, W2_ZT = W2_YT + 2 * MAT, W2_END = W2_ZT + 3 * 8192;
static_assert(W2_END <= RING_BYTES, "walker2 LDS");
template <int KIND>
__device__ __forceinline__ void mixer_walk2(const __attribute__((address_space(4))) Args* kp, int layer, int b, int h, LAS unsigned char* lds, const int pm = 0) {
    int tid = threadIdx.x; asm volatile("" : "+v"(tid));
    const int lane = tid & 63, wave = __builtin_amdgcn_readfirstlane(tid >> 6), fr = lane & 15, fq = lane >> 4;
    const int grp = wave >> 2, gl = tid & 255, lrow = gl >> 2, i4 = gl & 3;
    const int prow = tid >> 3, pcg = tid & 7;
    unsigned char* ws = kp->ws;
    const bf16* MIX = (const bf16*)(ws + WS_MIX); bf16* ZB = (bf16*)(ws + WS_ZB); float* SM = (float*)(ws + WS_SM); const float* ROPE = (const float*)(ws + WS_ROPE);
    const size_t tok0 = (size_t)b * SEQ;
    const int g = h >> 2;
    const int qcol = (KIND == 1 ? MX_BC + g * 64 : MX_CQ + h * 64) + i4 * 8, kcol = (KIND == 1 ? MX_BB + g * 64 : MX_CK + h * 64) + i4 * 8, vcol = (KIND == 1 ? MX_BX + h * 64 : MX_CV + h * 64) + i4 * 8;
    const int zc0 = KIND * 512 + h * 64;
    const float p_D = KIND == 1 ? kp->in[12][layer * 8 + h] : 0.f;
    const float p_lg = KIND == 2 ? log1pf(-exp2f(-5.0f - (float)h)) : 0.f;
    for (int i = tid; i < MAT / 4; i += 512) ((LAS unsigned*)(lds + W2_ST0))[i] = 0u;
    pg8::f32x4 sacc[4];
#pragma unroll
    for (int i = 0; i < 4; ++i) sacc[i] = (pg8::f32x4){0.f, 0.f, 0.f, 0.f};

    v4u tq0, tq1, tk0, tk1, tv0, tv1, tz0, tz1; float sg = 0.f, sd = 1.f;
    pg8::f32x4 rc0, rc1, rs0, rs1; (void)rc0; (void)rc1; (void)rs0; (void)rs1;
#define W2_FETCH(c) do { const size_t row = tok0 + (size_t)(pm ? 0 : (c)) * 64 + lrow; \
        tq0 = *(const GAS v4u*)(MIX + mixh(qcol, row)); tq1 = *(const GAS v4u*)(MIX + mixh(qcol + 32, row)); tk0 = *(const GAS v4u*)(MIX + mixh(kcol, row)); tk1 = *(const GAS v4u*)(MIX + mixh(kcol + 32, row)); \
        tv0 = *(const GAS v4u*)(MIX + mixh(vcol, row)); tv1 = *(const GAS v4u*)(MIX + mixh(vcol + 32, row)); \
        tz0 = *(const GAS v4u*)(ZB + row * ZB_LD + zc0 + i4 * 8); tz1 = *(const GAS v4u*)(ZB + row * ZB_LD + zc0 + 32 + i4 * 8); \
        if (KIND == 2) { const float* rp = ROPE + ((pm ? 0 : (c)) * 64 + lrow) * 32 + i4 * 8; rc0 = *(const GAS pg8::f32x4*)rp; rc1 = *(const GAS pg8::f32x4*)(rp + 4); \
            rs0 = *(const GAS pg8::f32x4*)(rp + SEQ * 32); rs1 = *(const GAS pg8::f32x4*)(rp + SEQ * 32 + 4); } \
        if (gl < 64) { const size_t r2 = tok0 + (size_t)(pm ? 0 : (c)) * 64 + gl; \
            if (KIND == 2) sg = (float)(gl + 1) * p_lg; else sg = SM[r2 * SM_LD + 16 + h]; \
            if (KIND == 1) sd = SM[r2 * SM_LD + 24 + h]; } } while (0)
#define W2_ROT(ta_, tb_, sc_) do { float a_[8], b_[8], o1_[8], o2_[8]; unpk8(ta_, a_); unpk8(tb_, b_); \
        _Pragma("unroll") for (int j_ = 0; j_ < 4; ++j_) { \
            o1_[j_] = (a_[j_] * rc0[j_] - b_[j_] * rs0[j_]) * (sc_); o2_[j_] = (a_[j_] * rs0[j_] + b_[j_] * rc0[j_]) * (sc_); \
            o1_[4 + j_] = (a_[4 + j_] * rc1[j_] - b_[4 + j_] * rs1[j_]) * (sc_); o2_[4 + j_] = (a_[4 + j_] * rs1[j_] + b_[4 + j_] * rc1[j_]) * (sc_); } \
        ta_ = pk8(o1_); tb_ = pk8(o2_); } while (0)
#define W2_STORE(c, z3_) do { LAS unsigned char* sp_ = lds + ((c) & 1) * W2_SET + lrow * (PT * 2) + i4 * 16; \
        if (KIND == 2) { W2_ROT(tq0, tq1, 1.0f); W2_ROT(tk0, tk1, 0.125f); } \
        *(LAS v4u*)(sp_ + W2_Q) = tq0; *(LAS v4u*)(sp_ + W2_Q + 64) = tq1; *(LAS v4u*)(sp_ + W2_K) = tk0; *(LAS v4u*)(sp_ + W2_K + 64) = tk1; \
        *(LAS v4u*)(sp_ + W2_V) = tv0; *(LAS v4u*)(sp_ + W2_V + 64) = tv1; \
        { LAS unsigned char* zp_ = lds + W2_ZT + (z3_) * 8192 + lrow * 128 + i4 * 16; *(LAS v4u*)zp_ = tz0; *(LAS v4u*)(zp_ + 64) = tz1; } \
        if (gl < 64) { LAS float* gp_ = (LAS float*)(lds + ((c) & 1) * W2_SET + W2_G); gp_[gl] = sg; gp_[64 + gl] = sd; } } while (0)

    if (grp == 0) { W2_FETCH(0); W2_STORE(0, 0); W2_FETCH(2); } else { W2_FETCH(1); }
    LBAR();
    int z3 = 0;
    for (int c = 0; c < SEQ / 64; ++c) {
        LAS unsigned char* STc = lds + ((c & 1) ? W2_ST1 : W2_ST0); LAS unsigned char* STn = lds + ((c & 1) ? W2_ST0 : W2_ST1);
        LAS unsigned char* sp = lds + (c & 1) * W2_SET;
        const LAS float* Gv = (const LAS float*)(sp + W2_G); const LAS float* Dv = (const LAS float*)(sp + W2_DT);
        LAS unsigned char* YTc = lds + W2_YT + (c & 1) * MAT;
        const int z3n = z3 == 2 ? 0 : z3 + 1;
        if (wave < 4) { const int lb = wave;
            bf16x8 Qf[2];
            Qf[0] = ldfrag(sp + W2_Q, 16 * lb + fr, 8 * fq); Qf[1] = ldfrag(sp + W2_Q, 16 * lb + fr, 32 + 8 * fq);
            bf16x8 Kb[4][2]; pg8::f32x4 gs[4], ds[4], pacc[4];
#pragma unroll
            for (int sb = 0; sb < 4; ++sb) if (sb <= lb) { Kb[sb][0] = ldfrag(sp + W2_K, 16 * sb + fr, 8 * fq); Kb[sb][1] = ldfrag(sp + W2_K, 16 * sb + fr, 32 + 8 * fq);
                gs[sb] = *(const LAS pg8::f32x4*)(Gv + 16 * sb + 4 * fq); ds[sb] = (pg8::f32x4){1.f, 1.f, 1.f, 1.f};
                if (KIND == 1) ds[sb] = *(const LAS pg8::f32x4*)(Dv + 16 * sb + 4 * fq); }
            const float gl_ = Gv[16 * lb + fr];
#pragma unroll
            for (int sb = 0; sb < 4; ++sb) if (sb <= lb) { pacc[sb] = MFMA16(Kb[sb][0], Qf[0], ((pg8::f32x4){0.f, 0.f, 0.f, 0.f})); }
#pragma unroll
            for (int sb = 0; sb < 4; ++sb) if (sb <= lb) { pacc[sb] = MFMA16(Kb[sb][1], Qf[1], pacc[sb]); }
            bf16x4 Pb[4]; const float egl_y = __expf(gl_);
#pragma unroll
            for (int sb = 0; sb < 4; ++sb) if (sb <= lb) { pg8::f32x4 pv;
#pragma unroll
                    for (int r = 0; r < 4; ++r) { pv[r] = (16 * sb + 4 * fq + r <= 16 * lb + fr) ? pacc[sb][r] * __expf(gl_ - gs[sb][r]) * ds[sb][r] : 0.f;
                        if (KIND == 1 && sb == lb && 4 * fq + r == fr) pv[r] += p_D; }
                    Pb[sb] = pk4(pv); }
            pg8::f32x4 yacc[4];
            { bf16x8 Sf[4][2];
#pragma unroll
              for (int eb = 0; eb < 4; ++eb) { Sf[eb][0] = ldfrag(STc, 16 * eb + fr, 8 * fq); Sf[eb][1] = ldfrag(STc, 16 * eb + fr, 32 + 8 * fq); }
#pragma unroll
              for (int eb = 0; eb < 4; ++eb) yacc[eb] = MFMA16(Sf[eb][0], Qf[0], ((pg8::f32x4){0.f, 0.f, 0.f, 0.f}));
#pragma unroll
              for (int eb = 0; eb < 4; ++eb) yacc[eb] = MFMA16(Sf[eb][1], Qf[1], yacc[eb]); }
#pragma unroll
            for (int eb = 0; eb < 4; ++eb) yacc[eb] *= egl_y;
#pragma unroll
            for (int sp2 = 0; sp2 < 2; ++sp2) if (2 * sp2 <= lb) { bf16x4 Va[4][2];
#pragma unroll
                for (int eb = 0; eb < 4; ++eb)
#pragma unroll
                    for (int s2 = 0; s2 < 2; ++s2) if (2 * sp2 + s2 <= lb) Va[eb][s2] = tr4(sp + W2_V + (16 * (2 * sp2 + s2) + 4 * fq + (fr >> 2)) * (PT * 2) + (16 * eb + 4 * (fr & 3)) * 2);
#pragma unroll
                for (int s2 = 0; s2 < 2; ++s2) if (2 * sp2 + s2 <= lb) {
#pragma unroll
                    for (int eb = 0; eb < 4; ++eb) yacc[eb] = MFMA16K16(Va[eb][s2], Pb[2 * sp2 + s2], yacc[eb]); } }
#pragma unroll
            for (int eb = 0; eb < 4; ++eb) { v2u o; o.x = pk2(yacc[eb][0], yacc[eb][1]); o.y = pk2(yacc[eb][2], yacc[eb][3]);
                *(LAS v2u*)(YTc + (16 * lb + fr) * (PT * 2) + (16 * eb + 4 * fq) * 2) = o; }
        } else { const int db = wave - 4;
            const float glast = Gv[63], egl = __expf(glast);
            bf16x8 Kr[2], Vf[4][2]; pg8::f32x4 g0[2], g1[2], d0[2], d1[2];
#pragma unroll
            for (int ks = 0; ks < 2; ++ks) { Kr[ks] = trfrag(sp + W2_K, 32 * ks + 8 * fq, 16 * db, fr);
                g0[ks] = *(const LAS pg8::f32x4*)(Gv + 32 * ks + 8 * fq); g1[ks] = *(const LAS pg8::f32x4*)(Gv + 32 * ks + 8 * fq + 4);
                d0[ks] = (pg8::f32x4){1.f, 1.f, 1.f, 1.f}; d1[ks] = d0[ks];
                if (KIND == 1) { d0[ks] = *(const LAS pg8::f32x4*)(Dv + 32 * ks + 8 * fq); d1[ks] = *(const LAS pg8::f32x4*)(Dv + 32 * ks + 8 * fq + 4); } }
#pragma unroll
            for (int eb = 0; eb < 4; ++eb) { Vf[eb][0] = trfrag(sp + W2_V, 8 * fq, 16 * eb, fr); Vf[eb][1] = trfrag(sp + W2_V, 32 + 8 * fq, 16 * eb, fr); }
            bf16x8 Kf[2];
#pragma unroll
            for (int ks = 0; ks < 2; ++ks) { float kf[8];
#pragma unroll
                for (int j = 0; j < 4; ++j) { kf[j] = bfs(Kr[ks][j]) * __expf(glast - g0[ks][j]) * d0[ks][j]; kf[4 + j] = bfs(Kr[ks][4 + j]) * __expf(glast - g1[ks][j]) * d1[ks][j]; }
                const v4u kw = pk8(kf); Kf[ks] = __builtin_bit_cast(bf16x8, kw); }
#pragma unroll
            for (int eb = 0; eb < 4; ++eb) sacc[eb] = MFMA16(Kf[0], Vf[eb][0], sacc[eb] * egl);
#pragma unroll
            for (int eb = 0; eb < 4; ++eb) sacc[eb] = MFMA16(Kf[1], Vf[eb][1], sacc[eb]);
#pragma unroll
            for (int eb = 0; eb < 4; ++eb) { v2u o; o.x = pk2(sacc[eb][0], sacc[eb][1]); o.y = pk2(sacc[eb][2], sacc[eb][3]);
                *(LAS v2u*)(STn + (16 * eb + fr) * (PT * 2) + (16 * db + 4 * fq) * 2) = o; }
        }
        if (grp == ((c + 1) & 1)) { if (c + 1 < SEQ / 64) W2_STORE(c + 1, z3n); if (c + 3 < SEQ / 64) W2_FETCH(c + 3); }
        LBAR();
        {
            float y[8], zf[8]; unpk8(*(const LAS v4u*)(YTc + prow * (PT * 2) + pcg * 16), y); unpk8(*(const LAS v4u*)(lds + W2_ZT + z3 * 8192 + prow * 128 + pcg * 16), zf);
            const size_t row = tok0 + (size_t)c * 64 + prow;
            float ss = 0.f;
            if (KIND == 1) {
#pragma unroll
                for (int j = 0; j < 8; ++j) { y[j] = y[j] * siluf(zf[j]); ss += y[j] * y[j]; }
                ss = sum8(ss);
                if (pcg == 0 && !pm) SM[row * SM_LD + 16 + h] = ss;
            } else {
#pragma unroll
                for (int j = 0; j < 8; ++j) ss += y[j] * y[j];
                ss = sum8(ss);
                const float rstd = rsqrtf(ss * (1.0f / 64.0f) + 1e-6f);
#pragma unroll
                for (int j = 0; j < 8; ++j) y[j] = y[j] * rstd * siluf(zf[j]); }
            if (!pm || y[0] == 1234.567f) *(GAS v4u*)(ZB + row * ZB_LD + zc0 + pcg * 8) = pk8(y);
        }
        z3 = z3n;
    }
#undef W2_FETCH
#undef W2_ROT
#undef W2_STORE
}

constexpr int SP_RAW = 0, SP_CW = 67 * 1536, SP_END = SP_CW + 5 * 768 * 4;
static_assert(SP_END <= RING_BYTES, "ssd_prep LDS");
__device__ __forceinline__ void ssd_prep(const __attribute__((address_space(4))) Args* kp, int layer, LAS unsigned char* lds, int G_) {
    int tid = threadIdx.x; asm volatile("" : "+v"(tid));
    const int lane = tid & 63, wave = __builtin_amdgcn_readfirstlane(tid >> 6);
    unsigned char* ws = kp->ws;
    bf16* MIX = (bf16*)(ws + WS_MIX); float* SM = (float*)(ws + WS_SM);
    const bf16* HALO = (const bf16*)(ws + ((layer & 1) ? WS_XB0 : WS_XB1) + HALO_OFF);
    LAS float* CW = (LAS float*)(lds + SP_CW);
    { const float* cw = kp->in[8] + (size_t)layer * 4 * 768; const float* cb = kp->in[9] + (size_t)layer * 768;
      for (int i = tid; i < 768; i += 512) { CW[i] = cw[i]; CW[768 + i] = cw[768 + i]; CW[2 * 768 + i] = cw[2 * 768 + i]; CW[3 * 768 + i] = cw[3 * 768 + i]; CW[4 * 768 + i] = cb[i]; } }
    const float Aexp = expf(kp->in[10][layer * 8 + wave]), dtb = kp->in[11][layer * 8 + wave];
    for (int unit = blockIdx.x; unit < NBATCH * 64; unit += G_) { const int b = unit >> 6, c = unit & 63; const size_t tok0 = (size_t)b * SEQ + (size_t)c * 64;
        LBAR();
        for (int i = tid; i < 67 * 96; i += 512) { const int r = i / 96, pc = i - r * 96; v4u v = (v4u){0u, 0u, 0u, 0u};
            if (r >= 3) v = *(const GAS v4u*)(MIX + mixh(MX_BX + pc * 8, tok0 + r - 3));
            else if (c > 0) v = *(const GAS v4u*)(HALO + ((size_t)(b * 64 + c - 1) * 3 + r) * HALO_LD + MX_BX + pc * 8);
            *(LAS v4u*)(lds + SP_RAW + r * 1536 + pc * 16) = v; }
        { const size_t r2 = tok0 + lane; const float dt = softplusf(SM[r2 * SM_LD + 16 + wave] + dtb); float gs = -Aexp * dt;
#pragma unroll
          for (int o = 1; o < 64; o <<= 1) { const float t_ = __shfl_up(gs, o); if (lane >= o) gs += t_; }
          SM[r2 * SM_LD + 16 + wave] = gs; SM[r2 * SM_LD + 24 + wave] = dt; }
        LBAR();
        for (int i = tid; i < 64 * 96; i += 512) { const int l = i / 96, pc = i - l * 96; float a[8];
            { const pg8::f32x4 b0 = *(const LAS pg8::f32x4*)(CW + 4 * 768 + pc * 8), b1 = *(const LAS pg8::f32x4*)(CW + 4 * 768 + pc * 8 + 4);
              a[0] = b0[0]; a[1] = b0[1]; a[2] = b0[2]; a[3] = b0[3]; a[4] = b1[0]; a[5] = b1[1]; a[6] = b1[2]; a[7] = b1[3]; }
#pragma unroll
            for (int k = 0; k < 4; ++k) { float f[8]; unpk8(*(const LAS v4u*)(lds + SP_RAW + (l + k) * 1536 + pc * 16), f);
                const pg8::f32x4 w0 = *(const LAS pg8::f32x4*)(CW + k * 768 + pc * 8), w1 = *(const LAS pg8::f32x4*)(CW + k * 768 + pc * 8 + 4);
#pragma unroll
                for (int j = 0; j < 4; ++j) { a[j] += w0[j] * f[j]; a[4 + j] += w1[j] * f[4 + j]; } }
#pragma unroll
            for (int j = 0; j < 8; ++j) a[j] = siluf(a[j]);
            *(GAS v4u*)(MIX + mixh(MX_BX + pc * 8, tok0 + l)) = pk8(a); }
    }
    LBAR();
}
constexpr int GQ_RAW = 0, GQ_KN = 67 * 384, GQ_VN = GQ_KN + MAT, GQ_NA = GQ_VN + MAT, GQ_AD = GQ_NA + MAT, GQ_S = GQ_AD + 4 * 16 * 20 * 4, GQ_CW = GQ_S + 512, GQ_TEAM = GQ_CW + 4 * 192 * 4;
static_assert(2 * GQ_TEAM <= RING_BYTES && 2 * MAT <= GQ_KN, "gdn_prep LDS");
__device__ __forceinline__ void gdn_prep(const __attribute__((address_space(4))) Args* kp, int layer, LAS unsigned char* lds_all, int G_) {
    int tid = threadIdx.x; asm volatile("" : "+v"(tid));
    const int team = __builtin_amdgcn_readfirstlane(tid >> 8), j = tid & 255, lane = tid & 63, tw = __builtin_amdgcn_readfirstlane((tid >> 6) & 3), fr = lane & 15, fq = lane >> 4;
    LAS unsigned char* lds = lds_all + team * GQ_TEAM;
    LAS float* AD = (LAS float*)(lds + GQ_AD); LAS float* Gs = (LAS float*)(lds + GQ_S); LAS float* Bs = Gs + 64; LAS float* CW = (LAS float*)(lds + GQ_CW);
    unsigned char* ws = kp->ws;
    bf16* MIX = (bf16*)(ws + WS_MIX); float* SM = (float*)(ws + WS_SM);
    unsigned char* xbf = ws + ((layer & 1) ? WS_XB0 : WS_XB1); bf16* GW = (bf16*)(xbf + GW_OFF); const bf16* HALO = (const bf16*)(xbf + HALO_OFF);
    const float* cw = kp->in[4] + (size_t)layer * 4 * 1536;
    v4u praw[7]; float pcw[3], pbl = 0.f, pal = 0.f;
#define GQ_FETCH(rnd) do { const int u_ = ((rnd) * G_ + (int)blockIdx.x) * 2 + team; const int un_ = u_ < NBATCH * 8 * 64 ? u_ : 0; \
        const int c_ = un_ & 63, h_ = (un_ >> 6) & 7, b_ = un_ >> 9; const size_t tk_ = (size_t)b_ * SEQ + (size_t)c_ * 64; \
        _Pragma("unroll") for (int n = 0; n < 7; ++n) { const int i = j + 256 * n; praw[n] = (v4u){0u, 0u, 0u, 0u}; \
            if (i < 67 * 24) { const int r = i / 24, pc = i - r * 24, col = (pc >> 3) * 512 + h_ * 64 + (pc & 7) * 8; \
                if (r >= 3) praw[n] = *(const GAS v4u*)(MIX + mixh(col, tk_ + r - 3)); \
                else if (c_ > 0) praw[n] = *(const GAS v4u*)(HALO + ((size_t)(b_ * 64 + c_ - 1) * 3 + r) * HALO_LD + col); } } \
        _Pragma("unroll") for (int n = 0; n < 3; ++n) { const int i = j + 256 * n, k = i / 192, cc = i - k * 192; pcw[n] = cw[k * 1536 + (cc >> 6) * 512 + h_ * 64 + (cc & 63)]; } \
        if (tw == 0) { pbl = SM[(tk_ + lane) * SM_LD + h_]; pal = SM[(tk_ + lane) * SM_LD + 8 + h_]; } } while (0)
    GQ_FETCH(0);
    const int nrounds = (NBATCH * 8 * 64 + 2 * G_ - 1) / (2 * G_);
    for (int round = 0; round < nrounds; ++round) {
        const int unit_ = (round * G_ + (int)blockIdx.x) * 2 + team;
        const bool live = unit_ < NBATCH * 8 * 64;
        const int unit = live ? unit_ : 0;
        const int c = unit & 63, h = (unit >> 6) & 7, b = unit >> 9;
        const size_t tok0 = (size_t)b * SEQ + (size_t)c * 64;
        LBAR();
#pragma unroll
        for (int n = 0; n < 7; ++n) { const int i = j + 256 * n; if (i < 67 * 24) { const int r = i / 24, pc = i - r * 24; *(LAS v4u*)(lds + GQ_RAW + r * 384 + pc * 16) = praw[n]; } }
#pragma unroll
        for (int n = 0; n < 3; ++n) CW[j + 256 * n] = pcw[n];
        if (tw == 0) {
            float gsum = -expf(kp->in[5][layer * 8 + h]) * softplusf(pal + kp->in[6][layer * 8 + h]);
#pragma unroll
            for (int o = 1; o < 64; o <<= 1) { const float t_ = __shfl_up(gsum, o); if (lane >= o) gsum += t_; }
            Gs[lane] = gsum; Bs[lane] = sigmf(pbl);
            if (live) SM[(tok0 + lane) * SM_LD + 8 + h] = gsum; }
        if (round + 1 < nrounds) GQ_FETCH(round + 1);
        LBAR();
#pragma unroll 1
        for (int n = 0; n < 3; ++n) { const int i = j + 256 * n, t2 = i / 24, pc = i - t2 * 24, tens = pc >> 3, ch = pc & 7; float a0[8], a1[8];
#pragma unroll
            for (int jj = 0; jj < 8; ++jj) { a0[jj] = 0.f; a1[jj] = 0.f; }
            pg8::f32x4 wl[4], wh[4];
#pragma unroll
            for (int k = 0; k < 4; ++k) { wl[k] = *(const LAS pg8::f32x4*)(CW + k * 192 + pc * 8); wh[k] = *(const LAS pg8::f32x4*)(CW + k * 192 + pc * 8 + 4); }
#pragma unroll
            for (int r = 0; r < 5; ++r) { float f[8]; unpk8(*(const LAS v4u*)(lds + GQ_RAW + (2 * t2 + r) * 384 + pc * 16), f);
                if (r < 4) {
#pragma unroll
                    for (int jj = 0; jj < 4; ++jj) { a0[jj] += wl[r][jj] * f[jj]; a0[4 + jj] += wh[r][jj] * f[4 + jj]; } }
                if (r > 0) {
#pragma unroll
                    for (int jj = 0; jj < 4; ++jj) { a1[jj] += wl[r - 1][jj] * f[jj]; a1[4 + jj] += wh[r - 1][jj] * f[4 + jj]; } } }
            float s0 = 0.f, s1 = 0.f;
#pragma unroll
            for (int jj = 0; jj < 8; ++jj) { a0[jj] = siluf(a0[jj]); a1[jj] = siluf(a1[jj]); s0 += a0[jj] * a0[jj]; s1 += a1[jj] * a1[jj]; }
            s0 = sum8(s0); s1 = sum8(s1);
            const float base = tens == 0 ? 0.125f : 1.0f, c0 = tens == 2 ? 1.0f : rsqrtf(s0 + 1e-6f) * base, c1 = tens == 2 ? 1.0f : rsqrtf(s1 + 1e-6f) * base;
#pragma unroll
            for (int jj = 0; jj < 8; ++jj) { a0[jj] *= c0; a1[jj] *= c1; }
            const v4u o0 = pk8(a0), o1 = pk8(a1); const int t = 2 * t2;
            if (tens == 0) { if (live) { *(GAS v4u*)(MIX + mixh(MX_AQ + h * 64 + ch * 8, tok0 + t)) = o0; *(GAS v4u*)(MIX + mixh(MX_AQ + h * 64 + ch * 8, tok0 + t + 1)) = o1; } }
            else if (tens == 1) { *(LAS v4u*)(lds + GQ_KN + t * (PT * 2) + ch * 16) = o0; *(LAS v4u*)(lds + GQ_KN + (t + 1) * (PT * 2) + ch * 16) = o1;
                if (live) { *(GAS v4u*)(MIX + mixh(MX_AK + h * 64 + ch * 8, tok0 + t)) = o0; *(GAS v4u*)(MIX + mixh(MX_AK + h * 64 + ch * 8, tok0 + t + 1)) = o1; } }
            else { *(LAS v4u*)(lds + GQ_VN + t * (PT * 2) + ch * 16) = o0; *(LAS v4u*)(lds + GQ_VN + (t + 1) * (PT * 2) + ch * 16) = o1; } }
        LBAR();
        for (int id = tw; id < 10; id += 4) { const int lb = id < 1 ? 0 : (id < 3 ? 1 : (id < 6 ? 2 : 3)), sb = id - (lb * (lb + 1)) / 2;
            pg8::f32x4 acc = (pg8::f32x4){0.f, 0.f, 0.f, 0.f};
#pragma unroll
            for (int ks = 0; ks < 2; ++ks) acc = MFMA16(ldfrag(lds + GQ_KN, 16 * lb + fr, 32 * ks + 8 * fq), ldfrag(lds + GQ_KN, 16 * sb + fr, 32 * ks + 8 * fq), acc);
            const int s = 16 * sb + fr; const float gsv = Gs[s];
#pragma unroll
            for (int r = 0; r < 4; ++r) { const int l = 16 * lb + 4 * fq + r; const float v = s < l ? Bs[l] * acc[r] * __expf(Gs[l] - gsv) : 0.f;
                if (lb == sb) AD[(lb * 16 + 4 * fq + r) * 20 + fr] = v;
                else *(LAS bf16*)(lds + GQ_NA + l * (PT * 2) + s * 2) = (bf16)f2bf(-v); } }
        LBAR();
        if (tw == 0) { const int bi = lane >> 4, cc = lane & 15; const LAS float* Ab = AD + bi * 16 * 20; float x[16];
#pragma unroll
            for (int r = 0; r < 16; ++r) { float a = (r == cc) ? 1.0f : 0.0f;
#pragma unroll
                for (int s4 = 0; s4 < r; s4 += 4) { const pg8::f32x4 av = *(const LAS pg8::f32x4*)(Ab + r * 20 + s4);
                    a -= av[0] * x[s4];
                    if (s4 + 1 < r) a -= av[1] * x[s4 + 1];
                    if (s4 + 2 < r) a -= av[2] * x[s4 + 2];
                    if (s4 + 3 < r) a -= av[3] * x[s4 + 3]; }
                x[r] = a; }
#pragma unroll
            for (int r = 0; r < 16; ++r) *(LAS bf16*)(lds + GQ_NA + (16 * bi + r) * (PT * 2) + (16 * bi + cc) * 2) = (bf16)f2bf(x[r]); }
        LBAR();
#pragma unroll 1
        for (int half = 0; half < 2; ++half) { LAS unsigned char* src = lds + (half == 0 ? GQ_VN : GQ_KN); const int c0 = 16 * tw;
            pg8::f32x4 R[4], X[4];
#pragma unroll
            for (int i = 0; i < 4; ++i) { const s16x4 raw = tr4(src + (16 * i + 4 * fq + (fr >> 2)) * (PT * 2) + (c0 + 4 * (fr & 3)) * 2);
                const pg8::f32x4 bv = *(const LAS pg8::f32x4*)(Bs + 16 * i + 4 * fq); pg8::f32x4 sc = bv;
                if (half == 1) { const pg8::f32x4 gv = *(const LAS pg8::f32x4*)(Gs + 16 * i + 4 * fq); sc = (pg8::f32x4){bv[0] * __expf(gv[0]), bv[1] * __expf(gv[1]), bv[2] * __expf(gv[2]), bv[3] * __expf(gv[3])}; }
                R[i] = (pg8::f32x4){bfs(raw[0]) * sc[0], bfs(raw[1]) * sc[1], bfs(raw[2]) * sc[2], bfs(raw[3]) * sc[3]}; }
#define NAF(ib, jb) (*(const LAS bf16x4*)(lds + GQ_NA + (16 * (ib) + fr) * (PT * 2) + (16 * (jb) + 4 * fq) * 2))
            const pg8::f32x4 Z = (pg8::f32x4){0.f, 0.f, 0.f, 0.f};
            X[0] = MFMA16K16(NAF(0, 0), pk4(R[0]), Z);
            { const bf16x4 x0 = pk4(X[0]); R[1] = MFMA16K16(NAF(1, 0), x0, R[1]); R[2] = MFMA16K16(NAF(2, 0), x0, R[2]); R[3] = MFMA16K16(NAF(3, 0), x0, R[3]); }
            X[1] = MFMA16K16(NAF(1, 1), pk4(R[1]), Z);
            { const bf16x4 x1 = pk4(X[1]); R[2] = MFMA16K16(NAF(2, 1), x1, R[2]); R[3] = MFMA16K16(NAF(3, 1), x1, R[3]); }
            X[2] = MFMA16K16(NAF(2, 2), pk4(R[2]), Z);
            { const bf16x4 x2 = pk4(X[2]); R[3] = MFMA16K16(NAF(3, 2), x2, R[3]); }
            X[3] = MFMA16K16(NAF(3, 3), pk4(R[3]), Z);
#undef NAF
#pragma unroll
            for (int i = 0; i < 4; ++i)
#pragma unroll
                for (int r = 0; r < 4; ++r) *(LAS bf16*)(lds + GQ_RAW + half * MAT + (16 * i + 4 * fq + r) * (PT * 2) + (c0 + fr) * 2) = (bf16)f2bf(X[i][r]);
        }
        LBAR();
        if (live) for (int i = j; i < 64 * 16; i += 256) { const int t = (i >> 3) & 63, ch = i & 7, half = i >> 9;
            const v4u v = *(const LAS v4u*)(lds + GQ_RAW + half * MAT + t * (PT * 2) + ch * 16);
            if (half == 0) *(GAS v4u*)(MIX + mixh(MX_AV + h * 64 + ch * 8, tok0 + t)) = v; else *(GAS v4u*)(GW + gwh(h, ch * 8, tok0 + t)) = v; }
    }
    LBAR();
}
#ifndef MK_ONE_LAUNCH
#define MK_ONE_LAUNCH 1
#endif
#define CONVERT_LAYER(L_, WB_) do { \
            int ibase = 0; \
            const float* w_in = kp->in[3] + (size_t)(L_) * DM * NIN; const float* nmix = kp->in[2] + (size_t)(L_) * DM; \
            TR_SEG(w_in, NIN, 1536, 512, DM, nmix, (bf16*)((WB_) + (W_1T - WS_W)), DM, 0, 0); \
            TR_SEG(w_in, NIN, 2064, 512, DM, nmix, (bf16*)((WB_) + (W_1T - WS_W)), DM, 512, 0); \
            TR_SEG(w_in, NIN, 4888, 512, DM, nmix, (bf16*)((WB_) + (W_1T - WS_W)), DM, 1024, 0); \
            TR_SEG(w_in, NIN, 0, 1536, DM, nmix, (bf16*)((WB_) + (W_1T - WS_W)), DM, 1536, 0); \
            TR_SEG(w_in, NIN, 2576, 768, DM, nmix, (bf16*)((WB_) + (W_1T - WS_W)), DM, 3072, 0); \
            TR_SEG(w_in, NIN, 3352, 1536, DM, nmix, (bf16*)((WB_) + (W_1T - WS_W)), DM, 3840, 0); \
            TR_SEG(w_in, NIN, 2048, 16, DM, nmix, (bf16*)((WB_) + (W_1T - WS_W)), DM, 5376, 0); \
            TR_SEG(w_in, NIN, 3344, 8, DM, nmix, (bf16*)((WB_) + (W_1T - WS_W)), DM, 5392, 0); \
            TR_SEG((const float*)nullptr, NIN, 0, 232, DM, (const float*)nullptr, (bf16*)((WB_) + (W_1T - WS_W)), DM, 5400, 0); \
            TR_SEG(w_in, NIN, 5400, 3072, DM, nmix, (bf16*)((WB_) + (W_GT - WS_W)), DM, 0, 0); \
            const float* wbr = kp->in[14] + (size_t)(L_) * 3 * 512 * DM; \
            TR_SEG(wbr, DM, 0, DM, 512, (const float*)nullptr, (bf16*)((WB_) + (W_MT - WS_W)), KMERGE, 0, 0); \
            TR_SEG(wbr + 512 * DM, DM, 0, DM, 512, kp->in[13] + (size_t)(L_) * 512, (bf16*)((WB_) + (W_MT - WS_W)), KMERGE, 0, 512); \
            TR_SEG(wbr + 2 * 512 * DM, DM, 0, DM, 512, (const float*)nullptr, (bf16*)((WB_) + (W_MT - WS_W)), KMERGE, 0, 1024); \
            TR_SEG(kp->in[15] + (size_t)(L_) * DM * DM, DM, 0, DM, DM, (const float*)nullptr, (bf16*)((WB_) + (W_OT - WS_W)), DM, 0, 0); \
            TR_SEG(kp->in[17] + (size_t)(L_) * DM * DFF, DFF, 0, DFF, DM, kp->in[16] + (size_t)(L_) * DM, (bf16*)((WB_) + (W_UT - WS_W)), DM, 0, 0); \
            TR_SEG(kp->in[18] + (size_t)(L_) * DFF * DM, DM, 0, DM, DFF, (const float*)nullptr, (bf16*)((WB_) + (W_DT - WS_W)), DFF, 0, 0); \
            TR_SEG(kp->in[20] + (size_t)(L_) * DM * DM, DM, 0, DM, DM, kp->in[19] + (size_t)(L_) * DM, (bf16*)((WB_) + (W_PGT - WS_W)), DM, 0, 0); \
            TR_SEG(kp->in[21] + (size_t)(L_) * PLED * DM, DM, 0, DM, PLED, (const float*)nullptr, (bf16*)((WB_) + (W_PPT - WS_W)), PLED, 0, 0); \
        } while (0)
__global__ void __launch_bounds__(512, 2) fwd_kernel(Args args) {
    extern __shared__ __attribute__((aligned(16))) unsigned char lds_raw[];
    LAS unsigned char* lds0 = (LAS unsigned char*)lds_raw;
    volatile LAS unsigned* MISC = (volatile LAS unsigned*)(lds0 + MISC_OFF);
    const int G = gridDim.x, NGW = G * 8;
    unsigned char* ws0 = args.ws;
    for (int u = threadIdx.x; u < (LDS_BYTES - RING_BYTES) / 4; u += 512) ((LAS unsigned*)(lds0 + RING_BYTES))[u] = 0u;
    __syncthreads();
#if MK_ONE_LAUNCH
    XcdBarrier bar = xcd_barrier_post((unsigned*)(ws0 + WS_CTL) + 4096, MISC + 8);
#define GRID_BAR() do { XcdBarrier b_ = bar; asm volatile("" : "+s"(b_.bar), "+s"(b_.x)); xcd_barrier(b_); } while (0)
#else
#define GRID_BAR() do {} while (0)
#endif
    const int lo = args.ph_lo, hi = args.ph_hi;
#define IN(p) (lo <= (p) && (p) < hi)
#define SEAM(p) do { if (IN(p) && IN((p) + 1)) GRID_BAR(); } while (0)
    typedef const __attribute__((address_space(4))) Args* KArgs;
    const KArgs kp0 = (KArgs)__builtin_amdgcn_kernarg_segment_ptr();
#define PHASE_PTRS() KArgs kp = kp0; asm volatile("" : "+s"(kp)); unsigned char* ws = kp->ws; float* X = kp->out; (void)X; \
    LAS unsigned char* lds = lds0; \
    int tid = threadIdx.x; asm volatile("" : "+v"(tid)); int bx = blockIdx.x; asm volatile("" : "+s"(bx)); const int lane = tid & 63, wave = __builtin_amdgcn_readfirstlane(tid >> 6), gw = bx * 8 + wave; (void)lane; (void)gw; \
    bf16* ZB = (bf16*)(ws + WS_ZB); bf16* MIX = (bf16*)(ws + WS_MIX); float* SM = (float*)(ws + WS_SM); (void)ZB; (void)MIX; (void)SM; \
    unsigned char* wbase = (layer & 1) ? (unsigned char*)X + 80 * MiB : ws + WS_W;     \
    float* SSQA = (float*)(wbase + (WS_SSQA - WS_W)); float* SSQB = (float*)(wbase + (WS_SSQB - WS_W)); float* SSQC = (float*)(ws + WS_SSQC); float* ROPE = (float*)(ws + WS_ROPE); (void)SSQA; (void)SSQB; (void)SSQC; (void)ROPE; \
    bf16* W1T = (bf16*)(wbase + (W_1T - WS_W)); bf16* WGT = (bf16*)(wbase + (W_GT - WS_W)); bf16* WMT = (bf16*)(wbase + (W_MT - WS_W)); bf16* WOT = (bf16*)(wbase + (W_OT - WS_W)); bf16* WUT = (bf16*)(wbase + (W_UT - WS_W)); (void)W1T; (void)WGT; (void)WMT; (void)WOT; (void)WUT; \
    bf16* WDT = (bf16*)(wbase + (W_DT - WS_W)); bf16* WPGT = (bf16*)(wbase + (W_PGT - WS_W)); bf16* WPPT = (bf16*)(wbase + (W_PPT - WS_W)); (void)WDT; (void)WPGT; (void)WPPT; \
    bf16* GATE = (bf16*)(ws + WS_GATE); bf16* U = (bf16*)(ws + WS_U); bf16* PB = (bf16*)X; bf16* PLE = (bf16*)X + (size_t)MTOK * PLED;     (void)GATE; (void)U; (void)PB; (void)PLE; \
    bf16* XBl = (bf16*)(ws + ((layer & 1) ? WS_XB1 : WS_XB0)); bf16* XBf = (bf16*)(ws + ((layer & 1) ? WS_XB0 : WS_XB1)); (void)XBl; (void)XBf
    if (IN(0)) { const int layer = 0; PHASE_PTRS();
        for (int e = bx * 512 + tid; e < SEQ * 32; e += G * 512) { const int t = e >> 5, i = e & 31;
            double f = 1.0; for (int j = 0; j < i; ++j) f *= 0.7429639507594948;
            const double ang = (double)t * f, kk = rint(ang * 0.15915494309189535);
            double r = fma(-kk, 6.283185307179586, ang); r = fma(-kk, 2.4492935982947064e-16, r); const double r2 = r * r;
            double sn = 1.0, cs = 1.0;
    #pragma unroll
            for (int n = 15; n >= 1; --n) { sn = 1.0 - r2 * (1.0 / (double)((2 * n) * (2 * n + 1))) * sn; cs = 1.0 - r2 * (1.0 / (double)((2 * n - 1) * (2 * n))) * cs; }
            ROPE[e] = (float)cs; ROPE[SEQ * 32 + e] = (float)(r * sn); }
    }
    for (int layer = 0; layer < DEPTH; ++layer) {
        const int P = layer * NPH;
        if (IN(P + 0)) { PHASE_PTRS();
            if (layer == 0 || G <= 192) CONVERT_LAYER(layer, wbase);
            if (layer == 0) {
                const float* xin = kp->in[0];
                for (int m0 = gw; m0 < MTOK; m0 += 2 * NGW) {
                    const bool two = m0 + NGW < MTOK; const int m1 = two ? m0 + NGW : m0;
                    const GAS f32x4* xr0 = (const GAS f32x4*)(xin + (size_t)m0 * DM) + lane; const GAS f32x4* xr1 = (const GAS f32x4*)(xin + (size_t)m1 * DM) + lane; f32x4 v[2][4]; float s0 = 0.f, s1 = 0.f;
#pragma unroll
                    for (int j = 0; j < 4; ++j) { v[0][j] = xr0[64 * j]; v[1][j] = xr1[64 * j]; }
#pragma unroll
                    for (int j = 0; j < 4; ++j) { s0 += (v[0][j].x * v[0][j].x + v[0][j].y * v[0][j].y) + (v[0][j].z * v[0][j].z + v[0][j].w * v[0][j].w);
                                                  s1 += (v[1][j].x * v[1][j].x + v[1][j].y * v[1][j].y) + (v[1][j].z * v[1][j].z + v[1][j].w * v[1][j].w); }
#pragma unroll
                    for (int o = 1; o < 64; o <<= 1) { s0 += __shfl_xor(s0, o); s1 += __shfl_xor(s1, o); }
                    GAS v2u* o0 = (GAS v2u*)(XBl + (size_t)m0 * DM) + lane; GAS v2u* o1 = (GAS v2u*)(XBl + (size_t)m1 * DM) + lane;
#pragma unroll
                    for (int j = 0; j < 4; ++j) { v2u w; w.x = pk2(v[0][j].x, v[0][j].y); w.y = pk2(v[0][j].z, v[0][j].w); o0[64 * j] = w; }
                    if (lane < 16) SSQC[(size_t)m0 * 16 + lane] = lane == 0 ? s0 : 0.f;
                    if (two) {
#pragma unroll
                        for (int j = 0; j < 4; ++j) { v2u w; w.x = pk2(v[1][j].x, v[1][j].y); w.y = pk2(v[1][j].z, v[1][j].w); o1[64 * j] = w; }
                        if (lane < 16) SSQC[(size_t)m1 * 16 + lane] = lane == 0 ? s1 : 0.f; }
                }
            }
        }
        if (layer == 0 || G <= 192) SEAM(P + 0);
        if (IN(P + 1)) { PHASE_PTRS();
            pg8::Gemm g{XBl, W1T, MTOK, N1, DM}; pg8::StaticOrder S; S.init(MTOK, N1, G, bx);
            build_rs_table(S, SSQC, lds, tid);
            pg8::EpiP1 E{ZB, MIX, SM, lds + RS_OFF, (bf16*)((unsigned char*)XBf + HALO_OFF),  0u};
            pg8::gemm_phase<pg8::EpiP1, pg8::StaticOrder, true, true>(lds, g, S, E);
        }
        SEAM(P + 1);
        if (IN(P + 2)) { PHASE_PTRS();
            gdn_prep(kp, layer, lds, G);
            ssd_prep(kp, layer, lds, G);
            const float* pl = kp->in[1] + (size_t)layer * MTOK * PLED;
            for (size_t e = (size_t)bx * 512 + tid; e < (size_t)MTOK * PLED / 4; e += (size_t)G * 512) { const f32x4 v = ((const GAS f32x4*)pl)[e]; v2u w; w.x = pk2(v.x, v.y); w.y = pk2(v.z, v.w); ((GAS v2u*)PB)[e] = w; }
        }
        SEAM(P + 2);
        if (IN(P + 3)) { PHASE_PTRS();
            for (int w = bx; w < 192; w += G) { const int kind = w >> 6, b = (w & 63) >> 3, h = w & 7;
                if (kind == 0) mixer_walk<0>(kp, layer, b, h, lds);
                else if (kind == 1) mixer_walk2<1>(kp, layer, b, h, lds);
                else mixer_walk2<2>(kp, layer, b, h, lds);
                __syncthreads(); }
            if (layer == 0 && bx >= 192 && G > 192) {
                const int bx_ = bx, G_ = G; { const int bx = bx_ - 192, G = G_ - 192; CONVERT_LAYER(1, (unsigned char*)X + 80 * MiB); }
            } else if ((bx >= 192 || G <= 192) && !(layer == 0 && G > 192)) {
                pg8::Gemm g{PB, WPPT, MTOK / 2, DM, PLED}; pg8::StaticOrder S; if (G > 192) S.init(MTOK / 2, DM, G - 192, bx - 192); else S.init(MTOK / 2, DM, G, bx);
                pg8::EpiRS<0> E{PLE, DM, (LAS unsigned char*)nullptr};
                pg8::gemm_phase<pg8::EpiRS<0>, pg8::StaticOrder, true, true>(lds, g, S, E); }
        }
        SEAM(P + 3);
        if (IN(P + 4)) { PHASE_PTRS();
            for (int m = bx * 512 + tid; m < MTOK; m += G * 512) {
                float* sp = SM + (size_t)m * SM_LD + 16; const f32x4 q0 = *(const f32x4*)sp, q1 = *(const f32x4*)(sp + 4);
                const float v0 = ((q0[0] + q0[1]) + (q0[2] + q0[3])) * (1.0f / 256.0f) + 1e-6f, v1 = ((q1[0] + q1[1]) + (q1[2] + q1[3])) * (1.0f / 256.0f) + 1e-6f;
                const float r0 = __builtin_amdgcn_sqrtf(v0), s1 = __builtin_amdgcn_rsqf(v1);
                *(f32x4*)(sp + 8) = (f32x4){r0, __builtin_amdgcn_rsqf(v0) * __builtin_amdgcn_sqrtf(v1), s1, 0.f}; }
            pg8::Gemm g{XBl, WGT, MTOK, NGATE, DM}; pg8::StaticOrder S; S.init(MTOK, NGATE, G, bx);
            build_rs_table(S, SSQC, lds, tid);
            pg8::EpiRS<2> E{GATE, NGATE, lds + RS_OFF};
            pg8::gemm_phase<pg8::EpiRS<2>, pg8::StaticOrder, true, true>(lds, g, S, E);
        }
        SEAM(P + 4);
        if (IN(P + 5)) { PHASE_PTRS();
            pg8::Gemm g{ZB, WMT, MTOK, DM, KMERGE}; pg8::StaticOrder S; S.init(MTOK, DM, G, bx);
            pg8::EpiMerge E{GATE, XBf, SM};
            pg8::gemm_phase<pg8::EpiMerge, pg8::StaticOrder, true, true>(lds, g, S, E);
        }
        SEAM(P + 5);
        if (IN(P + 6)) { PHASE_PTRS();
            pg8::Gemm g{XBf, WOT, MTOK, DM, DM}; pg8::StaticOrder S; S.init(MTOK, DM, G, bx);
            pg8::EpiResid<0> E{XBl, XBl, SSQA, (LAS unsigned char*)nullptr, nullptr,  1.0f};
            pg8::gemm_phase<pg8::EpiResid<0>, pg8::StaticOrder, true, true>(lds, g, S, E);
        }
        SEAM(P + 6);
        if (IN(P + 7)) { PHASE_PTRS();
            { pg8::Gemm g{XBl, WUT, MTOK, DFF, DM}; pg8::StaticOrder S; S.init(MTOK, DFF, G, bx);
              build_rs_table(S, SSQA, lds, tid);
              pg8::EpiRS<1> E{U, DFF, lds + RS_OFF};
              pg8::gemm_phase<pg8::EpiRS<1>, pg8::StaticOrder, true, true>(lds, g, S, E); }
        }
        SEAM(P + 7);
        if (IN(P + 8)) { PHASE_PTRS();
            pg8::Gemm g{U, WDT, MTOK, DM, DFF}; pg8::StaticOrder S; S.init(MTOK, DM, G, bx);
            pg8::EpiResid<0> E{XBl, XBl, SSQB, (LAS unsigned char*)nullptr, nullptr,  1.0f};
            pg8::gemm_phase<pg8::EpiResid<0>, pg8::StaticOrder, true, true>(lds, g, S, E);
            __builtin_amdgcn_sched_barrier(0);
            { const int r0 = (layer == 0 && G > 192) ? 0 : MTOK / 2;
              pg8::Gemm g2{PB + (size_t)r0 * PLED, WPPT, MTOK - r0, DM, PLED}; pg8::StaticOrder S2; S2.init(MTOK - r0, DM, G, bx);
              pg8::EpiRS<0> E2{PLE + (size_t)r0 * DM, DM, (LAS unsigned char*)nullptr};
              pg8::gemm_phase<pg8::EpiRS<0>, pg8::StaticOrder, true, true>(lds, g2, S2, E2); }
        }
        SEAM(P + 8);
        if (IN(P + 9)) { PHASE_PTRS();
            pg8::Gemm g{XBl, WPGT, MTOK, DM, DM}; pg8::StaticOrder S; S.init(MTOK, DM, G, bx);
            build_rs_table(S, SSQB, lds, tid);
            pg8::EpiResid<1> E{XBl, XBf, SSQC, lds + RS_OFF, PLE,  1.0f};
            pg8::gemm_phase<pg8::EpiResid<1>, pg8::StaticOrder, true, true>(lds, g, S, E);
        }
        SEAM(P + 9);
    }
    if (IN(PH_FINAL)) { const int layer = DEPTH; PHASE_PTRS();
        const float* nf = kp->in[22];
        f32x4 gn[2][2];
#pragma unroll
        for (int j = 0; j < 2; ++j) { const int c8 = (64 * j + lane) * 2; gn[j][0] = ((const GAS f32x4*)nf)[c8]; gn[j][1] = ((const GAS f32x4*)nf)[c8 + 1]; }
        for (int m0 = gw; m0 < MTOK; m0 += 2 * NGW) {
            const bool two = m0 + NGW < MTOK; const int m1 = two ? m0 + NGW : m0;
            float sp0 = lane < 16 ? SSQC[(size_t)m0 * 16 + lane] : 0.f, sp1 = lane < 16 ? SSQC[(size_t)m1 * 16 + lane] : 0.f;
            const GAS v4u* xr0 = (const GAS v4u*)(XBl + (size_t)m0 * DM) + lane; const GAS v4u* xr1 = (const GAS v4u*)(XBl + (size_t)m1 * DM) + lane;
            v4u w[2][2];
#pragma unroll
            for (int j = 0; j < 2; ++j) { w[0][j] = xr0[64 * j]; w[1][j] = xr1[64 * j]; }
#pragma unroll
            for (int o = 1; o < 16; o <<= 1) { sp0 += __shfl_xor(sp0, o); sp1 += __shfl_xor(sp1, o); }
            const float rstd0 = rsqrtf(rdl(sp0, 0) * (1.0f / 1024.0f) + 1e-6f), rstd1 = rsqrtf(rdl(sp1, 0) * (1.0f / 1024.0f) + 1e-6f);
#pragma unroll
            for (int r = 0; r < 2; ++r) { if (r == 1 && !two) break;
                GAS f32x4* orow = (GAS f32x4*)(X + (size_t)(r ? m1 : m0) * DM); const float rstd = r ? rstd1 : rstd0;
#pragma unroll
                for (int j = 0; j < 2; ++j) { const v4u ww = w[r][j]; const int c8 = (64 * j + lane) * 2;
                    f32x4 o0, o1; o0[0] = pg8::bflo(ww.x); o0[1] = pg8::bfhi(ww.x); o0[2] = pg8::bflo(ww.y); o0[3] = pg8::bfhi(ww.y); o1[0] = pg8::bflo(ww.z); o1[1] = pg8::bfhi(ww.z); o1[2] = pg8::bflo(ww.w); o1[3] = pg8::bfhi(ww.w);
                    orow[c8] = o0 * rstd * gn[j][0]; orow[c8 + 1] = o1 * rstd * gn[j][1]; } }
        }
    }
#undef IN
#undef SEAM
}

extern "C" void kernel_launch(void* const* d_in, const int* in_sizes, int n_in, void* d_out, int out_size, void* d_ws, size_t ws_size, hipStream_t stream) {
    static int grid = 0;
    if (grid == 0) {
        if (n_in != 23 || out_size != MTOK * DM || ws_size < WS_END) { fprintf(stderr, "kernel_launch: unexpected problem (n_in %d, out %d, ws %zu < %zu)\n", n_in, out_size, ws_size, (size_t)WS_END); grid = -1; return; }
        int dev = 0, cus = 0;
        if (hipGetDevice(&dev) != hipSuccess || hipDeviceGetAttribute(&cus, hipDeviceAttributeMultiprocessorCount, dev) != hipSuccess) { grid = -1; return; }
        if (hipFuncSetAttribute((const void*)fwd_kernel, hipFuncAttributeMaxDynamicSharedMemorySize, LDS_BYTES) != hipSuccess) { fprintf(stderr, "kernel_launch: hipFuncSetAttribute failed\n"); grid = -1; return; }
        int per_cu = 0;
        if (hipOccupancyMaxActiveBlocksPerMultiprocessor(&per_cu, (const void*)fwd_kernel, 512, LDS_BYTES) != hipSuccess || per_cu < 1) { fprintf(stderr, "kernel_launch: occupancy query says %d blocks per CU\n", per_cu); }
        (void)hipGetLastError();
        grid = cus < 256 ? cus : 256;
    }
    if (grid < 0) return;
    (void)hipMemsetAsync((char*)d_ws + WS_CTL, 0, CTL_BYTES, stream);
    Args a; memset(&a, 0, sizeof(a));
    for (int i = 0; i < 23; ++i) a.in[i] = (const float*)d_in[i];
    a.out = (float*)d_out; a.ws = (unsigned char*)d_ws;
#if MK_ONE_LAUNCH
    a.ph_lo = 0; a.ph_hi = N_PHASES;
    hipLaunchKernelGGL(fwd_kernel, dim3(grid), dim3(512), LDS_BYTES, stream, a);
#else
    for (int p = 0; p < N_PHASES; ++p) {
        a.ph_lo = p; a.ph_hi = p + 1;
        hipLaunchKernelGGL(fwd_kernel, dim3(grid), dim3(512), LDS_BYTES, stream, a);
    }
#endif
}
```

```cpp
#include <hip/hip_runtime.h>
#include <cstdio>
#include <cstdint>
#include <cstring>
__host__ __device__ __forceinline__ size_t mixh(int col, size_t m) {
    const size_t b = m >> 12, t = m & 4095;
    if (col < 2048) { const int ten = col >> 9, h = (col >> 6) & 7; return (size_t)ten * (16u << 20) + (((b * 8 + h) << 12) + t) * 64 + (col & 63); }
    if (col < 2304) { const int c2 = col - 2048, tb = c2 >> 7, g = (c2 >> 6) & 1; return (size_t)4 * (16u << 20) + (size_t)tb * (4u << 20) + (((b * 2 + g) << 12) + t) * 64 + (col & 63); }
    const int c2 = col - 2304, ten = c2 >> 9, h = (c2 >> 6) & 7; return (size_t)4 * (16u << 20) + (8u << 20) + (size_t)ten * (16u << 20) + (((b * 8 + h) << 12) + t) * 64 + (col & 63);
}
__host__ __device__ __forceinline__ size_t gwh(int h, int c, size_t m) { return ((((m >> 12) * 8 + h) << 12) + (m & 4095)) * 64 + c; }
namespace pg8 {
#define PG8_LAS __attribute__((address_space(3)))
typedef unsigned short bf16_t;
typedef short bf16x8 __attribute__((ext_vector_type(8)));
typedef float f32x4 __attribute__((ext_vector_type(4)));
typedef unsigned u32x4 __attribute__((ext_vector_type(4)));
typedef int i32x4 __attribute__((ext_vector_type(4)));
typedef int i32x8 __attribute__((ext_vector_type(8)));
constexpr int BM = 256, BK = 64, HALF = 128, HTB = HALF * BK * 2  , STAGE_BYTES = 8 * HTB, NXCD = 8, WGM = 8;

__host__ __device__ __forceinline__ int lds_byte(int r, int c) { const int st = (r >> 4) * 2 + (c >> 5), rr = r & 15, cc = c & 31, ob = rr * 64 + cc * 2; return st * 1024 + (ob ^ (((ob >> 9) & 1) << 5)); }
__host__ __device__ __forceinline__ void stage_rc(int b, int& R, int& C) { const int st = b / 1024, sb = b % 1024, swz = sb ^ (((sb >> 9) & 1) << 5); R = (st >> 1) * 16 + swz / 64; C = (st & 1) * 32 + (swz % 64) / 2; }
__host__ __device__ __forceinline__ int perm32(int rho) { const int n = rho >> 4, i = rho & 15; return 8 * (i >> 2) + 4 * n + (i & 3); }

struct Unit { int pm, pn; };
struct Gemm { const bf16_t* A; const bf16_t* Bt; int M, N, K; };

struct StaticOrder {
    int nM, nN, nwg, G, c;
    __host__ __device__ void init(int M, int N, int G_, int c_) { nM = M / BM; nN = N / BM; nwg = nM * nN; G = G_; c = c_; }
    __host__ __device__ bool next(int i, Unit& u) const {
        const long L = (long)i * G + c; if (L >= nwg) return false;
        int wgid = (int)L; { const int q = nwg / NXCD, r = nwg % NXCD, xcd = wgid % NXCD, off = wgid / NXCD; wgid = (xcd < r ? xcd * (q + 1) : r * (q + 1) + (xcd - r) * q) + off; }
        const int nig = WGM * nN, gid = wgid / nig, fm = gid * WGM, gsz = (nM - fm) < WGM ? (nM - fm) : WGM;
        u.pm = fm + ((wgid % nig) % gsz); u.pn = (wgid % nig) / gsz; return true;
    }
    __device__ __forceinline__ void a_ready(const Unit&) const {}
    __device__ __forceinline__ void done(const Unit&) const {}
};

typedef float f32x2c __attribute__((ext_vector_type(2))); typedef __bf16 bf16x2c __attribute__((ext_vector_type(2)));
__device__ __forceinline__ unsigned cvt_pk_bf16(float lo, float hi) { const f32x2c v = {lo, hi}; const bf16x2c b = __builtin_convertvector(v, bf16x2c); return __builtin_bit_cast(unsigned, b); }
typedef unsigned u32x2 __attribute__((ext_vector_type(2)));
__device__ __forceinline__ float bflo(unsigned w) { return __uint_as_float(w << 16); }
__device__ __forceinline__ float bfhi(unsigned w) { return __uint_as_float(w & 0xffff0000u); }
__device__ __forceinline__ u32x4 pack8(const f32x4 v0, const f32x4 v1) { u32x4 w; w.x = cvt_pk_bf16(v0[0], v0[1]); w.y = cvt_pk_bf16(v0[2], v0[3]); w.z = cvt_pk_bf16(v1[0], v1[1]); w.w = cvt_pk_bf16(v1[2], v1[3]); return w; }
__device__ __forceinline__ void unpack8(const u32x4 w, f32x4& v0, f32x4& v1) { v0 = (f32x4){bflo(w.x), bfhi(w.x), bflo(w.y), bfhi(w.y)}; v1 = (f32x4){bflo(w.z), bfhi(w.z), bflo(w.w), bfhi(w.w)}; }
constexpr float RMS_EPS = 1e-6f;
constexpr int RS_SLOTS = 8;
__device__ __forceinline__ void load_rstd(const PG8_LAS unsigned char* rst, int pm, int wr, int fr, float (&rs)[2][4]) {
    if (rst == nullptr) {
#pragma unroll
        for (int ai = 0; ai < 2; ++ai)
#pragma unroll
            for (int m = 0; m < 4; ++m) rs[ai][m] = 1.0f;
        return; }
    const PG8_LAS int* pml = (const PG8_LAS int*)rst; int slot = 0;
#pragma unroll
    for (int k = 1; k < RS_SLOTS; ++k) slot = pml[k] == pm ? k : slot;
    const PG8_LAS float* tab = (const PG8_LAS float*)(rst + 32) + slot * 256 + wr * 64 + fr;
#pragma unroll
    for (int ai = 0; ai < 2; ++ai)
#pragma unroll
        for (int m = 0; m < 4; ++m) rs[ai][m] = tab[ai * HALF + m * 16];
}
struct EpiP1 {
    static constexpr bool PERM = true, AFTER_DRAIN = false, HOOK = false; static constexpr int SEG1 = -1, SEG2 = -1;
    bf16_t* ZB; bf16_t* MIX; float* SM; const PG8_LAS unsigned char* rst; bf16_t* HALO; unsigned nost;
    __device__ __forceinline__ void rescale(f32x4 (&)[2][2][4][2], const Unit&, int, int, int, int, int) const {}
    __device__ __forceinline__ void operator()(const f32x4 (&acc)[2][2][4][2], const Unit& u, int wr, int wc, int fr, int fq) const {
        const int row0 = u.pm * BM + wr * 64 + fr;
        float rs[2][4]; load_rstd(rst, u.pm, wr, fr, rs);
        if (u.pn == 21) {
            if (wc == 0) {
#pragma unroll
                for (int ai = 0; ai < 2; ++ai)
#pragma unroll
                    for (int m = 0; m < 4; ++m) { float* p = SM + (size_t)(row0 + ai * HALF + m * 16) * 32 + 8 * fq;
                        *(f32x4*)p = acc[ai][0][m][0] * rs[ai][m]; *(f32x4*)(p + 4) = acc[ai][0][m][1] * rs[ai][m]; }
            }
            return;
        }
        const bool mixt = u.pn >= 6;
        const int colt = mixt ? (u.pn - 6) * BM : u.pn * BM, col0 = colt + wc * 64 + 8 * fq;
#pragma unroll
        for (int ai = 0; ai < 2; ++ai)
#pragma unroll
            for (int m = 0; m < 4; ++m) { const size_t row = (size_t)(row0 + ai * HALF + m * 16);
#pragma unroll
                for (int bj = 0; bj < 2; ++bj) { const u32x4 w = pack8(acc[ai][bj][m][0] * rs[ai][m], acc[ai][bj][m][1] * rs[ai][m]);
                    if (nost == 0u || (w.x ^ w.y ^ w.z) == nost) *(u32x4*)(mixt ? MIX + mixh(col0 + bj * 32, row) : ZB + row * 1536 + col0 + bj * 32) = w;
                    if (m == 3 && fr >= 13 && u.pn >= 6 && u.pn < 15) *(u32x4*)(HALO + ((size_t)((row0 + ai * HALF + m * 16) >> 6) * 3 + (fr - 13)) * 2304 + col0 + bj * 32) = w; } }
    }
};
template <int ACT> struct EpiRS {
    static constexpr bool PERM = true, AFTER_DRAIN = false, HOOK = false; static constexpr int SEG1 = -1, SEG2 = -1;
    bf16_t* O; int ldc; const PG8_LAS unsigned char* rst; float osc = 1.0f;
    __device__ __forceinline__ void rescale(f32x4 (&)[2][2][4][2], const Unit&, int, int, int, int, int) const {}
    __device__ __forceinline__ void operator()(const f32x4 (&acc)[2][2][4][2], const Unit& u, int wr, int wc, int fr, int fq) const {
        const int row0 = u.pm * BM + wr * 64 + fr, col0 = u.pn * BM + wc * 64 + 8 * fq;
        float rs[2][4]; load_rstd(rst, u.pm, wr, fr, rs);
#pragma unroll
        for (int ai = 0; ai < 2; ++ai)
#pragma unroll
            for (int m = 0; m < 4; ++m) rs[ai][m] *= (ACT == 2 ? osc * -1.44269504088896f : osc);
#pragma unroll
        for (int ai = 0; ai < 2; ++ai)
#pragma unroll
            for (int m = 0; m < 4; ++m) { bf16_t* rowp = O + (size_t)(row0 + ai * HALF + m * 16) * ldc + col0;
#pragma unroll
                for (int bj = 0; bj < 2; ++bj) { f32x4 v0 = acc[ai][bj][m][0] * rs[ai][m], v1 = acc[ai][bj][m][1] * rs[ai][m];
                    if (ACT == 1) {
#pragma unroll
                        for (int j = 0; j < 4; ++j) { const float a = fmaxf(v0[j], 0.f), b = fmaxf(v1[j], 0.f); v0[j] = a * a; v1[j] = b * b; } }
                    if (ACT == 2) {
#pragma unroll
                        for (int j = 0; j < 4; ++j) { v0[j] = 1.0f + __builtin_amdgcn_exp2f(v0[j]); v1[j] = 1.0f + __builtin_amdgcn_exp2f(v1[j]); } }
                    *(u32x4*)(rowp + bj * 32) = pack8(v0, v1); } }
    }
};
struct EpiMerge {
    static constexpr bool PERM = true, AFTER_DRAIN = false, HOOK = true; static constexpr int SEG1 = 8, SEG2 = 16, SEG3 = 12;
    const bf16_t* GATE; bf16_t* O; const float* SM;
    __device__ __forceinline__ void rowscale(f32x4 (&acc)[2][2][4][2], const Unit& u, int wr) const {
        int t_ = threadIdx.x; asm volatile("" : "+v"(t_)); const int fr = t_ & 15;
        const float* sp = SM + (size_t)(u.pm * BM + wr * 64 + fr) * 32 + 25;
#pragma unroll
        for (int ai = 0; ai < 2; ++ai)
#pragma unroll
            for (int m = 0; m < 4; ++m) { float f = sp[(size_t)(ai * HALF + m * 16) * 32]; asm volatile("" : "+v"(f));
#pragma unroll
                for (int bj = 0; bj < 2; ++bj) { acc[ai][bj][m][0] *= f; acc[ai][bj][m][1] *= f; } }
    }
    __device__ __forceinline__ void rescale(f32x4 (&acc)[2][2][4][2], const Unit& u, int seg, int wr, int wc, int, int) const {
        int t_ = threadIdx.x; asm volatile("" : "+v"(t_)); const int fr = t_ & 15, fq = (t_ & 63) >> 4;
        const int row0 = u.pm * BM + wr * 64 + fr;
        const int col0 = u.pn * BM + wc * 64 + 8 * fq + (seg - 1) * 1024, dofs = 1024, rcol = seg == 1 ? 24 : 26;
#pragma unroll
        for (int ai = 0; ai < 2; ++ai)
#pragma unroll
            for (int m = 0; m < 4; ++m) { const bf16_t* gp = GATE + (size_t)(row0 + ai * HALF + m * 16) * 3072 + col0;
                const float rf = SM[(size_t)(row0 + ai * HALF + m * 16) * 32 + rcol];
#pragma unroll
                for (int bj = 0; bj < 2; ++bj) { const u32x4 wa = *(const u32x4*)(gp + bj * 32), wb = *(const u32x4*)(gp + bj * 32 + dofs);
                    f32x4 a0, a1, b0, b1; unpack8(wa, a0, a1); unpack8(wb, b0, b1);
#pragma unroll
                    for (int j = 0; j < 4; ++j) {
                        acc[ai][bj][m][0][j] *= (b0[j] * rf) * __builtin_amdgcn_rcpf(a0[j]);
                        acc[ai][bj][m][1][j] *= (b1[j] * rf) * __builtin_amdgcn_rcpf(a1[j]); } }
                if (m == 3) asm volatile("" ::: "memory"); }
    }
    __device__ __forceinline__ void operator()(const f32x4 (&acc)[2][2][4][2], const Unit& u, int wr, int wc, int fr, int fq) const {
        const int row0 = u.pm * BM + wr * 64 + fr, col0 = u.pn * BM + wc * 64 + 8 * fq;
#pragma unroll
        for (int ai = 0; ai < 2; ++ai)
#pragma unroll
            for (int m = 0; m < 4; ++m) { const size_t r = (size_t)(row0 + ai * HALF + m * 16);
#pragma unroll
                for (int bj = 0; bj < 2; ++bj) { const u32x4 wa = *(const u32x4*)(GATE + r * 3072 + 2048 + col0 + bj * 32);
                    f32x4 a0, a1; unpack8(wa, a0, a1); f32x4 v0 = acc[ai][bj][m][0], v1 = acc[ai][bj][m][1];
#pragma unroll
                    for (int j = 0; j < 4; ++j) { v0[j] *= __builtin_amdgcn_rcpf(a0[j]); v1[j] *= __builtin_amdgcn_rcpf(a1[j]); }
                    *(u32x4*)(O + r * 1024 + col0 + bj * 32) = pack8(v0, v1); }
                if (m == 3) asm volatile("" ::: "memory"); }
    }
};
template <int MODE> struct EpiResid {
    static constexpr bool PERM = true, AFTER_DRAIN = false, HOOK = false; static constexpr int SEG1 = -1, SEG2 = -1;
    const bf16_t* XBin; bf16_t* XBout; float* ssq_out; const PG8_LAS unsigned char* rst; const bf16_t* PLE; float scale;
    unsigned char* X8out = nullptr; float osc = 1.0f;
    __device__ __forceinline__ void rescale(f32x4 (&)[2][2][4][2], const Unit&, int, int, int, int, int) const {}
    __device__ __forceinline__ void operator()(const f32x4 (&acc)[2][2][4][2], const Unit& u, int wr, int wc, int fr, int fq) const {
        const int row0 = u.pm * BM + wr * 64 + fr, col0 = u.pn * BM + wc * 64 + 8 * fq;
        unsigned char* x8 = X8out; asm volatile("" : "+s"(x8));
        float rs[2][4]; if (MODE == 1) { load_rstd(rst, u.pm, wr, fr, rs);
#pragma unroll
            for (int ai = 0; ai < 2; ++ai)
#pragma unroll
                for (int m = 0; m < 4; ++m) rs[ai][m] *= osc * -1.44269504088896f; }
#pragma unroll
        for (int ai = 0; ai < 2; ++ai)
#pragma unroll
            for (int m = 0; m < 4; ++m) { const size_t r = (size_t)(row0 + ai * HALF + m * 16); float ss = 0.f;
#pragma unroll
                for (int bj = 0; bj < 2; ++bj) { const size_t o = r * 1024 + col0 + bj * 32;
                    f32x4 v0 = acc[ai][bj][m][0], v1 = acc[ai][bj][m][1], b0, b1; unpack8(*(const u32x4*)(XBin + o), b0, b1);
                    if (MODE == 1) { const u32x4 wp = *(const u32x4*)(PLE + o); f32x4 p0, p1; unpack8(wp, p0, p1);
#pragma unroll
                        for (int j = 0; j < 4; ++j) { v0[j] = p0[j] * __builtin_amdgcn_rcpf(1.0f + __builtin_amdgcn_exp2f(v0[j] * rs[ai][m])); v1[j] = p1[j] * __builtin_amdgcn_rcpf(1.0f + __builtin_amdgcn_exp2f(v1[j] * rs[ai][m])); } }
                    v0 = v0 * scale + b0; v1 = v1 * scale + b1;
                    *(u32x4*)(XBout + o) = pack8(v0, v1);
                    if (x8 != nullptr) { unsigned w0 = 0u, w1 = 0u; w0 = __builtin_amdgcn_cvt_pk_fp8_f32(v0[0], v0[1], w0, false); w0 = __builtin_amdgcn_cvt_pk_fp8_f32(v0[2], v0[3], w0, true);
                        w1 = __builtin_amdgcn_cvt_pk_fp8_f32(v1[0], v1[1], w1, false); w1 = __builtin_amdgcn_cvt_pk_fp8_f32(v1[2], v1[3], w1, true); *(u32x2*)(x8 + o) = (u32x2){w0, w1}; }
                    ss += (v0[0] * v0[0] + v0[1] * v0[1]) + (v0[2] * v0[2] + v0[3] * v0[3]) + (v1[0] * v1[0] + v1[1] * v1[1]) + (v1[2] * v1[2] + v1[3] * v1[3]); }
                ss += __shfl_xor(ss, 16); ss += __shfl_xor(ss, 32);
                if (fq == 0) ssq_out[r * 16 + u.pn * 4 + wc] = ss;
                if (m == 3) asm volatile("" ::: "memory"); }
    }
};
template <class Epi, class Sched, bool ALIGN_EPI = false, bool SP2 = false, int PROBE = 0, bool FP8 = false>
__device__ __forceinline__ void gemm_phase(PG8_LAS unsigned char* lds, Gemm g, const Sched& S, const Epi& E) {
    asm volatile("" : "+s"(g.A), "+s"(g.Bt), "+s"(g.K));
    int tid_ = threadIdx.x; asm volatile("" : "+v"(tid_));
    const int tid = tid_, wid = __builtin_amdgcn_readfirstlane(tid >> 6), lane = tid & 63, wr = wid >> 2, wc = wid & 3, fr = lane & 15, fq = lane >> 4;
    const int K = g.K, nt = K / BK;
    unsigned voffA[2], voffB[2];
#pragma unroll
    for (int i = 0; i < 2; ++i) { int R, C; stage_rc(tid * 16 + i * 8192, R, C); const int Rb = Epi::PERM ? (64 * (R >> 5) + perm32(R & 31)) : R;
        voffA[i] = (unsigned)(R * K + C) * 2u; voffB[i] = (unsigned)(Rb * K + C) * 2u; }
    const size_t kstep = (size_t)(BK * 2);
    const size_t hstep = (size_t)HALF * K * 2;
    const size_t tstep = 2 * hstep;
    const size_t bstep = Epi::PERM ? (size_t)32 * K * 2 : hstep;
    const unsigned ldsw = (unsigned)wid * 1024u;
    const int aoff = lds_byte(wr * 64 + fr, fq * 8), boff = lds_byte(wc * 32 + fr, fq * 8);
#define PG8_SA(b, h) (((b) * 2 + (h)) * HTB)
#define PG8_SB(b, h) ((4 + (b) * 2 + (h)) * HTB)
#define PG8_STAGE(bufoff, gbase, voff) do { if constexpr (!(PROBE & 4)) _Pragma("unroll") for (int _i = 0; _i < 2; ++_i) \
        __builtin_amdgcn_global_load_lds((const unsigned*)((const char*)(gbase) + (voff)[_i]), (PG8_LAS unsigned*)(lds + (bufoff) + ldsw + _i * 8192), 16, 0, 0); } while (0)
#define PG8_LD16(off_) (*(const PG8_LAS i32x4*)(lds + (off_)))
#define PG8_LDA(dst, b, h) do { if constexpr (FP8) { _Pragma("unroll") for (int m = 0; m < 4; ++m) dst##8[m] = __builtin_shufflevector(PG8_LD16(PG8_SA(b, h) + aoff + m * 2048), PG8_LD16(PG8_SA(b, h) + aoff + m * 2048 + 1024), 0, 1, 2, 3, 4, 5, 6, 7); } \
        else { _Pragma("unroll") for (int m = 0; m < 4; ++m) _Pragma("unroll") for (int k = 0; k < 2; ++k) dst[m][k] = *(const PG8_LAS bf16x8*)(lds + PG8_SA(b, h) + aoff + m * 2048 + k * 1024); } } while (0)
#define PG8_LDB(dst, b, h) do { if constexpr (FP8) { _Pragma("unroll") for (int n = 0; n < 2; ++n) dst##8[n] = __builtin_shufflevector(PG8_LD16(PG8_SB(b, h) + boff + n * 2048), PG8_LD16(PG8_SB(b, h) + boff + n * 2048 + 1024), 0, 1, 2, 3, 4, 5, 6, 7); } \
        else { _Pragma("unroll") for (int n = 0; n < 2; ++n) _Pragma("unroll") for (int k = 0; k < 2; ++k) dst[n][k] = *(const PG8_LAS bf16x8*)(lds + PG8_SB(b, h) + boff + n * 2048 + k * 1024); } } while (0)
#define PG8_MMA(ai, bj, At, Bt) do { __builtin_amdgcn_s_setprio(1); if constexpr (!(PROBE & 2)) { \
        if constexpr (FP8) { _Pragma("unroll") for (int m = 0; m < 4; ++m) _Pragma("unroll") for (int n = 0; n < 2; ++n) \
            asm volatile("v_mfma_f32_16x16x128_f8f6f4 %0, %1, %2, %0" : "+v"(acc[ai][bj][m][n]) : "v"(Bt##8[n]), "v"(At##8[m])); } \
        else { _Pragma("unroll") for (int m = 0; m < 4; ++m) _Pragma("unroll") for (int n = 0; n < 2; ++n) _Pragma("unroll") for (int k = 0; k < 2; ++k) \
            acc[ai][bj][m][n] = __builtin_amdgcn_mfma_f32_16x16x32_bf16(Bt[n][k], At[m][k], acc[ai][bj][m][n], 0, 0, 0); } } __builtin_amdgcn_s_setprio(0); } while (0)
#define PG8_WAIT_V(n) asm volatile("s_waitcnt vmcnt(" #n ")" ::: "memory")
#define PG8_WAIT_L(n) asm volatile("s_waitcnt lgkmcnt(" #n ")" ::: "memory")
#define PG8_BAR __builtin_amdgcn_s_barrier()
#define PG8_SCHED __builtin_amdgcn_sched_barrier(0)
    Unit cur, nxt; int ui = 0;
    if (!S.next(0, cur)) return;
    f32x4 acc[2][2][4][2];
#pragma unroll
    for (int a = 0; a < 2; ++a)
#pragma unroll
        for (int b = 0; b < 2; ++b)
#pragma unroll
            for (int m = 0; m < 4; ++m)
#pragma unroll
                for (int n = 0; n < 2; ++n) acc[a][b][m][n] = (f32x4){0.f, 0.f, 0.f, 0.f};
    bf16x8 At[4][2], B0[2][2], B1[2][2]; i32x8 At8[4], B08[2], B18[2]; (void)At; (void)B0; (void)B1; (void)At8; (void)B08; (void)B18;
    const char* cA = (const char*)g.A + (size_t)cur.pm * tstep; const char* cB = (const char*)g.Bt + (size_t)cur.pn * tstep;
    S.a_ready(cur);
    if constexpr (SP2) {
        PG8_STAGE(PG8_SB(0, 0), cB, voffB); PG8_STAGE(PG8_SB(0, 1), cB + bstep, voffB); PG8_STAGE(PG8_SA(0, 0), cA, voffA); PG8_STAGE(PG8_SA(0, 1), cA + hstep, voffA);
        if (wr == 1) PG8_BAR;
        PG8_WAIT_V(2); PG8_BAR;
        PG8_STAGE(PG8_SB(1, 0), cB + kstep, voffB); PG8_STAGE(PG8_SA(1, 0), cA + kstep, voffA); PG8_STAGE(PG8_SB(1, 1), cB + bstep + kstep, voffB);
        PG8_WAIT_V(6); PG8_BAR;
    } else {
        PG8_STAGE(PG8_SB(0, 0), cB, voffB); PG8_STAGE(PG8_SA(0, 0), cA, voffA); PG8_STAGE(PG8_SB(0, 1), cB + bstep, voffB); PG8_STAGE(PG8_SA(0, 1), cA + hstep, voffA);
        if (wr == 1) PG8_BAR;
        PG8_WAIT_V(4); PG8_BAR;
        PG8_STAGE(PG8_SB(1, 0), cB + kstep, voffB); PG8_STAGE(PG8_SA(1, 0), cA + kstep, voffA); PG8_STAGE(PG8_SB(1, 1), cB + bstep + kstep, voffB);
        PG8_WAIT_V(6); PG8_BAR;
    }
    for (;;) {
        const bool has_next = S.next(ui + 1, nxt);
        const char* nA = has_next ? (const char*)g.A + (size_t)nxt.pm * tstep : cA; const char* nB = has_next ? (const char*)g.Bt + (size_t)nxt.pn * tstep : cB;
        asm volatile(".p2align 8" ::: "memory");
        for (int t = 0; t < nt; t += 2) {
            const bool last = (t == nt - 2);
            const char* a1 = cA + (size_t)(t + 1) * kstep;
            const char* a2 = last ? nA : cA + (size_t)(t + 2) * kstep; const char* b2 = last ? nB : cB + (size_t)(t + 2) * kstep;
            const char* a3 = a2 + kstep; const char* b3 = b2 + kstep;
            if (last && has_next) S.a_ready(nxt);
            if constexpr (Epi::HOOK) { if (t == Epi::SEG1 || t == Epi::SEG2) E.rescale(acc, cur, t == Epi::SEG1 ? 1 : 2, wr, wc, fr, fq); if (t == Epi::SEG3) E.rowscale(acc, cur, wr); }
            if constexpr (SP2) {
            PG8_LDB(B0, 0, 0); PG8_LDB(B1, 0, 1); PG8_SCHED; PG8_LDA(At, 0, 0); PG8_STAGE(PG8_SA(1, 1), a1 + hstep, voffA);
            PG8_WAIT_V(8); PG8_WAIT_L(0); PG8_BAR; PG8_MMA(0, 0, At, B0); PG8_MMA(0, 1, At, B1); PG8_BAR; PG8_SCHED;
            PG8_LDA(At, 0, 1); PG8_STAGE(PG8_SB(0, 0), b2, voffB); PG8_STAGE(PG8_SB(0, 1), b2 + bstep, voffB); PG8_STAGE(PG8_SA(0, 0), a2, voffA);
            PG8_WAIT_V(8); PG8_WAIT_L(0); PG8_BAR; PG8_MMA(1, 0, At, B0); PG8_MMA(1, 1, At, B1); PG8_BAR; PG8_SCHED;
            PG8_LDB(B0, 1, 0); PG8_LDB(B1, 1, 1); PG8_SCHED; PG8_LDA(At, 1, 0); PG8_STAGE(PG8_SA(0, 1), a2 + hstep, voffA);
            PG8_WAIT_V(8); PG8_WAIT_L(0); PG8_BAR; PG8_MMA(0, 0, At, B0); PG8_MMA(0, 1, At, B1); PG8_BAR; PG8_SCHED;
            PG8_LDA(At, 1, 1); PG8_STAGE(PG8_SB(1, 0), b3, voffB); PG8_STAGE(PG8_SB(1, 1), b3 + bstep, voffB); PG8_STAGE(PG8_SA(1, 0), a3, voffA);
            PG8_WAIT_V(8); PG8_WAIT_L(0); PG8_BAR; PG8_MMA(1, 0, At, B0); PG8_MMA(1, 1, At, B1); PG8_BAR; PG8_SCHED;
            } else {
            PG8_LDB(B0, 0, 0); PG8_SCHED; PG8_LDA(At, 0, 0); PG8_STAGE(PG8_SA(1, 1), a1 + hstep, voffA);
            PG8_WAIT_L(8); PG8_BAR; PG8_WAIT_L(0); PG8_MMA(0, 0, At, B0); PG8_BAR; PG8_SCHED;
            PG8_LDB(B1, 0, 1); PG8_STAGE(PG8_SB(0, 0), b2, voffB);
            PG8_BAR; PG8_WAIT_L(0); PG8_MMA(0, 1, At, B1); PG8_BAR;
            PG8_LDA(At, 0, 1); PG8_STAGE(PG8_SA(0, 0), a2, voffA);
            PG8_BAR; PG8_WAIT_L(0); PG8_MMA(1, 0, At, B0); PG8_BAR; PG8_SCHED;
            PG8_STAGE(PG8_SB(0, 1), b2 + bstep, voffB);
            PG8_WAIT_V(6); PG8_BAR; PG8_MMA(1, 1, At, B1); PG8_BAR;
            PG8_LDB(B0, 1, 0); PG8_SCHED; PG8_LDA(At, 1, 0); PG8_STAGE(PG8_SA(0, 1), a2 + hstep, voffA);
            PG8_WAIT_L(8); PG8_BAR; PG8_WAIT_L(0); PG8_MMA(0, 0, At, B0); PG8_BAR; PG8_SCHED;
            PG8_LDB(B1, 1, 1); PG8_STAGE(PG8_SB(1, 0), b3, voffB);
            PG8_BAR; PG8_WAIT_L(0); PG8_MMA(0, 1, At, B1); PG8_BAR;
            PG8_LDA(At, 1, 1); PG8_STAGE(PG8_SA(1, 0), a3, voffA);
            PG8_BAR; PG8_WAIT_L(0); PG8_MMA(1, 0, At, B0); PG8_BAR; PG8_SCHED;
            PG8_STAGE(PG8_SB(1, 1), b3 + bstep, voffB);
            PG8_WAIT_V(6); PG8_BAR; PG8_MMA(1, 1, At, B1); PG8_BAR;
            }
        }
        if constexpr (ALIGN_EPI) { if (wr == 0) PG8_BAR; }
        if constexpr (FP8) asm volatile("s_nop 15\n\ts_nop 15" ::: "memory");
        if constexpr ((PROBE & 8) != 0) { f32x4 s_ = acc[0][0][0][0];
#pragma unroll
            for (int a_ = 0; a_ < 2; ++a_)
#pragma unroll
                for (int b_ = 0; b_ < 2; ++b_)
#pragma unroll
                    for (int m_ = 0; m_ < 4; ++m_)
#pragma unroll
                        for (int n_ = 0; n_ < 2; ++n_) s_ += acc[a_][b_][m_][n_];
            if (s_[0] + s_[1] + s_[2] + s_[3] == 1234.567f) *(volatile float*)g.A = s_[0]; }
        if constexpr (!Epi::AFTER_DRAIN && !(PROBE & 1)) { int t2_ = threadIdx.x; asm volatile("" : "+v"(t2_)); E(acc, cur, wr, wc, t2_ & 15, (t2_ & 63) >> 4); S.done(cur); }
        if (!has_next) break;
#pragma unroll
        for (int a = 0; a < 2; ++a)
#pragma unroll
            for (int b = 0; b < 2; ++b)
#pragma unroll
                for (int m = 0; m < 4; ++m)
#pragma unroll
                    for (int n = 0; n < 2; ++n) acc[a][b][m][n] = (f32x4){0.f, 0.f, 0.f, 0.f};
        cur = nxt; cA = nA; cB = nB; ++ui;
        if constexpr (ALIGN_EPI) { if (wr == 1) PG8_BAR; }
    }
    PG8_WAIT_V(0);
    if constexpr (!ALIGN_EPI) { if (wr == 0) PG8_BAR; }
    PG8_BAR;
    if constexpr (Epi::AFTER_DRAIN) { E.fused(acc, cur, wr, wc, fr, fq, lds, wid, lane); S.done(cur); }
#undef PG8_SA
#undef PG8_SB
#undef PG8_STAGE
#undef PG8_LDA
#undef PG8_LD16
#undef PG8_LDB
#undef PG8_MMA
#undef PG8_WAIT_V
#undef PG8_WAIT_L
#undef PG8_BAR
#undef PG8_SCHED
}
}
constexpr int DM = 1024, NBATCH = 8, SEQ = 4096, MTOK = NBATCH * SEQ, DEPTH = 2, DFF = 4096, PLED = 256, NIN = 8472;
constexpr int ZB_LD = 1536, MIX_LD = 3840, SM_LD = 32, N1 = 5632, NGATE = 3072, KMERGE = 1536;
constexpr int MX_AQ = 0, MX_AK = 512, MX_AV = 1024, MX_BX = 1536, MX_BB = 2048, MX_BC = 2176, MX_CQ = 2304, MX_CK = 2816, MX_CV = 3328;
constexpr size_t KiB = 1024, MiB = 1024 * 1024;
constexpr size_t WS_CTL = 0, CTL_BYTES = 64 * KiB;
constexpr size_t WS_W = 64 * KiB;
constexpr size_t W_1T = WS_W, W_GT = W_1T + (size_t)N1 * DM * 2, W_MT = W_GT + (size_t)NGATE * DM * 2, W_OT = W_MT + (size_t)DM * KMERGE * 2, W_UT = W_OT + (size_t)DM * DM * 2,
                 W_DT = W_UT + (size_t)DFF * DM * 2, W_PGT = W_DT + (size_t)DM * DFF * 2, W_PPT = W_PGT + (size_t)DM * DM * 2, W_END = W_PPT + (size_t)DM * PLED * 2;
constexpr size_t WS_SSQA = W_1T + 1 * MiB, WS_SSQB = W_1T + 3 * MiB;
constexpr size_t WS_XB0 = W_END, WS_XB1 = WS_XB0 + 64 * MiB, WS_ZB = WS_XB1 + 64 * MiB, WS_MIX = WS_ZB + 96 * MiB, WS_SM = WS_MIX + 240 * MiB, WS_SSQC = WS_SM + 4 * MiB, WS_ROPE = WS_SSQC + 2 * MiB, WS_END = WS_ROPE + 1 * MiB;
constexpr size_t X8_L0_OUT = 16 * MiB, X8_L1_WS = W_1T + 5 * MiB;
static_assert(X8_L1_WS + 32 * MiB <= W_PGT, "x8");
constexpr size_t WS_PB = WS_ZB, WS_PLE = WS_ZB + 16 * MiB, WS_U = WS_ZB + 80 * MiB, WS_GATE = WS_MIX;
static_assert(W_END == WS_W + (size_t)(40 * MiB + 512 * KiB), "weights");
static_assert(WS_U + (size_t)MTOK * DFF * 2 == WS_SM, "U overlay");
static_assert(WS_END <= 512 * MiB, "workspace");
constexpr int LDS_BYTES = 147456, RING_BYTES = 131072, MISC_OFF = RING_BYTES + 320, RS_OFF = RING_BYTES + 1024;
static_assert(RS_OFF + 32 + pg8::RS_SLOTS * 1024 <= LDS_BYTES, "LDS map");

#define GAS __attribute__((address_space(1)))
#define LAS __attribute__((address_space(3)))
typedef unsigned short bf16;
typedef unsigned v4u __attribute__((ext_vector_type(4)));
typedef unsigned v2u __attribute__((ext_vector_type(2)));
typedef float f32x4 __attribute__((ext_vector_type(4)));
#define LDS_WAIT() asm volatile("s_waitcnt lgkmcnt(0)" ::: "memory")
typedef float f32x2_t __attribute__((ext_vector_type(2))); typedef __bf16 bf16x2_t __attribute__((ext_vector_type(2)));
__device__ __forceinline__ unsigned pk2(float lo, float hi) { f32x2_t v = {lo, hi}; bf16x2_t b = __builtin_convertvector(v, bf16x2_t); return __builtin_bit_cast(unsigned, b); }
__device__ __forceinline__ unsigned f2bf(float f) { return pk2(f, 0.f) & 0xffffu; }
__device__ __forceinline__ float bf2f(bf16 v) { return __uint_as_float((unsigned)v << 16); }
__device__ __forceinline__ float wave_sum(float v) {
#pragma unroll
    for (int o = 1; o < 64; o <<= 1) v += __shfl_xor(v, o);
    return v;
}
__device__ __forceinline__ float siluf(float x) { return x * __builtin_amdgcn_rcpf(1.0f + __expf(-x)); }
__device__ __forceinline__ float sigmf(float x) { return __builtin_amdgcn_rcpf(1.0f + __expf(-x)); }
__device__ __forceinline__ float softplusf(float x) { return fmaxf(x, 0.f) + log1pf(__expf(-fabsf(x))); }
__device__ __forceinline__ float rdl(float v, int l) { return __int_as_float(__builtin_amdgcn_readlane(__float_as_int(v), l)); }

#define XB_TMO      128
#define XB_XCNT(j)  (256  + 64 * (j))
#define XB_XSUB(j)  (1280 + 64 * (j))
#define XB_XGEN(j)  (2304 + 64 * (j))
#define XB_TOP      3328
#define XB_TOPGEN   3392
#define XCD_BAR_WORDS 3456
#define XB_SPIN_CAP (1u << 18)
__device__ __forceinline__ unsigned xb_ld(unsigned* p)              { return __hip_atomic_load(p, __ATOMIC_RELAXED, __HIP_MEMORY_SCOPE_AGENT); }
__device__ __forceinline__ unsigned xb_add(unsigned* p, unsigned v) { return __hip_atomic_fetch_add(p, v, __ATOMIC_RELAXED, __HIP_MEMORY_SCOPE_AGENT); }
__device__ __forceinline__ unsigned xb_xcc_id() { return (unsigned)__builtin_amdgcn_s_getreg((3 << 11) | 20) & 0xFu; }
#define XB_SPIN(cond, bar) do { unsigned _sp = 0; while (cond) { __builtin_amdgcn_s_sleep(1); \
    if ((++_sp & 255u) == 0u) { if (xb_ld(&(bar)[XB_TMO])) break; if (_sp > XB_SPIN_CAP) { atomicAdd(&(bar)[XB_TMO], 1u); break; } } } } while (0)
struct XcdBarrier { unsigned* bar; unsigned x; volatile LAS unsigned* st; };
__device__ __forceinline__ XcdBarrier xcd_barrier_post(unsigned* bar, volatile LAS unsigned* st) {
    XcdBarrier b; b.bar = bar; b.x = xb_xcc_id(); b.st = st;
    if (threadIdx.x == 0) (void)xb_add(&bar[XB_XCNT(b.x)], 1u);
    return b;
}
__device__ __forceinline__ void xcd_barrier_complete(unsigned* bar, unsigned x, unsigned& nloc, unsigned& nx) {
    const unsigned G = gridDim.x * gridDim.y * gridDim.z;
    unsigned sum, cnt, mine, sp = 0u;
    for (;;) {
        sum = 0u; cnt = 0u; mine = 0u;
#pragma unroll
        for (unsigned j = 0; j < 16; ++j) { const unsigned c = xb_ld(&bar[XB_XCNT(j)]); sum += c; cnt += (c > 0u) ? 1u : 0u; mine = (j == x) ? c : mine; }
        if (sum == G) break;
        __builtin_amdgcn_s_sleep(1);
        if ((++sp & 255u) == 0u) { if (xb_ld(&bar[XB_TMO])) break; if (sp > XB_SPIN_CAP) { atomicAdd(&bar[XB_TMO], 1u); break; } }
    }
    nloc = mine > 0u ? mine : 1u; nx = cnt > 0u ? cnt : 1u;
}
__device__ __forceinline__ void xcd_barrier(const XcdBarrier& b) {
    asm volatile("s_waitcnt vmcnt(0)" ::: "memory");
    __syncthreads();
    if (threadIdx.x == 0) {
        unsigned* bar = b.bar;
        __builtin_amdgcn_s_waitcnt(0);
        unsigned nloc = b.st[0], nx = b.st[1];
        if (nloc == 0u) { xcd_barrier_complete(bar, b.x, nloc, nx); b.st[0] = nloc; b.st[1] = nx; }
        const unsigned old = xb_add(&bar[XB_XSUB(b.x)], 1u);
        const unsigned gen = old / nloc;
        if (old + 1u == (gen + 1u) * nloc) {
            __builtin_amdgcn_fence(__ATOMIC_RELEASE, "agent");
            asm volatile("s_waitcnt vmcnt(0)" ::: "memory");
            const unsigned og = xb_add(&bar[XB_TOP], 1u);
            const unsigned tg = og / nx;
            if (og + 1u == (tg + 1u) * nx) xb_add(&bar[XB_TOPGEN], 1u);
            else XB_SPIN(xb_ld(&bar[XB_TOPGEN]) == tg, bar);
            __builtin_amdgcn_fence(__ATOMIC_ACQUIRE, "agent");
            xb_add(&bar[XB_XGEN(b.x)], 1u);
            asm volatile("s_waitcnt vmcnt(0)" ::: "memory");
        } else {
            XB_SPIN(xb_ld(&bar[XB_XGEN(b.x)]) == gen, bar);
            __builtin_amdgcn_fence(__ATOMIC_ACQUIRE, "agent");
            asm volatile("s_waitcnt vmcnt(0)" ::: "memory");
        }
    }
    __syncthreads();
}

__device__ __forceinline__ void tr_item(const float* W, int ldw, int c0, int ncols, const float* scale, bf16* dst, int ldd, int r0, int kofs, LAS unsigned char* lds, int item, int tid) {
    const int lane = tid & 63, wave = __builtin_amdgcn_readfirstlane(tid >> 6);
    const int nblk = (ncols + 255) / 256, kb = item / nblk, nb = item - kb * nblk, k0 = 64 * kb, n0 = 256 * nb;
    asm volatile("s_waitcnt lgkmcnt(0)\n\ts_barrier" ::: "memory");
    float v[8][4];
    const int n = n0 + 4 * lane;
    const bool vec = W != nullptr && ((c0 | ldw) & 3) == 0 && n + 3 < ncols;
    const float* wp = W + (size_t)(k0 + 8 * wave) * ldw + c0 + n;
#pragma unroll
    for (int kk = 0; kk < 8; ++kk) {
        if (vec) { const f32x4 t = *(const GAS f32x4*)(wp + (size_t)kk * ldw); v[kk][0] = t[0]; v[kk][1] = t[1]; v[kk][2] = t[2]; v[kk][3] = t[3]; }
        else {
#pragma unroll
            for (int q = 0; q < 4; ++q) v[kk][q] = (W != nullptr && n + q < ncols) ? wp[(size_t)kk * ldw + q] : 0.f; }
        if (scale) { const float s = scale[k0 + 8 * wave + kk];
#pragma unroll
            for (int q = 0; q < 4; ++q) v[kk][q] *= s; } }
#pragma unroll
    for (int q = 0; q < 4; ++q) { v4u o; o.x = pk2(v[0][q], v[1][q]); o.y = pk2(v[2][q], v[3][q]); o.z = pk2(v[4][q], v[5][q]); o.w = pk2(v[6][q], v[7][q]);
        *(LAS v4u*)(lds + (4 * lane + q) * 128 + ((wave ^ (lane & 7)) << 4)) = o; }
    asm volatile("s_waitcnt lgkmcnt(0)\n\ts_barrier" ::: "memory");
#pragma unroll
    for (int i = 0; i < 4; ++i) { const int nl = (tid >> 3) + 64 * i, ch = tid & 7;
        if (n0 + nl < ncols) *(GAS v4u*)(dst + (size_t)(r0 + n0 + nl) * ldd + kofs + k0 + ch * 8) = *(const LAS v4u*)(lds + nl * 128 + ((ch ^ ((nl >> 2) & 7)) << 4)); }
}
#define TR_SEG(W_, ldw_, c0_, ncols_, K_, scale_, dst_, ldd_, r0_, kofs_) do { const int _n = ((K_) / 64) * (((ncols_) + 255) / 256); \
    for (int _it = (bx + G - (ibase % G)) % G; _it < _n; _it += G) tr_item(W_, ldw_, c0_, ncols_, scale_, dst_, ldd_, r0_, kofs_, lds, _it, tid); ibase += _n; } while (0)

__device__ __forceinline__ void build_rs_table(const pg8::StaticOrder& S, const float* ssqp, LAS unsigned char* lds, int tid) {
    LAS int* pml = (LAS int*)(lds + RS_OFF); LAS float* tab = (LAS float*)(lds + RS_OFF + 32);
    __syncthreads();
    if (tid == 0) { int npm = 0;
        for (int k = 0; k < pg8::RS_SLOTS; ++k) pml[k] = -1;
        for (int i = 0; ; ++i) { pg8::Unit u; if (!S.next(i, u)) break; bool found = false;
            for (int k = 0; k < npm; ++k) found = found || (pml[k] == u.pm);
            if (!found && npm < pg8::RS_SLOTS) pml[npm++] = u.pm; } }
    __syncthreads();
#pragma unroll 1
    for (int s = tid >> 8; s < pg8::RS_SLOTS; s += 2) { const int pm = pml[s]; if (pm < 0) continue;
        const float* p = ssqp + ((size_t)pm * 256 + (tid & 255)) * 16;
        const f32x4 a = *(const f32x4*)p, b = *(const f32x4*)(p + 4), c = *(const f32x4*)(p + 8), d = *(const f32x4*)(p + 12);
        const float ss = ((a[0] + a[1]) + (a[2] + a[3])) + ((b[0] + b[1]) + (b[2] + b[3])) + ((c[0] + c[1]) + (c[2] + c[3])) + ((d[0] + d[1]) + (d[2] + d[3]));
        tab[s * 256 + (tid & 255)] = rsqrtf(ss * (1.0f / 1024.0f) + 1e-6f); }
    __syncthreads();
}
struct Args { const float* in[23]; float* out; unsigned char* ws; int ph_lo, ph_hi; };
constexpr int NPH = 10, PH_FINAL = DEPTH * NPH, N_PHASES = PH_FINAL + 1;

typedef short bf16x8 __attribute__((ext_vector_type(8)));
constexpr int PT = 72, MAT = 64 * PT * 2;
constexpr int SETB = 4 * MAT + 512;
constexpr int L_Q = 0, L_K = MAT, L_V = 2 * MAT, L_U = 2 * MAT, L_W = 3 * MAT, L_G = 4 * MAT, L_DT = 4 * MAT + 256;
constexpr int L_VT = 2 * SETB, L_ST0 = L_VT + MAT, L_ST1 = L_ST0 + MAT, L_PP = L_ST1 + MAT, L_YT = L_PP + MAT, L_WEND = L_YT + 2 * MAT;
static_assert(L_WEND <= RING_BYTES, "walker LDS");
constexpr size_t GW_OFF = 0, HALO_OFF = 32 * MiB;
constexpr int HALO_LD = 2304;
#define MFMA16(a, b, c) __builtin_amdgcn_mfma_f32_16x16x32_bf16(a, b, c, 0, 0, 0)
__device__ __forceinline__ bf16x8 ldfrag(LAS unsigned char* base, int row, int kelem) { return *(const LAS bf16x8*)(base + row * (PT * 2) + kelem * 2); }
__device__ __forceinline__ void unpk8(const v4u w, float (&f)[8]) { f[0] = pg8::bflo(w.x); f[1] = pg8::bfhi(w.x); f[2] = pg8::bflo(w.y); f[3] = pg8::bfhi(w.y); f[4] = pg8::bflo(w.z); f[5] = pg8::bfhi(w.z); f[6] = pg8::bflo(w.w); f[7] = pg8::bfhi(w.w); }
__device__ __forceinline__ v4u pk8(const float (&f)[8]) { v4u w; w.x = pk2(f[0], f[1]); w.y = pk2(f[2], f[3]); w.z = pk2(f[4], f[5]); w.w = pk2(f[6], f[7]); return w; }
__device__ __forceinline__ void st_tr8(LAS unsigned char* base, int row0, int col, const float (&f)[8]) {
#pragma unroll
    for (int j = 0; j < 8; ++j) *(LAS bf16*)(base + (row0 + j) * (PT * 2) + col * 2) = (bf16)f2bf(f[j]);
}

#define LBAR() asm volatile("s_waitcnt lgkmcnt(0)\n\ts_barrier" ::: "memory")
typedef short s16x4 __attribute__((ext_vector_type(4)));
__device__ __forceinline__ s16x4 tr4(LAS unsigned char* p) { return __builtin_bit_cast(s16x4, __builtin_amdgcn_ds_read_tr16_b64_v4i16((LAS s16x4*)p)); }
__device__ __forceinline__ bf16x8 trfrag(LAS unsigned char* tile, int krow0, int col0, int fr) {
    LAS unsigned char* a = tile + (krow0 + (fr >> 2)) * (PT * 2) + (col0 + 4 * (fr & 3)) * 2;
    const s16x4 lo = tr4(a), hi = tr4(a + 4 * PT * 2);
    return (bf16x8){lo[0], lo[1], lo[2], lo[3], hi[0], hi[1], hi[2], hi[3]};
}
__device__ __forceinline__ float bfs(short v) { return __uint_as_float((unsigned)(unsigned short)v << 16); }
__device__ __forceinline__ float sum8(float v) {
    v += __int_as_float(__builtin_amdgcn_update_dpp(0, __float_as_int(v), 0xB1, 0xF, 0xF, true));
    v += __int_as_float(__builtin_amdgcn_update_dpp(0, __float_as_int(v), 0x4E, 0xF, 0xF, true));
    v += __int_as_float(__builtin_amdgcn_update_dpp(0, __float_as_int(v), 0x141, 0xF, 0xF, true));
    return v;
}
typedef short bf16x4 __attribute__((ext_vector_type(4)));
#define MFMA16K16(a, b, c) __builtin_amdgcn_mfma_f32_16x16x16bf16_1k(a, b, c, 0, 0, 0)
__device__ __forceinline__ bf16x4 pk4(const pg8::f32x4 v) { v2u w; w.x = pk2(v[0], v[1]); w.y = pk2(v[2], v[3]); return __builtin_bit_cast(bf16x4, w); }

template <int KIND>
__device__ __forceinline__ void mixer_walk(const __attribute__((address_space(4))) Args* kp, int layer, int b, int h, LAS unsigned char* lds, const int pm = 0) {
    int tid = threadIdx.x; asm volatile("" : "+v"(tid));
    const int lane = tid & 63, wave = __builtin_amdgcn_readfirstlane(tid >> 6), fr = lane & 15, fq = lane >> 4;
    const int prow = tid >> 3, pcg = tid & 7;
    unsigned char* ws = kp->ws;
    const bf16* MIX = (const bf16*)(ws + WS_MIX); bf16* ZB = (bf16*)(ws + WS_ZB); float* SM = (float*)(ws + WS_SM);
    const bf16* GW = (const bf16*)(ws + ((layer & 1) ? WS_XB0 : WS_XB1) + GW_OFF);
    const size_t tok0 = (size_t)b * SEQ;
    const int g = h >> 2;
    const int qcol = (KIND == 0 ? MX_AQ + h * 64 : (KIND == 1 ? MX_BC + g * 64 : MX_CQ + h * 64)) + pcg * 8;
    const int kcol = (KIND == 0 ? MX_AK + h * 64 : (KIND == 1 ? MX_BB + g * 64 : MX_CK + h * 64)) + pcg * 8;
    const int vcol = (KIND == 0 ? MX_AV + h * 64 : (KIND == 1 ? MX_BX + h * 64 : MX_CV + h * 64)) + pcg * 8;
    const int zcol = KIND * 512 + h * 64 + pcg * 8;
    const int gcol = (KIND == 0 ? 8 : 16) + h;
    float nw[8];
    if (KIND == 0) {
#pragma unroll
        for (int j = 0; j < 8; ++j) nw[j] = kp->in[7][layer * 64 + pcg * 8 + j];
    }
    const float p_D = KIND == 1 ? kp->in[12][layer * 8 + h] : 0.f;
    const float p_lg = KIND == 2 ? log1pf(-exp2f(-5.0f - (float)h)) : 0.f;
    for (int i = tid; i < MAT / 4; i += 512) ((LAS unsigned*)(lds + L_ST0))[i] = 0u;
    pg8::f32x4 sacc[4];
#pragma unroll
    for (int i = 0; i < 4; ++i) sacc[i] = (pg8::f32x4){0.f, 0.f, 0.f, 0.f};

    v4u tq, tk, tv, tw, tz; float sg = 0.f, sd = 1.f; (void)tw;
    pg8::f32x4 rc0, rc1, rs0, rs1; (void)rc0; (void)rc1; (void)rs0; (void)rs1;
    const float* ROPE = (const float*)(ws + WS_ROPE);
#define WALK_LOAD(c) do { const size_t row = tok0 + (size_t)(pm ? 0 : (c)) * 64 + prow; \
        tq = *(const GAS v4u*)(MIX + mixh(qcol, row)); tk = *(const GAS v4u*)(MIX + mixh(kcol, row)); tv = *(const GAS v4u*)(MIX + mixh(vcol, row)); \
        if (KIND == 0) tw = *(const GAS v4u*)(GW + gwh(h, pcg * 8, row)); \
        if (KIND == 2) { const float* rp = ROPE + ((c) * 64 + prow) * 32 + (pcg & 3) * 8; rc0 = *(const GAS pg8::f32x4*)rp; rc1 = *(const GAS pg8::f32x4*)(rp + 4); \
            rs0 = *(const GAS pg8::f32x4*)(rp + SEQ * 32); rs1 = *(const GAS pg8::f32x4*)(rp + SEQ * 32 + 4); } \
        tz = *(const GAS v4u*)(ZB + row * ZB_LD + zcol); \
        if (tid < 64) { const size_t r2 = tok0 + (size_t)(pm ? 0 : (c)) * 64 + tid; \
            if (KIND == 2) sg = (float)(tid + 1) * p_lg; else sg = SM[r2 * SM_LD + gcol]; \
            if (KIND == 1) sd = SM[r2 * SM_LD + 24 + h]; } } while (0)
#define WALK_ROT(t_, sc_) do { v4u pw_; pw_.x = __shfl_xor(t_.x, 4); pw_.y = __shfl_xor(t_.y, 4); pw_.z = __shfl_xor(t_.z, 4); pw_.w = __shfl_xor(t_.w, 4); \
        float a_[8], p_[8]; unpk8(t_, a_); unpk8(pw_, p_); const float sg_ = (pcg < 4 ? -(sc_) : (sc_)); \
        _Pragma("unroll") for (int j_ = 0; j_ < 4; ++j_) { a_[j_] = a_[j_] * (rc0[j_] * (sc_)) + p_[j_] * (rs0[j_] * sg_); a_[4 + j_] = a_[4 + j_] * (rc1[j_] * (sc_)) + p_[4 + j_] * (rs1[j_] * sg_); } \
        t_ = pk8(a_); } while (0)
#define WALK_PREP(sb_) do { LAS unsigned char* sp_ = lds + (sb_) * SETB; \
        if (KIND == 2) { WALK_ROT(tq, 1.0f); WALK_ROT(tk, 0.125f); } \
        *(LAS v4u*)(sp_ + L_Q + prow * (PT * 2) + pcg * 16) = tq; *(LAS v4u*)(sp_ + L_K + prow * (PT * 2) + pcg * 16) = tk; \
        *(LAS v4u*)(sp_ + L_V + prow * (PT * 2) + pcg * 16) = tv; \
        if (KIND == 0) *(LAS v4u*)(sp_ + L_W + prow * (PT * 2) + pcg * 16) = tw; \
        if (tid < 64) { ((LAS float*)(sp_ + L_G))[tid] = sg; ((LAS float*)(sp_ + L_DT))[tid] = __expf(rdl(sg, 63) - sg); \
            const float gb_ = __shfl(sg, tid & 48), gn_ = __shfl(sg, (tid & 48) + (tid < 48 ? 16 : 15)); LAS float* ft_ = (LAS float*)(lds + L_PP + (sb_) * 512); \
            ft_[tid] = __expf(sg - gb_); ft_[64 + tid] = __expf(gn_ - sg); } } while (0)

    WALK_LOAD(0);
    WALK_PREP(0);
    v4u zc = tz, xc = tv;
    LBAR();
    asm volatile(".p2align 8" ::: "memory");
    for (int c = 0; c < SEQ / 64; ++c) {
        LAS unsigned char* STc = lds + ((c & 1) ? L_ST1 : L_ST0); LAS unsigned char* STn = lds + ((c & 1) ? L_ST0 : L_ST1);
        LAS unsigned char* sp = lds + (c & 1) * SETB;
        const LAS float* Gv = (const LAS float*)(sp + L_G); const LAS float* Dv = (const LAS float*)(sp + L_DT);
        const LAS float* FTv = (const LAS float*)(lds + L_PP + (c & 1) * 512);
        LAS unsigned char* YTc = lds + L_YT + (c & 1) * MAT;
        if (c + 1 < SEQ / 64) WALK_LOAD(c + 1);
        bf16x8 Qf[2]; bf16x4 Pb[4]; float egl_y = 1.f;
        if (wave < 4) { const int lb = wave;
            Qf[0] = ldfrag(sp + L_Q, 16 * lb + fr, 8 * fq); Qf[1] = ldfrag(sp + L_Q, 16 * lb + fr, 32 + 8 * fq);
            bf16x8 Kb[4][2]; pg8::f32x4 gs[4], ds[4], pacc[4];
#pragma unroll
            for (int sb = 0; sb < 4; ++sb) if (sb <= lb) { Kb[sb][0] = ldfrag(sp + L_K, 16 * sb + fr, 8 * fq); Kb[sb][1] = ldfrag(sp + L_K, 16 * sb + fr, 32 + 8 * fq);
                gs[sb] = *(const LAS pg8::f32x4*)((sb < lb ? FTv + 64 : Gv) + 16 * sb + 4 * fq); ds[sb] = (pg8::f32x4){1.f, 1.f, 1.f, 1.f};
                if (KIND == 1) ds[sb] = *(const LAS pg8::f32x4*)(Dv + 16 * sb + 4 * fq); }
            const float gl = Gv[16 * lb + fr], eAl = FTv[16 * lb + fr];
#pragma unroll
            for (int sb = 0; sb < 4; ++sb) if (sb <= lb) { pacc[sb] = MFMA16(Kb[sb][0], Qf[0], ((pg8::f32x4){0.f, 0.f, 0.f, 0.f})); }
#pragma unroll
            for (int sb = 0; sb < 4; ++sb) if (sb <= lb) { pacc[sb] = MFMA16(Kb[sb][1], Qf[1], pacc[sb]); }
            egl_y = __expf(gl);
#pragma unroll
            for (int sb = 0; sb < 4; ++sb) if (sb <= lb) { pg8::f32x4 pv;
                    if (sb < lb) {
                        const float rowf = eAl * ((sb + 1 == lb) ? 1.0f : __expf(Gv[16 * lb] - Gv[16 * (sb + 1)]));
#pragma unroll
                        for (int r = 0; r < 4; ++r) pv[r] = pacc[sb][r] * rowf * gs[sb][r] * ds[sb][r];
                    } else {
#pragma unroll
                        for (int r = 0; r < 4; ++r) pv[r] = (4 * fq + r <= fr) ? pacc[sb][r] * __expf(gl - gs[sb][r]) * ds[sb][r] : 0.f; }
                    Pb[sb] = pk4(pv); }
        } else if (KIND == 0) { const int wq = wave - 4;
            const bf16x8 Wf0 = ldfrag(sp + L_W, 16 * wq + fr, 8 * fq), Wf1 = ldfrag(sp + L_W, 16 * wq + fr, 32 + 8 * fq);
            bf16x8 Sf[4][2]; s16x4 u4[4]; pg8::f32x4 vacc[4];
#pragma unroll
            for (int eb = 0; eb < 4; ++eb) { Sf[eb][0] = ldfrag(STc, 16 * eb + fr, 8 * fq); Sf[eb][1] = ldfrag(STc, 16 * eb + fr, 32 + 8 * fq);
                u4[eb] = tr4(sp + L_U + (16 * wq + 4 * fq + (fr >> 2)) * (PT * 2) + (16 * eb + 4 * (fr & 3)) * 2); }
#pragma unroll
            for (int eb = 0; eb < 4; ++eb) vacc[eb] = MFMA16(Wf0, Sf[eb][0], ((pg8::f32x4){0.f, 0.f, 0.f, 0.f}));
#pragma unroll
            for (int eb = 0; eb < 4; ++eb) vacc[eb] = MFMA16(Wf1, Sf[eb][1], vacc[eb]);
#pragma unroll
            for (int eb = 0; eb < 4; ++eb) { v2u o; o.x = pk2(bfs(u4[eb][0]) - vacc[eb][0], bfs(u4[eb][1]) - vacc[eb][1]); o.y = pk2(bfs(u4[eb][2]) - vacc[eb][2], bfs(u4[eb][3]) - vacc[eb][3]);
                *(LAS v2u*)(lds + L_VT + (16 * eb + fr) * (PT * 2) + (16 * wq + 4 * fq) * 2) = o; }
        }
        if (KIND == 0) LBAR();
        if (wave < 4) { const int lb = wave;
            bf16x8 Sf[4][2]; bf16x4 Va[4][4]; pg8::f32x4 yacc[4];
#pragma unroll
            for (int eb = 0; eb < 4; ++eb) { Sf[eb][0] = ldfrag(STc, 16 * eb + fr, 8 * fq); Sf[eb][1] = ldfrag(STc, 16 * eb + fr, 32 + 8 * fq);
#pragma unroll
                for (int sb = 0; sb < 4; ++sb) if (sb <= lb) {
                    if (KIND == 0) Va[eb][sb] = *(const LAS bf16x4*)(lds + L_VT + (16 * eb + fr) * (PT * 2) + (16 * sb + 4 * fq) * 2);
                    else Va[eb][sb] = tr4(sp + L_V + (16 * sb + 4 * fq + (fr >> 2)) * (PT * 2) + (16 * eb + 4 * (fr & 3)) * 2); } }
#pragma unroll
            for (int eb = 0; eb < 4; ++eb) yacc[eb] = MFMA16(Sf[eb][0], Qf[0], ((pg8::f32x4){0.f, 0.f, 0.f, 0.f}));
#pragma unroll
            for (int eb = 0; eb < 4; ++eb) yacc[eb] = MFMA16(Sf[eb][1], Qf[1], yacc[eb]);
#pragma unroll
            for (int eb = 0; eb < 4; ++eb) yacc[eb] *= egl_y;
#pragma unroll
            for (int sb = 0; sb < 4; ++sb) if (sb <= lb) {
#pragma unroll
                for (int eb = 0; eb < 4; ++eb) yacc[eb] = MFMA16K16(Va[eb][sb], Pb[sb], yacc[eb]); }
#pragma unroll
            for (int eb = 0; eb < 4; ++eb) { v2u o; o.x = pk2(yacc[eb][0], yacc[eb][1]); o.y = pk2(yacc[eb][2], yacc[eb][3]);
                *(LAS v2u*)(YTc + (16 * lb + fr) * (PT * 2) + (16 * eb + 4 * fq) * 2) = o; }
        } else { const int db = wave - 4;
            const float glast = Gv[63], egl = __expf(glast);
            bf16x8 Kr[2], Vf[4][2]; pg8::f32x4 k0[2], k1[2];
#pragma unroll
            for (int ks = 0; ks < 2; ++ks) { Kr[ks] = trfrag(sp + L_K, 32 * ks + 8 * fq, 16 * db, fr);
                k0[ks] = *(const LAS pg8::f32x4*)(Dv + 32 * ks + 8 * fq); k1[ks] = *(const LAS pg8::f32x4*)(Dv + 32 * ks + 8 * fq + 4); }
#pragma unroll
            for (int eb = 0; eb < 4; ++eb) {
                if (KIND == 0) { Vf[eb][0] = ldfrag(lds + L_VT, 16 * eb + fr, 8 * fq); Vf[eb][1] = ldfrag(lds + L_VT, 16 * eb + fr, 32 + 8 * fq); }
                else { Vf[eb][0] = trfrag(sp + L_V, 8 * fq, 16 * eb, fr); Vf[eb][1] = trfrag(sp + L_V, 32 + 8 * fq, 16 * eb, fr); } }
            bf16x8 Kf[2];
#pragma unroll
            for (int ks = 0; ks < 2; ++ks) { float kf[8];
#pragma unroll
                for (int j = 0; j < 4; ++j) { kf[j] = bfs(Kr[ks][j]) * k0[ks][j]; kf[4 + j] = bfs(Kr[ks][4 + j]) * k1[ks][j]; }
                const v4u kw = pk8(kf); Kf[ks] = __builtin_bit_cast(bf16x8, kw); }
#pragma unroll
            for (int eb = 0; eb < 4; ++eb) sacc[eb] = MFMA16(Kf[0], Vf[eb][0], sacc[eb] * egl);
#pragma unroll
            for (int eb = 0; eb < 4; ++eb) sacc[eb] = MFMA16(Kf[1], Vf[eb][1], sacc[eb]);
#pragma unroll
            for (int eb = 0; eb < 4; ++eb) { v2u o; o.x = pk2(sacc[eb][0], sacc[eb][1]); o.y = pk2(sacc[eb][2], sacc[eb][3]);
                *(LAS v2u*)(STn + (16 * eb + fr) * (PT * 2) + (16 * db + 4 * fq) * 2) = o; }
        }
        const v4u zcur = zc, xcur = xc; (void)xcur;
        if (c + 1 < SEQ / 64) { WALK_PREP((c + 1) & 1); zc = tz; xc = tv; }
        LBAR();
        {
            float y[8], zf[8]; unpk8(*(const LAS v4u*)(YTc + prow * (PT * 2) + pcg * 16), y); unpk8(zcur, zf);
            const size_t row = tok0 + (size_t)c * 64 + prow;
            if (KIND == 1) { float ss = 0.f, xf[8]; unpk8(xcur, xf);
#pragma unroll
                for (int j = 0; j < 8; ++j) { y[j] = (y[j] + p_D * xf[j]) * siluf(zf[j]); ss += y[j] * y[j]; }
                ss = sum8(ss);
                if (pcg == 0 && !pm) SM[row * SM_LD + 16 + h] = ss;
            } else { float ss = 0.f;
#pragma unroll
                for (int j = 0; j < 8; ++j) ss += y[j] * y[j];
                ss = sum8(ss);
                const float rstd = rsqrtf(ss * (1.0f / 64.0f) + 1e-6f);
#pragma unroll
                for (int j = 0; j < 8; ++j) y[j] = y[j] * rstd * (KIND == 0 ? nw[j] : 1.0f) * siluf(zf[j]); }
            if (!pm || y[0] == 1234.567f) *(GAS v4u*)(ZB + row * ZB_LD + zcol) = pk8(y);
        }
    }
#undef WALK_LOAD
#undef WALK_PREP
#undef WALK_ROT
}

constexpr int W2_SET = 3 * MAT + 1280, W2_Q = 0, W2_K = MAT, W2_V = 2 * MAT, W2_G = 3 * MAT, W2_DT = 3 * MAT + 256, W2_KAP = 3 * MAT + 512, W2_FT = 3 * MAT + 768;
constexpr int W2_ST0 = 2 * W2_SET, W2_ST1 = W2_ST0 + MAT, W2_PP = W2_ST1 + MAT, W2_YT = W2_PP + MAT, W2_ZT = W2_YT + 2 * MAT, W2_END = W2_ZT + 3 * 8192;
static_assert(W2_END <= RING_BYTES, "walker2 LDS");
template <int KIND>
__device__ __forceinline__ void mixer_walk2(const __attribute__((address_space(4))) Args* kp, int layer, int b, int h, LAS unsigned char* lds, const int pm = 0) {
    int tid = threadIdx.x; asm volatile("" : "+v"(tid));
    const int lane = tid & 63, wave = __builtin_amdgcn_readfirstlane(tid >> 6), fr = lane & 15, fq = lane >> 4;
    const int grp = wave >> 2, gl = tid & 255, lrow = gl >> 2, i4 = gl & 3;
    const int prow = tid >> 3, pcg = tid & 7;
    unsigned char* ws = kp->ws;
    const bf16* MIX = (const bf16*)(ws + WS_MIX); bf16* ZB = (bf16*)(ws + WS_ZB); float* SM = (float*)(ws + WS_SM); const float* ROPE = (const float*)(ws + WS_ROPE);
    const size_t tok0 = (size_t)b * SEQ;
    const int g = h >> 2;
    const int qcol = (KIND == 1 ? MX_BC + g * 64 : MX_CQ + h * 64) + i4 * 8, kcol = (KIND == 1 ? MX_BB + g * 64 : MX_CK + h * 64) + i4 * 8, vcol = (KIND == 1 ? MX_BX + h * 64 : MX_CV + h * 64) + i4 * 8;
    const int zc0 = KIND * 512 + h * 64;
    const float p_D = KIND == 1 ? kp->in[12][layer * 8 + h] : 0.f;
    const float p_lg = KIND == 2 ? log1pf(-exp2f(-5.0f - (float)h)) : 0.f;
    for (int i = tid; i < MAT / 4; i += 512) ((LAS unsigned*)(lds + W2_ST0))[i] = 0u;
    pg8::f32x4 sacc[4];
#pragma unroll
    for (int i = 0; i < 4; ++i) sacc[i] = (pg8::f32x4){0.f, 0.f, 0.f, 0.f};

    v4u tq0, tq1, tk0, tk1, tv0, tv1, tz0, tz1; float sg = 0.f, sd = 1.f;
    pg8::f32x4 rc0, rc1, rs0, rs1; (void)rc0; (void)rc1; (void)rs0; (void)rs1;
#define W2_FETCH(c) do { const size_t row = tok0 + (size_t)(pm ? 0 : (c)) * 64 + lrow; \
        tq0 = *(const GAS v4u*)(MIX + mixh(qcol, row)); tq1 = *(const GAS v4u*)(MIX + mixh(qcol + 32, row)); tk0 = *(const GAS v4u*)(MIX + mixh(kcol, row)); tk1 = *(const GAS v4u*)(MIX + mixh(kcol + 32, row)); \
        tv0 = *(const GAS v4u*)(MIX + mixh(vcol, row)); tv1 = *(const GAS v4u*)(MIX + mixh(vcol + 32, row)); \
        tz0 = *(const GAS v4u*)(ZB + row * ZB_LD + zc0 + i4 * 8); tz1 = *(const GAS v4u*)(ZB + row * ZB_LD + zc0 + 32 + i4 * 8); \
        if (KIND == 2) { const float* rp = ROPE + ((pm ? 0 : (c)) * 64 + lrow) * 32 + i4 * 8; rc0 = *(const GAS pg8::f32x4*)rp; rc1 = *(const GAS pg8::f32x4*)(rp + 4); \
            rs0 = *(const GAS pg8::f32x4*)(rp + SEQ * 32); rs1 = *(const GAS pg8::f32x4*)(rp + SEQ * 32 + 4); } \
        if (gl < 64) { const size_t r2 = tok0 + (size_t)(pm ? 0 : (c)) * 64 + gl; \
            if (KIND == 2) sg = (float)(gl + 1) * p_lg; else sg = SM[r2 * SM_LD + 16 + h]; \
            if (KIND == 1) sd = SM[r2 * SM_LD + 24 + h]; } } while (0)
#define W2_ROT(ta_, tb_, sc_) do { float a_[8], b_[8], o1_[8], o2_[8]; unpk8(ta_, a_); unpk8(tb_, b_); \
        _Pragma("unroll") for (int j_ = 0; j_ < 4; ++j_) { \
            o1_[j_] = (a_[j_] * rc0[j_] - b_[j_] * rs0[j_]) * (sc_); o2_[j_] = (a_[j_] * rs0[j_] + b_[j_] * rc0[j_]) * (sc_); \
            o1_[4 + j_] = (a_[4 + j_] * rc1[j_] - b_[4 + j_] * rs1[j_]) * (sc_); o2_[4 + j_] = (a_[4 + j_] * rs1[j_] + b_[4 + j_] * rc1[j_]) * (sc_); } \
        ta_ = pk8(o1_); tb_ = pk8(o2_); } while (0)
#define W2_STORE(c, z3_) do { LAS unsigned char* sp_ = lds + ((c) & 1) * W2_SET + lrow * (PT * 2) + i4 * 16; \
        if (KIND == 2) { W2_ROT(tq0, tq1, 1.0f); W2_ROT(tk0, tk1, 0.125f); } \
        *(LAS v4u*)(sp_ + W2_Q) = tq0; *(LAS v4u*)(sp_ + W2_Q + 64) = tq1; *(LAS v4u*)(sp_ + W2_K) = tk0; *(LAS v4u*)(sp_ + W2_K + 64) = tk1; \
        *(LAS v4u*)(sp_ + W2_V) = tv0; *(LAS v4u*)(sp_ + W2_V + 64) = tv1; \
        { LAS unsigned char* zp_ = lds + W2_ZT + (z3_) * 8192 + lrow * 128 + i4 * 16; *(LAS v4u*)zp_ = tz0; *(LAS v4u*)(zp_ + 64) = tz1; } \
        if (gl < 64) { LAS float* gp_ = (LAS float*)(lds + ((c) & 1) * W2_SET + W2_G); gp_[gl] = sg; gp_[64 + gl] = sd; gp_[128 + gl] = __expf(rdl(sg, 63) - sg) * sd; \
            const float gb_ = __shfl(sg, gl & 48), gn_ = __shfl(sg, (gl & 48) + (gl < 48 ? 16 : 15)); gp_[192 + gl] = __expf(sg - gb_); gp_[256 + gl] = __expf(gn_ - sg) * sd; } } while (0)

    if (grp == 0) { W2_FETCH(0); W2_STORE(0, 0); W2_FETCH(2); } else { W2_FETCH(1); }
    LBAR();
    int z3 = 0;
    asm volatile(".p2align 8" ::: "memory");
    for (int c = 0; c < SEQ / 64; ++c) {
        LAS unsigned char* STc = lds + ((c & 1) ? W2_ST1 : W2_ST0); LAS unsigned char* STn = lds + ((c & 1) ? W2_ST0 : W2_ST1);
        LAS unsigned char* sp = lds + (c & 1) * W2_SET;
        const LAS float* Gv = (const LAS float*)(sp + W2_G); const LAS float* Dv = (const LAS float*)(sp + W2_DT);
        const LAS float* FTv = (const LAS float*)(sp + W2_FT);
        LAS unsigned char* YTc = lds + W2_YT + (c & 1) * MAT;
        const int z3n = z3 == 2 ? 0 : z3 + 1;
        if (wave < 4) { const int lb = wave;
            bf16x8 Qf[2];
            Qf[0] = ldfrag(sp + W2_Q, 16 * lb + fr, 8 * fq); Qf[1] = ldfrag(sp + W2_Q, 16 * lb + fr, 32 + 8 * fq);
            bf16x8 Kb[4][2]; pg8::f32x4 gs[4], ds[4], pacc[4];
#pragma unroll
            for (int sb = 0; sb < 4; ++sb) if (sb <= lb) { Kb[sb][0] = ldfrag(sp + W2_K, 16 * sb + fr, 8 * fq); Kb[sb][1] = ldfrag(sp + W2_K, 16 * sb + fr, 32 + 8 * fq);
                gs[sb] = *(const LAS pg8::f32x4*)((sb < lb ? FTv + 64 : Gv) + 16 * sb + 4 * fq); ds[sb] = (pg8::f32x4){1.f, 1.f, 1.f, 1.f};
                if (KIND == 1 && sb == lb) ds[sb] = *(const LAS pg8::f32x4*)(Dv + 16 * sb + 4 * fq); }
            const float gl_ = Gv[16 * lb + fr], eAl = FTv[16 * lb + fr];
#pragma unroll
            for (int sb = 0; sb < 4; ++sb) if (sb <= lb) { pacc[sb] = MFMA16(Kb[sb][0], Qf[0], ((pg8::f32x4){0.f, 0.f, 0.f, 0.f})); }
#pragma unroll
            for (int sb = 0; sb < 4; ++sb) if (sb <= lb) { pacc[sb] = MFMA16(Kb[sb][1], Qf[1], pacc[sb]); }
            bf16x4 Pb[4]; const float egl_y = __expf(gl_);
#pragma unroll
            for (int sb = 0; sb < 4; ++sb) if (sb <= lb) { pg8::f32x4 pv;
                    if (sb < lb) {
                        const float rowf = eAl * ((sb + 1 == lb) ? 1.0f : __expf(Gv[16 * lb] - Gv[16 * (sb + 1)]));
#pragma unroll
                        for (int r = 0; r < 4; ++r) pv[r] = pacc[sb][r] * rowf * gs[sb][r];
                    } else {
#pragma unroll
                        for (int r = 0; r < 4; ++r) { pv[r] = (4 * fq + r <= fr) ? pacc[sb][r] * __expf(gl_ - gs[sb][r]) * ds[sb][r] : 0.f;
                            if (KIND == 1 && 4 * fq + r == fr) pv[r] += p_D; } }
                    Pb[sb] = pk4(pv); }
            pg8::f32x4 yacc[4];
            { bf16x8 Sf[4][2];
#pragma unroll
              for (int eb = 0; eb < 4; ++eb) { Sf[eb][0] = ldfrag(STc, 16 * eb + fr, 8 * fq); Sf[eb][1] = ldfrag(STc, 16 * eb + fr, 32 + 8 * fq); }
#pragma unroll
              for (int eb = 0; eb < 4; ++eb) yacc[eb] = MFMA16(Sf[eb][0], Qf[0], ((pg8::f32x4){0.f, 0.f, 0.f, 0.f}));
#pragma unroll
              for (int eb = 0; eb < 4; ++eb) yacc[eb] = MFMA16(Sf[eb][1], Qf[1], yacc[eb]); }
#pragma unroll
            for (int eb = 0; eb < 4; ++eb) yacc[eb] *= egl_y;
#pragma unroll
            for (int sp2 = 0; sp2 < 2; ++sp2) if (2 * sp2 <= lb) { bf16x4 Va[4][2];
#pragma unroll
                for (int eb = 0; eb < 4; ++eb)
#pragma unroll
                    for (int s2 = 0; s2 < 2; ++s2) if (2 * sp2 + s2 <= lb) Va[eb][s2] = tr4(sp + W2_V + (16 * (2 * sp2 + s2) + 4 * fq + (fr >> 2)) * (PT * 2) + (16 * eb + 4 * (fr & 3)) * 2);
#pragma unroll
                for (int s2 = 0; s2 < 2; ++s2) if (2 * sp2 + s2 <= lb) {
#pragma unroll
                    for (int eb = 0; eb < 4; ++eb) yacc[eb] = MFMA16K16(Va[eb][s2], Pb[2 * sp2 + s2], yacc[eb]); } }
#pragma unroll
            for (int eb = 0; eb < 4; ++eb) { v2u o; o.x = pk2(yacc[eb][0], yacc[eb][1]); o.y = pk2(yacc[eb][2], yacc[eb][3]);
                *(LAS v2u*)(YTc + (16 * lb + fr) * (PT * 2) + (16 * eb + 4 * fq) * 2) = o; }
        } else { const int db = wave - 4;
            const float glast = Gv[63], egl = __expf(glast); const LAS float* Kv = (const LAS float*)(sp + W2_KAP);
            bf16x8 Kr[2], Vf[4][2]; pg8::f32x4 k0[2], k1[2];
#pragma unroll
            for (int ks = 0; ks < 2; ++ks) { Kr[ks] = trfrag(sp + W2_K, 32 * ks + 8 * fq, 16 * db, fr);
                k0[ks] = *(const LAS pg8::f32x4*)(Kv + 32 * ks + 8 * fq); k1[ks] = *(const LAS pg8::f32x4*)(Kv + 32 * ks + 8 * fq + 4); }
#pragma unroll
            for (int eb = 0; eb < 4; ++eb) { Vf[eb][0] = trfrag(sp + W2_V, 8 * fq, 16 * eb, fr); Vf[eb][1] = trfrag(sp + W2_V, 32 + 8 * fq, 16 * eb, fr); }
            bf16x8 Kf[2];
#pragma unroll
            for (int ks = 0; ks < 2; ++ks) { float kf[8];
#pragma unroll
                for (int j = 0; j < 4; ++j) { kf[j] = bfs(Kr[ks][j]) * k0[ks][j]; kf[4 + j] = bfs(Kr[ks][4 + j]) * k1[ks][j]; }
                const v4u kw = pk8(kf); Kf[ks] = __builtin_bit_cast(bf16x8, kw); }
#pragma unroll
            for (int eb = 0; eb < 4; ++eb) sacc[eb] = MFMA16(Kf[0], Vf[eb][0], sacc[eb] * egl);
#pragma unroll
            for (int eb = 0; eb < 4; ++eb) sacc[eb] = MFMA16(Kf[1], Vf[eb][1], sacc[eb]);
#pragma unroll
            for (int eb = 0; eb < 4; ++eb) { v2u o; o.x = pk2(sacc[eb][0], sacc[eb][1]); o.y = pk2(sacc[eb][2], sacc[eb][3]);
                *(LAS v2u*)(STn + (16 * eb + fr) * (PT * 2) + (16 * db + 4 * fq) * 2) = o; }
        }
        if (grp == ((c + 1) & 1)) { if (c + 1 < SEQ / 64) W2_STORE(c + 1, z3n); if (c + 3 < SEQ / 64) W2_FETCH(c + 3); }
        LBAR();
        {
            float y[8], zf[8]; unpk8(*(const LAS v4u*)(YTc + prow * (PT * 2) + pcg * 16), y); unpk8(*(const LAS v4u*)(lds + W2_ZT + z3 * 8192 + prow * 128 + pcg * 16), zf);
            const size_t row = tok0 + (size_t)c * 64 + prow;
            float ss = 0.f;
            if (KIND == 1) {
#pragma unroll
                for (int j = 0; j < 8; ++j) { y[j] = y[j] * siluf(zf[j]); ss += y[j] * y[j]; }
                ss = sum8(ss);
                if (pcg == 0 && !pm) SM[row * SM_LD + 16 + h] = ss;
            } else {
#pragma unroll
                for (int j = 0; j < 8; ++j) ss += y[j] * y[j];
                ss = sum8(ss);
                const float rstd = rsqrtf(ss * (1.0f / 64.0f) + 1e-6f);
#pragma unroll
                for (int j = 0; j < 8; ++j) y[j] = y[j] * rstd * siluf(zf[j]); }
            if (!pm || y[0] == 1234.567f) *(GAS v4u*)(ZB + row * ZB_LD + zc0 + pcg * 8) = pk8(y);
        }
        z3 = z3n;
    }
#undef W2_FETCH
#undef W2_ROT
#undef W2_STORE
}

constexpr int SP_RAW = 0, SP_CW = 67 * 1536, SP_END = SP_CW + 5 * 768 * 4;
static_assert(SP_END <= RING_BYTES, "ssd_prep LDS");
__device__ __forceinline__ void ssd_prep(const __attribute__((address_space(4))) Args* kp, int layer, LAS unsigned char* lds, int G_) {
    int tid = threadIdx.x; asm volatile("" : "+v"(tid));
    const int lane = tid & 63, wave = __builtin_amdgcn_readfirstlane(tid >> 6);
    unsigned char* ws = kp->ws;
    bf16* MIX = (bf16*)(ws + WS_MIX); float* SM = (float*)(ws + WS_SM);
    const bf16* HALO = (const bf16*)(ws + ((layer & 1) ? WS_XB0 : WS_XB1) + HALO_OFF);
    LAS float* CW = (LAS float*)(lds + SP_CW);
    { const float* cw = kp->in[8] + (size_t)layer * 4 * 768; const float* cb = kp->in[9] + (size_t)layer * 768;
      for (int i = tid; i < 768; i += 512) { CW[i] = cw[i]; CW[768 + i] = cw[768 + i]; CW[2 * 768 + i] = cw[2 * 768 + i]; CW[3 * 768 + i] = cw[3 * 768 + i]; CW[4 * 768 + i] = cb[i]; } }
    const float Aexp = expf(kp->in[10][layer * 8 + wave]), dtb = kp->in[11][layer * 8 + wave];
    for (int unit = blockIdx.x; unit < NBATCH * 64; unit += G_) { const int b = unit >> 6, c = unit & 63; const size_t tok0 = (size_t)b * SEQ + (size_t)c * 64;
        LBAR();
        for (int i = tid; i < 67 * 96; i += 512) { const int r = i / 96, pc = i - r * 96; v4u v = (v4u){0u, 0u, 0u, 0u};
            if (r >= 3) v = *(const GAS v4u*)(MIX + mixh(MX_BX + pc * 8, tok0 + r - 3));
            else if (c > 0) v = *(const GAS v4u*)(HALO + ((size_t)(b * 64 + c - 1) * 3 + r) * HALO_LD + MX_BX + pc * 8);
            *(LAS v4u*)(lds + SP_RAW + r * 1536 + pc * 16) = v; }
        { const size_t r2 = tok0 + lane; const float dt = softplusf(SM[r2 * SM_LD + 16 + wave] + dtb); float gs = -Aexp * dt;
#pragma unroll
          for (int o = 1; o < 64; o <<= 1) { const float t_ = __shfl_up(gs, o); if (lane >= o) gs += t_; }
          SM[r2 * SM_LD + 16 + wave] = gs; SM[r2 * SM_LD + 24 + wave] = dt; }
        LBAR();
        for (int i = tid; i < 64 * 96; i += 512) { const int l = i / 96, pc = i - l * 96; float a[8];
            { const pg8::f32x4 b0 = *(const LAS pg8::f32x4*)(CW + 4 * 768 + pc * 8), b1 = *(const LAS pg8::f32x4*)(CW + 4 * 768 + pc * 8 + 4);
              a[0] = b0[0]; a[1] = b0[1]; a[2] = b0[2]; a[3] = b0[3]; a[4] = b1[0]; a[5] = b1[1]; a[6] = b1[2]; a[7] = b1[3]; }
#pragma unroll
            for (int k = 0; k < 4; ++k) { float f[8]; unpk8(*(const LAS v4u*)(lds + SP_RAW + (l + k) * 1536 + pc * 16), f);
                const pg8::f32x4 w0 = *(const LAS pg8::f32x4*)(CW + k * 768 + pc * 8), w1 = *(const LAS pg8::f32x4*)(CW + k * 768 + pc * 8 + 4);
#pragma unroll
                for (int j = 0; j < 4; ++j) { a[j] += w0[j] * f[j]; a[4 + j] += w1[j] * f[4 + j]; } }
#pragma unroll
            for (int j = 0; j < 8; ++j) a[j] = siluf(a[j]);
            *(GAS v4u*)(MIX + mixh(MX_BX + pc * 8, tok0 + l)) = pk8(a); }
    }
    LBAR();
}
constexpr int GQ_RAW = 0, GQ_KN = 67 * 384, GQ_VN = GQ_KN + MAT, GQ_NA = GQ_VN + MAT, GQ_AD = GQ_NA + MAT, GQ_S = GQ_AD + 4 * 16 * 20 * 4, GQ_CW = GQ_S + 512, GQ_TEAM = GQ_CW + 4 * 192 * 4;
static_assert(2 * GQ_TEAM <= RING_BYTES && 2 * MAT <= GQ_KN, "gdn_prep LDS");
__device__ __forceinline__ void gdn_prep(const __attribute__((address_space(4))) Args* kp, int layer, LAS unsigned char* lds_all, int G_) {
    int tid = threadIdx.x; asm volatile("" : "+v"(tid));
    const int team = __builtin_amdgcn_readfirstlane(tid >> 8), j = tid & 255, lane = tid & 63, tw = __builtin_amdgcn_readfirstlane((tid >> 6) & 3), fr = lane & 15, fq = lane >> 4;
    LAS unsigned char* lds = lds_all + team * GQ_TEAM;
    LAS float* AD = (LAS float*)(lds + GQ_AD); LAS float* Gs = (LAS float*)(lds + GQ_S); LAS float* Bs = Gs + 64; LAS float* CW = (LAS float*)(lds + GQ_CW);
    unsigned char* ws = kp->ws;
    bf16* MIX = (bf16*)(ws + WS_MIX); float* SM = (float*)(ws + WS_SM);
    unsigned char* xbf = ws + ((layer & 1) ? WS_XB0 : WS_XB1); bf16* GW = (bf16*)(xbf + GW_OFF); const bf16* HALO = (const bf16*)(xbf + HALO_OFF);
    const float* cw = kp->in[4] + (size_t)layer * 4 * 1536;
    v4u praw[7]; float pcw[3], pbl = 0.f, pal = 0.f;
#define GQ_FETCH(rnd) do { const int u_ = ((rnd) * G_ + (int)blockIdx.x) * 2 + team; const int un_ = u_ < NBATCH * 8 * 64 ? u_ : 0; \
        const int c_ = un_ & 63, h_ = (un_ >> 6) & 7, b_ = un_ >> 9; const size_t tk_ = (size_t)b_ * SEQ + (size_t)c_ * 64; \
        _Pragma("unroll") for (int n = 0; n < 7; ++n) { const int i = j + 256 * n; praw[n] = (v4u){0u, 0u, 0u, 0u}; \
            if (i < 67 * 24) { const int r = i / 24, pc = i - r * 24, col = (pc >> 3) * 512 + h_ * 64 + (pc & 7) * 8; \
                if (r >= 3) praw[n] = *(const GAS v4u*)(MIX + mixh(col, tk_ + r - 3)); \
                else if (c_ > 0) praw[n] = *(const GAS v4u*)(HALO + ((size_t)(b_ * 64 + c_ - 1) * 3 + r) * HALO_LD + col); } } \
        _Pragma("unroll") for (int n = 0; n < 3; ++n) { const int i = j + 256 * n, k = i / 192, cc = i - k * 192; pcw[n] = cw[k * 1536 + (cc >> 6) * 512 + h_ * 64 + (cc & 63)]; } \
        if (tw == 0) { pbl = SM[(tk_ + lane) * SM_LD + h_]; pal = SM[(tk_ + lane) * SM_LD + 8 + h_]; } } while (0)
    GQ_FETCH(0);
    const int nrounds = (NBATCH * 8 * 64 + 2 * G_ - 1) / (2 * G_);
    for (int round = 0; round < nrounds; ++round) {
        const int unit_ = (round * G_ + (int)blockIdx.x) * 2 + team;
        const bool live = unit_ < NBATCH * 8 * 64;
        const int unit = live ? unit_ : 0;
        const int c = unit & 63, h = (unit >> 6) & 7, b = unit >> 9;
        const size_t tok0 = (size_t)b * SEQ + (size_t)c * 64;
        LBAR();
#pragma unroll
        for (int n = 0; n < 7; ++n) { const int i = j + 256 * n; if (i < 67 * 24) { const int r = i / 24, pc = i - r * 24; *(LAS v4u*)(lds + GQ_RAW + r * 384 + pc * 16) = praw[n]; } }
#pragma unroll
        for (int n = 0; n < 3; ++n) CW[j + 256 * n] = pcw[n];
        if (tw == 0) {
            float gsum = -expf(kp->in[5][layer * 8 + h]) * softplusf(pal + kp->in[6][layer * 8 + h]);
#pragma unroll
            for (int o = 1; o < 64; o <<= 1) { const float t_ = __shfl_up(gsum, o); if (lane >= o) gsum += t_; }
            Gs[lane] = gsum; Bs[lane] = sigmf(pbl);
            if (live) SM[(tok0 + lane) * SM_LD + 8 + h] = gsum; }
        if (round + 1 < nrounds) GQ_FETCH(round + 1);
        LBAR();
#pragma unroll 1
        for (int n = 0; n < 3; ++n) { const int i = j + 256 * n, t2 = i / 24, pc = i - t2 * 24, tens = pc >> 3, ch = pc & 7; float a0[8], a1[8];
#pragma unroll
            for (int jj = 0; jj < 8; ++jj) { a0[jj] = 0.f; a1[jj] = 0.f; }
            pg8::f32x4 wl[4], wh[4];
#pragma unroll
            for (int k = 0; k < 4; ++k) { wl[k] = *(const LAS pg8::f32x4*)(CW + k * 192 + pc * 8); wh[k] = *(const LAS pg8::f32x4*)(CW + k * 192 + pc * 8 + 4); }
#pragma unroll
            for (int r = 0; r < 5; ++r) { float f[8]; unpk8(*(const LAS v4u*)(lds + GQ_RAW + (2 * t2 + r) * 384 + pc * 16), f);
                if (r < 4) {
#pragma unroll
                    for (int jj = 0; jj < 4; ++jj) { a0[jj] += wl[r][jj] * f[jj]; a0[4 + jj] += wh[r][jj] * f[4 + jj]; } }
                if (r > 0) {
#pragma unroll
                    for (int jj = 0; jj < 4; ++jj) { a1[jj] += wl[r - 1][jj] * f[jj]; a1[4 + jj] += wh[r - 1][jj] * f[4 + jj]; } } }
            float s0 = 0.f, s1 = 0.f;
#pragma unroll
            for (int jj = 0; jj < 8; ++jj) { a0[jj] = siluf(a0[jj]); a1[jj] = siluf(a1[jj]); s0 += a0[jj] * a0[jj]; s1 += a1[jj] * a1[jj]; }
            s0 = sum8(s0); s1 = sum8(s1);
            const float base = tens == 0 ? 0.125f : 1.0f, c0 = tens == 2 ? 1.0f : rsqrtf(s0 + 1e-6f) * base, c1 = tens == 2 ? 1.0f : rsqrtf(s1 + 1e-6f) * base;
#pragma unroll
            for (int jj = 0; jj < 8; ++jj) { a0[jj] *= c0; a1[jj] *= c1; }
            const v4u o0 = pk8(a0), o1 = pk8(a1); const int t = 2 * t2;
            if (tens == 0) { if (live) { *(GAS v4u*)(MIX + mixh(MX_AQ + h * 64 + ch * 8, tok0 + t)) = o0; *(GAS v4u*)(MIX + mixh(MX_AQ + h * 64 + ch * 8, tok0 + t + 1)) = o1; } }
            else if (tens == 1) { *(LAS v4u*)(lds + GQ_KN + t * (PT * 2) + ch * 16) = o0; *(LAS v4u*)(lds + GQ_KN + (t + 1) * (PT * 2) + ch * 16) = o1;
                if (live) { *(GAS v4u*)(MIX + mixh(MX_AK + h * 64 + ch * 8, tok0 + t)) = o0; *(GAS v4u*)(MIX + mixh(MX_AK + h * 64 + ch * 8, tok0 + t + 1)) = o1; } }
            else { *(LAS v4u*)(lds + GQ_VN + t * (PT * 2) + ch * 16) = o0; *(LAS v4u*)(lds + GQ_VN + (t + 1) * (PT * 2) + ch * 16) = o1; } }
        LBAR();
        for (int id = tw; id < 10; id += 4) { const int lb = id < 1 ? 0 : (id < 3 ? 1 : (id < 6 ? 2 : 3)), sb = id - (lb * (lb + 1)) / 2;
            pg8::f32x4 acc = (pg8::f32x4){0.f, 0.f, 0.f, 0.f};
#pragma unroll
            for (int ks = 0; ks < 2; ++ks) acc = MFMA16(ldfrag(lds + GQ_KN, 16 * lb + fr, 32 * ks + 8 * fq), ldfrag(lds + GQ_KN, 16 * sb + fr, 32 * ks + 8 * fq), acc);
            const int s = 16 * sb + fr; const float gsv = Gs[s];
#pragma unroll
            for (int r = 0; r < 4; ++r) { const int l = 16 * lb + 4 * fq + r; const float v = s < l ? Bs[l] * acc[r] * __expf(Gs[l] - gsv) : 0.f;
                if (lb == sb) AD[(lb * 16 + 4 * fq + r) * 20 + fr] = v;
                else *(LAS bf16*)(lds + GQ_NA + l * (PT * 2) + s * 2) = (bf16)f2bf(-v); } }
        LBAR();
        if (tw == 0) { const int bi = lane >> 4, cc = lane & 15; const LAS float* Ab = AD + bi * 16 * 20; float x[16];
#pragma unroll
            for (int r = 0; r < 16; ++r) { float a = (r == cc) ? 1.0f : 0.0f;
#pragma unroll
                for (int s4 = 0; s4 < r; s4 += 4) { const pg8::f32x4 av = *(const LAS pg8::f32x4*)(Ab + r * 20 + s4);
                    a -= av[0] * x[s4];
                    if (s4 + 1 < r) a -= av[1] * x[s4 + 1];
                    if (s4 + 2 < r) a -= av[2] * x[s4 + 2];
                    if (s4 + 3 < r) a -= av[3] * x[s4 + 3]; }
                x[r] = a; }
#pragma unroll
            for (int r = 0; r < 16; ++r) *(LAS bf16*)(lds + GQ_NA + (16 * bi + r) * (PT * 2) + (16 * bi + cc) * 2) = (bf16)f2bf(x[r]); }
        LBAR();
#pragma unroll 1
        for (int half = 0; half < 2; ++half) { LAS unsigned char* src = lds + (half == 0 ? GQ_VN : GQ_KN); const int c0 = 16 * tw;
            pg8::f32x4 R[4], X[4];
#pragma unroll
            for (int i = 0; i < 4; ++i) { const s16x4 raw = tr4(src + (16 * i + 4 * fq + (fr >> 2)) * (PT * 2) + (c0 + 4 * (fr & 3)) * 2);
                const pg8::f32x4 bv = *(const LAS pg8::f32x4*)(Bs + 16 * i + 4 * fq); pg8::f32x4 sc = bv;
                if (half == 1) { const pg8::f32x4 gv = *(const LAS pg8::f32x4*)(Gs + 16 * i + 4 * fq); sc = (pg8::f32x4){bv[0] * __expf(gv[0]), bv[1] * __expf(gv[1]), bv[2] * __expf(gv[2]), bv[3] * __expf(gv[3])}; }
                R[i] = (pg8::f32x4){bfs(raw[0]) * sc[0], bfs(raw[1]) * sc[1], bfs(raw[2]) * sc[2], bfs(raw[3]) * sc[3]}; }
#define NAF(ib, jb) (*(const LAS bf16x4*)(lds + GQ_NA + (16 * (ib) + fr) * (PT * 2) + (16 * (jb) + 4 * fq) * 2))
            const pg8::f32x4 Z = (pg8::f32x4){0.f, 0.f, 0.f, 0.f};
            X[0] = MFMA16K16(NAF(0, 0), pk4(R[0]), Z);
            { const bf16x4 x0 = pk4(X[0]); R[1] = MFMA16K16(NAF(1, 0), x0, R[1]); R[2] = MFMA16K16(NAF(2, 0), x0, R[2]); R[3] = MFMA16K16(NAF(3, 0), x0, R[3]); }
            X[1] = MFMA16K16(NAF(1, 1), pk4(R[1]), Z);
            { const bf16x4 x1 = pk4(X[1]); R[2] = MFMA16K16(NAF(2, 1), x1, R[2]); R[3] = MFMA16K16(NAF(3, 1), x1, R[3]); }
            X[2] = MFMA16K16(NAF(2, 2), pk4(R[2]), Z);
            { const bf16x4 x2 = pk4(X[2]); R[3] = MFMA16K16(NAF(3, 2), x2, R[3]); }
            X[3] = MFMA16K16(NAF(3, 3), pk4(R[3]), Z);
#undef NAF
#pragma unroll
            for (int i = 0; i < 4; ++i)
#pragma unroll
                for (int r = 0; r < 4; ++r) *(LAS bf16*)(lds + GQ_RAW + half * MAT + (16 * i + 4 * fq + r) * (PT * 2) + (c0 + fr) * 2) = (bf16)f2bf(X[i][r]);
        }
        LBAR();
        if (live) for (int i = j; i < 64 * 16; i += 256) { const int t = (i >> 3) & 63, ch = i & 7, half = i >> 9;
            const v4u v = *(const LAS v4u*)(lds + GQ_RAW + half * MAT + t * (PT * 2) + ch * 16);
            if (half == 0) *(GAS v4u*)(MIX + mixh(MX_AV + h * 64 + ch * 8, tok0 + t)) = v; else *(GAS v4u*)(GW + gwh(h, ch * 8, tok0 + t)) = v; }
    }
    LBAR();
}
#ifndef MK_ONE_LAUNCH
#define MK_ONE_LAUNCH 1
#endif
#define CONVERT_LAYER(L_, WB_) do { \
            int ibase = 0; \
            const float* w_in = kp->in[3] + (size_t)(L_) * DM * NIN; const float* nmix = kp->in[2] + (size_t)(L_) * DM; \
            TR_SEG(w_in, NIN, 1536, 512, DM, nmix, (bf16*)((WB_) + (W_1T - WS_W)), DM, 0, 0); \
            TR_SEG(w_in, NIN, 2064, 512, DM, nmix, (bf16*)((WB_) + (W_1T - WS_W)), DM, 512, 0); \
            TR_SEG(w_in, NIN, 4888, 512, DM, nmix, (bf16*)((WB_) + (W_1T - WS_W)), DM, 1024, 0); \
            TR_SEG(w_in, NIN, 0, 1536, DM, nmix, (bf16*)((WB_) + (W_1T - WS_W)), DM, 1536, 0); \
            TR_SEG(w_in, NIN, 2576, 768, DM, nmix, (bf16*)((WB_) + (W_1T - WS_W)), DM, 3072, 0); \
            TR_SEG(w_in, NIN, 3352, 1536, DM, nmix, (bf16*)((WB_) + (W_1T - WS_W)), DM, 3840, 0); \
            TR_SEG(w_in, NIN, 2048, 16, DM, nmix, (bf16*)((WB_) + (W_1T - WS_W)), DM, 5376, 0); \
            TR_SEG(w_in, NIN, 3344, 8, DM, nmix, (bf16*)((WB_) + (W_1T - WS_W)), DM, 5392, 0); \
            TR_SEG((const float*)nullptr, NIN, 0, 232, DM, (const float*)nullptr, (bf16*)((WB_) + (W_1T - WS_W)), DM, 5400, 0); \
            { unsigned char* W8_ = (unsigned char*)(WB_) + (W_GT - WS_W);        \
              for (int idx_ = bx * 512 + tid; idx_ < NGATE * 64; idx_ += G * 512) { const int n_ = idx_ % NGATE, kb_ = idx_ / NGATE; const float* wp_ = w_in + (size_t)(16 * kb_) * NIN + 5400 + n_; const float* sc_ = nmix + 16 * kb_; v4u o_; \
                  _Pragma("unroll") for (int q_ = 0; q_ < 4; ++q_) { unsigned d_ = 0u; \
                      d_ = __builtin_amdgcn_cvt_pk_fp8_f32(wp_[(size_t)(4 * q_) * NIN] * (sc_[4 * q_] * 64.0f), wp_[(size_t)(4 * q_ + 1) * NIN] * (sc_[4 * q_ + 1] * 64.0f), d_, false); \
                      d_ = __builtin_amdgcn_cvt_pk_fp8_f32(wp_[(size_t)(4 * q_ + 2) * NIN] * (sc_[4 * q_ + 2] * 64.0f), wp_[(size_t)(4 * q_ + 3) * NIN] * (sc_[4 * q_ + 3] * 64.0f), d_, true); o_[q_] = d_; } \
                  *(GAS v4u*)(W8_ + (size_t)n_ * DM + 16 * kb_) = o_; } } \
            const float* wbr = kp->in[14] + (size_t)(L_) * 3 * 512 * DM; \
            TR_SEG(wbr, DM, 0, DM, 512, (const float*)nullptr, (bf16*)((WB_) + (W_MT - WS_W)), KMERGE, 0, 0); \
            TR_SEG(wbr + 512 * DM, DM, 0, DM, 512, kp->in[13] + (size_t)(L_) * 512, (bf16*)((WB_) + (W_MT - WS_W)), KMERGE, 0, 512); \
            TR_SEG(wbr + 2 * 512 * DM, DM, 0, DM, 512, (const float*)nullptr, (bf16*)((WB_) + (W_MT - WS_W)), KMERGE, 0, 1024); \
            TR_SEG(kp->in[15] + (size_t)(L_) * DM * DM, DM, 0, DM, DM, (const float*)nullptr, (bf16*)((WB_) + (W_OT - WS_W)), DM, 0, 0); \
            TR_SEG(kp->in[17] + (size_t)(L_) * DM * DFF, DFF, 0, DFF, DM, kp->in[16] + (size_t)(L_) * DM, (bf16*)((WB_) + (W_UT - WS_W)), DM, 0, 0); \
            TR_SEG(kp->in[18] + (size_t)(L_) * DFF * DM, DM, 0, DM, DFF, (const float*)nullptr, (bf16*)((WB_) + (W_DT - WS_W)), DFF, 0, 0); \
            TR_SEG(kp->in[20] + (size_t)(L_) * DM * DM, DM, 0, DM, DM, kp->in[19] + (size_t)(L_) * DM, (bf16*)((WB_) + (W_PGT - WS_W)), DM, 0, 0); \
            TR_SEG(kp->in[21] + (size_t)(L_) * PLED * DM, DM, 0, DM, PLED, (const float*)nullptr, (bf16*)((WB_) + (W_PPT - WS_W)), PLED, 0, 0); \
        } while (0)
__global__ void __launch_bounds__(512, 2) fwd_kernel(Args args) {
    extern __shared__ __attribute__((aligned(16))) unsigned char lds_raw[];
    LAS unsigned char* lds0 = (LAS unsigned char*)lds_raw;
    volatile LAS unsigned* MISC = (volatile LAS unsigned*)(lds0 + MISC_OFF);
    const int G = gridDim.x, NGW = G * 8;
    unsigned char* ws0 = args.ws;
    for (int u = threadIdx.x; u < (LDS_BYTES - RING_BYTES) / 4; u += 512) ((LAS unsigned*)(lds0 + RING_BYTES))[u] = 0u;
    __syncthreads();
#if MK_ONE_LAUNCH
    XcdBarrier bar = xcd_barrier_post((unsigned*)(ws0 + WS_CTL) + 4096, MISC + 8);
#define GRID_BAR() do { XcdBarrier b_ = bar; asm volatile("" : "+s"(b_.bar), "+s"(b_.x)); xcd_barrier(b_); } while (0)
#else
#define GRID_BAR() do {} while (0)
#endif
    const int lo = args.ph_lo, hi = args.ph_hi; (void)lo; (void)hi;
#if MK_ONE_LAUNCH
#define IN(p) true
#else
#define IN(p) (lo <= (p) && (p) < hi)
#endif
#define SEAM(p) do { if (IN(p) && IN((p) + 1)) GRID_BAR(); } while (0)
    typedef const __attribute__((address_space(4))) Args* KArgs;
    const KArgs kp0 = (KArgs)__builtin_amdgcn_kernarg_segment_ptr();
#define PHASE_PTRS() KArgs kp = kp0; asm volatile("" : "+s"(kp)); unsigned char* ws = kp->ws; float* X = kp->out; (void)X; \
    LAS unsigned char* lds = lds0; \
    int tid = threadIdx.x; asm volatile("" : "+v"(tid)); int bx = blockIdx.x; asm volatile("" : "+s"(bx)); const int lane = tid & 63, wave = __builtin_amdgcn_readfirstlane(tid >> 6), gw = bx * 8 + wave; (void)lane; (void)gw; \
    bf16* ZB = (bf16*)(ws + WS_ZB); bf16* MIX = (bf16*)(ws + WS_MIX); float* SM = (float*)(ws + WS_SM); (void)ZB; (void)MIX; (void)SM; \
    unsigned char* wbase = (layer & 1) ? (unsigned char*)X + 80 * MiB : ws + WS_W;     \
    float* SSQA = (float*)(wbase + (WS_SSQA - WS_W)); float* SSQB = (float*)(wbase + (WS_SSQB - WS_W)); float* SSQC = (float*)(ws + WS_SSQC); float* ROPE = (float*)(ws + WS_ROPE); (void)SSQA; (void)SSQB; (void)SSQC; (void)ROPE; \
    bf16* W1T = (bf16*)(wbase + (W_1T - WS_W)); bf16* WGT = (bf16*)(wbase + (W_GT - WS_W)); bf16* WMT = (bf16*)(wbase + (W_MT - WS_W)); bf16* WOT = (bf16*)(wbase + (W_OT - WS_W)); bf16* WUT = (bf16*)(wbase + (W_UT - WS_W)); (void)W1T; (void)WGT; (void)WMT; (void)WOT; (void)WUT; \
    bf16* WDT = (bf16*)(wbase + (W_DT - WS_W)); bf16* WPGT = (bf16*)(wbase + (W_PGT - WS_W)); bf16* WPPT = (bf16*)(wbase + (W_PPT - WS_W)); (void)WDT; (void)WPGT; (void)WPPT; \
    bf16* GATE = (bf16*)(ws + WS_GATE); bf16* U = (bf16*)(ws + WS_U); bf16* PB = (bf16*)X; bf16* PLE = (bf16*)X + (size_t)MTOK * PLED;     (void)GATE; (void)U; (void)PB; (void)PLE; \
    bf16* XBl = (bf16*)(ws + ((layer & 1) ? WS_XB1 : WS_XB0)); bf16* XBf = (bf16*)(ws + ((layer & 1) ? WS_XB0 : WS_XB1)); (void)XBl; (void)XBf; \
    unsigned char* X8 = (layer & 1) ? ws + X8_L1_WS : (unsigned char*)X + X8_L0_OUT; unsigned char* W8G = wbase + (W_GT - WS_W); (void)X8; (void)W8G
    if (IN(0)) { const int layer = 0; PHASE_PTRS();
        for (int e = bx * 512 + tid; e < SEQ * 32; e += G * 512) { const int t = e >> 5, i = e & 31;
            double f = 1.0; for (int j = 0; j < i; ++j) f *= 0.7429639507594948;
            const double ang = (double)t * f, kk = rint(ang * 0.15915494309189535);
            double r = fma(-kk, 6.283185307179586, ang); r = fma(-kk, 2.4492935982947064e-16, r); const double r2 = r * r;
            double sn = 1.0, cs = 1.0;
    #pragma unroll
            for (int n = 15; n >= 1; --n) { sn = 1.0 - r2 * (1.0 / (double)((2 * n) * (2 * n + 1))) * sn; cs = 1.0 - r2 * (1.0 / (double)((2 * n - 1) * (2 * n))) * cs; }
            ROPE[e] = (float)cs; ROPE[SEQ * 32 + e] = (float)(r * sn); }
    }
    for (int layer = 0; layer < DEPTH; ++layer) {
        const int P = layer * NPH;
        if (IN(P + 0)) { PHASE_PTRS();
            if (layer == 0 || G <= 192) CONVERT_LAYER(layer, wbase);
            if (layer == 0) {
                const float* xin = kp->in[0];
                for (int m = gw; m < MTOK; m += NGW) {
                    const GAS f32x4* xr = (const GAS f32x4*)(xin + (size_t)m * DM) + lane; f32x4 v[4]; float s = 0.f;
#pragma unroll
                    for (int j = 0; j < 4; ++j) { v[j] = xr[64 * j]; s += (v[j].x * v[j].x + v[j].y * v[j].y) + (v[j].z * v[j].z + v[j].w * v[j].w); }
                    s = wave_sum(s);
                    GAS v2u* o8 = (GAS v2u*)(XBl + (size_t)m * DM) + lane;
#pragma unroll
                    for (int j = 0; j < 4; ++j) { v2u w; w.x = pk2(v[j].x, v[j].y); w.y = pk2(v[j].z, v[j].w); o8[64 * j] = w; }
                    GAS unsigned* o4 = (GAS unsigned*)(X8 + (size_t)m * DM) + lane;
#pragma unroll
                    for (int j = 0; j < 4; ++j) { unsigned w = 0u; w = __builtin_amdgcn_cvt_pk_fp8_f32(v[j].x, v[j].y, w, false); w = __builtin_amdgcn_cvt_pk_fp8_f32(v[j].z, v[j].w, w, true); o4[64 * j] = w; }
                    if (lane < 16) SSQC[(size_t)m * 16 + lane] = lane == 0 ? s : 0.f;
                }
            }
        }
        if (layer == 0 || G <= 192) SEAM(P + 0);
        if (IN(P + 1)) { PHASE_PTRS();
            pg8::Gemm g{XBl, W1T, MTOK, N1, DM}; pg8::StaticOrder S; S.init(MTOK, N1, G, bx);
            build_rs_table(S, SSQC, lds, tid);
            pg8::EpiP1 E{ZB, MIX, SM, lds + RS_OFF, (bf16*)((unsigned char*)XBf + HALO_OFF),  0u};
            pg8::gemm_phase<pg8::EpiP1, pg8::StaticOrder, true, true>(lds, g, S, E);
        }
        SEAM(P + 1);
        if (IN(P + 2)) { PHASE_PTRS();
            gdn_prep(kp, layer, lds, G);
            ssd_prep(kp, layer, lds, G);
            const float* pl = kp->in[1] + (size_t)layer * MTOK * PLED;
            for (size_t e = (size_t)bx * 512 + tid; e < (size_t)MTOK * PLED / 4; e += (size_t)G * 512) { const f32x4 v = ((const GAS f32x4*)pl)[e]; v2u w; w.x = pk2(v.x, v.y); w.y = pk2(v.z, v.w); ((GAS v2u*)PB)[e] = w; }
        }
        SEAM(P + 2);
        if (IN(P + 3)) { PHASE_PTRS();
            for (int w = bx; w < 192; w += G) { const int kind = w >> 6, b = (w & 63) >> 3, h = w & 7;
                if (kind == 0) mixer_walk<0>(kp, layer, b, h, lds);
                else if (kind == 1) mixer_walk2<1>(kp, layer, b, h, lds);
                else mixer_walk2<2>(kp, layer, b, h, lds);
                __syncthreads(); }
            if (layer == 0 && bx >= 192 && G > 192) {
                const int bx_ = bx, G_ = G; { const int bx = bx_ - 192, G = G_ - 192; CONVERT_LAYER(1, (unsigned char*)X + 80 * MiB); }
            } else if (layer == 1 && (bx >= 192 || G <= 192)) {
                pg8::Gemm g{PB, WPPT, MTOK / 2, DM, PLED}; pg8::StaticOrder S; if (G > 192) S.init(MTOK / 2, DM, G - 192, bx - 192); else S.init(MTOK / 2, DM, G, bx);
                pg8::EpiRS<0> E{PLE, DM, (LAS unsigned char*)nullptr};
                pg8::gemm_phase<pg8::EpiRS<0>, pg8::StaticOrder, true, true>(lds, g, S, E); }
        }
        SEAM(P + 3);
        if (IN(P + 4)) { PHASE_PTRS();
            for (int m = bx * 512 + tid; m < MTOK; m += G * 512) {
                float* sp = SM + (size_t)m * SM_LD + 16; const f32x4 q0 = *(const f32x4*)sp, q1 = *(const f32x4*)(sp + 4);
                const float v0 = ((q0[0] + q0[1]) + (q0[2] + q0[3])) * (1.0f / 256.0f) + 1e-6f, v1 = ((q1[0] + q1[1]) + (q1[2] + q1[3])) * (1.0f / 256.0f) + 1e-6f;
                const float r0 = __builtin_amdgcn_sqrtf(v0), s1 = __builtin_amdgcn_rsqf(v1);
                *(f32x4*)(sp + 8) = (f32x4){r0, __builtin_amdgcn_rsqf(v0) * __builtin_amdgcn_sqrtf(v1), s1, 0.f}; }
            pg8::Gemm g{(const bf16*)X8, (const bf16*)W8G, MTOK, NGATE, DM / 2}; pg8::StaticOrder S; S.init(MTOK, NGATE, G, bx);
            build_rs_table(S, SSQC, lds, tid);
            pg8::EpiRS<2> E{GATE, NGATE, lds + RS_OFF, 1.0f / 64.0f};
            pg8::gemm_phase<pg8::EpiRS<2>, pg8::StaticOrder, true, true, 0, true>(lds, g, S, E);
        }
        SEAM(P + 4);
        if (IN(P + 5)) { PHASE_PTRS();
            pg8::Gemm g{ZB, WMT, MTOK, DM, KMERGE}; pg8::StaticOrder S; S.init(MTOK, DM, G, bx);
            pg8::EpiMerge E{GATE, XBf, SM};
            pg8::gemm_phase<pg8::EpiMerge, pg8::StaticOrder, true, true>(lds, g, S, E);
        }
        SEAM(P + 5);
        if (IN(P + 6)) { PHASE_PTRS();
            pg8::Gemm g{XBf, WOT, MTOK, DM, DM}; pg8::StaticOrder S; S.init(MTOK, DM, G, bx);
            pg8::EpiResid<0> E{XBl, XBl, SSQA, (LAS unsigned char*)nullptr, nullptr,  1.0f};
            pg8::gemm_phase<pg8::EpiResid<0>, pg8::StaticOrder, true, true>(lds, g, S, E);
        }
        SEAM(P + 6);
        if (IN(P + 7)) { PHASE_PTRS();
            { pg8::Gemm g{XBl, WUT, MTOK, DFF, DM}; pg8::StaticOrder S; S.init(MTOK, DFF, G, bx);
              build_rs_table(S, SSQA, lds, tid);
              pg8::EpiRS<1> E{U, DFF, lds + RS_OFF};
              pg8::gemm_phase<pg8::EpiRS<1>, pg8::StaticOrder, true, true>(lds, g, S, E); }
        }
        SEAM(P + 7);
        if (IN(P + 8)) { PHASE_PTRS();
            pg8::Gemm g{U, WDT, MTOK, DM, DFF}; pg8::StaticOrder S; S.init(MTOK, DM, G, bx);
            pg8::EpiResid<0> E{XBl, XBl, SSQB, (LAS unsigned char*)nullptr, nullptr,  1.0f};
            pg8::gemm_phase<pg8::EpiResid<0>, pg8::StaticOrder, true, true>(lds, g, S, E);
            __builtin_amdgcn_sched_barrier(0);
            { const int r0 = layer == 0 ? 0 : MTOK / 2;
              pg8::Gemm g2{PB + (size_t)r0 * PLED, WPPT, MTOK - r0, DM, PLED}; pg8::StaticOrder S2; S2.init(MTOK - r0, DM, G, bx);
              pg8::EpiRS<0> E2{PLE + (size_t)r0 * DM, DM, (LAS unsigned char*)nullptr};
              pg8::gemm_phase<pg8::EpiRS<0>, pg8::StaticOrder, true, true>(lds, g2, S2, E2); }
        }
        SEAM(P + 8);
        if (IN(P + 9)) { PHASE_PTRS();
            pg8::Gemm g{XBl, WPGT, MTOK, DM, DM}; pg8::StaticOrder S; S.init(MTOK, DM, G, bx);
            build_rs_table(S, SSQB, lds, tid);
            pg8::EpiResid<1> E{XBl, XBf, SSQC, lds + RS_OFF, PLE,  1.0f, layer + 1 < DEPTH ? ws + X8_L1_WS : (unsigned char*)nullptr, 1.0f};
            pg8::gemm_phase<pg8::EpiResid<1>, pg8::StaticOrder, true, true>(lds, g, S, E);
        }
        SEAM(P + 9);
    }
    if (IN(PH_FINAL)) { const int layer = DEPTH; PHASE_PTRS();
        const float* nf = kp->in[22];
        for (int m = gw; m < MTOK; m += NGW) {
            const float sp = lane < 16 ? SSQC[(size_t)m * 16 + lane] : 0.f;
            const float rstd = rsqrtf(wave_sum(sp) * (1.0f / 1024.0f) + 1e-6f);
            const GAS v4u* xr = (const GAS v4u*)(XBl + (size_t)m * DM) + lane; GAS f32x4* orow = (GAS f32x4*)(X + (size_t)m * DM);
#pragma unroll
            for (int j = 0; j < 2; ++j) { const v4u w = xr[64 * j]; const int c8 = (64 * j + lane) * 2; const f32x4 g0 = ((const GAS f32x4*)nf)[c8], g1 = ((const GAS f32x4*)nf)[c8 + 1];
                f32x4 o0, o1; o0[0] = pg8::bflo(w.x); o0[1] = pg8::bfhi(w.x); o0[2] = pg8::bflo(w.y); o0[3] = pg8::bfhi(w.y); o1[0] = pg8::bflo(w.z); o1[1] = pg8::bfhi(w.z); o1[2] = pg8::bflo(w.w); o1[3] = pg8::bfhi(w.w);
                orow[c8] = o0 * rstd * g0; orow[c8 + 1] = o1 * rstd * g1; }
        }
    }
#undef IN
#undef SEAM
}

extern "C" void kernel_launch(void* const* d_in, const int* in_sizes, int n_in, void* d_out, int out_size, void* d_ws, size_t ws_size, hipStream_t stream) {
    static int grid = 0;
    if (grid == 0) {
        if (n_in != 23 || out_size != MTOK * DM || ws_size < WS_END) { fprintf(stderr, "kernel_launch: unexpected problem (n_in %d, out %d, ws %zu < %zu)\n", n_in, out_size, ws_size, (size_t)WS_END); grid = -1; return; }
        int dev = 0, cus = 0;
        if (hipGetDevice(&dev) != hipSuccess || hipDeviceGetAttribute(&cus, hipDeviceAttributeMultiprocessorCount, dev) != hipSuccess) { grid = -1; return; }
        if (hipFuncSetAttribute((const void*)fwd_kernel, hipFuncAttributeMaxDynamicSharedMemorySize, LDS_BYTES) != hipSuccess) { fprintf(stderr, "kernel_launch: hipFuncSetAttribute failed\n"); grid = -1; return; }
        int per_cu = 0;
        if (hipOccupancyMaxActiveBlocksPerMultiprocessor(&per_cu, (const void*)fwd_kernel, 512, LDS_BYTES) != hipSuccess || per_cu < 1) { fprintf(stderr, "kernel_launch: occupancy query says %d blocks per CU\n", per_cu); }
        (void)hipGetLastError();
        grid = cus < 256 ? cus : 256;
    }
    if (grid < 0) return;
    (void)hipMemsetAsync((char*)d_ws + WS_CTL, 0, CTL_BYTES, stream);
    Args a; memset(&a, 0, sizeof(a));
    for (int i = 0; i < 23; ++i) a.in[i] = (const float*)d_in[i];
    a.out = (float*)d_out; a.ws = (unsigned char*)d_ws;
#if MK_ONE_LAUNCH
    a.ph_lo = 0; a.ph_hi = N_PHASES;
    hipLaunchKernelGGL(fwd_kernel, dim3(grid), dim3(512), LDS_BYTES, stream, a);
#else
    for (int p = 0; p < N_PHASES; ++p) {
        a.ph_lo = p; a.ph_hi = p + 1;
        hipLaunchKernelGGL(fwd_kernel, dim3(grid), dim3(512), LDS_BYTES, stream, a);
    }
#endif
}
```
